# Optimizing an MI355X kernel written in HIP

```python
import math
import jax
import jax.numpy as jnp
from jax import lax
import numpy as np

D_MODEL = 1024
BATCH = 2
SEQ = 8192
DEPTH = 4

GRID_W = 64
CTX_LEN = 256
HEAD_DIM = 64
N_HEADS = D_MODEL // 128
N_KV_HEADS = N_HEADS // 4
GQA_GROUP = N_HEADS // N_KV_HEADS
ATTN_WIDTH = N_HEADS * HEAD_DIM
KV_WIDTH = N_KV_HEADS * HEAD_DIM
WINDOW = 128
BLOCK = 128
ROPE_THETA = 10000.0
HYENA_ORDER = 2
HYENA_WIDTH = D_MODEL // 4
SHORT_CONV = 3
FILTER_BANDS = 16
FILTER_EMB = 2 * FILTER_BANDS + 1
FILTER_HIDDEN = 64
DECAY_TARGET = 1e-2
FAST_DECAY_PCT = 0.3
SLOW_DECAY_PCT = 1.5
FNET_WIDTH = D_MODEL // 4
FNET_GROUPS = 4
FNET_GROUP_DIM = FNET_WIDTH // FNET_GROUPS
N_BRANCHES = 3
Q_END = ATTN_WIDTH
K_END = Q_END + KV_WIDTH
V_END = K_END + KV_WIDTH
HY_END = V_END + (HYENA_ORDER + 1) * HYENA_WIDTH
FN_END = HY_END + FNET_WIDTH
IN_WIDTH = FN_END + N_BRANCHES * D_MODEL
D_FF = 256 * ((8 * D_MODEL // 3 + 255) // 256)
N_EXPERTS = 8
TOP_K = 2
EPS = 1e-6

kernel_name = "hybrid_dit_swa_hyena_fnet_moe"


def rms_norm(x, g):
    xf = x.astype(jnp.float32)
    y = xf * lax.rsqrt(jnp.mean(jnp.square(xf), axis=-1, keepdims=True) + EPS)
    return (y * g.astype(jnp.float32)).astype(x.dtype)


def modulate(x, g, shift, scale):
    return rms_norm(x, g) * (1 + scale[:, None, :]) + shift[:, None, :]


def adaln(cond, w, b, i):
    lo, hi = 3 * i * D_MODEL, 3 * (i + 1) * D_MODEL
    mod = jax.nn.silu(cond) @ w[:, lo:hi] + b[lo:hi]
    return jnp.split(mod, 3, axis=-1)


def axial_rope_tables(L):
    rows = L // GRID_W
    r, col = jnp.meshgrid(jnp.arange(rows), jnp.arange(GRID_W), indexing="ij")
    pos = jnp.stack([r.reshape(-1), col.reshape(-1)], axis=-1).astype(jnp.float32)
    n_freq = HEAD_DIM // 4
    inv = ROPE_THETA ** (-jnp.arange(n_freq, dtype=jnp.float32) / n_freq)
    ang = pos[:, :, None] * inv
    return jnp.cos(ang), jnp.sin(ang)


def apply_axial_rope(x, cos, sin):
    B, L, H, _ = x.shape
    xf = x.astype(jnp.float32).reshape(B, L, H, 2, 2, HEAD_DIM // 4)
    x1, x2 = xf[..., 0, :], xf[..., 1, :]
    c, s = cos[None, :, None], sin[None, :, None]
    out = jnp.stack([x1 * c - x2 * s, x1 * s + x2 * c], axis=-2)
    return out.reshape(B, L, H, HEAD_DIM).astype(x.dtype)


def q_heads(pr, q_gain):
    B, L, _ = pr.shape
    return rms_norm(pr[..., :Q_END].reshape(B, L, N_HEADS, HEAD_DIM), q_gain)


def kv_heads(pr_kv, k_gain):
    B, L, _ = pr_kv.shape
    k = rms_norm(pr_kv[..., :KV_WIDTH].reshape(B, L, N_KV_HEADS, HEAD_DIM), k_gain)
    v = pr_kv[..., KV_WIDTH:].reshape(B, L, N_KV_HEADS, HEAD_DIM)
    return k, v


def softmax_with_sink(s, sink):
    m = jnp.maximum(jnp.max(s, axis=-1, keepdims=True), sink)
    p = jnp.exp(s - m)
    return p / (jnp.sum(p, axis=-1, keepdims=True) + jnp.exp(sink - m))


def latent_window_attention(q, k, v, k_ctx, v_ctx, sink):
    B, L, _, _ = q.shape
    nb = L // BLOCK
    qb = q.reshape(B, nb, BLOCK, N_KV_HEADS, GQA_GROUP, HEAD_DIM)

    def band(t):
        tp = jnp.pad(t, ((0, 0), (BLOCK, BLOCK), (0, 0), (0, 0)))
        tp = tp.reshape(B, nb + 2, BLOCK, N_KV_HEADS, HEAD_DIM)
        return jnp.concatenate([tp[:, :-2], tp[:, 1:-1], tp[:, 2:]], axis=2)

    kb, vb = band(k), band(v)
    scale = HEAD_DIM ** -0.5
    s_loc = jnp.einsum("bnqhgd,bnjhd->bnhgqj", qb, kb,
                       preferred_element_type=jnp.float32) * scale
    qpos = jnp.arange(nb)[:, None, None] * BLOCK + jnp.arange(BLOCK)[None, :, None]
    kpos = (jnp.arange(nb)[:, None, None] - 1) * BLOCK + jnp.arange(3 * BLOCK)[None, None, :]
    mask = (jnp.abs(qpos - kpos) <= WINDOW) & (kpos >= 0) & (kpos < L)
    s_loc = jnp.where(mask[None, :, None, None], s_loc, -jnp.inf)
    s_ctx = jnp.einsum("bnqhgd,bjhd->bnhgqj", qb, k_ctx,
                       preferred_element_type=jnp.float32) * scale
    s = jnp.concatenate([s_loc, s_ctx], axis=-1)
    sk = sink.astype(jnp.float32).reshape(N_KV_HEADS, GQA_GROUP)[None, None, :, :, None, None]
    p = softmax_with_sink(s, sk).astype(v.dtype)
    n_loc = 3 * BLOCK
    o = (jnp.einsum("bnhgqj,bnjhd->bnqhgd", p[..., :n_loc], vb)
         + jnp.einsum("bnhgqj,bjhd->bnqhgd", p[..., n_loc:], v_ctx))
    return o.reshape(B, L, ATTN_WIDTH)


def context_attention(q, k, v, sink):
    B, C, _, _ = q.shape
    qg = q.reshape(B, C, N_KV_HEADS, GQA_GROUP, HEAD_DIM)
    s = jnp.einsum("bqhgd,bjhd->bhgqj", qg, k,
                   preferred_element_type=jnp.float32) * HEAD_DIM ** -0.5
    sk = sink.astype(jnp.float32).reshape(N_KV_HEADS, GQA_GROUP)[None, :, :, None, None]
    p = softmax_with_sink(s, sk).astype(v.dtype)
    o = jnp.einsum("bhgqj,bjhd->bqhgd", p, v)
    return o.reshape(B, C, ATTN_WIDTH)


def hyena_filter_spectrum(L, w1, b1, fr1, w2, b2, fr2, w3):
    f32 = jnp.float32
    t = jnp.linspace(0.0, 1.0, L, dtype=f32)[:, None]
    w = 2.0 * math.pi * jnp.arange(L, dtype=f32)[:, None] / L
    fb = jnp.linspace(1e-4, FILTER_BANDS - 1, FILTER_BANDS, dtype=f32)
    z = jnp.concatenate([t, jnp.cos(fb * w), -jnp.sin(fb * w)], axis=-1)
    h = jnp.sin(fr1.astype(f32) * (z @ w1.astype(f32) + b1.astype(f32)))
    h = jnp.sin(fr2.astype(f32) * (h @ w2.astype(f32) + b2.astype(f32)))
    h = (h @ w3.astype(f32)).reshape(L, 2, HYENA_ORDER, HYENA_WIDTH)
    deltas = jnp.abs(jnp.linspace(math.log(DECAY_TARGET) / SLOW_DECAY_PCT,
                                  math.log(DECAY_TARGET) / FAST_DECAY_PCT,
                                  HYENA_WIDTH, dtype=f32))
    h = h * jnp.exp(-t * deltas)[:, None, None, :]
    k = jnp.concatenate([h[:, 0], jnp.zeros_like(h[:1, 0]), h[:0:-1, 1]], axis=0)
    k = k / jnp.sum(jnp.abs(k), axis=0, keepdims=True)
    return jnp.fft.rfft(k, axis=0)


def hyena_mixer(u, conv_w, conv_b, k_spec, bias):
    L = u.shape[1]
    uc = lax.conv_general_dilated(u, conv_w, window_strides=(1,),
                                  padding=((SHORT_CONV // 2, SHORT_CONV // 2),),
                                  dimension_numbers=("NWC", "WIO", "NWC"),
                                  feature_group_count=u.shape[-1]) + conv_b
    *gates, z = jnp.split(uc.astype(jnp.float32), HYENA_ORDER + 1, axis=-1)
    for o, gate in enumerate(gates):
        zc = jnp.fft.irfft(jnp.fft.rfft(z, n=2 * L, axis=1) * k_spec[None, :, o],
                           n=2 * L, axis=1)[:, :L]
        z = gate * (zc + bias[o].astype(jnp.float32) * z)
    return z.astype(u.dtype)


def fnet_mixer(u):
    B, L, _ = u.shape
    ug = u.astype(jnp.float32).reshape(B, L, FNET_GROUPS, FNET_GROUP_DIM).transpose(0, 2, 1, 3)
    y = jnp.fft.fft2(ug, norm="ortho").real
    return y.transpose(0, 2, 1, 3).reshape(B, L, FNET_WIDTH).astype(u.dtype)


def merge_branches(pr, attn_o, hy_o, fn_o, w_pa, w_ph, w_pf, w_o):
    B, L, _ = pr.shape
    g = jax.nn.sigmoid(pr[..., FN_END:].reshape(B, L, N_BRANCHES, D_MODEL))
    m = (g[:, :, 0] * (attn_o @ w_pa) + g[:, :, 1] * (hy_o @ w_ph) + g[:, :, 2] * (fn_o @ w_pf))
    return m @ w_o


def swiglu(h, wg, wu, wd):
    return (jax.nn.silu(h @ wg) * (h @ wu)) @ wd


def moe_swiglu(h, w_router, wg, wu, wd):
    logits = jnp.einsum("bld,de->ble", h, w_router).astype(jnp.float32)
    top_val, top_idx = lax.top_k(logits, TOP_K)
    top_w = jax.nn.softmax(top_val, axis=-1)
    combine = jnp.einsum("blk,blke->ble", top_w,
                         jax.nn.one_hot(top_idx, N_EXPERTS, dtype=jnp.float32)).astype(h.dtype)
    out = jnp.zeros_like(h)
    for e in range(N_EXPERTS):
        out = out + combine[..., e:e + 1] * swiglu(h, wg[e], wu[e], wd[e])
    return out


def setup_inputs(seed: int = 0) -> dict:
    key = jax.random.key(seed)
    ks = iter(jax.random.split(key, 40))

    def nrm(shape, scale=1.0):
        return jax.random.normal(next(ks), shape, jnp.float32) * scale

    D, W, E, F = D_MODEL, HYENA_WIDTH, N_EXPERTS, D_FF
    n_dense, n_moe = (DEPTH + 1) // 2, DEPTH // 2
    return {
        "x": nrm((BATCH, SEQ, D)),
        "c": nrm((BATCH, D)),
        "ctx": nrm((BATCH, CTX_LEN, D)),
        "c_ctx": nrm((D,)),
        "w_ada": nrm((DEPTH, D, 6 * D), 0.5 * D ** -0.5),
        "b_ada": nrm((DEPTH, 6 * D), 0.01),
        "norm1_g": 1.0 + nrm((DEPTH, D), 0.02),
        "norm2_g": 1.0 + nrm((DEPTH, D), 0.02),
        "w_in": nrm((DEPTH, D, IN_WIDTH), D ** -0.5),
        "q_norm_g": 1.0 + nrm((DEPTH, HEAD_DIM), 0.02),
        "k_norm_g": 1.0 + nrm((DEPTH, HEAD_DIM), 0.02),
        "attn_sink": nrm((DEPTH, N_HEADS), 0.5),
        "hy_conv_w": nrm((DEPTH, SHORT_CONV, 1, (HYENA_ORDER + 1) * W), SHORT_CONV ** -0.5),
        "hy_conv_b": nrm((DEPTH, (HYENA_ORDER + 1) * W), 0.02),
        "hy_filt_w1": nrm((DEPTH, FILTER_EMB, FILTER_HIDDEN), FILTER_EMB ** -0.5),
        "hy_filt_b1": nrm((DEPTH, FILTER_HIDDEN), 0.1),
        "hy_filt_freq1": 1.0 + nrm((DEPTH, FILTER_HIDDEN), 0.02),
        "hy_filt_w2": nrm((DEPTH, FILTER_HIDDEN, FILTER_HIDDEN), FILTER_HIDDEN ** -0.5),
        "hy_filt_b2": nrm((DEPTH, FILTER_HIDDEN), 0.1),
        "hy_filt_freq2": 1.0 + nrm((DEPTH, FILTER_HIDDEN), 0.02),
        "hy_filt_w3": nrm((DEPTH, FILTER_HIDDEN, 2 * HYENA_ORDER * W), FILTER_HIDDEN ** -0.5),
        "hy_bias": nrm((DEPTH, HYENA_ORDER, W)),
        "w_proj_attn": nrm((DEPTH, ATTN_WIDTH, D), ATTN_WIDTH ** -0.5),
        "w_proj_hyena": nrm((DEPTH, W, D), W ** -0.5),
        "w_proj_fnet": nrm((DEPTH, FNET_WIDTH, D), FNET_WIDTH ** -0.5),
        "w_out": nrm((DEPTH, D, D), D ** -0.5),
        "ffn_w_gate": nrm((n_dense, D, F), D ** -0.5),
        "ffn_w_up": nrm((n_dense, D, F), D ** -0.5),
        "ffn_w_down": nrm((n_dense, F, D), F ** -0.5),
        "moe_router": nrm((n_moe, D, E), D ** -0.5),
        "moe_w_gate": nrm((n_moe, E, D, F), D ** -0.5),
        "moe_w_up": nrm((n_moe, E, D, F), D ** -0.5),
        "moe_w_down": nrm((n_moe, E, F, D), F ** -0.5),
    }


def reference(x, c, ctx, c_ctx, w_ada, b_ada, norm1_g, norm2_g, w_in, q_norm_g, k_norm_g,
              attn_sink, hy_conv_w, hy_conv_b, hy_filt_w1, hy_filt_b1, hy_filt_freq1,
              hy_filt_w2, hy_filt_b2, hy_filt_freq2, hy_filt_w3, hy_bias, w_proj_attn,
              w_proj_hyena, w_proj_fnet, w_out, ffn_w_gate, ffn_w_up, ffn_w_down,
              moe_router, moe_w_gate, moe_w_up, moe_w_down):
    L = x.shape[1]
    C = ctx.shape[1]
    cos, sin = axial_rope_tables(L)
    cond_ctx = c_ctx[None, :]
    for l in range(DEPTH):
        last = l == DEPTH - 1
        filt = (hy_filt_w1[l], hy_filt_b1[l], hy_filt_freq1[l], hy_filt_w2[l], hy_filt_b2[l],
                hy_filt_freq2[l], hy_filt_w3[l])
        proj = (w_proj_attn[l], w_proj_hyena[l], w_proj_fnet[l], w_out[l])

        sh, sc, gt = adaln(c, w_ada[l], b_ada[l], 0)
        sh_c, sc_c, gt_c = adaln(cond_ctx, w_ada[l], b_ada[l], 0)
        h = modulate(x, norm1_g[l], sh, sc)
        h_c = modulate(ctx, norm1_g[l], sh_c, sc_c)

        pr = h @ w_in[l]
        q = apply_axial_rope(q_heads(pr, q_norm_g[l]), cos, sin)
        k, v = kv_heads(pr[..., Q_END:V_END], k_norm_g[l])
        k = apply_axial_rope(k, cos, sin)
        if last:
            k_c, v_c = kv_heads(h_c @ w_in[l][:, Q_END:V_END], k_norm_g[l])
        else:
            pr_c = h_c @ w_in[l]
            q_c = q_heads(pr_c, q_norm_g[l])
            k_c, v_c = kv_heads(pr_c[..., Q_END:V_END], k_norm_g[l])

        attn_o = latent_window_attention(q, k, v, k_c, v_c, attn_sink[l])
        hy_o = hyena_mixer(pr[..., V_END:HY_END], hy_conv_w[l], hy_conv_b[l],
                           hyena_filter_spectrum(L, *filt), hy_bias[l])
        fn_o = fnet_mixer(pr[..., HY_END:FN_END])
        y = merge_branches(pr, attn_o, hy_o, fn_o, *proj)
        x = x + gt[:, None, :] * y

        if not last:
            attn_c = context_attention(q_c, k_c, v_c, attn_sink[l])
            hy_c = hyena_mixer(pr_c[..., V_END:HY_END], hy_conv_w[l], hy_conv_b[l],
                               hyena_filter_spectrum(C, *filt), hy_bias[l])
            fn_c = fnet_mixer(pr_c[..., HY_END:FN_END])
            ctx = ctx + gt_c[:, None, :] * merge_branches(pr_c, attn_c, hy_c, fn_c, *proj)

        sh2, sc2, gt2 = adaln(c, w_ada[l], b_ada[l], 1)
        if l % 2 == 0:
            i = l // 2
            ffn = functools_partial_dense = (lambda t, i=i: swiglu(t, ffn_w_gate[i], ffn_w_up[i], ffn_w_down[i]))
        else:
            i = l // 2
            ffn = (lambda t, i=i: moe_swiglu(t, moe_router[i], moe_w_gate[i], moe_w_up[i],
                                            moe_w_down[i]))
        x = x + gt2[:, None, :] * ffn(modulate(x, norm2_g[l], sh2, sc2))
        if not last:
            sh2_c, sc2_c, gt2_c = adaln(cond_ctx, w_ada[l], b_ada[l], 1)
            ctx = ctx + gt2_c[:, None, :] * ffn(modulate(ctx, norm2_g[l], sh2_c, sc2_c))
    return x
```

```cpp
#include <hip/hip_runtime.h>
#include <cstdio>
#include <cstdint>
namespace pg8 {
#define PG8_LAS __attribute__((address_space(3)))
typedef unsigned short bf16_t;
typedef short bf16x8 __attribute__((ext_vector_type(8)));
typedef float f32x4 __attribute__((ext_vector_type(4)));
typedef unsigned u32x4 __attribute__((ext_vector_type(4)));
constexpr int BM = 256, BK = 64, HALF = 128, HTB = HALF * BK * 2  , STAGE_BYTES = 8 * HTB, NXCD = 8, WGM = 8;

__host__ __device__ __forceinline__ int lds_byte(int r, int c) { const int st = (r >> 4) * 2 + (c >> 5), rr = r & 15, cc = c & 31, ob = rr * 64 + cc * 2; return st * 1024 + (ob ^ (((ob >> 9) & 1) << 5)); }
__host__ __device__ __forceinline__ void stage_rc(int b, int& R, int& C) { const int st = b / 1024, sb = b % 1024, swz = sb ^ (((sb >> 9) & 1) << 5); R = (st >> 1) * 16 + swz / 64; C = (st & 1) * 32 + (swz % 64) / 2; }
__host__ __device__ __forceinline__ int perm32(int rho) { const int n = rho >> 4, i = rho & 15; return 8 * (i >> 2) + 4 * n + (i & 3); }

struct Unit { int pm, pn; };
struct Gemm { const bf16_t* A; const bf16_t* Bt; int M, N, K; };

struct StaticOrder {
    int nM, nN, nwg, G, c;
    __host__ __device__ void init(int M, int N, int G_, int c_) { nM = M / BM; nN = N / BM; nwg = nM * nN; G = G_; c = c_; }
    __host__ __device__ bool next(int i, Unit& u) const {
        const long L = (long)i * G + c; if (L >= nwg) return false;
        int wgid = (int)L; { const int q = nwg / NXCD, r = nwg % NXCD, xcd = wgid % NXCD, off = wgid / NXCD; wgid = (xcd < r ? xcd * (q + 1) : r * (q + 1) + (xcd - r) * q) + off; }
        const int nig = WGM * nN, gid = wgid / nig, fm = gid * WGM, gsz = (nM - fm) < WGM ? (nM - fm) : WGM;
        u.pm = fm + ((wgid % nig) % gsz); u.pn = (wgid % nig) / gsz; return true;
    }
    __device__ __forceinline__ void a_ready(const Unit&) const {}
    __device__ __forceinline__ void done(const Unit&) const {}
};

__device__ __forceinline__ unsigned cvt_pk_bf16(float lo, float hi) { unsigned r; asm volatile("v_cvt_pk_bf16_f32 %0, %1, %2" : "=v"(r) : "v"(lo), "v"(hi)); return r; }
typedef float f32x2 __attribute__((ext_vector_type(2)));
template <class Epi, class Sched, bool ALIGN_EPI = false, bool SP2 = false>
__device__ __forceinline__ void gemm_phase(PG8_LAS unsigned char* lds, const Gemm g, const Sched& S, const Epi& E) {
    int tid_ = threadIdx.x; asm volatile("" : "+v"(tid_)); const int tid = tid_, wid = __builtin_amdgcn_readfirstlane(tid >> 6), lane = tid & 63, wr = wid >> 2, wc = wid & 3, fr = lane & 15, fq = lane >> 4;
    const int K = g.K, nt = K / BK;
    unsigned voffA[2], voffB[2];
#pragma unroll
    for (int i = 0; i < 2; ++i) { int R, C; stage_rc(tid * 16 + i * 8192, R, C); const int Rb = Epi::PERM ? ((R & ~31) + perm32(R & 31)) : R;
        voffA[i] = (unsigned)(R * K + C) * 2u; voffB[i] = (unsigned)(Rb * K + C) * 2u; }
    const size_t kstep = (size_t)(BK * 2);
    const size_t hstep = (size_t)HALF * K * 2;
    const size_t tstep = 2 * hstep;
    const unsigned ldsw = (unsigned)wid * 1024u;
    const int aoff = lds_byte(wr * 64 + fr, fq * 8), boff = lds_byte(wc * 32 + fr, fq * 8);
#define PG8_SA(b, h) (((b) * 2 + (h)) * HTB)
#define PG8_SB(b, h) ((4 + (b) * 2 + (h)) * HTB)
#define PG8_STAGE(bufoff, gbase, voff) do { _Pragma("unroll") for (int _i = 0; _i < 2; ++_i) \
        __builtin_amdgcn_global_load_lds((const unsigned*)((const char*)(gbase) + (voff)[_i]), (PG8_LAS unsigned*)(lds + (bufoff) + ldsw + _i * 8192), 16, 0, 0); } while (0)
#define PG8_LDA(dst, b, h) do { _Pragma("unroll") for (int m = 0; m < 4; ++m) _Pragma("unroll") for (int k = 0; k < 2; ++k) dst[m][k] = *(const PG8_LAS bf16x8*)(lds + PG8_SA(b, h) + aoff + m * 2048 + k * 1024); } while (0)
#define PG8_LDB(dst, b, h) do { _Pragma("unroll") for (int n = 0; n < 2; ++n) _Pragma("unroll") for (int k = 0; k < 2; ++k) dst[n][k] = *(const PG8_LAS bf16x8*)(lds + PG8_SB(b, h) + boff + n * 2048 + k * 1024); } while (0)
#define PG8_MMA(ai, bj, At, Bt) do { __builtin_amdgcn_s_setprio(1); _Pragma("unroll") for (int m = 0; m < 4; ++m) _Pragma("unroll") for (int n = 0; n < 2; ++n) _Pragma("unroll") for (int k = 0; k < 2; ++k) \
        acc[ai][bj][m][n] = __builtin_amdgcn_mfma_f32_16x16x32_bf16(Bt[n][k], At[m][k], acc[ai][bj][m][n], 0, 0, 0); __builtin_amdgcn_s_setprio(0); } while (0)
#define PG8_WAIT_V(n) asm volatile("s_waitcnt vmcnt(" #n ")" ::: "memory")
#define PG8_WAIT_L(n) asm volatile("s_waitcnt lgkmcnt(" #n ")" ::: "memory")
#define PG8_BAR __builtin_amdgcn_s_barrier()
#define PG8_SCHED __builtin_amdgcn_sched_barrier(0)
    Unit cur, nxt; int ui = 0;
    if (!S.next(0, cur)) return;
    f32x4 acc[2][2][4][2];
#pragma unroll
    for (int a = 0; a < 2; ++a)
#pragma unroll
        for (int b = 0; b < 2; ++b)
#pragma unroll
            for (int m = 0; m < 4; ++m)
#pragma unroll
                for (int n = 0; n < 2; ++n) acc[a][b][m][n] = (f32x4){0.f, 0.f, 0.f, 0.f};
    bf16x8 At[4][2], B0[2][2], B1[2][2];
    const char* cA = (const char*)g.A + (size_t)cur.pm * tstep; const char* cB = (const char*)g.Bt + (size_t)cur.pn * tstep;
    S.a_ready(cur);
    if constexpr (SP2) {
        PG8_STAGE(PG8_SB(0, 0), cB, voffB); PG8_STAGE(PG8_SB(0, 1), cB + hstep, voffB); PG8_STAGE(PG8_SA(0, 0), cA, voffA); PG8_STAGE(PG8_SA(0, 1), cA + hstep, voffA);
        if (wr == 1) PG8_BAR;
        PG8_WAIT_V(2); PG8_BAR;
        PG8_STAGE(PG8_SB(1, 0), cB + kstep, voffB); PG8_STAGE(PG8_SA(1, 0), cA + kstep, voffA); PG8_STAGE(PG8_SB(1, 1), cB + hstep + kstep, voffB);
        PG8_WAIT_V(6); PG8_BAR;
    } else {
        PG8_STAGE(PG8_SB(0, 0), cB, voffB); PG8_STAGE(PG8_SA(0, 0), cA, voffA); PG8_STAGE(PG8_SB(0, 1), cB + hstep, voffB); PG8_STAGE(PG8_SA(0, 1), cA + hstep, voffA);
        if (wr == 1) PG8_BAR;
        PG8_WAIT_V(4); PG8_BAR;
        PG8_STAGE(PG8_SB(1, 0), cB + kstep, voffB); PG8_STAGE(PG8_SA(1, 0), cA + kstep, voffA); PG8_STAGE(PG8_SB(1, 1), cB + hstep + kstep, voffB);
        PG8_WAIT_V(6); PG8_BAR;
    }
    for (;;) {
        const bool has_next = S.next(ui + 1, nxt);
        const char* nA = has_next ? (const char*)g.A + (size_t)nxt.pm * tstep : cA; const char* nB = has_next ? (const char*)g.Bt + (size_t)nxt.pn * tstep : cB;
        for (int t = 0; t < nt; t += 2) {
            const bool last = (t == nt - 2);
            const char* a1 = cA + (size_t)(t + 1) * kstep;
            const char* a2 = last ? nA : cA + (size_t)(t + 2) * kstep; const char* b2 = last ? nB : cB + (size_t)(t + 2) * kstep;
            const char* a3 = a2 + kstep; const char* b3 = b2 + kstep;
            if (last && has_next) S.a_ready(nxt);
            if constexpr (SP2) {
            PG8_LDB(B0, 0, 0); PG8_LDB(B1, 0, 1); PG8_SCHED; PG8_LDA(At, 0, 0); PG8_STAGE(PG8_SA(1, 1), a1 + hstep, voffA);
            PG8_WAIT_V(8); PG8_WAIT_L(0); PG8_BAR; PG8_MMA(0, 0, At, B0); PG8_MMA(0, 1, At, B1); PG8_BAR; PG8_SCHED;
            PG8_LDA(At, 0, 1); PG8_STAGE(PG8_SB(0, 0), b2, voffB); PG8_STAGE(PG8_SB(0, 1), b2 + hstep, voffB); PG8_STAGE(PG8_SA(0, 0), a2, voffA);
            PG8_WAIT_V(8); PG8_WAIT_L(0); PG8_BAR; PG8_MMA(1, 0, At, B0); PG8_MMA(1, 1, At, B1); PG8_BAR; PG8_SCHED;
            PG8_LDB(B0, 1, 0); PG8_LDB(B1, 1, 1); PG8_SCHED; PG8_LDA(At, 1, 0); PG8_STAGE(PG8_SA(0, 1), a2 + hstep, voffA);
            PG8_WAIT_V(8); PG8_WAIT_L(0); PG8_BAR; PG8_MMA(0, 0, At, B0); PG8_MMA(0, 1, At, B1); PG8_BAR; PG8_SCHED;
            PG8_LDA(At, 1, 1); PG8_STAGE(PG8_SB(1, 0), b3, voffB); PG8_STAGE(PG8_SB(1, 1), b3 + hstep, voffB); PG8_STAGE(PG8_SA(1, 0), a3, voffA);
            PG8_WAIT_V(8); PG8_WAIT_L(0); PG8_BAR; PG8_MMA(1, 0, At, B0); PG8_MMA(1, 1, At, B1); PG8_BAR; PG8_SCHED;
            } else {
            PG8_LDB(B0, 0, 0); PG8_SCHED; PG8_LDA(At, 0, 0); PG8_STAGE(PG8_SA(1, 1), a1 + hstep, voffA);
            PG8_WAIT_L(8); PG8_BAR; PG8_WAIT_L(0); PG8_MMA(0, 0, At, B0); PG8_BAR; PG8_SCHED;
            PG8_LDB(B1, 0, 1); PG8_STAGE(PG8_SB(0, 0), b2, voffB);
            PG8_BAR; PG8_WAIT_L(0); PG8_MMA(0, 1, At, B1); PG8_BAR;
            PG8_LDA(At, 0, 1); PG8_STAGE(PG8_SA(0, 0), a2, voffA);
            PG8_BAR; PG8_WAIT_L(0); PG8_MMA(1, 0, At, B0); PG8_BAR; PG8_SCHED;
            PG8_STAGE(PG8_SB(0, 1), b2 + hstep, voffB);
            PG8_WAIT_V(6); PG8_BAR; PG8_MMA(1, 1, At, B1); PG8_BAR;
            PG8_LDB(B0, 1, 0); PG8_SCHED; PG8_LDA(At, 1, 0); PG8_STAGE(PG8_SA(0, 1), a2 + hstep, voffA);
            PG8_WAIT_L(8); PG8_BAR; PG8_WAIT_L(0); PG8_MMA(0, 0, At, B0); PG8_BAR; PG8_SCHED;
            PG8_LDB(B1, 1, 1); PG8_STAGE(PG8_SB(1, 0), b3, voffB);
            PG8_BAR; PG8_WAIT_L(0); PG8_MMA(0, 1, At, B1); PG8_BAR;
            PG8_LDA(At, 1, 1); PG8_STAGE(PG8_SA(1, 0), a3, voffA);
            PG8_BAR; PG8_WAIT_L(0); PG8_MMA(1, 0, At, B0); PG8_BAR; PG8_SCHED;
            PG8_STAGE(PG8_SB(1, 1), b3 + hstep, voffB);
            PG8_WAIT_V(6); PG8_BAR; PG8_MMA(1, 1, At, B1); PG8_BAR;
            }
        }
        if constexpr (ALIGN_EPI) { if (wr == 0) PG8_BAR; }
        if constexpr (!Epi::AFTER_DRAIN) { E(acc, cur, wr, wc, fr, fq); S.done(cur); }
        if (!has_next) break;
#pragma unroll
        for (int a = 0; a < 2; ++a)
#pragma unroll
            for (int b = 0; b < 2; ++b)
#pragma unroll
                for (int m = 0; m < 4; ++m)
#pragma unroll
                    for (int n = 0; n < 2; ++n) acc[a][b][m][n] = (f32x4){0.f, 0.f, 0.f, 0.f};
        cur = nxt; cA = nA; cB = nB; ++ui;
        if constexpr (ALIGN_EPI) { if (wr == 1) PG8_BAR; }
    }
    PG8_WAIT_V(0);
    if constexpr (!ALIGN_EPI) { if (wr == 0) PG8_BAR; }
    PG8_BAR;
    if constexpr (Epi::AFTER_DRAIN) { E.fused(acc, cur, wr, wc, fr, fq, lds, wid, lane); S.done(cur); }
#undef PG8_SA
#undef PG8_SB
#undef PG8_STAGE
#undef PG8_LDA
#undef PG8_LDB
#undef PG8_MMA
#undef PG8_WAIT_V
#undef PG8_WAIT_L
#undef PG8_BAR
#undef PG8_SCHED
}
}

constexpr int NWAVES = 8, NTHREADS = 512;
constexpr int BATCH = 2, SEQ = 8192, DM = 1024, DEPTH = 4, CTXL = 256;
constexpr int ML = BATCH * SEQ;
constexpr int MC = BATCH * CTXL;
constexpr int MT = ML + MC;
constexpr int HD = 64, NH = 8, NKV = 2;
constexpr int QW = 512, KVW = 128;
constexpr int HYW = 256, FNW = 256;
constexpr int Q_END = 512, K_END = 640, V_END = 768, HY_END = 1536, FN_END = 1792, INW = 4864;
constexpr int DFF = 2816, NEXP = 8;
constexpr int FH = 64, FEMB = 33;
constexpr float EPS = 1e-6f;

constexpr size_t MiB = 1u << 20;
constexpr size_t WS_CTL = 0, CTL_ZERO_BYTES = 4 * MiB;
constexpr size_t WS_WIN = 4 * MiB;
constexpr size_t WS_WPA = WS_WIN + 38 * MiB;
constexpr size_t WS_WPH = WS_WPA + 4 * MiB;
constexpr size_t WS_WPF = WS_WPH + 2 * MiB;
constexpr size_t WS_WO = WS_WPF + 2 * MiB;
constexpr size_t WS_FGU = WS_WO + 8 * MiB;
constexpr size_t WS_FD = WS_FGU + 22 * MiB;
constexpr size_t WS_MGU = WS_FD + 11 * MiB;
constexpr size_t WS_MD = WS_MGU + 176 * MiB;
constexpr size_t WS_XC = WS_MD + 88 * MiB;
constexpr size_t WS_H = WS_XC + 2 * MiB;
constexpr size_t WS_COMB = WS_H + 33 * MiB;
constexpr size_t WS_HF = WS_COMB + 1 * MiB;
constexpr size_t WS_HFC = WS_HF + 32 * MiB;
constexpr size_t WS_S = WS_HFC + 1 * MiB;
constexpr size_t WS_PR = WS_S;
constexpr size_t WS_QK = WS_PR + 157 * MiB;
constexpr size_t WS_ATT = WS_QK + 21 * MiB;
constexpr size_t WS_HYO = WS_ATT + 17 * MiB;
constexpr size_t WS_FNO = WS_HYO + 9 * MiB;
constexpr size_t WS_MACC = WS_FNO + 9 * MiB;
constexpr size_t WS_M = WS_MACC + 66 * MiB;
constexpr size_t WS_END = WS_M + 33 * MiB;
constexpr size_t WS_HYT = WS_MACC + 32 * MiB;
constexpr size_t WS_FNT = WS_MACC + 44 * MiB;
constexpr size_t WS_HID = WS_S;
static_assert((size_t)MT * INW * 2 <= 157 * MiB && (size_t)MT * DFF * 2 <= 157 * MiB, "scratch sizes");
constexpr int CW_BAR = 4096;
constexpr int CW_MOD = 262144;
static_assert((CW_MOD + 4 * 3 * 6144) * 4 <= (int)CTL_ZERO_BYTES, "ctl");

constexpr int LDS_BYTES = 147456;
constexpr int MISC_OFF = LDS_BYTES - 256;

#define LAS __attribute__((address_space(3)))
typedef unsigned short bf16;
typedef unsigned v4u __attribute__((ext_vector_type(4)));
typedef unsigned v2u __attribute__((ext_vector_type(2)));
typedef float f32x4 __attribute__((ext_vector_type(4)));
typedef float f32x2 __attribute__((ext_vector_type(2)));
#define LDS_WAIT() asm volatile("s_waitcnt lgkmcnt(0)" ::: "memory")
__device__ __forceinline__ unsigned f2bf(float f) { unsigned u = __builtin_bit_cast(unsigned, f); return (u + 0x7fffu + ((u >> 16) & 1u)) >> 16; }
__device__ __forceinline__ unsigned pk2(float lo, float hi) { return f2bf(lo) | (f2bf(hi) << 16); }
__device__ __forceinline__ float bf2f(unsigned short h) { return __builtin_bit_cast(float, (unsigned)h << 16); }
__device__ __forceinline__ float bflo(unsigned w) { return __builtin_bit_cast(float, w << 16); }
__device__ __forceinline__ float bfhi(unsigned w) { return __builtin_bit_cast(float, w & 0xffff0000u); }
__device__ __forceinline__ float shx(float v, int lane, int o) { return __builtin_bit_cast(float, __builtin_amdgcn_ds_bpermute((lane ^ o) << 2, __builtin_bit_cast(int, v))); }
__device__ __forceinline__ float wave_sum(float v, int lane) {
#pragma unroll
    for (int o = 1; o < 64; o <<= 1) v += shx(v, lane, o);
    return v;
}
__device__ __forceinline__ float wave_max(float v, int lane) {
#pragma unroll
    for (int o = 1; o < 64; o <<= 1) v = fmaxf(v, shx(v, lane, o));
    return v;
}
__device__ __forceinline__ float sin_rev(float r) { return __builtin_amdgcn_sinf(__builtin_amdgcn_fractf(r)); }
__device__ __forceinline__ float cos_rev(float r) { return __builtin_amdgcn_cosf(__builtin_amdgcn_fractf(r)); }
__device__ __forceinline__ float sigmoidf_(float x) { return __builtin_amdgcn_rcpf(1.0f + __expf(-x)); }
constexpr float INV_2PI = 0.15915494309189535f;

#define XB_TMO      128
#define XB_XCNT(j)  (256  + 64 * (j))
#define XB_XSUB(j)  (1280 + 64 * (j))
#define XB_XGEN(j)  (2304 + 64 * (j))
#define XB_TOP      3328
#define XB_TOPGEN   3392
#define XCD_BAR_WORDS 3456
#define XB_SPIN_CAP (1u << 18)

__device__ __forceinline__ unsigned xb_ld(unsigned* p)              { return __hip_atomic_load(p, __ATOMIC_RELAXED, __HIP_MEMORY_SCOPE_AGENT); }
__device__ __forceinline__ unsigned xb_add(unsigned* p, unsigned v) { return __hip_atomic_fetch_add(p, v, __ATOMIC_RELAXED, __HIP_MEMORY_SCOPE_AGENT); }
__device__ __forceinline__ unsigned xb_xcc_id() { return (unsigned)__builtin_amdgcn_s_getreg((3 << 11) | 20) & 0xFu; }
#define XB_SPIN(cond, bar) do { unsigned _sp = 0; while (cond) { __builtin_amdgcn_s_sleep(1); \
    if ((++_sp & 255u) == 0u) { if (xb_ld(&(bar)[XB_TMO])) break; if (_sp > XB_SPIN_CAP) { atomicAdd(&(bar)[XB_TMO], 1u); break; } } } } while (0)

struct XcdBarrier {
    unsigned* bar; unsigned x;
    volatile LAS unsigned* st;
};

__device__ __forceinline__ XcdBarrier xcd_barrier_post(unsigned* bar, volatile LAS unsigned* st) {
    XcdBarrier b; b.bar = bar; b.x = xb_xcc_id(); b.st = st;
    if (threadIdx.x == 0) (void)xb_add(&bar[XB_XCNT(b.x)], 1u);
    return b;
}
__device__ __forceinline__ void xcd_barrier_complete(unsigned* bar, unsigned x, unsigned& nloc, unsigned& nx) {
    const unsigned G = gridDim.x * gridDim.y * gridDim.z;
    unsigned sum, cnt, mine, sp = 0u;
    for (;;) {
        sum = 0u; cnt = 0u; mine = 0u;
#pragma unroll
        for (unsigned j = 0; j < 16; ++j) { const unsigned c = xb_ld(&bar[XB_XCNT(j)]); sum += c; cnt += (c > 0u) ? 1u : 0u; mine = (j == x) ? c : mine; }
        if (sum == G) break;
        __builtin_amdgcn_s_sleep(1);
        if ((++sp & 255u) == 0u) { if (xb_ld(&bar[XB_TMO])) break; if (sp > XB_SPIN_CAP) { atomicAdd(&bar[XB_TMO], 1u); break; } }
    }
    nloc = mine > 0u ? mine : 1u; nx = cnt > 0u ? cnt : 1u;
}

__device__ __attribute__((noinline)) void xcd_barrier_impl(unsigned* b_bar, unsigned b_x, volatile LAS unsigned* b_st) {
    XcdBarrier b; b.bar = b_bar; b.x = b_x; b.st = b_st;
    asm volatile("s_waitcnt vmcnt(0)" ::: "memory");
    __syncthreads();
    if (threadIdx.x == 0) {
        unsigned* bar = b.bar;
        __builtin_amdgcn_s_waitcnt(0);
        unsigned nloc = b.st[0], nx = b.st[1];
        if (nloc == 0u) { xcd_barrier_complete(bar, b.x, nloc, nx); b.st[0] = nloc; b.st[1] = nx; }
        const unsigned old = xb_add(&bar[XB_XSUB(b.x)], 1u);
        const unsigned gen = old / nloc;
        if (old + 1u == (gen + 1u) * nloc) {
            __builtin_amdgcn_fence(__ATOMIC_RELEASE, "agent");
            asm volatile("s_waitcnt vmcnt(0)" ::: "memory");
            const unsigned og = xb_add(&bar[XB_TOP], 1u);
            const unsigned tg = og / nx;
            if (og + 1u == (tg + 1u) * nx) xb_add(&bar[XB_TOPGEN], 1u);
            else XB_SPIN(xb_ld(&bar[XB_TOPGEN]) == tg, bar);
            __builtin_amdgcn_fence(__ATOMIC_ACQUIRE, "agent");
            xb_add(&bar[XB_XGEN(b.x)], 1u);
            asm volatile("s_waitcnt vmcnt(0)" ::: "memory");
        } else {
            XB_SPIN(xb_ld(&bar[XB_XGEN(b.x)]) == gen, bar);
            __builtin_amdgcn_fence(__ATOMIC_ACQUIRE, "agent");
            asm volatile("s_waitcnt vmcnt(0)" ::: "memory");
        }
    }
    __syncthreads();
}

struct Args { const float* in[34]; unsigned char* ws; int ph_lo, ph_hi; };
struct Frame {
    LAS unsigned char* lds;
    unsigned* ctl;
    unsigned char* ws;
    int tid, lane, wave, G, bid;
    const struct Args* a; int z;
};
__device__ __forceinline__ const float* inp(const Frame& F, int i) { return F.a->in[i + F.z]; }
__device__ __forceinline__ float* outp(const Frame& F) { return (float*)F.a->in[33 + F.z]; }
__device__ __forceinline__ unsigned char* wsp(const Frame& F) { return F.a->ws + F.z; }
enum { I_X = 0, I_C, I_CTX, I_CCTX, I_WADA, I_BADA, I_N1G, I_N2G, I_WIN, I_QG, I_KG, I_SINK, I_HCW, I_HCB, I_FW1, I_FB1, I_FF1, I_FW2, I_FB2, I_FF2, I_FW3, I_HBIAS,
       I_WPA, I_WPH, I_WPF, I_WOUT, I_FG, I_FU, I_FDN, I_ROUTER, I_MG, I_MU, I_MDN };

namespace pg8 {
struct EpiStore {
    static constexpr bool PERM = true, AFTER_DRAIN = false;
    bf16_t* O; int ldc;
    __device__ __forceinline__ void operator()(const f32x4 (&acc)[2][2][4][2], const Unit& u, int wr, int wc, int fr, int fq) const {
        const int row0 = u.pm * BM + wr * 64 + fr, col0 = u.pn * BM + wc * 32 + 8 * fq;
#pragma unroll
        for (int ai = 0; ai < 2; ++ai)
#pragma unroll
            for (int m = 0; m < 4; ++m) { bf16_t* rowp = O + (size_t)(row0 + ai * HALF + m * 16) * ldc + col0;
#pragma unroll
                for (int bj = 0; bj < 2; ++bj) { const f32x4 v0 = acc[ai][bj][m][0], v1 = acc[ai][bj][m][1];
                    u32x4 w; w.x = cvt_pk_bf16(v0[0], v0[1]); w.y = cvt_pk_bf16(v0[2], v0[3]); w.z = cvt_pk_bf16(v1[0], v1[1]); w.w = cvt_pk_bf16(v1[2], v1[3]);
                    *(u32x4*)(rowp + bj * HALF) = w; } }
    }
};
struct EpiSwiglu {
    static constexpr bool PERM = true, AFTER_DRAIN = false;
    bf16_t* O; int ldc;
    __device__ __forceinline__ void operator()(const f32x4 (&acc)[2][2][4][2], const Unit& u, int wr, int wc, int fr, int fq) const {
        const int row0 = u.pm * BM + wr * 64 + fr, col0 = u.pn * HALF + wc * 32 + 8 * fq;
#pragma unroll
        for (int ai = 0; ai < 2; ++ai)
#pragma unroll
            for (int m = 0; m < 4; ++m) { bf16_t* rowp = O + (size_t)(row0 + ai * HALF + m * 16) * ldc + col0;
                float h[8];
#pragma unroll
                for (int n = 0; n < 2; ++n)
#pragma unroll
                    for (int e = 0; e < 4; ++e) { const float g = acc[ai][0][m][n][e], uu = acc[ai][1][m][n][e]; h[n * 4 + e] = g * __builtin_amdgcn_rcpf(1.0f + __expf(-g)) * uu; }
                u32x4 w; w.x = cvt_pk_bf16(h[0], h[1]); w.y = cvt_pk_bf16(h[2], h[3]); w.z = cvt_pk_bf16(h[4], h[5]); w.w = cvt_pk_bf16(h[6], h[7]);
                *(u32x4*)rowp = w; }
    }
};
struct EpiMerge {
    static constexpr bool PERM = false, AFTER_DRAIN = false;
    const bf16_t* PR; float* MACC; bf16_t* Mo; int mode;
    __device__ __forceinline__ void operator()(const f32x4 (&acc)[2][2][4][2], const Unit& u, int wr, int wc, int fr, int fq) const {
        const int col0 = u.pn * BM + wc * 32 + 4 * fq;
#pragma unroll
        for (int ai = 0; ai < 2; ++ai)
#pragma unroll
            for (int m = 0; m < 4; ++m) { const int r = u.pm * BM + ai * HALF + wr * 64 + m * 16 + fr;
#pragma unroll
                for (int bj = 0; bj < 2; ++bj)
#pragma unroll
                    for (int n = 0; n < 2; ++n) { const int c = col0 + bj * HALF + n * 16;
                        typedef unsigned u32x2v __attribute__((ext_vector_type(2)));
                        const u32x2v gw = *(const u32x2v*)(PR + (size_t)r * 4864 + 1792 + mode * 1024 + c);
                        f32x4 g; g[0] = __builtin_bit_cast(float, gw.x << 16); g[1] = __builtin_bit_cast(float, gw.x & 0xffff0000u); g[2] = __builtin_bit_cast(float, gw.y << 16); g[3] = __builtin_bit_cast(float, gw.y & 0xffff0000u);
                        f32x4 v;
#pragma unroll
                        for (int e = 0; e < 4; ++e) v[e] = __builtin_amdgcn_rcpf(1.0f + __expf(-g[e])) * acc[ai][bj][m][n][e];
                        float* mp = MACC + (size_t)r * 1024 + c;
                        if (mode == 0) { *(f32x4*)mp = v; }
                        else if (mode == 1) { *(f32x4*)mp = *(const f32x4*)mp + v; }
                        else { const f32x4 t = *(const f32x4*)mp + v; u32x2v w; w.x = cvt_pk_bf16(t[0], t[1]); w.y = cvt_pk_bf16(t[2], t[3]); *(u32x2v*)(Mo + (size_t)r * 1024 + c) = w; }
                    } }
    }
};
struct EpiResid {
    static constexpr bool PERM = false, AFTER_DRAIN = false;
    const float* xin_lat; const float* xin_ctx; float* xout_lat; float* xout_ctx; const float* gate  ; const float* rowscale  ;
    __device__ __forceinline__ void operator()(const f32x4 (&acc)[2][2][4][2], const Unit& u, int wr, int wc, int fr, int fq) const {
        const int col0 = u.pn * BM + wc * 32 + 4 * fq;
        const bool isctx = u.pm >= 64;
        const int cond = isctx ? 2 : (u.pm >> 5);
        const float* xi = isctx ? xin_ctx - (size_t)16384 * 1024 : xin_lat;
        float* xo = isctx ? xout_ctx - (size_t)16384 * 1024 : xout_lat;
        const float* gp = gate + cond * 6144;
        f32x4 gv[2][2];
#pragma unroll
        for (int bj = 0; bj < 2; ++bj)
#pragma unroll
            for (int n = 0; n < 2; ++n) gv[bj][n] = *(const f32x4*)(gp + col0 + bj * HALF + n * 16);
#pragma unroll
        for (int ai = 0; ai < 2; ++ai)
#pragma unroll
            for (int m = 0; m < 4; ++m) { const int r = u.pm * BM + ai * HALF + wr * 64 + m * 16 + fr;
                const float rs = rowscale ? rowscale[(size_t)r * 8] : 1.0f;
#pragma unroll
                for (int bj = 0; bj < 2; ++bj)
#pragma unroll
                    for (int n = 0; n < 2; ++n) { const size_t off = (size_t)r * 1024 + col0 + bj * HALF + n * 16;
                        const f32x4 xv = *(const f32x4*)(xi + off);
                        *(f32x4*)(xo + off) = xv + gv[bj][n] * rs * acc[ai][bj][m][n]; } }
    }
};
}

__device__ __forceinline__ void transpose_item(const float* W, int K, int N, bf16* WT, int map, LAS float* scr, int item, int lane) {
    const int nblk = N / 32, kb = item / nblk, nb = item % nblk, k0 = 64 * kb, n0 = 32 * nb;
#pragma unroll 8
    for (int i = 0; i < 32; ++i) { const int kk = 2 * i + (lane >> 5); scr[kk * 33 + (lane & 31)] = W[(size_t)(k0 + kk) * N + n0 + (lane & 31)]; }
    LDS_WAIT(); asm volatile("" ::: "memory");
    const int c = lane & 7;
#pragma unroll
    for (int j = 0; j < 4; ++j) { const int n = (lane >> 3) + 8 * j; const LAS float* s = scr + (8 * c) * 33 + n;
        v4u o; o.x = pk2(s[0 * 33], s[1 * 33]); o.y = pk2(s[2 * 33], s[3 * 33]); o.z = pk2(s[4 * 33], s[5 * 33]); o.w = pk2(s[6 * 33], s[7 * 33]);
        const int nn = n0 + n; const int drow = (map == 0) ? nn : ((nn >> 7) * 256 + (nn & 127) + (map == 2 ? 128 : 0));
        *(v4u*)(WT + (size_t)drow * K + k0 + 8 * c) = o; }
    LDS_WAIT(); asm volatile("" ::: "memory");
}

#define TR_GROUP(SRC, DST, CNT, KK, NN, MAP, DSTRIDE) { constexpr int per = ((KK) / 64) * ((NN) / 32); constexpr int tot = (CNT) * per; \
    if (r < tot) { const int mi = r / per, it2 = r % per; transpose_item((SRC) + (size_t)mi * (KK) * (NN), (KK), (NN), (DST) + (size_t)mi * (DSTRIDE), (MAP), scr, it2, F.lane); continue; } r -= tot; }

__device__ __forceinline__ void phase_prologue(Frame& F) {
    LAS float* scr = (LAS float*)(F.lds + F.wave * 16384);
    const int gw = F.bid * NWAVES + F.wave, NGW = F.G * NWAVES;
    constexpr int TOT_ITEMS = 4 * (16 * 152 + 8 * 32 + 4 * 32 + 4 * 32 + 16 * 32) + 2 * (16 * 88 * 2 + 44 * 32) + 16 * (16 * 88 * 2 + 44 * 32);
    for (int it = gw; it < TOT_ITEMS; it += NGW) {
        int r = it;
        TR_GROUP(inp(F, I_WIN), ((bf16*)(wsp(F) + WS_WIN)), 4, 1024, 4864, 0, (size_t)4864 * 1024)
        TR_GROUP(inp(F, I_WPA), ((bf16*)(wsp(F) + WS_WPA)), 4, 512, 1024, 0, (size_t)1024 * 512)
        TR_GROUP(inp(F, I_WPH), ((bf16*)(wsp(F) + WS_WPH)), 4, 256, 1024, 0, (size_t)1024 * 256)
        TR_GROUP(inp(F, I_WPF), ((bf16*)(wsp(F) + WS_WPF)), 4, 256, 1024, 0, (size_t)1024 * 256)
        TR_GROUP(inp(F, I_WOUT), ((bf16*)(wsp(F) + WS_WO)), 4, 1024, 1024, 0, (size_t)1024 * 1024)
        TR_GROUP(inp(F, I_FG), ((bf16*)(wsp(F) + WS_FGU)), 2, 1024, 2816, 1, (size_t)5632 * 1024)
        TR_GROUP(inp(F, I_FU), ((bf16*)(wsp(F) + WS_FGU)), 2, 1024, 2816, 2, (size_t)5632 * 1024)
        TR_GROUP(inp(F, I_FDN), ((bf16*)(wsp(F) + WS_FD)), 2, 2816, 1024, 0, (size_t)1024 * 2816)
        TR_GROUP(inp(F, I_MG), ((bf16*)(wsp(F) + WS_MGU)), 16, 1024, 2816, 1, (size_t)5632 * 1024)
        TR_GROUP(inp(F, I_MU), ((bf16*)(wsp(F) + WS_MGU)), 16, 1024, 2816, 2, (size_t)5632 * 1024)
        TR_GROUP(inp(F, I_MDN), ((bf16*)(wsp(F) + WS_MD)), 16, 2816, 1024, 0, (size_t)1024 * 2816)
    }
    for (int it = gw; it < 4 * 96; it += NGW) {
        const int l = it / 96, cb = it % 96;
        const float* W = inp(F, I_WADA) + (size_t)l * 1024 * 6144 + cb * 64 + F.lane;
        float a0 = 0.f, a1 = 0.f, a2 = 0.f;
#pragma unroll 8
        for (int k = 0; k < 1024; ++k) {
            const float c0 = inp(F, I_C)[k], c1 = inp(F, I_C)[1024 + k], c2 = inp(F, I_CCTX)[k];
            const float s0 = c0 * sigmoidf_(c0), s1 = c1 * sigmoidf_(c1), s2 = c2 * sigmoidf_(c2);
            const float w = W[(size_t)k * 6144];
            a0 += w * s0; a1 += w * s1; a2 += w * s2;
        }
        const float bb = inp(F, I_BADA)[l * 6144 + cb * 64 + F.lane];
        float* mo = ((float*)(wsp(F) + WS_CTL) + CW_MOD) + (size_t)l * 3 * 6144 + cb * 64 + F.lane;
        mo[0] = a0 + bb; mo[6144] = a1 + bb; mo[2 * 6144] = a2 + bb;
    }
}

template <bool ROUTER>
__device__ __forceinline__ void phase_norm(Frame& F, int l, const float* xlat, const float* xctx, const float* g, int moff, const float* wr) {
    const int gw = F.bid * NWAVES + F.wave, NGW = F.G * NWAVES;
    const float* mod = ((float*)(wsp(F) + WS_CTL) + CW_MOD) + (size_t)l * 3 * 6144 + moff;
    for (int r = gw; r < MT; r += NGW) {
        const bool isctx = r >= ML; const int cond = isctx ? 2 : (r >> 13);
        const float* xr = isctx ? xctx + (size_t)(r - ML) * 1024 : xlat + (size_t)r * 1024;
        f32x4 v[4]; float s = 0.f;
#pragma unroll
        for (int j = 0; j < 4; ++j) { v[j] = *(const f32x4*)(xr + 256 * j + 4 * F.lane); s += (v[j][0] * v[j][0] + v[j][1] * v[j][1]) + (v[j][2] * v[j][2] + v[j][3] * v[j][3]); }
        const float rstd = 1.0f / sqrtf(wave_sum(s, F.lane) * (1.0f / 1024.0f) + EPS);
        const float* sh = mod + cond * 6144; const float* sc = sh + 1024;
        float lg[8];
        if (ROUTER) {
#pragma unroll
            for (int e = 0; e < 8; ++e) lg[e] = 0.f;
        }
#pragma unroll
        for (int j = 0; j < 4; ++j) { const int c = 256 * j + 4 * F.lane;
            const f32x4 gg = *(const f32x4*)(g + c), s1 = *(const f32x4*)(sc + c), s0 = *(const f32x4*)(sh + c);
            f32x4 y;
#pragma unroll
            for (int e = 0; e < 4; ++e) y[e] = (v[j][e] * rstd * gg[e]) * (1.0f + s1[e]) + s0[e];
            v2u o; o.x = pk2(y[0], y[1]); o.y = pk2(y[2], y[3]);
            *(v2u*)(((bf16*)(wsp(F) + WS_H)) + (size_t)r * 1024 + c) = o;
            if (ROUTER) {
#pragma unroll
                for (int e = 0; e < 4; ++e) { const f32x4 w0 = *(const f32x4*)(wr + (size_t)(c + e) * 8), w1 = *(const f32x4*)(wr + (size_t)(c + e) * 8 + 4);
                    lg[0] += y[e] * w0[0]; lg[1] += y[e] * w0[1]; lg[2] += y[e] * w0[2]; lg[3] += y[e] * w0[3];
                    lg[4] += y[e] * w1[0]; lg[5] += y[e] * w1[1]; lg[6] += y[e] * w1[2]; lg[7] += y[e] * w1[3]; }
            }
        }
        if (ROUTER) {
#pragma unroll
            for (int e = 0; e < 8; ++e) lg[e] = wave_sum(lg[e], F.lane);
            int i0 = 0; float v0 = lg[0];
#pragma unroll
            for (int e = 1; e < 8; ++e) if (lg[e] > v0) { v0 = lg[e]; i0 = e; }
            int i1 = -1; float v1 = -INFINITY;
#pragma unroll
            for (int e = 0; e < 8; ++e) if (e != i0 && lg[e] > v1) { v1 = lg[e]; i1 = e; }
            const float w0 = 1.0f / (1.0f + __expf(v1 - v0)), w1 = 1.0f - w0;
            if (F.lane < 8) ((float*)(wsp(F) + WS_COMB))[(size_t)r * 8 + F.lane] = (F.lane == i0) ? w0 : ((F.lane == i1) ? w1 : 0.0f);
        }
    }
}

__device__ __forceinline__ void filter_tile(Frame& F, int l, int L, int p0, float* dst  ) {
    LAS float* emb = (LAS float*)F.lds;
    LAS float* h1 = emb + 64 * 33;
    LAS float* h2 = h1 + 64 * 65;
    const float* w1 = inp(F, I_FW1) + l * 33 * 64; const float* b1 = inp(F, I_FB1) + l * 64; const float* f1 = inp(F, I_FF1) + l * 64;
    const float* w2 = inp(F, I_FW2) + l * 64 * 64; const float* b2 = inp(F, I_FB2) + l * 64; const float* f2 = inp(F, I_FF2) + l * 64;
    const float* w3 = inp(F, I_FW3) + (size_t)l * 64 * 1024;
    for (int idx = F.tid; idx < 64 * 33; idx += NTHREADS) {
        const int pos = idx / 33, f = idx % 33, i = p0 + pos;
        float val;
        if (f == 0) val = (float)i / (float)(L - 1);
        else { const int j = (f - 1) & 15; const float fb = 1e-4f + (float)j * ((15.0f - 1e-4f) / 15.0f); const float rev = fb * (float)i / (float)L;
               val = (f <= 16) ? cos_rev(rev) : -sin_rev(rev); }
        emb[pos * 33 + f] = val;
    }
    __syncthreads();
    for (int idx = F.tid; idx < 4096; idx += NTHREADS) {
        const int pos = idx >> 6, u = idx & 63; float a = b1[u];
        for (int f = 0; f < 33; ++f) a += emb[pos * 33 + f] * w1[f * 64 + u];
        h1[pos * 65 + u] = sin_rev(f1[u] * a * INV_2PI);
    }
    __syncthreads();
    for (int idx = F.tid; idx < 4096; idx += NTHREADS) {
        const int pos = idx >> 6, u = idx & 63; float a = b2[u];
        for (int f = 0; f < 64; ++f) a += h1[pos * 65 + f] * w2[f * 64 + u];
        h2[pos * 65 + u] = sin_rev(f2[u] * a * INV_2PI);
    }
    __syncthreads();
    const int pos = F.lane, i = p0 + pos; const float t = (float)i / (float)(L - 1);
    for (int col = F.wave; col < 1024; col += NWAVES) {
        float a = 0.f;
        for (int f = 0; f < 64; ++f) a += h2[pos * 65 + f] * w3[f * 1024 + col];
        const int ch = col & 255; const float delta = 3.0701134573253946f + 12.280453829301578f * ((float)ch / 255.0f);
        dst[(size_t)col * L + i] = a * __expf(-t * delta);
    }
    __syncthreads();
}

__device__ __forceinline__ void phase_qkprep(Frame& F, int l) {
    const int gw = F.bid * NWAVES + F.wave, NGW = F.G * NWAVES;
    const int lane = F.lane; const int a = lane >> 5, half = (lane >> 4) & 1, f = lane & 15;
    const float inv = exp2f(-(float)f * (13.287712379549449f / 16.0f)) * INV_2PI;
    const float gq = inp(F, I_QG)[l * 64 + lane], gk = inp(F, I_KG)[l * 64 + lane];
    for (int r = gw; r < MT; r += NGW) {
        const bool isctx = r >= ML; const int t = r & 8191; const int pos = a == 0 ? (t >> 6) : (t & 63);
        float cs = 1.f, sn = 0.f;
        if (!isctx) { const float rev = (float)pos * inv; cs = cos_rev(rev); sn = sin_rev(rev); }
        const bf16* pr = ((bf16*)(wsp(F) + WS_PR)) + (size_t)r * INW;
        bf16* qk = ((bf16*)(wsp(F) + WS_QK)) + (size_t)r * 640;
#pragma unroll
        for (int h = 0; h < 10; ++h) {
            const float v = bf2f(pr[h * 64 + lane]);
            const float ss = wave_sum(v * v, lane);
            const float y = v * (1.0f / sqrtf(ss * (1.0f / 64.0f) + EPS)) * (h < 8 ? gq : gk);
            const float p = shx(y, lane, 16);
            const float o = half == 0 ? y * cs - p * sn : y * cs + p * sn;
            qk[h * 64 + lane] = (bf16)f2bf(o);
        }
    }
}

__device__ __forceinline__ float block_sum(Frame& F, float v, LAS float* red) {
    v = wave_sum(v, F.lane);
    __syncthreads();
    if (F.lane == 0) red[F.wave] = v;
    __syncthreads();
    float t = 0.f;
#pragma unroll
    for (int w = 0; w < NWAVES; ++w) t += red[w];
    return t;
}

template <int L>
__device__ __forceinline__ float hy_uc(const bf16* PR, int rowbase, int b, int t, int ch, const float* cw, const float* cb) {
    float a = cb[ch];
#pragma unroll
    for (int j = 0; j < 3; ++j) { const int tt = t + j - 1; if (tt >= 0 && tt < L) a += bf2f(PR[(size_t)(rowbase + b * L + tt) * INW + V_END + ch]) * cw[j * 768 + ch]; }
    return a;
}

template <int L>
__device__ __forceinline__ void hyena_item_naive(Frame& F, int l, int c, int rowbase, const float* taps) {
    constexpr int NT = (L + NTHREADS - 1) / NTHREADS;
    LAS float* kt = (LAS float*)F.lds;
    LAS f32x2* z = (LAS f32x2*)(F.lds + 2 * L * 4);
    LAS float* red = (LAS float*)(F.lds + 2 * L * 4 + L * 8);
    const float* cw = inp(F, I_HCW) + l * 3 * 768; const float* cb = inp(F, I_HCB) + l * 768; const float* hb = inp(F, I_HBIAS) + l * 512;
    for (int t = F.tid; t < L; t += NTHREADS) { f32x2 v; v.x = hy_uc<L>(((bf16*)(wsp(F) + WS_PR)), rowbase, 0, t, 512 + c, cw, cb); v.y = hy_uc<L>(((bf16*)(wsp(F) + WS_PR)), rowbase, 1, t, 512 + c, cw, cb); z[t] = v; }
    for (int o = 0; o < 2; ++o) {
        const float* fwd = taps + (size_t)(o * 256 + c) * L; const float* bwd = taps + (size_t)(512 + o * 256 + c) * L;
        float part = 0.f;
        for (int d = F.tid; d < L; d += NTHREADS) { const float kf = fwd[d]; kt[L + d] = kf; part += fabsf(kf);
            if (d >= 1) { const float kb = bwd[d]; kt[L - d] = kb; part += fabsf(kb); } else kt[0] = 0.f; }
        const float tot = block_sum(F, part, red);
        const float inv = 1.0f / tot;
        __syncthreads();
        float* tmp = (float*)(wsp(F) + WS_MACC) + (size_t)c * 2 * SEQ;
#pragma unroll 1
        for (int t = F.tid; t < L; t += NTHREADS) {
            float a0 = 0.f, a1 = 0.f;
#pragma unroll 4
            for (int s = 0; s < L; ++s) { const f32x2 zz = z[s]; const float kv = kt[L + t - s]; a0 += kv * zz.x; a1 += kv * zz.y; }
            tmp[t] = a0; tmp[SEQ + t] = a1;
        }
        __syncthreads();
        const float bo = hb[o * 256 + c];
#pragma unroll 1
        for (int t = F.tid; t < L; t += NTHREADS) {
            const float g0 = hy_uc<L>(((bf16*)(wsp(F) + WS_PR)), rowbase, 0, t, o * 256 + c, cw, cb), g1 = hy_uc<L>(((bf16*)(wsp(F) + WS_PR)), rowbase, 1, t, o * 256 + c, cw, cb);
            const f32x2 zo = z[t]; f32x2 zn; zn.x = g0 * (tmp[t] * inv + bo * zo.x); zn.y = g1 * (tmp[SEQ + t] * inv + bo * zo.y); z[t] = zn;
        }
        __syncthreads();
    }
    for (int t = F.tid; t < L; t += NTHREADS) { const f32x2 v = z[t];
        ((bf16*)(wsp(F) + WS_HYT))[(size_t)c * MT + rowbase + t] = (bf16)f2bf(v.x); ((bf16*)(wsp(F) + WS_HYT))[(size_t)c * MT + rowbase + L + t] = (bf16)f2bf(v.y); }
    __syncthreads();
}

template <int L>
__device__ __forceinline__ void fnet_item_naive(Frame& F, int b, int g, int m, int rowbase) {
    LAS f32x2* AB = (LAS f32x2*)F.lds;
    LAS f32x2* tab = (LAS f32x2*)(F.lds + L * 8);
    LAS f32x2* cs64 = (LAS f32x2*)(F.lds + 2 * L * 8);
    for (int i = F.tid; i < L; i += NTHREADS) { f32x2 v; const float rev = (float)i / (float)L; v.x = cos_rev(rev); v.y = sin_rev(rev); tab[i] = v; }
    if (F.tid < 64) { f32x2 v; const float rev = (float)F.tid / 64.0f; v.x = cos_rev(rev); v.y = sin_rev(rev); cs64[F.tid] = v; }
    __syncthreads();
    for (int n = F.tid; n < L; n += NTHREADS) {
        const bf16* up = ((bf16*)(wsp(F) + WS_PR)) + (size_t)(rowbase + b * L + n) * INW + HY_END + g * 64;
        float A = 0.f, Bv = 0.f;
        for (int c = 0; c < 64; ++c) { const float u = bf2f(up[c]); const f32x2 cs = cs64[(m * c) & 63]; A += u * cs.x; Bv += u * cs.y; }
        f32x2 v; v.x = A; v.y = Bv; AB[n] = v;
    }
    __syncthreads();
    const float scale = 1.0f / sqrtf((float)L * 64.0f);
    for (int k = F.tid; k < L; k += NTHREADS) {
        float acc = 0.f; int idx = 0;
        for (int n = 0; n < L; ++n) { const f32x2 ab = AB[n]; const f32x2 cs = tab[idx]; acc += ab.x * cs.x - ab.y * cs.y; idx = (idx + k) & (L - 1); }
        ((bf16*)(wsp(F) + WS_FNT))[(size_t)(g * 64 + m) * MT + rowbase + b * L + k] = (bf16)f2bf(acc * scale);
    }
    __syncthreads();
}

__device__ __forceinline__ void attn_item_naive(Frame& F, int l, int r, int kvh, LAS float* wq, LAS float* wp) {
    const int lane = F.lane;
    const bool isctx = r >= ML; const int b = isctx ? ((r - ML) >> 8) : (r >> 13); const int t = r & 8191;
    const int lo = (t - 128) < 0 ? 0 : (t - 128), hi = (t + 128) > (SEQ - 1) ? (SEQ - 1) : (t + 128);
    const int nloc = isctx ? 0 : (hi - lo + 1), nk = nloc + CTXL;
#pragma unroll
    for (int h = 0; h < 4; ++h) wq[h * 64 + lane] = bf2f(((bf16*)(wsp(F) + WS_QK))[(size_t)r * 640 + (4 * kvh + h) * 64 + lane]) * 0.125f;
    LDS_WAIT(); asm volatile("" ::: "memory");
    for (int j = lane; j < nk; j += 64) {
        const int krow = j < nloc ? (b * SEQ + lo + j) : (ML + b * CTXL + (j - nloc));
        const bf16* kp = ((bf16*)(wsp(F) + WS_QK)) + (size_t)krow * 640 + 512 + kvh * 64;
        float s0 = 0.f, s1 = 0.f, s2 = 0.f, s3 = 0.f;
#pragma unroll
        for (int d8 = 0; d8 < 8; ++d8) { const v4u kw = *(const v4u*)(kp + d8 * 8);
            float kf[8]; kf[0] = bflo(kw.x); kf[1] = bfhi(kw.x); kf[2] = bflo(kw.y); kf[3] = bfhi(kw.y); kf[4] = bflo(kw.z); kf[5] = bfhi(kw.z); kf[6] = bflo(kw.w); kf[7] = bfhi(kw.w);
#pragma unroll
            for (int e = 0; e < 8; ++e) { const int d = d8 * 8 + e; s0 += kf[e] * wq[d]; s1 += kf[e] * wq[64 + d]; s2 += kf[e] * wq[128 + d]; s3 += kf[e] * wq[192 + d]; } }
        f32x4 sv; sv[0] = s0; sv[1] = s1; sv[2] = s2; sv[3] = s3;
        *(LAS f32x4*)(wp + j * 4) = sv;
    }
    LDS_WAIT(); asm volatile("" ::: "memory");
    f32x4 mx = {-INFINITY, -INFINITY, -INFINITY, -INFINITY};
    for (int j = lane; j < nk; j += 64) { const f32x4 sv = *(LAS f32x4*)(wp + j * 4);
#pragma unroll
        for (int h = 0; h < 4; ++h) mx[h] = fmaxf(mx[h], sv[h]); }
    f32x4 sink, den;
#pragma unroll
    for (int h = 0; h < 4; ++h) { sink[h] = inp(F, I_SINK)[l * 8 + 4 * kvh + h]; mx[h] = fmaxf(wave_max(mx[h], lane), sink[h]); den[h] = 0.f; }
    for (int j = lane; j < nk; j += 64) { f32x4 sv = *(LAS f32x4*)(wp + j * 4);
#pragma unroll
        for (int h = 0; h < 4; ++h) { sv[h] = __expf(sv[h] - mx[h]); den[h] += sv[h]; }
        *(LAS f32x4*)(wp + j * 4) = sv; }
#pragma unroll
    for (int h = 0; h < 4; ++h) den[h] = wave_sum(den[h], lane) + __expf(sink[h] - mx[h]);
    LDS_WAIT(); asm volatile("" ::: "memory");
    f32x4 o = {0.f, 0.f, 0.f, 0.f};
    for (int j = 0; j < nk; ++j) {
        const int krow = j < nloc ? (b * SEQ + lo + j) : (ML + b * CTXL + (j - nloc));
        const float v = bf2f(((bf16*)(wsp(F) + WS_PR))[(size_t)krow * INW + K_END + kvh * 64 + lane]);
        const f32x4 p = *(LAS f32x4*)(wp + j * 4);
        o += p * v;
    }
#pragma unroll
    for (int h = 0; h < 4; ++h) ((bf16*)(wsp(F) + WS_ATT))[(size_t)r * 512 + (4 * kvh + h) * 64 + lane] = (bf16)f2bf(o[h] / den[h]);
    LDS_WAIT(); asm volatile("" ::: "memory");
}


__device__ __forceinline__ void phase_trans(Frame& F) {
    LAS unsigned* tl = (LAS unsigned*)(F.lds + F.wave * 16640);
    const int gw = F.bid * NWAVES + F.wave, NGW = F.G * NWAVES, lane = F.lane;
    for (int it = gw; it < 2 * 264 * 4; it += NGW) {
        const int which = it / (264 * 4), rem = it % (264 * 4), rt = rem >> 2, ct = rem & 3;
        const bf16* src = which == 0 ? ((const bf16*)(wsp(F) + WS_HYT)) : ((const bf16*)(wsp(F) + WS_FNT));
        bf16* dst = which == 0 ? ((bf16*)(wsp(F) + WS_HYO)) : ((bf16*)(wsp(F) + WS_FNO));
#pragma unroll 8
        for (int ch = 0; ch < 64; ++ch) tl[ch * 65 + lane] = src[(size_t)(ct * 64 + ch) * MT + rt * 64 + lane];
        LDS_WAIT(); asm volatile("" ::: "memory");
#pragma unroll 8
        for (int row = 0; row < 64; ++row) dst[(size_t)(rt * 64 + row) * 256 + ct * 64 + lane] = (bf16)tl[lane * 65 + row];
        LDS_WAIT(); asm volatile("" ::: "memory");
    }
}

__device__ __forceinline__ void phase_mix_naive(Frame& F, int l) {
    { LAS float* wq = (LAS float*)(F.lds + F.wave * 10240); LAS float* wp = wq + 256;
      const int gw = F.bid * NWAVES + F.wave, NGW = F.G * NWAVES;
      for (int it = gw; it < MT * 2; it += NGW) attn_item_naive(F, l, it >> 1, it & 1, wq, wp); }
    __syncthreads();
    for (int c = F.bid; c < 256; c += F.G) hyena_item_naive<SEQ>(F, l, c, 0, ((float*)(wsp(F) + WS_HF)));
    for (int c = F.bid; c < 256; c += F.G) hyena_item_naive<CTXL>(F, l, c, ML, ((float*)(wsp(F) + WS_HFC)));
    for (int it = F.bid; it < 512; it += F.G) fnet_item_naive<SEQ>(F, it >> 8, (it >> 6) & 3, it & 63, 0);
    for (int it = F.bid; it < 512; it += F.G) fnet_item_naive<CTXL>(F, it >> 8, (it >> 6) & 3, it & 63, ML);
}

constexpr int NPL = 24;
constexpr int NPHASES = 1 + DEPTH * NPL;
#ifndef ONE_LAUNCH
#define ONE_LAUNCH 0
#endif

__global__ void __launch_bounds__(NTHREADS, 2) fwd_kernel(Args args) {
    extern __shared__ __attribute__((aligned(16))) unsigned char lds[];
    Frame F;
    F.lds = (LAS unsigned char*)lds;
    F.tid = threadIdx.x; F.lane = F.tid & 63; F.wave = __builtin_amdgcn_readfirstlane(F.tid >> 6);
    F.G = gridDim.x; F.bid = blockIdx.x;
    unsigned char* ws = args.ws; F.ws = ws;
    F.ctl = (unsigned*)(ws + WS_CTL);
    F.a = &args; F.z = 0;
    volatile LAS unsigned* MISC = (volatile LAS unsigned*)(F.lds + MISC_OFF);
    for (int u = F.tid; u < 64; u += NTHREADS) MISC[u] = 0u;
    __syncthreads();
    const int lo = args.ph_lo, hi = args.ph_hi;
    XcdBarrier bar; bar.bar = F.ctl + CW_BAR; bar.x = 0; bar.st = nullptr;
    if (hi - lo > 1) bar = xcd_barrier_post(F.ctl + CW_BAR, MISC + 8);
#define PH_BEGIN(k) if (lo <= (k) && (k) < hi) { { int t_ = threadIdx.x; asm volatile("" : "+v"(t_)); F.tid = t_; F.lane = t_ & 63; F.wave = __builtin_amdgcn_readfirstlane(t_ >> 6); int z_ = 0; asm volatile("" : "+s"(z_)); F.z = z_; }
#define PH_END(k) if ((k) + 1 < hi) xcd_barrier_impl(bar.bar, bar.x, bar.st); }

    PH_BEGIN(0) phase_prologue(F); PH_END(0)

    for (int l = 0; l < DEPTH; ++l) {
        const int pb = 1 + l * NPL;
        const float* xin_lat = (l == 0) ? inp(F, I_X) : outp(F);
        const float* xin_ctx = (l == 0) ? inp(F, I_CTX) : ((float*)(wsp(F) + WS_XC));
        const float* modl = ((float*)(wsp(F) + WS_CTL) + CW_MOD) + (size_t)l * 3 * 6144;
        const bool moe = (l & 1) != 0; const int fi = l >> 1;

        PH_BEGIN(pb + 0)
            phase_norm<false>(F, l, xin_lat, xin_ctx, inp(F, I_N1G) + l * 1024, 0, nullptr);
            for (int it = F.bid; it < 132; it += F.G) { if (it < 128) filter_tile(F, l, SEQ, it * 64, ((float*)(wsp(F) + WS_HF))); else filter_tile(F, l, CTXL, (it - 128) * 64, ((float*)(wsp(F) + WS_HFC))); }
        PH_END(pb + 0)

        PH_BEGIN(pb + 1)
            pg8::Gemm g{((bf16*)(wsp(F) + WS_H)), ((bf16*)(wsp(F) + WS_WIN)) + (size_t)l * INW * 1024, MT, INW, 1024}; pg8::StaticOrder S; S.init(MT, INW, F.G, F.bid);
            pg8::EpiStore E{((bf16*)(wsp(F) + WS_PR)), INW};
            pg8::gemm_phase<pg8::EpiStore, pg8::StaticOrder, true, true>(F.lds, g, S, E);
        PH_END(pb + 1)

        PH_BEGIN(pb + 2) phase_qkprep(F, l); PH_END(pb + 2)

        PH_BEGIN(pb + 3) phase_mix_naive(F, l); PH_END(pb + 3)

        PH_BEGIN(pb + 4) phase_trans(F); PH_END(pb + 4)

        PH_BEGIN(pb + 5)
            for (int br = 0; br < 3; ++br) {
                const bf16* A = br == 0 ? ((bf16*)(wsp(F) + WS_ATT)) : (br == 1 ? ((bf16*)(wsp(F) + WS_HYO)) : ((bf16*)(wsp(F) + WS_FNO)));
                const bf16* Bt = br == 0 ? ((bf16*)(wsp(F) + WS_WPA)) + (size_t)l * 1024 * 512 : (br == 1 ? ((bf16*)(wsp(F) + WS_WPH)) + (size_t)l * 1024 * 256 : ((bf16*)(wsp(F) + WS_WPF)) + (size_t)l * 1024 * 256);
                const int K = br == 0 ? 512 : 256;
                pg8::Gemm g{A, Bt, MT, 1024, K}; pg8::StaticOrder S; S.init(MT, 1024, F.G, F.bid);
                pg8::EpiMerge E{((bf16*)(wsp(F) + WS_PR)), ((float*)(wsp(F) + WS_MACC)), ((bf16*)(wsp(F) + WS_M)), br};
                pg8::gemm_phase<pg8::EpiMerge, pg8::StaticOrder, true, true>(F.lds, g, S, E);
                __syncthreads();
            }
        PH_END(pb + 5)

        PH_BEGIN(pb + 6)
            pg8::Gemm g{((bf16*)(wsp(F) + WS_M)), ((bf16*)(wsp(F) + WS_WO)) + (size_t)l * 1024 * 1024, MT, 1024, 1024}; pg8::StaticOrder S; S.init(MT, 1024, F.G, F.bid);
            pg8::EpiResid E{xin_lat, xin_ctx, outp(F), ((float*)(wsp(F) + WS_XC)), modl + 2048, nullptr};
            pg8::gemm_phase<pg8::EpiResid, pg8::StaticOrder, true, true>(F.lds, g, S, E);
        PH_END(pb + 6)

        PH_BEGIN(pb + 7)
            if (moe) phase_norm<true>(F, l, outp(F), ((float*)(wsp(F) + WS_XC)), inp(F, I_N2G) + l * 1024, 3072, inp(F, I_ROUTER) + (size_t)fi * 1024 * 8);
            else phase_norm<false>(F, l, outp(F), ((float*)(wsp(F) + WS_XC)), inp(F, I_N2G) + l * 1024, 3072, nullptr);
        PH_END(pb + 7)

        const int ne = moe ? NEXP : 1;
        for (int e = 0; e < ne; ++e) {
            const bf16* Wgu = moe ? ((bf16*)(wsp(F) + WS_MGU)) + (size_t)(fi * 8 + e) * 5632 * 1024 : ((bf16*)(wsp(F) + WS_FGU)) + (size_t)fi * 5632 * 1024;
            const bf16* Wd = moe ? ((bf16*)(wsp(F) + WS_MD)) + (size_t)(fi * 8 + e) * 1024 * 2816 : ((bf16*)(wsp(F) + WS_FD)) + (size_t)fi * 1024 * 2816;
            PH_BEGIN(pb + 8 + 2 * e)
                pg8::Gemm g{((bf16*)(wsp(F) + WS_H)), Wgu, MT, 5632, 1024}; pg8::StaticOrder S; S.init(MT, 5632, F.G, F.bid);
                pg8::EpiSwiglu E{((bf16*)(wsp(F) + WS_HID)), DFF};
                pg8::gemm_phase<pg8::EpiSwiglu, pg8::StaticOrder, true, true>(F.lds, g, S, E);
            PH_END(pb + 8 + 2 * e)
            PH_BEGIN(pb + 9 + 2 * e)
                pg8::Gemm g{((bf16*)(wsp(F) + WS_HID)), Wd, MT, 1024, DFF}; pg8::StaticOrder S; S.init(MT, 1024, F.G, F.bid);
                pg8::EpiResid E{outp(F), ((float*)(wsp(F) + WS_XC)), outp(F), ((float*)(wsp(F) + WS_XC)), modl + 5120, moe ? ((float*)(wsp(F) + WS_COMB)) + e : nullptr};
                pg8::gemm_phase<pg8::EpiResid, pg8::StaticOrder, true, true>(F.lds, g, S, E);
            PH_END(pb + 9 + 2 * e)
        }
    }
#undef PH_BEGIN
#undef PH_END
}

extern "C" void kernel_launch(void* const* d_in, const int* in_sizes, int n_in, void* d_out, int out_size, void* d_ws, size_t ws_size, hipStream_t stream) {
    static int grid = 0;
    if (grid == 0) {
        if (n_in != 33 || out_size != ML * DM || ws_size < WS_END) { fprintf(stderr, "kernel_launch: unexpected shapes (n_in %d out %d ws %zu need %zu)\n", n_in, out_size, ws_size, (size_t)WS_END); grid = -1; return; }
        int dev = 0, cus = 0, per_cu = 0;
        if (hipGetDevice(&dev) != hipSuccess || hipDeviceGetAttribute(&cus, hipDeviceAttributeMultiprocessorCount, dev) != hipSuccess) { grid = -1; return; }
        if (hipFuncSetAttribute((const void*)fwd_kernel, hipFuncAttributeMaxDynamicSharedMemorySize, LDS_BYTES) != hipSuccess) { fprintf(stderr, "kernel_launch: hipFuncSetAttribute failed\n"); grid = -1; return; }
        if (hipOccupancyMaxActiveBlocksPerMultiprocessor(&per_cu, (const void*)fwd_kernel, NTHREADS, LDS_BYTES) != hipSuccess || per_cu < 1) { fprintf(stderr, "kernel_launch: occupancy query says %d\n", per_cu); }
        (void)hipGetLastError();
        grid = cus;
    }
    if (grid < 0) return;
    if (hipMemsetAsync((char*)d_ws + WS_CTL, 0, CTL_ZERO_BYTES, stream) != hipSuccess) return;
    Args a{};
    for (int i = 0; i < 33; ++i) a.in[i] = (const float*)d_in[i];
    a.in[33] = (const float*)d_out; a.ws = (unsigned char*)d_ws;
#if ONE_LAUNCH
    a.ph_lo = 0; a.ph_hi = NPHASES;
    hipLaunchKernelGGL(fwd_kernel, dim3(grid), dim3(NTHREADS), LDS_BYTES, stream, a);
#else
    for (int k = 0; k < NPHASES; ++k) {
        if (k >= 1) { const int l = (k - 1) / NPL, p = (k - 1) % NPL; if ((l & 1) == 0 && p >= 10) continue; }
        a.ph_lo = k; a.ph_hi = k + 1;
        hipLaunchKernelGGL(fwd_kernel, dim3(grid), dim3(NTHREADS), LDS_BYTES, stream, a);
    }
#endif
}
```

```cpp
#include <hip/hip_runtime.h>
#include <cstdio>
#include <cstdint>
namespace pg8 {
#define PG8_LAS __attribute__((address_space(3)))
typedef unsigned short bf16_t;
typedef short bf16x8 __attribute__((ext_vector_type(8)));
typedef float f32x4 __attribute__((ext_vector_type(4)));
typedef unsigned u32x4 __attribute__((ext_vector_type(4)));
constexpr int BM = 256, BK = 64, HALF = 128, HTB = HALF * BK * 2  , STAGE_BYTES = 8 * HTB, NXCD = 8, WGM = 8;

__host__ __device__ __forceinline__ int lds_byte(int r, int c) { const int st = (r >> 4) * 2 + (c >> 5), rr = r & 15, cc = c & 31, ob = rr * 64 + cc * 2; return st * 1024 + (ob ^ (((ob >> 9) & 1) << 5)); }
__host__ __device__ __forceinline__ void stage_rc(int b, int& R, int& C) { const int st = b / 1024, sb = b % 1024, swz = sb ^ (((sb >> 9) & 1) << 5); R = (st >> 1) * 16 + swz / 64; C = (st & 1) * 32 + (swz % 64) / 2; }
__host__ __device__ __forceinline__ int perm32(int rho) { const int n = rho >> 4, i = rho & 15; return 8 * (i >> 2) + 4 * n + (i & 3); }

struct Unit { int pm, pn; };
struct Gemm { const bf16_t* A; const bf16_t* Bt; int M, N, K; };

struct StaticOrder {
    int nM, nN, nwg, G, c;
    __host__ __device__ void init(int M, int N, int G_, int c_) { nM = M / BM; nN = N / BM; nwg = nM * nN; G = G_; c = c_; }
    __host__ __device__ bool next(int i, Unit& u) const {
        const long L = (long)i * G + c; if (L >= nwg) return false;
        int wgid = (int)L; { const int q = nwg / NXCD, r = nwg % NXCD, xcd = wgid % NXCD, off = wgid / NXCD; wgid = (xcd < r ? xcd * (q + 1) : r * (q + 1) + (xcd - r) * q) + off; }
        const int nig = WGM * nN, gid = wgid / nig, fm = gid * WGM, gsz = (nM - fm) < WGM ? (nM - fm) : WGM;
        u.pm = fm + ((wgid % nig) % gsz); u.pn = (wgid % nig) / gsz; return true;
    }
    __device__ __forceinline__ void a_ready(const Unit&) const {}
    __device__ __forceinline__ void done(const Unit&) const {}
};

__device__ __forceinline__ unsigned cvt_pk_bf16(float lo, float hi) { unsigned r; asm volatile("v_cvt_pk_bf16_f32 %0, %1, %2" : "=v"(r) : "v"(lo), "v"(hi)); return r; }
typedef float f32x2 __attribute__((ext_vector_type(2)));
template <class Epi, class Sched, bool ALIGN_EPI = false, bool SP2 = false>
__device__ __forceinline__ void gemm_phase(PG8_LAS unsigned char* lds, const Gemm g, const Sched& S, const Epi& E) {
    int tid_ = threadIdx.x; asm volatile("" : "+v"(tid_)); const int tid = tid_, wid = __builtin_amdgcn_readfirstlane(tid >> 6), lane = tid & 63, wr = wid >> 2, wc = wid & 3, fr = lane & 15, fq = lane >> 4;
    const int K = g.K, nt = K / BK;
    unsigned voffA[2], voffB[2];
#pragma unroll
    for (int i = 0; i < 2; ++i) { int R, C; stage_rc(tid * 16 + i * 8192, R, C); const int Rb = Epi::PERM ? ((R & ~31) + perm32(R & 31)) : R;
        voffA[i] = (unsigned)(R * K + C) * 2u; voffB[i] = (unsigned)(Rb * K + C) * 2u; }
    const size_t kstep = (size_t)(BK * 2);
    const size_t hstep = (size_t)HALF * K * 2;
    const size_t tstep = 2 * hstep;
    const unsigned ldsw = (unsigned)wid * 1024u;
    const int aoff = lds_byte(wr * 64 + fr, fq * 8), boff = lds_byte(wc * 32 + fr, fq * 8);
#define PG8_SA(b, h) (((b) * 2 + (h)) * HTB)
#define PG8_SB(b, h) ((4 + (b) * 2 + (h)) * HTB)
#define PG8_STAGE(bufoff, gbase, voff) do { _Pragma("unroll") for (int _i = 0; _i < 2; ++_i) \
        __builtin_amdgcn_global_load_lds((const unsigned*)((const char*)(gbase) + (voff)[_i]), (PG8_LAS unsigned*)(lds + (bufoff) + ldsw + _i * 8192), 16, 0, 0); } while (0)
#define PG8_LDA(dst, b, h) do { _Pragma("unroll") for (int m = 0; m < 4; ++m) _Pragma("unroll") for (int k = 0; k < 2; ++k) dst[m][k] = *(const PG8_LAS bf16x8*)(lds + PG8_SA(b, h) + aoff + m * 2048 + k * 1024); } while (0)
#define PG8_LDB(dst, b, h) do { _Pragma("unroll") for (int n = 0; n < 2; ++n) _Pragma("unroll") for (int k = 0; k < 2; ++k) dst[n][k] = *(const PG8_LAS bf16x8*)(lds + PG8_SB(b, h) + boff + n * 2048 + k * 1024); } while (0)
#define PG8_MMA(ai, bj, At, Bt) do { __builtin_amdgcn_s_setprio(1); _Pragma("unroll") for (int m = 0; m < 4; ++m) _Pragma("unroll") for (int n = 0; n < 2; ++n) _Pragma("unroll") for (int k = 0; k < 2; ++k) \
        acc[ai][bj][m][n] = __builtin_amdgcn_mfma_f32_16x16x32_bf16(Bt[n][k], At[m][k], acc[ai][bj][m][n], 0, 0, 0); __builtin_amdgcn_s_setprio(0); } while (0)
#define PG8_WAIT_V(n) asm volatile("s_waitcnt vmcnt(" #n ")" ::: "memory")
#define PG8_WAIT_L(n) asm volatile("s_waitcnt lgkmcnt(" #n ")" ::: "memory")
#define PG8_BAR __builtin_amdgcn_s_barrier()
#define PG8_SCHED __builtin_amdgcn_sched_barrier(0)
    Unit cur, nxt; int ui = 0;
    if (!S.next(0, cur)) return;
    f32x4 acc[2][2][4][2];
#pragma unroll
    for (int a = 0; a < 2; ++a)
#pragma unroll
        for (int b = 0; b < 2; ++b)
#pragma unroll
            for (int m = 0; m < 4; ++m)
#pragma unroll
                for (int n = 0; n < 2; ++n) acc[a][b][m][n] = (f32x4){0.f, 0.f, 0.f, 0.f};
    bf16x8 At[4][2], B0[2][2], B1[2][2];
    const char* cA = (const char*)g.A + (size_t)cur.pm * tstep; const char* cB = (const char*)g.Bt + (size_t)cur.pn * tstep;
    S.a_ready(cur);
    if constexpr (SP2) {
        PG8_STAGE(PG8_SB(0, 0), cB, voffB); PG8_STAGE(PG8_SB(0, 1), cB + hstep, voffB); PG8_STAGE(PG8_SA(0, 0), cA, voffA); PG8_STAGE(PG8_SA(0, 1), cA + hstep, voffA);
        if (wr == 1) PG8_BAR;
        PG8_WAIT_V(2); PG8_BAR;
        PG8_STAGE(PG8_SB(1, 0), cB + kstep, voffB); PG8_STAGE(PG8_SA(1, 0), cA + kstep, voffA); PG8_STAGE(PG8_SB(1, 1), cB + hstep + kstep, voffB);
        PG8_WAIT_V(6); PG8_BAR;
    } else {
        PG8_STAGE(PG8_SB(0, 0), cB, voffB); PG8_STAGE(PG8_SA(0, 0), cA, voffA); PG8_STAGE(PG8_SB(0, 1), cB + hstep, voffB); PG8_STAGE(PG8_SA(0, 1), cA + hstep, voffA);
        if (wr == 1) PG8_BAR;
        PG8_WAIT_V(4); PG8_BAR;
        PG8_STAGE(PG8_SB(1, 0), cB + kstep, voffB); PG8_STAGE(PG8_SA(1, 0), cA + kstep, voffA); PG8_STAGE(PG8_SB(1, 1), cB + hstep + kstep, voffB);
        PG8_WAIT_V(6); PG8_BAR;
    }
    for (;;) {
        const bool has_next = S.next(ui + 1, nxt);
        const char* nA = has_next ? (const char*)g.A + (size_t)nxt.pm * tstep : cA; const char* nB = has_next ? (const char*)g.Bt + (size_t)nxt.pn * tstep : cB;
        for (int t = 0; t < nt; t += 2) {
            const bool last = (t == nt - 2);
            const char* a1 = cA + (size_t)(t + 1) * kstep;
            const char* a2 = last ? nA : cA + (size_t)(t + 2) * kstep; const char* b2 = last ? nB : cB + (size_t)(t + 2) * kstep;
            const char* a3 = a2 + kstep; const char* b3 = b2 + kstep;
            if (last && has_next) S.a_ready(nxt);
            if constexpr (SP2) {
            PG8_LDB(B0, 0, 0); PG8_LDB(B1, 0, 1); PG8_SCHED; PG8_LDA(At, 0, 0); PG8_STAGE(PG8_SA(1, 1), a1 + hstep, voffA);
            PG8_WAIT_V(8); PG8_WAIT_L(0); PG8_BAR; PG8_MMA(0, 0, At, B0); PG8_MMA(0, 1, At, B1); PG8_BAR; PG8_SCHED;
            PG8_LDA(At, 0, 1); PG8_STAGE(PG8_SB(0, 0), b2, voffB); PG8_STAGE(PG8_SB(0, 1), b2 + hstep, voffB); PG8_STAGE(PG8_SA(0, 0), a2, voffA);
            PG8_WAIT_V(8); PG8_WAIT_L(0); PG8_BAR; PG8_MMA(1, 0, At, B0); PG8_MMA(1, 1, At, B1); PG8_BAR; PG8_SCHED;
            PG8_LDB(B0, 1, 0); PG8_LDB(B1, 1, 1); PG8_SCHED; PG8_LDA(At, 1, 0); PG8_STAGE(PG8_SA(0, 1), a2 + hstep, voffA);
            PG8_WAIT_V(8); PG8_WAIT_L(0); PG8_BAR; PG8_MMA(0, 0, At, B0); PG8_MMA(0, 1, At, B1); PG8_BAR; PG8_SCHED;
            PG8_LDA(At, 1, 1); PG8_STAGE(PG8_SB(1, 0), b3, voffB); PG8_STAGE(PG8_SB(1, 1), b3 + hstep, voffB); PG8_STAGE(PG8_SA(1, 0), a3, voffA);
            PG8_WAIT_V(8); PG8_WAIT_L(0); PG8_BAR; PG8_MMA(1, 0, At, B0); PG8_MMA(1, 1, At, B1); PG8_BAR; PG8_SCHED;
            } else {
            PG8_LDB(B0, 0, 0); PG8_SCHED; PG8_LDA(At, 0, 0); PG8_STAGE(PG8_SA(1, 1), a1 + hstep, voffA);
            PG8_WAIT_L(8); PG8_BAR; PG8_WAIT_L(0); PG8_MMA(0, 0, At, B0); PG8_BAR; PG8_SCHED;
            PG8_LDB(B1, 0, 1); PG8_STAGE(PG8_SB(0, 0), b2, voffB);
            PG8_BAR; PG8_WAIT_L(0); PG8_MMA(0, 1, At, B1); PG8_BAR;
            PG8_LDA(At, 0, 1); PG8_STAGE(PG8_SA(0, 0), a2, voffA);
            PG8_BAR; PG8_WAIT_L(0); PG8_MMA(1, 0, At, B0); PG8_BAR; PG8_SCHED;
            PG8_STAGE(PG8_SB(0, 1), b2 + hstep, voffB);
            PG8_WAIT_V(6); PG8_BAR; PG8_MMA(1, 1, At, B1); PG8_BAR;
            PG8_LDB(B0, 1, 0); PG8_SCHED; PG8_LDA(At, 1, 0); PG8_STAGE(PG8_SA(0, 1), a2 + hstep, voffA);
            PG8_WAIT_L(8); PG8_BAR; PG8_WAIT_L(0); PG8_MMA(0, 0, At, B0); PG8_BAR; PG8_SCHED;
            PG8_LDB(B1, 1, 1); PG8_STAGE(PG8_SB(1, 0), b3, voffB);
            PG8_BAR; PG8_WAIT_L(0); PG8_MMA(0, 1, At, B1); PG8_BAR;
            PG8_LDA(At, 1, 1); PG8_STAGE(PG8_SA(1, 0), a3, voffA);
            PG8_BAR; PG8_WAIT_L(0); PG8_MMA(1, 0, At, B0); PG8_BAR; PG8_SCHED;
            PG8_STAGE(PG8_SB(1, 1), b3 + hstep, voffB);
            PG8_WAIT_V(6); PG8_BAR; PG8_MMA(1, 1, At, B1); PG8_BAR;
            }
        }
        if constexpr (ALIGN_EPI) { if (wr == 0) PG8_BAR; }
        if constexpr (!Epi::AFTER_DRAIN) { E(acc, cur, wr, wc, fr, fq); S.done(cur); }
        if (!has_next) break;
#pragma unroll
        for (int a = 0; a < 2; ++a)
#pragma unroll
            for (int b = 0; b < 2; ++b)
#pragma unroll
                for (int m = 0; m < 4; ++m)
#pragma unroll
                    for (int n = 0; n < 2; ++n) acc[a][b][m][n] = (f32x4){0.f, 0.f, 0.f, 0.f};
        cur = nxt; cA = nA; cB = nB; ++ui;
        if constexpr (ALIGN_EPI) { if (wr == 1) PG8_BAR; }
    }
    PG8_WAIT_V(0);
    if constexpr (!ALIGN_EPI) { if (wr == 0) PG8_BAR; }
    PG8_BAR;
    if constexpr (Epi::AFTER_DRAIN) { E.fused(acc, cur, wr, wc, fr, fq, lds, wid, lane); S.done(cur); }
#undef PG8_SA
#undef PG8_SB
#undef PG8_STAGE
#undef PG8_LDA
#undef PG8_LDB
#undef PG8_MMA
#undef PG8_WAIT_V
#undef PG8_WAIT_L
#undef PG8_BAR
#undef PG8_SCHED
}
}

constexpr int NWAVES = 8, NTHREADS = 512;
constexpr int BATCH = 2, SEQ = 8192, DM = 1024, DEPTH = 4, CTXL = 256;
constexpr int ML = BATCH * SEQ;
constexpr int MC = BATCH * CTXL;
constexpr int MT = ML + MC;
constexpr int HD = 64, NH = 8, NKV = 2;
constexpr int QW = 512, KVW = 128;
constexpr int HYW = 256, FNW = 256;
constexpr int Q_END = 512, K_END = 640, V_END = 768, HY_END = 1536, FN_END = 1792, INW = 4864;
constexpr int DFF = 2816, NEXP = 8;
constexpr int FH = 64, FEMB = 33;
constexpr float EPS = 1e-6f;

constexpr size_t MiB = 1u << 20;
constexpr size_t WS_CTL = 0, CTL_ZERO_BYTES = 4 * MiB;
constexpr size_t WS_WIN = 4 * MiB;
constexpr size_t WS_WPA = WS_WIN + 38 * MiB;
constexpr size_t WS_WPH = WS_WPA + 4 * MiB;
constexpr size_t WS_WPF = WS_WPH + 2 * MiB;
constexpr size_t WS_WO = WS_WPF + 2 * MiB;
constexpr size_t WS_FGU = WS_WO + 8 * MiB;
constexpr size_t WS_FD = WS_FGU + 22 * MiB;
constexpr size_t WS_MGU = WS_FD + 11 * MiB;
constexpr size_t WS_MD = WS_MGU + 176 * MiB;
constexpr size_t WS_XC = WS_MD + 88 * MiB;
constexpr size_t WS_H = WS_XC + 2 * MiB;
constexpr size_t WS_COMB = WS_H + 33 * MiB;
constexpr size_t WS_HF = WS_COMB + 1 * MiB;
constexpr size_t WS_HFC = WS_HF + 32 * MiB;
constexpr size_t WS_S = WS_HFC + 1 * MiB;
constexpr size_t WS_PR = WS_S;
constexpr size_t WS_QK = WS_PR + 157 * MiB;
constexpr size_t WS_ATT = WS_QK + 21 * MiB;
constexpr size_t WS_HYO = WS_ATT + 17 * MiB;
constexpr size_t WS_FNO = WS_HYO + 9 * MiB;
constexpr size_t WS_MACC = WS_FNO + 9 * MiB;
constexpr size_t WS_M = WS_MACC + 66 * MiB;
constexpr size_t WS_END = WS_M + 33 * MiB;
constexpr size_t WS_HYT = WS_MACC + 32 * MiB;
constexpr size_t WS_FNT = WS_MACC + 44 * MiB;
constexpr size_t WS_HID = WS_S;
static_assert((size_t)MT * INW * 2 <= 157 * MiB && (size_t)MT * DFF * 2 <= 157 * MiB, "scratch sizes");
constexpr int CW_BAR = 4096;
constexpr int CW_MOD = 262144;
static_assert((CW_MOD + 4 * 3 * 6144) * 4 <= (int)CTL_ZERO_BYTES, "ctl");

constexpr int LDS_BYTES = 147456;
constexpr int MISC_OFF = LDS_BYTES - 256;

#define LAS __attribute__((address_space(3)))
typedef unsigned short bf16;
typedef unsigned v4u __attribute__((ext_vector_type(4)));
typedef unsigned v2u __attribute__((ext_vector_type(2)));
typedef float f32x4 __attribute__((ext_vector_type(4)));
typedef float f32x2 __attribute__((ext_vector_type(2)));
#define LDS_WAIT() asm volatile("s_waitcnt lgkmcnt(0)" ::: "memory")
__device__ __forceinline__ unsigned f2bf(float f) { unsigned u = __builtin_bit_cast(unsigned, f); return (u + 0x7fffu + ((u >> 16) & 1u)) >> 16; }
__device__ __forceinline__ unsigned pk2(float lo, float hi) { return f2bf(lo) | (f2bf(hi) << 16); }
__device__ __forceinline__ float bf2f(unsigned short h) { return __builtin_bit_cast(float, (unsigned)h << 16); }
__device__ __forceinline__ float bflo(unsigned w) { return __builtin_bit_cast(float, w << 16); }
__device__ __forceinline__ float bfhi(unsigned w) { return __builtin_bit_cast(float, w & 0xffff0000u); }
__device__ __forceinline__ float shx(float v, int lane, int o) { return __builtin_bit_cast(float, __builtin_amdgcn_ds_bpermute((lane ^ o) << 2, __builtin_bit_cast(int, v))); }
__device__ __forceinline__ float wave_sum(float v, int lane) {
#pragma unroll
    for (int o = 1; o < 64; o <<= 1) v += shx(v, lane, o);
    return v;
}
__device__ __forceinline__ float wave_max(float v, int lane) {
#pragma unroll
    for (int o = 1; o < 64; o <<= 1) v = fmaxf(v, shx(v, lane, o));
    return v;
}
__device__ __forceinline__ float sin_rev(float r) { return __builtin_amdgcn_sinf(__builtin_amdgcn_fractf(r)); }
__device__ __forceinline__ float cos_rev(float r) { return __builtin_amdgcn_cosf(__builtin_amdgcn_fractf(r)); }
__device__ __forceinline__ float sigmoidf_(float x) { return __builtin_amdgcn_rcpf(1.0f + __expf(-x)); }
constexpr float INV_2PI = 0.15915494309189535f;

#define XB_TMO      128
#define XB_XCNT(j)  (256  + 64 * (j))
#define XB_XSUB(j)  (1280 + 64 * (j))
#define XB_XGEN(j)  (2304 + 64 * (j))
#define XB_TOP      3328
#define XB_TOPGEN   3392
#define XCD_BAR_WORDS 3456
#define XB_SPIN_CAP (1u << 18)

__device__ __forceinline__ unsigned xb_ld(unsigned* p)              { return __hip_atomic_load(p, __ATOMIC_RELAXED, __HIP_MEMORY_SCOPE_AGENT); }
__device__ __forceinline__ unsigned xb_add(unsigned* p, unsigned v) { return __hip_atomic_fetch_add(p, v, __ATOMIC_RELAXED, __HIP_MEMORY_SCOPE_AGENT); }
__device__ __forceinline__ unsigned xb_xcc_id() { return (unsigned)__builtin_amdgcn_s_getreg((3 << 11) | 20) & 0xFu; }
#define XB_SPIN(cond, bar) do { unsigned _sp = 0; while (cond) { __builtin_amdgcn_s_sleep(1); \
    if ((++_sp & 255u) == 0u) { if (xb_ld(&(bar)[XB_TMO])) break; if (_sp > XB_SPIN_CAP) { atomicAdd(&(bar)[XB_TMO], 1u); break; } } } } while (0)

struct XcdBarrier {
    unsigned* bar; unsigned x;
    volatile LAS unsigned* st;
};

__device__ __forceinline__ XcdBarrier xcd_barrier_post(unsigned* bar, volatile LAS unsigned* st) {
    XcdBarrier b; b.bar = bar; b.x = xb_xcc_id(); b.st = st;
    if (threadIdx.x == 0) (void)xb_add(&bar[XB_XCNT(b.x)], 1u);
    return b;
}
__device__ __forceinline__ void xcd_barrier_complete(unsigned* bar, unsigned x, unsigned& nloc, unsigned& nx) {
    const unsigned G = gridDim.x * gridDim.y * gridDim.z;
    unsigned sum, cnt, mine, sp = 0u;
    for (;;) {
        sum = 0u; cnt = 0u; mine = 0u;
#pragma unroll
        for (unsigned j = 0; j < 16; ++j) { const unsigned c = xb_ld(&bar[XB_XCNT(j)]); sum += c; cnt += (c > 0u) ? 1u : 0u; mine = (j == x) ? c : mine; }
        if (sum == G) break;
        __builtin_amdgcn_s_sleep(1);
        if ((++sp & 255u) == 0u) { if (xb_ld(&bar[XB_TMO])) break; if (sp > XB_SPIN_CAP) { atomicAdd(&bar[XB_TMO], 1u); break; } }
    }
    nloc = mine > 0u ? mine : 1u; nx = cnt > 0u ? cnt : 1u;
}

__device__ __attribute__((noinline)) void xcd_barrier_impl(unsigned* b_bar, unsigned b_x, volatile LAS unsigned* b_st) {
    XcdBarrier b; b.bar = b_bar; b.x = b_x; b.st = b_st;
    asm volatile("s_waitcnt vmcnt(0)" ::: "memory");
    __syncthreads();
    if (threadIdx.x == 0) {
        unsigned* bar = b.bar;
        __builtin_amdgcn_s_waitcnt(0);
        unsigned nloc = b.st[0], nx = b.st[1];
        if (nloc == 0u) { xcd_barrier_complete(bar, b.x, nloc, nx); b.st[0] = nloc; b.st[1] = nx; }
        const unsigned old = xb_add(&bar[XB_XSUB(b.x)], 1u);
        const unsigned gen = old / nloc;
        if (old + 1u == (gen + 1u) * nloc) {
            __builtin_amdgcn_fence(__ATOMIC_RELEASE, "agent");
            asm volatile("s_waitcnt vmcnt(0)" ::: "memory");
            const unsigned og = xb_add(&bar[XB_TOP], 1u);
            const unsigned tg = og / nx;
            if (og + 1u == (tg + 1u) * nx) xb_add(&bar[XB_TOPGEN], 1u);
            else XB_SPIN(xb_ld(&bar[XB_TOPGEN]) == tg, bar);
            __builtin_amdgcn_fence(__ATOMIC_ACQUIRE, "agent");
            xb_add(&bar[XB_XGEN(b.x)], 1u);
            asm volatile("s_waitcnt vmcnt(0)" ::: "memory");
        } else {
            XB_SPIN(xb_ld(&bar[XB_XGEN(b.x)]) == gen, bar);
            __builtin_amdgcn_fence(__ATOMIC_ACQUIRE, "agent");
            asm volatile("s_waitcnt vmcnt(0)" ::: "memory");
        }
    }
    __syncthreads();
}

struct Args { const float* in[34]; unsigned char* ws; int ph_lo, ph_hi; };
struct Frame {
    LAS unsigned char* lds;
    unsigned* ctl;
    unsigned char* ws;
    int tid, lane, wave, G, bid;
    const struct Args* a; int z;
};
__device__ __forceinline__ const float* inp(const Frame& F, int i) { return F.a->in[i + F.z]; }
__device__ __forceinline__ float* outp(const Frame& F) { return (float*)F.a->in[33 + F.z]; }
__device__ __forceinline__ unsigned char* wsp(const Frame& F) { return F.a->ws + F.z; }
enum { I_X = 0, I_C, I_CTX, I_CCTX, I_WADA, I_BADA, I_N1G, I_N2G, I_WIN, I_QG, I_KG, I_SINK, I_HCW, I_HCB, I_FW1, I_FB1, I_FF1, I_FW2, I_FB2, I_FF2, I_FW3, I_HBIAS,
       I_WPA, I_WPH, I_WPF, I_WOUT, I_FG, I_FU, I_FDN, I_ROUTER, I_MG, I_MU, I_MDN };

namespace pg8 {
struct EpiStore {
    static constexpr bool PERM = true, AFTER_DRAIN = false;
    bf16_t* O; int ldc;
    __device__ __forceinline__ void operator()(const f32x4 (&acc)[2][2][4][2], const Unit& u, int wr, int wc, int fr, int fq) const {
        const int row0 = u.pm * BM + wr * 64 + fr, col0 = u.pn * BM + wc * 32 + 8 * fq;
#pragma unroll
        for (int ai = 0; ai < 2; ++ai)
#pragma unroll
            for (int m = 0; m < 4; ++m) { bf16_t* rowp = O + (size_t)(row0 + ai * HALF + m * 16) * ldc + col0;
#pragma unroll
                for (int bj = 0; bj < 2; ++bj) { const f32x4 v0 = acc[ai][bj][m][0], v1 = acc[ai][bj][m][1];
                    u32x4 w; w.x = cvt_pk_bf16(v0[0], v0[1]); w.y = cvt_pk_bf16(v0[2], v0[3]); w.z = cvt_pk_bf16(v1[0], v1[1]); w.w = cvt_pk_bf16(v1[2], v1[3]);
                    *(u32x4*)(rowp + bj * HALF) = w; } }
    }
};
struct EpiSwiglu {
    static constexpr bool PERM = true, AFTER_DRAIN = false;
    bf16_t* O; int ldc;
    __device__ __forceinline__ void operator()(const f32x4 (&acc)[2][2][4][2], const Unit& u, int wr, int wc, int fr, int fq) const {
        const int row0 = u.pm * BM + wr * 64 + fr, col0 = u.pn * HALF + wc * 32 + 8 * fq;
#pragma unroll
        for (int ai = 0; ai < 2; ++ai)
#pragma unroll
            for (int m = 0; m < 4; ++m) { bf16_t* rowp = O + (size_t)(row0 + ai * HALF + m * 16) * ldc + col0;
                float h[8];
#pragma unroll
                for (int n = 0; n < 2; ++n)
#pragma unroll
                    for (int e = 0; e < 4; ++e) { const float g = acc[ai][0][m][n][e], uu = acc[ai][1][m][n][e]; h[n * 4 + e] = g * __builtin_amdgcn_rcpf(1.0f + __expf(-g)) * uu; }
                u32x4 w; w.x = cvt_pk_bf16(h[0], h[1]); w.y = cvt_pk_bf16(h[2], h[3]); w.z = cvt_pk_bf16(h[4], h[5]); w.w = cvt_pk_bf16(h[6], h[7]);
                *(u32x4*)rowp = w; }
    }
};
struct EpiMerge {
    static constexpr bool PERM = false, AFTER_DRAIN = false;
    const bf16_t* PR; float* MACC; bf16_t* Mo; int mode;
    __device__ __forceinline__ void operator()(const f32x4 (&acc)[2][2][4][2], const Unit& u, int wr, int wc, int fr, int fq) const {
        const int col0 = u.pn * BM + wc * 32 + 4 * fq;
#pragma unroll
        for (int ai = 0; ai < 2; ++ai)
#pragma unroll
            for (int m = 0; m < 4; ++m) { const int r = u.pm * BM + ai * HALF + wr * 64 + m * 16 + fr;
#pragma unroll
                for (int bj = 0; bj < 2; ++bj)
#pragma unroll
                    for (int n = 0; n < 2; ++n) { const int c = col0 + bj * HALF + n * 16;
                        typedef unsigned u32x2v __attribute__((ext_vector_type(2)));
                        const u32x2v gw = *(const u32x2v*)(PR + (size_t)r * 4864 + 1792 + mode * 1024 + c);
                        f32x4 g; g[0] = __builtin_bit_cast(float, gw.x << 16); g[1] = __builtin_bit_cast(float, gw.x & 0xffff0000u); g[2] = __builtin_bit_cast(float, gw.y << 16); g[3] = __builtin_bit_cast(float, gw.y & 0xffff0000u);
                        f32x4 v;
#pragma unroll
                        for (int e = 0; e < 4; ++e) v[e] = __builtin_amdgcn_rcpf(1.0f + __expf(-g[e])) * acc[ai][bj][m][n][e];
                        float* mp = MACC + (size_t)r * 1024 + c;
                        if (mode == 0) { *(f32x4*)mp = v; }
                        else if (mode == 1) { *(f32x4*)mp = *(const f32x4*)mp + v; }
                        else { const f32x4 t = *(const f32x4*)mp + v; u32x2v w; w.x = cvt_pk_bf16(t[0], t[1]); w.y = cvt_pk_bf16(t[2], t[3]); *(u32x2v*)(Mo + (size_t)r * 1024 + c) = w; }
                    } }
    }
};
struct EpiResid {
    static constexpr bool PERM = false, AFTER_DRAIN = false;
    const float* xin_lat; const float* xin_ctx; float* xout_lat; float* xout_ctx; const float* gate  ; const float* rowscale  ;
    __device__ __forceinline__ void operator()(const f32x4 (&acc)[2][2][4][2], const Unit& u, int wr, int wc, int fr, int fq) const {
        const int col0 = u.pn * BM + wc * 32 + 4 * fq;
        const bool isctx = u.pm >= 64;
        const int cond = isctx ? 2 : (u.pm >> 5);
        const float* xi = isctx ? xin_ctx - (size_t)16384 * 1024 : xin_lat;
        float* xo = isctx ? xout_ctx - (size_t)16384 * 1024 : xout_lat;
        const float* gp = gate + cond * 6144;
        f32x4 gv[2][2];
#pragma unroll
        for (int bj = 0; bj < 2; ++bj)
#pragma unroll
            for (int n = 0; n < 2; ++n) gv[bj][n] = *(const f32x4*)(gp + col0 + bj * HALF + n * 16);
#pragma unroll
        for (int ai = 0; ai < 2; ++ai)
#pragma unroll
            for (int m = 0; m < 4; ++m) { const int r = u.pm * BM + ai * HALF + wr * 64 + m * 16 + fr;
                const float rs = rowscale ? rowscale[(size_t)r * 8] : 1.0f;
#pragma unroll
                for (int bj = 0; bj < 2; ++bj)
#pragma unroll
                    for (int n = 0; n < 2; ++n) { const size_t off = (size_t)r * 1024 + col0 + bj * HALF + n * 16;
                        const f32x4 xv = *(const f32x4*)(xi + off);
                        *(f32x4*)(xo + off) = xv + gv[bj][n] * rs * acc[ai][bj][m][n]; } }
    }
};
}

__device__ __forceinline__ void transpose_item(const float* W, int K, int N, bf16* WT, int map, LAS float* scr, int item, int lane) {
    const int nblk = N / 32, kb = item / nblk, nb = item % nblk, k0 = 64 * kb, n0 = 32 * nb;
#pragma unroll 8
    for (int i = 0; i < 32; ++i) { const int kk = 2 * i + (lane >> 5); scr[kk * 33 + (lane & 31)] = W[(size_t)(k0 + kk) * N + n0 + (lane & 31)]; }
    LDS_WAIT(); asm volatile("" ::: "memory");
    const int c = lane & 7;
#pragma unroll
    for (int j = 0; j < 4; ++j) { const int n = (lane >> 3) + 8 * j; const LAS float* s = scr + (8 * c) * 33 + n;
        v4u o; o.x = pk2(s[0 * 33], s[1 * 33]); o.y = pk2(s[2 * 33], s[3 * 33]); o.z = pk2(s[4 * 33], s[5 * 33]); o.w = pk2(s[6 * 33], s[7 * 33]);
        const int nn = n0 + n; const int drow = (map == 0) ? nn : ((nn >> 7) * 256 + (nn & 127) + (map == 2 ? 128 : 0));
        *(v4u*)(WT + (size_t)drow * K + k0 + 8 * c) = o; }
    LDS_WAIT(); asm volatile("" ::: "memory");
}

#define TR_GROUP(SRC, DST, CNT, KK, NN, MAP, DSTRIDE) { constexpr int per = ((KK) / 64) * ((NN) / 32); constexpr int tot = (CNT) * per; \
    if (r < tot) { const int mi = r / per, it2 = r % per; transpose_item((SRC) + (size_t)mi * (KK) * (NN), (KK), (NN), (DST) + (size_t)mi * (DSTRIDE), (MAP), scr, it2, F.lane); continue; } r -= tot; }

__device__ __forceinline__ void phase_prologue(Frame& F) {
    LAS float* scr = (LAS float*)(F.lds + F.wave * 16384);
    const int gw = F.bid * NWAVES + F.wave, NGW = F.G * NWAVES;
    constexpr int TOT_ITEMS = 4 * (16 * 152 + 8 * 32 + 4 * 32 + 4 * 32 + 16 * 32) + 2 * (16 * 88 * 2 + 44 * 32) + 16 * (16 * 88 * 2 + 44 * 32);
    for (int it = gw; it < TOT_ITEMS; it += NGW) {
        int r = it;
        TR_GROUP(inp(F, I_WIN), ((bf16*)(wsp(F) + WS_WIN)), 4, 1024, 4864, 0, (size_t)4864 * 1024)
        TR_GROUP(inp(F, I_WPA), ((bf16*)(wsp(F) + WS_WPA)), 4, 512, 1024, 0, (size_t)1024 * 512)
        TR_GROUP(inp(F, I_WPH), ((bf16*)(wsp(F) + WS_WPH)), 4, 256, 1024, 0, (size_t)1024 * 256)
        TR_GROUP(inp(F, I_WPF), ((bf16*)(wsp(F) + WS_WPF)), 4, 256, 1024, 0, (size_t)1024 * 256)
        TR_GROUP(inp(F, I_WOUT), ((bf16*)(wsp(F) + WS_WO)), 4, 1024, 1024, 0, (size_t)1024 * 1024)
        TR_GROUP(inp(F, I_FG), ((bf16*)(wsp(F) + WS_FGU)), 2, 1024, 2816, 1, (size_t)5632 * 1024)
        TR_GROUP(inp(F, I_FU), ((bf16*)(wsp(F) + WS_FGU)), 2, 1024, 2816, 2, (size_t)5632 * 1024)
        TR_GROUP(inp(F, I_FDN), ((bf16*)(wsp(F) + WS_FD)), 2, 2816, 1024, 0, (size_t)1024 * 2816)
        TR_GROUP(inp(F, I_MG), ((bf16*)(wsp(F) + WS_MGU)), 16, 1024, 2816, 1, (size_t)5632 * 1024)
        TR_GROUP(inp(F, I_MU), ((bf16*)(wsp(F) + WS_MGU)), 16, 1024, 2816, 2, (size_t)5632 * 1024)
        TR_GROUP(inp(F, I_MDN), ((bf16*)(wsp(F) + WS_MD)), 16, 2816, 1024, 0, (size_t)1024 * 2816)
    }
    for (int it = gw; it < 4 * 96; it += NGW) {
        const int l = it / 96, cb = it % 96;
        const float* W = inp(F, I_WADA) + (size_t)l * 1024 * 6144 + cb * 64 + F.lane;
        float a0 = 0.f, a1 = 0.f, a2 = 0.f;
#pragma unroll 8
        for (int k = 0; k < 1024; ++k) {
            const float c0 = inp(F, I_C)[k], c1 = inp(F, I_C)[1024 + k], c2 = inp(F, I_CCTX)[k];
            const float s0 = c0 * sigmoidf_(c0), s1 = c1 * sigmoidf_(c1), s2 = c2 * sigmoidf_(c2);
            const float w = W[(size_t)k * 6144];
            a0 += w * s0; a1 += w * s1; a2 += w * s2;
        }
        const float bb = inp(F, I_BADA)[l * 6144 + cb * 64 + F.lane];
        float* mo = ((float*)(wsp(F) + WS_CTL) + CW_MOD) + (size_t)l * 3 * 6144 + cb * 64 + F.lane;
        mo[0] = a0 + bb; mo[6144] = a1 + bb; mo[2 * 6144] = a2 + bb;
    }
}

template <bool ROUTER>
__device__ __forceinline__ void phase_norm(Frame& F, int l, const float* xlat, const float* xctx, const float* g, int moff, const float* wr) {
    const int gw = F.bid * NWAVES + F.wave, NGW = F.G * NWAVES;
    const float* mod = ((float*)(wsp(F) + WS_CTL) + CW_MOD) + (size_t)l * 3 * 6144 + moff;
    for (int r = gw; r < MT; r += NGW) {
        const bool isctx = r >= ML; const int cond = isctx ? 2 : (r >> 13);
        const float* xr = isctx ? xctx + (size_t)(r - ML) * 1024 : xlat + (size_t)r * 1024;
        f32x4 v[4]; float s = 0.f;
#pragma unroll
        for (int j = 0; j < 4; ++j) { v[j] = *(const f32x4*)(xr + 256 * j + 4 * F.lane); s += (v[j][0] * v[j][0] + v[j][1] * v[j][1]) + (v[j][2] * v[j][2] + v[j][3] * v[j][3]); }
        const float rstd = 1.0f / sqrtf(wave_sum(s, F.lane) * (1.0f / 1024.0f) + EPS);
        const float* sh = mod + cond * 6144; const float* sc = sh + 1024;
        float lg[8];
        if (ROUTER) {
#pragma unroll
            for (int e = 0; e < 8; ++e) lg[e] = 0.f;
        }
#pragma unroll
        for (int j = 0; j < 4; ++j) { const int c = 256 * j + 4 * F.lane;
            const f32x4 gg = *(const f32x4*)(g + c), s1 = *(const f32x4*)(sc + c), s0 = *(const f32x4*)(sh + c);
            f32x4 y;
#pragma unroll
            for (int e = 0; e < 4; ++e) y[e] = (v[j][e] * rstd * gg[e]) * (1.0f + s1[e]) + s0[e];
            v2u o; o.x = pk2(y[0], y[1]); o.y = pk2(y[2], y[3]);
            *(v2u*)(((bf16*)(wsp(F) + WS_H)) + (size_t)r * 1024 + c) = o;
            if (ROUTER) {
#pragma unroll
                for (int e = 0; e < 4; ++e) { const f32x4 w0 = *(const f32x4*)(wr + (size_t)(c + e) * 8), w1 = *(const f32x4*)(wr + (size_t)(c + e) * 8 + 4);
                    lg[0] += y[e] * w0[0]; lg[1] += y[e] * w0[1]; lg[2] += y[e] * w0[2]; lg[3] += y[e] * w0[3];
                    lg[4] += y[e] * w1[0]; lg[5] += y[e] * w1[1]; lg[6] += y[e] * w1[2]; lg[7] += y[e] * w1[3]; }
            }
        }
        if (ROUTER) {
#pragma unroll
            for (int e = 0; e < 8; ++e) lg[e] = wave_sum(lg[e], F.lane);
            int i0 = 0; float v0 = lg[0];
#pragma unroll
            for (int e = 1; e < 8; ++e) if (lg[e] > v0) { v0 = lg[e]; i0 = e; }
            int i1 = -1; float v1 = -INFINITY;
#pragma unroll
            for (int e = 0; e < 8; ++e) if (e != i0 && lg[e] > v1) { v1 = lg[e]; i1 = e; }
            const float w0 = 1.0f / (1.0f + __expf(v1 - v0)), w1 = 1.0f - w0;
            if (F.lane < 8) ((float*)(wsp(F) + WS_COMB))[(size_t)r * 8 + F.lane] = (F.lane == i0) ? w0 : ((F.lane == i1) ? w1 : 0.0f);
        }
    }
}

__device__ __forceinline__ void filter_tile(Frame& F, int l, int L, int p0, float* dst  ) {
    LAS float* emb = (LAS float*)F.lds;
    LAS float* h1 = emb + 64 * 33;
    LAS float* h2 = h1 + 64 * 65;
    const float* w1 = inp(F, I_FW1) + l * 33 * 64; const float* b1 = inp(F, I_FB1) + l * 64; const float* f1 = inp(F, I_FF1) + l * 64;
    const float* w2 = inp(F, I_FW2) + l * 64 * 64; const float* b2 = inp(F, I_FB2) + l * 64; const float* f2 = inp(F, I_FF2) + l * 64;
    const float* w3 = inp(F, I_FW3) + (size_t)l * 64 * 1024;
    for (int idx = F.tid; idx < 64 * 33; idx += NTHREADS) {
        const int pos = idx / 33, f = idx % 33, i = p0 + pos;
        float val;
        if (f == 0) val = (float)i / (float)(L - 1);
        else { const int j = (f - 1) & 15; const float fb = 1e-4f + (float)j * ((15.0f - 1e-4f) / 15.0f); const float rev = fb * (float)i / (float)L;
               val = (f <= 16) ? cos_rev(rev) : -sin_rev(rev); }
        emb[pos * 33 + f] = val;
    }
    __syncthreads();
    for (int idx = F.tid; idx < 4096; idx += NTHREADS) {
        const int pos = idx >> 6, u = idx & 63; float a = b1[u];
        for (int f = 0; f < 33; ++f) a += emb[pos * 33 + f] * w1[f * 64 + u];
        h1[pos * 65 + u] = sin_rev(f1[u] * a * INV_2PI);
    }
    __syncthreads();
    for (int idx = F.tid; idx < 4096; idx += NTHREADS) {
        const int pos = idx >> 6, u = idx & 63; float a = b2[u];
        for (int f = 0; f < 64; ++f) a += h1[pos * 65 + f] * w2[f * 64 + u];
        h2[pos * 65 + u] = sin_rev(f2[u] * a * INV_2PI);
    }
    __syncthreads();
    const int pos = F.lane, i = p0 + pos; const float t = (float)i / (float)(L - 1);
    for (int col = F.wave; col < 1024; col += NWAVES) {
        float a = 0.f;
        for (int f = 0; f < 64; ++f) a += h2[pos * 65 + f] * w3[f * 1024 + col];
        const int ch = col & 255; const float delta = 3.0701134573253946f + 12.280453829301578f * ((float)ch / 255.0f);
        dst[(size_t)col * L + i] = a * __expf(-t * delta);
    }
    __syncthreads();
}

__device__ __forceinline__ void phase_qkprep(Frame& F, int l) {
    const int gw = F.bid * NWAVES + F.wave, NGW = F.G * NWAVES;
    const int lane = F.lane; const int a = lane >> 5, half = (lane >> 4) & 1, f = lane & 15;
    const float inv = exp2f(-(float)f * (13.287712379549449f / 16.0f)) * INV_2PI;
    const float gq = inp(F, I_QG)[l * 64 + lane], gk = inp(F, I_KG)[l * 64 + lane];
    for (int r = gw; r < MT; r += NGW) {
        const bool isctx = r >= ML; const int t = r & 8191; const int pos = a == 0 ? (t >> 6) : (t & 63);
        float cs = 1.f, sn = 0.f;
        if (!isctx) { const float rev = (float)pos * inv; cs = cos_rev(rev); sn = sin_rev(rev); }
        const bf16* pr = ((bf16*)(wsp(F) + WS_PR)) + (size_t)r * INW;
        bf16* qk = ((bf16*)(wsp(F) + WS_QK)) + (size_t)r * 640;
#pragma unroll
        for (int h = 0; h < 10; ++h) {
            const float v = bf2f(pr[h * 64 + lane]);
            const float ss = wave_sum(v * v, lane);
            const float y = v * (1.0f / sqrtf(ss * (1.0f / 64.0f) + EPS)) * (h < 8 ? gq : gk);
            const float p = shx(y, lane, 16);
            const float o = half == 0 ? y * cs - p * sn : y * cs + p * sn;
            qk[h * 64 + lane] = (bf16)f2bf(o);
        }
    }
}

__device__ __forceinline__ float block_sum(Frame& F, float v, LAS float* red) {
    v = wave_sum(v, F.lane);
    __syncthreads();
    if (F.lane == 0) red[F.wave] = v;
    __syncthreads();
    float t = 0.f;
#pragma unroll
    for (int w = 0; w < NWAVES; ++w) t += red[w];
    return t;
}

template <int L>
__device__ __forceinline__ float hy_uc(const bf16* PR, int rowbase, int b, int t, int ch, const float* cw, const float* cb) {
    float a = cb[ch];
#pragma unroll
    for (int j = 0; j < 3; ++j) { const int tt = t + j - 1; if (tt >= 0 && tt < L) a += bf2f(PR[(size_t)(rowbase + b * L + tt) * INW + V_END + ch]) * cw[j * 768 + ch]; }
    return a;
}

template <int L>
__device__ __forceinline__ void hyena_item_naive(Frame& F, int l, int c, int rowbase, const float* taps) {
    constexpr int NT = (L + NTHREADS - 1) / NTHREADS;
    LAS float* kt = (LAS float*)F.lds;
    LAS f32x2* z = (LAS f32x2*)(F.lds + 2 * L * 4);
    LAS float* red = (LAS float*)(F.lds + 2 * L * 4 + L * 8);
    const float* cw = inp(F, I_HCW) + l * 3 * 768; const float* cb = inp(F, I_HCB) + l * 768; const float* hb = inp(F, I_HBIAS) + l * 512;
    for (int t = F.tid; t < L; t += NTHREADS) { f32x2 v; v.x = hy_uc<L>(((bf16*)(wsp(F) + WS_PR)), rowbase, 0, t, 512 + c, cw, cb); v.y = hy_uc<L>(((bf16*)(wsp(F) + WS_PR)), rowbase, 1, t, 512 + c, cw, cb); z[t] = v; }
    for (int o = 0; o < 2; ++o) {
        const float* fwd = taps + (size_t)(o * 256 + c) * L; const float* bwd = taps + (size_t)(512 + o * 256 + c) * L;
        float part = 0.f;
        for (int d = F.tid; d < L; d += NTHREADS) { const float kf = fwd[d]; kt[L + d] = kf; part += fabsf(kf);
            if (d >= 1) { const float kb = bwd[d]; kt[L - d] = kb; part += fabsf(kb); } else kt[0] = 0.f; }
        const float tot = block_sum(F, part, red);
        const float inv = 1.0f / tot;
        __syncthreads();
        float* tmp = (float*)(wsp(F) + WS_MACC) + (size_t)c * 2 * SEQ;
#pragma unroll 1
        for (int t = F.tid; t < L; t += NTHREADS) {
            float a0 = 0.f, a1 = 0.f;
#pragma unroll 4
            for (int s = 0; s < L; ++s) { const f32x2 zz = z[s]; const float kv = kt[L + t - s]; a0 += kv * zz.x; a1 += kv * zz.y; }
            tmp[t] = a0; tmp[SEQ + t] = a1;
        }
        __syncthreads();
        const float bo = hb[o * 256 + c];
#pragma unroll 1
        for (int t = F.tid; t < L; t += NTHREADS) {
            const float g0 = hy_uc<L>(((bf16*)(wsp(F) + WS_PR)), rowbase, 0, t, o * 256 + c, cw, cb), g1 = hy_uc<L>(((bf16*)(wsp(F) + WS_PR)), rowbase, 1, t, o * 256 + c, cw, cb);
            const f32x2 zo = z[t]; f32x2 zn; zn.x = g0 * (tmp[t] * inv + bo * zo.x); zn.y = g1 * (tmp[SEQ + t] * inv + bo * zo.y); z[t] = zn;
        }
        __syncthreads();
    }
    for (int t = F.tid; t < L; t += NTHREADS) { const f32x2 v = z[t];
        ((bf16*)(wsp(F) + WS_HYT))[(size_t)c * MT + rowbase + t] = (bf16)f2bf(v.x); ((bf16*)(wsp(F) + WS_HYT))[(size_t)c * MT + rowbase + L + t] = (bf16)f2bf(v.y); }
    __syncthreads();
}

template <int L>
__device__ __forceinline__ void fnet_item_naive(Frame& F, int b, int g, int m, int rowbase) {
    LAS f32x2* AB = (LAS f32x2*)F.lds;
    LAS f32x2* tab = (LAS f32x2*)(F.lds + L * 8);
    LAS f32x2* cs64 = (LAS f32x2*)(F.lds + 2 * L * 8);
    for (int i = F.tid; i < L; i += NTHREADS) { f32x2 v; const float rev = (float)i / (float)L; v.x = cos_rev(rev); v.y = sin_rev(rev); tab[i] = v; }
    if (F.tid < 64) { f32x2 v; const float rev = (float)F.tid / 64.0f; v.x = cos_rev(rev); v.y = sin_rev(rev); cs64[F.tid] = v; }
    __syncthreads();
    for (int n = F.tid; n < L; n += NTHREADS) {
        const bf16* up = ((bf16*)(wsp(F) + WS_PR)) + (size_t)(rowbase + b * L + n) * INW + HY_END + g * 64;
        float A = 0.f, Bv = 0.f;
        for (int c = 0; c < 64; ++c) { const float u = bf2f(up[c]); const f32x2 cs = cs64[(m * c) & 63]; A += u * cs.x; Bv += u * cs.y; }
        f32x2 v; v.x = A; v.y = Bv; AB[n] = v;
    }
    __syncthreads();
    const float scale = 1.0f / sqrtf((float)L * 64.0f);
    for (int k = F.tid; k < L; k += NTHREADS) {
        float acc = 0.f; int idx = 0;
        for (int n = 0; n < L; ++n) { const f32x2 ab = AB[n]; const f32x2 cs = tab[idx]; acc += ab.x * cs.x - ab.y * cs.y; idx = (idx + k) & (L - 1); }
        ((bf16*)(wsp(F) + WS_FNT))[(size_t)(g * 64 + m) * MT + rowbase + b * L + k] = (bf16)f2bf(acc * scale);
    }
    __syncthreads();
}

__device__ __forceinline__ void attn_item_naive(Frame& F, int l, int r, int kvh, LAS float* wq, LAS float* wp) {
    const int lane = F.lane;
    const bool isctx = r >= ML; const int b = isctx ? ((r - ML) >> 8) : (r >> 13); const int t = r & 8191;
    const int lo = (t - 128) < 0 ? 0 : (t - 128), hi = (t + 128) > (SEQ - 1) ? (SEQ - 1) : (t + 128);
    const int nloc = isctx ? 0 : (hi - lo + 1), nk = nloc + CTXL;
#pragma unroll
    for (int h = 0; h < 4; ++h) wq[h * 64 + lane] = bf2f(((bf16*)(wsp(F) + WS_QK))[(size_t)r * 640 + (4 * kvh + h) * 64 + lane]) * 0.125f;
    LDS_WAIT(); asm volatile("" ::: "memory");
    for (int j = lane; j < nk; j += 64) {
        const int krow = j < nloc ? (b * SEQ + lo + j) : (ML + b * CTXL + (j - nloc));
        const bf16* kp = ((bf16*)(wsp(F) + WS_QK)) + (size_t)krow * 640 + 512 + kvh * 64;
        float s0 = 0.f, s1 = 0.f, s2 = 0.f, s3 = 0.f;
#pragma unroll
        for (int d8 = 0; d8 < 8; ++d8) { const v4u kw = *(const v4u*)(kp + d8 * 8);
            float kf[8]; kf[0] = bflo(kw.x); kf[1] = bfhi(kw.x); kf[2] = bflo(kw.y); kf[3] = bfhi(kw.y); kf[4] = bflo(kw.z); kf[5] = bfhi(kw.z); kf[6] = bflo(kw.w); kf[7] = bfhi(kw.w);
#pragma unroll
            for (int e = 0; e < 8; ++e) { const int d = d8 * 8 + e; s0 += kf[e] * wq[d]; s1 += kf[e] * wq[64 + d]; s2 += kf[e] * wq[128 + d]; s3 += kf[e] * wq[192 + d]; } }
        f32x4 sv; sv[0] = s0; sv[1] = s1; sv[2] = s2; sv[3] = s3;
        *(LAS f32x4*)(wp + j * 4) = sv;
    }
    LDS_WAIT(); asm volatile("" ::: "memory");
    f32x4 mx = {-INFINITY, -INFINITY, -INFINITY, -INFINITY};
    for (int j = lane; j < nk; j += 64) { const f32x4 sv = *(LAS f32x4*)(wp + j * 4);
#pragma unroll
        for (int h = 0; h < 4; ++h) mx[h] = fmaxf(mx[h], sv[h]); }
    f32x4 sink, den;
#pragma unroll
    for (int h = 0; h < 4; ++h) { sink[h] = inp(F, I_SINK)[l * 8 + 4 * kvh + h]; mx[h] = fmaxf(wave_max(mx[h], lane), sink[h]); den[h] = 0.f; }
    for (int j = lane; j < nk; j += 64) { f32x4 sv = *(LAS f32x4*)(wp + j * 4);
#pragma unroll
        for (int h = 0; h < 4; ++h) { sv[h] = __expf(sv[h] - mx[h]); den[h] += sv[h]; }
        *(LAS f32x4*)(wp + j * 4) = sv; }
#pragma unroll
    for (int h = 0; h < 4; ++h) den[h] = wave_sum(den[h], lane) + __expf(sink[h] - mx[h]);
    LDS_WAIT(); asm volatile("" ::: "memory");
    f32x4 o = {0.f, 0.f, 0.f, 0.f};
    for (int j = 0; j < nk; ++j) {
        const int krow = j < nloc ? (b * SEQ + lo + j) : (ML + b * CTXL + (j - nloc));
        const float v = bf2f(((bf16*)(wsp(F) + WS_PR))[(size_t)krow * INW + K_END + kvh * 64 + lane]);
        const f32x4 p = *(LAS f32x4*)(wp + j * 4);
        o += p * v;
    }
#pragma unroll
    for (int h = 0; h < 4; ++h) ((bf16*)(wsp(F) + WS_ATT))[(size_t)r * 512 + (4 * kvh + h) * 64 + lane] = (bf16)f2bf(o[h] / den[h]);
    LDS_WAIT(); asm volatile("" ::: "memory");
}


__device__ __forceinline__ void phase_trans(Frame& F) {
    LAS unsigned* tl = (LAS unsigned*)(F.lds + F.wave * 16640);
    const int gw = F.bid * NWAVES + F.wave, NGW = F.G * NWAVES, lane = F.lane;
    for (int it = gw; it < 2 * 264 * 4; it += NGW) {
        const int which = it / (264 * 4), rem = it % (264 * 4), rt = rem >> 2, ct = rem & 3;
        const bf16* src = which == 0 ? ((const bf16*)(wsp(F) + WS_HYT)) : ((const bf16*)(wsp(F) + WS_FNT));
        bf16* dst = which == 0 ? ((bf16*)(wsp(F) + WS_HYO)) : ((bf16*)(wsp(F) + WS_FNO));
#pragma unroll 8
        for (int ch = 0; ch < 64; ++ch) tl[ch * 65 + lane] = src[(size_t)(ct * 64 + ch) * MT + rt * 64 + lane];
        LDS_WAIT(); asm volatile("" ::: "memory");
#pragma unroll 8
        for (int row = 0; row < 64; ++row) dst[(size_t)(rt * 64 + row) * 256 + ct * 64 + lane] = (bf16)tl[lane * 65 + row];
        LDS_WAIT(); asm volatile("" ::: "memory");
    }
}

__device__ __forceinline__ void phase_mix_naive(Frame& F, int l) {
    { LAS float* wq = (LAS float*)(F.lds + F.wave * 10240); LAS float* wp = wq + 256;
      const int gw = F.bid * NWAVES + F.wave, NGW = F.G * NWAVES;
      for (int it = gw; it < MT * 2; it += NGW) attn_item_naive(F, l, it >> 1, it & 1, wq, wp); }
    __syncthreads();
    for (int c = F.bid; c < 256; c += F.G) hyena_item_naive<SEQ>(F, l, c, 0, ((float*)(wsp(F) + WS_HF)));
    for (int c = F.bid; c < 256; c += F.G) hyena_item_naive<CTXL>(F, l, c, ML, ((float*)(wsp(F) + WS_HFC)));
    for (int it = F.bid; it < 512; it += F.G) fnet_item_naive<SEQ>(F, it >> 8, (it >> 6) & 3, it & 63, 0);
    for (int it = F.bid; it < 512; it += F.G) fnet_item_naive<CTXL>(F, it >> 8, (it >> 6) & 3, it & 63, ML);
}

constexpr int NPL = 24;
constexpr int NPHASES = 1 + DEPTH * NPL;
#ifndef ONE_LAUNCH
#define ONE_LAUNCH 1
#endif

__global__ void __launch_bounds__(NTHREADS, 2) fwd_kernel(Args args) {
    extern __shared__ __attribute__((aligned(16))) unsigned char lds[];
    Frame F;
    F.lds = (LAS unsigned char*)lds;
    F.tid = threadIdx.x; F.lane = F.tid & 63; F.wave = __builtin_amdgcn_readfirstlane(F.tid >> 6);
    F.G = gridDim.x; F.bid = blockIdx.x;
    unsigned char* ws = args.ws; F.ws = ws;
    F.ctl = (unsigned*)(ws + WS_CTL);
    F.a = &args; F.z = 0;
    volatile LAS unsigned* MISC = (volatile LAS unsigned*)(F.lds + MISC_OFF);
    for (int u = F.tid; u < 64; u += NTHREADS) MISC[u] = 0u;
    __syncthreads();
    const int lo = args.ph_lo, hi = args.ph_hi;
    XcdBarrier bar; bar.bar = F.ctl + CW_BAR; bar.x = 0; bar.st = nullptr;
    if (hi - lo > 1) bar = xcd_barrier_post(F.ctl + CW_BAR, MISC + 8);
#define PH_BEGIN(k) if (lo <= (k) && (k) < hi) { { int t_ = threadIdx.x; asm volatile("" : "+v"(t_)); F.tid = t_; F.lane = t_ & 63; F.wave = __builtin_amdgcn_readfirstlane(t_ >> 6); int z_ = 0; asm volatile("" : "+s"(z_)); F.z = z_; }
#define PH_END(k) if ((k) + 1 < hi) xcd_barrier_impl(bar.bar, bar.x, bar.st); }

    PH_BEGIN(0) phase_prologue(F); PH_END(0)

    for (int l = 0; l < DEPTH; ++l) {
        const int pb = 1 + l * NPL;
        const float* xin_lat = (l == 0) ? inp(F, I_X) : outp(F);
        const float* xin_ctx = (l == 0) ? inp(F, I_CTX) : ((float*)(wsp(F) + WS_XC));
        const float* modl = ((float*)(wsp(F) + WS_CTL) + CW_MOD) + (size_t)l * 3 * 6144;
        const bool moe = (l & 1) != 0; const int fi = l >> 1;

        PH_BEGIN(pb + 0)
            phase_norm<false>(F, l, xin_lat, xin_ctx, inp(F, I_N1G) + l * 1024, 0, nullptr);
            for (int it = F.bid; it < 132; it += F.G) { if (it < 128) filter_tile(F, l, SEQ, it * 64, ((float*)(wsp(F) + WS_HF))); else filter_tile(F, l, CTXL, (it - 128) * 64, ((float*)(wsp(F) + WS_HFC))); }
        PH_END(pb + 0)

        PH_BEGIN(pb + 1)
            pg8::Gemm g{((bf16*)(wsp(F) + WS_H)), ((bf16*)(wsp(F) + WS_WIN)) + (size_t)l * INW * 1024, MT, INW, 1024}; pg8::StaticOrder S; S.init(MT, INW, F.G, F.bid);
            pg8::EpiStore E{((bf16*)(wsp(F) + WS_PR)), INW};
            pg8::gemm_phase<pg8::EpiStore, pg8::StaticOrder, true, true>(F.lds, g, S, E);
        PH_END(pb + 1)

        PH_BEGIN(pb + 2) phase_qkprep(F, l); PH_END(pb + 2)

        PH_BEGIN(pb + 3) phase_mix_naive(F, l); PH_END(pb + 3)

        PH_BEGIN(pb + 4) phase_trans(F); PH_END(pb + 4)

        PH_BEGIN(pb + 5)
            for (int br = 0; br < 3; ++br) {
                const bf16* A = br == 0 ? ((bf16*)(wsp(F) + WS_ATT)) : (br == 1 ? ((bf16*)(wsp(F) + WS_HYO)) : ((bf16*)(wsp(F) + WS_FNO)));
                const bf16* Bt = br == 0 ? ((bf16*)(wsp(F) + WS_WPA)) + (size_t)l * 1024 * 512 : (br == 1 ? ((bf16*)(wsp(F) + WS_WPH)) + (size_t)l * 1024 * 256 : ((bf16*)(wsp(F) + WS_WPF)) + (size_t)l * 1024 * 256);
                const int K = br == 0 ? 512 : 256;
                pg8::Gemm g{A, Bt, MT, 1024, K}; pg8::StaticOrder S; S.init(MT, 1024, F.G, F.bid);
                pg8::EpiMerge E{((bf16*)(wsp(F) + WS_PR)), ((float*)(wsp(F) + WS_MACC)), ((bf16*)(wsp(F) + WS_M)), br};
                pg8::gemm_phase<pg8::EpiMerge, pg8::StaticOrder, true, true>(F.lds, g, S, E);
                __syncthreads();
            }
        PH_END(pb + 5)

        PH_BEGIN(pb + 6)
            pg8::Gemm g{((bf16*)(wsp(F) + WS_M)), ((bf16*)(wsp(F) + WS_WO)) + (size_t)l * 1024 * 1024, MT, 1024, 1024}; pg8::StaticOrder S; S.init(MT, 1024, F.G, F.bid);
            pg8::EpiResid E{xin_lat, xin_ctx, outp(F), ((float*)(wsp(F) + WS_XC)), modl + 2048, nullptr};
            pg8::gemm_phase<pg8::EpiResid, pg8::StaticOrder, true, true>(F.lds, g, S, E);
        PH_END(pb + 6)

        PH_BEGIN(pb + 7)
            if (moe) phase_norm<true>(F, l, outp(F), ((float*)(wsp(F) + WS_XC)), inp(F, I_N2G) + l * 1024, 3072, inp(F, I_ROUTER) + (size_t)fi * 1024 * 8);
            else phase_norm<false>(F, l, outp(F), ((float*)(wsp(F) + WS_XC)), inp(F, I_N2G) + l * 1024, 3072, nullptr);
        PH_END(pb + 7)

        const int ne = moe ? NEXP : 1;
        for (int e = 0; e < ne; ++e) {
            const bf16* Wgu = moe ? ((bf16*)(wsp(F) + WS_MGU)) + (size_t)(fi * 8 + e) * 5632 * 1024 : ((bf16*)(wsp(F) + WS_FGU)) + (size_t)fi * 5632 * 1024;
            const bf16* Wd = moe ? ((bf16*)(wsp(F) + WS_MD)) + (size_t)(fi * 8 + e) * 1024 * 2816 : ((bf16*)(wsp(F) + WS_FD)) + (size_t)fi * 1024 * 2816;
            PH_BEGIN(pb + 8 + 2 * e)
                pg8::Gemm g{((bf16*)(wsp(F) + WS_H)), Wgu, MT, 5632, 1024}; pg8::StaticOrder S; S.init(MT, 5632, F.G, F.bid);
                pg8::EpiSwiglu E{((bf16*)(wsp(F) + WS_HID)), DFF};
                pg8::gemm_phase<pg8::EpiSwiglu, pg8::StaticOrder, true, true>(F.lds, g, S, E);
            PH_END(pb + 8 + 2 * e)
            PH_BEGIN(pb + 9 + 2 * e)
                pg8::Gemm g{((bf16*)(wsp(F) + WS_HID)), Wd, MT, 1024, DFF}; pg8::StaticOrder S; S.init(MT, 1024, F.G, F.bid);
                pg8::EpiResid E{outp(F), ((float*)(wsp(F) + WS_XC)), outp(F), ((float*)(wsp(F) + WS_XC)), modl + 5120, moe ? ((float*)(wsp(F) + WS_COMB)) + e : nullptr};
                pg8::gemm_phase<pg8::EpiResid, pg8::StaticOrder, true, true>(F.lds, g, S, E);
            PH_END(pb + 9 + 2 * e)
        }
    }
#undef PH_BEGIN
#undef PH_END
}

extern "C" void kernel_launch(void* const* d_in, const int* in_sizes, int n_in, void* d_out, int out_size, void* d_ws, size_t ws_size, hipStream_t stream) {
    static int grid = 0;
    if (grid == 0) {
        if (n_in != 33 || out_size != ML * DM || ws_size < WS_END) { fprintf(stderr, "kernel_launch: unexpected shapes (n_in %d out %d ws %zu need %zu)\n", n_in, out_size, ws_size, (size_t)WS_END); grid = -1; return; }
        int dev = 0, cus = 0, per_cu = 0;
        if (hipGetDevice(&dev) != hipSuccess || hipDeviceGetAttribute(&cus, hipDeviceAttributeMultiprocessorCount, dev) != hipSuccess) { grid = -1; return; }
        if (hipFuncSetAttribute((const void*)fwd_kernel, hipFuncAttributeMaxDynamicSharedMemorySize, LDS_BYTES) != hipSuccess) { fprintf(stderr, "kernel_launch: hipFuncSetAttribute failed\n"); grid = -1; return; }
        if (hipOccupancyMaxActiveBlocksPerMultiprocessor(&per_cu, (const void*)fwd_kernel, NTHREADS, LDS_BYTES) != hipSuccess || per_cu < 1) { fprintf(stderr, "kernel_launch: occupancy query says %d\n", per_cu); }
        (void)hipGetLastError();
        grid = cus;
    }
    if (grid < 0) return;
    if (hipMemsetAsync((char*)d_ws + WS_CTL, 0, CTL_ZERO_BYTES, stream) != hipSuccess) return;
    Args a{};
    for (int i = 0; i < 33; ++i) a.in[i] = (const float*)d_in[i];
    a.in[33] = (const float*)d_out; a.ws = (unsigned char*)d_ws;
#if ONE_LAUNCH
    a.ph_lo = 0; a.ph_hi = NPHASES;
    hipLaunchKernelGGL(fwd_kernel, dim3(grid), dim3(NTHREADS), LDS_BYTES, stream, a);
#else
    for (int k = 0; k < NPHASES; ++k) {
        if (k >= 1) { const int l = (k - 1) / NPL, p = (k - 1) % NPL; if ((l & 1) == 0 && p >= 10) continue; }
        a.ph_lo = k; a.ph_hi = k + 1;
        hipLaunchKernelGGL(fwd_kernel, dim3(grid), dim3(NTHREADS), LDS_BYTES, stream, a);
    }
#endif
}
```

```cpp
#include <hip/hip_runtime.h>
#include <cstdio>
#include <cstdint>
namespace pg8 {
#define PG8_LAS __attribute__((address_space(3)))
typedef unsigned short bf16_t;
typedef short bf16x8 __attribute__((ext_vector_type(8)));
typedef float f32x4 __attribute__((ext_vector_type(4)));
typedef unsigned u32x4 __attribute__((ext_vector_type(4)));
constexpr int BM = 256, BK = 64, HALF = 128, HTB = HALF * BK * 2  , STAGE_BYTES = 8 * HTB, NXCD = 8, WGM = 8;

__host__ __device__ __forceinline__ int lds_byte(int r, int c) { const int st = (r >> 4) * 2 + (c >> 5), rr = r & 15, cc = c & 31, ob = rr * 64 + cc * 2; return st * 1024 + (ob ^ (((ob >> 9) & 1) << 5)); }
__host__ __device__ __forceinline__ void stage_rc(int b, int& R, int& C) { const int st = b / 1024, sb = b % 1024, swz = sb ^ (((sb >> 9) & 1) << 5); R = (st >> 1) * 16 + swz / 64; C = (st & 1) * 32 + (swz % 64) / 2; }
__host__ __device__ __forceinline__ int perm32(int rho) { const int n = rho >> 4, i = rho & 15; return 8 * (i >> 2) + 4 * n + (i & 3); }

struct Unit { int pm, pn; };
struct Gemm { const bf16_t* A; const bf16_t* Bt; int M, N, K; };

struct StaticOrder {
    int nM, nN, nwg, G, c;
    __host__ __device__ void init(int M, int N, int G_, int c_) { nM = M / BM; nN = N / BM; nwg = nM * nN; G = G_; c = c_; }
    __host__ __device__ bool next(int i, Unit& u) const {
        const long L = (long)i * G + c; if (L >= nwg) return false;
        int wgid = (int)L; { const int q = nwg / NXCD, r = nwg % NXCD, xcd = wgid % NXCD, off = wgid / NXCD; wgid = (xcd < r ? xcd * (q + 1) : r * (q + 1) + (xcd - r) * q) + off; }
        const int nig = WGM * nN, gid = wgid / nig, fm = gid * WGM, gsz = (nM - fm) < WGM ? (nM - fm) : WGM;
        u.pm = fm + ((wgid % nig) % gsz); u.pn = (wgid % nig) / gsz; return true;
    }
    __device__ __forceinline__ void a_ready(const Unit&) const {}
    __device__ __forceinline__ void done(const Unit&) const {}
};

__device__ __forceinline__ unsigned cvt_pk_bf16(float lo, float hi) { unsigned r; asm volatile("v_cvt_pk_bf16_f32 %0, %1, %2" : "=v"(r) : "v"(lo), "v"(hi)); return r; }
typedef float f32x2 __attribute__((ext_vector_type(2)));
template <class Epi, class Sched, bool ALIGN_EPI = false, bool SP2 = false>
__device__ __forceinline__ void gemm_phase(PG8_LAS unsigned char* lds, const Gemm g, const Sched& S, const Epi& E) {
    int tid_ = threadIdx.x; asm volatile("" : "+v"(tid_)); const int tid = tid_, wid = __builtin_amdgcn_readfirstlane(tid >> 6), lane = tid & 63, wr = wid >> 2, wc = wid & 3, fr = lane & 15, fq = lane >> 4;
    const int K = g.K, nt = K / BK;
    unsigned voffA[2], voffB[2];
#pragma unroll
    for (int i = 0; i < 2; ++i) { int R, C; stage_rc(tid * 16 + i * 8192, R, C); const int Rb = Epi::PERM ? ((R & ~31) + perm32(R & 31)) : R;
        voffA[i] = (unsigned)(R * K + C) * 2u; voffB[i] = (unsigned)(Rb * K + C) * 2u; }
    const size_t kstep = (size_t)(BK * 2);
    const size_t hstep = (size_t)HALF * K * 2;
    const size_t tstep = 2 * hstep;
    const unsigned ldsw = (unsigned)wid * 1024u;
    const int aoff = lds_byte(wr * 64 + fr, fq * 8), boff = lds_byte(wc * 32 + fr, fq * 8);
#define PG8_SA(b, h) (((b) * 2 + (h)) * HTB)
#define PG8_SB(b, h) ((4 + (b) * 2 + (h)) * HTB)
#define PG8_STAGE(bufoff, gbase, voff) do { _Pragma("unroll") for (int _i = 0; _i < 2; ++_i) \
        __builtin_amdgcn_global_load_lds((const unsigned*)((const char*)(gbase) + (voff)[_i]), (PG8_LAS unsigned*)(lds + (bufoff) + ldsw + _i * 8192), 16, 0, 0); } while (0)
#define PG8_LDA(dst, b, h) do { _Pragma("unroll") for (int m = 0; m < 4; ++m) _Pragma("unroll") for (int k = 0; k < 2; ++k) dst[m][k] = *(const PG8_LAS bf16x8*)(lds + PG8_SA(b, h) + aoff + m * 2048 + k * 1024); } while (0)
#define PG8_LDB(dst, b, h) do { _Pragma("unroll") for (int n = 0; n < 2; ++n) _Pragma("unroll") for (int k = 0; k < 2; ++k) dst[n][k] = *(const PG8_LAS bf16x8*)(lds + PG8_SB(b, h) + boff + n * 2048 + k * 1024); } while (0)
#define PG8_MMA(ai, bj, At, Bt) do { __builtin_amdgcn_s_setprio(1); _Pragma("unroll") for (int m = 0; m < 4; ++m) _Pragma("unroll") for (int n = 0; n < 2; ++n) _Pragma("unroll") for (int k = 0; k < 2; ++k) \
        acc[ai][bj][m][n] = __builtin_amdgcn_mfma_f32_16x16x32_bf16(Bt[n][k], At[m][k], acc[ai][bj][m][n], 0, 0, 0); __builtin_amdgcn_s_setprio(0); } while (0)
#define PG8_WAIT_V(n) asm volatile("s_waitcnt vmcnt(" #n ")" ::: "memory")
#define PG8_WAIT_L(n) asm volatile("s_waitcnt lgkmcnt(" #n ")" ::: "memory")
#define PG8_BAR __builtin_amdgcn_s_barrier()
#define PG8_SCHED __builtin_amdgcn_sched_barrier(0)
    Unit cur, nxt; int ui = 0;
    if (!S.next(0, cur)) return;
    f32x4 acc[2][2][4][2];
#pragma unroll
    for (int a = 0; a < 2; ++a)
#pragma unroll
        for (int b = 0; b < 2; ++b)
#pragma unroll
            for (int m = 0; m < 4; ++m)
#pragma unroll
                for (int n = 0; n < 2; ++n) acc[a][b][m][n] = (f32x4){0.f, 0.f, 0.f, 0.f};
    bf16x8 At[4][2], B0[2][2], B1[2][2];
    const char* cA = (const char*)g.A + (size_t)cur.pm * tstep; const char* cB = (const char*)g.Bt + (size_t)cur.pn * tstep;
    S.a_ready(cur);
    if constexpr (SP2) {
        PG8_STAGE(PG8_SB(0, 0), cB, voffB); PG8_STAGE(PG8_SB(0, 1), cB + hstep, voffB); PG8_STAGE(PG8_SA(0, 0), cA, voffA); PG8_STAGE(PG8_SA(0, 1), cA + hstep, voffA);
        if (wr == 1) PG8_BAR;
        PG8_WAIT_V(2); PG8_BAR;
        PG8_STAGE(PG8_SB(1, 0), cB + kstep, voffB); PG8_STAGE(PG8_SA(1, 0), cA + kstep, voffA); PG8_STAGE(PG8_SB(1, 1), cB + hstep + kstep, voffB);
        PG8_WAIT_V(6); PG8_BAR;
    } else {
        PG8_STAGE(PG8_SB(0, 0), cB, voffB); PG8_STAGE(PG8_SA(0, 0), cA, voffA); PG8_STAGE(PG8_SB(0, 1), cB + hstep, voffB); PG8_STAGE(PG8_SA(0, 1), cA + hstep, voffA);
        if (wr == 1) PG8_BAR;
        PG8_WAIT_V(4); PG8_BAR;
        PG8_STAGE(PG8_SB(1, 0), cB + kstep, voffB); PG8_STAGE(PG8_SA(1, 0), cA + kstep, voffA); PG8_STAGE(PG8_SB(1, 1), cB + hstep + kstep, voffB);
        PG8_WAIT_V(6); PG8_BAR;
    }
    for (;;) {
        const bool has_next = S.next(ui + 1, nxt);
        const char* nA = has_next ? (const char*)g.A + (size_t)nxt.pm * tstep : cA; const char* nB = has_next ? (const char*)g.Bt + (size_t)nxt.pn * tstep : cB;
        for (int t = 0; t < nt; t += 2) {
            const bool last = (t == nt - 2);
            const char* a1 = cA + (size_t)(t + 1) * kstep;
            const char* a2 = last ? nA : cA + (size_t)(t + 2) * kstep; const char* b2 = last ? nB : cB + (size_t)(t + 2) * kstep;
            const char* a3 = a2 + kstep; const char* b3 = b2 + kstep;
            if (last && has_next) S.a_ready(nxt);
            if constexpr (SP2) {
            PG8_LDB(B0, 0, 0); PG8_LDB(B1, 0, 1); PG8_SCHED; PG8_LDA(At, 0, 0); PG8_STAGE(PG8_SA(1, 1), a1 + hstep, voffA);
            PG8_WAIT_V(8); PG8_WAIT_L(0); PG8_BAR; PG8_MMA(0, 0, At, B0); PG8_MMA(0, 1, At, B1); PG8_BAR; PG8_SCHED;
            PG8_LDA(At, 0, 1); PG8_STAGE(PG8_SB(0, 0), b2, voffB); PG8_STAGE(PG8_SB(0, 1), b2 + hstep, voffB); PG8_STAGE(PG8_SA(0, 0), a2, voffA);
            PG8_WAIT_V(8); PG8_WAIT_L(0); PG8_BAR; PG8_MMA(1, 0, At, B0); PG8_MMA(1, 1, At, B1); PG8_BAR; PG8_SCHED;
            PG8_LDB(B0, 1, 0); PG8_LDB(B1, 1, 1); PG8_SCHED; PG8_LDA(At, 1, 0); PG8_STAGE(PG8_SA(0, 1), a2 + hstep, voffA);
            PG8_WAIT_V(8); PG8_WAIT_L(0); PG8_BAR; PG8_MMA(0, 0, At, B0); PG8_MMA(0, 1, At, B1); PG8_BAR; PG8_SCHED;
            PG8_LDA(At, 1, 1); PG8_STAGE(PG8_SB(1, 0), b3, voffB); PG8_STAGE(PG8_SB(1, 1), b3 + hstep, voffB); PG8_STAGE(PG8_SA(1, 0), a3, voffA);
            PG8_WAIT_V(8); PG8_WAIT_L(0); PG8_BAR; PG8_MMA(1, 0, At, B0); PG8_MMA(1, 1, At, B1); PG8_BAR; PG8_SCHED;
            } else {
            PG8_LDB(B0, 0, 0); PG8_SCHED; PG8_LDA(At, 0, 0); PG8_STAGE(PG8_SA(1, 1), a1 + hstep, voffA);
            PG8_WAIT_L(8); PG8_BAR; PG8_WAIT_L(0); PG8_MMA(0, 0, At, B0); PG8_BAR; PG8_SCHED;
            PG8_LDB(B1, 0, 1); PG8_STAGE(PG8_SB(0, 0), b2, voffB);
            PG8_BAR; PG8_WAIT_L(0); PG8_MMA(0, 1, At, B1); PG8_BAR;
            PG8_LDA(At, 0, 1); PG8_STAGE(PG8_SA(0, 0), a2, voffA);
            PG8_BAR; PG8_WAIT_L(0); PG8_MMA(1, 0, At, B0); PG8_BAR; PG8_SCHED;
            PG8_STAGE(PG8_SB(0, 1), b2 + hstep, voffB);
            PG8_WAIT_V(6); PG8_BAR; PG8_MMA(1, 1, At, B1); PG8_BAR;
            PG8_LDB(B0, 1, 0); PG8_SCHED; PG8_LDA(At, 1, 0); PG8_STAGE(PG8_SA(0, 1), a2 + hstep, voffA);
            PG8_WAIT_L(8); PG8_BAR; PG8_WAIT_L(0); PG8_MMA(0, 0, At, B0); PG8_BAR; PG8_SCHED;
            PG8_LDB(B1, 1, 1); PG8_STAGE(PG8_SB(1, 0), b3, voffB);
            PG8_BAR; PG8_WAIT_L(0); PG8_MMA(0, 1, At, B1); PG8_BAR;
            PG8_LDA(At, 1, 1); PG8_STAGE(PG8_SA(1, 0), a3, voffA);
            PG8_BAR; PG8_WAIT_L(0); PG8_MMA(1, 0, At, B0); PG8_BAR; PG8_SCHED;
            PG8_STAGE(PG8_SB(1, 1), b3 + hstep, voffB);
            PG8_WAIT_V(6); PG8_BAR; PG8_MMA(1, 1, At, B1); PG8_BAR;
            }
        }
        if constexpr (ALIGN_EPI) { if (wr == 0) PG8_BAR; }
        if constexpr (!Epi::AFTER_DRAIN) { E(acc, cur, wr, wc, fr, fq); S.done(cur); }
        if (!has_next) break;
#pragma unroll
        for (int a = 0; a < 2; ++a)
#pragma unroll
            for (int b = 0; b < 2; ++b)
#pragma unroll
                for (int m = 0; m < 4; ++m)
#pragma unroll
                    for (int n = 0; n < 2; ++n) acc[a][b][m][n] = (f32x4){0.f, 0.f, 0.f, 0.f};
        cur = nxt; cA = nA; cB = nB; ++ui;
        if constexpr (ALIGN_EPI) { if (wr == 1) PG8_BAR; }
    }
    PG8_WAIT_V(0);
    if constexpr (!ALIGN_EPI) { if (wr == 0) PG8_BAR; }
    PG8_BAR;
    if constexpr (Epi::AFTER_DRAIN) { E.fused(acc, cur, wr, wc, fr, fq, lds, wid, lane); S.done(cur); }
#undef PG8_SA
#undef PG8_SB
#undef PG8_STAGE
#undef PG8_LDA
#undef PG8_LDB
#undef PG8_MMA
#undef PG8_WAIT_V
#undef PG8_WAIT_L
#undef PG8_BAR
#undef PG8_SCHED
}
}

constexpr int NWAVES = 8, NTHREADS = 512;
constexpr int BATCH = 2, SEQ = 8192, DM = 1024, DEPTH = 4, CTXL = 256;
constexpr int ML = BATCH * SEQ;
constexpr int MC = BATCH * CTXL;
constexpr int MT = ML + MC;
constexpr int HD = 64, NH = 8, NKV = 2;
constexpr int QW = 512, KVW = 128;
constexpr int HYW = 256, FNW = 256;
constexpr int Q_END = 512, K_END = 640, V_END = 768, HY_END = 1536, FN_END = 1792, INW = 4864;
constexpr int DFF = 2816, NEXP = 8;
constexpr int FH = 64, FEMB = 33;
constexpr float EPS = 1e-6f;

constexpr size_t MiB = 1u << 20;
constexpr size_t WS_CTL = 0, CTL_ZERO_BYTES = 4 * MiB;
constexpr size_t WS_WIN = 4 * MiB;
constexpr size_t WS_WPA = WS_WIN + 38 * MiB;
constexpr size_t WS_WPH = WS_WPA + 4 * MiB;
constexpr size_t WS_WPF = WS_WPH + 2 * MiB;
constexpr size_t WS_WO = WS_WPF + 2 * MiB;
constexpr size_t WS_FGU = WS_WO + 8 * MiB;
constexpr size_t WS_FD = WS_FGU + 22 * MiB;
constexpr size_t WS_MGU = WS_FD + 11 * MiB;
constexpr size_t WS_MD = WS_MGU + 176 * MiB;
constexpr size_t WS_XC = WS_MD + 88 * MiB;
constexpr size_t WS_H = WS_XC + 2 * MiB;
constexpr size_t WS_COMB = WS_H + 33 * MiB;
constexpr size_t WS_HF = WS_COMB + 1 * MiB;
constexpr size_t WS_HFC = WS_HF + 32 * MiB;
constexpr size_t WS_S = WS_HFC + 1 * MiB;
constexpr size_t WS_PR = WS_S;
constexpr size_t WS_QK = WS_PR + 157 * MiB;
constexpr size_t WS_ATT = WS_QK + 21 * MiB;
constexpr size_t WS_HYO = WS_ATT + 17 * MiB;
constexpr size_t WS_FNO = WS_HYO + 9 * MiB;
constexpr size_t WS_MACC = WS_FNO + 9 * MiB;
constexpr size_t WS_M = WS_MACC + 66 * MiB;
constexpr size_t WS_END = WS_M + 33 * MiB;
constexpr size_t WS_KS = WS_MACC;
constexpr size_t WS_ZS = WS_MACC + 32 * MiB;
constexpr size_t WS_HYT = WS_MACC + 48 * MiB;
constexpr size_t WS_FNT = WS_MACC + 57 * MiB;
constexpr size_t WS_CTMP = WS_M;
constexpr size_t WS_UT = WS_END;
constexpr size_t WS_END2 = WS_UT + 33 * MiB;
constexpr size_t WS_HID = WS_S;
static_assert((size_t)MT * INW * 2 <= 157 * MiB && (size_t)MT * DFF * 2 <= 157 * MiB, "scratch sizes");
constexpr int CW_BAR = 4096;
constexpr int CW_MOD = 262144;
static_assert((CW_MOD + 4 * 3 * 6144) * 4 <= (int)CTL_ZERO_BYTES, "ctl");

constexpr int LDS_BYTES = 147456;
constexpr int MISC_OFF = LDS_BYTES - 256;

#define LAS __attribute__((address_space(3)))
typedef unsigned short bf16;
typedef unsigned v4u __attribute__((ext_vector_type(4)));
typedef unsigned v2u __attribute__((ext_vector_type(2)));
typedef float f32x4 __attribute__((ext_vector_type(4)));
typedef float f32x2 __attribute__((ext_vector_type(2)));
#define LDS_WAIT() asm volatile("s_waitcnt lgkmcnt(0)" ::: "memory")
__device__ __forceinline__ unsigned f2bf(float f) { unsigned u = __builtin_bit_cast(unsigned, f); return (u + 0x7fffu + ((u >> 16) & 1u)) >> 16; }
__device__ __forceinline__ unsigned pk2(float lo, float hi) { return f2bf(lo) | (f2bf(hi) << 16); }
__device__ __forceinline__ float bf2f(unsigned short h) { return __builtin_bit_cast(float, (unsigned)h << 16); }
__device__ __forceinline__ float bflo(unsigned w) { return __builtin_bit_cast(float, w << 16); }
__device__ __forceinline__ float bfhi(unsigned w) { return __builtin_bit_cast(float, w & 0xffff0000u); }
__device__ __forceinline__ float shx(float v, int lane, int o) { return __builtin_bit_cast(float, __builtin_amdgcn_ds_bpermute((lane ^ o) << 2, __builtin_bit_cast(int, v))); }
__device__ __forceinline__ float wave_sum(float v, int lane) {
#pragma unroll
    for (int o = 1; o < 64; o <<= 1) v += shx(v, lane, o);
    return v;
}
__device__ __forceinline__ float wave_max(float v, int lane) {
#pragma unroll
    for (int o = 1; o < 64; o <<= 1) v = fmaxf(v, shx(v, lane, o));
    return v;
}
__device__ __forceinline__ float sin_rev(float r) { return __builtin_amdgcn_sinf(__builtin_amdgcn_fractf(r)); }
__device__ __forceinline__ float cos_rev(float r) { return __builtin_amdgcn_cosf(__builtin_amdgcn_fractf(r)); }
__device__ __forceinline__ float sigmoidf_(float x) { return __builtin_amdgcn_rcpf(1.0f + __expf(-x)); }
constexpr float INV_2PI = 0.15915494309189535f;

#define XB_TMO      128
#define XB_XCNT(j)  (256  + 64 * (j))
#define XB_XSUB(j)  (1280 + 64 * (j))
#define XB_XGEN(j)  (2304 + 64 * (j))
#define XB_TOP      3328
#define XB_TOPGEN   3392
#define XCD_BAR_WORDS 3456
#define XB_SPIN_CAP (1u << 18)

__device__ __forceinline__ unsigned xb_ld(unsigned* p)              { return __hip_atomic_load(p, __ATOMIC_RELAXED, __HIP_MEMORY_SCOPE_AGENT); }
__device__ __forceinline__ unsigned xb_add(unsigned* p, unsigned v) { return __hip_atomic_fetch_add(p, v, __ATOMIC_RELAXED, __HIP_MEMORY_SCOPE_AGENT); }
__device__ __forceinline__ unsigned xb_xcc_id() { return (unsigned)__builtin_amdgcn_s_getreg((3 << 11) | 20) & 0xFu; }
#define XB_SPIN(cond, bar) do { unsigned _sp = 0; while (cond) { __builtin_amdgcn_s_sleep(1); \
    if ((++_sp & 255u) == 0u) { if (xb_ld(&(bar)[XB_TMO])) break; if (_sp > XB_SPIN_CAP) { atomicAdd(&(bar)[XB_TMO], 1u); break; } } } } while (0)

struct XcdBarrier {
    unsigned* bar; unsigned x;
    volatile LAS unsigned* st;
};

__device__ __forceinline__ XcdBarrier xcd_barrier_post(unsigned* bar, volatile LAS unsigned* st) {
    XcdBarrier b; b.bar = bar; b.x = xb_xcc_id(); b.st = st;
    if (threadIdx.x == 0) (void)xb_add(&bar[XB_XCNT(b.x)], 1u);
    return b;
}
__device__ __forceinline__ void xcd_barrier_complete(unsigned* bar, unsigned x, unsigned& nloc, unsigned& nx) {
    const unsigned G = gridDim.x * gridDim.y * gridDim.z;
    unsigned sum, cnt, mine, sp = 0u;
    for (;;) {
        sum = 0u; cnt = 0u; mine = 0u;
#pragma unroll
        for (unsigned j = 0; j < 16; ++j) { const unsigned c = xb_ld(&bar[XB_XCNT(j)]); sum += c; cnt += (c > 0u) ? 1u : 0u; mine = (j == x) ? c : mine; }
        if (sum == G) break;
        __builtin_amdgcn_s_sleep(1);
        if ((++sp & 255u) == 0u) { if (xb_ld(&bar[XB_TMO])) break; if (sp > XB_SPIN_CAP) { atomicAdd(&bar[XB_TMO], 1u); break; } }
    }
    nloc = mine > 0u ? mine : 1u; nx = cnt > 0u ? cnt : 1u;
}

__device__ __attribute__((noinline)) void xcd_barrier_impl(unsigned* b_bar, unsigned b_x, volatile LAS unsigned* b_st) {
    XcdBarrier b; b.bar = b_bar; b.x = b_x; b.st = b_st;
    asm volatile("s_waitcnt vmcnt(0)" ::: "memory");
    __syncthreads();
    if (threadIdx.x == 0) {
        unsigned* bar = b.bar;
        __builtin_amdgcn_s_waitcnt(0);
        unsigned nloc = b.st[0], nx = b.st[1];
        if (nloc == 0u) { xcd_barrier_complete(bar, b.x, nloc, nx); b.st[0] = nloc; b.st[1] = nx; }
        const unsigned old = xb_add(&bar[XB_XSUB(b.x)], 1u);
        const unsigned gen = old / nloc;
        if (old + 1u == (gen + 1u) * nloc) {
            __builtin_amdgcn_fence(__ATOMIC_RELEASE, "agent");
            asm volatile("s_waitcnt vmcnt(0)" ::: "memory");
            const unsigned og = xb_add(&bar[XB_TOP], 1u);
            const unsigned tg = og / nx;
            if (og + 1u == (tg + 1u) * nx) xb_add(&bar[XB_TOPGEN], 1u);
            else XB_SPIN(xb_ld(&bar[XB_TOPGEN]) == tg, bar);
            __builtin_amdgcn_fence(__ATOMIC_ACQUIRE, "agent");
            xb_add(&bar[XB_XGEN(b.x)], 1u);
            asm volatile("s_waitcnt vmcnt(0)" ::: "memory");
        } else {
            XB_SPIN(xb_ld(&bar[XB_XGEN(b.x)]) == gen, bar);
            __builtin_amdgcn_fence(__ATOMIC_ACQUIRE, "agent");
            asm volatile("s_waitcnt vmcnt(0)" ::: "memory");
        }
    }
    __syncthreads();
}

struct Args { const float* in[34]; unsigned char* ws; int ph_lo, ph_hi; };
struct Frame {
    LAS unsigned char* lds;
    unsigned* ctl;
    unsigned char* ws;
    int tid, lane, wave, G, bid;
    const struct Args* a; int z;
};
__device__ __forceinline__ const float* inp(const Frame& F, int i) { return F.a->in[i + F.z]; }
__device__ __forceinline__ float* outp(const Frame& F) { return (float*)F.a->in[33 + F.z]; }
__device__ __forceinline__ unsigned char* wsp(const Frame& F) { return F.a->ws + F.z; }
enum { I_X = 0, I_C, I_CTX, I_CCTX, I_WADA, I_BADA, I_N1G, I_N2G, I_WIN, I_QG, I_KG, I_SINK, I_HCW, I_HCB, I_FW1, I_FB1, I_FF1, I_FW2, I_FB2, I_FF2, I_FW3, I_HBIAS,
       I_WPA, I_WPH, I_WPF, I_WOUT, I_FG, I_FU, I_FDN, I_ROUTER, I_MG, I_MU, I_MDN };

namespace pg8 {
struct EpiStore {
    static constexpr bool PERM = true, AFTER_DRAIN = false;
    bf16_t* O; int ldc;
    __device__ __forceinline__ void operator()(const f32x4 (&acc)[2][2][4][2], const Unit& u, int wr, int wc, int fr, int fq) const {
        const int row0 = u.pm * BM + wr * 64 + fr, col0 = u.pn * BM + wc * 32 + 8 * fq;
#pragma unroll
        for (int ai = 0; ai < 2; ++ai)
#pragma unroll
            for (int m = 0; m < 4; ++m) { bf16_t* rowp = O + (size_t)(row0 + ai * HALF + m * 16) * ldc + col0;
#pragma unroll
                for (int bj = 0; bj < 2; ++bj) { const f32x4 v0 = acc[ai][bj][m][0], v1 = acc[ai][bj][m][1];
                    u32x4 w; w.x = cvt_pk_bf16(v0[0], v0[1]); w.y = cvt_pk_bf16(v0[2], v0[3]); w.z = cvt_pk_bf16(v1[0], v1[1]); w.w = cvt_pk_bf16(v1[2], v1[3]);
                    *(u32x4*)(rowp + bj * HALF) = w; } }
    }
};
struct EpiIn {
    static constexpr bool PERM = true, AFTER_DRAIN = false;
    bf16_t* O; int ldc; bf16_t* UT; int mt;
    __device__ __forceinline__ void operator()(const f32x4 (&acc)[2][2][4][2], const Unit& u, int wr, int wc, int fr, int fq) const {
        const int row0 = u.pm * BM + wr * 64 + fr, col0 = u.pn * BM + wc * 32 + 8 * fq;
        if (u.pn >= 3 && u.pn < 7) {
#pragma unroll
            for (int ai = 0; ai < 2; ++ai)
#pragma unroll
                for (int bj = 0; bj < 2; ++bj)
#pragma unroll
                    for (int n = 0; n < 2; ++n)
#pragma unroll
                        for (int e = 0; e < 4; ++e) { bf16_t* cp = UT + (size_t)(col0 - 768 + bj * HALF + n * 4 + e) * mt + row0 + ai * HALF;
#pragma unroll
                            for (int m = 0; m < 4; ++m) cp[m * 16] = (bf16_t)(cvt_pk_bf16(acc[ai][bj][m][n][e], 0.f) & 0xffffu); }
        } else {
#pragma unroll
            for (int ai = 0; ai < 2; ++ai)
#pragma unroll
                for (int m = 0; m < 4; ++m) { bf16_t* rowp = O + (size_t)(row0 + ai * HALF + m * 16) * ldc + col0;
#pragma unroll
                    for (int bj = 0; bj < 2; ++bj) { const f32x4 v0 = acc[ai][bj][m][0], v1 = acc[ai][bj][m][1];
                        u32x4 w; w.x = cvt_pk_bf16(v0[0], v0[1]); w.y = cvt_pk_bf16(v0[2], v0[3]); w.z = cvt_pk_bf16(v1[0], v1[1]); w.w = cvt_pk_bf16(v1[2], v1[3]);
                        *(u32x4*)(rowp + bj * HALF) = w; } }
        }
    }
};
struct EpiSwiglu {
    static constexpr bool PERM = true, AFTER_DRAIN = false;
    bf16_t* O; int ldc;
    __device__ __forceinline__ void operator()(const f32x4 (&acc)[2][2][4][2], const Unit& u, int wr, int wc, int fr, int fq) const {
        const int row0 = u.pm * BM + wr * 64 + fr, col0 = u.pn * HALF + wc * 32 + 8 * fq;
#pragma unroll
        for (int ai = 0; ai < 2; ++ai)
#pragma unroll
            for (int m = 0; m < 4; ++m) { bf16_t* rowp = O + (size_t)(row0 + ai * HALF + m * 16) * ldc + col0;
                float h[8];
#pragma unroll
                for (int n = 0; n < 2; ++n)
#pragma unroll
                    for (int e = 0; e < 4; ++e) { const float g = acc[ai][0][m][n][e], uu = acc[ai][1][m][n][e]; h[n * 4 + e] = g * __builtin_amdgcn_rcpf(1.0f + __expf(-g)) * uu; }
                u32x4 w; w.x = cvt_pk_bf16(h[0], h[1]); w.y = cvt_pk_bf16(h[2], h[3]); w.z = cvt_pk_bf16(h[4], h[5]); w.w = cvt_pk_bf16(h[6], h[7]);
                *(u32x4*)rowp = w; }
    }
};
struct EpiMerge {
    static constexpr bool PERM = false, AFTER_DRAIN = false;
    const bf16_t* PR; float* MACC; bf16_t* Mo; int mode;
    __device__ __forceinline__ void operator()(const f32x4 (&acc)[2][2][4][2], const Unit& u, int wr, int wc, int fr, int fq) const {
        const int col0 = u.pn * BM + wc * 32 + 4 * fq;
#pragma unroll
        for (int ai = 0; ai < 2; ++ai)
#pragma unroll
            for (int m = 0; m < 4; ++m) { const int r = u.pm * BM + ai * HALF + wr * 64 + m * 16 + fr;
#pragma unroll
                for (int bj = 0; bj < 2; ++bj)
#pragma unroll
                    for (int n = 0; n < 2; ++n) { const int c = col0 + bj * HALF + n * 16;
                        typedef unsigned u32x2v __attribute__((ext_vector_type(2)));
                        const u32x2v gw = *(const u32x2v*)(PR + (size_t)r * 4864 + 1792 + mode * 1024 + c);
                        f32x4 g; g[0] = __builtin_bit_cast(float, gw.x << 16); g[1] = __builtin_bit_cast(float, gw.x & 0xffff0000u); g[2] = __builtin_bit_cast(float, gw.y << 16); g[3] = __builtin_bit_cast(float, gw.y & 0xffff0000u);
                        f32x4 v;
#pragma unroll
                        for (int e = 0; e < 4; ++e) v[e] = __builtin_amdgcn_rcpf(1.0f + __expf(-g[e])) * acc[ai][bj][m][n][e];
                        float* mp = MACC + (size_t)r * 1024 + c;
                        if (mode == 0) { *(f32x4*)mp = v; }
                        else if (mode == 1) { *(f32x4*)mp = *(const f32x4*)mp + v; }
                        else { const f32x4 t = *(const f32x4*)mp + v; u32x2v w; w.x = cvt_pk_bf16(t[0], t[1]); w.y = cvt_pk_bf16(t[2], t[3]); *(u32x2v*)(Mo + (size_t)r * 1024 + c) = w; }
                    } }
    }
};
struct EpiResid {
    static constexpr bool PERM = false, AFTER_DRAIN = false;
    const float* xin_lat; const float* xin_ctx; float* xout_lat; float* xout_ctx; const float* gate  ; const float* rowscale  ;
    __device__ __forceinline__ void operator()(const f32x4 (&acc)[2][2][4][2], const Unit& u, int wr, int wc, int fr, int fq) const {
        const int col0 = u.pn * BM + wc * 32 + 4 * fq;
        const bool isctx = u.pm >= 64;
        const int cond = isctx ? 2 : (u.pm >> 5);
        const float* xi = isctx ? xin_ctx - (size_t)16384 * 1024 : xin_lat;
        float* xo = isctx ? xout_ctx - (size_t)16384 * 1024 : xout_lat;
        const float* gp = gate + cond * 6144;
        f32x4 gv[2][2];
#pragma unroll
        for (int bj = 0; bj < 2; ++bj)
#pragma unroll
            for (int n = 0; n < 2; ++n) gv[bj][n] = *(const f32x4*)(gp + col0 + bj * HALF + n * 16);
#pragma unroll
        for (int ai = 0; ai < 2; ++ai)
#pragma unroll
            for (int m = 0; m < 4; ++m) { const int r = u.pm * BM + ai * HALF + wr * 64 + m * 16 + fr;
                const float rs = rowscale ? rowscale[(size_t)r * 8] : 1.0f;
#pragma unroll
                for (int bj = 0; bj < 2; ++bj)
#pragma unroll
                    for (int n = 0; n < 2; ++n) { const size_t off = (size_t)r * 1024 + col0 + bj * HALF + n * 16;
                        const f32x4 xv = *(const f32x4*)(xi + off);
                        *(f32x4*)(xo + off) = xv + gv[bj][n] * rs * acc[ai][bj][m][n]; } }
    }
};
}

__device__ __forceinline__ void transpose_item(const float* W, int K, int N, bf16* WT, int map, LAS float* scr, int item, int lane) {
    const int nblk = N / 32, kb = item / nblk, nb = item % nblk, k0 = 64 * kb, n0 = 32 * nb;
#pragma unroll 8
    for (int i = 0; i < 32; ++i) { const int kk = 2 * i + (lane >> 5); scr[kk * 33 + (lane & 31)] = W[(size_t)(k0 + kk) * N + n0 + (lane & 31)]; }
    LDS_WAIT(); asm volatile("" ::: "memory");
    const int c = lane & 7;
#pragma unroll
    for (int j = 0; j < 4; ++j) { const int n = (lane >> 3) + 8 * j; const LAS float* s = scr + (8 * c) * 33 + n;
        v4u o; o.x = pk2(s[0 * 33], s[1 * 33]); o.y = pk2(s[2 * 33], s[3 * 33]); o.z = pk2(s[4 * 33], s[5 * 33]); o.w = pk2(s[6 * 33], s[7 * 33]);
        const int nn = n0 + n; const int drow = (map == 0) ? nn : ((nn >> 7) * 256 + (nn & 127) + (map == 2 ? 128 : 0));
        *(v4u*)(WT + (size_t)drow * K + k0 + 8 * c) = o; }
    LDS_WAIT(); asm volatile("" ::: "memory");
}

#define TR_GROUP(SRC, DST, CNT, KK, NN, MAP, DSTRIDE) { constexpr int per = ((KK) / 64) * ((NN) / 32); constexpr int tot = (CNT) * per; \
    if (r < tot) { const int mi = r / per, it2 = r % per; transpose_item((SRC) + (size_t)mi * (KK) * (NN), (KK), (NN), (DST) + (size_t)mi * (DSTRIDE), (MAP), scr, it2, F.lane); continue; } r -= tot; }

__device__ __forceinline__ void phase_prologue(Frame& F) {
    LAS float* scr = (LAS float*)(F.lds + F.wave * 17408);
    const int gw = F.bid * NWAVES + F.wave, NGW = F.G * NWAVES;
    constexpr int TOT_ITEMS = 4 * (16 * 152 + 8 * 32 + 4 * 32 + 4 * 32 + 16 * 32) + 2 * (16 * 88 * 2 + 44 * 32) + 16 * (16 * 88 * 2 + 44 * 32);
    for (int it = gw; it < TOT_ITEMS; it += NGW) {
        int r = it;
        { constexpr int per = 16 * 152, tot = 4 * per;
          if (r < tot) { const int mi = r / per, it2 = r % per; const int nb = it2 % 152;
              if (nb < 48 || nb >= 56) transpose_item(inp(F, I_WIN) + (size_t)mi * 1024 * 4864, 1024, 4864, ((bf16*)(wsp(F) + WS_WIN)) + (size_t)mi * 4864 * 1024, 0, scr, it2, F.lane);
              continue; } r -= tot; }
        TR_GROUP(inp(F, I_WPA), ((bf16*)(wsp(F) + WS_WPA)), 4, 512, 1024, 0, (size_t)1024 * 512)
        TR_GROUP(inp(F, I_WPH), ((bf16*)(wsp(F) + WS_WPH)), 4, 256, 1024, 0, (size_t)1024 * 256)
        TR_GROUP(inp(F, I_WPF), ((bf16*)(wsp(F) + WS_WPF)), 4, 256, 1024, 0, (size_t)1024 * 256)
        TR_GROUP(inp(F, I_WOUT), ((bf16*)(wsp(F) + WS_WO)), 4, 1024, 1024, 0, (size_t)1024 * 1024)
        TR_GROUP(inp(F, I_FG), ((bf16*)(wsp(F) + WS_FGU)), 2, 1024, 2816, 1, (size_t)5632 * 1024)
        TR_GROUP(inp(F, I_FU), ((bf16*)(wsp(F) + WS_FGU)), 2, 1024, 2816, 2, (size_t)5632 * 1024)
        TR_GROUP(inp(F, I_FDN), ((bf16*)(wsp(F) + WS_FD)), 2, 2816, 1024, 0, (size_t)1024 * 2816)
        TR_GROUP(inp(F, I_MG), ((bf16*)(wsp(F) + WS_MGU)), 16, 1024, 2816, 1, (size_t)5632 * 1024)
        TR_GROUP(inp(F, I_MU), ((bf16*)(wsp(F) + WS_MGU)), 16, 1024, 2816, 2, (size_t)5632 * 1024)
        TR_GROUP(inp(F, I_MDN), ((bf16*)(wsp(F) + WS_MD)), 16, 2816, 1024, 0, (size_t)1024 * 2816)
    }
    { LAS float* tl = (LAS float*)(F.lds + F.wave * 17408); LAS float* ctab = tl + 64 * 65; LAS float* stab = ctab + 64;
      ctab[F.lane] = cos_rev((float)F.lane * (1.0f / 64.0f)); stab[F.lane] = sin_rev((float)F.lane * (1.0f / 64.0f));
      for (int it = gw; it < 4 * 16 * 4; it += NGW) {
        const int l = it >> 6, kb = (it >> 2) & 15, g = it & 3;
        const float* W = inp(F, I_WIN) + (size_t)l * 1024 * 4864 + (size_t)(kb * 64) * 4864 + 1536 + g * 64;
#pragma unroll 8
        for (int kk = 0; kk < 64; ++kk) tl[kk * 65 + F.lane] = W[(size_t)kk * 4864 + F.lane];
        LDS_WAIT(); asm volatile("" ::: "memory");
        bf16* dst = ((bf16*)(wsp(F) + WS_WIN)) + (size_t)l * 4864 * 1024 + (size_t)(1536 + g * 64) * 1024 + kb * 64 + F.lane;
        for (int j = 0; j < 64; ++j) {
            const int mm = j <= 32 ? j : j - 32; float a = 0.f;
            if (j <= 32) { for (int c = 0; c < 64; ++c) a += tl[F.lane * 65 + c] * ctab[(mm * c) & 63]; }
            else { for (int c = 0; c < 64; ++c) a += tl[F.lane * 65 + c] * stab[(mm * c) & 63]; }
            dst[(size_t)j * 1024] = (bf16)f2bf(a);
        }
        LDS_WAIT(); asm volatile("" ::: "memory");
      } }
    for (int it = gw; it < 4 * 96; it += NGW) {
        const int l = it / 96, cb = it % 96;
        const float* W = inp(F, I_WADA) + (size_t)l * 1024 * 6144 + cb * 64 + F.lane;
        float a0 = 0.f, a1 = 0.f, a2 = 0.f;
#pragma unroll 8
        for (int k = 0; k < 1024; ++k) {
            const float c0 = inp(F, I_C)[k], c1 = inp(F, I_C)[1024 + k], c2 = inp(F, I_CCTX)[k];
            const float s0 = c0 * sigmoidf_(c0), s1 = c1 * sigmoidf_(c1), s2 = c2 * sigmoidf_(c2);
            const float w = W[(size_t)k * 6144];
            a0 += w * s0; a1 += w * s1; a2 += w * s2;
        }
        const float bb = inp(F, I_BADA)[l * 6144 + cb * 64 + F.lane];
        float* mo = ((float*)(wsp(F) + WS_CTL) + CW_MOD) + (size_t)l * 3 * 6144 + cb * 64 + F.lane;
        mo[0] = a0 + bb; mo[6144] = a1 + bb; mo[2 * 6144] = a2 + bb;
    }
}

template <bool ROUTER>
__device__ __forceinline__ void phase_norm(Frame& F, int l, const float* xlat, const float* xctx, const float* g, int moff, const float* wr) {
    const int gw = F.bid * NWAVES + F.wave, NGW = F.G * NWAVES;
    const float* mod = ((float*)(wsp(F) + WS_CTL) + CW_MOD) + (size_t)l * 3 * 6144 + moff;
    for (int r = gw; r < MT; r += NGW) {
        const bool isctx = r >= ML; const int cond = isctx ? 2 : (r >> 13);
        const float* xr = isctx ? xctx + (size_t)(r - ML) * 1024 : xlat + (size_t)r * 1024;
        f32x4 v[4]; float s = 0.f;
#pragma unroll
        for (int j = 0; j < 4; ++j) { v[j] = *(const f32x4*)(xr + 256 * j + 4 * F.lane); s += (v[j][0] * v[j][0] + v[j][1] * v[j][1]) + (v[j][2] * v[j][2] + v[j][3] * v[j][3]); }
        const float rstd = 1.0f / sqrtf(wave_sum(s, F.lane) * (1.0f / 1024.0f) + EPS);
        const float* sh = mod + cond * 6144; const float* sc = sh + 1024;
        float lg[8];
        if (ROUTER) {
#pragma unroll
            for (int e = 0; e < 8; ++e) lg[e] = 0.f;
        }
#pragma unroll
        for (int j = 0; j < 4; ++j) { const int c = 256 * j + 4 * F.lane;
            const f32x4 gg = *(const f32x4*)(g + c), s1 = *(const f32x4*)(sc + c), s0 = *(const f32x4*)(sh + c);
            f32x4 y;
#pragma unroll
            for (int e = 0; e < 4; ++e) y[e] = (v[j][e] * rstd * gg[e]) * (1.0f + s1[e]) + s0[e];
            v2u o; o.x = pk2(y[0], y[1]); o.y = pk2(y[2], y[3]);
            *(v2u*)(((bf16*)(wsp(F) + WS_H)) + (size_t)r * 1024 + c) = o;
            if (ROUTER) {
#pragma unroll
                for (int e = 0; e < 4; ++e) { const f32x4 w0 = *(const f32x4*)(wr + (size_t)(c + e) * 8), w1 = *(const f32x4*)(wr + (size_t)(c + e) * 8 + 4);
                    lg[0] += y[e] * w0[0]; lg[1] += y[e] * w0[1]; lg[2] += y[e] * w0[2]; lg[3] += y[e] * w0[3];
                    lg[4] += y[e] * w1[0]; lg[5] += y[e] * w1[1]; lg[6] += y[e] * w1[2]; lg[7] += y[e] * w1[3]; }
            }
        }
        if (ROUTER) {
#pragma unroll
            for (int e = 0; e < 8; ++e) lg[e] = wave_sum(lg[e], F.lane);
            int i0 = 0; float v0 = lg[0];
#pragma unroll
            for (int e = 1; e < 8; ++e) if (lg[e] > v0) { v0 = lg[e]; i0 = e; }
            int i1 = -1; float v1 = -INFINITY;
#pragma unroll
            for (int e = 0; e < 8; ++e) if (e != i0 && lg[e] > v1) { v1 = lg[e]; i1 = e; }
            const float w0 = 1.0f / (1.0f + __expf(v1 - v0)), w1 = 1.0f - w0;
            if (F.lane < 8) ((float*)(wsp(F) + WS_COMB))[(size_t)r * 8 + F.lane] = (F.lane == i0) ? w0 : ((F.lane == i1) ? w1 : 0.0f);
        }
    }
}

__device__ __forceinline__ void filter_tile(Frame& F, int l, int L, int p0, float* dst  ) {
    LAS float* emb = (LAS float*)F.lds;
    LAS float* h1 = emb + 64 * 33;
    LAS float* h2 = h1 + 64 * 65;
    const float* w1 = inp(F, I_FW1) + l * 33 * 64; const float* b1 = inp(F, I_FB1) + l * 64; const float* f1 = inp(F, I_FF1) + l * 64;
    const float* w2 = inp(F, I_FW2) + l * 64 * 64; const float* b2 = inp(F, I_FB2) + l * 64; const float* f2 = inp(F, I_FF2) + l * 64;
    const float* w3 = inp(F, I_FW3) + (size_t)l * 64 * 1024;
    for (int idx = F.tid; idx < 64 * 33; idx += NTHREADS) {
        const int pos = idx / 33, f = idx % 33, i = p0 + pos;
        float val;
        if (f == 0) val = (float)i / (float)(L - 1);
        else { const int j = (f - 1) & 15; const float fb = 1e-4f + (float)j * ((15.0f - 1e-4f) / 15.0f); const float rev = fb * (float)i / (float)L;
               val = (f <= 16) ? cos_rev(rev) : -sin_rev(rev); }
        emb[pos * 33 + f] = val;
    }
    __syncthreads();
    for (int idx = F.tid; idx < 4096; idx += NTHREADS) {
        const int pos = idx >> 6, u = idx & 63; float a = b1[u];
        for (int f = 0; f < 33; ++f) a += emb[pos * 33 + f] * w1[f * 64 + u];
        h1[pos * 65 + u] = sin_rev(f1[u] * a * INV_2PI);
    }
    __syncthreads();
    for (int idx = F.tid; idx < 4096; idx += NTHREADS) {
        const int pos = idx >> 6, u = idx & 63; float a = b2[u];
        for (int f = 0; f < 64; ++f) a += h1[pos * 65 + f] * w2[f * 64 + u];
        h2[pos * 65 + u] = sin_rev(f2[u] * a * INV_2PI);
    }
    __syncthreads();
    const int pos = F.lane, i = p0 + pos; const float t = (float)i / (float)(L - 1);
    for (int col = F.wave; col < 1024; col += NWAVES) {
        float a = 0.f;
        for (int f = 0; f < 64; ++f) a += h2[pos * 65 + f] * w3[f * 1024 + col];
        const int ch = col & 255; const float delta = 3.0701134573253946f + 12.280453829301578f * ((float)ch / 255.0f);
        dst[(size_t)col * L + i] = a * __expf(-t * delta);
    }
    __syncthreads();
}

__device__ __forceinline__ void phase_qkprep(Frame& F, int l) {
    const int gw = F.bid * NWAVES + F.wave, NGW = F.G * NWAVES;
    const int lane = F.lane; const int a = lane >> 5, half = (lane >> 4) & 1, f = lane & 15;
    const float inv = exp2f(-(float)f * (13.287712379549449f / 16.0f)) * INV_2PI;
    const float gq = inp(F, I_QG)[l * 64 + lane], gk = inp(F, I_KG)[l * 64 + lane];
    for (int r = gw; r < MT; r += NGW) {
        const bool isctx = r >= ML; const int t = r & 8191; const int pos = a == 0 ? (t >> 6) : (t & 63);
        float cs = 1.f, sn = 0.f;
        if (!isctx) { const float rev = (float)pos * inv; cs = cos_rev(rev); sn = sin_rev(rev); }
        const bf16* pr = ((bf16*)(wsp(F) + WS_PR)) + (size_t)r * INW;
        bf16* qk = ((bf16*)(wsp(F) + WS_QK)) + (size_t)r * 640;
#pragma unroll
        for (int h = 0; h < 10; ++h) {
            const float v = bf2f(pr[h * 64 + lane]);
            const float ss = wave_sum(v * v, lane);
            const float y = v * (1.0f / sqrtf(ss * (1.0f / 64.0f) + EPS)) * (h < 8 ? gq : gk);
            const float p = shx(y, lane, 16);
            const float o = half == 0 ? y * cs - p * sn : y * cs + p * sn;
            qk[h * 64 + lane] = (bf16)f2bf(o);
        }
    }
}

__device__ __forceinline__ float block_sum(Frame& F, float v, LAS float* red) {
    v = wave_sum(v, F.lane);
    __syncthreads();
    if (F.lane == 0) red[F.wave] = v;
    __syncthreads();
    float t = 0.f;
#pragma unroll
    for (int w = 0; w < NWAVES; ++w) t += red[w];
    return t;
}

template <int L>
__device__ __forceinline__ float hy_uc(const bf16* UT, int rowbase, int b, int t, int ch, const float* cw, const float* cb) {
    float a = cb[ch];
    const bf16* up = UT + (size_t)ch * MT + rowbase + b * L;
#pragma unroll
    for (int j = 0; j < 3; ++j) { const int tt = t + j - 1; if (tt >= 0 && tt < L) a += bf2f(up[tt]) * cw[j * 768 + ch]; }
    return a;
}

template <int L>
__device__ __forceinline__ void hyena_item_naive(Frame& F, int l, int c, int rowbase, const float* taps) {
    constexpr int NT = (L + NTHREADS - 1) / NTHREADS;
    LAS float* kt = (LAS float*)F.lds;
    LAS f32x2* z = (LAS f32x2*)(F.lds + 2 * L * 4);
    LAS float* red = (LAS float*)(F.lds + 2 * L * 4 + L * 8);
    const float* cw = inp(F, I_HCW) + l * 3 * 768; const float* cb = inp(F, I_HCB) + l * 768; const float* hb = inp(F, I_HBIAS) + l * 512;
    for (int t = F.tid; t < L; t += NTHREADS) { f32x2 v; v.x = hy_uc<L>(((bf16*)(wsp(F) + WS_UT)), rowbase, 0, t, 512 + c, cw, cb); v.y = hy_uc<L>(((bf16*)(wsp(F) + WS_UT)), rowbase, 1, t, 512 + c, cw, cb); z[t] = v; }
    for (int o = 0; o < 2; ++o) {
        const float* fwd = taps + (size_t)(o * 256 + c) * L; const float* bwd = taps + (size_t)(512 + o * 256 + c) * L;
        float part = 0.f;
        for (int d = F.tid; d < L; d += NTHREADS) { const float kf = fwd[d]; kt[L + d] = kf; part += fabsf(kf);
            if (d >= 1) { const float kb = bwd[d]; kt[L - d] = kb; part += fabsf(kb); } else kt[0] = 0.f; }
        const float tot = block_sum(F, part, red);
        const float inv = 1.0f / tot;
        __syncthreads();
        float* tmp = (float*)(wsp(F) + WS_CTMP) + (size_t)c * 2 * L;
#pragma unroll 1
        for (int t = F.tid; t < L; t += NTHREADS) {
            float a0 = 0.f, a1 = 0.f;
#pragma unroll 4
            for (int s = 0; s < L; ++s) { const f32x2 zz = z[s]; const float kv = kt[L + t - s]; a0 += kv * zz.x; a1 += kv * zz.y; }
            tmp[t] = a0; tmp[L + t] = a1;
        }
        __syncthreads();
        const float bo = hb[o * 256 + c];
#pragma unroll 1
        for (int t = F.tid; t < L; t += NTHREADS) {
            const float g0 = hy_uc<L>(((bf16*)(wsp(F) + WS_UT)), rowbase, 0, t, o * 256 + c, cw, cb), g1 = hy_uc<L>(((bf16*)(wsp(F) + WS_UT)), rowbase, 1, t, o * 256 + c, cw, cb);
            const f32x2 zo = z[t]; f32x2 zn; zn.x = g0 * (tmp[t] * inv + bo * zo.x); zn.y = g1 * (tmp[L + t] * inv + bo * zo.y); z[t] = zn;
        }
        __syncthreads();
    }
    for (int t = F.tid; t < L; t += NTHREADS) { const f32x2 v = z[t];
        ((bf16*)(wsp(F) + WS_HYT))[(size_t)c * MT + rowbase + t] = (bf16)f2bf(v.x); ((bf16*)(wsp(F) + WS_HYT))[(size_t)c * MT + rowbase + L + t] = (bf16)f2bf(v.y); }
    __syncthreads();
}

template <int L>
__device__ __forceinline__ void fnet_item_naive(Frame& F, int b, int g, int m, int rowbase) {
    LAS f32x2* AB = (LAS f32x2*)F.lds;
    LAS f32x2* tab = (LAS f32x2*)(F.lds + L * 8);
    LAS f32x2* cs64 = (LAS f32x2*)(F.lds + 2 * L * 8);
    for (int i = F.tid; i < L; i += NTHREADS) { f32x2 v; const float rev = (float)i / (float)L; v.x = cos_rev(rev); v.y = sin_rev(rev); tab[i] = v; }
    if (F.tid < 64) { f32x2 v; const float rev = (float)F.tid / 64.0f; v.x = cos_rev(rev); v.y = sin_rev(rev); cs64[F.tid] = v; }
    __syncthreads();
    for (int n = F.tid; n < L; n += NTHREADS) {
        const bf16* ut = ((const bf16*)(wsp(F) + WS_UT)) + (size_t)(768 + g * 64) * MT + rowbase + b * L + n;
        const int mm = m <= 32 ? m : 64 - m;
        f32x2 v; v.x = bf2f(ut[(size_t)mm * MT]);
        v.y = (m == 0 || m == 32) ? 0.f : (m < 32 ? bf2f(ut[(size_t)(32 + m) * MT]) : -bf2f(ut[(size_t)(32 + mm) * MT]));
        AB[n] = v;
    }
    __syncthreads();
    const float scale = 1.0f / sqrtf((float)L * 64.0f);
    for (int k = F.tid; k < L; k += NTHREADS) {
        float acc = 0.f; int idx = 0;
        for (int n = 0; n < L; ++n) { const f32x2 ab = AB[n]; const f32x2 cs = tab[idx]; acc += ab.x * cs.x - ab.y * cs.y; idx = (idx + k) & (L - 1); }
        ((bf16*)(wsp(F) + WS_FNT))[(size_t)(g * 64 + m) * MT + rowbase + b * L + k] = (bf16)f2bf(acc * scale);
    }
    __syncthreads();
}

#ifdef FFT_HOST
#define FFT_LDS
#define FFT_HD
static inline float fft_cos_rev(float r) { return (float)cos(6.283185307179586 * (double)r); }
static inline float fft_sin_rev(float r) { return (float)sin(6.283185307179586 * (double)r); }
#else
#define FFT_LDS LAS
#define FFT_HD __device__ __forceinline__
__device__ __forceinline__ float fft_cos_rev(float r) { return __builtin_amdgcn_cosf(r); }
__device__ __forceinline__ float fft_sin_rev(float r) { return __builtin_amdgcn_sinf(r); }
#endif
FFT_HD int fft_phys(int i) { return i + ((i >> 5) << 1); }
FFT_HD f32x2 fft_cmul(f32x2 a, f32x2 b) { f32x2 r; r.x = a.x * b.x - a.y * b.y; r.y = a.x * b.y + a.y * b.x; return r; }
template <int R> FFT_HD constexpr int fft_brev(int p) { int r = 0; for (int b = 1; b < R; b <<= 1) { r = (r << 1) | ((p & b) ? 1 : 0); } return r; }
template <int R, bool INV> FFT_HD void fft_regs(f32x2 (&a)[R]) {
    constexpr float C16[16] = {1.0f, 0.92387953251128674f, 0.70710678118654752f, 0.38268343236508977f, 0.0f, -0.38268343236508977f, -0.70710678118654752f, -0.92387953251128674f,
                               -1.0f, -0.92387953251128674f, -0.70710678118654752f, -0.38268343236508977f, 0.0f, 0.38268343236508977f, 0.70710678118654752f, 0.92387953251128674f};
    constexpr float S16[16] = {0.0f, 0.38268343236508977f, 0.70710678118654752f, 0.92387953251128674f, 1.0f, 0.92387953251128674f, 0.70710678118654752f, 0.38268343236508977f,
                               0.0f, -0.38268343236508977f, -0.70710678118654752f, -0.92387953251128674f, -1.0f, -0.92387953251128674f, -0.70710678118654752f, -0.38268343236508977f};
#pragma unroll
    for (int s = R / 2; s >= 1; s >>= 1) {
#pragma unroll
        for (int i = 0; i < R; ++i) {
            if ((i & s) == 0) {
                const int k = i & (s - 1);
                const f32x2 u = a[i], v = a[i + s];
                a[i] = u + v;
                const f32x2 d = u - v;
                if (k == 0) a[i + s] = d;
                else if (2 * k == s) { f32x2 t; if (INV) { t.x = -d.y; t.y = d.x; } else { t.x = d.y; t.y = -d.x; } a[i + s] = t; }
                else { const int idx = k * (16 / (2 * s)); f32x2 w; w.x = C16[idx]; w.y = INV ? S16[idx] : -S16[idx]; a[i + s] = fft_cmul(d, w); }
            }
        }
    }
}
template <int N, int NCUR, int R, bool INV, int NT>
FFT_HD void fft_pass(FFT_LDS f32x2* buf, int tid) {
    constexpr int M = NCUR / R;
#pragma unroll 1
    for (int i = tid; i < N / R; i += NT) {
        const int blk = i / M, j = i - blk * M, base = blk * NCUR + j;
        f32x2 a[R];
#pragma unroll
        for (int q = 0; q < R; ++q) a[q] = buf[fft_phys(base + q * M)];
        f32x2 w1; { const float rev = (float)j * (1.0f / (float)NCUR); w1.x = fft_cos_rev(rev); w1.y = INV ? fft_sin_rev(rev) : -fft_sin_rev(rev); }
        if (M > 1) {
            if (INV) { f32x2 w = w1;
#pragma unroll
                for (int p = 1; p < R; ++p) { a[p] = fft_cmul(a[p], w); if (p + 1 < R) w = fft_cmul(w, w1); } }
        }
        fft_regs<R, INV>(a);
        if (M > 1 && !INV) { f32x2 w = w1;
#pragma unroll
            for (int p = 1; p < R; ++p) { a[fft_brev<R>(p)] = fft_cmul(a[fft_brev<R>(p)], w); if (p + 1 < R) w = fft_cmul(w, w1); } }
#pragma unroll
        for (int p = 0; p < R; ++p) buf[fft_phys(base + p * M)] = a[fft_brev<R>(p)];
    }
}
#ifdef FFT_HOST
#define FFT_SYNC()
#else
#define FFT_SYNC() __syncthreads()
#endif

template <bool INV> __device__ __forceinline__ void fft16k(LAS f32x2* buf, int tid) {
    constexpr int N = 16384;
    if (!INV) { fft_pass<N, 16384, 16, false, NTHREADS>(buf, tid); __syncthreads(); fft_pass<N, 1024, 16, false, NTHREADS>(buf, tid); __syncthreads();
                fft_pass<N, 64, 16, false, NTHREADS>(buf, tid); __syncthreads(); fft_pass<N, 4, 4, false, NTHREADS>(buf, tid); __syncthreads(); }
    else { fft_pass<N, 4, 4, true, NTHREADS>(buf, tid); __syncthreads(); fft_pass<N, 64, 16, true, NTHREADS>(buf, tid); __syncthreads();
           fft_pass<N, 1024, 16, true, NTHREADS>(buf, tid); __syncthreads(); fft_pass<N, 16384, 16, true, NTHREADS>(buf, tid); __syncthreads(); }
}
__device__ __forceinline__ void fft8k_fwd(LAS f32x2* buf, int tid) {
    constexpr int N = 8192;
    fft_pass<N, 8192, 16, false, NTHREADS>(buf, tid); __syncthreads(); fft_pass<N, 512, 16, false, NTHREADS>(buf, tid); __syncthreads();
    fft_pass<N, 32, 16, false, NTHREADS>(buf, tid); __syncthreads(); fft_pass<N, 2, 2, false, NTHREADS>(buf, tid); __syncthreads();
}

__device__ __forceinline__ void hyena_item_fft(Frame& F, int l, int c) {
    constexpr int L = SEQ, N = 2 * SEQ;
    LAS f32x2* buf = (LAS f32x2*)F.lds;
    LAS float* red = (LAS float*)(F.lds + 139264);
    const bf16* UT = (const bf16*)(wsp(F) + WS_UT);
    const float* cw = inp(F, I_HCW) + l * 3 * 768; const float* cb = inp(F, I_HCB) + l * 768; const float* hb = inp(F, I_HBIAS) + l * 512;
    f32x2* kspec = (f32x2*)(wsp(F) + WS_KS) + (size_t)F.bid * N;
    f32x2* zold = (f32x2*)(wsp(F) + WS_ZS) + (size_t)F.bid * L;
    const float* HFp = (const float*)(wsp(F) + WS_HF);
    for (int o = 0; o < 2; ++o) {
        const float* fwd = HFp + (size_t)(o * 256 + c) * L; const float* bwd = HFp + (size_t)(512 + o * 256 + c) * L;
        float part = 0.f;
#pragma unroll 1
        for (int i = F.tid; i < N; i += NTHREADS) { float v; if (i < L) v = fwd[i]; else if (i == L) v = 0.f; else v = bwd[N - i]; part += fabsf(v); f32x2 w; w.x = v; w.y = 0.f; buf[fft_phys(i)] = w; }
        const float tot = block_sum(F, part, red);
        fft16k<false>(buf, F.tid);
        const float scale = 1.0f / (tot * (float)N);
#pragma unroll 1
        for (int i = F.tid; i < N; i += NTHREADS) kspec[i] = buf[fft_phys(i)] * scale;
        __syncthreads();
        if (o == 0) {
#pragma unroll 1
            for (int t = F.tid; t < L; t += NTHREADS) { f32x2 v; v.x = hy_uc<L>(UT, 0, 0, t, 512 + c, cw, cb); v.y = hy_uc<L>(UT, 0, 1, t, 512 + c, cw, cb);
                buf[fft_phys(t)] = v; zold[t] = v; f32x2 zz; zz.x = 0.f; zz.y = 0.f; buf[fft_phys(L + t)] = zz; }
        } else {
#pragma unroll 1
            for (int t = F.tid; t < L; t += NTHREADS) { buf[fft_phys(t)] = zold[t]; f32x2 zz; zz.x = 0.f; zz.y = 0.f; buf[fft_phys(L + t)] = zz; }
        }
        __syncthreads();
        fft16k<false>(buf, F.tid);
#pragma unroll 1
        for (int i = F.tid; i < N; i += NTHREADS) buf[fft_phys(i)] = fft_cmul(buf[fft_phys(i)], kspec[i]);
        __syncthreads();
        fft16k<true>(buf, F.tid);
        const float bo = hb[o * 256 + c];
#pragma unroll 1
        for (int t = F.tid; t < L; t += NTHREADS) {
            const f32x2 cv = buf[fft_phys(t)], zo = zold[t];
            const float g0 = hy_uc<L>(UT, 0, 0, t, o * 256 + c, cw, cb), g1 = hy_uc<L>(UT, 0, 1, t, o * 256 + c, cw, cb);
            f32x2 zn; zn.x = g0 * (cv.x + bo * zo.x); zn.y = g1 * (cv.y + bo * zo.y);
            if (o == 0) zold[t] = zn;
            else { ((bf16*)(wsp(F) + WS_HYT))[(size_t)c * MT + t] = (bf16)f2bf(zn.x); ((bf16*)(wsp(F) + WS_HYT))[(size_t)c * MT + L + t] = (bf16)f2bf(zn.y); }
        }
        __syncthreads();
    }
}

__device__ __forceinline__ void fnet_item_fft(Frame& F, int b, int g, int m) {
    constexpr int N = SEQ;
    LAS f32x2* buf = (LAS f32x2*)F.lds;
    LAS float* re = (LAS float*)(F.lds + 69632);
    LAS float* im = re + N;
    const bf16* ut = ((const bf16*)(wsp(F) + WS_UT)) + (size_t)(768 + g * 64) * MT + b * N;
    bf16* fnt = ((bf16*)(wsp(F) + WS_FNT)) + (size_t)(g * 64) * MT + b * N;
#pragma unroll 1
    for (int n = F.tid; n < N; n += NTHREADS) { f32x2 v;
        if (m == 0) { v.x = bf2f(ut[n]); v.y = bf2f(ut[(size_t)32 * MT + n]); }
        else { v.x = bf2f(ut[(size_t)m * MT + n]); v.y = -bf2f(ut[(size_t)(32 + m) * MT + n]); }
        buf[fft_phys(n)] = v; }
    __syncthreads();
    fft8k_fwd(buf, F.tid);
#pragma unroll 1
    for (int pos = F.tid; pos < N; pos += NTHREADS) { const int k = (pos >> 9) + 16 * ((pos >> 5) & 15) + 256 * ((pos >> 1) & 15) + 4096 * (pos & 1);
        const f32x2 v = buf[fft_phys(pos)]; re[k] = v.x; im[k] = v.y; }
    __syncthreads();
    const float scale = 1.0f / sqrtf((float)N * 64.0f);
#pragma unroll 1
    for (int k = F.tid; k < N; k += NTHREADS) { const int nk = (N - k) & (N - 1);
        if (m == 0) { fnt[k] = (bf16)f2bf(0.5f * (re[k] + re[nk]) * scale); fnt[(size_t)32 * MT + k] = (bf16)f2bf(0.5f * (im[k] + im[nk]) * scale); }
        else { fnt[(size_t)m * MT + k] = (bf16)f2bf(re[k] * scale); fnt[(size_t)(64 - m) * MT + k] = (bf16)f2bf(re[nk] * scale); } }
    __syncthreads();
}

__device__ __forceinline__ void attn_item_naive(Frame& F, int l, int r, int kvh, LAS float* wq, LAS float* wp) {
    const int lane = F.lane;
    const bool isctx = r >= ML; const int b = isctx ? ((r - ML) >> 8) : (r >> 13); const int t = r & 8191;
    const int lo = (t - 128) < 0 ? 0 : (t - 128), hi = (t + 128) > (SEQ - 1) ? (SEQ - 1) : (t + 128);
    const int nloc = isctx ? 0 : (hi - lo + 1), nk = nloc + CTXL;
#pragma unroll
    for (int h = 0; h < 4; ++h) wq[h * 64 + lane] = bf2f(((bf16*)(wsp(F) + WS_QK))[(size_t)r * 640 + (4 * kvh + h) * 64 + lane]) * 0.125f;
    LDS_WAIT(); asm volatile("" ::: "memory");
    for (int j = lane; j < nk; j += 64) {
        const int krow = j < nloc ? (b * SEQ + lo + j) : (ML + b * CTXL + (j - nloc));
        const bf16* kp = ((bf16*)(wsp(F) + WS_QK)) + (size_t)krow * 640 + 512 + kvh * 64;
        float s0 = 0.f, s1 = 0.f, s2 = 0.f, s3 = 0.f;
#pragma unroll
        for (int d8 = 0; d8 < 8; ++d8) { const v4u kw = *(const v4u*)(kp + d8 * 8);
            float kf[8]; kf[0] = bflo(kw.x); kf[1] = bfhi(kw.x); kf[2] = bflo(kw.y); kf[3] = bfhi(kw.y); kf[4] = bflo(kw.z); kf[5] = bfhi(kw.z); kf[6] = bflo(kw.w); kf[7] = bfhi(kw.w);
#pragma unroll
            for (int e = 0; e < 8; ++e) { const int d = d8 * 8 + e; s0 += kf[e] * wq[d]; s1 += kf[e] * wq[64 + d]; s2 += kf[e] * wq[128 + d]; s3 += kf[e] * wq[192 + d]; } }
        f32x4 sv; sv[0] = s0; sv[1] = s1; sv[2] = s2; sv[3] = s3;
        *(LAS f32x4*)(wp + j * 4) = sv;
    }
    LDS_WAIT(); asm volatile("" ::: "memory");
    f32x4 mx = {-INFINITY, -INFINITY, -INFINITY, -INFINITY};
    for (int j = lane; j < nk; j += 64) { const f32x4 sv = *(LAS f32x4*)(wp + j * 4);
#pragma unroll
        for (int h = 0; h < 4; ++h) mx[h] = fmaxf(mx[h], sv[h]); }
    f32x4 sink, den;
#pragma unroll
    for (int h = 0; h < 4; ++h) { sink[h] = inp(F, I_SINK)[l * 8 + 4 * kvh + h]; mx[h] = fmaxf(wave_max(mx[h], lane), sink[h]); den[h] = 0.f; }
    for (int j = lane; j < nk; j += 64) { f32x4 sv = *(LAS f32x4*)(wp + j * 4);
#pragma unroll
        for (int h = 0; h < 4; ++h) { sv[h] = __expf(sv[h] - mx[h]); den[h] += sv[h]; }
        *(LAS f32x4*)(wp + j * 4) = sv; }
#pragma unroll
    for (int h = 0; h < 4; ++h) den[h] = wave_sum(den[h], lane) + __expf(sink[h] - mx[h]);
    LDS_WAIT(); asm volatile("" ::: "memory");
    f32x4 o = {0.f, 0.f, 0.f, 0.f};
    for (int j = 0; j < nk; ++j) {
        const int krow = j < nloc ? (b * SEQ + lo + j) : (ML + b * CTXL + (j - nloc));
        const float v = bf2f(((bf16*)(wsp(F) + WS_PR))[(size_t)krow * INW + K_END + kvh * 64 + lane]);
        const f32x4 p = *(LAS f32x4*)(wp + j * 4);
        o += p * v;
    }
#pragma unroll
    for (int h = 0; h < 4; ++h) ((bf16*)(wsp(F) + WS_ATT))[(size_t)r * 512 + (4 * kvh + h) * 64 + lane] = (bf16)f2bf(o[h] / den[h]);
    LDS_WAIT(); asm volatile("" ::: "memory");
}


__device__ __forceinline__ void phase_trans(Frame& F) {
    LAS unsigned* tl = (LAS unsigned*)(F.lds + F.wave * 16640);
    const int gw = F.bid * NWAVES + F.wave, NGW = F.G * NWAVES, lane = F.lane;
    for (int it = gw; it < 2 * 264 * 4; it += NGW) {
        const int which = it / (264 * 4), rem = it % (264 * 4), rt = rem >> 2, ct = rem & 3;
        const bf16* src = which == 0 ? ((const bf16*)(wsp(F) + WS_HYT)) : ((const bf16*)(wsp(F) + WS_FNT));
        bf16* dst = which == 0 ? ((bf16*)(wsp(F) + WS_HYO)) : ((bf16*)(wsp(F) + WS_FNO));
#pragma unroll 8
        for (int ch = 0; ch < 64; ++ch) tl[ch * 65 + lane] = src[(size_t)(ct * 64 + ch) * MT + rt * 64 + lane];
        LDS_WAIT(); asm volatile("" ::: "memory");
#pragma unroll 8
        for (int row = 0; row < 64; ++row) dst[(size_t)(rt * 64 + row) * 256 + ct * 64 + lane] = (bf16)tl[lane * 65 + row];
        LDS_WAIT(); asm volatile("" ::: "memory");
    }
}

__device__ __forceinline__ void phase_mix_naive(Frame& F, int l) {
    { LAS float* wq = (LAS float*)(F.lds + F.wave * 10240); LAS float* wp = wq + 256;
      const int gw = F.bid * NWAVES + F.wave, NGW = F.G * NWAVES;
      for (int it = gw; it < MT * 2; it += NGW) attn_item_naive(F, l, it >> 1, it & 1, wq, wp); }
    __syncthreads();
    for (int c = F.bid; c < 256; c += F.G) hyena_item_fft(F, l, c);
    for (int c = F.bid; c < 256; c += F.G) hyena_item_naive<CTXL>(F, l, c, ML, ((float*)(wsp(F) + WS_HFC)));
    for (int it = F.bid; it < 256; it += F.G) fnet_item_fft(F, it >> 7, (it >> 5) & 3, it & 31);
    for (int it = F.bid; it < 512; it += F.G) fnet_item_naive<CTXL>(F, it >> 8, (it >> 6) & 3, it & 63, ML);
}

constexpr int NPL = 24;
constexpr int NPHASES = 1 + DEPTH * NPL;
#ifndef ONE_LAUNCH
#define ONE_LAUNCH 1
#endif

__global__ void __launch_bounds__(NTHREADS, 2) fwd_kernel(Args args) {
    extern __shared__ __attribute__((aligned(16))) unsigned char lds[];
    Frame F;
    F.lds = (LAS unsigned char*)lds;
    F.tid = threadIdx.x; F.lane = F.tid & 63; F.wave = __builtin_amdgcn_readfirstlane(F.tid >> 6);
    F.G = gridDim.x; F.bid = blockIdx.x;
    unsigned char* ws = args.ws; F.ws = ws;
    F.ctl = (unsigned*)(ws + WS_CTL);
    F.a = &args; F.z = 0;
    volatile LAS unsigned* MISC = (volatile LAS unsigned*)(F.lds + MISC_OFF);
    for (int u = F.tid; u < 64; u += NTHREADS) MISC[u] = 0u;
    __syncthreads();
    const int lo = args.ph_lo, hi = args.ph_hi;
    XcdBarrier bar; bar.bar = F.ctl + CW_BAR; bar.x = 0; bar.st = nullptr;
    if (hi - lo > 1) bar = xcd_barrier_post(F.ctl + CW_BAR, MISC + 8);
#define PH_BEGIN(k) if (lo <= (k) && (k) < hi) { { int t_ = threadIdx.x; asm volatile("" : "+v"(t_)); F.tid = t_; F.lane = t_ & 63; F.wave = __builtin_amdgcn_readfirstlane(t_ >> 6); int z_ = 0; asm volatile("" : "+s"(z_)); F.z = z_; }
#define PH_END(k) if ((k) + 1 < hi) xcd_barrier_impl(bar.bar, bar.x, bar.st); }

    PH_BEGIN(0) phase_prologue(F); PH_END(0)

    for (int l = 0; l < DEPTH; ++l) {
        const int pb = 1 + l * NPL;
        const float* xin_lat = (l == 0) ? inp(F, I_X) : outp(F);
        const float* xin_ctx = (l == 0) ? inp(F, I_CTX) : ((float*)(wsp(F) + WS_XC));
        const float* modl = ((float*)(wsp(F) + WS_CTL) + CW_MOD) + (size_t)l * 3 * 6144;
        const bool moe = (l & 1) != 0; const int fi = l >> 1;

        PH_BEGIN(pb + 0)
            phase_norm<false>(F, l, xin_lat, xin_ctx, inp(F, I_N1G) + l * 1024, 0, nullptr);
            for (int it = F.bid; it < 132; it += F.G) { if (it < 128) filter_tile(F, l, SEQ, it * 64, ((float*)(wsp(F) + WS_HF))); else filter_tile(F, l, CTXL, (it - 128) * 64, ((float*)(wsp(F) + WS_HFC))); }
        PH_END(pb + 0)

        PH_BEGIN(pb + 1)
            pg8::Gemm g{((bf16*)(wsp(F) + WS_H)), ((bf16*)(wsp(F) + WS_WIN)) + (size_t)l * INW * 1024, MT, INW, 1024}; pg8::StaticOrder S; S.init(MT, INW, F.G, F.bid);
            pg8::EpiIn E{((bf16*)(wsp(F) + WS_PR)), INW, ((bf16*)(wsp(F) + WS_UT)), MT};
            pg8::gemm_phase<pg8::EpiIn, pg8::StaticOrder, true, true>(F.lds, g, S, E);
        PH_END(pb + 1)

        PH_BEGIN(pb + 2) phase_qkprep(F, l); PH_END(pb + 2)

        PH_BEGIN(pb + 3) phase_mix_naive(F, l); PH_END(pb + 3)

        PH_BEGIN(pb + 4) phase_trans(F); PH_END(pb + 4)

        PH_BEGIN(pb + 5)
            for (int br = 0; br < 3; ++br) {
                const bf16* A = br == 0 ? ((bf16*)(wsp(F) + WS_ATT)) : (br == 1 ? ((bf16*)(wsp(F) + WS_HYO)) : ((bf16*)(wsp(F) + WS_FNO)));
                const bf16* Bt = br == 0 ? ((bf16*)(wsp(F) + WS_WPA)) + (size_t)l * 1024 * 512 : (br == 1 ? ((bf16*)(wsp(F) + WS_WPH)) + (size_t)l * 1024 * 256 : ((bf16*)(wsp(F) + WS_WPF)) + (size_t)l * 1024 * 256);
                const int K = br == 0 ? 512 : 256;
                pg8::Gemm g{A, Bt, MT, 1024, K}; pg8::StaticOrder S; S.init(MT, 1024, F.G, F.bid);
                pg8::EpiMerge E{((bf16*)(wsp(F) + WS_PR)), ((float*)(wsp(F) + WS_MACC)), ((bf16*)(wsp(F) + WS_M)), br};
                pg8::gemm_phase<pg8::EpiMerge, pg8::StaticOrder, true, true>(F.lds, g, S, E);
                __syncthreads();
            }
        PH_END(pb + 5)

        PH_BEGIN(pb + 6)
            pg8::Gemm g{((bf16*)(wsp(F) + WS_M)), ((bf16*)(wsp(F) + WS_WO)) + (size_t)l * 1024 * 1024, MT, 1024, 1024}; pg8::StaticOrder S; S.init(MT, 1024, F.G, F.bid);
            pg8::EpiResid E{xin_lat, xin_ctx, outp(F), ((float*)(wsp(F) + WS_XC)), modl + 2048, nullptr};
            pg8::gemm_phase<pg8::EpiResid, pg8::StaticOrder, true, true>(F.lds, g, S, E);
        PH_END(pb + 6)

        PH_BEGIN(pb + 7)
            if (moe) phase_norm<true>(F, l, outp(F), ((float*)(wsp(F) + WS_XC)), inp(F, I_N2G) + l * 1024, 3072, inp(F, I_ROUTER) + (size_t)fi * 1024 * 8);
            else phase_norm<false>(F, l, outp(F), ((float*)(wsp(F) + WS_XC)), inp(F, I_N2G) + l * 1024, 3072, nullptr);
        PH_END(pb + 7)

        const int ne = moe ? NEXP : 1;
        for (int e = 0; e < ne; ++e) {
            const bf16* Wgu = moe ? ((bf16*)(wsp(F) + WS_MGU)) + (size_t)(fi * 8 + e) * 5632 * 1024 : ((bf16*)(wsp(F) + WS_FGU)) + (size_t)fi * 5632 * 1024;
            const bf16* Wd = moe ? ((bf16*)(wsp(F) + WS_MD)) + (size_t)(fi * 8 + e) * 1024 * 2816 : ((bf16*)(wsp(F) + WS_FD)) + (size_t)fi * 1024 * 2816;
            PH_BEGIN(pb + 8 + 2 * e)
                pg8::Gemm g{((bf16*)(wsp(F) + WS_H)), Wgu, MT, 5632, 1024}; pg8::StaticOrder S; S.init(MT, 5632, F.G, F.bid);
                pg8::EpiSwiglu E{((bf16*)(wsp(F) + WS_HID)), DFF};
                pg8::gemm_phase<pg8::EpiSwiglu, pg8::StaticOrder, true, true>(F.lds, g, S, E);
            PH_END(pb + 8 + 2 * e)
            PH_BEGIN(pb + 9 + 2 * e)
                pg8::Gemm g{((bf16*)(wsp(F) + WS_HID)), Wd, MT, 1024, DFF}; pg8::StaticOrder S; S.init(MT, 1024, F.G, F.bid);
                pg8::EpiResid E{outp(F), ((float*)(wsp(F) + WS_XC)), outp(F), ((float*)(wsp(F) + WS_XC)), modl + 5120, moe ? ((float*)(wsp(F) + WS_COMB)) + e : nullptr};
                pg8::gemm_phase<pg8::EpiResid, pg8::StaticOrder, true, true>(F.lds, g, S, E);
            PH_END(pb + 9 + 2 * e)
        }
    }
#undef PH_BEGIN
#undef PH_END
}

extern "C" void kernel_launch(void* const* d_in, const int* in_sizes, int n_in, void* d_out, int out_size, void* d_ws, size_t ws_size, hipStream_t stream) {
    static int grid = 0;
    if (grid == 0) {
        if (n_in != 33 || out_size != ML * DM || ws_size < WS_END2) { fprintf(stderr, "kernel_launch: unexpected shapes (n_in %d out %d ws %zu need %zu)\n", n_in, out_size, ws_size, (size_t)WS_END2); grid = -1; return; }
        int dev = 0, cus = 0, per_cu = 0;
        if (hipGetDevice(&dev) != hipSuccess || hipDeviceGetAttribute(&cus, hipDeviceAttributeMultiprocessorCount, dev) != hipSuccess) { grid = -1; return; }
        if (hipFuncSetAttribute((const void*)fwd_kernel, hipFuncAttributeMaxDynamicSharedMemorySize, LDS_BYTES) != hipSuccess) { fprintf(stderr, "kernel_launch: hipFuncSetAttribute failed\n"); grid = -1; return; }
        if (hipOccupancyMaxActiveBlocksPerMultiprocessor(&per_cu, (const void*)fwd_kernel, NTHREADS, LDS_BYTES) != hipSuccess || per_cu < 1) { fprintf(stderr, "kernel_launch: occupancy query says %d\n", per_cu); }
        (void)hipGetLastError();
        grid = cus;
    }
    if (grid < 0) return;
    if (hipMemsetAsync((char*)d_ws + WS_CTL, 0, CTL_ZERO_BYTES, stream) != hipSuccess) return;
    Args a{};
    for (int i = 0; i < 33; ++i) a.in[i] = (const float*)d_in[i];
    a.in[33] = (const float*)d_out; a.ws = (unsigned char*)d_ws;
#if ONE_LAUNCH
    a.ph_lo = 0; a.ph_hi = NPHASES;
    hipLaunchKernelGGL(fwd_kernel, dim3(grid), dim3(NTHREADS), LDS_BYTES, stream, a);
#else
    for (int k = 0; k < NPHASES; ++k) {
        if (k >= 1) { const int l = (k - 1) / NPL, p = (k - 1) % NPL; if ((l & 1) == 0 && p >= 10) continue; }
        a.ph_lo = k; a.ph_hi = k + 1;
        hipLaunchKernelGGL(fwd_kernel, dim3(grid), dim3(NTHREADS), LDS_BYTES, stream, a);
    }
#endif
}
```

```cpp
#include <hip/hip_runtime.h>
#include <cstdio>
#include <cstdint>
namespace pg8 {
#define PG8_LAS __attribute__((address_space(3)))
typedef unsigned short bf16_t;
typedef short bf16x8 __attribute__((ext_vector_type(8)));
typedef float f32x4 __attribute__((ext_vector_type(4)));
typedef unsigned u32x4 __attribute__((ext_vector_type(4)));
constexpr int BM = 256, BK = 64, HALF = 128, HTB = HALF * BK * 2  , STAGE_BYTES = 8 * HTB, NXCD = 8, WGM = 8;

__host__ __device__ __forceinline__ int lds_byte(int r, int c) { const int st = (r >> 4) * 2 + (c >> 5), rr = r & 15, cc = c & 31, ob = rr * 64 + cc * 2; return st * 1024 + (ob ^ (((ob >> 9) & 1) << 5)); }
__host__ __device__ __forceinline__ void stage_rc(int b, int& R, int& C) { const int st = b / 1024, sb = b % 1024, swz = sb ^ (((sb >> 9) & 1) << 5); R = (st >> 1) * 16 + swz / 64; C = (st & 1) * 32 + (swz % 64) / 2; }
__host__ __device__ __forceinline__ int perm32(int rho) { const int n = rho >> 4, i = rho & 15; return 8 * (i >> 2) + 4 * n + (i & 3); }

struct Unit { int pm, pn; };
struct Gemm { const bf16_t* A; const bf16_t* Bt; int M, N, K; };

struct StaticOrder {
    int nM, nN, nwg, G, c;
    __host__ __device__ void init(int M, int N, int G_, int c_) { nM = M / BM; nN = N / BM; nwg = nM * nN; G = G_; c = c_; }
    __host__ __device__ bool next(int i, Unit& u) const {
        const long L = (long)i * G + c; if (L >= nwg) return false;
        int wgid = (int)L; { const int q = nwg / NXCD, r = nwg % NXCD, xcd = wgid % NXCD, off = wgid / NXCD; wgid = (xcd < r ? xcd * (q + 1) : r * (q + 1) + (xcd - r) * q) + off; }
        const int nig = WGM * nN, gid = wgid / nig, fm = gid * WGM, gsz = (nM - fm) < WGM ? (nM - fm) : WGM;
        u.pm = fm + ((wgid % nig) % gsz); u.pn = (wgid % nig) / gsz; return true;
    }
    __device__ __forceinline__ void a_ready(const Unit&) const {}
    __device__ __forceinline__ void done(const Unit&) const {}
};

__device__ __forceinline__ unsigned cvt_pk_bf16(float lo, float hi) { unsigned r; asm volatile("v_cvt_pk_bf16_f32 %0, %1, %2" : "=v"(r) : "v"(lo), "v"(hi)); return r; }
typedef float f32x2 __attribute__((ext_vector_type(2)));
template <class Epi, class Sched, bool ALIGN_EPI = false, bool SP2 = false>
__device__ __forceinline__ void gemm_phase(PG8_LAS unsigned char* lds, const Gemm g, const Sched& S, const Epi& E) {
    int tid_ = threadIdx.x; asm volatile("" : "+v"(tid_)); const int tid = tid_, wid = __builtin_amdgcn_readfirstlane(tid >> 6), lane = tid & 63, wr = wid >> 2, wc = wid & 3, fr = lane & 15, fq = lane >> 4;
    const int K = g.K, nt = K / BK;
    unsigned voffA[2], voffB[2];
#pragma unroll
    for (int i = 0; i < 2; ++i) { int R, C; stage_rc(tid * 16 + i * 8192, R, C); const int Rb = Epi::PERM ? ((R & ~31) + perm32(R & 31)) : R;
        voffA[i] = (unsigned)(R * K + C) * 2u; voffB[i] = (unsigned)(Rb * K + C) * 2u; }
    const size_t kstep = (size_t)(BK * 2);
    const size_t hstep = (size_t)HALF * K * 2;
    const size_t tstep = 2 * hstep;
    const unsigned ldsw = (unsigned)wid * 1024u;
    const int aoff = lds_byte(wr * 64 + fr, fq * 8), boff = lds_byte(wc * 32 + fr, fq * 8);
#define PG8_SA(b, h) (((b) * 2 + (h)) * HTB)
#define PG8_SB(b, h) ((4 + (b) * 2 + (h)) * HTB)
#define PG8_STAGE(bufoff, gbase, voff) do { _Pragma("unroll") for (int _i = 0; _i < 2; ++_i) \
        __builtin_amdgcn_global_load_lds((const unsigned*)((const char*)(gbase) + (voff)[_i]), (PG8_LAS unsigned*)(lds + (bufoff) + ldsw + _i * 8192), 16, 0, 0); } while (0)
#define PG8_LDA(dst, b, h) do { _Pragma("unroll") for (int m = 0; m < 4; ++m) _Pragma("unroll") for (int k = 0; k < 2; ++k) dst[m][k] = *(const PG8_LAS bf16x8*)(lds + PG8_SA(b, h) + aoff + m * 2048 + k * 1024); } while (0)
#define PG8_LDB(dst, b, h) do { _Pragma("unroll") for (int n = 0; n < 2; ++n) _Pragma("unroll") for (int k = 0; k < 2; ++k) dst[n][k] = *(const PG8_LAS bf16x8*)(lds + PG8_SB(b, h) + boff + n * 2048 + k * 1024); } while (0)
#define PG8_MMA(ai, bj, At, Bt) do { __builtin_amdgcn_s_setprio(1); _Pragma("unroll") for (int m = 0; m < 4; ++m) _Pragma("unroll") for (int n = 0; n < 2; ++n) _Pragma("unroll") for (int k = 0; k < 2; ++k) \
        acc[ai][bj][m][n] = __builtin_amdgcn_mfma_f32_16x16x32_bf16(Bt[n][k], At[m][k], acc[ai][bj][m][n], 0, 0, 0); __builtin_amdgcn_s_setprio(0); } while (0)
#define PG8_WAIT_V(n) asm volatile("s_waitcnt vmcnt(" #n ")" ::: "memory")
#define PG8_WAIT_L(n) asm volatile("s_waitcnt lgkmcnt(" #n ")" ::: "memory")
#define PG8_BAR __builtin_amdgcn_s_barrier()
#define PG8_SCHED __builtin_amdgcn_sched_barrier(0)
    Unit cur, nxt; int ui = 0;
    if (!S.next(0, cur)) return;
    f32x4 acc[2][2][4][2];
#pragma unroll
    for (int a = 0; a < 2; ++a)
#pragma unroll
        for (int b = 0; b < 2; ++b)
#pragma unroll
            for (int m = 0; m < 4; ++m)
#pragma unroll
                for (int n = 0; n < 2; ++n) acc[a][b][m][n] = (f32x4){0.f, 0.f, 0.f, 0.f};
    bf16x8 At[4][2], B0[2][2], B1[2][2];
    const char* cA = (const char*)g.A + (size_t)cur.pm * tstep; const char* cB = (const char*)g.Bt + (size_t)cur.pn * tstep;
    S.a_ready(cur);
    if constexpr (SP2) {
        PG8_STAGE(PG8_SB(0, 0), cB, voffB); PG8_STAGE(PG8_SB(0, 1), cB + hstep, voffB); PG8_STAGE(PG8_SA(0, 0), cA, voffA); PG8_STAGE(PG8_SA(0, 1), cA + hstep, voffA);
        if (wr == 1) PG8_BAR;
        PG8_WAIT_V(2); PG8_BAR;
        PG8_STAGE(PG8_SB(1, 0), cB + kstep, voffB); PG8_STAGE(PG8_SA(1, 0), cA + kstep, voffA); PG8_STAGE(PG8_SB(1, 1), cB + hstep + kstep, voffB);
        PG8_WAIT_V(6); PG8_BAR;
    } else {
        PG8_STAGE(PG8_SB(0, 0), cB, voffB); PG8_STAGE(PG8_SA(0, 0), cA, voffA); PG8_STAGE(PG8_SB(0, 1), cB + hstep, voffB); PG8_STAGE(PG8_SA(0, 1), cA + hstep, voffA);
        if (wr == 1) PG8_BAR;
        PG8_WAIT_V(4); PG8_BAR;
        PG8_STAGE(PG8_SB(1, 0), cB + kstep, voffB); PG8_STAGE(PG8_SA(1, 0), cA + kstep, voffA); PG8_STAGE(PG8_SB(1, 1), cB + hstep + kstep, voffB);
        PG8_WAIT_V(6); PG8_BAR;
    }
    for (;;) {
        const bool has_next = S.next(ui + 1, nxt);
        const char* nA = has_next ? (const char*)g.A + (size_t)nxt.pm * tstep : cA; const char* nB = has_next ? (const char*)g.Bt + (size_t)nxt.pn * tstep : cB;
        for (int t = 0; t < nt; t += 2) {
            const bool last = (t == nt - 2);
            const char* a1 = cA + (size_t)(t + 1) * kstep;
            const char* a2 = last ? nA : cA + (size_t)(t + 2) * kstep; const char* b2 = last ? nB : cB + (size_t)(t + 2) * kstep;
            const char* a3 = a2 + kstep; const char* b3 = b2 + kstep;
            if (last && has_next) S.a_ready(nxt);
            if constexpr (SP2) {
            PG8_LDB(B0, 0, 0); PG8_LDB(B1, 0, 1); PG8_SCHED; PG8_LDA(At, 0, 0); PG8_STAGE(PG8_SA(1, 1), a1 + hstep, voffA);
            PG8_WAIT_V(8); PG8_WAIT_L(0); PG8_BAR; PG8_MMA(0, 0, At, B0); PG8_MMA(0, 1, At, B1); PG8_BAR; PG8_SCHED;
            PG8_LDA(At, 0, 1); PG8_STAGE(PG8_SB(0, 0), b2, voffB); PG8_STAGE(PG8_SB(0, 1), b2 + hstep, voffB); PG8_STAGE(PG8_SA(0, 0), a2, voffA);
            PG8_WAIT_V(8); PG8_WAIT_L(0); PG8_BAR; PG8_MMA(1, 0, At, B0); PG8_MMA(1, 1, At, B1); PG8_BAR; PG8_SCHED;
            PG8_LDB(B0, 1, 0); PG8_LDB(B1, 1, 1); PG8_SCHED; PG8_LDA(At, 1, 0); PG8_STAGE(PG8_SA(0, 1), a2 + hstep, voffA);
            PG8_WAIT_V(8); PG8_WAIT_L(0); PG8_BAR; PG8_MMA(0, 0, At, B0); PG8_MMA(0, 1, At, B1); PG8_BAR; PG8_SCHED;
            PG8_LDA(At, 1, 1); PG8_STAGE(PG8_SB(1, 0), b3, voffB); PG8_STAGE(PG8_SB(1, 1), b3 + hstep, voffB); PG8_STAGE(PG8_SA(1, 0), a3, voffA);
            PG8_WAIT_V(8); PG8_WAIT_L(0); PG8_BAR; PG8_MMA(1, 0, At, B0); PG8_MMA(1, 1, At, B1); PG8_BAR; PG8_SCHED;
            } else {
            PG8_LDB(B0, 0, 0); PG8_SCHED; PG8_LDA(At, 0, 0); PG8_STAGE(PG8_SA(1, 1), a1 + hstep, voffA);
            PG8_WAIT_L(8); PG8_BAR; PG8_WAIT_L(0); PG8_MMA(0, 0, At, B0); PG8_BAR; PG8_SCHED;
            PG8_LDB(B1, 0, 1); PG8_STAGE(PG8_SB(0, 0), b2, voffB);
            PG8_BAR; PG8_WAIT_L(0); PG8_MMA(0, 1, At, B1); PG8_BAR;
            PG8_LDA(At, 0, 1); PG8_STAGE(PG8_SA(0, 0), a2, voffA);
            PG8_BAR; PG8_WAIT_L(0); PG8_MMA(1, 0, At, B0); PG8_BAR; PG8_SCHED;
            PG8_STAGE(PG8_SB(0, 1), b2 + hstep, voffB);
            PG8_WAIT_V(6); PG8_BAR; PG8_MMA(1, 1, At, B1); PG8_BAR;
            PG8_LDB(B0, 1, 0); PG8_SCHED; PG8_LDA(At, 1, 0); PG8_STAGE(PG8_SA(0, 1), a2 + hstep, voffA);
            PG8_WAIT_L(8); PG8_BAR; PG8_WAIT_L(0); PG8_MMA(0, 0, At, B0); PG8_BAR; PG8_SCHED;
            PG8_LDB(B1, 1, 1); PG8_STAGE(PG8_SB(1, 0), b3, voffB);
            PG8_BAR; PG8_WAIT_L(0); PG8_MMA(0, 1, At, B1); PG8_BAR;
            PG8_LDA(At, 1, 1); PG8_STAGE(PG8_SA(1, 0), a3, voffA);
            PG8_BAR; PG8_WAIT_L(0); PG8_MMA(1, 0, At, B0); PG8_BAR; PG8_SCHED;
            PG8_STAGE(PG8_SB(1, 1), b3 + hstep, voffB);
            PG8_WAIT_V(6); PG8_BAR; PG8_MMA(1, 1, At, B1); PG8_BAR;
            }
        }
        if constexpr (ALIGN_EPI) { if (wr == 0) PG8_BAR; }
        if constexpr (!Epi::AFTER_DRAIN) { E(acc, cur, wr, wc, fr, fq); S.done(cur); }
        if (!has_next) break;
#pragma unroll
        for (int a = 0; a < 2; ++a)
#pragma unroll
            for (int b = 0; b < 2; ++b)
#pragma unroll
                for (int m = 0; m < 4; ++m)
#pragma unroll
                    for (int n = 0; n < 2; ++n) acc[a][b][m][n] = (f32x4){0.f, 0.f, 0.f, 0.f};
        cur = nxt; cA = nA; cB = nB; ++ui;
        if constexpr (ALIGN_EPI) { if (wr == 1) PG8_BAR; }
    }
    PG8_WAIT_V(0);
    if constexpr (!ALIGN_EPI) { if (wr == 0) PG8_BAR; }
    PG8_BAR;
    if constexpr (Epi::AFTER_DRAIN) { E.fused(acc, cur, wr, wc, fr, fq, lds, wid, lane); S.done(cur); }
#undef PG8_SA
#undef PG8_SB
#undef PG8_STAGE
#undef PG8_LDA
#undef PG8_LDB
#undef PG8_MMA
#undef PG8_WAIT_V
#undef PG8_WAIT_L
#undef PG8_BAR
#undef PG8_SCHED
}
}

constexpr int NWAVES = 8, NTHREADS = 512;
constexpr int BATCH = 2, SEQ = 8192, DM = 1024, DEPTH = 4, CTXL = 256;
constexpr int ML = BATCH * SEQ;
constexpr int MC = BATCH * CTXL;
constexpr int MT = ML + MC;
constexpr int HD = 64, NH = 8, NKV = 2;
constexpr int QW = 512, KVW = 128;
constexpr int HYW = 256, FNW = 256;
constexpr int Q_END = 512, K_END = 640, V_END = 768, HY_END = 1536, FN_END = 1792, INW = 4864;
constexpr int DFF = 2816, NEXP = 8;
constexpr int FH = 64, FEMB = 33;
constexpr float EPS = 1e-6f;

constexpr size_t MiB = 1u << 20;
constexpr size_t WS_CTL = 0, CTL_ZERO_BYTES = 4 * MiB;
constexpr size_t WS_WIN = 4 * MiB;
constexpr size_t WS_WPA = WS_WIN + 38 * MiB;
constexpr size_t WS_WPH = WS_WPA + 4 * MiB;
constexpr size_t WS_WPF = WS_WPH + 2 * MiB;
constexpr size_t WS_WO = WS_WPF + 2 * MiB;
constexpr size_t WS_FGU = WS_WO + 8 * MiB;
constexpr size_t WS_FD = WS_FGU + 22 * MiB;
constexpr size_t WS_MGU = WS_FD + 11 * MiB;
constexpr size_t WS_MD = WS_MGU + 176 * MiB;
constexpr size_t WS_XC = WS_MD + 88 * MiB;
constexpr size_t WS_H = WS_XC + 2 * MiB;
constexpr size_t WS_COMB = WS_H + 33 * MiB;
constexpr size_t WS_HF = WS_COMB + 1 * MiB;
constexpr size_t WS_HFC = WS_HF + 32 * MiB;
constexpr size_t WS_S = WS_HFC + 1 * MiB;
constexpr size_t WS_PR = WS_S;
constexpr size_t WS_QK = WS_PR + 157 * MiB;
constexpr size_t WS_ATT = WS_QK + 21 * MiB;
constexpr size_t WS_HYO = WS_ATT + 17 * MiB;
constexpr size_t WS_FNO = WS_HYO + 9 * MiB;
constexpr size_t WS_MACC = WS_FNO + 9 * MiB;
constexpr size_t WS_M = WS_MACC + 66 * MiB;
constexpr size_t WS_END = WS_M + 33 * MiB;
constexpr size_t WS_KS = WS_MACC;
constexpr size_t WS_ZS = WS_MACC + 32 * MiB;
constexpr size_t WS_HYT = WS_MACC + 48 * MiB;
constexpr size_t WS_FNT = WS_MACC + 57 * MiB;
constexpr size_t WS_CTMP = WS_M;
constexpr size_t WS_UT = WS_END;
constexpr size_t WS_VT = WS_UT + 33 * MiB;
constexpr size_t WS_END2 = WS_VT + 5 * MiB;
constexpr size_t WS_HID = WS_S;
static_assert((size_t)MT * INW * 2 <= 157 * MiB && (size_t)MT * DFF * 2 <= 157 * MiB, "scratch sizes");
constexpr int CW_BAR = 4096;
constexpr int CW_MOD = 262144;
static_assert((CW_MOD + 4 * 3 * 6144) * 4 <= (int)CTL_ZERO_BYTES, "ctl");

constexpr int LDS_BYTES = 147456;
constexpr int MISC_OFF = LDS_BYTES - 256;

#define LAS __attribute__((address_space(3)))
typedef unsigned short bf16;
typedef unsigned v4u __attribute__((ext_vector_type(4)));
typedef unsigned v2u __attribute__((ext_vector_type(2)));
typedef float f32x4 __attribute__((ext_vector_type(4)));
typedef float f32x2 __attribute__((ext_vector_type(2)));
#define LDS_WAIT() asm volatile("s_waitcnt lgkmcnt(0)" ::: "memory")
__device__ __forceinline__ unsigned f2bf(float f) { unsigned u = __builtin_bit_cast(unsigned, f); return (u + 0x7fffu + ((u >> 16) & 1u)) >> 16; }
__device__ __forceinline__ unsigned pk2(float lo, float hi) { return f2bf(lo) | (f2bf(hi) << 16); }
__device__ __forceinline__ float bf2f(unsigned short h) { return __builtin_bit_cast(float, (unsigned)h << 16); }
__device__ __forceinline__ float bflo(unsigned w) { return __builtin_bit_cast(float, w << 16); }
__device__ __forceinline__ float bfhi(unsigned w) { return __builtin_bit_cast(float, w & 0xffff0000u); }
__device__ __forceinline__ float shx(float v, int lane, int o) { return __builtin_bit_cast(float, __builtin_amdgcn_ds_bpermute((lane ^ o) << 2, __builtin_bit_cast(int, v))); }
__device__ __forceinline__ float wave_sum(float v, int lane) {
#pragma unroll
    for (int o = 1; o < 64; o <<= 1) v += shx(v, lane, o);
    return v;
}
__device__ __forceinline__ float wave_max(float v, int lane) {
#pragma unroll
    for (int o = 1; o < 64; o <<= 1) v = fmaxf(v, shx(v, lane, o));
    return v;
}
__device__ __forceinline__ float sin_rev(float r) { return __builtin_amdgcn_sinf(__builtin_amdgcn_fractf(r)); }
__device__ __forceinline__ float cos_rev(float r) { return __builtin_amdgcn_cosf(__builtin_amdgcn_fractf(r)); }
__device__ __forceinline__ float sigmoidf_(float x) { return __builtin_amdgcn_rcpf(1.0f + __expf(-x)); }
constexpr float INV_2PI = 0.15915494309189535f;

#define XB_TMO      128
#define XB_XCNT(j)  (256  + 64 * (j))
#define XB_XSUB(j)  (1280 + 64 * (j))
#define XB_XGEN(j)  (2304 + 64 * (j))
#define XB_TOP      3328
#define XB_TOPGEN   3392
#define XCD_BAR_WORDS 3456
#define XB_SPIN_CAP (1u << 18)

__device__ __forceinline__ unsigned xb_ld(unsigned* p)              { return __hip_atomic_load(p, __ATOMIC_RELAXED, __HIP_MEMORY_SCOPE_AGENT); }
__device__ __forceinline__ unsigned xb_add(unsigned* p, unsigned v) { return __hip_atomic_fetch_add(p, v, __ATOMIC_RELAXED, __HIP_MEMORY_SCOPE_AGENT); }
__device__ __forceinline__ unsigned xb_xcc_id() { return (unsigned)__builtin_amdgcn_s_getreg((3 << 11) | 20) & 0xFu; }
#define XB_SPIN(cond, bar) do { unsigned _sp = 0; while (cond) { __builtin_amdgcn_s_sleep(1); \
    if ((++_sp & 255u) == 0u) { if (xb_ld(&(bar)[XB_TMO])) break; if (_sp > XB_SPIN_CAP) { atomicAdd(&(bar)[XB_TMO], 1u); break; } } } } while (0)

struct XcdBarrier {
    unsigned* bar; unsigned x;
    volatile LAS unsigned* st;
};

__device__ __forceinline__ XcdBarrier xcd_barrier_post(unsigned* bar, volatile LAS unsigned* st) {
    XcdBarrier b; b.bar = bar; b.x = xb_xcc_id(); b.st = st;
    if (threadIdx.x == 0) (void)xb_add(&bar[XB_XCNT(b.x)], 1u);
    return b;
}
__device__ __forceinline__ void xcd_barrier_complete(unsigned* bar, unsigned x, unsigned& nloc, unsigned& nx) {
    const unsigned G = gridDim.x * gridDim.y * gridDim.z;
    unsigned sum, cnt, mine, sp = 0u;
    for (;;) {
        sum = 0u; cnt = 0u; mine = 0u;
#pragma unroll
        for (unsigned j = 0; j < 16; ++j) { const unsigned c = xb_ld(&bar[XB_XCNT(j)]); sum += c; cnt += (c > 0u) ? 1u : 0u; mine = (j == x) ? c : mine; }
        if (sum == G) break;
        __builtin_amdgcn_s_sleep(1);
        if ((++sp & 255u) == 0u) { if (xb_ld(&bar[XB_TMO])) break; if (sp > XB_SPIN_CAP) { atomicAdd(&bar[XB_TMO], 1u); break; } }
    }
    nloc = mine > 0u ? mine : 1u; nx = cnt > 0u ? cnt : 1u;
}

__device__ __attribute__((noinline)) void xcd_barrier_impl(unsigned* b_bar, unsigned b_x, volatile LAS unsigned* b_st) {
    XcdBarrier b; b.bar = b_bar; b.x = b_x; b.st = b_st;
    asm volatile("s_waitcnt vmcnt(0)" ::: "memory");
    __syncthreads();
    if (threadIdx.x == 0) {
        unsigned* bar = b.bar;
        __builtin_amdgcn_s_waitcnt(0);
        unsigned nloc = b.st[0], nx = b.st[1];
        if (nloc == 0u) { xcd_barrier_complete(bar, b.x, nloc, nx); b.st[0] = nloc; b.st[1] = nx; }
        const unsigned old = xb_add(&bar[XB_XSUB(b.x)], 1u);
        const unsigned gen = old / nloc;
        if (old + 1u == (gen + 1u) * nloc) {
            __builtin_amdgcn_fence(__ATOMIC_RELEASE, "agent");
            asm volatile("s_waitcnt vmcnt(0)" ::: "memory");
            const unsigned og = xb_add(&bar[XB_TOP], 1u);
            const unsigned tg = og / nx;
            if (og + 1u == (tg + 1u) * nx) xb_add(&bar[XB_TOPGEN], 1u);
            else XB_SPIN(xb_ld(&bar[XB_TOPGEN]) == tg, bar);
            __builtin_amdgcn_fence(__ATOMIC_ACQUIRE, "agent");
            xb_add(&bar[XB_XGEN(b.x)], 1u);
            asm volatile("s_waitcnt vmcnt(0)" ::: "memory");
        } else {
            XB_SPIN(xb_ld(&bar[XB_XGEN(b.x)]) == gen, bar);
            __builtin_amdgcn_fence(__ATOMIC_ACQUIRE, "agent");
            asm volatile("s_waitcnt vmcnt(0)" ::: "memory");
        }
    }
    __syncthreads();
}

struct Args { const float* in[34]; unsigned char* ws; int ph_lo, ph_hi; };
struct Frame {
    LAS unsigned char* lds;
    unsigned* ctl;
    unsigned char* ws;
    int tid, lane, wave, G, bid;
    const struct Args* a; int z;
};
__device__ __forceinline__ const float* inp(const Frame& F, int i) { return F.a->in[i + F.z]; }
__device__ __forceinline__ float* outp(const Frame& F) { return (float*)F.a->in[33 + F.z]; }
__device__ __forceinline__ unsigned char* wsp(const Frame& F) { return F.a->ws + F.z; }
enum { I_X = 0, I_C, I_CTX, I_CCTX, I_WADA, I_BADA, I_N1G, I_N2G, I_WIN, I_QG, I_KG, I_SINK, I_HCW, I_HCB, I_FW1, I_FB1, I_FF1, I_FW2, I_FB2, I_FF2, I_FW3, I_HBIAS,
       I_WPA, I_WPH, I_WPF, I_WOUT, I_FG, I_FU, I_FDN, I_ROUTER, I_MG, I_MU, I_MDN };

namespace pg8 {
struct EpiStore {
    static constexpr bool PERM = true, AFTER_DRAIN = false;
    bf16_t* O; int ldc;
    __device__ __forceinline__ void operator()(const f32x4 (&acc)[2][2][4][2], const Unit& u, int wr, int wc, int fr, int fq) const {
        const int row0 = u.pm * BM + wr * 64 + fr, col0 = u.pn * BM + wc * 32 + 8 * fq;
#pragma unroll
        for (int ai = 0; ai < 2; ++ai)
#pragma unroll
            for (int m = 0; m < 4; ++m) { bf16_t* rowp = O + (size_t)(row0 + ai * HALF + m * 16) * ldc + col0;
#pragma unroll
                for (int bj = 0; bj < 2; ++bj) { const f32x4 v0 = acc[ai][bj][m][0], v1 = acc[ai][bj][m][1];
                    u32x4 w; w.x = cvt_pk_bf16(v0[0], v0[1]); w.y = cvt_pk_bf16(v0[2], v0[3]); w.z = cvt_pk_bf16(v1[0], v1[1]); w.w = cvt_pk_bf16(v1[2], v1[3]);
                    *(u32x4*)(rowp + bj * HALF) = w; } }
    }
};
struct EpiIn {
    static constexpr bool PERM = true, AFTER_DRAIN = false;
    bf16_t* O; int ldc; bf16_t* UT; bf16_t* VT; int mt;
    __device__ __forceinline__ void operator()(const f32x4 (&acc)[2][2][4][2], const Unit& u, int wr, int wc, int fr, int fq) const {
        const int row0 = u.pm * BM + wr * 64 + fr, col0 = u.pn * BM + wc * 32 + 8 * fq;
        if (u.pn == 2) {
#pragma unroll
            for (int ai = 0; ai < 2; ++ai) {
#pragma unroll
                for (int m = 0; m < 4; ++m) { bf16_t* rowp = O + (size_t)(row0 + ai * HALF + m * 16) * ldc + col0; const f32x4 v0 = acc[ai][0][m][0], v1 = acc[ai][0][m][1];
                    u32x4 w; w.x = cvt_pk_bf16(v0[0], v0[1]); w.y = cvt_pk_bf16(v0[2], v0[3]); w.z = cvt_pk_bf16(v1[0], v1[1]); w.w = cvt_pk_bf16(v1[2], v1[3]); *(u32x4*)rowp = w; }
#pragma unroll
                for (int n = 0; n < 2; ++n)
#pragma unroll
                    for (int e = 0; e < 4; ++e) { bf16_t* cp = VT + (unsigned)((wc * 32 + 8 * fq + n * 4 + e) * mt + row0 + ai * HALF);
#pragma unroll
                        for (int m = 0; m < 4; ++m) cp[m * 16] = (bf16_t)(cvt_pk_bf16(acc[ai][1][m][n][e], 0.f) & 0xffffu); }
            }
        } else if (u.pn >= 3 && u.pn < 7) {
#pragma unroll
            for (int ai = 0; ai < 2; ++ai)
#pragma unroll
                for (int bj = 0; bj < 2; ++bj)
#pragma unroll
                    for (int n = 0; n < 2; ++n)
#pragma unroll
                        for (int e = 0; e < 4; ++e) { bf16_t* cp = UT + (unsigned)((col0 - 768 + bj * HALF + n * 4 + e) * mt + row0 + ai * HALF);
#pragma unroll
                            for (int m = 0; m < 4; ++m) cp[m * 16] = (bf16_t)(cvt_pk_bf16(acc[ai][bj][m][n][e], 0.f) & 0xffffu); }
        } else {
#pragma unroll
            for (int ai = 0; ai < 2; ++ai)
#pragma unroll
                for (int m = 0; m < 4; ++m) { bf16_t* rowp = O + (size_t)(row0 + ai * HALF + m * 16) * ldc + col0;
#pragma unroll
                    for (int bj = 0; bj < 2; ++bj) { const f32x4 v0 = acc[ai][bj][m][0], v1 = acc[ai][bj][m][1];
                        u32x4 w; w.x = cvt_pk_bf16(v0[0], v0[1]); w.y = cvt_pk_bf16(v0[2], v0[3]); w.z = cvt_pk_bf16(v1[0], v1[1]); w.w = cvt_pk_bf16(v1[2], v1[3]);
                        *(u32x4*)(rowp + bj * HALF) = w; } }
        }
    }
};
struct EpiSwiglu {
    static constexpr bool PERM = true, AFTER_DRAIN = false;
    bf16_t* O; int ldc;
    __device__ __forceinline__ void operator()(const f32x4 (&acc)[2][2][4][2], const Unit& u, int wr, int wc, int fr, int fq) const {
        const int row0 = u.pm * BM + wr * 64 + fr, col0 = u.pn * HALF + wc * 32 + 8 * fq;
#pragma unroll
        for (int ai = 0; ai < 2; ++ai)
#pragma unroll
            for (int m = 0; m < 4; ++m) { bf16_t* rowp = O + (size_t)(row0 + ai * HALF + m * 16) * ldc + col0;
                float h[8];
#pragma unroll
                for (int n = 0; n < 2; ++n)
#pragma unroll
                    for (int e = 0; e < 4; ++e) { const float g = acc[ai][0][m][n][e], uu = acc[ai][1][m][n][e]; h[n * 4 + e] = g * __builtin_amdgcn_rcpf(1.0f + __expf(-g)) * uu; }
                u32x4 w; w.x = cvt_pk_bf16(h[0], h[1]); w.y = cvt_pk_bf16(h[2], h[3]); w.z = cvt_pk_bf16(h[4], h[5]); w.w = cvt_pk_bf16(h[6], h[7]);
                *(u32x4*)rowp = w; }
    }
};
struct EpiMerge {
    static constexpr bool PERM = false, AFTER_DRAIN = false;
    const bf16_t* PR; float* MACC; bf16_t* Mo; int mode;
    __device__ __forceinline__ void operator()(const f32x4 (&acc)[2][2][4][2], const Unit& u, int wr, int wc, int fr, int fq) const {
        const int col0 = u.pn * BM + wc * 32 + 4 * fq;
#pragma unroll
        for (int ai = 0; ai < 2; ++ai)
#pragma unroll
            for (int m = 0; m < 4; ++m) { const int r = u.pm * BM + ai * HALF + wr * 64 + m * 16 + fr;
#pragma unroll
                for (int bj = 0; bj < 2; ++bj)
#pragma unroll
                    for (int n = 0; n < 2; ++n) { const int c = col0 + bj * HALF + n * 16;
                        typedef unsigned u32x2v __attribute__((ext_vector_type(2)));
                        const u32x2v gw = *(const u32x2v*)(PR + (size_t)r * 4864 + 1792 + mode * 1024 + c);
                        f32x4 g; g[0] = __builtin_bit_cast(float, gw.x << 16); g[1] = __builtin_bit_cast(float, gw.x & 0xffff0000u); g[2] = __builtin_bit_cast(float, gw.y << 16); g[3] = __builtin_bit_cast(float, gw.y & 0xffff0000u);
                        f32x4 v;
#pragma unroll
                        for (int e = 0; e < 4; ++e) v[e] = __builtin_amdgcn_rcpf(1.0f + __expf(-g[e])) * acc[ai][bj][m][n][e];
                        float* mp = MACC + (size_t)r * 1024 + c;
                        if (mode == 0) { *(f32x4*)mp = v; }
                        else if (mode == 1) { *(f32x4*)mp = *(const f32x4*)mp + v; }
                        else { const f32x4 t = *(const f32x4*)mp + v; u32x2v w; w.x = cvt_pk_bf16(t[0], t[1]); w.y = cvt_pk_bf16(t[2], t[3]); *(u32x2v*)(Mo + (size_t)r * 1024 + c) = w; }
                    } }
    }
};
struct EpiResid {
    static constexpr bool PERM = false, AFTER_DRAIN = false;
    const float* xin_lat; const float* xin_ctx; float* xout_lat; float* xout_ctx; const float* gate  ; const float* rowscale  ;
    __device__ __forceinline__ void operator()(const f32x4 (&acc)[2][2][4][2], const Unit& u, int wr, int wc, int fr, int fq) const {
        const int col0 = u.pn * BM + wc * 32 + 4 * fq;
        const bool isctx = u.pm >= 64;
        const int cond = isctx ? 2 : (u.pm >> 5);
        const float* xi = isctx ? xin_ctx - (size_t)16384 * 1024 : xin_lat;
        float* xo = isctx ? xout_ctx - (size_t)16384 * 1024 : xout_lat;
        const float* gp = gate + cond * 6144;
        f32x4 gv[2][2];
#pragma unroll
        for (int bj = 0; bj < 2; ++bj)
#pragma unroll
            for (int n = 0; n < 2; ++n) gv[bj][n] = *(const f32x4*)(gp + col0 + bj * HALF + n * 16);
#pragma unroll
        for (int ai = 0; ai < 2; ++ai)
#pragma unroll
            for (int m = 0; m < 4; ++m) { const int r = u.pm * BM + ai * HALF + wr * 64 + m * 16 + fr;
                const float rs = rowscale ? rowscale[(size_t)r * 8] : 1.0f;
#pragma unroll
                for (int bj = 0; bj < 2; ++bj)
#pragma unroll
                    for (int n = 0; n < 2; ++n) { const size_t off = (size_t)r * 1024 + col0 + bj * HALF + n * 16;
                        const f32x4 xv = *(const f32x4*)(xi + off);
                        *(f32x4*)(xo + off) = xv + gv[bj][n] * rs * acc[ai][bj][m][n]; } }
    }
};
}

__device__ __forceinline__ void transpose_item(const float* W, int K, int N, bf16* WT, int map, LAS float* scr, int item, int lane) {
    const int nblk = N / 32, kb = item / nblk, nb = item % nblk, k0 = 64 * kb, n0 = 32 * nb;
#pragma unroll 8
    for (int i = 0; i < 32; ++i) { const int kk = 2 * i + (lane >> 5); scr[kk * 33 + (lane & 31)] = W[(size_t)(k0 + kk) * N + n0 + (lane & 31)]; }
    LDS_WAIT(); asm volatile("" ::: "memory");
    const int c = lane & 7;
#pragma unroll
    for (int j = 0; j < 4; ++j) { const int n = (lane >> 3) + 8 * j; const LAS float* s = scr + (8 * c) * 33 + n;
        v4u o; o.x = pk2(s[0 * 33], s[1 * 33]); o.y = pk2(s[2 * 33], s[3 * 33]); o.z = pk2(s[4 * 33], s[5 * 33]); o.w = pk2(s[6 * 33], s[7 * 33]);
        const int nn = n0 + n; const int drow = (map == 0) ? nn : ((nn >> 7) * 256 + (nn & 127) + (map == 2 ? 128 : 0));
        *(v4u*)(WT + (size_t)drow * K + k0 + 8 * c) = o; }
    LDS_WAIT(); asm volatile("" ::: "memory");
}

#define TR_GROUP(SRC, DST, CNT, KK, NN, MAP, DSTRIDE) { constexpr int per = ((KK) / 64) * ((NN) / 32); constexpr int tot = (CNT) * per; \
    if (r < tot) { const int mi = r / per, it2 = r % per; transpose_item((SRC) + (size_t)mi * (KK) * (NN), (KK), (NN), (DST) + (size_t)mi * (DSTRIDE), (MAP), scr, it2, F.lane); continue; } r -= tot; }

__device__ __forceinline__ void phase_prologue(Frame& F) {
    LAS float* scr = (LAS float*)(F.lds + F.wave * 17408);
    const int gw = F.bid * NWAVES + F.wave, NGW = F.G * NWAVES;
    constexpr int TOT_ITEMS = 4 * (16 * 152 + 8 * 32 + 4 * 32 + 4 * 32 + 16 * 32) + 2 * (16 * 88 * 2 + 44 * 32) + 16 * (16 * 88 * 2 + 44 * 32);
    for (int it = gw; it < TOT_ITEMS; it += NGW) {
        int r = it;
        { constexpr int per = 16 * 152, tot = 4 * per;
          if (r < tot) { const int mi = r / per, it2 = r % per; const int nb = it2 % 152;
              if (nb < 48 || nb >= 56) transpose_item(inp(F, I_WIN) + (size_t)mi * 1024 * 4864, 1024, 4864, ((bf16*)(wsp(F) + WS_WIN)) + (size_t)mi * 4864 * 1024, 0, scr, it2, F.lane);
              continue; } r -= tot; }
        TR_GROUP(inp(F, I_WPA), ((bf16*)(wsp(F) + WS_WPA)), 4, 512, 1024, 0, (size_t)1024 * 512)
        TR_GROUP(inp(F, I_WPH), ((bf16*)(wsp(F) + WS_WPH)), 4, 256, 1024, 0, (size_t)1024 * 256)
        TR_GROUP(inp(F, I_WPF), ((bf16*)(wsp(F) + WS_WPF)), 4, 256, 1024, 0, (size_t)1024 * 256)
        TR_GROUP(inp(F, I_WOUT), ((bf16*)(wsp(F) + WS_WO)), 4, 1024, 1024, 0, (size_t)1024 * 1024)
        TR_GROUP(inp(F, I_FG), ((bf16*)(wsp(F) + WS_FGU)), 2, 1024, 2816, 1, (size_t)5632 * 1024)
        TR_GROUP(inp(F, I_FU), ((bf16*)(wsp(F) + WS_FGU)), 2, 1024, 2816, 2, (size_t)5632 * 1024)
        TR_GROUP(inp(F, I_FDN), ((bf16*)(wsp(F) + WS_FD)), 2, 2816, 1024, 0, (size_t)1024 * 2816)
        TR_GROUP(inp(F, I_MG), ((bf16*)(wsp(F) + WS_MGU)), 16, 1024, 2816, 1, (size_t)5632 * 1024)
        TR_GROUP(inp(F, I_MU), ((bf16*)(wsp(F) + WS_MGU)), 16, 1024, 2816, 2, (size_t)5632 * 1024)
        TR_GROUP(inp(F, I_MDN), ((bf16*)(wsp(F) + WS_MD)), 16, 2816, 1024, 0, (size_t)1024 * 2816)
    }
    { LAS float* tl = (LAS float*)(F.lds + F.wave * 17408); LAS float* ctab = tl + 64 * 65; LAS float* stab = ctab + 64;
      ctab[F.lane] = cos_rev((float)F.lane * (1.0f / 64.0f)); stab[F.lane] = sin_rev((float)F.lane * (1.0f / 64.0f));
      for (int it = gw; it < 4 * 16 * 4; it += NGW) {
        const int l = it >> 6, kb = (it >> 2) & 15, g = it & 3;
        const float* W = inp(F, I_WIN) + (size_t)l * 1024 * 4864 + (size_t)(kb * 64) * 4864 + 1536 + g * 64;
#pragma unroll 8
        for (int kk = 0; kk < 64; ++kk) tl[kk * 65 + F.lane] = W[(size_t)kk * 4864 + F.lane];
        LDS_WAIT(); asm volatile("" ::: "memory");
        bf16* dst = ((bf16*)(wsp(F) + WS_WIN)) + (size_t)l * 4864 * 1024 + (size_t)(1536 + g * 64) * 1024 + kb * 64 + F.lane;
        for (int j = 0; j < 64; ++j) {
            const int mm = j <= 32 ? j : j - 32; float a = 0.f;
            if (j <= 32) { for (int c = 0; c < 64; ++c) a += tl[F.lane * 65 + c] * ctab[(mm * c) & 63]; }
            else { for (int c = 0; c < 64; ++c) a += tl[F.lane * 65 + c] * stab[(mm * c) & 63]; }
            dst[(size_t)j * 1024] = (bf16)f2bf(a);
        }
        LDS_WAIT(); asm volatile("" ::: "memory");
      } }
    for (int it = gw; it < 4 * 96; it += NGW) {
        const int l = it / 96, cb = it % 96;
        const float* W = inp(F, I_WADA) + (size_t)l * 1024 * 6144 + cb * 64 + F.lane;
        float a0 = 0.f, a1 = 0.f, a2 = 0.f;
#pragma unroll 8
        for (int k = 0; k < 1024; ++k) {
            const float c0 = inp(F, I_C)[k], c1 = inp(F, I_C)[1024 + k], c2 = inp(F, I_CCTX)[k];
            const float s0 = c0 * sigmoidf_(c0), s1 = c1 * sigmoidf_(c1), s2 = c2 * sigmoidf_(c2);
            const float w = W[(size_t)k * 6144];
            a0 += w * s0; a1 += w * s1; a2 += w * s2;
        }
        const float bb = inp(F, I_BADA)[l * 6144 + cb * 64 + F.lane];
        float* mo = ((float*)(wsp(F) + WS_CTL) + CW_MOD) + (size_t)l * 3 * 6144 + cb * 64 + F.lane;
        mo[0] = a0 + bb; mo[6144] = a1 + bb; mo[2 * 6144] = a2 + bb;
    }
}

template <bool ROUTER>
__device__ __forceinline__ void phase_norm(Frame& F, int l, const float* xlat, const float* xctx, const float* g, int moff, const float* wr) {
    const int gw = F.bid * NWAVES + F.wave, NGW = F.G * NWAVES;
    const float* mod = ((float*)(wsp(F) + WS_CTL) + CW_MOD) + (size_t)l * 3 * 6144 + moff;
    for (int r = gw; r < MT; r += NGW) {
        const bool isctx = r >= ML; const int cond = isctx ? 2 : (r >> 13);
        const float* xr = isctx ? xctx + (size_t)(r - ML) * 1024 : xlat + (size_t)r * 1024;
        f32x4 v[4]; float s = 0.f;
#pragma unroll
        for (int j = 0; j < 4; ++j) { v[j] = *(const f32x4*)(xr + 256 * j + 4 * F.lane); s += (v[j][0] * v[j][0] + v[j][1] * v[j][1]) + (v[j][2] * v[j][2] + v[j][3] * v[j][3]); }
        const float rstd = 1.0f / sqrtf(wave_sum(s, F.lane) * (1.0f / 1024.0f) + EPS);
        const float* sh = mod + cond * 6144; const float* sc = sh + 1024;
        float lg[8];
        if (ROUTER) {
#pragma unroll
            for (int e = 0; e < 8; ++e) lg[e] = 0.f;
        }
#pragma unroll
        for (int j = 0; j < 4; ++j) { const int c = 256 * j + 4 * F.lane;
            const f32x4 gg = *(const f32x4*)(g + c), s1 = *(const f32x4*)(sc + c), s0 = *(const f32x4*)(sh + c);
            f32x4 y;
#pragma unroll
            for (int e = 0; e < 4; ++e) y[e] = (v[j][e] * rstd * gg[e]) * (1.0f + s1[e]) + s0[e];
            v2u o; o.x = pk2(y[0], y[1]); o.y = pk2(y[2], y[3]);
            *(v2u*)(((bf16*)(wsp(F) + WS_H)) + (size_t)r * 1024 + c) = o;
            if (ROUTER) {
#pragma unroll
                for (int e = 0; e < 4; ++e) { const f32x4 w0 = *(const f32x4*)(wr + (size_t)(c + e) * 8), w1 = *(const f32x4*)(wr + (size_t)(c + e) * 8 + 4);
                    lg[0] += y[e] * w0[0]; lg[1] += y[e] * w0[1]; lg[2] += y[e] * w0[2]; lg[3] += y[e] * w0[3];
                    lg[4] += y[e] * w1[0]; lg[5] += y[e] * w1[1]; lg[6] += y[e] * w1[2]; lg[7] += y[e] * w1[3]; }
            }
        }
        if (ROUTER) {
#pragma unroll
            for (int e = 0; e < 8; ++e) lg[e] = wave_sum(lg[e], F.lane);
            int i0 = 0; float v0 = lg[0];
#pragma unroll
            for (int e = 1; e < 8; ++e) if (lg[e] > v0) { v0 = lg[e]; i0 = e; }
            int i1 = -1; float v1 = -INFINITY;
#pragma unroll
            for (int e = 0; e < 8; ++e) if (e != i0 && lg[e] > v1) { v1 = lg[e]; i1 = e; }
            const float w0 = 1.0f / (1.0f + __expf(v1 - v0)), w1 = 1.0f - w0;
            if (F.lane < 8) ((float*)(wsp(F) + WS_COMB))[(size_t)r * 8 + F.lane] = (F.lane == i0) ? w0 : ((F.lane == i1) ? w1 : 0.0f);
        }
    }
}

__device__ __forceinline__ void filter_tile(Frame& F, int l, int L, int p0, float* dst  ) {
    LAS float* emb = (LAS float*)F.lds;
    LAS float* h1 = emb + 64 * 33;
    LAS float* h2 = h1 + 64 * 65;
    const float* w1 = inp(F, I_FW1) + l * 33 * 64; const float* b1 = inp(F, I_FB1) + l * 64; const float* f1 = inp(F, I_FF1) + l * 64;
    const float* w2 = inp(F, I_FW2) + l * 64 * 64; const float* b2 = inp(F, I_FB2) + l * 64; const float* f2 = inp(F, I_FF2) + l * 64;
    const float* w3 = inp(F, I_FW3) + (size_t)l * 64 * 1024;
    for (int idx = F.tid; idx < 64 * 33; idx += NTHREADS) {
        const int pos = idx / 33, f = idx % 33, i = p0 + pos;
        float val;
        if (f == 0) val = (float)i / (float)(L - 1);
        else { const int j = (f - 1) & 15; const float fb = 1e-4f + (float)j * ((15.0f - 1e-4f) / 15.0f); const float rev = fb * (float)i / (float)L;
               val = (f <= 16) ? cos_rev(rev) : -sin_rev(rev); }
        emb[pos * 33 + f] = val;
    }
    __syncthreads();
    for (int idx = F.tid; idx < 4096; idx += NTHREADS) {
        const int pos = idx >> 6, u = idx & 63; float a = b1[u];
        for (int f = 0; f < 33; ++f) a += emb[pos * 33 + f] * w1[f * 64 + u];
        h1[pos * 65 + u] = sin_rev(f1[u] * a * INV_2PI);
    }
    __syncthreads();
    for (int idx = F.tid; idx < 4096; idx += NTHREADS) {
        const int pos = idx >> 6, u = idx & 63; float a = b2[u];
        for (int f = 0; f < 64; ++f) a += h1[pos * 65 + f] * w2[f * 64 + u];
        h2[pos * 65 + u] = sin_rev(f2[u] * a * INV_2PI);
    }
    __syncthreads();
    const int pos = F.lane, i = p0 + pos; const float t = (float)i / (float)(L - 1);
    for (int col = F.wave; col < 1024; col += NWAVES) {
        float a = 0.f;
        for (int f = 0; f < 64; ++f) a += h2[pos * 65 + f] * w3[f * 1024 + col];
        const int ch = col & 255; const float delta = 3.0701134573253946f + 12.280453829301578f * ((float)ch / 255.0f);
        dst[(size_t)col * L + i] = a * __expf(-t * delta);
    }
    __syncthreads();
}

__device__ __forceinline__ void phase_qkprep(Frame& F, int l) {
    const int gw = F.bid * NWAVES + F.wave, NGW = F.G * NWAVES;
    const int lane = F.lane; const int a = lane >> 5, half = (lane >> 4) & 1, f = lane & 15;
    const float inv = exp2f(-(float)f * (13.287712379549449f / 16.0f)) * INV_2PI;
    const float gq = inp(F, I_QG)[l * 64 + lane], gk = inp(F, I_KG)[l * 64 + lane];
    for (int r = gw; r < MT; r += NGW) {
        const bool isctx = r >= ML; const int t = r & 8191; const int pos = a == 0 ? (t >> 6) : (t & 63);
        float cs = 1.f, sn = 0.f;
        if (!isctx) { const float rev = (float)pos * inv; cs = cos_rev(rev); sn = sin_rev(rev); }
        const bf16* pr = ((bf16*)(wsp(F) + WS_PR)) + (size_t)r * INW;
        bf16* qk = ((bf16*)(wsp(F) + WS_QK)) + (size_t)r * 640;
#pragma unroll
        for (int h = 0; h < 10; ++h) {
            const float v = bf2f(pr[h * 64 + lane]);
            const float ss = wave_sum(v * v, lane);
            const float y = v * (1.0f / sqrtf(ss * (1.0f / 64.0f) + EPS)) * (h < 8 ? gq : gk);
            const float p = shx(y, lane, 16);
            const float o = half == 0 ? y * cs - p * sn : y * cs + p * sn;
            qk[h * 64 + lane] = (bf16)f2bf(h < 8 ? o * 0.18033688011112042f : o);
        }
    }
}

__device__ __forceinline__ float block_sum(Frame& F, float v, LAS float* red) {
    v = wave_sum(v, F.lane);
    __syncthreads();
    if (F.lane == 0) red[F.wave] = v;
    __syncthreads();
    float t = 0.f;
#pragma unroll
    for (int w = 0; w < NWAVES; ++w) t += red[w];
    return t;
}

template <int L>
__device__ __forceinline__ float hy_uc(const bf16* UT, int rowbase, int b, int t, int ch, const float* cw, const float* cb) {
    float a = cb[ch];
    const bf16* up = UT + (size_t)ch * MT + rowbase + b * L;
#pragma unroll
    for (int j = 0; j < 3; ++j) { const int tt = t + j - 1; if (tt >= 0 && tt < L) a += bf2f(up[tt]) * cw[j * 768 + ch]; }
    return a;
}

template <int L>
__device__ __forceinline__ void hyena_item_naive(Frame& F, int l, int c, int rowbase, const float* taps) {
    constexpr int NT = (L + NTHREADS - 1) / NTHREADS;
    LAS float* kt = (LAS float*)F.lds;
    LAS f32x2* z = (LAS f32x2*)(F.lds + 2 * L * 4);
    LAS float* red = (LAS float*)(F.lds + 2 * L * 4 + L * 8);
    const float* cw = inp(F, I_HCW) + l * 3 * 768; const float* cb = inp(F, I_HCB) + l * 768; const float* hb = inp(F, I_HBIAS) + l * 512;
    for (int t = F.tid; t < L; t += NTHREADS) { f32x2 v; v.x = hy_uc<L>(((bf16*)(wsp(F) + WS_UT)), rowbase, 0, t, 512 + c, cw, cb); v.y = hy_uc<L>(((bf16*)(wsp(F) + WS_UT)), rowbase, 1, t, 512 + c, cw, cb); z[t] = v; }
    for (int o = 0; o < 2; ++o) {
        const float* fwd = taps + (size_t)(o * 256 + c) * L; const float* bwd = taps + (size_t)(512 + o * 256 + c) * L;
        float part = 0.f;
        for (int d = F.tid; d < L; d += NTHREADS) { const float kf = fwd[d]; kt[L + d] = kf; part += fabsf(kf);
            if (d >= 1) { const float kb = bwd[d]; kt[L - d] = kb; part += fabsf(kb); } else kt[0] = 0.f; }
        const float tot = block_sum(F, part, red);
        const float inv = 1.0f / tot;
        __syncthreads();
        float* tmp = (float*)(wsp(F) + WS_CTMP) + (size_t)c * 2 * L;
#pragma unroll 1
        for (int t = F.tid; t < L; t += NTHREADS) {
            float a0 = 0.f, a1 = 0.f;
#pragma unroll 4
            for (int s = 0; s < L; ++s) { const f32x2 zz = z[s]; const float kv = kt[L + t - s]; a0 += kv * zz.x; a1 += kv * zz.y; }
            tmp[t] = a0; tmp[L + t] = a1;
        }
        __syncthreads();
        const float bo = hb[o * 256 + c];
#pragma unroll 1
        for (int t = F.tid; t < L; t += NTHREADS) {
            const float g0 = hy_uc<L>(((bf16*)(wsp(F) + WS_UT)), rowbase, 0, t, o * 256 + c, cw, cb), g1 = hy_uc<L>(((bf16*)(wsp(F) + WS_UT)), rowbase, 1, t, o * 256 + c, cw, cb);
            const f32x2 zo = z[t]; f32x2 zn; zn.x = g0 * (tmp[t] * inv + bo * zo.x); zn.y = g1 * (tmp[L + t] * inv + bo * zo.y); z[t] = zn;
        }
        __syncthreads();
    }
    for (int t = F.tid; t < L; t += NTHREADS) { const f32x2 v = z[t];
        ((bf16*)(wsp(F) + WS_HYT))[(size_t)c * MT + rowbase + t] = (bf16)f2bf(v.x); ((bf16*)(wsp(F) + WS_HYT))[(size_t)c * MT + rowbase + L + t] = (bf16)f2bf(v.y); }
    __syncthreads();
}

template <int L>
__device__ __forceinline__ void fnet_item_naive(Frame& F, int b, int g, int m, int rowbase) {
    LAS f32x2* AB = (LAS f32x2*)F.lds;
    LAS f32x2* tab = (LAS f32x2*)(F.lds + L * 8);
    LAS f32x2* cs64 = (LAS f32x2*)(F.lds + 2 * L * 8);
    for (int i = F.tid; i < L; i += NTHREADS) { f32x2 v; const float rev = (float)i / (float)L; v.x = cos_rev(rev); v.y = sin_rev(rev); tab[i] = v; }
    if (F.tid < 64) { f32x2 v; const float rev = (float)F.tid / 64.0f; v.x = cos_rev(rev); v.y = sin_rev(rev); cs64[F.tid] = v; }
    __syncthreads();
    for (int n = F.tid; n < L; n += NTHREADS) {
        const bf16* ut = ((const bf16*)(wsp(F) + WS_UT)) + (size_t)(768 + g * 64) * MT + rowbase + b * L + n;
        const int mm = m <= 32 ? m : 64 - m;
        f32x2 v; v.x = bf2f(ut[(size_t)mm * MT]);
        v.y = (m == 0 || m == 32) ? 0.f : (m < 32 ? bf2f(ut[(size_t)(32 + m) * MT]) : -bf2f(ut[(size_t)(32 + mm) * MT]));
        AB[n] = v;
    }
    __syncthreads();
    const float scale = 1.0f / sqrtf((float)L * 64.0f);
    for (int k = F.tid; k < L; k += NTHREADS) {
        float acc = 0.f; int idx = 0;
        for (int n = 0; n < L; ++n) { const f32x2 ab = AB[n]; const f32x2 cs = tab[idx]; acc += ab.x * cs.x - ab.y * cs.y; idx = (idx + k) & (L - 1); }
        ((bf16*)(wsp(F) + WS_FNT))[(size_t)(g * 64 + m) * MT + rowbase + b * L + k] = (bf16)f2bf(acc * scale);
    }
    __syncthreads();
}

#ifdef FFT_HOST
#define FFT_LDS
#define FFT_HD
static inline float fft_cos_rev(float r) { return (float)cos(6.283185307179586 * (double)r); }
static inline float fft_sin_rev(float r) { return (float)sin(6.283185307179586 * (double)r); }
#else
#define FFT_LDS LAS
#define FFT_HD __device__ __forceinline__
__device__ __forceinline__ float fft_cos_rev(float r) { return __builtin_amdgcn_cosf(r); }
__device__ __forceinline__ float fft_sin_rev(float r) { return __builtin_amdgcn_sinf(r); }
#endif
FFT_HD int fft_phys(int i) { return i + ((i >> 5) << 1); }
FFT_HD f32x2 fft_cmul(f32x2 a, f32x2 b) { f32x2 r; r.x = a.x * b.x - a.y * b.y; r.y = a.x * b.y + a.y * b.x; return r; }
template <int R> FFT_HD constexpr int fft_brev(int p) { int r = 0; for (int b = 1; b < R; b <<= 1) { r = (r << 1) | ((p & b) ? 1 : 0); } return r; }
template <int R, bool INV> FFT_HD void fft_regs(f32x2 (&a)[R]) {
    constexpr float C16[16] = {1.0f, 0.92387953251128674f, 0.70710678118654752f, 0.38268343236508977f, 0.0f, -0.38268343236508977f, -0.70710678118654752f, -0.92387953251128674f,
                               -1.0f, -0.92387953251128674f, -0.70710678118654752f, -0.38268343236508977f, 0.0f, 0.38268343236508977f, 0.70710678118654752f, 0.92387953251128674f};
    constexpr float S16[16] = {0.0f, 0.38268343236508977f, 0.70710678118654752f, 0.92387953251128674f, 1.0f, 0.92387953251128674f, 0.70710678118654752f, 0.38268343236508977f,
                               0.0f, -0.38268343236508977f, -0.70710678118654752f, -0.92387953251128674f, -1.0f, -0.92387953251128674f, -0.70710678118654752f, -0.38268343236508977f};
#pragma unroll
    for (int s = R / 2; s >= 1; s >>= 1) {
#pragma unroll
        for (int i = 0; i < R; ++i) {
            if ((i & s) == 0) {
                const int k = i & (s - 1);
                const f32x2 u = a[i], v = a[i + s];
                a[i] = u + v;
                const f32x2 d = u - v;
                if (k == 0) a[i + s] = d;
                else if (2 * k == s) { f32x2 t; if (INV) { t.x = -d.y; t.y = d.x; } else { t.x = d.y; t.y = -d.x; } a[i + s] = t; }
                else { const int idx = k * (16 / (2 * s)); f32x2 w; w.x = C16[idx]; w.y = INV ? S16[idx] : -S16[idx]; a[i + s] = fft_cmul(d, w); }
            }
        }
    }
}
template <int N, int NCUR, int R, bool INV, int NT>
FFT_HD void fft_pass(FFT_LDS f32x2* buf, int tid) {
    constexpr int M = NCUR / R;
#pragma unroll 1
    for (int i = tid; i < N / R; i += NT) {
        const int blk = i / M, j = i - blk * M, base = blk * NCUR + j;
        f32x2 a[R];
#pragma unroll
        for (int q = 0; q < R; ++q) a[q] = buf[fft_phys(base + q * M)];
        f32x2 w1; { const float rev = (float)j * (1.0f / (float)NCUR); w1.x = fft_cos_rev(rev); w1.y = INV ? fft_sin_rev(rev) : -fft_sin_rev(rev); }
        if (M > 1) {
            if (INV) { f32x2 w = w1;
#pragma unroll
                for (int p = 1; p < R; ++p) { a[p] = fft_cmul(a[p], w); if (p + 1 < R) w = fft_cmul(w, w1); } }
        }
        fft_regs<R, INV>(a);
        if (M > 1 && !INV) { f32x2 w = w1;
#pragma unroll
            for (int p = 1; p < R; ++p) { a[fft_brev<R>(p)] = fft_cmul(a[fft_brev<R>(p)], w); if (p + 1 < R) w = fft_cmul(w, w1); } }
#pragma unroll
        for (int p = 0; p < R; ++p) buf[fft_phys(base + p * M)] = a[fft_brev<R>(p)];
    }
}
#ifdef FFT_HOST
#define FFT_SYNC()
#else
#define FFT_SYNC() __syncthreads()
#endif

template <bool INV> __device__ __forceinline__ void fft16k(LAS f32x2* buf, int tid) {
    constexpr int N = 16384;
    if (!INV) { fft_pass<N, 16384, 16, false, NTHREADS>(buf, tid); __syncthreads(); fft_pass<N, 1024, 16, false, NTHREADS>(buf, tid); __syncthreads();
                fft_pass<N, 64, 16, false, NTHREADS>(buf, tid); __syncthreads(); fft_pass<N, 4, 4, false, NTHREADS>(buf, tid); __syncthreads(); }
    else { fft_pass<N, 4, 4, true, NTHREADS>(buf, tid); __syncthreads(); fft_pass<N, 64, 16, true, NTHREADS>(buf, tid); __syncthreads();
           fft_pass<N, 1024, 16, true, NTHREADS>(buf, tid); __syncthreads(); fft_pass<N, 16384, 16, true, NTHREADS>(buf, tid); __syncthreads(); }
}
__device__ __forceinline__ void fft8k_fwd(LAS f32x2* buf, int tid) {
    constexpr int N = 8192;
    fft_pass<N, 8192, 16, false, NTHREADS>(buf, tid); __syncthreads(); fft_pass<N, 512, 16, false, NTHREADS>(buf, tid); __syncthreads();
    fft_pass<N, 32, 16, false, NTHREADS>(buf, tid); __syncthreads(); fft_pass<N, 2, 2, false, NTHREADS>(buf, tid); __syncthreads();
}

__device__ __forceinline__ void hyena_item_fft(Frame& F, int l, int c) {
    constexpr int L = SEQ, N = 2 * SEQ;
    LAS f32x2* buf = (LAS f32x2*)F.lds;
    LAS float* red = (LAS float*)(F.lds + 139264);
    const bf16* UT = (const bf16*)(wsp(F) + WS_UT);
    const float* cw = inp(F, I_HCW) + l * 3 * 768; const float* cb = inp(F, I_HCB) + l * 768; const float* hb = inp(F, I_HBIAS) + l * 512;
    f32x2* kspec = (f32x2*)(wsp(F) + WS_KS) + (size_t)F.bid * N;
    f32x2* zold = (f32x2*)(wsp(F) + WS_ZS) + (size_t)F.bid * L;
    const float* HFp = (const float*)(wsp(F) + WS_HF);
    for (int o = 0; o < 2; ++o) {
        const float* fwd = HFp + (size_t)(o * 256 + c) * L; const float* bwd = HFp + (size_t)(512 + o * 256 + c) * L;
        float part = 0.f;
#pragma unroll 1
        for (int i = F.tid; i < N; i += NTHREADS) { float v; if (i < L) v = fwd[i]; else if (i == L) v = 0.f; else v = bwd[N - i]; part += fabsf(v); f32x2 w; w.x = v; w.y = 0.f; buf[fft_phys(i)] = w; }
        const float tot = block_sum(F, part, red);
        fft16k<false>(buf, F.tid);
        const float scale = 1.0f / (tot * (float)N);
#pragma unroll 1
        for (int i = F.tid; i < N; i += NTHREADS) kspec[i] = buf[fft_phys(i)] * scale;
        __syncthreads();
        if (o == 0) {
#pragma unroll 1
            for (int t = F.tid; t < L; t += NTHREADS) { f32x2 v; v.x = hy_uc<L>(UT, 0, 0, t, 512 + c, cw, cb); v.y = hy_uc<L>(UT, 0, 1, t, 512 + c, cw, cb);
                buf[fft_phys(t)] = v; zold[t] = v; f32x2 zz; zz.x = 0.f; zz.y = 0.f; buf[fft_phys(L + t)] = zz; }
        } else {
#pragma unroll 1
            for (int t = F.tid; t < L; t += NTHREADS) { buf[fft_phys(t)] = zold[t]; f32x2 zz; zz.x = 0.f; zz.y = 0.f; buf[fft_phys(L + t)] = zz; }
        }
        __syncthreads();
        fft16k<false>(buf, F.tid);
#pragma unroll 1
        for (int i = F.tid; i < N; i += NTHREADS) buf[fft_phys(i)] = fft_cmul(buf[fft_phys(i)], kspec[i]);
        __syncthreads();
        fft16k<true>(buf, F.tid);
        const float bo = hb[o * 256 + c];
#pragma unroll 1
        for (int t = F.tid; t < L; t += NTHREADS) {
            const f32x2 cv = buf[fft_phys(t)], zo = zold[t];
            const float g0 = hy_uc<L>(UT, 0, 0, t, o * 256 + c, cw, cb), g1 = hy_uc<L>(UT, 0, 1, t, o * 256 + c, cw, cb);
            f32x2 zn; zn.x = g0 * (cv.x + bo * zo.x); zn.y = g1 * (cv.y + bo * zo.y);
            if (o == 0) zold[t] = zn;
            else { ((bf16*)(wsp(F) + WS_HYT))[(size_t)c * MT + t] = (bf16)f2bf(zn.x); ((bf16*)(wsp(F) + WS_HYT))[(size_t)c * MT + L + t] = (bf16)f2bf(zn.y); }
        }
        __syncthreads();
    }
}

__device__ __forceinline__ void fnet_item_fft(Frame& F, int b, int g, int m) {
    constexpr int N = SEQ;
    LAS f32x2* buf = (LAS f32x2*)F.lds;
    LAS float* re = (LAS float*)(F.lds + 69632);
    LAS float* im = re + N;
    const bf16* ut = ((const bf16*)(wsp(F) + WS_UT)) + (size_t)(768 + g * 64) * MT + b * N;
    bf16* fnt = ((bf16*)(wsp(F) + WS_FNT)) + (size_t)(g * 64) * MT + b * N;
#pragma unroll 1
    for (int n = F.tid; n < N; n += NTHREADS) { f32x2 v;
        if (m == 0) { v.x = bf2f(ut[n]); v.y = bf2f(ut[(size_t)32 * MT + n]); }
        else { v.x = bf2f(ut[(size_t)m * MT + n]); v.y = -bf2f(ut[(size_t)(32 + m) * MT + n]); }
        buf[fft_phys(n)] = v; }
    __syncthreads();
    fft8k_fwd(buf, F.tid);
#pragma unroll 1
    for (int pos = F.tid; pos < N; pos += NTHREADS) { const int k = (pos >> 9) + 16 * ((pos >> 5) & 15) + 256 * ((pos >> 1) & 15) + 4096 * (pos & 1);
        const f32x2 v = buf[fft_phys(pos)]; re[k] = v.x; im[k] = v.y; }
    __syncthreads();
    const float scale = 1.0f / sqrtf((float)N * 64.0f);
#pragma unroll 1
    for (int k = F.tid; k < N; k += NTHREADS) { const int nk = (N - k) & (N - 1);
        if (m == 0) { fnt[k] = (bf16)f2bf(0.5f * (re[k] + re[nk]) * scale); fnt[(size_t)32 * MT + k] = (bf16)f2bf(0.5f * (im[k] + im[nk]) * scale); }
        else { fnt[(size_t)m * MT + k] = (bf16)f2bf(re[k] * scale); fnt[(size_t)(64 - m) * MT + k] = (bf16)f2bf(re[nk] * scale); } }
    __syncthreads();
}

typedef short bf16x8 __attribute__((ext_vector_type(8)));
typedef float f32x16 __attribute__((ext_vector_type(16)));
__device__ __forceinline__ unsigned cvtpk(float lo, float hi) { unsigned r; asm volatile("v_cvt_pk_bf16_f32 %0, %1, %2" : "=v"(r) : "v"(lo), "v"(hi)); return r; }
struct AttnChunk { bf16x8 k[4]; v2u v[2][2][2]; };
__device__ __forceinline__ void attn_load_chunk(AttnChunk& C, const bf16* QK, const bf16* VT, int keyrow0, int kvh, int r, int h) {
    const bf16* kp = QK + (size_t)(keyrow0 + r) * 640 + 512 + kvh * 64 + 8 * h;
#pragma unroll
    for (int s = 0; s < 4; ++s) C.k[s] = *(const bf16x8*)(kp + 16 * s);
#pragma unroll
    for (int dd = 0; dd < 2; ++dd) { const bf16* vp = VT + (size_t)(kvh * 64 + 32 * dd + r) * MT + keyrow0 + 4 * h;
#pragma unroll
        for (int s = 0; s < 2; ++s) { C.v[dd][s][0] = *(const v2u*)(vp + 16 * s); C.v[dd][s][1] = *(const v2u*)(vp + 16 * s + 8); } }
}
__device__ __forceinline__ void attn_item(Frame& F, int l, int item) {
    const int lane = F.lane, r = lane & 31, h = lane >> 5;
    const bf16* QK = (const bf16*)(wsp(F) + WS_QK); const bf16* VT = (const bf16*)(wsp(F) + WS_VT);
    int g, kvh, b, qrow0, t0; bool isctx;
    if (item < 4096) { g = item & 3; const int qblk = (item >> 2) & 255; kvh = (item >> 10) & 1; b = item >> 11; isctx = false; t0 = qblk * 32; qrow0 = b * SEQ + t0; }
    else { const int j = item - 4096; g = j & 3; const int qb = (j >> 2) & 7; kvh = (j >> 5) & 1; b = j >> 6; isctx = true; t0 = 0; qrow0 = ML + b * CTXL + qb * 32; }
    const int head = 4 * kvh + g;
    bf16x8 qf[4];
    { const bf16* qp = QK + (size_t)(qrow0 + r) * 640 + head * 64 + 8 * h;
#pragma unroll
      for (int s = 0; s < 4; ++s) qf[s] = *(const bf16x8*)(qp + 16 * s); }
    float m = inp(F, I_SINK)[l * 8 + head] * 1.4426950408889634f;
    float lsum = (h == 0) ? 1.0f : 0.0f;
    f32x16 o0, o1;
#pragma unroll
    for (int i = 0; i < 16; ++i) { o0[i] = 0.f; o1[i] = 0.f; }
    const int nch = isctx ? 8 : 17, nloc = isctx ? 0 : 9;
#define ATT_KEYROW(c) (((c) < nloc) ? ((t0 - 128 + 32 * (c) >= 0 && t0 - 128 + 32 * (c) < SEQ) ? (b * SEQ + t0 - 128 + 32 * (c)) : -1) : (ML + b * CTXL + 32 * ((c) - nloc)))
    AttnChunk cur, nxt;
    int c = 0; int krow = ATT_KEYROW(0);
    while (krow < 0) { ++c; krow = ATT_KEYROW(c); }
    attn_load_chunk(cur, QK, VT, krow, kvh, r, h);
    while (c < nch) {
        int cn = c + 1; int krn = -1;
        while (cn < nch) { krn = ATT_KEYROW(cn); if (krn >= 0) break; ++cn; }
        if (cn < nch) attn_load_chunk(nxt, QK, VT, krn, kvh, r, h);
        f32x16 S;
#pragma unroll
        for (int i = 0; i < 16; ++i) S[i] = 0.f;
#pragma unroll
        for (int s = 0; s < 4; ++s) S = __builtin_amdgcn_mfma_f32_32x32x16_bf16(cur.k[s], qf[s], S, 0, 0, 0);
        if (c < nloc && (c == 0 || c == 8)) {
#pragma unroll
            for (int i = 0; i < 16; ++i) { const int kidx = (i & 3) + 8 * (i >> 2) + 4 * h; const bool ok = (c == 0) ? (kidx >= r) : (kidx <= r); if (!ok) S[i] = -INFINITY; }
        }
        float cm = S[0];
#pragma unroll
        for (int i = 1; i < 16; ++i) cm = fmaxf(cm, S[i]);
        cm = fmaxf(cm, shx(cm, lane, 32));
        const float mn = fmaxf(m, cm), alpha = __builtin_amdgcn_exp2f(m - mn); m = mn;
        float ps = 0.f;
#pragma unroll
        for (int i = 0; i < 16; ++i) { S[i] = __builtin_amdgcn_exp2f(S[i] - m); ps += S[i]; }
        lsum = lsum * alpha + ps;
#pragma unroll
        for (int i = 0; i < 16; ++i) { o0[i] *= alpha; o1[i] *= alpha; }
        bf16x8 pf[2];
#pragma unroll
        for (int s = 0; s < 2; ++s) { v4u w; w.x = cvtpk(S[8 * s + 0], S[8 * s + 1]); w.y = cvtpk(S[8 * s + 2], S[8 * s + 3]); w.z = cvtpk(S[8 * s + 4], S[8 * s + 5]); w.w = cvtpk(S[8 * s + 6], S[8 * s + 7]); pf[s] = __builtin_bit_cast(bf16x8, w); }
#pragma unroll
        for (int s = 0; s < 2; ++s) {
            v4u a0; a0.x = cur.v[0][s][0].x; a0.y = cur.v[0][s][0].y; a0.z = cur.v[0][s][1].x; a0.w = cur.v[0][s][1].y;
            v4u a1; a1.x = cur.v[1][s][0].x; a1.y = cur.v[1][s][0].y; a1.z = cur.v[1][s][1].x; a1.w = cur.v[1][s][1].y;
            o0 = __builtin_amdgcn_mfma_f32_32x32x16_bf16(__builtin_bit_cast(bf16x8, a0), pf[s], o0, 0, 0, 0);
            o1 = __builtin_amdgcn_mfma_f32_32x32x16_bf16(__builtin_bit_cast(bf16x8, a1), pf[s], o1, 0, 0, 0);
        }
        cur = nxt; c = cn;
    }
#undef ATT_KEYROW
    lsum += shx(lsum, lane, 32);
    const float inv = 1.0f / lsum;
    bf16* op = ((bf16*)(wsp(F) + WS_ATT)) + (size_t)(qrow0 + r) * 512 + head * 64 + 4 * h;
#pragma unroll
    for (int g4 = 0; g4 < 4; ++g4) {
        v2u w0; w0.x = cvtpk(o0[4 * g4 + 0] * inv, o0[4 * g4 + 1] * inv); w0.y = cvtpk(o0[4 * g4 + 2] * inv, o0[4 * g4 + 3] * inv); *(v2u*)(op + 8 * g4) = w0;
        v2u w1; w1.x = cvtpk(o1[4 * g4 + 0] * inv, o1[4 * g4 + 1] * inv); w1.y = cvtpk(o1[4 * g4 + 2] * inv, o1[4 * g4 + 3] * inv); *(v2u*)(op + 32 + 8 * g4) = w1;
    }
}

__device__ __forceinline__ void attn_item_naive(Frame& F, int l, int r, int kvh, LAS float* wq, LAS float* wp) {
    const int lane = F.lane;
    const bool isctx = r >= ML; const int b = isctx ? ((r - ML) >> 8) : (r >> 13); const int t = r & 8191;
    const int lo = (t - 128) < 0 ? 0 : (t - 128), hi = (t + 128) > (SEQ - 1) ? (SEQ - 1) : (t + 128);
    const int nloc = isctx ? 0 : (hi - lo + 1), nk = nloc + CTXL;
#pragma unroll
    for (int h = 0; h < 4; ++h) wq[h * 64 + lane] = bf2f(((bf16*)(wsp(F) + WS_QK))[(size_t)r * 640 + (4 * kvh + h) * 64 + lane]) * 0.125f;
    LDS_WAIT(); asm volatile("" ::: "memory");
    for (int j = lane; j < nk; j += 64) {
        const int krow = j < nloc ? (b * SEQ + lo + j) : (ML + b * CTXL + (j - nloc));
        const bf16* kp = ((bf16*)(wsp(F) + WS_QK)) + (size_t)krow * 640 + 512 + kvh * 64;
        float s0 = 0.f, s1 = 0.f, s2 = 0.f, s3 = 0.f;
#pragma unroll
        for (int d8 = 0; d8 < 8; ++d8) { const v4u kw = *(const v4u*)(kp + d8 * 8);
            float kf[8]; kf[0] = bflo(kw.x); kf[1] = bfhi(kw.x); kf[2] = bflo(kw.y); kf[3] = bfhi(kw.y); kf[4] = bflo(kw.z); kf[5] = bfhi(kw.z); kf[6] = bflo(kw.w); kf[7] = bfhi(kw.w);
#pragma unroll
            for (int e = 0; e < 8; ++e) { const int d = d8 * 8 + e; s0 += kf[e] * wq[d]; s1 += kf[e] * wq[64 + d]; s2 += kf[e] * wq[128 + d]; s3 += kf[e] * wq[192 + d]; } }
        f32x4 sv; sv[0] = s0; sv[1] = s1; sv[2] = s2; sv[3] = s3;
        *(LAS f32x4*)(wp + j * 4) = sv;
    }
    LDS_WAIT(); asm volatile("" ::: "memory");
    f32x4 mx = {-INFINITY, -INFINITY, -INFINITY, -INFINITY};
    for (int j = lane; j < nk; j += 64) { const f32x4 sv = *(LAS f32x4*)(wp + j * 4);
#pragma unroll
        for (int h = 0; h < 4; ++h) mx[h] = fmaxf(mx[h], sv[h]); }
    f32x4 sink, den;
#pragma unroll
    for (int h = 0; h < 4; ++h) { sink[h] = inp(F, I_SINK)[l * 8 + 4 * kvh + h]; mx[h] = fmaxf(wave_max(mx[h], lane), sink[h]); den[h] = 0.f; }
    for (int j = lane; j < nk; j += 64) { f32x4 sv = *(LAS f32x4*)(wp + j * 4);
#pragma unroll
        for (int h = 0; h < 4; ++h) { sv[h] = __expf(sv[h] - mx[h]); den[h] += sv[h]; }
        *(LAS f32x4*)(wp + j * 4) = sv; }
#pragma unroll
    for (int h = 0; h < 4; ++h) den[h] = wave_sum(den[h], lane) + __expf(sink[h] - mx[h]);
    LDS_WAIT(); asm volatile("" ::: "memory");
    f32x4 o = {0.f, 0.f, 0.f, 0.f};
    for (int j = 0; j < nk; ++j) {
        const int krow = j < nloc ? (b * SEQ + lo + j) : (ML + b * CTXL + (j - nloc));
        const float v = bf2f(((bf16*)(wsp(F) + WS_PR))[(size_t)krow * INW + K_END + kvh * 64 + lane]);
        const f32x4 p = *(LAS f32x4*)(wp + j * 4);
        o += p * v;
    }
#pragma unroll
    for (int h = 0; h < 4; ++h) ((bf16*)(wsp(F) + WS_ATT))[(size_t)r * 512 + (4 * kvh + h) * 64 + lane] = (bf16)f2bf(o[h] / den[h]);
    LDS_WAIT(); asm volatile("" ::: "memory");
}


__device__ __forceinline__ void phase_trans(Frame& F) {
    LAS unsigned* tl = (LAS unsigned*)(F.lds + F.wave * 16640);
    const int gw = F.bid * NWAVES + F.wave, NGW = F.G * NWAVES, lane = F.lane;
    for (int it = gw; it < 2 * 264 * 4; it += NGW) {
        const int which = it / (264 * 4), rem = it % (264 * 4), rt = rem >> 2, ct = rem & 3;
        const bf16* src = which == 0 ? ((const bf16*)(wsp(F) + WS_HYT)) : ((const bf16*)(wsp(F) + WS_FNT));
        bf16* dst = which == 0 ? ((bf16*)(wsp(F) + WS_HYO)) : ((bf16*)(wsp(F) + WS_FNO));
#pragma unroll 8
        for (int ch = 0; ch < 64; ++ch) tl[ch * 65 + lane] = src[(size_t)(ct * 64 + ch) * MT + rt * 64 + lane];
        LDS_WAIT(); asm volatile("" ::: "memory");
#pragma unroll 8
        for (int row = 0; row < 64; ++row) dst[(size_t)(rt * 64 + row) * 256 + ct * 64 + lane] = (bf16)tl[lane * 65 + row];
        LDS_WAIT(); asm volatile("" ::: "memory");
    }
}

__device__ __forceinline__ void phase_mix_naive(Frame& F, int l) {
    { const int gw = F.bid * NWAVES + F.wave, NGW = F.G * NWAVES;
      for (int it = gw; it < 4096 + 128; it += NGW) attn_item(F, l, it); }
    __syncthreads();
    for (int c = F.bid; c < 256; c += F.G) hyena_item_fft(F, l, c);
    for (int c = F.bid; c < 256; c += F.G) hyena_item_naive<CTXL>(F, l, c, ML, ((float*)(wsp(F) + WS_HFC)));
    for (int it = F.bid; it < 256; it += F.G) fnet_item_fft(F, it >> 7, (it >> 5) & 3, it & 31);
    for (int it = F.bid; it < 512; it += F.G) fnet_item_naive<CTXL>(F, it >> 8, (it >> 6) & 3, it & 63, ML);
}

constexpr int NPL = 24;
constexpr int NPHASES = 1 + DEPTH * NPL;
#ifndef ONE_LAUNCH
#define ONE_LAUNCH 1
#endif

__global__ void __launch_bounds__(NTHREADS, 2) fwd_kernel(Args args) {
    extern __shared__ __attribute__((aligned(16))) unsigned char lds[];
    Frame F;
    F.lds = (LAS unsigned char*)lds;
    F.tid = threadIdx.x; F.lane = F.tid & 63; F.wave = __builtin_amdgcn_readfirstlane(F.tid >> 6);
    F.G = gridDim.x; F.bid = blockIdx.x;
    unsigned char* ws = args.ws; F.ws = ws;
    F.ctl = (unsigned*)(ws + WS_CTL);
    F.a = &args; F.z = 0;
    volatile LAS unsigned* MISC = (volatile LAS unsigned*)(F.lds + MISC_OFF);
    for (int u = F.tid; u < 64; u += NTHREADS) MISC[u] = 0u;
    __syncthreads();
    const int lo = args.ph_lo, hi = args.ph_hi;
    XcdBarrier bar; bar.bar = F.ctl + CW_BAR; bar.x = 0; bar.st = nullptr;
    if (hi - lo > 1) bar = xcd_barrier_post(F.ctl + CW_BAR, MISC + 8);
#define PH_BEGIN(k) if (lo <= (k) && (k) < hi) { { int t_ = threadIdx.x; asm volatile("" : "+v"(t_)); F.tid = t_; F.lane = t_ & 63; F.wave = __builtin_amdgcn_readfirstlane(t_ >> 6); int z_ = 0; asm volatile("" : "+s"(z_)); F.z = z_; }
#define PH_END(k) if ((k) + 1 < hi) xcd_barrier_impl(bar.bar, bar.x, bar.st); }

    PH_BEGIN(0) phase_prologue(F); PH_END(0)

    for (int l = 0; l < DEPTH; ++l) {
        const int pb = 1 + l * NPL;
        const float* xin_lat = (l == 0) ? inp(F, I_X) : outp(F);
        const float* xin_ctx = (l == 0) ? inp(F, I_CTX) : ((float*)(wsp(F) + WS_XC));
        const float* modl = ((float*)(wsp(F) + WS_CTL) + CW_MOD) + (size_t)l * 3 * 6144;
        const bool moe = (l & 1) != 0; const int fi = l >> 1;

        PH_BEGIN(pb + 0)
            phase_norm<false>(F, l, xin_lat, xin_ctx, inp(F, I_N1G) + l * 1024, 0, nullptr);
            for (int it = F.bid; it < 132; it += F.G) { if (it < 128) filter_tile(F, l, SEQ, it * 64, ((float*)(wsp(F) + WS_HF))); else filter_tile(F, l, CTXL, (it - 128) * 64, ((float*)(wsp(F) + WS_HFC))); }
        PH_END(pb + 0)

        PH_BEGIN(pb + 1)
            pg8::Gemm g{((bf16*)(wsp(F) + WS_H)), ((bf16*)(wsp(F) + WS_WIN)) + (size_t)l * INW * 1024, MT, INW, 1024}; pg8::StaticOrder S; S.init(MT, INW, F.G, F.bid);
            pg8::EpiIn E{((bf16*)(wsp(F) + WS_PR)), INW, ((bf16*)(wsp(F) + WS_UT)), ((bf16*)(wsp(F) + WS_VT)), MT};
            pg8::gemm_phase<pg8::EpiIn, pg8::StaticOrder, true, true>(F.lds, g, S, E);
        PH_END(pb + 1)

        PH_BEGIN(pb + 2) phase_qkprep(F, l); PH_END(pb + 2)

        PH_BEGIN(pb + 3) phase_mix_naive(F, l); PH_END(pb + 3)

        PH_BEGIN(pb + 4) phase_trans(F); PH_END(pb + 4)

        PH_BEGIN(pb + 5)
            for (int br = 0; br < 3; ++br) {
                const bf16* A = br == 0 ? ((bf16*)(wsp(F) + WS_ATT)) : (br == 1 ? ((bf16*)(wsp(F) + WS_HYO)) : ((bf16*)(wsp(F) + WS_FNO)));
                const bf16* Bt = br == 0 ? ((bf16*)(wsp(F) + WS_WPA)) + (size_t)l * 1024 * 512 : (br == 1 ? ((bf16*)(wsp(F) + WS_WPH)) + (size_t)l * 1024 * 256 : ((bf16*)(wsp(F) + WS_WPF)) + (size_t)l * 1024 * 256);
                const int K = br == 0 ? 512 : 256;
                pg8::Gemm g{A, Bt, MT, 1024, K}; pg8::StaticOrder S; S.init(MT, 1024, F.G, F.bid);
                pg8::EpiMerge E{((bf16*)(wsp(F) + WS_PR)), ((float*)(wsp(F) + WS_MACC)), ((bf16*)(wsp(F) + WS_M)), br};
                pg8::gemm_phase<pg8::EpiMerge, pg8::StaticOrder, true, true>(F.lds, g, S, E);
                __syncthreads();
            }
        PH_END(pb + 5)

        PH_BEGIN(pb + 6)
            pg8::Gemm g{((bf16*)(wsp(F) + WS_M)), ((bf16*)(wsp(F) + WS_WO)) + (size_t)l * 1024 * 1024, MT, 1024, 1024}; pg8::StaticOrder S; S.init(MT, 1024, F.G, F.bid);
            pg8::EpiResid E{xin_lat, xin_ctx, outp(F), ((float*)(wsp(F) + WS_XC)), modl + 2048, nullptr};
            pg8::gemm_phase<pg8::EpiResid, pg8::StaticOrder, true, true>(F.lds, g, S, E);
        PH_END(pb + 6)

        PH_BEGIN(pb + 7)
            if (moe) phase_norm<true>(F, l, outp(F), ((float*)(wsp(F) + WS_XC)), inp(F, I_N2G) + l * 1024, 3072, inp(F, I_ROUTER) + (size_t)fi * 1024 * 8);
            else phase_norm<false>(F, l, outp(F), ((float*)(wsp(F) + WS_XC)), inp(F, I_N2G) + l * 1024, 3072, nullptr);
        PH_END(pb + 7)

        const int ne = moe ? NEXP : 1;
        for (int e = 0; e < ne; ++e) {
            const bf16* Wgu = moe ? ((bf16*)(wsp(F) + WS_MGU)) + (size_t)(fi * 8 + e) * 5632 * 1024 : ((bf16*)(wsp(F) + WS_FGU)) + (size_t)fi * 5632 * 1024;
            const bf16* Wd = moe ? ((bf16*)(wsp(F) + WS_MD)) + (size_t)(fi * 8 + e) * 1024 * 2816 : ((bf16*)(wsp(F) + WS_FD)) + (size_t)fi * 1024 * 2816;
            PH_BEGIN(pb + 8 + 2 * e)
                pg8::Gemm g{((bf16*)(wsp(F) + WS_H)), Wgu, MT, 5632, 1024}; pg8::StaticOrder S; S.init(MT, 5632, F.G, F.bid);
                pg8::EpiSwiglu E{((bf16*)(wsp(F) + WS_HID)), DFF};
                pg8::gemm_phase<pg8::EpiSwiglu, pg8::StaticOrder, true, true>(F.lds, g, S, E);
            PH_END(pb + 8 + 2 * e)
            PH_BEGIN(pb + 9 + 2 * e)
                pg8::Gemm g{((bf16*)(wsp(F) + WS_HID)), Wd, MT, 1024, DFF}; pg8::StaticOrder S; S.init(MT, 1024, F.G, F.bid);
                pg8::EpiResid E{outp(F), ((float*)(wsp(F) + WS_XC)), outp(F), ((float*)(wsp(F) + WS_XC)), modl + 5120, moe ? ((float*)(wsp(F) + WS_COMB)) + e : nullptr};
                pg8::gemm_phase<pg8::EpiResid, pg8::StaticOrder, true, true>(F.lds, g, S, E);
            PH_END(pb + 9 + 2 * e)
        }
    }
#undef PH_BEGIN
#undef PH_END
}

extern "C" void kernel_launch(void* const* d_in, const int* in_sizes, int n_in, void* d_out, int out_size, void* d_ws, size_t ws_size, hipStream_t stream) {
    static int grid = 0;
    if (grid == 0) {
        if (n_in != 33 || out_size != ML * DM || ws_size < WS_END2) { fprintf(stderr, "kernel_launch: unexpected shapes (n_in %d out %d ws %zu need %zu)\n", n_in, out_size, ws_size, (size_t)WS_END2); grid = -1; return; }
        int dev = 0, cus = 0, per_cu = 0;
        if (hipGetDevice(&dev) != hipSuccess || hipDeviceGetAttribute(&cus, hipDeviceAttributeMultiprocessorCount, dev) != hipSuccess) { grid = -1; return; }
        if (hipFuncSetAttribute((const void*)fwd_kernel, hipFuncAttributeMaxDynamicSharedMemorySize, LDS_BYTES) != hipSuccess) { fprintf(stderr, "kernel_launch: hipFuncSetAttribute failed\n"); grid = -1; return; }
        if (hipOccupancyMaxActiveBlocksPerMultiprocessor(&per_cu, (const void*)fwd_kernel, NTHREADS, LDS_BYTES) != hipSuccess || per_cu < 1) { fprintf(stderr, "kernel_launch: occupancy query says %d\n", per_cu); }
        (void)hipGetLastError();
        grid = cus;
    }
    if (grid < 0) return;
    if (hipMemsetAsync((char*)d_ws + WS_CTL, 0, CTL_ZERO_BYTES, stream) != hipSuccess) return;
    Args a{};
    for (int i = 0; i < 33; ++i) a.in[i] = (const float*)d_in[i];
    a.in[33] = (const float*)d_out; a.ws = (unsigned char*)d_ws;
#if ONE_LAUNCH
    a.ph_lo = 0; a.ph_hi = NPHASES;
    hipLaunchKernelGGL(fwd_kernel, dim3(grid), dim3(NTHREADS), LDS_BYTES, stream, a);
#else
    for (int k = 0; k < NPHASES; ++k) {
        if (k >= 1) { const int l = (k - 1) / NPL, p = (k - 1) % NPL; if ((l & 1) == 0 && p >= 10) continue; }
        a.ph_lo = k; a.ph_hi = k + 1;
        hipLaunchKernelGGL(fwd_kernel, dim3(grid), dim3(NTHREADS), LDS_BYTES, stream, a);
    }
#endif
}
```

```cpp
#include <hip/hip_runtime.h>
#include <cstdio>
#include <cstdint>
namespace pg8 {
#define PG8_LAS __attribute__((address_space(3)))
typedef unsigned short bf16_t;
typedef short bf16x8 __attribute__((ext_vector_type(8)));
typedef float f32x4 __attribute__((ext_vector_type(4)));
typedef unsigned u32x4 __attribute__((ext_vector_type(4)));
constexpr int BM = 256, BK = 64, HALF = 128, HTB = HALF * BK * 2  , STAGE_BYTES = 8 * HTB, NXCD = 8, WGM = 8;

__host__ __device__ __forceinline__ int lds_byte(int r, int c) { const int st = (r >> 4) * 2 + (c >> 5), rr = r & 15, cc = c & 31, ob = rr * 64 + cc * 2; return st * 1024 + (ob ^ (((ob >> 9) & 1) << 5)); }
__host__ __device__ __forceinline__ void stage_rc(int b, int& R, int& C) { const int st = b / 1024, sb = b % 1024, swz = sb ^ (((sb >> 9) & 1) << 5); R = (st >> 1) * 16 + swz / 64; C = (st & 1) * 32 + (swz % 64) / 2; }
__host__ __device__ __forceinline__ int perm32(int rho) { const int n = rho >> 4, i = rho & 15; return 8 * (i >> 2) + 4 * n + (i & 3); }

struct Unit { int pm, pn; };
struct Gemm { const bf16_t* A; const bf16_t* Bt; int M, N, K; };

struct StaticOrder {
    int nM, nN, nwg, G, c;
    __host__ __device__ void init(int M, int N, int G_, int c_) { nM = M / BM; nN = N / BM; nwg = nM * nN; G = G_; c = c_; }
    __host__ __device__ bool next(int i, Unit& u) const {
        const long L = (long)i * G + c; if (L >= nwg) return false;
        int wgid = (int)L; { const int q = nwg / NXCD, r = nwg % NXCD, xcd = wgid % NXCD, off = wgid / NXCD; wgid = (xcd < r ? xcd * (q + 1) : r * (q + 1) + (xcd - r) * q) + off; }
        const int nig = WGM * nN, gid = wgid / nig, fm = gid * WGM, gsz = (nM - fm) < WGM ? (nM - fm) : WGM;
        u.pm = fm + ((wgid % nig) % gsz); u.pn = (wgid % nig) / gsz; return true;
    }
    __device__ __forceinline__ void a_ready(const Unit&) const {}
    __device__ __forceinline__ void done(const Unit&) const {}
};

__device__ __forceinline__ unsigned cvt_pk_bf16(float lo, float hi) { unsigned r; asm volatile("v_cvt_pk_bf16_f32 %0, %1, %2" : "=v"(r) : "v"(lo), "v"(hi)); return r; }
typedef float f32x2 __attribute__((ext_vector_type(2)));
template <class Epi, class Sched, bool ALIGN_EPI = false, bool SP2 = false>
__device__ __forceinline__ void gemm_phase(PG8_LAS unsigned char* lds, const Gemm g, const Sched& S, const Epi& E) {
    int tid_ = threadIdx.x; asm volatile("" : "+v"(tid_)); const int tid = tid_, wid = __builtin_amdgcn_readfirstlane(tid >> 6), lane = tid & 63, wr = wid >> 2, wc = wid & 3, fr = lane & 15, fq = lane >> 4;
    const int K = g.K, nt = K / BK;
    unsigned voffA[2], voffB[2];
#pragma unroll
    for (int i = 0; i < 2; ++i) { int R, C; stage_rc(tid * 16 + i * 8192, R, C); const int Rb = Epi::PERM ? ((R & ~31) + perm32(R & 31)) : R;
        voffA[i] = (unsigned)(R * K + C) * 2u; voffB[i] = (unsigned)(Rb * K + C) * 2u; }
    const size_t kstep = (size_t)(BK * 2);
    const size_t hstep = (size_t)HALF * K * 2;
    const size_t tstep = 2 * hstep;
    const unsigned ldsw = (unsigned)wid * 1024u;
    const int aoff = lds_byte(wr * 64 + fr, fq * 8), boff = lds_byte(wc * 32 + fr, fq * 8);
#define PG8_SA(b, h) (((b) * 2 + (h)) * HTB)
#define PG8_SB(b, h) ((4 + (b) * 2 + (h)) * HTB)
#define PG8_STAGE(bufoff, gbase, voff) do { _Pragma("unroll") for (int _i = 0; _i < 2; ++_i) \
        __builtin_amdgcn_global_load_lds((const unsigned*)((const char*)(gbase) + (voff)[_i]), (PG8_LAS unsigned*)(lds + (bufoff) + ldsw + _i * 8192), 16, 0, 0); } while (0)
#define PG8_LDA(dst, b, h) do { _Pragma("unroll") for (int m = 0; m < 4; ++m) _Pragma("unroll") for (int k = 0; k < 2; ++k) dst[m][k] = *(const PG8_LAS bf16x8*)(lds + PG8_SA(b, h) + aoff + m * 2048 + k * 1024); } while (0)
#define PG8_LDB(dst, b, h) do { _Pragma("unroll") for (int n = 0; n < 2; ++n) _Pragma("unroll") for (int k = 0; k < 2; ++k) dst[n][k] = *(const PG8_LAS bf16x8*)(lds + PG8_SB(b, h) + boff + n * 2048 + k * 1024); } while (0)
#define PG8_MMA(ai, bj, At, Bt) do { __builtin_amdgcn_s_setprio(1); _Pragma("unroll") for (int m = 0; m < 4; ++m) _Pragma("unroll") for (int n = 0; n < 2; ++n) _Pragma("unroll") for (int k = 0; k < 2; ++k) \
        acc[ai][bj][m][n] = __builtin_amdgcn_mfma_f32_16x16x32_bf16(Bt[n][k], At[m][k], acc[ai][bj][m][n], 0, 0, 0); __builtin_amdgcn_s_setprio(0); } while (0)
#define PG8_WAIT_V(n) asm volatile("s_waitcnt vmcnt(" #n ")" ::: "memory")
#define PG8_WAIT_L(n) asm volatile("s_waitcnt lgkmcnt(" #n ")" ::: "memory")
#define PG8_BAR __builtin_amdgcn_s_barrier()
#define PG8_SCHED __builtin_amdgcn_sched_barrier(0)
    Unit cur, nxt; int ui = 0;
    if (!S.next(0, cur)) return;
    f32x4 acc[2][2][4][2];
#pragma unroll
    for (int a = 0; a < 2; ++a)
#pragma unroll
        for (int b = 0; b < 2; ++b)
#pragma unroll
            for (int m = 0; m < 4; ++m)
#pragma unroll
                for (int n = 0; n < 2; ++n) acc[a][b][m][n] = (f32x4){0.f, 0.f, 0.f, 0.f};
    bf16x8 At[4][2], B0[2][2], B1[2][2];
    const char* cA = (const char*)g.A + (size_t)cur.pm * tstep; const char* cB = (const char*)g.Bt + (size_t)cur.pn * tstep;
    S.a_ready(cur);
    if constexpr (SP2) {
        PG8_STAGE(PG8_SB(0, 0), cB, voffB); PG8_STAGE(PG8_SB(0, 1), cB + hstep, voffB); PG8_STAGE(PG8_SA(0, 0), cA, voffA); PG8_STAGE(PG8_SA(0, 1), cA + hstep, voffA);
        if (wr == 1) PG8_BAR;
        PG8_WAIT_V(2); PG8_BAR;
        PG8_STAGE(PG8_SB(1, 0), cB + kstep, voffB); PG8_STAGE(PG8_SA(1, 0), cA + kstep, voffA); PG8_STAGE(PG8_SB(1, 1), cB + hstep + kstep, voffB);
        PG8_WAIT_V(6); PG8_BAR;
    } else {
        PG8_STAGE(PG8_SB(0, 0), cB, voffB); PG8_STAGE(PG8_SA(0, 0), cA, voffA); PG8_STAGE(PG8_SB(0, 1), cB + hstep, voffB); PG8_STAGE(PG8_SA(0, 1), cA + hstep, voffA);
        if (wr == 1) PG8_BAR;
        PG8_WAIT_V(4); PG8_BAR;
        PG8_STAGE(PG8_SB(1, 0), cB + kstep, voffB); PG8_STAGE(PG8_SA(1, 0), cA + kstep, voffA); PG8_STAGE(PG8_SB(1, 1), cB + hstep + kstep, voffB);
        PG8_WAIT_V(6); PG8_BAR;
    }
    for (;;) {
        const bool has_next = S.next(ui + 1, nxt);
        const char* nA = has_next ? (const char*)g.A + (size_t)nxt.pm * tstep : cA; const char* nB = has_next ? (const char*)g.Bt + (size_t)nxt.pn * tstep : cB;
        for (int t = 0; t < nt; t += 2) {
            const bool last = (t == nt - 2);
            const char* a1 = cA + (size_t)(t + 1) * kstep;
            const char* a2 = last ? nA : cA + (size_t)(t + 2) * kstep; const char* b2 = last ? nB : cB + (size_t)(t + 2) * kstep;
            const char* a3 = a2 + kstep; const char* b3 = b2 + kstep;
            if (last && has_next) S.a_ready(nxt);
            if constexpr (SP2) {
            PG8_LDB(B0, 0, 0); PG8_LDB(B1, 0, 1); PG8_SCHED; PG8_LDA(At, 0, 0); PG8_STAGE(PG8_SA(1, 1), a1 + hstep, voffA);
            PG8_WAIT_V(8); PG8_WAIT_L(0); PG8_BAR; PG8_MMA(0, 0, At, B0); PG8_MMA(0, 1, At, B1); PG8_BAR; PG8_SCHED;
            PG8_LDA(At, 0, 1); PG8_STAGE(PG8_SB(0, 0), b2, voffB); PG8_STAGE(PG8_SB(0, 1), b2 + hstep, voffB); PG8_STAGE(PG8_SA(0, 0), a2, voffA);
            PG8_WAIT_V(8); PG8_WAIT_L(0); PG8_BAR; PG8_MMA(1, 0, At, B0); PG8_MMA(1, 1, At, B1); PG8_BAR; PG8_SCHED;
            PG8_LDB(B0, 1, 0); PG8_LDB(B1, 1, 1); PG8_SCHED; PG8_LDA(At, 1, 0); PG8_STAGE(PG8_SA(0, 1), a2 + hstep, voffA);
            PG8_WAIT_V(8); PG8_WAIT_L(0); PG8_BAR; PG8_MMA(0, 0, At, B0); PG8_MMA(0, 1, At, B1); PG8_BAR; PG8_SCHED;
            PG8_LDA(At, 1, 1); PG8_STAGE(PG8_SB(1, 0), b3, voffB); PG8_STAGE(PG8_SB(1, 1), b3 + hstep, voffB); PG8_STAGE(PG8_SA(1, 0), a3, voffA);
            PG8_WAIT_V(8); PG8_WAIT_L(0); PG8_BAR; PG8_MMA(1, 0, At, B0); PG8_MMA(1, 1, At, B1); PG8_BAR; PG8_SCHED;
            } else {
            PG8_LDB(B0, 0, 0); PG8_SCHED; PG8_LDA(At, 0, 0); PG8_STAGE(PG8_SA(1, 1), a1 + hstep, voffA);
            PG8_WAIT_L(8); PG8_BAR; PG8_WAIT_L(0); PG8_MMA(0, 0, At, B0); PG8_BAR; PG8_SCHED;
            PG8_LDB(B1, 0, 1); PG8_STAGE(PG8_SB(0, 0), b2, voffB);
            PG8_BAR; PG8_WAIT_L(0); PG8_MMA(0, 1, At, B1); PG8_BAR;
            PG8_LDA(At, 0, 1); PG8_STAGE(PG8_SA(0, 0), a2, voffA);
            PG8_BAR; PG8_WAIT_L(0); PG8_MMA(1, 0, At, B0); PG8_BAR; PG8_SCHED;
            PG8_STAGE(PG8_SB(0, 1), b2 + hstep, voffB);
            PG8_WAIT_V(6); PG8_BAR; PG8_MMA(1, 1, At, B1); PG8_BAR;
            PG8_LDB(B0, 1, 0); PG8_SCHED; PG8_LDA(At, 1, 0); PG8_STAGE(PG8_SA(0, 1), a2 + hstep, voffA);
            PG8_WAIT_L(8); PG8_BAR; PG8_WAIT_L(0); PG8_MMA(0, 0, At, B0); PG8_BAR; PG8_SCHED;
            PG8_LDB(B1, 1, 1); PG8_STAGE(PG8_SB(1, 0), b3, voffB);
            PG8_BAR; PG8_WAIT_L(0); PG8_MMA(0, 1, At, B1); PG8_BAR;
            PG8_LDA(At, 1, 1); PG8_STAGE(PG8_SA(1, 0), a3, voffA);
            PG8_BAR; PG8_WAIT_L(0); PG8_MMA(1, 0, At, B0); PG8_BAR; PG8_SCHED;
            PG8_STAGE(PG8_SB(1, 1), b3 + hstep, voffB);
            PG8_WAIT_V(6); PG8_BAR; PG8_MMA(1, 1, At, B1); PG8_BAR;
            }
        }
        if constexpr (ALIGN_EPI) { if (wr == 0) PG8_BAR; }
        if constexpr (!Epi::AFTER_DRAIN) { E(acc, cur, wr, wc, fr, fq); S.done(cur); }
        if (!has_next) break;
#pragma unroll
        for (int a = 0; a < 2; ++a)
#pragma unroll
            for (int b = 0; b < 2; ++b)
#pragma unroll
                for (int m = 0; m < 4; ++m)
#pragma unroll
                    for (int n = 0; n < 2; ++n) acc[a][b][m][n] = (f32x4){0.f, 0.f, 0.f, 0.f};
        cur = nxt; cA = nA; cB = nB; ++ui;
        if constexpr (ALIGN_EPI) { if (wr == 1) PG8_BAR; }
    }
    PG8_WAIT_V(0);
    if constexpr (!ALIGN_EPI) { if (wr == 0) PG8_BAR; }
    PG8_BAR;
    if constexpr (Epi::AFTER_DRAIN) { E.fused(acc, cur, wr, wc, fr, fq, lds, wid, lane); S.done(cur); }
#undef PG8_SA
#undef PG8_SB
#undef PG8_STAGE
#undef PG8_LDA
#undef PG8_LDB
#undef PG8_MMA
#undef PG8_WAIT_V
#undef PG8_WAIT_L
#undef PG8_BAR
#undef PG8_SCHED
}
}

constexpr int NWAVES = 8, NTHREADS = 512;
constexpr int BATCH = 2, SEQ = 8192, DM = 1024, DEPTH = 4, CTXL = 256;
constexpr int ML = BATCH * SEQ;
constexpr int MC = BATCH * CTXL;
constexpr int MT = ML + MC;
constexpr int HD = 64, NH = 8, NKV = 2;
constexpr int QW = 512, KVW = 128;
constexpr int HYW = 256, FNW = 256;
constexpr int Q_END = 512, K_END = 640, V_END = 768, HY_END = 1536, FN_END = 1792, INW = 4864;
constexpr int DFF = 2816, NEXP = 8;
constexpr int FH = 64, FEMB = 33;
constexpr float EPS = 1e-6f;

constexpr size_t MiB = 1u << 20;
constexpr size_t WS_CTL = 0, CTL_ZERO_BYTES = 4 * MiB;
constexpr size_t WS_WIN = 4 * MiB;
constexpr size_t WS_WPA = WS_WIN + 38 * MiB;
constexpr size_t WS_WPH = WS_WPA + 4 * MiB;
constexpr size_t WS_WPF = WS_WPH + 2 * MiB;
constexpr size_t WS_WO = WS_WPF + 2 * MiB;
constexpr size_t WS_FGU = WS_WO + 8 * MiB;
constexpr size_t WS_FD = WS_FGU + 22 * MiB;
constexpr size_t WS_MGU = WS_FD + 11 * MiB;
constexpr size_t WS_MD = WS_MGU + 176 * MiB;
constexpr size_t WS_XC = WS_MD + 88 * MiB;
constexpr size_t WS_H = WS_XC + 2 * MiB;
constexpr size_t WS_COMB = WS_H + 33 * MiB;
constexpr size_t WS_HF = WS_COMB + 1 * MiB;
constexpr size_t WS_HFC = WS_HF + 32 * MiB;
constexpr size_t WS_S = WS_HFC + 1 * MiB;
constexpr size_t WS_PR = WS_S;
constexpr size_t WS_QK = WS_PR + 157 * MiB;
constexpr size_t WS_ATT = WS_QK + 21 * MiB;
constexpr size_t WS_HYO = WS_ATT + 17 * MiB;
constexpr size_t WS_FNO = WS_HYO + 9 * MiB;
constexpr size_t WS_MACC = WS_FNO + 9 * MiB;
constexpr size_t WS_M = WS_MACC + 66 * MiB;
constexpr size_t WS_END = WS_M + 33 * MiB;
constexpr size_t WS_KS = WS_MACC;
constexpr size_t WS_ZS = WS_MACC + 32 * MiB;
constexpr size_t WS_HYT = WS_MACC + 48 * MiB;
constexpr size_t WS_FNT = WS_MACC + 57 * MiB;
constexpr size_t WS_CTMP = WS_M;
constexpr size_t WS_UT = WS_END;
constexpr size_t WS_VT = WS_UT + 33 * MiB;
constexpr size_t WS_END2 = WS_VT + 5 * MiB;
constexpr size_t WS_HID = WS_S;
constexpr int MOE_MAXP = 140;
constexpr size_t WS_XG = WS_S;
constexpr size_t WS_HIDG = WS_S + 70 * MiB;
constexpr size_t WS_Y = WS_S + 263 * MiB;
static_assert((size_t)MOE_MAXP * 256 * 2816 * 2 <= 193 * MiB && WS_Y + 70 * MiB <= WS_S + 350 * MiB, "moe scratch");
static_assert((size_t)MT * INW * 2 <= 157 * MiB && (size_t)MT * DFF * 2 <= 157 * MiB, "scratch sizes");
constexpr int CW_BAR = 4096;
constexpr int CW_CNT = 8192;
constexpr int CW_MOD = 262144;
static_assert((CW_MOD + 4 * 3 * 6144) * 4 <= (int)CTL_ZERO_BYTES, "ctl");

constexpr int LDS_BYTES = 147456;
constexpr int MISC_OFF = LDS_BYTES - 256;
constexpr int LDS_TAB = 131072;

#define LAS __attribute__((address_space(3)))
typedef unsigned short bf16;
typedef unsigned v4u __attribute__((ext_vector_type(4)));
typedef unsigned v2u __attribute__((ext_vector_type(2)));
typedef float f32x4 __attribute__((ext_vector_type(4)));
typedef float f32x2 __attribute__((ext_vector_type(2)));
#define LDS_WAIT() asm volatile("s_waitcnt lgkmcnt(0)" ::: "memory")
__device__ __forceinline__ unsigned f2bf(float f) { unsigned u = __builtin_bit_cast(unsigned, f); return (u + 0x7fffu + ((u >> 16) & 1u)) >> 16; }
__device__ __forceinline__ unsigned pk2(float lo, float hi) { return f2bf(lo) | (f2bf(hi) << 16); }
__device__ __forceinline__ float bf2f(unsigned short h) { return __builtin_bit_cast(float, (unsigned)h << 16); }
__device__ __forceinline__ float bflo(unsigned w) { return __builtin_bit_cast(float, w << 16); }
__device__ __forceinline__ float bfhi(unsigned w) { return __builtin_bit_cast(float, w & 0xffff0000u); }
__device__ __forceinline__ float shx(float v, int lane, int o) { return __builtin_bit_cast(float, __builtin_amdgcn_ds_bpermute((lane ^ o) << 2, __builtin_bit_cast(int, v))); }
__device__ __forceinline__ float wave_sum(float v, int lane) {
#pragma unroll
    for (int o = 1; o < 64; o <<= 1) v += shx(v, lane, o);
    return v;
}
__device__ __forceinline__ float wave_max(float v, int lane) {
#pragma unroll
    for (int o = 1; o < 64; o <<= 1) v = fmaxf(v, shx(v, lane, o));
    return v;
}
__device__ __forceinline__ float sin_rev(float r) { return __builtin_amdgcn_sinf(__builtin_amdgcn_fractf(r)); }
__device__ __forceinline__ float cos_rev(float r) { return __builtin_amdgcn_cosf(__builtin_amdgcn_fractf(r)); }
__device__ __forceinline__ float sigmoidf_(float x) { return __builtin_amdgcn_rcpf(1.0f + __expf(-x)); }
constexpr float INV_2PI = 0.15915494309189535f;

#define XB_TMO      128
#define XB_XCNT(j)  (256  + 64 * (j))
#define XB_XSUB(j)  (1280 + 64 * (j))
#define XB_XGEN(j)  (2304 + 64 * (j))
#define XB_TOP      3328
#define XB_TOPGEN   3392
#define XCD_BAR_WORDS 3456
#define XB_SPIN_CAP (1u << 18)

__device__ __forceinline__ unsigned xb_ld(unsigned* p)              { return __hip_atomic_load(p, __ATOMIC_RELAXED, __HIP_MEMORY_SCOPE_AGENT); }
__device__ __forceinline__ unsigned xb_add(unsigned* p, unsigned v) { return __hip_atomic_fetch_add(p, v, __ATOMIC_RELAXED, __HIP_MEMORY_SCOPE_AGENT); }
__device__ __forceinline__ unsigned xb_xcc_id() { return (unsigned)__builtin_amdgcn_s_getreg((3 << 11) | 20) & 0xFu; }
#define XB_SPIN(cond, bar) do { unsigned _sp = 0; while (cond) { __builtin_amdgcn_s_sleep(1); \
    if ((++_sp & 255u) == 0u) { if (xb_ld(&(bar)[XB_TMO])) break; if (_sp > XB_SPIN_CAP) { atomicAdd(&(bar)[XB_TMO], 1u); break; } } } } while (0)

struct XcdBarrier {
    unsigned* bar; unsigned x;
    volatile LAS unsigned* st;
};

__device__ __forceinline__ XcdBarrier xcd_barrier_post(unsigned* bar, volatile LAS unsigned* st) {
    XcdBarrier b; b.bar = bar; b.x = xb_xcc_id(); b.st = st;
    if (threadIdx.x == 0) (void)xb_add(&bar[XB_XCNT(b.x)], 1u);
    return b;
}
__device__ __forceinline__ void xcd_barrier_complete(unsigned* bar, unsigned x, unsigned& nloc, unsigned& nx) {
    const unsigned G = gridDim.x * gridDim.y * gridDim.z;
    unsigned sum, cnt, mine, sp = 0u;
    for (;;) {
        sum = 0u; cnt = 0u; mine = 0u;
#pragma unroll
        for (unsigned j = 0; j < 16; ++j) { const unsigned c = xb_ld(&bar[XB_XCNT(j)]); sum += c; cnt += (c > 0u) ? 1u : 0u; mine = (j == x) ? c : mine; }
        if (sum == G) break;
        __builtin_amdgcn_s_sleep(1);
        if ((++sp & 255u) == 0u) { if (xb_ld(&bar[XB_TMO])) break; if (sp > XB_SPIN_CAP) { atomicAdd(&bar[XB_TMO], 1u); break; } }
    }
    nloc = mine > 0u ? mine : 1u; nx = cnt > 0u ? cnt : 1u;
}

__device__ __attribute__((noinline)) void xcd_barrier_impl(unsigned* b_bar, unsigned b_x, volatile LAS unsigned* b_st) {
    XcdBarrier b; b.bar = b_bar; b.x = b_x; b.st = b_st;
    asm volatile("s_waitcnt vmcnt(0)" ::: "memory");
    __syncthreads();
    if (threadIdx.x == 0) {
        unsigned* bar = b.bar;
        __builtin_amdgcn_s_waitcnt(0);
        unsigned nloc = b.st[0], nx = b.st[1];
        if (nloc == 0u) { xcd_barrier_complete(bar, b.x, nloc, nx); b.st[0] = nloc; b.st[1] = nx; }
        const unsigned old = xb_add(&bar[XB_XSUB(b.x)], 1u);
        const unsigned gen = old / nloc;
        if (old + 1u == (gen + 1u) * nloc) {
            __builtin_amdgcn_fence(__ATOMIC_RELEASE, "agent");
            asm volatile("s_waitcnt vmcnt(0)" ::: "memory");
            const unsigned og = xb_add(&bar[XB_TOP], 1u);
            const unsigned tg = og / nx;
            if (og + 1u == (tg + 1u) * nx) xb_add(&bar[XB_TOPGEN], 1u);
            else XB_SPIN(xb_ld(&bar[XB_TOPGEN]) == tg, bar);
            __builtin_amdgcn_fence(__ATOMIC_ACQUIRE, "agent");
            xb_add(&bar[XB_XGEN(b.x)], 1u);
            asm volatile("s_waitcnt vmcnt(0)" ::: "memory");
        } else {
            XB_SPIN(xb_ld(&bar[XB_XGEN(b.x)]) == gen, bar);
            __builtin_amdgcn_fence(__ATOMIC_ACQUIRE, "agent");
            asm volatile("s_waitcnt vmcnt(0)" ::: "memory");
        }
    }
    __syncthreads();
}

struct Args { const float* in[34]; unsigned char* ws; int ph_lo, ph_hi; };
struct Frame {
    LAS unsigned char* lds;
    unsigned* ctl;
    unsigned char* ws;
    int tid, lane, wave, G, bid;
    const struct Args* a; int z;
};
__device__ __forceinline__ const float* inp(const Frame& F, int i) { return F.a->in[i + F.z]; }
__device__ __forceinline__ float* outp(const Frame& F) { return (float*)F.a->in[33 + F.z]; }
__device__ __forceinline__ unsigned char* wsp(const Frame& F) { return F.a->ws + F.z; }
enum { I_X = 0, I_C, I_CTX, I_CCTX, I_WADA, I_BADA, I_N1G, I_N2G, I_WIN, I_QG, I_KG, I_SINK, I_HCW, I_HCB, I_FW1, I_FB1, I_FF1, I_FW2, I_FB2, I_FF2, I_FW3, I_HBIAS,
       I_WPA, I_WPH, I_WPF, I_WOUT, I_FG, I_FU, I_FDN, I_ROUTER, I_MG, I_MU, I_MDN };

namespace pg8 {
struct EpiStore {
    static constexpr bool PERM = true, AFTER_DRAIN = false;
    bf16_t* O; int ldc; int ntn;
    __device__ __forceinline__ void operator()(const f32x4 (&acc)[2][2][4][2], const Unit& u, int wr, int wc, int fr, int fq) const {
        const int row0 = u.pm * BM + wr * 64 + fr, col0 = (u.pn % ntn) * BM + wc * 32 + 8 * fq;
#pragma unroll
        for (int ai = 0; ai < 2; ++ai)
#pragma unroll
            for (int m = 0; m < 4; ++m) { bf16_t* rowp = O + (size_t)(row0 + ai * HALF + m * 16) * ldc + col0;
#pragma unroll
                for (int bj = 0; bj < 2; ++bj) { const f32x4 v0 = acc[ai][bj][m][0], v1 = acc[ai][bj][m][1];
                    u32x4 w; w.x = cvt_pk_bf16(v0[0], v0[1]); w.y = cvt_pk_bf16(v0[2], v0[3]); w.z = cvt_pk_bf16(v1[0], v1[1]); w.w = cvt_pk_bf16(v1[2], v1[3]);
                    *(u32x4*)(rowp + bj * HALF) = w; } }
    }
};
struct EpiIn {
    static constexpr bool PERM = true, AFTER_DRAIN = false;
    bf16_t* O; int ldc; bf16_t* UT; bf16_t* VT; int mt;
    __device__ __forceinline__ void operator()(const f32x4 (&acc)[2][2][4][2], const Unit& u, int wr, int wc, int fr, int fq) const {
        const int row0 = u.pm * BM + wr * 64 + fr, col0 = u.pn * BM + wc * 32 + 8 * fq;
        if (u.pn == 2) {
#pragma unroll
            for (int ai = 0; ai < 2; ++ai) {
#pragma unroll
                for (int m = 0; m < 4; ++m) { bf16_t* rowp = O + (size_t)(row0 + ai * HALF + m * 16) * ldc + col0; const f32x4 v0 = acc[ai][0][m][0], v1 = acc[ai][0][m][1];
                    u32x4 w; w.x = cvt_pk_bf16(v0[0], v0[1]); w.y = cvt_pk_bf16(v0[2], v0[3]); w.z = cvt_pk_bf16(v1[0], v1[1]); w.w = cvt_pk_bf16(v1[2], v1[3]); *(u32x4*)rowp = w; }
#pragma unroll
                for (int n = 0; n < 2; ++n)
#pragma unroll
                    for (int e = 0; e < 4; ++e) { bf16_t* cp = VT + (unsigned)((wc * 32 + 8 * fq + n * 4 + e) * mt + row0 + ai * HALF);
#pragma unroll
                        for (int m = 0; m < 4; ++m) cp[m * 16] = (bf16_t)(cvt_pk_bf16(acc[ai][1][m][n][e], 0.f) & 0xffffu); }
            }
        } else if (u.pn >= 3 && u.pn < 7) {
#pragma unroll
            for (int ai = 0; ai < 2; ++ai)
#pragma unroll
                for (int bj = 0; bj < 2; ++bj)
#pragma unroll
                    for (int n = 0; n < 2; ++n)
#pragma unroll
                        for (int e = 0; e < 4; ++e) { bf16_t* cp = UT + (unsigned)((col0 - 768 + bj * HALF + n * 4 + e) * mt + row0 + ai * HALF);
#pragma unroll
                            for (int m = 0; m < 4; ++m) cp[m * 16] = (bf16_t)(cvt_pk_bf16(acc[ai][bj][m][n][e], 0.f) & 0xffffu); }
        } else {
#pragma unroll
            for (int ai = 0; ai < 2; ++ai)
#pragma unroll
                for (int m = 0; m < 4; ++m) { bf16_t* rowp = O + (size_t)(row0 + ai * HALF + m * 16) * ldc + col0;
#pragma unroll
                    for (int bj = 0; bj < 2; ++bj) { const f32x4 v0 = acc[ai][bj][m][0], v1 = acc[ai][bj][m][1];
                        u32x4 w; w.x = cvt_pk_bf16(v0[0], v0[1]); w.y = cvt_pk_bf16(v0[2], v0[3]); w.z = cvt_pk_bf16(v1[0], v1[1]); w.w = cvt_pk_bf16(v1[2], v1[3]);
                        *(u32x4*)(rowp + bj * HALF) = w; } }
        }
    }
};
struct EpiSwiglu {
    static constexpr bool PERM = true, AFTER_DRAIN = false;
    bf16_t* O; int ldc; int ntn;
    __device__ __forceinline__ void operator()(const f32x4 (&acc)[2][2][4][2], const Unit& u, int wr, int wc, int fr, int fq) const {
        const int row0 = u.pm * BM + wr * 64 + fr, col0 = (u.pn % ntn) * HALF + wc * 32 + 8 * fq;
#pragma unroll
        for (int ai = 0; ai < 2; ++ai)
#pragma unroll
            for (int m = 0; m < 4; ++m) { bf16_t* rowp = O + (size_t)(row0 + ai * HALF + m * 16) * ldc + col0;
                float h[8];
#pragma unroll
                for (int n = 0; n < 2; ++n)
#pragma unroll
                    for (int e = 0; e < 4; ++e) { const float g = acc[ai][0][m][n][e], uu = acc[ai][1][m][n][e]; h[n * 4 + e] = g * __builtin_amdgcn_rcpf(1.0f + __expf(-g)) * uu; }
                u32x4 w; w.x = cvt_pk_bf16(h[0], h[1]); w.y = cvt_pk_bf16(h[2], h[3]); w.z = cvt_pk_bf16(h[4], h[5]); w.w = cvt_pk_bf16(h[6], h[7]);
                *(u32x4*)rowp = w; }
    }
};
struct EpiMerge {
    static constexpr bool PERM = false, AFTER_DRAIN = false;
    const bf16_t* PR; float* MACC; bf16_t* Mo; int mode;
    __device__ __forceinline__ void operator()(const f32x4 (&acc)[2][2][4][2], const Unit& u, int wr, int wc, int fr, int fq) const {
        const int col0 = u.pn * BM + wc * 32 + 4 * fq;
#pragma unroll
        for (int ai = 0; ai < 2; ++ai)
#pragma unroll
            for (int m = 0; m < 4; ++m) { const int r = u.pm * BM + ai * HALF + wr * 64 + m * 16 + fr;
#pragma unroll
                for (int bj = 0; bj < 2; ++bj)
#pragma unroll
                    for (int n = 0; n < 2; ++n) { const int c = col0 + bj * HALF + n * 16;
                        typedef unsigned u32x2v __attribute__((ext_vector_type(2)));
                        const u32x2v gw = *(const u32x2v*)(PR + (size_t)r * 4864 + 1792 + mode * 1024 + c);
                        f32x4 g; g[0] = __builtin_bit_cast(float, gw.x << 16); g[1] = __builtin_bit_cast(float, gw.x & 0xffff0000u); g[2] = __builtin_bit_cast(float, gw.y << 16); g[3] = __builtin_bit_cast(float, gw.y & 0xffff0000u);
                        f32x4 v;
#pragma unroll
                        for (int e = 0; e < 4; ++e) v[e] = __builtin_amdgcn_rcpf(1.0f + __expf(-g[e])) * acc[ai][bj][m][n][e];
                        float* mp = MACC + (size_t)r * 1024 + c;
                        if (mode == 0) { *(f32x4*)mp = v; }
                        else if (mode == 1) { *(f32x4*)mp = *(const f32x4*)mp + v; }
                        else { const f32x4 t = *(const f32x4*)mp + v; u32x2v w; w.x = cvt_pk_bf16(t[0], t[1]); w.y = cvt_pk_bf16(t[2], t[3]); *(u32x2v*)(Mo + (size_t)r * 1024 + c) = w; }
                    } }
    }
};
struct EpiResid {
    static constexpr bool PERM = false, AFTER_DRAIN = false;
    const float* xin_lat; const float* xin_ctx; float* xout_lat; float* xout_ctx; const float* gate  ; const float* rowscale  ;
    __device__ __forceinline__ void operator()(const f32x4 (&acc)[2][2][4][2], const Unit& u, int wr, int wc, int fr, int fq) const {
        const int col0 = u.pn * BM + wc * 32 + 4 * fq;
        const bool isctx = u.pm >= 64;
        const int cond = isctx ? 2 : (u.pm >> 5);
        const float* xi = isctx ? xin_ctx - (size_t)16384 * 1024 : xin_lat;
        float* xo = isctx ? xout_ctx - (size_t)16384 * 1024 : xout_lat;
        const float* gp = gate + cond * 6144;
        f32x4 gv[2][2];
#pragma unroll
        for (int bj = 0; bj < 2; ++bj)
#pragma unroll
            for (int n = 0; n < 2; ++n) gv[bj][n] = *(const f32x4*)(gp + col0 + bj * HALF + n * 16);
#pragma unroll
        for (int ai = 0; ai < 2; ++ai)
#pragma unroll
            for (int m = 0; m < 4; ++m) { const int r = u.pm * BM + ai * HALF + wr * 64 + m * 16 + fr;
                const float rs = rowscale ? rowscale[(size_t)r * 8] : 1.0f;
#pragma unroll
                for (int bj = 0; bj < 2; ++bj)
#pragma unroll
                    for (int n = 0; n < 2; ++n) { const size_t off = (size_t)r * 1024 + col0 + bj * HALF + n * 16;
                        const f32x4 xv = *(const f32x4*)(xi + off);
                        *(f32x4*)(xo + off) = xv + gv[bj][n] * rs * acc[ai][bj][m][n]; } }
    }
};
struct MoeOrder {
    int ntn, G, c; const PG8_LAS int* poff;
    __device__ __forceinline__ bool next(int i, Unit& u) const {
        const int L = i * G + c; const int np = __builtin_amdgcn_readfirstlane(poff[8]);
        if (L >= np * ntn) return false;
        const int p = L / ntn, t = L - p * ntn; int e = 0;
#pragma unroll
        for (int k = 1; k < 8; ++k) e += (p >= __builtin_amdgcn_readfirstlane(poff[k])) ? 1 : 0;
        u.pm = p; u.pn = e * ntn + t; return true;
    }
    __device__ __forceinline__ void a_ready(const Unit&) const {}
    __device__ __forceinline__ void done(const Unit&) const {}
};
}

__device__ __forceinline__ void transpose_item(const float* W, int K, int N, bf16* WT, int map, LAS float* scr, int item, int lane) {
    const int nblk = N / 32, kb = item / nblk, nb = item % nblk, k0 = 64 * kb, n0 = 32 * nb;
#pragma unroll 8
    for (int i = 0; i < 32; ++i) { const int kk = 2 * i + (lane >> 5); scr[kk * 33 + (lane & 31)] = W[(size_t)(k0 + kk) * N + n0 + (lane & 31)]; }
    LDS_WAIT(); asm volatile("" ::: "memory");
    const int c = lane & 7;
#pragma unroll
    for (int j = 0; j < 4; ++j) { const int n = (lane >> 3) + 8 * j; const LAS float* s = scr + (8 * c) * 33 + n;
        v4u o; o.x = pk2(s[0 * 33], s[1 * 33]); o.y = pk2(s[2 * 33], s[3 * 33]); o.z = pk2(s[4 * 33], s[5 * 33]); o.w = pk2(s[6 * 33], s[7 * 33]);
        const int nn = n0 + n; const int drow = (map == 0) ? nn : ((nn >> 7) * 256 + (nn & 127) + (map == 2 ? 128 : 0));
        *(v4u*)(WT + (size_t)drow * K + k0 + 8 * c) = o; }
    LDS_WAIT(); asm volatile("" ::: "memory");
}

#define TR_GROUP(SRC, DST, CNT, KK, NN, MAP, DSTRIDE) { constexpr int per = ((KK) / 64) * ((NN) / 32); constexpr int tot = (CNT) * per; \
    if (r < tot) { const int mi = r / per, it2 = r % per; transpose_item((SRC) + (size_t)mi * (KK) * (NN), (KK), (NN), (DST) + (size_t)mi * (DSTRIDE), (MAP), scr, it2, F.lane); continue; } r -= tot; }

__device__ __forceinline__ void phase_prologue(Frame& F) {
    LAS float* scr = (LAS float*)(F.lds + F.wave * 17408);
    const int gw = F.bid * NWAVES + F.wave, NGW = F.G * NWAVES;
    constexpr int TOT_ITEMS = 4 * (16 * 152 + 8 * 32 + 4 * 32 + 4 * 32 + 16 * 32) + 2 * (16 * 88 * 2 + 44 * 32) + 16 * (16 * 88 * 2 + 44 * 32);
    for (int it = gw; it < TOT_ITEMS; it += NGW) {
        int r = it;
        { constexpr int per = 16 * 152, tot = 4 * per;
          if (r < tot) { const int mi = r / per, it2 = r % per; const int nb = it2 % 152;
              if (nb < 48 || nb >= 56) transpose_item(inp(F, I_WIN) + (size_t)mi * 1024 * 4864, 1024, 4864, ((bf16*)(wsp(F) + WS_WIN)) + (size_t)mi * 4864 * 1024, 0, scr, it2, F.lane);
              continue; } r -= tot; }
        TR_GROUP(inp(F, I_WPA), ((bf16*)(wsp(F) + WS_WPA)), 4, 512, 1024, 0, (size_t)1024 * 512)
        TR_GROUP(inp(F, I_WPH), ((bf16*)(wsp(F) + WS_WPH)), 4, 256, 1024, 0, (size_t)1024 * 256)
        TR_GROUP(inp(F, I_WPF), ((bf16*)(wsp(F) + WS_WPF)), 4, 256, 1024, 0, (size_t)1024 * 256)
        TR_GROUP(inp(F, I_WOUT), ((bf16*)(wsp(F) + WS_WO)), 4, 1024, 1024, 0, (size_t)1024 * 1024)
        TR_GROUP(inp(F, I_FG), ((bf16*)(wsp(F) + WS_FGU)), 2, 1024, 2816, 1, (size_t)5632 * 1024)
        TR_GROUP(inp(F, I_FU), ((bf16*)(wsp(F) + WS_FGU)), 2, 1024, 2816, 2, (size_t)5632 * 1024)
        TR_GROUP(inp(F, I_FDN), ((bf16*)(wsp(F) + WS_FD)), 2, 2816, 1024, 0, (size_t)1024 * 2816)
        TR_GROUP(inp(F, I_MG), ((bf16*)(wsp(F) + WS_MGU)), 16, 1024, 2816, 1, (size_t)5632 * 1024)
        TR_GROUP(inp(F, I_MU), ((bf16*)(wsp(F) + WS_MGU)), 16, 1024, 2816, 2, (size_t)5632 * 1024)
        TR_GROUP(inp(F, I_MDN), ((bf16*)(wsp(F) + WS_MD)), 16, 2816, 1024, 0, (size_t)1024 * 2816)
    }
    { LAS float* tl = (LAS float*)(F.lds + F.wave * 17408); LAS float* ctab = tl + 64 * 65; LAS float* stab = ctab + 64;
      ctab[F.lane] = cos_rev((float)F.lane * (1.0f / 64.0f)); stab[F.lane] = sin_rev((float)F.lane * (1.0f / 64.0f));
      for (int it = gw; it < 4 * 16 * 4; it += NGW) {
        const int l = it >> 6, kb = (it >> 2) & 15, g = it & 3;
        const float* W = inp(F, I_WIN) + (size_t)l * 1024 * 4864 + (size_t)(kb * 64) * 4864 + 1536 + g * 64;
#pragma unroll 8
        for (int kk = 0; kk < 64; ++kk) tl[kk * 65 + F.lane] = W[(size_t)kk * 4864 + F.lane];
        LDS_WAIT(); asm volatile("" ::: "memory");
        bf16* dst = ((bf16*)(wsp(F) + WS_WIN)) + (size_t)l * 4864 * 1024 + (size_t)(1536 + g * 64) * 1024 + kb * 64 + F.lane;
        for (int j = 0; j < 64; ++j) {
            const int mm = j <= 32 ? j : j - 32; float a = 0.f;
            if (j <= 32) { for (int c = 0; c < 64; ++c) a += tl[F.lane * 65 + c] * ctab[(mm * c) & 63]; }
            else { for (int c = 0; c < 64; ++c) a += tl[F.lane * 65 + c] * stab[(mm * c) & 63]; }
            dst[(size_t)j * 1024] = (bf16)f2bf(a);
        }
        LDS_WAIT(); asm volatile("" ::: "memory");
      } }
    for (int it = gw; it < 4 * 96; it += NGW) {
        const int l = it / 96, cb = it % 96;
        const float* W = inp(F, I_WADA) + (size_t)l * 1024 * 6144 + cb * 64 + F.lane;
        float a0 = 0.f, a1 = 0.f, a2 = 0.f;
#pragma unroll 8
        for (int k = 0; k < 1024; ++k) {
            const float c0 = inp(F, I_C)[k], c1 = inp(F, I_C)[1024 + k], c2 = inp(F, I_CCTX)[k];
            const float s0 = c0 * sigmoidf_(c0), s1 = c1 * sigmoidf_(c1), s2 = c2 * sigmoidf_(c2);
            const float w = W[(size_t)k * 6144];
            a0 += w * s0; a1 += w * s1; a2 += w * s2;
        }
        const float bb = inp(F, I_BADA)[l * 6144 + cb * 64 + F.lane];
        float* mo = ((float*)(wsp(F) + WS_CTL) + CW_MOD) + (size_t)l * 3 * 6144 + cb * 64 + F.lane;
        mo[0] = a0 + bb; mo[6144] = a1 + bb; mo[2 * 6144] = a2 + bb;
    }
}

__device__ __forceinline__ void moe_offsets(Frame& F, int l, LAS int* poff) {
    if (F.tid == 0) { const unsigned* cnt = (const unsigned*)(wsp(F) + WS_CTL) + CW_CNT + l * 64; int o = 0;
        for (int e = 0; e < 8; ++e) { poff[e] = o; o += (int)((__hip_atomic_load(cnt + e, __ATOMIC_RELAXED, __HIP_MEMORY_SCOPE_AGENT) + 255u) >> 8); } poff[8] = o; }
    __syncthreads();
}
template <bool ROUTER, bool COMBINE, bool NORM>
__device__ __forceinline__ void phase_norm(Frame& F, int l, const float* xlat, const float* xctx, const float* g, int moff, const float* wr, int nrows) {
    const int gw = F.bid * NWAVES + F.wave, NGW = F.G * NWAVES;
    const float* mod = ((float*)(wsp(F) + WS_CTL) + CW_MOD) + (size_t)l * 3 * 6144 + moff;
    LAS int* lcnt = (LAS int*)(F.lds + LDS_TAB);
    unsigned* info_all = (unsigned*)(wsp(F) + WS_COMB);
    if (ROUTER) { if (F.tid < 16) lcnt[F.tid] = 0; __syncthreads(); }
    for (int r = gw; r < nrows; r += NGW) {
        const bool isctx = r >= ML; const int cond = isctx ? 2 : (r >> 13);
        const float* xr = isctx ? xctx + (size_t)(r - ML) * 1024 : xlat + (size_t)r * 1024;
        f32x4 v[4]; float s = 0.f;
#pragma unroll
        for (int j = 0; j < 4; ++j) v[j] = *(const f32x4*)(xr + 256 * j + 4 * F.lane);
        if (COMBINE) {
            const unsigned* info = info_all + (size_t)r * 8;
            const float w0 = __builtin_bit_cast(float, info[2]), w1 = __builtin_bit_cast(float, info[3]);
            const bf16* y0 = ((const bf16*)(wsp(F) + WS_Y)) + (size_t)info[6] * 1024; const bf16* y1 = ((const bf16*)(wsp(F) + WS_Y)) + (size_t)info[7] * 1024;
            const float* gt = ((float*)(wsp(F) + WS_CTL) + CW_MOD) + (size_t)(l - (NORM ? 1 : 0)) * 3 * 6144 + 5120 + cond * 6144;
            float* xo = isctx ? ((float*)(wsp(F) + WS_XC)) + (size_t)(r - ML) * 1024 : outp(F) + (size_t)r * 1024;
#pragma unroll
            for (int j = 0; j < 4; ++j) { const int c = 256 * j + 4 * F.lane;
                const v2u a = *(const v2u*)(y0 + c), b = *(const v2u*)(y1 + c); const f32x4 gg = *(const f32x4*)(gt + c);
                v[j][0] += gg[0] * (w0 * bflo(a.x) + w1 * bflo(b.x)); v[j][1] += gg[1] * (w0 * bfhi(a.x) + w1 * bfhi(b.x));
                v[j][2] += gg[2] * (w0 * bflo(a.y) + w1 * bflo(b.y)); v[j][3] += gg[3] * (w0 * bfhi(a.y) + w1 * bfhi(b.y));
                *(f32x4*)(xo + c) = v[j]; }
        }
        if (!NORM) continue;
#pragma unroll
        for (int j = 0; j < 4; ++j) s += (v[j][0] * v[j][0] + v[j][1] * v[j][1]) + (v[j][2] * v[j][2] + v[j][3] * v[j][3]);
        const float rstd = 1.0f / sqrtf(wave_sum(s, F.lane) * (1.0f / 1024.0f) + EPS);
        const float* sh = mod + cond * 6144; const float* sc = sh + 1024;
        float lg[8];
        if (ROUTER) {
#pragma unroll
            for (int e = 0; e < 8; ++e) lg[e] = 0.f;
        }
#pragma unroll
        for (int j = 0; j < 4; ++j) { const int c = 256 * j + 4 * F.lane;
            const f32x4 gg = *(const f32x4*)(g + c), s1 = *(const f32x4*)(sc + c), s0 = *(const f32x4*)(sh + c);
            f32x4 y;
#pragma unroll
            for (int e = 0; e < 4; ++e) y[e] = (v[j][e] * rstd * gg[e]) * (1.0f + s1[e]) + s0[e];
            v2u o; o.x = pk2(y[0], y[1]); o.y = pk2(y[2], y[3]);
            *(v2u*)(((bf16*)(wsp(F) + WS_H)) + (size_t)r * 1024 + c) = o;
            if (ROUTER) {
#pragma unroll
                for (int e = 0; e < 4; ++e) { const f32x4 w0 = *(const f32x4*)(wr + (size_t)(c + e) * 8), w1 = *(const f32x4*)(wr + (size_t)(c + e) * 8 + 4);
                    lg[0] += y[e] * w0[0]; lg[1] += y[e] * w0[1]; lg[2] += y[e] * w0[2]; lg[3] += y[e] * w0[3];
                    lg[4] += y[e] * w1[0]; lg[5] += y[e] * w1[1]; lg[6] += y[e] * w1[2]; lg[7] += y[e] * w1[3]; }
            }
        }
        if (ROUTER) {
#pragma unroll
            for (int e = 0; e < 8; ++e) lg[e] = wave_sum(lg[e], F.lane);
            int i0 = 0; float v0 = lg[0];
#pragma unroll
            for (int e = 1; e < 8; ++e) if (lg[e] > v0) { v0 = lg[e]; i0 = e; }
            int i1 = -1; float v1 = -INFINITY;
#pragma unroll
            for (int e = 0; e < 8; ++e) if (e != i0 && lg[e] > v1) { v1 = lg[e]; i1 = e; }
            const float w0 = 1.0f / (1.0f + __expf(v1 - v0)), w1 = 1.0f - w0;
            if (F.lane == 0) { const int p0 = atomicAdd((int*)(lcnt + i0), 1), p1 = atomicAdd((int*)(lcnt + i1), 1);
                unsigned* info = info_all + (size_t)r * 8;
                info[0] = (unsigned)i0; info[1] = (unsigned)i1; info[2] = __builtin_bit_cast(unsigned, w0); info[3] = __builtin_bit_cast(unsigned, w1); info[4] = (unsigned)p0; info[5] = (unsigned)p1; }
        }
    }
    if (ROUTER) {
        asm volatile("s_waitcnt vmcnt(0) lgkmcnt(0)" ::: "memory");
        __syncthreads();
        if (F.tid < 8) { unsigned* cnt = (unsigned*)(wsp(F) + WS_CTL) + CW_CNT + l * 64; lcnt[8 + F.tid] = (int)__hip_atomic_fetch_add(cnt + F.tid, (unsigned)lcnt[F.tid], __ATOMIC_RELAXED, __HIP_MEMORY_SCOPE_AGENT); }
        __syncthreads();
        for (int r = gw; r < nrows; r += NGW) { if (F.lane < 2) { unsigned* info = info_all + (size_t)r * 8; const int e = (int)info[F.lane]; info[4 + F.lane] += (unsigned)lcnt[8 + e]; } }
    }
}

__device__ __forceinline__ void phase_gather(Frame& F, int l) {
    LAS int* poff = (LAS int*)(F.lds + LDS_TAB + 64);
    moe_offsets(F, l, poff);
    const int gw = F.bid * NWAVES + F.wave, NGW = F.G * NWAVES;
    unsigned* info_all = (unsigned*)(wsp(F) + WS_COMB);
    for (int it = gw; it < MT * 2; it += NGW) {
        const int tok = it >> 1, k = it & 1; unsigned* info = info_all + (size_t)tok * 8;
        const int e = (int)info[k], pos = (int)info[4 + k]; const int grow = 256 * poff[e] + pos;
        if (F.lane == 0) info[6 + k] = (unsigned)grow;
        const v4u* s = (const v4u*)(((const bf16*)(wsp(F) + WS_H)) + (size_t)tok * 1024); v4u* d = (v4u*)(((bf16*)(wsp(F) + WS_XG)) + (size_t)grow * 1024);
        d[F.lane] = s[F.lane]; d[64 + F.lane] = s[64 + F.lane];
    }
}

__device__ __forceinline__ void filter_tile(Frame& F, int l, int L, int p0, float* dst  ) {
    LAS float* emb = (LAS float*)F.lds;
    LAS float* h1 = emb + 64 * 33;
    LAS float* h2 = h1 + 64 * 65;
    const float* w1 = inp(F, I_FW1) + l * 33 * 64; const float* b1 = inp(F, I_FB1) + l * 64; const float* f1 = inp(F, I_FF1) + l * 64;
    const float* w2 = inp(F, I_FW2) + l * 64 * 64; const float* b2 = inp(F, I_FB2) + l * 64; const float* f2 = inp(F, I_FF2) + l * 64;
    const float* w3 = inp(F, I_FW3) + (size_t)l * 64 * 1024;
    for (int idx = F.tid; idx < 64 * 33; idx += NTHREADS) {
        const int pos = idx / 33, f = idx % 33, i = p0 + pos;
        float val;
        if (f == 0) val = (float)i / (float)(L - 1);
        else { const int j = (f - 1) & 15; const float fb = 1e-4f + (float)j * ((15.0f - 1e-4f) / 15.0f); const float rev = fb * (float)i / (float)L;
               val = (f <= 16) ? cos_rev(rev) : -sin_rev(rev); }
        emb[pos * 33 + f] = val;
    }
    __syncthreads();
    for (int idx = F.tid; idx < 4096; idx += NTHREADS) {
        const int pos = idx >> 6, u = idx & 63; float a = b1[u];
        for (int f = 0; f < 33; ++f) a += emb[pos * 33 + f] * w1[f * 64 + u];
        h1[pos * 65 + u] = sin_rev(f1[u] * a * INV_2PI);
    }
    __syncthreads();
    for (int idx = F.tid; idx < 4096; idx += NTHREADS) {
        const int pos = idx >> 6, u = idx & 63; float a = b2[u];
        for (int f = 0; f < 64; ++f) a += h1[pos * 65 + f] * w2[f * 64 + u];
        h2[pos * 65 + u] = sin_rev(f2[u] * a * INV_2PI);
    }
    __syncthreads();
    const int pos = F.lane, i = p0 + pos; const float t = (float)i / (float)(L - 1);
    for (int col = F.wave; col < 1024; col += NWAVES) {
        float a = 0.f;
        for (int f = 0; f < 64; ++f) a += h2[pos * 65 + f] * w3[f * 1024 + col];
        const int ch = col & 255; const float delta = 3.0701134573253946f + 12.280453829301578f * ((float)ch / 255.0f);
        dst[(size_t)col * L + i] = a * __expf(-t * delta);
    }
    __syncthreads();
}

__device__ __forceinline__ void phase_qkprep(Frame& F, int l) {
    const int gw = F.bid * NWAVES + F.wave, NGW = F.G * NWAVES;
    const int lane = F.lane; const int a = lane >> 5, half = (lane >> 4) & 1, f = lane & 15;
    const float inv = exp2f(-(float)f * (13.287712379549449f / 16.0f)) * INV_2PI;
    const float gq = inp(F, I_QG)[l * 64 + lane], gk = inp(F, I_KG)[l * 64 + lane];
    for (int r = gw; r < MT; r += NGW) {
        const bool isctx = r >= ML; const int t = r & 8191; const int pos = a == 0 ? (t >> 6) : (t & 63);
        float cs = 1.f, sn = 0.f;
        if (!isctx) { const float rev = (float)pos * inv; cs = cos_rev(rev); sn = sin_rev(rev); }
        const bf16* pr = ((bf16*)(wsp(F) + WS_PR)) + (size_t)r * INW;
        bf16* qk = ((bf16*)(wsp(F) + WS_QK)) + (size_t)r * 640;
#pragma unroll
        for (int h = 0; h < 10; ++h) {
            const float v = bf2f(pr[h * 64 + lane]);
            const float ss = wave_sum(v * v, lane);
            const float y = v * (1.0f / sqrtf(ss * (1.0f / 64.0f) + EPS)) * (h < 8 ? gq : gk);
            const float p = shx(y, lane, 16);
            const float o = half == 0 ? y * cs - p * sn : y * cs + p * sn;
            qk[h * 64 + lane] = (bf16)f2bf(h < 8 ? o * 0.18033688011112042f : o);
        }
    }
}

__device__ __forceinline__ float block_sum(Frame& F, float v, LAS float* red) {
    v = wave_sum(v, F.lane);
    __syncthreads();
    if (F.lane == 0) red[F.wave] = v;
    __syncthreads();
    float t = 0.f;
#pragma unroll
    for (int w = 0; w < NWAVES; ++w) t += red[w];
    return t;
}

template <int L>
__device__ __forceinline__ float hy_uc(const bf16* UT, int rowbase, int b, int t, int ch, const float* cw, const float* cb) {
    float a = cb[ch];
    const bf16* up = UT + (size_t)ch * MT + rowbase + b * L;
#pragma unroll
    for (int j = 0; j < 3; ++j) { const int tt = t + j - 1; if (tt >= 0 && tt < L) a += bf2f(up[tt]) * cw[j * 768 + ch]; }
    return a;
}

template <int L>
__device__ __forceinline__ void hyena_item_naive(Frame& F, int l, int c, int rowbase, const float* taps) {
    constexpr int NT = (L + NTHREADS - 1) / NTHREADS;
    LAS float* kt = (LAS float*)F.lds;
    LAS f32x2* z = (LAS f32x2*)(F.lds + 2 * L * 4);
    LAS float* red = (LAS float*)(F.lds + 2 * L * 4 + L * 8);
    const float* cw = inp(F, I_HCW) + l * 3 * 768; const float* cb = inp(F, I_HCB) + l * 768; const float* hb = inp(F, I_HBIAS) + l * 512;
    for (int t = F.tid; t < L; t += NTHREADS) { f32x2 v; v.x = hy_uc<L>(((bf16*)(wsp(F) + WS_UT)), rowbase, 0, t, 512 + c, cw, cb); v.y = hy_uc<L>(((bf16*)(wsp(F) + WS_UT)), rowbase, 1, t, 512 + c, cw, cb); z[t] = v; }
    for (int o = 0; o < 2; ++o) {
        const float* fwd = taps + (size_t)(o * 256 + c) * L; const float* bwd = taps + (size_t)(512 + o * 256 + c) * L;
        float part = 0.f;
        for (int d = F.tid; d < L; d += NTHREADS) { const float kf = fwd[d]; kt[L + d] = kf; part += fabsf(kf);
            if (d >= 1) { const float kb = bwd[d]; kt[L - d] = kb; part += fabsf(kb); } else kt[0] = 0.f; }
        const float tot = block_sum(F, part, red);
        const float inv = 1.0f / tot;
        __syncthreads();
        float* tmp = (float*)(wsp(F) + WS_CTMP) + (size_t)c * 2 * L;
#pragma unroll 1
        for (int t = F.tid; t < L; t += NTHREADS) {
            float a0 = 0.f, a1 = 0.f;
#pragma unroll 4
            for (int s = 0; s < L; ++s) { const f32x2 zz = z[s]; const float kv = kt[L + t - s]; a0 += kv * zz.x; a1 += kv * zz.y; }
            tmp[t] = a0; tmp[L + t] = a1;
        }
        __syncthreads();
        const float bo = hb[o * 256 + c];
#pragma unroll 1
        for (int t = F.tid; t < L; t += NTHREADS) {
            const float g0 = hy_uc<L>(((bf16*)(wsp(F) + WS_UT)), rowbase, 0, t, o * 256 + c, cw, cb), g1 = hy_uc<L>(((bf16*)(wsp(F) + WS_UT)), rowbase, 1, t, o * 256 + c, cw, cb);
            const f32x2 zo = z[t]; f32x2 zn; zn.x = g0 * (tmp[t] * inv + bo * zo.x); zn.y = g1 * (tmp[L + t] * inv + bo * zo.y); z[t] = zn;
        }
        __syncthreads();
    }
    for (int t = F.tid; t < L; t += NTHREADS) { const f32x2 v = z[t];
        ((bf16*)(wsp(F) + WS_HYT))[(size_t)c * MT + rowbase + t] = (bf16)f2bf(v.x); ((bf16*)(wsp(F) + WS_HYT))[(size_t)c * MT + rowbase + L + t] = (bf16)f2bf(v.y); }
    __syncthreads();
}

template <int L>
__device__ __forceinline__ void fnet_item_naive(Frame& F, int b, int g, int m, int rowbase) {
    LAS f32x2* AB = (LAS f32x2*)F.lds;
    LAS f32x2* tab = (LAS f32x2*)(F.lds + L * 8);
    LAS f32x2* cs64 = (LAS f32x2*)(F.lds + 2 * L * 8);
    for (int i = F.tid; i < L; i += NTHREADS) { f32x2 v; const float rev = (float)i / (float)L; v.x = cos_rev(rev); v.y = sin_rev(rev); tab[i] = v; }
    if (F.tid < 64) { f32x2 v; const float rev = (float)F.tid / 64.0f; v.x = cos_rev(rev); v.y = sin_rev(rev); cs64[F.tid] = v; }
    __syncthreads();
    for (int n = F.tid; n < L; n += NTHREADS) {
        const bf16* ut = ((const bf16*)(wsp(F) + WS_UT)) + (size_t)(768 + g * 64) * MT + rowbase + b * L + n;
        const int mm = m <= 32 ? m : 64 - m;
        f32x2 v; v.x = bf2f(ut[(size_t)mm * MT]);
        v.y = (m == 0 || m == 32) ? 0.f : (m < 32 ? bf2f(ut[(size_t)(32 + m) * MT]) : -bf2f(ut[(size_t)(32 + mm) * MT]));
        AB[n] = v;
    }
    __syncthreads();
    const float scale = 1.0f / sqrtf((float)L * 64.0f);
    for (int k = F.tid; k < L; k += NTHREADS) {
        float acc = 0.f; int idx = 0;
        for (int n = 0; n < L; ++n) { const f32x2 ab = AB[n]; const f32x2 cs = tab[idx]; acc += ab.x * cs.x - ab.y * cs.y; idx = (idx + k) & (L - 1); }
        ((bf16*)(wsp(F) + WS_FNT))[(size_t)(g * 64 + m) * MT + rowbase + b * L + k] = (bf16)f2bf(acc * scale);
    }
    __syncthreads();
}

#ifdef FFT_HOST
#define FFT_LDS
#define FFT_HD
static inline float fft_cos_rev(float r) { return (float)cos(6.283185307179586 * (double)r); }
static inline float fft_sin_rev(float r) { return (float)sin(6.283185307179586 * (double)r); }
#else
#define FFT_LDS LAS
#define FFT_HD __device__ __forceinline__
__device__ __forceinline__ float fft_cos_rev(float r) { return __builtin_amdgcn_cosf(r); }
__device__ __forceinline__ float fft_sin_rev(float r) { return __builtin_amdgcn_sinf(r); }
#endif
FFT_HD int fft_phys(int i) { return i + ((i >> 5) << 1); }
FFT_HD f32x2 fft_cmul(f32x2 a, f32x2 b) { f32x2 r; r.x = a.x * b.x - a.y * b.y; r.y = a.x * b.y + a.y * b.x; return r; }
template <int R> FFT_HD constexpr int fft_brev(int p) { int r = 0; for (int b = 1; b < R; b <<= 1) { r = (r << 1) | ((p & b) ? 1 : 0); } return r; }
template <int R, bool INV> FFT_HD void fft_regs(f32x2 (&a)[R]) {
    constexpr float C16[16] = {1.0f, 0.92387953251128674f, 0.70710678118654752f, 0.38268343236508977f, 0.0f, -0.38268343236508977f, -0.70710678118654752f, -0.92387953251128674f,
                               -1.0f, -0.92387953251128674f, -0.70710678118654752f, -0.38268343236508977f, 0.0f, 0.38268343236508977f, 0.70710678118654752f, 0.92387953251128674f};
    constexpr float S16[16] = {0.0f, 0.38268343236508977f, 0.70710678118654752f, 0.92387953251128674f, 1.0f, 0.92387953251128674f, 0.70710678118654752f, 0.38268343236508977f,
                               0.0f, -0.38268343236508977f, -0.70710678118654752f, -0.92387953251128674f, -1.0f, -0.92387953251128674f, -0.70710678118654752f, -0.38268343236508977f};
#pragma unroll
    for (int s = R / 2; s >= 1; s >>= 1) {
#pragma unroll
        for (int i = 0; i < R; ++i) {
            if ((i & s) == 0) {
                const int k = i & (s - 1);
                const f32x2 u = a[i], v = a[i + s];
                a[i] = u + v;
                const f32x2 d = u - v;
                if (k == 0) a[i + s] = d;
                else if (2 * k == s) { f32x2 t; if (INV) { t.x = -d.y; t.y = d.x; } else { t.x = d.y; t.y = -d.x; } a[i + s] = t; }
                else { const int idx = k * (16 / (2 * s)); f32x2 w; w.x = C16[idx]; w.y = INV ? S16[idx] : -S16[idx]; a[i + s] = fft_cmul(d, w); }
            }
        }
    }
}
template <int N, int NCUR, int R, bool INV, int NT>
FFT_HD void fft_pass(FFT_LDS f32x2* buf, int tid) {
    constexpr int M = NCUR / R;
#pragma unroll 1
    for (int i = tid; i < N / R; i += NT) {
        const int blk = i / M, j = i - blk * M, base = blk * NCUR + j;
        f32x2 a[R];
#pragma unroll
        for (int q = 0; q < R; ++q) a[q] = buf[fft_phys(base + q * M)];
        f32x2 w1; { const float rev = (float)j * (1.0f / (float)NCUR); w1.x = fft_cos_rev(rev); w1.y = INV ? fft_sin_rev(rev) : -fft_sin_rev(rev); }
        if (M > 1) {
            if (INV) { f32x2 w = w1;
#pragma unroll
                for (int p = 1; p < R; ++p) { a[p] = fft_cmul(a[p], w); if (p + 1 < R) w = fft_cmul(w, w1); } }
        }
        fft_regs<R, INV>(a);
        if (M > 1 && !INV) { f32x2 w = w1;
#pragma unroll
            for (int p = 1; p < R; ++p) { a[fft_brev<R>(p)] = fft_cmul(a[fft_brev<R>(p)], w); if (p + 1 < R) w = fft_cmul(w, w1); } }
#pragma unroll
        for (int p = 0; p < R; ++p) buf[fft_phys(base + p * M)] = a[fft_brev<R>(p)];
    }
}
#ifdef FFT_HOST
#define FFT_SYNC()
#else
#define FFT_SYNC() __syncthreads()
#endif

template <bool INV> __device__ __forceinline__ void fft16k(LAS f32x2* buf, int tid) {
    constexpr int N = 16384;
    if (!INV) { fft_pass<N, 16384, 16, false, NTHREADS>(buf, tid); __syncthreads(); fft_pass<N, 1024, 16, false, NTHREADS>(buf, tid); __syncthreads();
                fft_pass<N, 64, 16, false, NTHREADS>(buf, tid); __syncthreads(); fft_pass<N, 4, 4, false, NTHREADS>(buf, tid); __syncthreads(); }
    else { fft_pass<N, 4, 4, true, NTHREADS>(buf, tid); __syncthreads(); fft_pass<N, 64, 16, true, NTHREADS>(buf, tid); __syncthreads();
           fft_pass<N, 1024, 16, true, NTHREADS>(buf, tid); __syncthreads(); fft_pass<N, 16384, 16, true, NTHREADS>(buf, tid); __syncthreads(); }
}
__device__ __forceinline__ void fft8k_fwd(LAS f32x2* buf, int tid) {
    constexpr int N = 8192;
    fft_pass<N, 8192, 16, false, NTHREADS>(buf, tid); __syncthreads(); fft_pass<N, 512, 16, false, NTHREADS>(buf, tid); __syncthreads();
    fft_pass<N, 32, 16, false, NTHREADS>(buf, tid); __syncthreads(); fft_pass<N, 2, 2, false, NTHREADS>(buf, tid); __syncthreads();
}

__device__ __forceinline__ void hyena_item_fft(Frame& F, int l, int c) {
    constexpr int L = SEQ, N = 2 * SEQ;
    LAS f32x2* buf = (LAS f32x2*)F.lds;
    LAS float* red = (LAS float*)(F.lds + 139264);
    const bf16* UT = (const bf16*)(wsp(F) + WS_UT);
    const float* cw = inp(F, I_HCW) + l * 3 * 768; const float* cb = inp(F, I_HCB) + l * 768; const float* hb = inp(F, I_HBIAS) + l * 512;
    f32x2* kspec = (f32x2*)(wsp(F) + WS_KS) + (size_t)F.bid * N;
    f32x2* zold = (f32x2*)(wsp(F) + WS_ZS) + (size_t)F.bid * L;
    const float* HFp = (const float*)(wsp(F) + WS_HF);
    for (int o = 0; o < 2; ++o) {
        const float* fwd = HFp + (size_t)(o * 256 + c) * L; const float* bwd = HFp + (size_t)(512 + o * 256 + c) * L;
        float part = 0.f;
#pragma unroll 1
        for (int i = F.tid; i < N; i += NTHREADS) { float v; if (i < L) v = fwd[i]; else if (i == L) v = 0.f; else v = bwd[N - i]; part += fabsf(v); f32x2 w; w.x = v; w.y = 0.f; buf[fft_phys(i)] = w; }
        const float tot = block_sum(F, part, red);
        fft16k<false>(buf, F.tid);
        const float scale = 1.0f / (tot * (float)N);
#pragma unroll 1
        for (int i = F.tid; i < N; i += NTHREADS) kspec[i] = buf[fft_phys(i)] * scale;
        __syncthreads();
        if (o == 0) {
#pragma unroll 1
            for (int t = F.tid; t < L; t += NTHREADS) { f32x2 v; v.x = hy_uc<L>(UT, 0, 0, t, 512 + c, cw, cb); v.y = hy_uc<L>(UT, 0, 1, t, 512 + c, cw, cb);
                buf[fft_phys(t)] = v; zold[t] = v; f32x2 zz; zz.x = 0.f; zz.y = 0.f; buf[fft_phys(L + t)] = zz; }
        } else {
#pragma unroll 1
            for (int t = F.tid; t < L; t += NTHREADS) { buf[fft_phys(t)] = zold[t]; f32x2 zz; zz.x = 0.f; zz.y = 0.f; buf[fft_phys(L + t)] = zz; }
        }
        __syncthreads();
        fft16k<false>(buf, F.tid);
#pragma unroll 1
        for (int i = F.tid; i < N; i += NTHREADS) buf[fft_phys(i)] = fft_cmul(buf[fft_phys(i)], kspec[i]);
        __syncthreads();
        fft16k<true>(buf, F.tid);
        const float bo = hb[o * 256 + c];
#pragma unroll 1
        for (int t = F.tid; t < L; t += NTHREADS) {
            const f32x2 cv = buf[fft_phys(t)], zo = zold[t];
            const float g0 = hy_uc<L>(UT, 0, 0, t, o * 256 + c, cw, cb), g1 = hy_uc<L>(UT, 0, 1, t, o * 256 + c, cw, cb);
            f32x2 zn; zn.x = g0 * (cv.x + bo * zo.x); zn.y = g1 * (cv.y + bo * zo.y);
            if (o == 0) zold[t] = zn;
            else { ((bf16*)(wsp(F) + WS_HYT))[(size_t)c * MT + t] = (bf16)f2bf(zn.x); ((bf16*)(wsp(F) + WS_HYT))[(size_t)c * MT + L + t] = (bf16)f2bf(zn.y); }
        }
        __syncthreads();
    }
}

__device__ __forceinline__ void fnet_item_fft(Frame& F, int b, int g, int m) {
    constexpr int N = SEQ;
    LAS f32x2* buf = (LAS f32x2*)F.lds;
    LAS float* re = (LAS float*)(F.lds + 69632);
    LAS float* im = re + N;
    const bf16* ut = ((const bf16*)(wsp(F) + WS_UT)) + (size_t)(768 + g * 64) * MT + b * N;
    bf16* fnt = ((bf16*)(wsp(F) + WS_FNT)) + (size_t)(g * 64) * MT + b * N;
#pragma unroll 1
    for (int n = F.tid; n < N; n += NTHREADS) { f32x2 v;
        if (m == 0) { v.x = bf2f(ut[n]); v.y = bf2f(ut[(size_t)32 * MT + n]); }
        else { v.x = bf2f(ut[(size_t)m * MT + n]); v.y = -bf2f(ut[(size_t)(32 + m) * MT + n]); }
        buf[fft_phys(n)] = v; }
    __syncthreads();
    fft8k_fwd(buf, F.tid);
#pragma unroll 1
    for (int pos = F.tid; pos < N; pos += NTHREADS) { const int k = (pos >> 9) + 16 * ((pos >> 5) & 15) + 256 * ((pos >> 1) & 15) + 4096 * (pos & 1);
        const f32x2 v = buf[fft_phys(pos)]; re[k] = v.x; im[k] = v.y; }
    __syncthreads();
    const float scale = 1.0f / sqrtf((float)N * 64.0f);
#pragma unroll 1
    for (int k = F.tid; k < N; k += NTHREADS) { const int nk = (N - k) & (N - 1);
        if (m == 0) { fnt[k] = (bf16)f2bf(0.5f * (re[k] + re[nk]) * scale); fnt[(size_t)32 * MT + k] = (bf16)f2bf(0.5f * (im[k] + im[nk]) * scale); }
        else { fnt[(size_t)m * MT + k] = (bf16)f2bf(re[k] * scale); fnt[(size_t)(64 - m) * MT + k] = (bf16)f2bf(re[nk] * scale); } }
    __syncthreads();
}

typedef short bf16x8 __attribute__((ext_vector_type(8)));
typedef float f32x16 __attribute__((ext_vector_type(16)));
__device__ __forceinline__ unsigned cvtpk(float lo, float hi) { unsigned r; asm volatile("v_cvt_pk_bf16_f32 %0, %1, %2" : "=v"(r) : "v"(lo), "v"(hi)); return r; }
struct AttnChunk { bf16x8 k[4]; v2u v[2][2][2]; };
__device__ __forceinline__ void attn_load_chunk(AttnChunk& C, const bf16* QK, const bf16* VT, int keyrow0, int kvh, int r, int h) {
    const bf16* kp = QK + (size_t)(keyrow0 + r) * 640 + 512 + kvh * 64 + 8 * h;
#pragma unroll
    for (int s = 0; s < 4; ++s) C.k[s] = *(const bf16x8*)(kp + 16 * s);
#pragma unroll
    for (int dd = 0; dd < 2; ++dd) { const bf16* vp = VT + (size_t)(kvh * 64 + 32 * dd + r) * MT + keyrow0 + 4 * h;
#pragma unroll
        for (int s = 0; s < 2; ++s) { C.v[dd][s][0] = *(const v2u*)(vp + 16 * s); C.v[dd][s][1] = *(const v2u*)(vp + 16 * s + 8); } }
}
__device__ __forceinline__ void attn_item(Frame& F, int l, int item) {
    const int lane = F.lane, r = lane & 31, h = lane >> 5;
    const bf16* QK = (const bf16*)(wsp(F) + WS_QK); const bf16* VT = (const bf16*)(wsp(F) + WS_VT);
    int g, kvh, b, qrow0, t0; bool isctx;
    if (item < 4096) { g = item & 3; const int qblk = (item >> 2) & 255; kvh = (item >> 10) & 1; b = item >> 11; isctx = false; t0 = qblk * 32; qrow0 = b * SEQ + t0; }
    else { const int j = item - 4096; g = j & 3; const int qb = (j >> 2) & 7; kvh = (j >> 5) & 1; b = j >> 6; isctx = true; t0 = 0; qrow0 = ML + b * CTXL + qb * 32; }
    const int head = 4 * kvh + g;
    bf16x8 qf[4];
    { const bf16* qp = QK + (size_t)(qrow0 + r) * 640 + head * 64 + 8 * h;
#pragma unroll
      for (int s = 0; s < 4; ++s) qf[s] = *(const bf16x8*)(qp + 16 * s); }
    float m = inp(F, I_SINK)[l * 8 + head] * 1.4426950408889634f;
    float lsum = (h == 0) ? 1.0f : 0.0f;
    f32x16 o0, o1;
#pragma unroll
    for (int i = 0; i < 16; ++i) { o0[i] = 0.f; o1[i] = 0.f; }
    const int nch = isctx ? 8 : 17, nloc = isctx ? 0 : 9;
#define ATT_KEYROW(c) (((c) < nloc) ? ((t0 - 128 + 32 * (c) >= 0 && t0 - 128 + 32 * (c) < SEQ) ? (b * SEQ + t0 - 128 + 32 * (c)) : -1) : (ML + b * CTXL + 32 * ((c) - nloc)))
    AttnChunk cur, nxt;
    int c = 0; int krow = ATT_KEYROW(0);
    while (krow < 0) { ++c; krow = ATT_KEYROW(c); }
    attn_load_chunk(cur, QK, VT, krow, kvh, r, h);
    while (c < nch) {
        int cn = c + 1; int krn = -1;
        while (cn < nch) { krn = ATT_KEYROW(cn); if (krn >= 0) break; ++cn; }
        if (cn < nch) attn_load_chunk(nxt, QK, VT, krn, kvh, r, h);
        f32x16 S;
#pragma unroll
        for (int i = 0; i < 16; ++i) S[i] = 0.f;
#pragma unroll
        for (int s = 0; s < 4; ++s) S = __builtin_amdgcn_mfma_f32_32x32x16_bf16(cur.k[s], qf[s], S, 0, 0, 0);
        if (c < nloc && (c == 0 || c == 8)) {
#pragma unroll
            for (int i = 0; i < 16; ++i) { const int kidx = (i & 3) + 8 * (i >> 2) + 4 * h; const bool ok = (c == 0) ? (kidx >= r) : (kidx <= r); if (!ok) S[i] = -INFINITY; }
        }
        float cm = S[0];
#pragma unroll
        for (int i = 1; i < 16; ++i) cm = fmaxf(cm, S[i]);
        cm = fmaxf(cm, shx(cm, lane, 32));
        const float mn = fmaxf(m, cm), alpha = __builtin_amdgcn_exp2f(m - mn); m = mn;
        float ps = 0.f;
#pragma unroll
        for (int i = 0; i < 16; ++i) { S[i] = __builtin_amdgcn_exp2f(S[i] - m); ps += S[i]; }
        lsum = lsum * alpha + ps;
#pragma unroll
        for (int i = 0; i < 16; ++i) { o0[i] *= alpha; o1[i] *= alpha; }
        bf16x8 pf[2];
#pragma unroll
        for (int s = 0; s < 2; ++s) { v4u w; w.x = cvtpk(S[8 * s + 0], S[8 * s + 1]); w.y = cvtpk(S[8 * s + 2], S[8 * s + 3]); w.z = cvtpk(S[8 * s + 4], S[8 * s + 5]); w.w = cvtpk(S[8 * s + 6], S[8 * s + 7]); pf[s] = __builtin_bit_cast(bf16x8, w); }
#pragma unroll
        for (int s = 0; s < 2; ++s) {
            v4u a0; a0.x = cur.v[0][s][0].x; a0.y = cur.v[0][s][0].y; a0.z = cur.v[0][s][1].x; a0.w = cur.v[0][s][1].y;
            v4u a1; a1.x = cur.v[1][s][0].x; a1.y = cur.v[1][s][0].y; a1.z = cur.v[1][s][1].x; a1.w = cur.v[1][s][1].y;
            o0 = __builtin_amdgcn_mfma_f32_32x32x16_bf16(__builtin_bit_cast(bf16x8, a0), pf[s], o0, 0, 0, 0);
            o1 = __builtin_amdgcn_mfma_f32_32x32x16_bf16(__builtin_bit_cast(bf16x8, a1), pf[s], o1, 0, 0, 0);
        }
        cur = nxt; c = cn;
    }
#undef ATT_KEYROW
    lsum += shx(lsum, lane, 32);
    const float inv = 1.0f / lsum;
    bf16* op = ((bf16*)(wsp(F) + WS_ATT)) + (size_t)(qrow0 + r) * 512 + head * 64 + 4 * h;
#pragma unroll
    for (int g4 = 0; g4 < 4; ++g4) {
        v2u w0; w0.x = cvtpk(o0[4 * g4 + 0] * inv, o0[4 * g4 + 1] * inv); w0.y = cvtpk(o0[4 * g4 + 2] * inv, o0[4 * g4 + 3] * inv); *(v2u*)(op + 8 * g4) = w0;
        v2u w1; w1.x = cvtpk(o1[4 * g4 + 0] * inv, o1[4 * g4 + 1] * inv); w1.y = cvtpk(o1[4 * g4 + 2] * inv, o1[4 * g4 + 3] * inv); *(v2u*)(op + 32 + 8 * g4) = w1;
    }
}

__device__ __forceinline__ void attn_item_naive(Frame& F, int l, int r, int kvh, LAS float* wq, LAS float* wp) {
    const int lane = F.lane;
    const bool isctx = r >= ML; const int b = isctx ? ((r - ML) >> 8) : (r >> 13); const int t = r & 8191;
    const int lo = (t - 128) < 0 ? 0 : (t - 128), hi = (t + 128) > (SEQ - 1) ? (SEQ - 1) : (t + 128);
    const int nloc = isctx ? 0 : (hi - lo + 1), nk = nloc + CTXL;
#pragma unroll
    for (int h = 0; h < 4; ++h) wq[h * 64 + lane] = bf2f(((bf16*)(wsp(F) + WS_QK))[(size_t)r * 640 + (4 * kvh + h) * 64 + lane]) * 0.125f;
    LDS_WAIT(); asm volatile("" ::: "memory");
    for (int j = lane; j < nk; j += 64) {
        const int krow = j < nloc ? (b * SEQ + lo + j) : (ML + b * CTXL + (j - nloc));
        const bf16* kp = ((bf16*)(wsp(F) + WS_QK)) + (size_t)krow * 640 + 512 + kvh * 64;
        float s0 = 0.f, s1 = 0.f, s2 = 0.f, s3 = 0.f;
#pragma unroll
        for (int d8 = 0; d8 < 8; ++d8) { const v4u kw = *(const v4u*)(kp + d8 * 8);
            float kf[8]; kf[0] = bflo(kw.x); kf[1] = bfhi(kw.x); kf[2] = bflo(kw.y); kf[3] = bfhi(kw.y); kf[4] = bflo(kw.z); kf[5] = bfhi(kw.z); kf[6] = bflo(kw.w); kf[7] = bfhi(kw.w);
#pragma unroll
            for (int e = 0; e < 8; ++e) { const int d = d8 * 8 + e; s0 += kf[e] * wq[d]; s1 += kf[e] * wq[64 + d]; s2 += kf[e] * wq[128 + d]; s3 += kf[e] * wq[192 + d]; } }
        f32x4 sv; sv[0] = s0; sv[1] = s1; sv[2] = s2; sv[3] = s3;
        *(LAS f32x4*)(wp + j * 4) = sv;
    }
    LDS_WAIT(); asm volatile("" ::: "memory");
    f32x4 mx = {-INFINITY, -INFINITY, -INFINITY, -INFINITY};
    for (int j = lane; j < nk; j += 64) { const f32x4 sv = *(LAS f32x4*)(wp + j * 4);
#pragma unroll
        for (int h = 0; h < 4; ++h) mx[h] = fmaxf(mx[h], sv[h]); }
    f32x4 sink, den;
#pragma unroll
    for (int h = 0; h < 4; ++h) { sink[h] = inp(F, I_SINK)[l * 8 + 4 * kvh + h]; mx[h] = fmaxf(wave_max(mx[h], lane), sink[h]); den[h] = 0.f; }
    for (int j = lane; j < nk; j += 64) { f32x4 sv = *(LAS f32x4*)(wp + j * 4);
#pragma unroll
        for (int h = 0; h < 4; ++h) { sv[h] = __expf(sv[h] - mx[h]); den[h] += sv[h]; }
        *(LAS f32x4*)(wp + j * 4) = sv; }
#pragma unroll
    for (int h = 0; h < 4; ++h) den[h] = wave_sum(den[h], lane) + __expf(sink[h] - mx[h]);
    LDS_WAIT(); asm volatile("" ::: "memory");
    f32x4 o = {0.f, 0.f, 0.f, 0.f};
    for (int j = 0; j < nk; ++j) {
        const int krow = j < nloc ? (b * SEQ + lo + j) : (ML + b * CTXL + (j - nloc));
        const float v = bf2f(((bf16*)(wsp(F) + WS_PR))[(size_t)krow * INW + K_END + kvh * 64 + lane]);
        const f32x4 p = *(LAS f32x4*)(wp + j * 4);
        o += p * v;
    }
#pragma unroll
    for (int h = 0; h < 4; ++h) ((bf16*)(wsp(F) + WS_ATT))[(size_t)r * 512 + (4 * kvh + h) * 64 + lane] = (bf16)f2bf(o[h] / den[h]);
    LDS_WAIT(); asm volatile("" ::: "memory");
}


__device__ __forceinline__ void phase_trans(Frame& F) {
    LAS unsigned* tl = (LAS unsigned*)(F.lds + F.wave * 16640);
    const int gw = F.bid * NWAVES + F.wave, NGW = F.G * NWAVES, lane = F.lane;
    for (int it = gw; it < 2 * 264 * 4; it += NGW) {
        const int which = it / (264 * 4), rem = it % (264 * 4), rt = rem >> 2, ct = rem & 3;
        const bf16* src = which == 0 ? ((const bf16*)(wsp(F) + WS_HYT)) : ((const bf16*)(wsp(F) + WS_FNT));
        bf16* dst = which == 0 ? ((bf16*)(wsp(F) + WS_HYO)) : ((bf16*)(wsp(F) + WS_FNO));
#pragma unroll 8
        for (int ch = 0; ch < 64; ++ch) tl[ch * 65 + lane] = src[(size_t)(ct * 64 + ch) * MT + rt * 64 + lane];
        LDS_WAIT(); asm volatile("" ::: "memory");
#pragma unroll 8
        for (int row = 0; row < 64; ++row) dst[(size_t)(rt * 64 + row) * 256 + ct * 64 + lane] = (bf16)tl[lane * 65 + row];
        LDS_WAIT(); asm volatile("" ::: "memory");
    }
}

__device__ __forceinline__ void phase_mix_naive(Frame& F, int l) {
    { const int gw = F.bid * NWAVES + F.wave, NGW = F.G * NWAVES;
      for (int it = gw; it < 4096 + 128; it += NGW) attn_item(F, l, it); }
    __syncthreads();
    for (int c = F.bid; c < 256; c += F.G) hyena_item_fft(F, l, c);
    for (int c = F.bid; c < 256; c += F.G) hyena_item_naive<CTXL>(F, l, c, ML, ((float*)(wsp(F) + WS_HFC)));
    for (int it = F.bid; it < 256; it += F.G) fnet_item_fft(F, it >> 7, (it >> 5) & 3, it & 31);
    for (int it = F.bid; it < 512; it += F.G) fnet_item_naive<CTXL>(F, it >> 8, (it >> 6) & 3, it & 63, ML);
}

constexpr int NPL = 11;
constexpr int NPHASES = 1 + DEPTH * NPL + 1;
#ifndef ONE_LAUNCH
#define ONE_LAUNCH 1
#endif

__global__ void __launch_bounds__(NTHREADS, 2) fwd_kernel(Args args) {
    extern __shared__ __attribute__((aligned(16))) unsigned char lds[];
    Frame F;
    F.lds = (LAS unsigned char*)lds;
    F.tid = threadIdx.x; F.lane = F.tid & 63; F.wave = __builtin_amdgcn_readfirstlane(F.tid >> 6);
    F.G = gridDim.x; F.bid = blockIdx.x;
    unsigned char* ws = args.ws; F.ws = ws;
    F.ctl = (unsigned*)(ws + WS_CTL);
    F.a = &args; F.z = 0;
    volatile LAS unsigned* MISC = (volatile LAS unsigned*)(F.lds + MISC_OFF);
    for (int u = F.tid; u < 64; u += NTHREADS) MISC[u] = 0u;
    __syncthreads();
    const int lo = args.ph_lo, hi = args.ph_hi;
    XcdBarrier bar; bar.bar = F.ctl + CW_BAR; bar.x = 0; bar.st = nullptr;
    if (hi - lo > 1) bar = xcd_barrier_post(F.ctl + CW_BAR, MISC + 8);
#define PH_BEGIN(k) if (lo <= (k) && (k) < hi) { { int t_ = threadIdx.x; asm volatile("" : "+v"(t_)); F.tid = t_; F.lane = t_ & 63; F.wave = __builtin_amdgcn_readfirstlane(t_ >> 6); int z_ = 0; asm volatile("" : "+s"(z_)); F.z = z_; }
#define PH_END(k) if ((k) + 1 < hi) xcd_barrier_impl(bar.bar, bar.x, bar.st); }

    PH_BEGIN(0) phase_prologue(F); PH_END(0)

    for (int l = 0; l < DEPTH; ++l) {
        const int pb = 1 + l * NPL;
        const float* xin_lat = (l == 0) ? inp(F, I_X) : outp(F);
        const float* xin_ctx = (l == 0) ? inp(F, I_CTX) : ((float*)(wsp(F) + WS_XC));
        const float* modl = ((float*)(wsp(F) + WS_CTL) + CW_MOD) + (size_t)l * 3 * 6144;
        const bool moe = (l & 1) != 0; const int fi = l >> 1;

        PH_BEGIN(pb + 0)
            if (l > 0 && ((l - 1) & 1)) phase_norm<false, true, true>(F, l, xin_lat, xin_ctx, inp(F, I_N1G) + l * 1024, 0, nullptr, MT);
            else phase_norm<false, false, true>(F, l, xin_lat, xin_ctx, inp(F, I_N1G) + l * 1024, 0, nullptr, MT);
            for (int it = F.bid; it < 132; it += F.G) { if (it < 128) filter_tile(F, l, SEQ, it * 64, ((float*)(wsp(F) + WS_HF))); else filter_tile(F, l, CTXL, (it - 128) * 64, ((float*)(wsp(F) + WS_HFC))); }
        PH_END(pb + 0)

        PH_BEGIN(pb + 1)
            pg8::Gemm g{((bf16*)(wsp(F) + WS_H)), ((bf16*)(wsp(F) + WS_WIN)) + (size_t)l * INW * 1024, MT, INW, 1024}; pg8::StaticOrder S; S.init(MT, INW, F.G, F.bid);
            pg8::EpiIn E{((bf16*)(wsp(F) + WS_PR)), INW, ((bf16*)(wsp(F) + WS_UT)), ((bf16*)(wsp(F) + WS_VT)), MT};
            pg8::gemm_phase<pg8::EpiIn, pg8::StaticOrder, true, true>(F.lds, g, S, E);
        PH_END(pb + 1)

        PH_BEGIN(pb + 2) phase_qkprep(F, l); PH_END(pb + 2)

        PH_BEGIN(pb + 3) phase_mix_naive(F, l); PH_END(pb + 3)

        PH_BEGIN(pb + 4) phase_trans(F); PH_END(pb + 4)

        PH_BEGIN(pb + 5)
            for (int br = 0; br < 3; ++br) {
                const bf16* A = br == 0 ? ((bf16*)(wsp(F) + WS_ATT)) : (br == 1 ? ((bf16*)(wsp(F) + WS_HYO)) : ((bf16*)(wsp(F) + WS_FNO)));
                const bf16* Bt = br == 0 ? ((bf16*)(wsp(F) + WS_WPA)) + (size_t)l * 1024 * 512 : (br == 1 ? ((bf16*)(wsp(F) + WS_WPH)) + (size_t)l * 1024 * 256 : ((bf16*)(wsp(F) + WS_WPF)) + (size_t)l * 1024 * 256);
                const int K = br == 0 ? 512 : 256;
                pg8::Gemm g{A, Bt, MT, 1024, K}; pg8::StaticOrder S; S.init(MT, 1024, F.G, F.bid);
                pg8::EpiMerge E{((bf16*)(wsp(F) + WS_PR)), ((float*)(wsp(F) + WS_MACC)), ((bf16*)(wsp(F) + WS_M)), br};
                pg8::gemm_phase<pg8::EpiMerge, pg8::StaticOrder, true, true>(F.lds, g, S, E);
                __syncthreads();
            }
        PH_END(pb + 5)

        PH_BEGIN(pb + 6)
            pg8::Gemm g{((bf16*)(wsp(F) + WS_M)), ((bf16*)(wsp(F) + WS_WO)) + (size_t)l * 1024 * 1024, MT, 1024, 1024}; pg8::StaticOrder S; S.init(MT, 1024, F.G, F.bid);
            pg8::EpiResid E{xin_lat, xin_ctx, outp(F), ((float*)(wsp(F) + WS_XC)), modl + 2048, nullptr};
            pg8::gemm_phase<pg8::EpiResid, pg8::StaticOrder, true, true>(F.lds, g, S, E);
        PH_END(pb + 6)

        PH_BEGIN(pb + 7)
            if (moe) phase_norm<true, false, true>(F, l, outp(F), ((float*)(wsp(F) + WS_XC)), inp(F, I_N2G) + l * 1024, 3072, inp(F, I_ROUTER) + (size_t)fi * 1024 * 8, MT);
            else phase_norm<false, false, true>(F, l, outp(F), ((float*)(wsp(F) + WS_XC)), inp(F, I_N2G) + l * 1024, 3072, nullptr, MT);
        PH_END(pb + 7)

        if (moe) {
            PH_BEGIN(pb + 8) phase_gather(F, l); PH_END(pb + 8)
        }

        PH_BEGIN(pb + 9)
            LAS int* poff = (LAS int*)(F.lds + LDS_TAB + 64);
            if (moe) {
                moe_offsets(F, l, poff);
                pg8::Gemm g{((bf16*)(wsp(F) + WS_XG)), ((bf16*)(wsp(F) + WS_MGU)) + (size_t)(fi * 8) * 5632 * 1024, MOE_MAXP * 256, 8 * 5632, 1024}; pg8::MoeOrder S{22, F.G, F.bid, poff};
                pg8::EpiSwiglu E{((bf16*)(wsp(F) + WS_HIDG)), DFF, 22};
                pg8::gemm_phase<pg8::EpiSwiglu, pg8::MoeOrder, true, true>(F.lds, g, S, E);
            } else {
                pg8::Gemm g{((bf16*)(wsp(F) + WS_H)), ((bf16*)(wsp(F) + WS_FGU)) + (size_t)fi * 5632 * 1024, MT, 5632, 1024}; pg8::StaticOrder S; S.init(MT, 5632, F.G, F.bid);
                pg8::EpiSwiglu E{((bf16*)(wsp(F) + WS_HID)), DFF, 22};
                pg8::gemm_phase<pg8::EpiSwiglu, pg8::StaticOrder, true, true>(F.lds, g, S, E);
            }
        PH_END(pb + 9)

        PH_BEGIN(pb + 10)
            LAS int* poff = (LAS int*)(F.lds + LDS_TAB + 64);
            if (moe) {
                moe_offsets(F, l, poff);
                pg8::Gemm g{((bf16*)(wsp(F) + WS_HIDG)), ((bf16*)(wsp(F) + WS_MD)) + (size_t)(fi * 8) * 1024 * 2816, MOE_MAXP * 256, 8 * 1024, DFF}; pg8::MoeOrder S{4, F.G, F.bid, poff};
                pg8::EpiStore E{((bf16*)(wsp(F) + WS_Y)), 1024, 4};
                pg8::gemm_phase<pg8::EpiStore, pg8::MoeOrder, true, true>(F.lds, g, S, E);
            } else {
                pg8::Gemm g{((bf16*)(wsp(F) + WS_HID)), ((bf16*)(wsp(F) + WS_FD)) + (size_t)fi * 1024 * 2816, MT, 1024, DFF}; pg8::StaticOrder S; S.init(MT, 1024, F.G, F.bid);
                pg8::EpiResid E{outp(F), ((float*)(wsp(F) + WS_XC)), outp(F), ((float*)(wsp(F) + WS_XC)), modl + 5120, nullptr};
                pg8::gemm_phase<pg8::EpiResid, pg8::StaticOrder, true, true>(F.lds, g, S, E);
            }
        PH_END(pb + 10)
    }
    PH_BEGIN(1 + DEPTH * NPL) phase_norm<false, true, false>(F, DEPTH - 1, outp(F), ((float*)(wsp(F) + WS_XC)), nullptr, 0, nullptr, ML); PH_END(1 + DEPTH * NPL)
#undef PH_BEGIN
#undef PH_END
}

extern "C" void kernel_launch(void* const* d_in, const int* in_sizes, int n_in, void* d_out, int out_size, void* d_ws, size_t ws_size, hipStream_t stream) {
    static int grid = 0;
    if (grid == 0) {
        if (n_in != 33 || out_size != ML * DM || ws_size < WS_END2) { fprintf(stderr, "kernel_launch: unexpected shapes (n_in %d out %d ws %zu need %zu)\n", n_in, out_size, ws_size, (size_t)WS_END2); grid = -1; return; }
        int dev = 0, cus = 0, per_cu = 0;
        if (hipGetDevice(&dev) != hipSuccess || hipDeviceGetAttribute(&cus, hipDeviceAttributeMultiprocessorCount, dev) != hipSuccess) { grid = -1; return; }
        if (hipFuncSetAttribute((const void*)fwd_kernel, hipFuncAttributeMaxDynamicSharedMemorySize, LDS_BYTES) != hipSuccess) { fprintf(stderr, "kernel_launch: hipFuncSetAttribute failed\n"); grid = -1; return; }
        if (hipOccupancyMaxActiveBlocksPerMultiprocessor(&per_cu, (const void*)fwd_kernel, NTHREADS, LDS_BYTES) != hipSuccess || per_cu < 1) { fprintf(stderr, "kernel_launch: occupancy query says %d\n", per_cu); }
        (void)hipGetLastError();
        grid = cus;
    }
    if (grid < 0) return;
    if (hipMemsetAsync((char*)d_ws + WS_CTL, 0, CTL_ZERO_BYTES, stream) != hipSuccess) return;
    Args a{};
    for (int i = 0; i < 33; ++i) a.in[i] = (const float*)d_in[i];
    a.in[33] = (const float*)d_out; a.ws = (unsigned char*)d_ws;
#if ONE_LAUNCH
    a.ph_lo = 0; a.ph_hi = NPHASES;
    hipLaunchKernelGGL(fwd_kernel, dim3(grid), dim3(NTHREADS), LDS_BYTES, stream, a);
#else
    for (int k = 0; k < NPHASES; ++k) {
        if (k >= 1 && k < NPHASES - 1) { const int l = (k - 1) / NPL, p = (k - 1) % NPL; if ((l & 1) == 0 && p == 8) continue; }
        a.ph_lo = k; a.ph_hi = k + 1;
        hipLaunchKernelGGL(fwd_kernel, dim3(grid), dim3(NTHREADS), LDS_BYTES, stream, a);
    }
#endif
}
```

```cpp
#include <hip/hip_runtime.h>
#include <cstdio>
#include <cstdint>
#ifndef PROBE_MASK
#define PROBE_MASK 0
#endif
#ifndef PROBE_AMP
#define PROBE_AMP 4
#endif
#define SUBPR_START(t) if (PROBE_MASK && ((PROBE_MASK >> (t)) & 1)) { __syncthreads(); F.pr_t0 = __builtin_amdgcn_s_memrealtime(); }
#define SUBPR_STOP(t) if (PROBE_MASK && ((PROBE_MASK >> (t)) & 1)) { __syncthreads(); F.pr_acc += __builtin_amdgcn_s_memrealtime() - F.pr_t0; }
namespace pg8 {
#define PG8_LAS __attribute__((address_space(3)))
typedef unsigned short bf16_t;
typedef short bf16x8 __attribute__((ext_vector_type(8)));
typedef float f32x4 __attribute__((ext_vector_type(4)));
typedef unsigned u32x4 __attribute__((ext_vector_type(4)));
constexpr int BM = 256, BK = 64, HALF = 128, HTB = HALF * BK * 2  , STAGE_BYTES = 8 * HTB, NXCD = 8, WGM = 8;

__host__ __device__ __forceinline__ int lds_byte(int r, int c) { const int st = (r >> 4) * 2 + (c >> 5), rr = r & 15, cc = c & 31, ob = rr * 64 + cc * 2; return st * 1024 + (ob ^ (((ob >> 9) & 1) << 5)); }
__host__ __device__ __forceinline__ void stage_rc(int b, int& R, int& C) { const int st = b / 1024, sb = b % 1024, swz = sb ^ (((sb >> 9) & 1) << 5); R = (st >> 1) * 16 + swz / 64; C = (st & 1) * 32 + (swz % 64) / 2; }
__host__ __device__ __forceinline__ int perm32(int rho) { const int n = rho >> 4, i = rho & 15; return 8 * (i >> 2) + 4 * n + (i & 3); }

struct Unit { int pm, pn; };
struct Gemm { const bf16_t* A; const bf16_t* Bt; int M, N, K; };

struct StaticOrder {
    int nM, nN, nwg, G, c;
    __host__ __device__ void init(int M, int N, int G_, int c_) { nM = M / BM; nN = N / BM; nwg = nM * nN; G = G_; c = c_; }
    __host__ __device__ bool next(int i, Unit& u) const {
        const long L = (long)i * G + c; if (L >= nwg) return false;
        int wgid = (int)L; { const int q = nwg / NXCD, r = nwg % NXCD, xcd = wgid % NXCD, off = wgid / NXCD; wgid = (xcd < r ? xcd * (q + 1) : r * (q + 1) + (xcd - r) * q) + off; }
        const int nig = WGM * nN, gid = wgid / nig, fm = gid * WGM, gsz = (nM - fm) < WGM ? (nM - fm) : WGM;
        u.pm = fm + ((wgid % nig) % gsz); u.pn = (wgid % nig) / gsz; return true;
    }
    __device__ __forceinline__ void a_ready(const Unit&) const {}
    __device__ __forceinline__ void done(const Unit&) const {}
};

__device__ __forceinline__ unsigned cvt_pk_bf16(float lo, float hi) { typedef float f32x2_c __attribute__((ext_vector_type(2))); typedef __bf16 bf16x2_c __attribute__((ext_vector_type(2))); f32x2_c v = {lo, hi}; bf16x2_c b = __builtin_convertvector(v, bf16x2_c); return __builtin_bit_cast(unsigned, b); }
typedef float f32x2 __attribute__((ext_vector_type(2)));
template <class Epi, class Sched, bool ALIGN_EPI = false, bool SP2 = false>
__device__ __forceinline__ void gemm_phase(PG8_LAS unsigned char* lds, const Gemm g, const Sched& S, const Epi& E) {
    int tid_ = threadIdx.x; asm volatile("" : "+v"(tid_)); const int tid = tid_, wid = __builtin_amdgcn_readfirstlane(tid >> 6), lane = tid & 63, wr = wid >> 2, wc = wid & 3, fr = lane & 15, fq = lane >> 4;
    const int K = g.K, nt = K / BK;
    unsigned voffA[2], voffB[2];
#pragma unroll
    for (int i = 0; i < 2; ++i) { int R, C; stage_rc(tid * 16 + i * 8192, R, C); const int Rb = Epi::PERM ? ((R & ~31) + perm32(R & 31)) : R;
        voffA[i] = (unsigned)(R * K + C) * 2u; voffB[i] = (unsigned)(Rb * K + C) * 2u; }
    const size_t kstep = (size_t)(BK * 2);
    const size_t hstep = (size_t)HALF * K * 2;
    const size_t tstep = 2 * hstep;
    const unsigned ldsw = (unsigned)wid * 1024u;
    const int aoff = lds_byte(wr * 64 + fr, fq * 8), boff = lds_byte(wc * 32 + fr, fq * 8);
#define PG8_SA(b, h) (((b) * 2 + (h)) * HTB)
#define PG8_SB(b, h) ((4 + (b) * 2 + (h)) * HTB)
#define PG8_STAGE(bufoff, gbase, voff) do { _Pragma("unroll") for (int _i = 0; _i < 2; ++_i) \
        __builtin_amdgcn_global_load_lds((const unsigned*)((const char*)(gbase) + (voff)[_i]), (PG8_LAS unsigned*)(lds + (bufoff) + ldsw + _i * 8192), 16, 0, 0); } while (0)
#define PG8_LDA(dst, b, h) do { _Pragma("unroll") for (int m = 0; m < 4; ++m) _Pragma("unroll") for (int k = 0; k < 2; ++k) dst[m][k] = *(const PG8_LAS bf16x8*)(lds + PG8_SA(b, h) + aoff + m * 2048 + k * 1024); } while (0)
#define PG8_LDB(dst, b, h) do { _Pragma("unroll") for (int n = 0; n < 2; ++n) _Pragma("unroll") for (int k = 0; k < 2; ++k) dst[n][k] = *(const PG8_LAS bf16x8*)(lds + PG8_SB(b, h) + boff + n * 2048 + k * 1024); } while (0)
#define PG8_MMA(ai, bj, At, Bt) do { __builtin_amdgcn_s_setprio(1); _Pragma("unroll") for (int m = 0; m < 4; ++m) _Pragma("unroll") for (int n = 0; n < 2; ++n) _Pragma("unroll") for (int k = 0; k < 2; ++k) \
        acc[ai][bj][m][n] = __builtin_amdgcn_mfma_f32_16x16x32_bf16(Bt[n][k], At[m][k], acc[ai][bj][m][n], 0, 0, 0); __builtin_amdgcn_s_setprio(0); } while (0)
#define PG8_WAIT_V(n) asm volatile("s_waitcnt vmcnt(" #n ")" ::: "memory")
#define PG8_WAIT_L(n) asm volatile("s_waitcnt lgkmcnt(" #n ")" ::: "memory")
#define PG8_BAR __builtin_amdgcn_s_barrier()
#define PG8_SCHED __builtin_amdgcn_sched_barrier(0)
    Unit cur, nxt; int ui = 0;
    if (!S.next(0, cur)) return;
    f32x4 acc[2][2][4][2];
#pragma unroll
    for (int a = 0; a < 2; ++a)
#pragma unroll
        for (int b = 0; b < 2; ++b)
#pragma unroll
            for (int m = 0; m < 4; ++m)
#pragma unroll
                for (int n = 0; n < 2; ++n) acc[a][b][m][n] = (f32x4){0.f, 0.f, 0.f, 0.f};
    bf16x8 At[4][2], B0[2][2], B1[2][2];
    const char* cA = (const char*)g.A + (size_t)cur.pm * tstep; const char* cB = (const char*)g.Bt + (size_t)cur.pn * tstep;
    S.a_ready(cur);
    if constexpr (SP2) {
        PG8_STAGE(PG8_SB(0, 0), cB, voffB); PG8_STAGE(PG8_SB(0, 1), cB + hstep, voffB); PG8_STAGE(PG8_SA(0, 0), cA, voffA); PG8_STAGE(PG8_SA(0, 1), cA + hstep, voffA);
        if (wr == 1) PG8_BAR;
        PG8_WAIT_V(2); PG8_BAR;
        PG8_STAGE(PG8_SB(1, 0), cB + kstep, voffB); PG8_STAGE(PG8_SA(1, 0), cA + kstep, voffA); PG8_STAGE(PG8_SB(1, 1), cB + hstep + kstep, voffB);
        PG8_WAIT_V(6); PG8_BAR;
    } else {
        PG8_STAGE(PG8_SB(0, 0), cB, voffB); PG8_STAGE(PG8_SA(0, 0), cA, voffA); PG8_STAGE(PG8_SB(0, 1), cB + hstep, voffB); PG8_STAGE(PG8_SA(0, 1), cA + hstep, voffA);
        if (wr == 1) PG8_BAR;
        PG8_WAIT_V(4); PG8_BAR;
        PG8_STAGE(PG8_SB(1, 0), cB + kstep, voffB); PG8_STAGE(PG8_SA(1, 0), cA + kstep, voffA); PG8_STAGE(PG8_SB(1, 1), cB + hstep + kstep, voffB);
        PG8_WAIT_V(6); PG8_BAR;
    }
    for (;;) {
        const bool has_next = S.next(ui + 1, nxt);
        const char* nA = has_next ? (const char*)g.A + (size_t)nxt.pm * tstep : cA; const char* nB = has_next ? (const char*)g.Bt + (size_t)nxt.pn * tstep : cB;
        for (int t = 0; t < nt; t += 2) {
            if constexpr (Epi::HOOK) { if (E.hook_at(t)) E.hook(acc, cur, t, wr, wc, fr, fq); }
            const bool last = (t == nt - 2);
            const char* a1 = cA + (size_t)(t + 1) * kstep;
            const char* a2 = last ? nA : cA + (size_t)(t + 2) * kstep; const char* b2 = last ? nB : cB + (size_t)(t + 2) * kstep;
            const char* a3 = a2 + kstep; const char* b3 = b2 + kstep;
            if (last && has_next) S.a_ready(nxt);
            if constexpr (SP2) {
            PG8_LDB(B0, 0, 0); PG8_LDB(B1, 0, 1); PG8_SCHED; PG8_LDA(At, 0, 0); PG8_STAGE(PG8_SA(1, 1), a1 + hstep, voffA);
            PG8_WAIT_V(8); PG8_WAIT_L(0); PG8_BAR; PG8_MMA(0, 0, At, B0); PG8_MMA(0, 1, At, B1); PG8_BAR; PG8_SCHED;
            PG8_LDA(At, 0, 1); PG8_STAGE(PG8_SB(0, 0), b2, voffB); PG8_STAGE(PG8_SB(0, 1), b2 + hstep, voffB); PG8_STAGE(PG8_SA(0, 0), a2, voffA);
            PG8_WAIT_V(8); PG8_WAIT_L(0); PG8_BAR; PG8_MMA(1, 0, At, B0); PG8_MMA(1, 1, At, B1); PG8_BAR; PG8_SCHED;
            PG8_LDB(B0, 1, 0); PG8_LDB(B1, 1, 1); PG8_SCHED; PG8_LDA(At, 1, 0); PG8_STAGE(PG8_SA(0, 1), a2 + hstep, voffA);
            PG8_WAIT_V(8); PG8_WAIT_L(0); PG8_BAR; PG8_MMA(0, 0, At, B0); PG8_MMA(0, 1, At, B1); PG8_BAR; PG8_SCHED;
            PG8_LDA(At, 1, 1); PG8_STAGE(PG8_SB(1, 0), b3, voffB); PG8_STAGE(PG8_SB(1, 1), b3 + hstep, voffB); PG8_STAGE(PG8_SA(1, 0), a3, voffA);
            PG8_WAIT_V(8); PG8_WAIT_L(0); PG8_BAR; PG8_MMA(1, 0, At, B0); PG8_MMA(1, 1, At, B1); PG8_BAR; PG8_SCHED;
            } else {
            PG8_LDB(B0, 0, 0); PG8_SCHED; PG8_LDA(At, 0, 0); PG8_STAGE(PG8_SA(1, 1), a1 + hstep, voffA);
            PG8_WAIT_L(8); PG8_BAR; PG8_WAIT_L(0); PG8_MMA(0, 0, At, B0); PG8_BAR; PG8_SCHED;
            PG8_LDB(B1, 0, 1); PG8_STAGE(PG8_SB(0, 0), b2, voffB);
            PG8_BAR; PG8_WAIT_L(0); PG8_MMA(0, 1, At, B1); PG8_BAR;
            PG8_LDA(At, 0, 1); PG8_STAGE(PG8_SA(0, 0), a2, voffA);
            PG8_BAR; PG8_WAIT_L(0); PG8_MMA(1, 0, At, B0); PG8_BAR; PG8_SCHED;
            PG8_STAGE(PG8_SB(0, 1), b2 + hstep, voffB);
            PG8_WAIT_V(6); PG8_BAR; PG8_MMA(1, 1, At, B1); PG8_BAR;
            PG8_LDB(B0, 1, 0); PG8_SCHED; PG8_LDA(At, 1, 0); PG8_STAGE(PG8_SA(0, 1), a2 + hstep, voffA);
            PG8_WAIT_L(8); PG8_BAR; PG8_WAIT_L(0); PG8_MMA(0, 0, At, B0); PG8_BAR; PG8_SCHED;
            PG8_LDB(B1, 1, 1); PG8_STAGE(PG8_SB(1, 0), b3, voffB);
            PG8_BAR; PG8_WAIT_L(0); PG8_MMA(0, 1, At, B1); PG8_BAR;
            PG8_LDA(At, 1, 1); PG8_STAGE(PG8_SA(1, 0), a3, voffA);
            PG8_BAR; PG8_WAIT_L(0); PG8_MMA(1, 0, At, B0); PG8_BAR; PG8_SCHED;
            PG8_STAGE(PG8_SB(1, 1), b3 + hstep, voffB);
            PG8_WAIT_V(6); PG8_BAR; PG8_MMA(1, 1, At, B1); PG8_BAR;
            }
        }
        if constexpr (ALIGN_EPI) { if (wr == 0) PG8_BAR; }
        if constexpr (!Epi::AFTER_DRAIN) { E(acc, cur, wr, wc, fr, fq); S.done(cur); }
        if (!has_next) break;
#pragma unroll
        for (int a = 0; a < 2; ++a)
#pragma unroll
            for (int b = 0; b < 2; ++b)
#pragma unroll
                for (int m = 0; m < 4; ++m)
#pragma unroll
                    for (int n = 0; n < 2; ++n) acc[a][b][m][n] = (f32x4){0.f, 0.f, 0.f, 0.f};
        cur = nxt; cA = nA; cB = nB; ++ui;
        if constexpr (ALIGN_EPI) { if (wr == 1) PG8_BAR; }
    }
    PG8_WAIT_V(0);
    if constexpr (!ALIGN_EPI) { if (wr == 0) PG8_BAR; }
    PG8_BAR;
    if constexpr (Epi::AFTER_DRAIN) { E.fused(acc, cur, wr, wc, fr, fq, lds, wid, lane); S.done(cur); }
#undef PG8_SA
#undef PG8_SB
#undef PG8_STAGE
#undef PG8_LDA
#undef PG8_LDB
#undef PG8_MMA
#undef PG8_WAIT_V
#undef PG8_WAIT_L
#undef PG8_BAR
#undef PG8_SCHED
}
}

constexpr int NWAVES = 8, NTHREADS = 512;
constexpr int BATCH = 2, SEQ = 8192, DM = 1024, DEPTH = 4, CTXL = 256;
constexpr int ML = BATCH * SEQ;
constexpr int MC = BATCH * CTXL;
constexpr int MT = ML + MC;
constexpr int HD = 64, NH = 8, NKV = 2;
constexpr int QW = 512, KVW = 128;
constexpr int HYW = 256, FNW = 256;
constexpr int Q_END = 512, K_END = 640, V_END = 768, HY_END = 1536, FN_END = 1792, INW = 4864;
constexpr int DFF = 2816, NEXP = 8;
constexpr int FH = 64, FEMB = 33;
constexpr float EPS = 1e-6f;

constexpr size_t MiB = 1u << 20;
constexpr size_t WS_CTL = 0, CTL_ZERO_BYTES = 64 * 1024, CTL_BYTES = 4 * MiB;
constexpr size_t WS_WIN = 4 * MiB;
constexpr size_t WS_WPA = WS_WIN + 38 * MiB;
constexpr size_t WS_WPH = WS_WPA + 4 * MiB;
constexpr size_t WS_WPF = WS_WPH + 2 * MiB;
constexpr size_t WS_WO = WS_WPF + 2 * MiB;
constexpr size_t WS_FGU = WS_WO + 8 * MiB;
constexpr size_t WS_FD = WS_FGU + 22 * MiB;
constexpr size_t WS_MGU = WS_FD + 11 * MiB;
constexpr size_t WS_MD = WS_MGU + 176 * MiB;
constexpr size_t WS_XC = WS_MD + 88 * MiB;
constexpr size_t WS_H = WS_XC + 2 * MiB;
constexpr size_t WS_COMB = WS_H + 33 * MiB;
constexpr size_t WS_HF = WS_COMB + 1 * MiB;
constexpr size_t WS_HFC = WS_HF + 32 * MiB;
constexpr size_t WS_S = WS_HFC + 1 * MiB;
constexpr size_t WS_PR = WS_S;
constexpr size_t WS_QK = WS_PR + 157 * MiB;
constexpr size_t WS_ATT = WS_QK + 21 * MiB;
constexpr size_t WS_HYO = WS_ATT + 17 * MiB;
constexpr size_t WS_FNO = WS_HYO + 9 * MiB;
constexpr size_t WS_AM = WS_ATT;
constexpr size_t WS_MACC = WS_FNO + 9 * MiB;
constexpr size_t WS_M = WS_MACC + 66 * MiB;
constexpr size_t WS_END = WS_M + 33 * MiB;
constexpr size_t WS_KS = WS_MACC;
constexpr size_t WS_ZS = WS_MACC + 64 * MiB;
constexpr size_t WS_HYT = WS_MACC + 80 * MiB;
constexpr size_t WS_FNT = WS_MACC + 89 * MiB;
static_assert(WS_FNT + 9 * MiB <= WS_MACC + 99 * MiB, "mix scratch inside MACC + M");
constexpr size_t WS_CTMP = WS_M;
constexpr size_t WS_UT = WS_END;
constexpr size_t WS_VT = WS_UT + 33 * MiB;
constexpr size_t WS_KT = WS_VT + 5 * MiB;
constexpr size_t WS_XS = WS_KT + 5 * MiB;
constexpr size_t WS_W3T = WS_XS + 33 * MiB;
constexpr size_t WS_END2 = WS_W3T + 1 * MiB;
constexpr int NKB = MT / 32;
constexpr size_t WS_HID = WS_S;
constexpr int MOE_MAXP = 140;
constexpr size_t WS_XG = WS_S;
constexpr size_t WS_HIDG = WS_S + 70 * MiB;
constexpr size_t WS_Y = WS_S + 263 * MiB;
static_assert((size_t)MOE_MAXP * 256 * 2816 * 2 <= 193 * MiB && WS_Y + 70 * MiB <= WS_S + 350 * MiB, "moe scratch");
static_assert((size_t)MT * INW * 2 <= 157 * MiB && (size_t)MT * DFF * 2 <= 157 * MiB, "scratch sizes");
#define EPI_WS_PR WS_PR
#define EPI_WS_UT WS_UT
#define EPI_WS_VT WS_VT
#define EPI_WS_KT WS_KT
#define EPI_WS_QK WS_QK
#define EPI_WS_QKG (WS_CTL + (size_t)CW_QKG * 4)
constexpr int CW_BAR = 4096;
constexpr int CW_QKG = 12288;
constexpr int CW_CNT = 8192;
constexpr int CW_MOD = 262144;
static_assert((CW_MOD + 4 * 3 * 6144) * 4 <= (int)CTL_BYTES && (CW_CNT + 4 * 64) * 4 <= (int)CTL_ZERO_BYTES && (CW_BAR + 3456) * 4 <= (int)CTL_ZERO_BYTES, "ctl");

constexpr int LDS_BYTES = 147456;
constexpr int MISC_OFF = LDS_BYTES - 256;
constexpr int LDS_TAB = 131072;

#define LAS __attribute__((address_space(3)))
typedef unsigned short bf16;
typedef unsigned v4u __attribute__((ext_vector_type(4)));
typedef unsigned v2u __attribute__((ext_vector_type(2)));
typedef float f32x4 __attribute__((ext_vector_type(4)));
typedef float f32x2 __attribute__((ext_vector_type(2)));
#define LDS_WAIT() asm volatile("s_waitcnt lgkmcnt(0)" ::: "memory")
__device__ __forceinline__ unsigned f2bf(float f) { unsigned u = __builtin_bit_cast(unsigned, f); return (u + 0x7fffu + ((u >> 16) & 1u)) >> 16; }
__device__ __forceinline__ unsigned pk2(float lo, float hi) { return f2bf(lo) | (f2bf(hi) << 16); }
__device__ __forceinline__ float bf2f(unsigned short h) { return __builtin_bit_cast(float, (unsigned)h << 16); }
__device__ __forceinline__ float bflo(unsigned w) { return __builtin_bit_cast(float, w << 16); }
__device__ __forceinline__ float bfhi(unsigned w) { return __builtin_bit_cast(float, w & 0xffff0000u); }
__device__ __forceinline__ float shx(float v, int lane, int o) { return __builtin_bit_cast(float, __builtin_amdgcn_ds_bpermute((lane ^ o) << 2, __builtin_bit_cast(int, v))); }
__device__ __forceinline__ float wave_sum(float v, int lane) {
#pragma unroll
    for (int o = 1; o < 64; o <<= 1) v += shx(v, lane, o);
    return v;
}
__device__ __forceinline__ float wave_max(float v, int lane) {
#pragma unroll
    for (int o = 1; o < 64; o <<= 1) v = fmaxf(v, shx(v, lane, o));
    return v;
}
__device__ __forceinline__ float sin_rev(float r) { return __builtin_amdgcn_sinf(__builtin_amdgcn_fractf(r)); }
__device__ __forceinline__ float cos_rev(float r) { return __builtin_amdgcn_cosf(__builtin_amdgcn_fractf(r)); }
__device__ __forceinline__ float sigmoidf_(float x) { return __builtin_amdgcn_rcpf(1.0f + __expf(-x)); }
constexpr float INV_2PI = 0.15915494309189535f;

#define XB_TMO      128
#define XB_XCNT(j)  (256  + 64 * (j))
#define XB_XSUB(j)  (1280 + 64 * (j))
#define XB_XGEN(j)  (2304 + 64 * (j))
#define XB_TOP      3328
#define XB_TOPGEN   3392
#define XCD_BAR_WORDS 3456
#define XB_SPIN_CAP (1u << 18)

__device__ __forceinline__ unsigned xb_ld(unsigned* p)              { return __hip_atomic_load(p, __ATOMIC_RELAXED, __HIP_MEMORY_SCOPE_AGENT); }
__device__ __forceinline__ unsigned xb_add(unsigned* p, unsigned v) { return __hip_atomic_fetch_add(p, v, __ATOMIC_RELAXED, __HIP_MEMORY_SCOPE_AGENT); }
__device__ __forceinline__ unsigned xb_xcc_id() { return (unsigned)__builtin_amdgcn_s_getreg((3 << 11) | 20) & 0xFu; }
#define XB_SPIN(cond, bar) do { unsigned _sp = 0; while (cond) { __builtin_amdgcn_s_sleep(1); \
    if ((++_sp & 255u) == 0u) { if (xb_ld(&(bar)[XB_TMO])) break; if (_sp > XB_SPIN_CAP) { atomicAdd(&(bar)[XB_TMO], 1u); break; } } } } while (0)

struct XcdBarrier {
    unsigned* bar; unsigned x;
    volatile LAS unsigned* st;
};

__device__ __forceinline__ XcdBarrier xcd_barrier_post(unsigned* bar, volatile LAS unsigned* st) {
    XcdBarrier b; b.bar = bar; b.x = xb_xcc_id(); b.st = st;
    if (threadIdx.x == 0) (void)xb_add(&bar[XB_XCNT(b.x)], 1u);
    return b;
}
__device__ __forceinline__ void xcd_barrier_complete(unsigned* bar, unsigned x, unsigned& nloc, unsigned& nx) {
    const unsigned G = gridDim.x * gridDim.y * gridDim.z;
    unsigned sum, cnt, mine, sp = 0u;
    for (;;) {
        sum = 0u; cnt = 0u; mine = 0u;
#pragma unroll
        for (unsigned j = 0; j < 16; ++j) { const unsigned c = xb_ld(&bar[XB_XCNT(j)]); sum += c; cnt += (c > 0u) ? 1u : 0u; mine = (j == x) ? c : mine; }
        if (sum == G) break;
        __builtin_amdgcn_s_sleep(1);
        if ((++sp & 255u) == 0u) { if (xb_ld(&bar[XB_TMO])) break; if (sp > XB_SPIN_CAP) { atomicAdd(&bar[XB_TMO], 1u); break; } }
    }
    nloc = mine > 0u ? mine : 1u; nx = cnt > 0u ? cnt : 1u;
}

__device__ __attribute__((noinline)) void xcd_barrier_impl(unsigned* b_bar, unsigned b_x, volatile LAS unsigned* b_st) {
    XcdBarrier b; b.bar = b_bar; b.x = b_x; b.st = b_st;
    asm volatile("s_waitcnt vmcnt(0)" ::: "memory");
    __syncthreads();
    if (threadIdx.x == 0) {
        unsigned* bar = b.bar;
        __builtin_amdgcn_s_waitcnt(0);
        unsigned nloc = b.st[0], nx = b.st[1];
        if (nloc == 0u) { xcd_barrier_complete(bar, b.x, nloc, nx); b.st[0] = nloc; b.st[1] = nx; }
        const unsigned old = xb_add(&bar[XB_XSUB(b.x)], 1u);
        const unsigned gen = old / nloc;
        if (old + 1u == (gen + 1u) * nloc) {
            __builtin_amdgcn_fence(__ATOMIC_RELEASE, "agent");
            asm volatile("s_waitcnt vmcnt(0)" ::: "memory");
            const unsigned og = xb_add(&bar[XB_TOP], 1u);
            const unsigned tg = og / nx;
            if (og + 1u == (tg + 1u) * nx) xb_add(&bar[XB_TOPGEN], 1u);
            else XB_SPIN(xb_ld(&bar[XB_TOPGEN]) == tg, bar);
            __builtin_amdgcn_fence(__ATOMIC_ACQUIRE, "agent");
            xb_add(&bar[XB_XGEN(b.x)], 1u);
            asm volatile("s_waitcnt vmcnt(0)" ::: "memory");
        } else {
            XB_SPIN(xb_ld(&bar[XB_XGEN(b.x)]) == gen, bar);
            __builtin_amdgcn_fence(__ATOMIC_ACQUIRE, "agent");
            asm volatile("s_waitcnt vmcnt(0)" ::: "memory");
        }
    }
    __syncthreads();
}

struct Args { const float* in[34]; unsigned char* ws; int ph_lo, ph_hi; };
struct Frame {
    LAS unsigned char* lds;
    unsigned* ctl;
    unsigned char* ws;
    int tid, lane, wave, G, bid;
    const struct Args* a; int z;
    unsigned long long pr_acc, pr_t0;
};
__device__ __forceinline__ const float* inp(const Frame& F, int i) { return F.a->in[i + F.z]; }
__device__ __forceinline__ float* outp(const Frame& F) { return (float*)F.a->in[33 + F.z]; }
__device__ __forceinline__ unsigned char* wsp(const Frame& F) { return F.a->ws + F.z; }
enum { I_X = 0, I_C, I_CTX, I_CCTX, I_WADA, I_BADA, I_N1G, I_N2G, I_WIN, I_QG, I_KG, I_SINK, I_HCW, I_HCB, I_FW1, I_FB1, I_FF1, I_FW2, I_FB2, I_FF2, I_FW3, I_HBIAS,
       I_WPA, I_WPH, I_WPF, I_WOUT, I_FG, I_FU, I_FDN, I_ROUTER, I_MG, I_MU, I_MDN };

namespace pg8 {
struct EpiStore {
    static constexpr bool PERM = true, AFTER_DRAIN = false, HOOK = false;
    bf16_t* O; int ldc; int ntn;
    __device__ __forceinline__ void operator()(const f32x4 (&acc)[2][2][4][2], const Unit& u, int wr, int wc, int fr, int fq) const {
        const int row0 = u.pm * BM + wr * 64 + fr, col0 = (u.pn % ntn) * BM + wc * 32 + 8 * fq;
#pragma unroll
        for (int ai = 0; ai < 2; ++ai)
#pragma unroll
            for (int m = 0; m < 4; ++m) { bf16_t* rowp = O + (size_t)(row0 + ai * HALF + m * 16) * ldc + col0;
#pragma unroll
                for (int bj = 0; bj < 2; ++bj) { const f32x4 v0 = acc[ai][bj][m][0], v1 = acc[ai][bj][m][1];
                    u32x4 w; w.x = cvt_pk_bf16(v0[0], v0[1]); w.y = cvt_pk_bf16(v0[2], v0[3]); w.z = cvt_pk_bf16(v1[0], v1[1]); w.w = cvt_pk_bf16(v1[2], v1[3]);
                    *(u32x4*)(rowp + bj * HALF) = w; } }
    }
};
struct EpiIn {
    static constexpr bool PERM = true, AFTER_DRAIN = false, HOOK = false;
    unsigned char* ws; int l;
    __device__ __forceinline__ void operator()(const f32x4 (&acc)[2][2][4][2], const Unit& u, int wr, int wc, int fr_, int fq_) const {
        int fr = fr_, fq = fq_; asm volatile("" : "+v"(fr), "+v"(fq));
        constexpr int ldc = 4864, mt = 16896;
        bf16_t* const O = (bf16_t*)(ws + EPI_WS_PR); bf16_t* const UT = (bf16_t*)(ws + EPI_WS_UT); bf16_t* const VT = (bf16_t*)(ws + EPI_WS_VT); bf16_t* const KT = (bf16_t*)(ws + EPI_WS_KT); bf16_t* const QK = (bf16_t*)(ws + EPI_WS_QK);
        const float* const qg = (const float*)(ws + EPI_WS_QKG) + l * 128; const float* const kg = qg + 64;
        const int row0 = u.pm * BM + wr * 64 + fr, col0 = u.pn * BM + wc * 32 + 8 * fq;
        if (u.pn < 2 || (u.pn == 2 && wc < 2)) {
            const bool isk = (u.pn == 2); const float* gain = isk ? kg : qg; const int lane = fr + 16 * fq; const bool rope = u.pm < 64;
            f32x4 gn[2][2]; float invf[4];
#pragma unroll
            for (int bj = 0; bj < 2; ++bj)
#pragma unroll
                for (int n = 0; n < 2; ++n) gn[bj][n] = *(const f32x4*)(gain + 32 * bj + 16 * n + 4 * fq);
#pragma unroll
            for (int e = 0; e < 4; ++e) invf[e] = exp2f(-(float)(4 * fq + e) * (13.287712379549449f / 16.0f)) * 0.15915494309189535f;
            const float osc = isk ? 1.0f : 0.18033688011112042f;
#pragma unroll
            for (int ai = 0; ai < 2; ++ai)
#pragma unroll
                for (int m = 0; m < 4; ++m) { const int row = row0 + ai * HALF + m * 16;
                    float ss = 0.f;
#pragma unroll
                    for (int bj = 0; bj < 2; ++bj)
#pragma unroll
                        for (int n = 0; n < 2; ++n) { const f32x4 v = acc[ai][bj][m][n]; ss += (v[0] * v[0] + v[1] * v[1]) + (v[2] * v[2] + v[3] * v[3]); }
                    { const unsigned sb = __builtin_bit_cast(unsigned, ss); auto r16 = __builtin_amdgcn_permlane16_swap(sb, sb, false, false);
                      ss = __builtin_bit_cast(float, (unsigned)r16[0]) + __builtin_bit_cast(float, (unsigned)r16[1]);
                      const unsigned sc = __builtin_bit_cast(unsigned, ss); auto r32 = __builtin_amdgcn_permlane32_swap(sc, sc, false, false);
                      ss = __builtin_bit_cast(float, (unsigned)r32[0]) + __builtin_bit_cast(float, (unsigned)r32[1]); }
                    const float rstd = 1.0f / sqrtf(ss * (1.0f / 64.0f) + 1e-6f) * osc;
                    const int t = row & 8191;
#pragma unroll
                    for (int bj = 0; bj < 2; ++bj) { const float pos = (float)(bj == 0 ? (t >> 6) : (t & 63));
                        f32x4 o1, o2;
#pragma unroll
                        for (int e = 0; e < 4; ++e) { float cs = 1.f, sn = 0.f;
                            if (rope) { const float rev = __builtin_amdgcn_fractf(pos * invf[e]); cs = __builtin_amdgcn_cosf(rev); sn = __builtin_amdgcn_sinf(rev); }
                            const float y1 = acc[ai][bj][m][0][e] * rstd * gn[bj][0][e], y2 = acc[ai][bj][m][1][e] * rstd * gn[bj][1][e];
                            o1[e] = y1 * cs - y2 * sn; o2[e] = y1 * sn + y2 * cs; }
                        typedef unsigned u32x2v __attribute__((ext_vector_type(2)));
                        u32x2v w1, w2; w1.x = cvt_pk_bf16(o1[0], o1[1]); w1.y = cvt_pk_bf16(o1[2], o1[3]); w2.x = cvt_pk_bf16(o2[0], o2[1]); w2.y = cvt_pk_bf16(o2[2], o2[3]);
                        if (!isk) { bf16_t* qp = QK + (size_t)row * 640 + (4 * u.pn + wc) * 64 + 32 * bj + 4 * fq; *(u32x2v*)qp = w1; *(u32x2v*)(qp + 16) = w2; }
                        else { bf16_t* kp = KT + (unsigned)(((wc * (mt >> 5) + (row >> 5)) * 4 + 2 * bj) * 512 + (fq >> 1) * 256 + (row & 31) * 8 + 4 * (fq & 1)); *(u32x2v*)kp = w1; *(u32x2v*)(kp + 512) = w2; }
                    }
                    asm volatile("" ::: "memory"); __builtin_amdgcn_sched_barrier(0); }
        } else if (u.pn == 2) {
            bf16_t* vb = VT + (unsigned)(((fr >> 2) & 1) * 256 + ((fr >> 3) & 1) * 4 + (fr & 3) + (u.pm * 8 + wr * 2) * 2048 + (wc - 2) * (mt >> 5) * 2048 + fq * 64);
#pragma unroll
            for (int ai = 0; ai < 2; ++ai)
#pragma unroll
                for (int bj = 0; bj < 2; ++bj)
#pragma unroll
                    for (int m = 0; m < 4; ++m)
#pragma unroll
                        for (int n = 0; n < 2; ++n)
#pragma unroll
                            for (int e = 0; e < 4; ++e) vb[bj * 1024 + ai * 4 * 2048 + (m >> 1) * 2048 + (m & 1) * 512 + (4 * n + e) * 8] = (bf16_t)(cvt_pk_bf16(acc[ai][bj][m][n][e], 0.f) & 0xffffu);
        } else if (u.pn < 7) {
#pragma unroll
            for (int ai = 0; ai < 2; ++ai)
#pragma unroll
                for (int bj = 0; bj < 2; ++bj)
#pragma unroll
                    for (int n = 0; n < 2; ++n)
#pragma unroll
                        for (int e = 0; e < 4; ++e) { bf16_t* cp = UT + (unsigned)((col0 - 768 + bj * HALF + n * 4 + e) * mt + row0 + ai * HALF);
#pragma unroll
                            for (int m = 0; m < 4; ++m) cp[m * 16] = (bf16_t)(cvt_pk_bf16(acc[ai][bj][m][n][e], 0.f) & 0xffffu); }
        } else {
#pragma unroll
            for (int ai = 0; ai < 2; ++ai)
#pragma unroll
                for (int m = 0; m < 4; ++m) { bf16_t* rowp = O + (size_t)(row0 + ai * HALF + m * 16) * ldc + col0;
#pragma unroll
                    for (int bj = 0; bj < 2; ++bj) { f32x4 v0 = acc[ai][bj][m][0], v1 = acc[ai][bj][m][1];
#pragma unroll
                        for (int e = 0; e < 4; ++e) { v0[e] = __builtin_amdgcn_rcpf(1.0f + __expf(-v0[e])); v1[e] = __builtin_amdgcn_rcpf(1.0f + __expf(-v1[e])); }
                        u32x4 w; w.x = cvt_pk_bf16(v0[0], v0[1]); w.y = cvt_pk_bf16(v0[2], v0[3]); w.z = cvt_pk_bf16(v1[0], v1[1]); w.w = cvt_pk_bf16(v1[2], v1[3]);
                        *(u32x4*)(rowp + bj * HALF) = w; } }
        }
    }
};
struct EpiSwiglu {
    static constexpr bool PERM = true, AFTER_DRAIN = false, HOOK = false;
    bf16_t* O; int ldc; int ntn;
    __device__ __forceinline__ void operator()(const f32x4 (&acc)[2][2][4][2], const Unit& u, int wr, int wc, int fr, int fq) const {
        const int row0 = u.pm * BM + wr * 64 + fr, col0 = (u.pn % ntn) * HALF + wc * 32 + 8 * fq;
#pragma unroll
        for (int ai = 0; ai < 2; ++ai)
#pragma unroll
            for (int m = 0; m < 4; ++m) { bf16_t* rowp = O + (size_t)(row0 + ai * HALF + m * 16) * ldc + col0;
                float h[8];
#pragma unroll
                for (int n = 0; n < 2; ++n)
#pragma unroll
                    for (int e = 0; e < 4; ++e) { const float g = acc[ai][0][m][n][e], uu = acc[ai][1][m][n][e]; h[n * 4 + e] = g * __builtin_amdgcn_rcpf(1.0f + __expf(-g)) * uu; }
                u32x4 w; w.x = cvt_pk_bf16(h[0], h[1]); w.y = cvt_pk_bf16(h[2], h[3]); w.z = cvt_pk_bf16(h[4], h[5]); w.w = cvt_pk_bf16(h[6], h[7]);
                *(u32x4*)rowp = w; }
    }
};
struct EpiMerge {
    static constexpr bool PERM = true, AFTER_DRAIN = false, HOOK = true;
    const bf16_t* PR; bf16_t* Mo;
    __device__ __forceinline__ bool hook_at(int t) const { return t == 8 || t == 12; }
    __device__ __forceinline__ static void ld8(const bf16_t* p, float (&g)[8]) { const u32x4 w = *(const u32x4*)p;
        g[0] = __builtin_bit_cast(float, w.x << 16); g[1] = __builtin_bit_cast(float, w.x & 0xffff0000u); g[2] = __builtin_bit_cast(float, w.y << 16); g[3] = __builtin_bit_cast(float, w.y & 0xffff0000u);
        g[4] = __builtin_bit_cast(float, w.z << 16); g[5] = __builtin_bit_cast(float, w.z & 0xffff0000u); g[6] = __builtin_bit_cast(float, w.w << 16); g[7] = __builtin_bit_cast(float, w.w & 0xffff0000u); }
    __device__ __forceinline__ void hook(f32x4 (&acc)[2][2][4][2], const Unit& u, int t, int wr, int wc, int fr, int fq) const {
        const int col0 = u.pn * BM + wc * 32 + 8 * fq; const int ga = t == 8 ? 0 : 1;
#pragma unroll
        for (int ai = 0; ai < 2; ++ai)
#pragma unroll
            for (int m = 0; m < 4; ++m) { const int r = u.pm * BM + ai * HALF + wr * 64 + m * 16 + fr; const bf16_t* gp = PR + (size_t)r * 4864 + 1792 + ga * 1024 + col0;
#pragma unroll
                for (int bj = 0; bj < 2; ++bj) { float sa[8], sb[8]; ld8(gp + bj * HALF, sa); ld8(gp + 1024 + bj * HALF, sb);
#pragma unroll
                    for (int e = 0; e < 4; ++e) { acc[ai][bj][m][0][e] *= sa[e] * __builtin_amdgcn_rcpf(sb[e]); acc[ai][bj][m][1][e] *= sa[4 + e] * __builtin_amdgcn_rcpf(sb[4 + e]); } } }
    }
    __device__ __forceinline__ void operator()(const f32x4 (&acc)[2][2][4][2], const Unit& u, int wr, int wc, int fr, int fq) const {
        const int col0 = u.pn * BM + wc * 32 + 8 * fq;
#pragma unroll
        for (int ai = 0; ai < 2; ++ai)
#pragma unroll
            for (int m = 0; m < 4; ++m) { const int r = u.pm * BM + ai * HALF + wr * 64 + m * 16 + fr; const bf16_t* gp = PR + (size_t)r * 4864 + 1792 + 2048 + col0;
#pragma unroll
                for (int bj = 0; bj < 2; ++bj) { float s2[8]; ld8(gp + bj * HALF, s2); const f32x4 v0 = acc[ai][bj][m][0], v1 = acc[ai][bj][m][1];
                    u32x4 w; w.x = cvt_pk_bf16(v0[0] * s2[0], v0[1] * s2[1]); w.y = cvt_pk_bf16(v0[2] * s2[2], v0[3] * s2[3]); w.z = cvt_pk_bf16(v1[0] * s2[4], v1[1] * s2[5]); w.w = cvt_pk_bf16(v1[2] * s2[6], v1[3] * s2[7]);
                    *(u32x4*)(Mo + (size_t)r * 1024 + col0 + bj * HALF) = w; } }
    }
};
struct EpiResid {
    static constexpr bool PERM = false, AFTER_DRAIN = false, HOOK = false;
    bf16_t* xs  ; const float* gate  ;
    __device__ __forceinline__ void operator()(const f32x4 (&acc)[2][2][4][2], const Unit& u, int wr, int wc, int fr, int fq) const {
        const int col0 = u.pn * BM + wc * 32 + 4 * fq;
        const int cond = u.pm >> 5;
        const float* gp = gate + cond * 6144;
        f32x4 gv[2][2];
#pragma unroll
        for (int bj = 0; bj < 2; ++bj)
#pragma unroll
            for (int n = 0; n < 2; ++n) gv[bj][n] = *(const f32x4*)(gp + col0 + bj * HALF + n * 16);
        typedef unsigned u32x2v __attribute__((ext_vector_type(2)));
#pragma unroll
        for (int ai = 0; ai < 2; ++ai)
#pragma unroll
            for (int m = 0; m < 4; ++m) { const int r = u.pm * BM + ai * HALF + wr * 64 + m * 16 + fr;
#pragma unroll
                for (int bj = 0; bj < 2; ++bj)
#pragma unroll
                    for (int n = 0; n < 2; ++n) { const unsigned off = (unsigned)r * 1024u + (unsigned)(col0 + bj * HALF + n * 16);
                        const u32x2v xw = *(const u32x2v*)(xs + off);
                        f32x4 xv; xv[0] = __builtin_bit_cast(float, xw.x << 16); xv[1] = __builtin_bit_cast(float, xw.x & 0xffff0000u); xv[2] = __builtin_bit_cast(float, xw.y << 16); xv[3] = __builtin_bit_cast(float, xw.y & 0xffff0000u);
                        const f32x4 y = xv + gv[bj][n] * acc[ai][bj][m][n];
                        u32x2v o; o.x = cvt_pk_bf16(y[0], y[1]); o.y = cvt_pk_bf16(y[2], y[3]);
                        *(u32x2v*)(xs + off) = o; } }
    }
};
struct MoeOrder {
    int ntn, G, c; const PG8_LAS int* poff;
    __device__ __forceinline__ bool next(int i, Unit& u) const {
        const int L = i * G + c; const int np = __builtin_amdgcn_readfirstlane(poff[8]);
        if (L >= np * ntn) return false;
        const int p = L / ntn, t = L - p * ntn; int e = 0;
#pragma unroll
        for (int k = 1; k < 8; ++k) e += (p >= __builtin_amdgcn_readfirstlane(poff[k])) ? 1 : 0;
        u.pm = p; u.pn = e * ntn + t; return true;
    }
    __device__ __forceinline__ void a_ready(const Unit&) const {}
    __device__ __forceinline__ void done(const Unit&) const {}
};
}

struct TrDesc { const float* W; bf16* WT; int K, N, map, ldk, koff, item; bool skip; };
__device__ __forceinline__ void tr_load(const TrDesc& d, float (&tv)[32], int lane) {
    if (d.skip) return;
    const int nblk = d.N / 32, kb = d.item / nblk, nb = d.item % nblk, k0 = 64 * kb, n0 = 32 * nb;
#pragma unroll
    for (int i = 0; i < 32; ++i) tv[i] = d.W[(size_t)(k0 + 2 * i + (lane >> 5)) * d.N + n0 + (lane & 31)];
}
__device__ __forceinline__ void tr_finish(const TrDesc& d, const float (&tv)[32], LAS float* scr, int lane) {
    if (d.skip) return;
    const int nblk = d.N / 32, kb = d.item / nblk, nb = d.item % nblk, k0 = 64 * kb, n0 = 32 * nb;
#pragma unroll
    for (int i = 0; i < 32; ++i) scr[(2 * i + (lane >> 5)) * 33 + (lane & 31)] = tv[i];
    LDS_WAIT(); asm volatile("" ::: "memory");
    const int c = lane & 7;
#pragma unroll
    for (int j = 0; j < 4; ++j) { const int n = (lane >> 3) + 8 * j; const LAS float* s = scr + (8 * c) * 33 + n;
        v4u o; o.x = pk2(s[0 * 33], s[1 * 33]); o.y = pk2(s[2 * 33], s[3 * 33]); o.z = pk2(s[4 * 33], s[5 * 33]); o.w = pk2(s[6 * 33], s[7 * 33]);
        const int nn = n0 + n; int drow;
        if (d.map == 0) drow = nn;
        else if (d.map == 3) {
            if (nn < 640) { const int head = nn >> 6, dd = nn & 63, a = dd >> 5, hf = (dd >> 4) & 1, f = dd & 15; const int tile = head < 8 ? (head >> 2) : 2, wcc = head < 8 ? (head & 3) : (head - 8);
                drow = tile * 256 + 128 * a + 32 * wcc + 8 * (f >> 2) + 4 * hf + (f & 3); }
            else if (nn < 768) { const int vh = (nn - 640) >> 6, dd = nn & 63; drow = 512 + 128 * (dd >> 5) + 32 * (2 + vh) + (dd & 31); }
            else drow = nn; }
        else drow = (nn >> 7) * 256 + (nn & 127) + (d.map == 2 ? 128 : 0);
        *(v4u*)(d.WT + (size_t)drow * d.ldk + d.koff + k0 + 8 * c) = o; }
    LDS_WAIT(); asm volatile("" ::: "memory");
}
#define TR_GROUP(SRC, DST, CNT, KK, NN, MAP, DSTRIDE, LDK, KOFF) if (!found) { constexpr int per = ((KK) / 64) * ((NN) / 32); constexpr int tot = (CNT) * per; \
    if (r < tot) { const int mi = r / per; d.W = (SRC) + (size_t)mi * (KK) * (NN); d.WT = (DST) + (size_t)mi * (DSTRIDE); d.K = (KK); d.N = (NN); d.map = (MAP); d.ldk = (LDK); d.koff = (KOFF); d.item = r % per; found = true; } else r -= tot; }
__device__ __forceinline__ TrDesc tr_decode(Frame& F, int it) {
    TrDesc d; d.W = nullptr; d.WT = nullptr; d.K = 64; d.N = 32; d.map = 0; d.ldk = 64; d.koff = 0; d.item = 0; d.skip = false;
    int r = it; bool found = false;
    TR_GROUP(inp(F, I_WIN), ((bf16*)(wsp(F) + WS_WIN)), 4, 1024, 4864, 3, (size_t)4864 * 1024, 1024, 0)
    if (found && d.N == 4864) { const int nb = d.item % 152; d.skip = (nb >= 48 && nb < 56); }
    TR_GROUP(inp(F, I_WPA), ((bf16*)(wsp(F) + WS_WPA)), 4, 512, 1024, 0, (size_t)1024 * 1024, 1024, 0)
    TR_GROUP(inp(F, I_WPH), ((bf16*)(wsp(F) + WS_WPA)), 4, 256, 1024, 0, (size_t)1024 * 1024, 1024, 512)
    TR_GROUP(inp(F, I_WPF), ((bf16*)(wsp(F) + WS_WPA)), 4, 256, 1024, 0, (size_t)1024 * 1024, 1024, 768)
    TR_GROUP(inp(F, I_WOUT), ((bf16*)(wsp(F) + WS_WO)), 4, 1024, 1024, 0, (size_t)1024 * 1024, 1024, 0)
    TR_GROUP(inp(F, I_FG), ((bf16*)(wsp(F) + WS_FGU)), 2, 1024, 2816, 1, (size_t)5632 * 1024, 1024, 0)
    TR_GROUP(inp(F, I_FU), ((bf16*)(wsp(F) + WS_FGU)), 2, 1024, 2816, 2, (size_t)5632 * 1024, 1024, 0)
    TR_GROUP(inp(F, I_FDN), ((bf16*)(wsp(F) + WS_FD)), 2, 2816, 1024, 0, (size_t)1024 * 2816, 2816, 0)
    TR_GROUP(inp(F, I_MG), ((bf16*)(wsp(F) + WS_MGU)), 16, 1024, 2816, 1, (size_t)5632 * 1024, 1024, 0)
    TR_GROUP(inp(F, I_MU), ((bf16*)(wsp(F) + WS_MGU)), 16, 1024, 2816, 2, (size_t)5632 * 1024, 1024, 0)
    TR_GROUP(inp(F, I_MDN), ((bf16*)(wsp(F) + WS_MD)), 16, 2816, 1024, 0, (size_t)1024 * 2816, 2816, 0)
    return d;
}

__device__ __forceinline__ void phase_prologue(Frame& F) {
    constexpr int TOT_ITEMS = 4 * (16 * 152 + 8 * 32 + 4 * 32 + 4 * 32 + 16 * 32) + 2 * (16 * 88 * 2 + 44 * 32) + 16 * (16 * 88 * 2 + 44 * 32);
    constexpr int PER_BLOCK = (TOT_ITEMS + 255) / 256;
    LAS float* scr = (LAS float*)(F.lds + F.wave * 8448);
    LAS float* tl = (LAS float*)(F.lds + 8 * 8448);
    LAS float* sl = (LAS float*)(F.lds + 8 * 8448 + 17152);
    LAS int* ctr = (LAS int*)(F.lds + 8 * 8448 + 17152 + 12288);
    for (int i = F.tid; i < 3072; i += NTHREADS) { const float cv = i < 2048 ? inp(F, I_C)[i] : inp(F, I_CCTX)[i - 2048]; sl[i] = cv * sigmoidf_(cv); }
    if (F.tid == 0) ctr[0] = 0;
    for (int idx = F.bid * NTHREADS + F.tid; idx < 4 * 32 * 4 * 64 * 8; idx += F.G * NTHREADS) { const int e = idx & 7, ln = (idx >> 3) & 63, kk = (idx >> 9) & 3, blk = (idx >> 11) & 31, ll = idx >> 16;
        ((float*)(wsp(F) + WS_W3T))[idx] = inp(F, I_FW3)[(size_t)ll * 64 * 1024 + (size_t)(16 * kk + 8 * (ln >> 5) + e) * 1024 + blk * 32 + (ln & 31)]; }
    if (F.bid == 0) { for (int i = F.tid; i < 512; i += NTHREADS) { const int ll = i >> 7, j = i & 127; ((float*)(wsp(F) + WS_CTL) + CW_QKG)[i] = j < 64 ? inp(F, I_QG)[ll * 64 + j] : inp(F, I_KG)[ll * 64 + j - 64]; } }
    __syncthreads();
    if (F.wave >= 6) {
        for (int it = (F.wave - 6) * F.G + F.bid; it < 4 * 96; it += 2 * F.G) {
            const int l = it / 96, cb = it % 96;
            const float* W = inp(F, I_WADA) + (size_t)l * 1024 * 6144 + cb * 64 + F.lane;
            float a0 = 0.f, a1 = 0.f, a2 = 0.f;
#pragma unroll 16
            for (int k = 0; k < 1024; ++k) { const float w = W[(size_t)k * 6144]; a0 += w * sl[k]; a1 += w * sl[1024 + k]; a2 += w * sl[2048 + k]; }
            const float bb = inp(F, I_BADA)[l * 6144 + cb * 64 + F.lane];
            float* mo = ((float*)(wsp(F) + WS_CTL) + CW_MOD) + (size_t)l * 3 * 6144 + cb * 64 + F.lane;
            mo[0] = a0 + bb; mo[6144] = a1 + bb; mo[2 * 6144] = a2 + bb;
        }
    } else if (F.wave == 5) {
        LAS float* ctab = tl + 64 * 65; LAS float* stab = ctab + 64;
        ctab[F.lane] = cos_rev((float)F.lane * (1.0f / 64.0f)); stab[F.lane] = sin_rev((float)F.lane * (1.0f / 64.0f));
        for (int it = F.bid; it < 4 * 16 * 4; it += F.G) {
            const int l = it >> 6, kb = (it >> 2) & 15, g = it & 3;
            const float* W = inp(F, I_WIN) + (size_t)l * 1024 * 4864 + (size_t)(kb * 64) * 4864 + 1536 + g * 64;
#pragma unroll 8
            for (int kk = 0; kk < 64; ++kk) tl[kk * 65 + F.lane] = W[(size_t)kk * 4864 + F.lane];
            LDS_WAIT(); asm volatile("" ::: "memory");
            bf16* dst = ((bf16*)(wsp(F) + WS_WIN)) + (size_t)l * 4864 * 1024 + (size_t)(1536 + g * 64) * 1024 + kb * 64 + F.lane;
            for (int j = 0; j < 64; ++j) {
                const int mm = j <= 32 ? j : j - 32; float a = 0.f;
                if (j <= 32) { for (int c = 0; c < 64; ++c) a += tl[F.lane * 65 + c] * ctab[(mm * c) & 63]; }
                else { for (int c = 0; c < 64; ++c) a += tl[F.lane * 65 + c] * stab[(mm * c) & 63]; }
                dst[(size_t)j * 1024] = (bf16)f2bf(a);
            }
            LDS_WAIT(); asm volatile("" ::: "memory");
        }
    }
    {
        const int ib = F.bid * PER_BLOCK, ie = (ib + PER_BLOCK) < TOT_ITEMS ? (ib + PER_BLOCK) : TOT_ITEMS;
        int it = ib + __builtin_amdgcn_readfirstlane(F.lane == 0 ? atomicAdd((int*)ctr, 1) : 0);
        if (it < ie) {
            TrDesc cur = tr_decode(F, it); float tv[32], tn[32];
            tr_load(cur, tv, F.lane);
            for (;;) {
                const int itn = ib + __builtin_amdgcn_readfirstlane(F.lane == 0 ? atomicAdd((int*)ctr, 1) : 0);
                TrDesc nxt = cur; const bool more = itn < ie;
                if (more) { nxt = tr_decode(F, itn); tr_load(nxt, tn, F.lane); }
                tr_finish(cur, tv, scr, F.lane);
                if (!more) break;
                cur = nxt;
#pragma unroll
                for (int i = 0; i < 32; ++i) tv[i] = tn[i];
            }
        }
    }
}

__device__ __forceinline__ void moe_offsets(Frame& F, int l, LAS int* poff) {
    if (F.tid == 0) { const unsigned* cnt = (const unsigned*)(wsp(F) + WS_CTL) + CW_CNT + l * 64; int o = 0;
        for (int e = 0; e < 8; ++e) { poff[e] = o; o += (int)((__hip_atomic_load(cnt + e, __ATOMIC_RELAXED, __HIP_MEMORY_SCOPE_AGENT) + 255u) >> 8); } poff[8] = o; }
    __syncthreads();
}
template <bool XB> struct NormRaw { typedef f32x4 T; };
template <> struct NormRaw<true> { typedef v2u T; };
__device__ __forceinline__ f32x4 norm_cvt(const f32x4 a) { return a; }
__device__ __forceinline__ f32x4 norm_cvt(const v2u a) { f32x4 r; r[0] = bflo(a.x); r[1] = bfhi(a.x); r[2] = bflo(a.y); r[3] = bfhi(a.y); return r; }
template <bool ROUTER, bool COMBINE, bool NORM, bool XB = true>
__device__ __forceinline__ void phase_norm(Frame& F, int l, const float* xlat, const float* xctx, const float* g, int moff, const float* wr, int nrows, int skipb = 0) {
    const int gw = (F.bid - skipb) * NWAVES + F.wave + (F.bid < skipb ? (1 << 28) : 0), NGW = (F.G - skipb) * NWAVES;
    const float* mod = ((float*)(wsp(F) + WS_CTL) + CW_MOD) + (size_t)l * 3 * 6144 + moff;
    LAS int* lcnt = (LAS int*)(F.lds + LDS_TAB);
    LAS float* wrl = (LAS float*)F.lds;
    unsigned* info_all = (unsigned*)(wsp(F) + WS_COMB);
    if (ROUTER) { if (F.tid < 16) lcnt[F.tid] = 0;
        for (int i = F.tid; i < 2048; i += NTHREADS) { const int c = i >> 1, hf = i & 1; *(LAS f32x4*)(wrl + 4 * (hf * 1024 + (((c >> 8) * 4 + (c & 3)) * 64 + ((c >> 2) & 63)))) = *(const f32x4*)(wr + 4 * i); }
        __syncthreads(); }
    f32x4 gg[4], s1[4], s0[4]; int cur_cond = -1;
    if (NORM) {
#pragma unroll
        for (int j = 0; j < 4; ++j) gg[j] = *(const f32x4*)(g + 256 * j + 4 * F.lane);
    }
    typedef typename NormRaw<XB>::T RawT;
    bf16* const XS = (bf16*)(wsp(F) + WS_XS);
    f32x4 v[4]; RawT vn[4], vn2[4];
#define NORM_LOADROW(DST, rr_) { if (XB) { const bf16* xr = XS + (size_t)(rr_) * 1024; _Pragma("unroll") for (int j = 0; j < 4; ++j) DST[j] = *(const RawT*)(xr + 256 * j + 4 * F.lane); } \
        else { const float* xr = (rr_) >= ML ? xctx + (size_t)((rr_) - ML) * 1024 : xlat + (size_t)(rr_) * 1024; _Pragma("unroll") for (int j = 0; j < 4; ++j) DST[j] = *(const RawT*)(xr + 256 * j + 4 * F.lane); } }
    if (gw < nrows) NORM_LOADROW(vn, gw)
    if (gw + NGW < nrows) NORM_LOADROW(vn2, gw + NGW)
    for (int r = gw; r < nrows; r += NGW) {
        const bool isctx = r >= ML; const int cond = isctx ? 2 : (r >> 13);
#pragma unroll
        for (int j = 0; j < 4; ++j) { v[j] = norm_cvt(vn[j]); vn[j] = vn2[j]; }
        { const int rn = r + 2 * NGW; if (rn < nrows) NORM_LOADROW(vn2, rn) }
        if (!XB) {
#pragma unroll
            for (int j = 0; j < 4; ++j) { v2u o; o.x = pk2(v[j][0], v[j][1]); o.y = pk2(v[j][2], v[j][3]); *(v2u*)(XS + (size_t)r * 1024 + 256 * j + 4 * F.lane) = o; }
        }
        float s = 0.f;
        if (COMBINE) {
            const unsigned* info = info_all + (size_t)r * 8;
            const float w0 = __builtin_bit_cast(float, info[2]), w1 = __builtin_bit_cast(float, info[3]);
            const bf16* y0 = ((const bf16*)(wsp(F) + WS_Y)) + (size_t)info[6] * 1024; const bf16* y1 = ((const bf16*)(wsp(F) + WS_Y)) + (size_t)info[7] * 1024;
            const float* gt = ((float*)(wsp(F) + WS_CTL) + CW_MOD) + (size_t)(l - (NORM ? 1 : 0)) * 3 * 6144 + 5120 + cond * 6144;
#pragma unroll
            for (int j = 0; j < 4; ++j) { const int c = 256 * j + 4 * F.lane;
                const v2u a = *(const v2u*)(y0 + c), b = *(const v2u*)(y1 + c); const f32x4 gtv = *(const f32x4*)(gt + c);
                v[j][0] += gtv[0] * (w0 * bflo(a.x) + w1 * bflo(b.x)); v[j][1] += gtv[1] * (w0 * bfhi(a.x) + w1 * bfhi(b.x));
                v[j][2] += gtv[2] * (w0 * bflo(a.y) + w1 * bflo(b.y)); v[j][3] += gtv[3] * (w0 * bfhi(a.y) + w1 * bfhi(b.y));
                if (NORM) { v2u o; o.x = pk2(v[j][0], v[j][1]); o.y = pk2(v[j][2], v[j][3]); *(v2u*)(XS + (size_t)r * 1024 + c) = o; }
                else *(f32x4*)(outp(F) + (size_t)r * 1024 + c) = v[j]; }
        }
        if (!NORM) continue;
        if (cond != cur_cond) { cur_cond = cond; const float* sh = mod + cond * 6144; const float* sc = sh + 1024;
#pragma unroll
            for (int j = 0; j < 4; ++j) { s1[j] = *(const f32x4*)(sc + 256 * j + 4 * F.lane); s0[j] = *(const f32x4*)(sh + 256 * j + 4 * F.lane); } }
#pragma unroll
        for (int j = 0; j < 4; ++j) s += (v[j][0] * v[j][0] + v[j][1] * v[j][1]) + (v[j][2] * v[j][2] + v[j][3] * v[j][3]);
        const float rstd = 1.0f / sqrtf(wave_sum(s, F.lane) * (1.0f / 1024.0f) + EPS);
        float lg[8];
        if (ROUTER) {
#pragma unroll
            for (int e = 0; e < 8; ++e) lg[e] = 0.f;
        }
#pragma unroll
        for (int j = 0; j < 4; ++j) { const int c = 256 * j + 4 * F.lane;
            f32x4 y;
#pragma unroll
            for (int e = 0; e < 4; ++e) y[e] = (v[j][e] * rstd * gg[j][e]) * (1.0f + s1[j][e]) + s0[j][e];
            v2u o; o.x = pk2(y[0], y[1]); o.y = pk2(y[2], y[3]);
            *(v2u*)(((bf16*)(wsp(F) + WS_H)) + (size_t)r * 1024 + c) = o;
            if (ROUTER) {
#pragma unroll
                for (int e = 0; e < 4; ++e) { const f32x4 w0 = *(LAS f32x4*)(wrl + 4 * ((j * 4 + e) * 64 + F.lane)), w1 = *(LAS f32x4*)(wrl + 4 * (1024 + (j * 4 + e) * 64 + F.lane));
                    lg[0] += y[e] * w0[0]; lg[1] += y[e] * w0[1]; lg[2] += y[e] * w0[2]; lg[3] += y[e] * w0[3];
                    lg[4] += y[e] * w1[0]; lg[5] += y[e] * w1[1]; lg[6] += y[e] * w1[2]; lg[7] += y[e] * w1[3]; }
            }
        }
        if (ROUTER) {
#pragma unroll
            for (int e = 0; e < 8; ++e) lg[e] = wave_sum(lg[e], F.lane);
            int i0 = 0; float v0 = lg[0];
#pragma unroll
            for (int e = 1; e < 8; ++e) if (lg[e] > v0) { v0 = lg[e]; i0 = e; }
            int i1 = -1; float v1 = -INFINITY;
#pragma unroll
            for (int e = 0; e < 8; ++e) if (e != i0 && lg[e] > v1) { v1 = lg[e]; i1 = e; }
            const float w0 = 1.0f / (1.0f + __expf(v1 - v0)), w1 = 1.0f - w0;
            if (F.lane == 0) { const int p0 = atomicAdd((int*)(lcnt + i0), 1), p1 = atomicAdd((int*)(lcnt + i1), 1);
                unsigned* info = info_all + (size_t)r * 8;
                info[0] = (unsigned)i0; info[1] = (unsigned)i1; info[2] = __builtin_bit_cast(unsigned, w0); info[3] = __builtin_bit_cast(unsigned, w1); info[4] = (unsigned)p0; info[5] = (unsigned)p1; }
        }
    }
    if (ROUTER) {
        asm volatile("s_waitcnt vmcnt(0) lgkmcnt(0)" ::: "memory");
        __syncthreads();
        if (F.tid < 8) { unsigned* cnt = (unsigned*)(wsp(F) + WS_CTL) + CW_CNT + l * 64; lcnt[8 + F.tid] = (int)__hip_atomic_fetch_add(cnt + F.tid, (unsigned)lcnt[F.tid], __ATOMIC_RELAXED, __HIP_MEMORY_SCOPE_AGENT); }
        __syncthreads();
        for (int r = gw; r < nrows; r += NGW) { if (F.lane < 2) { unsigned* info = info_all + (size_t)r * 8; const int e = (int)info[F.lane]; info[4 + F.lane] += (unsigned)lcnt[8 + e]; } }
    }
}

#undef NORM_LOADROW
__device__ __forceinline__ void phase_gather(Frame& F, int l) {
    LAS int* poff = (LAS int*)(F.lds + LDS_TAB + 64);
    moe_offsets(F, l, poff);
    const int gw = F.bid * NWAVES + F.wave, NGW = F.G * NWAVES;
    unsigned* info_all = (unsigned*)(wsp(F) + WS_COMB);
    for (int it = gw; it < MT * 2; it += NGW) {
        const int tok = it >> 1, k = it & 1; unsigned* info = info_all + (size_t)tok * 8;
        const int e = (int)info[k], pos = (int)info[4 + k]; const int grow = 256 * poff[e] + pos;
        if (F.lane == 0) info[6 + k] = (unsigned)grow;
        const v4u* s = (const v4u*)(((const bf16*)(wsp(F) + WS_H)) + (size_t)tok * 1024); v4u* d = (v4u*)(((bf16*)(wsp(F) + WS_XG)) + (size_t)grow * 1024);
        d[F.lane] = s[F.lane]; d[64 + F.lane] = s[64 + F.lane];
    }
}

__device__ __forceinline__ void filter_tile(Frame& F, int l, int L, int p0, float* dst  , bool stage) {
    LAS float* emb = (LAS float*)F.lds;
    LAS float* h1 = emb + 32 * 33;
    LAS float* h2 = h1 + 32 * 65;
    LAS float* w1s = h2 + 32 * 65;
    LAS float* w2s = w1s + 33 * 64;
    const float* w1 = inp(F, I_FW1) + l * 33 * 64; const float* b1 = inp(F, I_FB1) + l * 64; const float* f1 = inp(F, I_FF1) + l * 64;
    const float* w2 = inp(F, I_FW2) + l * 64 * 64; const float* b2 = inp(F, I_FB2) + l * 64; const float* f2 = inp(F, I_FF2) + l * 64;
    const float* w3 = inp(F, I_FW3) + (size_t)l * 64 * 1024;
    float awA[32], awB[32];
#define FILT_LOADW(AW, blk_) { unsigned vo_ = (unsigned)((((l * 32 + (blk_)) * 4) * 64 + F.lane) * 8); asm volatile("" : "+v"(vo_)); const float* wt_ = (const float*)(wsp(F) + WS_W3T); \
        _Pragma("unroll") for (int kk = 0; kk < 4; ++kk) { const f32x4 qa = *(const f32x4*)(wt_ + vo_ + kk * 512), qb = *(const f32x4*)(wt_ + vo_ + kk * 512 + 4); \
            _Pragma("unroll") for (int e = 0; e < 4; ++e) { AW[8 * kk + e] = qa[e]; AW[8 * kk + 4 + e] = qb[e]; } } }
    FILT_LOADW(awA, F.wave) __builtin_amdgcn_sched_barrier(0);
    if (stage) {
        const f32x4 sa = *(const f32x4*)(w1 + 4 * F.tid), sb = *(const f32x4*)(w2 + 4 * F.tid), sc = *(const f32x4*)(w2 + 4 * (F.tid + NTHREADS));
        f32x4 sd = sa; if (F.tid < 16) sd = *(const f32x4*)(w1 + 4 * (F.tid + NTHREADS));
        *(LAS f32x4*)(w1s + 4 * F.tid) = sa; *(LAS f32x4*)(w2s + 4 * F.tid) = sb; *(LAS f32x4*)(w2s + 4 * (F.tid + NTHREADS)) = sc;
        if (F.tid < 16) *(LAS f32x4*)(w1s + 4 * (F.tid + NTHREADS)) = sd;
    }
    for (int idx = F.tid; idx < 32 * 33; idx += NTHREADS) {
        const int pos = idx / 33, f = idx % 33, i = p0 + pos;
        float val;
        if (f == 0) val = (float)i / (float)(L - 1);
        else { const int j = (f - 1) & 15; const float fb = 1e-4f + (float)j * ((15.0f - 1e-4f) / 15.0f); const float rev = fb * (float)i / (float)L;
               val = (f <= 16) ? cos_rev(rev) : -sin_rev(rev); }
        emb[pos * 33 + f] = val;
    }
    __syncthreads();
    { const int pos = F.tid >> 4, u0 = (F.tid & 15) * 4;
      f32x4 a = *(const f32x4*)(b1 + u0);
#pragma unroll 11
      for (int f = 0; f < 33; ++f) a += emb[pos * 33 + f] * *(LAS f32x4*)(w1s + f * 64 + u0);
      const f32x4 fr = *(const f32x4*)(f1 + u0);
#pragma unroll
      for (int e = 0; e < 4; ++e) h1[pos * 65 + u0 + e] = sin_rev(fr[e] * a[e] * INV_2PI);
    }
    __syncthreads();
    { const int pos = F.tid >> 4, u0 = (F.tid & 15) * 4;
      f32x4 a = *(const f32x4*)(b2 + u0);
#pragma unroll 16
      for (int f = 0; f < 64; ++f) a += h1[pos * 65 + f] * *(LAS f32x4*)(w2s + f * 64 + u0);
      const f32x4 fr = *(const f32x4*)(f2 + u0);
#pragma unroll
      for (int e = 0; e < 4; ++e) h2[pos * 65 + u0 + e] = sin_rev(fr[e] * a[e] * INV_2PI);
    }
    __syncthreads();
    { const int r = F.lane & 31, h = F.lane >> 5;
      typedef float f32x16_t __attribute__((ext_vector_type(16))); typedef short bf16x8_t __attribute__((ext_vector_type(8)));
      const int i = p0 + r; const float t = (float)i / (float)(L - 1);
#define FILT_SPLIT(X, HI, LO) { v4u hi_, lo_; \
        _Pragma("unroll") for (int p = 0; p < 4; ++p) { const float x0 = (X)[2 * p], x1 = (X)[2 * p + 1]; const unsigned hw = pg8::cvt_pk_bf16(x0, x1); hi_[p] = hw; lo_[p] = pg8::cvt_pk_bf16(x0 - bflo(hw), x1 - bfhi(hw)); } \
        HI = __builtin_bit_cast(bf16x8_t, hi_); LO = __builtin_bit_cast(bf16x8_t, lo_); }
      bf16x8_t bh[4], bl[4];
#pragma unroll
      for (int kk = 0; kk < 4; ++kk) { float hv[8];
#pragma unroll
          for (int e = 0; e < 8; ++e) hv[e] = h2[r * 65 + 16 * kk + 8 * h + e];
          FILT_SPLIT(hv, bh[kk], bl[kk]) }
#define FILT_BLOCK(AW, blk_) { int c0 = (blk_) * 32; asm volatile("" : "+v"(c0)); f32x16_t acc;        \
        _Pragma("unroll") for (int q = 0; q < 16; ++q) acc[q] = 0.f; \
        _Pragma("unroll") for (int kk = 0; kk < 4; ++kk) { bf16x8_t ah_, al_; FILT_SPLIT((AW + 8 * kk), ah_, al_) \
            acc = __builtin_amdgcn_mfma_f32_32x32x16_bf16(al_, bh[kk], acc, 0, 0, 0); acc = __builtin_amdgcn_mfma_f32_32x32x16_bf16(ah_, bl[kk], acc, 0, 0, 0); acc = __builtin_amdgcn_mfma_f32_32x32x16_bf16(ah_, bh[kk], acc, 0, 0, 0); } \
        _Pragma("unroll") for (int q = 0; q < 16; ++q) { const int col = c0 + (q & 3) + 8 * (q >> 2) + 4 * h; const int ch = col & 255; \
            const float delta = 3.0701134573253946f + 12.280453829301578f * ((float)ch * (1.0f / 255.0f)); \
            dst[(size_t)col * L + i] = acc[q] * __expf(-t * delta); } }
#pragma unroll 1
      for (int jj = 0; jj < 2; ++jj) {
          FILT_LOADW(awB, F.wave + 8 * (2 * jj + 1)) __builtin_amdgcn_sched_barrier(0); FILT_BLOCK(awA, F.wave + 16 * jj) __builtin_amdgcn_sched_barrier(0);
          FILT_LOADW(awA, F.wave + 8 * ((2 * jj + 2) & 3)) __builtin_amdgcn_sched_barrier(0); FILT_BLOCK(awB, F.wave + 8 * (2 * jj + 1)) __builtin_amdgcn_sched_barrier(0);
      }
#undef FILT_BLOCK
#undef FILT_LOADW
#undef FILT_SPLIT
    }
    __syncthreads();
}

__device__ __forceinline__ void phase_qkprep(Frame& F, int l) {
    const int gw = F.bid * NWAVES + F.wave, NGW = F.G * NWAVES;
    const int lane = F.lane; const int a = lane >> 5, half = (lane >> 4) & 1, f = lane & 15;
    const float inv = exp2f(-(float)f * (13.287712379549449f / 16.0f)) * INV_2PI;
    const float gq = inp(F, I_QG)[l * 64 + lane], gk = inp(F, I_KG)[l * 64 + lane];
    for (int r = gw; r < MT; r += NGW) {
        const bool isctx = r >= ML; const int t = r & 8191; const int pos = a == 0 ? (t >> 6) : (t & 63);
        float cs = 1.f, sn = 0.f;
        if (!isctx) { const float rev = (float)pos * inv; cs = cos_rev(rev); sn = sin_rev(rev); }
        const bf16* pr = ((bf16*)(wsp(F) + WS_PR)) + (size_t)r * INW;
        bf16* qk = ((bf16*)(wsp(F) + WS_QK)) + (size_t)r * 640;
#pragma unroll
        for (int h = 0; h < 10; ++h) {
            const float v = bf2f(pr[h * 64 + lane]);
            const float ss = wave_sum(v * v, lane);
            const float y = v * (1.0f / sqrtf(ss * (1.0f / 64.0f) + EPS)) * (h < 8 ? gq : gk);
            const float p = shx(y, lane, 16);
            const float o = half == 0 ? y * cs - p * sn : y * cs + p * sn;
            if (h < 8) qk[h * 64 + lane] = (bf16)f2bf(o * 0.18033688011112042f);
            else ((bf16*)(wsp(F) + WS_KT))[(size_t)((((h - 8) * NKB + (r >> 5)) * 4 + (lane >> 4)) * 512 + ((lane >> 3) & 1) * 256 + (r & 31) * 8 + (lane & 7))] = (bf16)f2bf(o);
        }
    }
}

__device__ __forceinline__ float block_sum(Frame& F, float v, LAS float* red) {
    v = wave_sum(v, F.lane);
    __syncthreads();
    if (F.lane == 0) red[F.wave] = v;
    __syncthreads();
    float t = 0.f;
#pragma unroll
    for (int w = 0; w < NWAVES; ++w) t += red[w];
    return t;
}

template <int L>
__device__ __forceinline__ float hy_uc(const bf16* UT, int rowbase, int b, int t, int ch, const float* cw, const float* cb) {
    float a = cb[ch];
    const bf16* up = UT + (size_t)ch * MT + rowbase + b * L;
#pragma unroll
    for (int j = 0; j < 3; ++j) { const int tt = t + j - 1; const bool ok = tt >= 0 && tt < L; const float x = bf2f(up[ok ? tt : t]); a += ok ? x * cw[j * 768 + ch] : 0.f; }
    return a;
}

template <int L>
__device__ __forceinline__ void hyena_item_naive(Frame& F, int l, int c, int rowbase, const float* taps) {
    constexpr int NT = (L + NTHREADS - 1) / NTHREADS;
    LAS float* kt = (LAS float*)F.lds;
    LAS f32x2* z = (LAS f32x2*)(F.lds + 2 * L * 4);
    LAS float* red = (LAS float*)(F.lds + 2 * L * 4 + L * 8);
    const float* cw = inp(F, I_HCW) + l * 3 * 768; const float* cb = inp(F, I_HCB) + l * 768; const float* hb = inp(F, I_HBIAS) + l * 512;
    for (int t = F.tid; t < L; t += NTHREADS) { f32x2 v; v.x = hy_uc<L>(((bf16*)(wsp(F) + WS_UT)), rowbase, 0, t, 512 + c, cw, cb); v.y = hy_uc<L>(((bf16*)(wsp(F) + WS_UT)), rowbase, 1, t, 512 + c, cw, cb); z[t] = v; }
    for (int o = 0; o < 2; ++o) {
        const float* fwd = taps + (size_t)(o * 256 + c) * L; const float* bwd = taps + (size_t)(512 + o * 256 + c) * L;
        float part = 0.f;
        for (int d = F.tid; d < L; d += NTHREADS) { const float kf = fwd[d]; kt[L + d] = kf; part += fabsf(kf);
            if (d >= 1) { const float kb = bwd[d]; kt[L - d] = kb; part += fabsf(kb); } else kt[0] = 0.f; }
        const float tot = block_sum(F, part, red);
        const float inv = 1.0f / tot;
        __syncthreads();
        float* tmp = (float*)(wsp(F) + WS_CTMP) + (size_t)c * 2 * L;
#pragma unroll 1
        for (int t = F.tid; t < L; t += NTHREADS) {
            float a0 = 0.f, a1 = 0.f;
#pragma unroll 4
            for (int s = 0; s < L; ++s) { const f32x2 zz = z[s]; const float kv = kt[L + t - s]; a0 += kv * zz.x; a1 += kv * zz.y; }
            tmp[t] = a0; tmp[L + t] = a1;
        }
        __syncthreads();
        const float bo = hb[o * 256 + c];
#pragma unroll 1
        for (int t = F.tid; t < L; t += NTHREADS) {
            const float g0 = hy_uc<L>(((bf16*)(wsp(F) + WS_UT)), rowbase, 0, t, o * 256 + c, cw, cb), g1 = hy_uc<L>(((bf16*)(wsp(F) + WS_UT)), rowbase, 1, t, o * 256 + c, cw, cb);
            const f32x2 zo = z[t]; f32x2 zn; zn.x = g0 * (tmp[t] * inv + bo * zo.x); zn.y = g1 * (tmp[L + t] * inv + bo * zo.y); z[t] = zn;
        }
        __syncthreads();
    }
    for (int t = F.tid; t < L; t += NTHREADS) { const f32x2 v = z[t];
        ((bf16*)(wsp(F) + WS_HYT))[(size_t)c * MT + rowbase + t] = (bf16)f2bf(v.x); ((bf16*)(wsp(F) + WS_HYT))[(size_t)c * MT + rowbase + L + t] = (bf16)f2bf(v.y); }
    __syncthreads();
}

template <int L>
__device__ __forceinline__ void fnet_item_naive(Frame& F, int b, int g, int m, int rowbase) {
    LAS f32x2* AB = (LAS f32x2*)F.lds;
    LAS f32x2* tab = (LAS f32x2*)(F.lds + L * 8);
    LAS f32x2* cs64 = (LAS f32x2*)(F.lds + 2 * L * 8);
    for (int i = F.tid; i < L; i += NTHREADS) { f32x2 v; const float rev = (float)i / (float)L; v.x = cos_rev(rev); v.y = sin_rev(rev); tab[i] = v; }
    if (F.tid < 64) { f32x2 v; const float rev = (float)F.tid / 64.0f; v.x = cos_rev(rev); v.y = sin_rev(rev); cs64[F.tid] = v; }
    __syncthreads();
    for (int n = F.tid; n < L; n += NTHREADS) {
        const bf16* ut = ((const bf16*)(wsp(F) + WS_UT)) + (size_t)(768 + g * 64) * MT + rowbase + b * L + n;
        const int mm = m <= 32 ? m : 64 - m;
        f32x2 v; v.x = bf2f(ut[(size_t)mm * MT]);
        v.y = (m == 0 || m == 32) ? 0.f : (m < 32 ? bf2f(ut[(size_t)(32 + m) * MT]) : -bf2f(ut[(size_t)(32 + mm) * MT]));
        AB[n] = v;
    }
    __syncthreads();
    const float scale = 1.0f / sqrtf((float)L * 64.0f);
    for (int k = F.tid; k < L; k += NTHREADS) {
        float acc = 0.f; int idx = 0;
        for (int n = 0; n < L; ++n) { const f32x2 ab = AB[n]; const f32x2 cs = tab[idx]; acc += ab.x * cs.x - ab.y * cs.y; idx = (idx + k) & (L - 1); }
        ((bf16*)(wsp(F) + WS_FNT))[(size_t)(g * 64 + m) * MT + rowbase + b * L + k] = (bf16)f2bf(acc * scale);
    }
    __syncthreads();
}

#ifdef FFT_HOST
#define FFT_LDS
#define FFT_HD
static inline float fft_cos_rev(float r) { return (float)cos(6.283185307179586 * (double)r); }
static inline float fft_sin_rev(float r) { return (float)sin(6.283185307179586 * (double)r); }
#else
#define FFT_LDS LAS
#define FFT_HD __device__ __forceinline__
__device__ __forceinline__ float fft_cos_rev(float r) { return __builtin_amdgcn_cosf(r); }
__device__ __forceinline__ float fft_sin_rev(float r) { return __builtin_amdgcn_sinf(r); }
#endif
FFT_HD int fft_phys(int i) { return i + ((i >> 5) << 1); }
FFT_HD f32x2 fft_cmul(f32x2 a, f32x2 b) { const f32x2 ax = {a.x, a.x}, ay = {a.y, a.y}, bs = {-b.y, b.x}; return ax * b + ay * bs; }
template <int R> FFT_HD constexpr int fft_brev(int p) { int r = 0; for (int b = 1; b < R; b <<= 1) { r = (r << 1) | ((p & b) ? 1 : 0); } return r; }
template <int R, bool INV> FFT_HD void fft_regs(f32x2 (&a)[R]) {
    constexpr float C16[16] = {1.0f, 0.92387953251128674f, 0.70710678118654752f, 0.38268343236508977f, 0.0f, -0.38268343236508977f, -0.70710678118654752f, -0.92387953251128674f,
                               -1.0f, -0.92387953251128674f, -0.70710678118654752f, -0.38268343236508977f, 0.0f, 0.38268343236508977f, 0.70710678118654752f, 0.92387953251128674f};
    constexpr float S16[16] = {0.0f, 0.38268343236508977f, 0.70710678118654752f, 0.92387953251128674f, 1.0f, 0.92387953251128674f, 0.70710678118654752f, 0.38268343236508977f,
                               0.0f, -0.38268343236508977f, -0.70710678118654752f, -0.92387953251128674f, -1.0f, -0.92387953251128674f, -0.70710678118654752f, -0.38268343236508977f};
#pragma unroll
    for (int s = R / 2; s >= 1; s >>= 1) {
#pragma unroll
        for (int i = 0; i < R; ++i) {
            if ((i & s) == 0) {
                const int k = i & (s - 1);
                const f32x2 u = a[i], v = a[i + s];
                a[i] = u + v;
                const f32x2 d = u - v;
                if (k == 0) a[i + s] = d;
                else if (2 * k == s) { f32x2 t; if (INV) { t.x = -d.y; t.y = d.x; } else { t.x = d.y; t.y = -d.x; } a[i + s] = t; }
                else { const int idx = k * (16 / (2 * s)); f32x2 w; w.x = C16[idx]; w.y = INV ? S16[idx] : -S16[idx]; a[i + s] = fft_cmul(d, w); }
            }
        }
    }
}
template <int N, int NCUR, int R, bool INV, int NT>
FFT_HD void fft_pass(FFT_LDS f32x2* buf, int tid) {
    constexpr int M = NCUR / R;
    if constexpr (M == 1) {
        constexpr int U = 4; static_assert((N / R) % (NT * U) == 0, "trip count");
#pragma unroll 1
        for (int i0 = tid; i0 < N / R; i0 += NT * U) {
            f32x2 a[U][R]; int pb[U];
#pragma unroll
            for (int u = 0; u < U; ++u) { pb[u] = fft_phys((i0 + u * NT) * R);
#pragma unroll
                for (int q = 0; q < R; ++q) a[u][q] = buf[pb[u] + q]; }
#pragma unroll
            for (int u = 0; u < U; ++u) fft_regs<R, INV>(a[u]);
#pragma unroll
            for (int u = 0; u < U; ++u)
#pragma unroll
                for (int p = 0; p < R; ++p) buf[pb[u] + p] = a[u][fft_brev<R>(p)];
        }
        return;
    }
    constexpr int U = ((N / R) % (NT * 2) == 0) ? 2 : 1;
#pragma unroll 1
    for (int i0 = tid; i0 < N / R; i0 += NT * U) {
        f32x2 a[U][R]; int pb[U]; f32x2 w1[U];
#pragma unroll
        for (int u = 0; u < U; ++u) { const int i = i0 + u * NT; const int blk = i / M, j = i - blk * M, base = blk * NCUR + j;
            pb[u] = fft_phys(base);
#pragma unroll
            for (int q = 0; q < R; ++q) a[u][q] = buf[pb[u] + q * M + 2 * ((q * M) >> 5)];
            const float rev = (float)j * (1.0f / (float)NCUR); w1[u].x = fft_cos_rev(rev); w1[u].y = INV ? fft_sin_rev(rev) : -fft_sin_rev(rev); }
#pragma unroll
        for (int u = 0; u < U; ++u) {
            f32x2 w[R]; w[1] = w1[u];
#pragma unroll
            for (int p = 2; p < R; ++p) { const int hb = (p >= 8) ? 8 : ((p >= 4) ? 4 : 2); w[p] = (p == hb) ? fft_cmul(w[hb / 2], w[hb / 2]) : fft_cmul(w[hb], w[p - hb]); }
            if (INV) {
#pragma unroll
                for (int p = 1; p < R; ++p) a[u][p] = fft_cmul(a[u][p], w[p]);
                fft_regs<R, INV>(a[u]);
            } else {
                fft_regs<R, INV>(a[u]);
#pragma unroll
                for (int p = 1; p < R; ++p) a[u][fft_brev<R>(p)] = fft_cmul(a[u][fft_brev<R>(p)], w[p]);
            }
#pragma unroll
            for (int p = 0; p < R; ++p) buf[pb[u] + p * M + 2 * ((p * M) >> 5)] = a[u][fft_brev<R>(p)];
        }
    }
}
#ifdef FFT_HOST
#define FFT_SYNC()
#else
#define FFT_SYNC() __syncthreads()
#endif

template <bool INV> __device__ __forceinline__ void fft16k(LAS f32x2* buf, int tid) {
    constexpr int N = 16384;
    if (!INV) { fft_pass<N, 16384, 16, false, NTHREADS>(buf, tid); __syncthreads(); fft_pass<N, 1024, 16, false, NTHREADS>(buf, tid); __syncthreads();
                fft_pass<N, 64, 16, false, NTHREADS>(buf, tid); __syncthreads(); fft_pass<N, 4, 4, false, NTHREADS>(buf, tid); __syncthreads(); }
    else { fft_pass<N, 4, 4, true, NTHREADS>(buf, tid); __syncthreads(); fft_pass<N, 64, 16, true, NTHREADS>(buf, tid); __syncthreads();
           fft_pass<N, 1024, 16, true, NTHREADS>(buf, tid); __syncthreads(); fft_pass<N, 16384, 16, true, NTHREADS>(buf, tid); __syncthreads(); }
}
__device__ __forceinline__ void fft8k_fwd(LAS f32x2* buf, int tid) {
    constexpr int N = 8192;
    fft_pass<N, 8192, 16, false, NTHREADS>(buf, tid); __syncthreads(); fft_pass<N, 512, 16, false, NTHREADS>(buf, tid); __syncthreads();
    fft_pass<N, 32, 16, false, NTHREADS>(buf, tid); __syncthreads(); fft_pass<N, 2, 2, false, NTHREADS>(buf, tid); __syncthreads();
}

__device__ __forceinline__ void hy_uc8(const bf16* UT, int b, int t0, int ch, const float* cw, const float* cb, float (&o)[8]) {
    const bf16* up = UT + (size_t)ch * MT + b * SEQ + t0;
    const v4u w = *(const v4u*)up;
    const bool hl = t0 > 0, hr = t0 + 8 < SEQ;
    const float hm = bf2f(up[hl ? -1 : 0]), hp = bf2f(up[hr ? 8 : 7]);
    float x[10]; x[0] = hl ? hm : 0.f; x[9] = hr ? hp : 0.f;
    x[1] = bflo(w.x); x[2] = bfhi(w.x); x[3] = bflo(w.y); x[4] = bfhi(w.y); x[5] = bflo(w.z); x[6] = bfhi(w.z); x[7] = bflo(w.w); x[8] = bfhi(w.w);
    const float w0 = cw[ch], w1 = cw[768 + ch], w2 = cw[1536 + ch], bias = cb[ch];
#pragma unroll
    for (int e = 0; e < 8; ++e) o[e] = ((bias + x[e] * w0) + x[e + 1] * w1) + x[e + 2] * w2;
}
__device__ __forceinline__ void hyena_item_fft(Frame& F, int l, int c) {
    constexpr int L = SEQ, N = 2 * SEQ;
    LAS f32x2* buf = (LAS f32x2*)F.lds;
    LAS float* red = (LAS float*)(F.lds + 139264);
    const bf16* UT = (const bf16*)(wsp(F) + WS_UT);
    const float* cw = inp(F, I_HCW) + l * 3 * 768; const float* cb = inp(F, I_HCB) + l * 768; const float* hb = inp(F, I_HBIAS) + l * 512;
    f32x2* kspec = (f32x2*)(wsp(F) + WS_KS) + (size_t)F.bid * 2 * N;
    const float* HFp = (const float*)(wsp(F) + WS_HF);
    {
        const float* f0 = HFp + (size_t)c * L; const float* b0 = HFp + (size_t)(512 + c) * L; const float* f1 = HFp + (size_t)(256 + c) * L; const float* b1 = HFp + (size_t)(768 + c) * L;
        float p0 = 0.f, p1 = 0.f;
#pragma unroll
        for (int k = 0; k < 4; ++k) { const int i0 = 4 * (F.tid + NTHREADS * k);
            const f32x4 a = *(const f32x4*)(f0 + i0), b = *(const f32x4*)(f1 + i0), cbk = *(const f32x4*)(b0 + i0), d = *(const f32x4*)(b1 + i0);
            LAS f32x4* bp = (LAS f32x4*)(buf + fft_phys(i0));
            f32x4 w; w[0] = a[0]; w[1] = b[0]; w[2] = a[1]; w[3] = b[1]; bp[0] = w; w[0] = a[2]; w[1] = b[2]; w[2] = a[3]; w[3] = b[3]; bp[1] = w;
#pragma unroll
            for (int e = 0; e < 4; ++e) { p0 += fabsf(a[e]); p1 += fabsf(b[e]); }
            if (i0 > 0) { p0 += fabsf(cbk[0]); p1 += fabsf(d[0]); f32x2 v; v.x = cbk[0]; v.y = d[0]; buf[fft_phys(N - i0)] = v; }
            else { float zf = 0.f; asm volatile("" : "+v"(zf)); f32x2 v; v.x = zf; v.y = zf; buf[fft_phys(L)] = v; }
#pragma unroll
            for (int e = 1; e < 4; ++e) { p0 += fabsf(cbk[e]); p1 += fabsf(d[e]); f32x2 v; v.x = cbk[e]; v.y = d[e]; buf[fft_phys(N - i0 - e)] = v; } }
        const float tot0 = block_sum(F, p0, red); const float tot1 = block_sum(F, p1, red);
        __syncthreads();
        fft16k<false>(buf, F.tid);
        const float s0 = 0.5f / tot0, s1 = 0.5f / tot1;
        typedef _Float16 f16x2 __attribute__((ext_vector_type(2)));
        int tp = F.tid; asm volatile("" : "+v"(tp));
#pragma unroll 2
        for (int k = 0; k < 8; ++k) { const int pos0 = 4 * (tp + NTHREADS * k);
            const LAS f32x4* ap = (const LAS f32x4*)(buf + fft_phys(pos0)); const f32x4 a01 = ap[0], a23 = ap[1];
            f32x2 o0[4], o1[4];
#pragma unroll
            for (int e = 0; e < 4; ++e) { const int pos = pos0 + e;
                const int f = (pos >> 10) + 16 * ((pos >> 6) & 15) + 256 * ((pos >> 2) & 15) + 4096 * (pos & 3), nf = (N - f) & (N - 1);
                const int pos2 = (nf & 15) * 1024 + ((nf >> 4) & 15) * 64 + ((nf >> 8) & 15) * 4 + (nf >> 12);
                f32x2 a; a.x = (e < 2 ? a01 : a23)[2 * (e & 1)]; a.y = (e < 2 ? a01 : a23)[2 * (e & 1) + 1];
                const f32x2 b = buf[fft_phys(pos2)];
                f32x2 k0, k1; k0.x = ((a.x + b.x) * s0); k0.y = ((a.y - b.y) * s0); k1.x = ((a.y + b.y) * s1); k1.y = ((b.x - a.x) * s1);
                o0[e] = k0; o1[e] = k1; }
            { f32x4 w; w[0] = o0[0].x; w[1] = o0[0].y; w[2] = o0[1].x; w[3] = o0[1].y; *(f32x4*)(kspec + pos0) = w; w[0] = o0[2].x; w[1] = o0[2].y; w[2] = o0[3].x; w[3] = o0[3].y; *(f32x4*)(kspec + pos0 + 2) = w;
              w[0] = o1[0].x; w[1] = o1[0].y; w[2] = o1[1].x; w[3] = o1[1].y; *(f32x4*)(kspec + N + pos0) = w; w[0] = o1[2].x; w[1] = o1[2].y; w[2] = o1[3].x; w[3] = o1[3].y; *(f32x4*)(kspec + N + pos0 + 2) = w; } }
        __syncthreads();
    }
    f32x2 zr[2][8];
    int tz = F.tid; asm volatile("" : "+v"(tz));
#pragma unroll
    for (int k = 0; k < 2; ++k) { const int t0 = 8 * (tz + NTHREADS * k);
        float zf = 0.f; asm volatile("" : "+v"(zf)); f32x4 zero4; zero4[0] = zf; zero4[1] = zf; zero4[2] = zf; zero4[3] = zf;
        float a0[8], a1[8]; hy_uc8(UT, 0, t0, 512 + c, cw, cb, a0); hy_uc8(UT, 1, t0, 512 + c, cw, cb, a1);
        LAS f32x4* bp = (LAS f32x4*)(buf + fft_phys(t0)); LAS f32x4* zp = (LAS f32x4*)(buf + fft_phys(L + t0));
#pragma unroll
        for (int e = 0; e < 8; ++e) { zr[k][e].x = a0[e]; zr[k][e].y = a1[e]; }
#pragma unroll
        for (int e2 = 0; e2 < 4; ++e2) { f32x4 w; w[0] = a0[2 * e2]; w[1] = a1[2 * e2]; w[2] = a0[2 * e2 + 1]; w[3] = a1[2 * e2 + 1]; bp[e2] = w; zp[e2] = zero4; } }
    __syncthreads();
#pragma unroll 1
    for (int o = 0; o < 2; ++o) {
        fft16k<false>(buf, F.tid);
        { int tm = F.tid; asm volatile("" : "+v"(tm));
          const f32x2* ks = kspec + o * N;
#pragma unroll
          for (int kh = 0; kh < 2; ++kh) {
              f32x4 kw[4][2];
#pragma unroll
              for (int k = 0; k < 4; ++k) { const f32x2* kp = ks + 4 * (tm + NTHREADS * (4 * kh + k)); kw[k][0] = *(const f32x4*)kp; kw[k][1] = *(const f32x4*)(kp + 2); }
#pragma unroll
              for (int k = 0; k < 4; ++k) { LAS f32x4* bp = (LAS f32x4*)(buf + fft_phys(4 * (tm + NTHREADS * (4 * kh + k))));
#pragma unroll
                  for (int e2 = 0; e2 < 2; ++e2) { const f32x4 z = bp[e2];
                      f32x2 za, zb, ka, kb; za.x = z[0]; za.y = z[1]; zb.x = z[2]; zb.y = z[3]; ka.x = kw[k][e2][0]; ka.y = kw[k][e2][1]; kb.x = kw[k][e2][2]; kb.y = kw[k][e2][3];
                      const f32x2 ra = fft_cmul(za, ka), rb = fft_cmul(zb, kb);
                      f32x4 w; w[0] = ra.x; w[1] = ra.y; w[2] = rb.x; w[3] = rb.y; bp[e2] = w; } } } }
        __syncthreads();
        fft16k<true>(buf, F.tid);
        const float bo = hb[o * 256 + c]; const float invn = 1.0f / (float)N;
        int tg = F.tid; asm volatile("" : "+v"(tg));
#pragma unroll
        for (int k = 0; k < 2; ++k) { const int t0 = 8 * (tg + NTHREADS * k);
            float zf = 0.f; asm volatile("" : "+v"(zf)); f32x4 zero4; zero4[0] = zf; zero4[1] = zf; zero4[2] = zf; zero4[3] = zf;
            float g0[8], g1[8]; hy_uc8(UT, 0, t0, o * 256 + c, cw, cb, g0); hy_uc8(UT, 1, t0, o * 256 + c, cw, cb, g1);
            LAS f32x4* bp = (LAS f32x4*)(buf + fft_phys(t0)); LAS f32x4* zp = (LAS f32x4*)(buf + fft_phys(L + t0));
#pragma unroll
            for (int e2 = 0; e2 < 4; ++e2) { const f32x4 cv = bp[e2];
                f32x2 za, zb; za.x = g0[2 * e2] * (cv[0] * invn + bo * zr[k][2 * e2].x); za.y = g1[2 * e2] * (cv[1] * invn + bo * zr[k][2 * e2].y);
                zb.x = g0[2 * e2 + 1] * (cv[2] * invn + bo * zr[k][2 * e2 + 1].x); zb.y = g1[2 * e2 + 1] * (cv[3] * invn + bo * zr[k][2 * e2 + 1].y);
                zr[k][2 * e2] = za; zr[k][2 * e2 + 1] = zb; }
            if (o == 0) {
#pragma unroll
                for (int e2 = 0; e2 < 4; ++e2) { f32x4 w; w[0] = zr[k][2 * e2].x; w[1] = zr[k][2 * e2].y; w[2] = zr[k][2 * e2 + 1].x; w[3] = zr[k][2 * e2 + 1].y; bp[e2] = w; zp[e2] = zero4; }
            } else {
                v4u o0, o1; o0.x = pk2(zr[k][0].x, zr[k][1].x); o0.y = pk2(zr[k][2].x, zr[k][3].x); o0.z = pk2(zr[k][4].x, zr[k][5].x); o0.w = pk2(zr[k][6].x, zr[k][7].x);
                o1.x = pk2(zr[k][0].y, zr[k][1].y); o1.y = pk2(zr[k][2].y, zr[k][3].y); o1.z = pk2(zr[k][4].y, zr[k][5].y); o1.w = pk2(zr[k][6].y, zr[k][7].y);
                bf16* hy = ((bf16*)(wsp(F) + WS_HYT)) + (size_t)c * MT + t0;
                *(v4u*)hy = o0; *(v4u*)(hy + L) = o1;
            } }
        __syncthreads();
    }
}

__device__ __forceinline__ void fnet_item_fft(Frame& F, int b, int g, int m) {
    constexpr int N = SEQ;
    LAS f32x2* buf = (LAS f32x2*)F.lds;
    LAS float* re = (LAS float*)(F.lds + 69632);
    LAS float* im = re + N + 128;
#define FN_PHYS(k) ((k) + 4 * ((k) >> 8))
    const bf16* ut = ((const bf16*)(wsp(F) + WS_UT)) + (size_t)(768 + g * 64) * MT + b * N;
    bf16* fnt = ((bf16*)(wsp(F) + WS_FNT)) + (size_t)(g * 64) * MT + b * N;
    const float sgn = (m == 0) ? 1.0f : -1.0f;
#pragma unroll
    for (int k = 0; k < 2; ++k) { const int n0 = 8 * (F.tid + NTHREADS * k);
        const v4u a = *(const v4u*)(ut + (size_t)m * MT + n0), bb = *(const v4u*)(ut + (size_t)(32 + m) * MT + n0);
        LAS f32x4* bp = (LAS f32x4*)(buf + fft_phys(n0));
        f32x4 w; w[0] = bflo(a.x); w[1] = sgn * bflo(bb.x); w[2] = bfhi(a.x); w[3] = sgn * bfhi(bb.x); bp[0] = w;
        w[0] = bflo(a.y); w[1] = sgn * bflo(bb.y); w[2] = bfhi(a.y); w[3] = sgn * bfhi(bb.y); bp[1] = w;
        w[0] = bflo(a.z); w[1] = sgn * bflo(bb.z); w[2] = bfhi(a.z); w[3] = sgn * bfhi(bb.z); bp[2] = w;
        w[0] = bflo(a.w); w[1] = sgn * bflo(bb.w); w[2] = bfhi(a.w); w[3] = sgn * bfhi(bb.w); bp[3] = w; }
    __syncthreads();
    fft8k_fwd(buf, F.tid);
#pragma unroll 4
    for (int pos = F.tid; pos < N; pos += NTHREADS) { const int k = (pos >> 9) + 16 * ((pos >> 5) & 15) + 256 * ((pos >> 1) & 15) + 4096 * (pos & 1);
        const f32x2 v = buf[fft_phys(pos)]; re[FN_PHYS(k)] = v.x; if (m == 0) im[FN_PHYS(k)] = v.y; }
    __syncthreads();
    const float scale = 1.0f / sqrtf((float)N * 64.0f);
#pragma unroll
    for (int j = 0; j < 2; ++j) { const int k0 = 8 * (F.tid + NTHREADS * j);
        float ra[8], rb[8];
        { const f32x4 x0 = *(const LAS f32x4*)(re + FN_PHYS(k0)), x1 = *(const LAS f32x4*)(re + FN_PHYS(k0) + 4);
#pragma unroll
          for (int e = 0; e < 4; ++e) { ra[e] = x0[e]; ra[4 + e] = x1[e]; }
#pragma unroll
          for (int e = 0; e < 8; ++e) rb[e] = re[FN_PHYS((N - k0 - e) & (N - 1))]; }
        if (m == 0) {
            float ia[8], ib[8];
            const f32x4 y0 = *(const LAS f32x4*)(im + FN_PHYS(k0)), y1 = *(const LAS f32x4*)(im + FN_PHYS(k0) + 4);
#pragma unroll
            for (int e = 0; e < 4; ++e) { ia[e] = y0[e]; ia[4 + e] = y1[e]; }
#pragma unroll
            for (int e = 0; e < 8; ++e) ib[e] = im[FN_PHYS((N - k0 - e) & (N - 1))];
            const float hs = 0.5f * scale;
            v4u o0, o1;
            o0.x = pk2((ra[0] + rb[0]) * hs, (ra[1] + rb[1]) * hs); o0.y = pk2((ra[2] + rb[2]) * hs, (ra[3] + rb[3]) * hs); o0.z = pk2((ra[4] + rb[4]) * hs, (ra[5] + rb[5]) * hs); o0.w = pk2((ra[6] + rb[6]) * hs, (ra[7] + rb[7]) * hs);
            o1.x = pk2((ia[0] + ib[0]) * hs, (ia[1] + ib[1]) * hs); o1.y = pk2((ia[2] + ib[2]) * hs, (ia[3] + ib[3]) * hs); o1.z = pk2((ia[4] + ib[4]) * hs, (ia[5] + ib[5]) * hs); o1.w = pk2((ia[6] + ib[6]) * hs, (ia[7] + ib[7]) * hs);
            *(v4u*)(fnt + k0) = o0; *(v4u*)(fnt + (size_t)32 * MT + k0) = o1;
        } else {
            v4u o0, o1;
            o0.x = pk2(ra[0] * scale, ra[1] * scale); o0.y = pk2(ra[2] * scale, ra[3] * scale); o0.z = pk2(ra[4] * scale, ra[5] * scale); o0.w = pk2(ra[6] * scale, ra[7] * scale);
            o1.x = pk2(rb[0] * scale, rb[1] * scale); o1.y = pk2(rb[2] * scale, rb[3] * scale); o1.z = pk2(rb[4] * scale, rb[5] * scale); o1.w = pk2(rb[6] * scale, rb[7] * scale);
            *(v4u*)(fnt + (size_t)m * MT + k0) = o0; *(v4u*)(fnt + (size_t)(64 - m) * MT + k0) = o1;
        } }
    __syncthreads();
}

#undef FN_PHYS
typedef short bf16x8 __attribute__((ext_vector_type(8)));
typedef float f32x16 __attribute__((ext_vector_type(16)));
__device__ __forceinline__ unsigned cvtpk(float lo, float hi) { return pg8::cvt_pk_bf16(lo, hi); }
struct AttnChunk { bf16x8 k[4]; bf16x8 v[2][2]; };
__device__ __forceinline__ void attn_load_chunk(AttnChunk& C, const bf16* KT, const bf16* VT, int keyrow0, int kvh, int lane) {
    const int kb = keyrow0 >> 5;
    const bf16* kp = KT + (size_t)((kvh * NKB + kb) * 4) * 512 + lane * 8;
#pragma unroll
    for (int s = 0; s < 4; ++s) C.k[s] = *(const bf16x8*)(kp + s * 512);
    const bf16* vp = VT + (size_t)((kvh * NKB + kb) * 4) * 512 + lane * 8;
#pragma unroll
    for (int dd = 0; dd < 2; ++dd)
#pragma unroll
        for (int s = 0; s < 2; ++s) C.v[dd][s] = *(const bf16x8*)(vp + (dd * 2 + s) * 512);
}
__device__ __forceinline__ void attn_item(Frame& F, int l, int item) {
    const int lane = F.lane, r = lane & 31, h = lane >> 5;
    const bf16* QK = (const bf16*)(wsp(F) + WS_QK); const bf16* VT = (const bf16*)(wsp(F) + WS_VT); const bf16* KT = (const bf16*)(wsp(F) + WS_KT);
    int g, kvh, b, qrow0, t0; bool isctx;
    if (item < 4096) { g = item & 3; const int qblk = (item >> 2) & 255; kvh = (item >> 10) & 1; b = item >> 11; isctx = false; t0 = qblk * 32; qrow0 = b * SEQ + t0; }
    else { const int j = item - 4096; g = j & 3; const int qb = (j >> 2) & 7; kvh = (j >> 5) & 1; b = j >> 6; isctx = true; t0 = 0; qrow0 = ML + b * CTXL + qb * 32; }
    const int head = 4 * kvh + g;
    bf16x8 qf[4];
    { const bf16* qp = QK + (size_t)(qrow0 + r) * 640 + head * 64 + 8 * h;
#pragma unroll
      for (int s = 0; s < 4; ++s) qf[s] = *(const bf16x8*)(qp + 16 * s); }
    float m = inp(F, I_SINK)[l * 8 + head] * 1.4426950408889634f;
    float lsum = (h == 0) ? 1.0f : 0.0f;
    f32x16 o0, o1;
#pragma unroll
    for (int i = 0; i < 16; ++i) { o0[i] = 0.f; o1[i] = 0.f; }
    int c_lo = 0, nl = 0;
    if (!isctx) { const int qblk = t0 >> 5; c_lo = qblk < 4 ? 4 - qblk : 0; const int c_hi = (259 - qblk) < 8 ? (259 - qblk) : 8; nl = c_hi - c_lo + 1; }
    const int n = nl + 8;
    const int lrow0 = b * SEQ + t0 - 128 + 32 * c_lo, crow0 = ML + b * CTXL - 32 * nl;
#define ATT_LOAD(BUF, i_) { const int ii_ = (i_) < n ? (i_) : n - 1; attn_load_chunk(BUF, KT, VT, ii_ < nl ? lrow0 + 32 * ii_ : crow0 + 32 * ii_, kvh, lane); }
#define ATT_COMPUTE(BUF, i_) { \
        const int cc_ = (i_) < nl ? c_lo + (i_) : 100; \
        f32x16 S; \
        _Pragma("unroll") for (int i = 0; i < 16; ++i) S[i] = 0.f; \
        _Pragma("unroll") for (int s = 0; s < 4; ++s) S = __builtin_amdgcn_mfma_f32_32x32x16_bf16(BUF.k[s], qf[s], S, 0, 0, 0); \
        if (cc_ == 0 || cc_ == 8) { \
            _Pragma("unroll") for (int i = 0; i < 16; ++i) { const int kidx = (i & 3) + 8 * (i >> 2) + 4 * h; const bool ok = (cc_ == 0) ? (kidx >= r) : (kidx <= r); if (!ok) S[i] = -INFINITY; } \
        } \
        float cm = S[0]; \
        _Pragma("unroll") for (int i = 1; i < 16; ++i) cm = fmaxf(cm, S[i]); \
        cm = fmaxf(cm, shx(cm, lane, 32)); \
        const float mn = fmaxf(m, cm), alpha = __builtin_amdgcn_exp2f(m - mn); m = mn; \
        float ps = 0.f; \
        _Pragma("unroll") for (int i = 0; i < 16; ++i) { S[i] = __builtin_amdgcn_exp2f(S[i] - m); ps += S[i]; } \
        lsum = lsum * alpha + ps; \
        _Pragma("unroll") for (int i = 0; i < 16; ++i) { o0[i] *= alpha; o1[i] *= alpha; } \
        bf16x8 pf[2]; \
        _Pragma("unroll") for (int s = 0; s < 2; ++s) { v4u w; w.x = cvtpk(S[8 * s + 0], S[8 * s + 1]); w.y = cvtpk(S[8 * s + 2], S[8 * s + 3]); w.z = cvtpk(S[8 * s + 4], S[8 * s + 5]); w.w = cvtpk(S[8 * s + 6], S[8 * s + 7]); pf[s] = __builtin_bit_cast(bf16x8, w); } \
        _Pragma("unroll") for (int s = 0; s < 2; ++s) { \
            o0 = __builtin_amdgcn_mfma_f32_32x32x16_bf16(BUF.v[0][s], pf[s], o0, 0, 0, 0); \
            o1 = __builtin_amdgcn_mfma_f32_32x32x16_bf16(BUF.v[1][s], pf[s], o1, 0, 0, 0); \
        } }
    AttnChunk ca, cb2, cc3;
    ATT_LOAD(ca, 0) ATT_LOAD(cb2, 1)
    { int ci = 0;
      for (;;) {
        ATT_LOAD(cc3, ci + 2) ATT_COMPUTE(ca, ci) if (++ci >= n) break;
        ATT_LOAD(ca, ci + 2) ATT_COMPUTE(cb2, ci) if (++ci >= n) break;
        ATT_LOAD(cb2, ci + 2) ATT_COMPUTE(cc3, ci) if (++ci >= n) break;
      } }
#undef ATT_LOAD
#undef ATT_COMPUTE
    lsum += shx(lsum, lane, 32);
    const float inv = 1.0f / lsum;
    bf16* op = ((bf16*)(wsp(F) + WS_AM)) + (size_t)(qrow0 + r) * 1024 + head * 64 + 4 * h;
#pragma unroll
    for (int g4 = 0; g4 < 4; ++g4) {
        v2u w0; w0.x = cvtpk(o0[4 * g4 + 0] * inv, o0[4 * g4 + 1] * inv); w0.y = cvtpk(o0[4 * g4 + 2] * inv, o0[4 * g4 + 3] * inv); *(v2u*)(op + 8 * g4) = w0;
        v2u w1; w1.x = cvtpk(o1[4 * g4 + 0] * inv, o1[4 * g4 + 1] * inv); w1.y = cvtpk(o1[4 * g4 + 2] * inv, o1[4 * g4 + 3] * inv); *(v2u*)(op + 32 + 8 * g4) = w1;
    }
}

__device__ __forceinline__ void attn_item_naive(Frame& F, int l, int r, int kvh, LAS float* wq, LAS float* wp) {
    const int lane = F.lane;
    const bool isctx = r >= ML; const int b = isctx ? ((r - ML) >> 8) : (r >> 13); const int t = r & 8191;
    const int lo = (t - 128) < 0 ? 0 : (t - 128), hi = (t + 128) > (SEQ - 1) ? (SEQ - 1) : (t + 128);
    const int nloc = isctx ? 0 : (hi - lo + 1), nk = nloc + CTXL;
#pragma unroll
    for (int h = 0; h < 4; ++h) wq[h * 64 + lane] = bf2f(((bf16*)(wsp(F) + WS_QK))[(size_t)r * 640 + (4 * kvh + h) * 64 + lane]) * 0.125f;
    LDS_WAIT(); asm volatile("" ::: "memory");
    for (int j = lane; j < nk; j += 64) {
        const int krow = j < nloc ? (b * SEQ + lo + j) : (ML + b * CTXL + (j - nloc));
        const bf16* kp = ((bf16*)(wsp(F) + WS_QK)) + (size_t)krow * 640 + 512 + kvh * 64;
        float s0 = 0.f, s1 = 0.f, s2 = 0.f, s3 = 0.f;
#pragma unroll
        for (int d8 = 0; d8 < 8; ++d8) { const v4u kw = *(const v4u*)(kp + d8 * 8);
            float kf[8]; kf[0] = bflo(kw.x); kf[1] = bfhi(kw.x); kf[2] = bflo(kw.y); kf[3] = bfhi(kw.y); kf[4] = bflo(kw.z); kf[5] = bfhi(kw.z); kf[6] = bflo(kw.w); kf[7] = bfhi(kw.w);
#pragma unroll
            for (int e = 0; e < 8; ++e) { const int d = d8 * 8 + e; s0 += kf[e] * wq[d]; s1 += kf[e] * wq[64 + d]; s2 += kf[e] * wq[128 + d]; s3 += kf[e] * wq[192 + d]; } }
        f32x4 sv; sv[0] = s0; sv[1] = s1; sv[2] = s2; sv[3] = s3;
        *(LAS f32x4*)(wp + j * 4) = sv;
    }
    LDS_WAIT(); asm volatile("" ::: "memory");
    f32x4 mx = {-INFINITY, -INFINITY, -INFINITY, -INFINITY};
    for (int j = lane; j < nk; j += 64) { const f32x4 sv = *(LAS f32x4*)(wp + j * 4);
#pragma unroll
        for (int h = 0; h < 4; ++h) mx[h] = fmaxf(mx[h], sv[h]); }
    f32x4 sink, den;
#pragma unroll
    for (int h = 0; h < 4; ++h) { sink[h] = inp(F, I_SINK)[l * 8 + 4 * kvh + h]; mx[h] = fmaxf(wave_max(mx[h], lane), sink[h]); den[h] = 0.f; }
    for (int j = lane; j < nk; j += 64) { f32x4 sv = *(LAS f32x4*)(wp + j * 4);
#pragma unroll
        for (int h = 0; h < 4; ++h) { sv[h] = __expf(sv[h] - mx[h]); den[h] += sv[h]; }
        *(LAS f32x4*)(wp + j * 4) = sv; }
#pragma unroll
    for (int h = 0; h < 4; ++h) den[h] = wave_sum(den[h], lane) + __expf(sink[h] - mx[h]);
    LDS_WAIT(); asm volatile("" ::: "memory");
    f32x4 o = {0.f, 0.f, 0.f, 0.f};
    for (int j = 0; j < nk; ++j) {
        const int krow = j < nloc ? (b * SEQ + lo + j) : (ML + b * CTXL + (j - nloc));
        const float v = bf2f(((bf16*)(wsp(F) + WS_PR))[(size_t)krow * INW + K_END + kvh * 64 + lane]);
        const f32x4 p = *(LAS f32x4*)(wp + j * 4);
        o += p * v;
    }
#pragma unroll
    for (int h = 0; h < 4; ++h) ((bf16*)(wsp(F) + WS_ATT))[(size_t)r * 512 + (4 * kvh + h) * 64 + lane] = (bf16)f2bf(o[h] / den[h]);
    LDS_WAIT(); asm volatile("" ::: "memory");
}


__device__ __forceinline__ void hyena_ctx_wave(Frame& F, int l, int c, LAS float* kt  , LAS f32x2* z  ) {
    constexpr int L = CTXL; const int lane = F.lane;
    const bf16* UT = (const bf16*)(wsp(F) + WS_UT); const float* HFC = (const float*)(wsp(F) + WS_HFC);
    const float* cw = inp(F, I_HCW) + l * 3 * 768; const float* cb = inp(F, I_HCB) + l * 768; const float* hb = inp(F, I_HBIAS) + l * 512;
#pragma unroll
    for (int j = 0; j < 4; ++j) { const int t = lane + 64 * j; f32x2 v; v.x = hy_uc<L>(UT, ML, 0, t, 512 + c, cw, cb); v.y = hy_uc<L>(UT, ML, 1, t, 512 + c, cw, cb); z[t] = v; }
    for (int o = 0; o < 2; ++o) {
        const float* fwd = HFC + (size_t)(o * 256 + c) * L; const float* bwd = HFC + (size_t)(512 + o * 256 + c) * L;
        float part = 0.f;
#pragma unroll
        for (int j = 0; j < 4; ++j) { const int d = lane + 64 * j; const float kf = fwd[d]; kt[L + d] = kf; part += fabsf(kf);
            if (d >= 1) { const float kb = bwd[d]; kt[L - d] = kb; part += fabsf(kb); } else kt[0] = 0.f; }
        const float inv = 1.0f / wave_sum(part, lane);
        LDS_WAIT(); asm volatile("" ::: "memory");
        float r0[4] = {0.f, 0.f, 0.f, 0.f}, r1[4] = {0.f, 0.f, 0.f, 0.f};
#pragma unroll 4
        for (int s = 0; s < L; ++s) { const f32x2 zz = z[s];
#pragma unroll
            for (int j = 0; j < 4; ++j) { const float kv = kt[L + lane + 64 * j - s]; r0[j] += kv * zz.x; r1[j] += kv * zz.y; } }
        LDS_WAIT(); asm volatile("" ::: "memory");
        const float bo = hb[o * 256 + c];
#pragma unroll
        for (int j = 0; j < 4; ++j) { const int t = lane + 64 * j;
            const float g0 = hy_uc<L>(UT, ML, 0, t, o * 256 + c, cw, cb), g1 = hy_uc<L>(UT, ML, 1, t, o * 256 + c, cw, cb);
            const f32x2 zo = z[t]; f32x2 zn; zn.x = g0 * (r0[j] * inv + bo * zo.x); zn.y = g1 * (r1[j] * inv + bo * zo.y); z[t] = zn; }
        LDS_WAIT(); asm volatile("" ::: "memory");
    }
    bf16* hyt = ((bf16*)(wsp(F) + WS_HYT)) + (size_t)c * MT + ML;
#pragma unroll
    for (int j = 0; j < 4; ++j) { const int t = lane + 64 * j; const f32x2 v = z[t]; hyt[t] = (bf16)f2bf(v.x); hyt[L + t] = (bf16)f2bf(v.y); }
    LDS_WAIT(); asm volatile("" ::: "memory");
}
__device__ __forceinline__ void fnet_ctx_wave(Frame& F, int b, int g, int m, LAS f32x2* AB  , LAS f32x2* tab  ) {
    constexpr int L = CTXL; const int lane = F.lane;
    const bf16* ut = ((const bf16*)(wsp(F) + WS_UT)) + (size_t)(768 + g * 64) * MT + ML + b * L;
    const int mm = m <= 32 ? m : 64 - m;
#pragma unroll
    for (int j = 0; j < 4; ++j) { const int n = lane + 64 * j; f32x2 t; const float rev = (float)n * (1.0f / (float)L); t.x = cos_rev(rev); t.y = sin_rev(rev); tab[n] = t;
        f32x2 v; v.x = bf2f(ut[(size_t)mm * MT + n]);
        v.y = (m == 0 || m == 32) ? 0.f : (m < 32 ? bf2f(ut[(size_t)(32 + m) * MT + n]) : -bf2f(ut[(size_t)(32 + mm) * MT + n]));
        AB[n] = v; }
    LDS_WAIT(); asm volatile("" ::: "memory");
    const float scale = 1.0f / sqrtf((float)L * 64.0f);
    bf16* fnt = ((bf16*)(wsp(F) + WS_FNT)) + (size_t)(g * 64 + m) * MT + ML + b * L;
    { float acc[4] = {0.f, 0.f, 0.f, 0.f}; int idx[4] = {0, 0, 0, 0};
#pragma unroll 4
      for (int n = 0; n < L; ++n) { const f32x2 ab = AB[n];
#pragma unroll
          for (int j = 0; j < 4; ++j) { const f32x2 cs = tab[idx[j]]; acc[j] += ab.x * cs.x - ab.y * cs.y; idx[j] = (idx[j] + lane + 64 * j) & (L - 1); } }
#pragma unroll
      for (int j = 0; j < 4; ++j) fnt[lane + 64 * j] = (bf16)f2bf(acc[j] * scale); }
    LDS_WAIT(); asm volatile("" ::: "memory");
}

__device__ __forceinline__ void phase_trans(Frame& F) {
    LAS unsigned* tl = (LAS unsigned*)(F.lds + F.wave * 16640);
    const int gw = F.bid * NWAVES + F.wave, NGW = F.G * NWAVES, lane = F.lane;
    const int seg = lane & 7, q = lane >> 3;
    for (int it = gw; it < 2 * 264 * 4; it += NGW) {
        const int which = it / (264 * 4), rem = it % (264 * 4), rt = rem >> 2, ct = rem & 3;
        const bf16* src = (which == 0 ? ((const bf16*)(wsp(F) + WS_HYT)) : ((const bf16*)(wsp(F) + WS_FNT))) + (size_t)(ct * 64) * MT + rt * 64 + 8 * seg;
        bf16* dst = ((bf16*)(wsp(F) + WS_AM)) + (which == 0 ? 512 : 768) + (size_t)(rt * 64) * 1024 + ct * 64 + 8 * seg;
        v4u a[4], b[4];
#pragma unroll
        for (int j = 0; j < 4; ++j) { const bf16* p = src + (size_t)(2 * (8 * j + q)) * MT; a[j] = *(const v4u*)p; b[j] = *(const v4u*)(p + MT); }
#pragma unroll
        for (int j = 0; j < 4; ++j) { LAS unsigned* tp = tl + (8 * seg) * 33 + 8 * j + q;
            tp[0 * 33] = (a[j].x & 0xffffu) | (b[j].x << 16); tp[1 * 33] = (a[j].x >> 16) | (b[j].x & 0xffff0000u);
            tp[2 * 33] = (a[j].y & 0xffffu) | (b[j].y << 16); tp[3 * 33] = (a[j].y >> 16) | (b[j].y & 0xffff0000u);
            tp[4 * 33] = (a[j].z & 0xffffu) | (b[j].z << 16); tp[5 * 33] = (a[j].z >> 16) | (b[j].z & 0xffff0000u);
            tp[6 * 33] = (a[j].w & 0xffffu) | (b[j].w << 16); tp[7 * 33] = (a[j].w >> 16) | (b[j].w & 0xffff0000u); }
        LDS_WAIT(); asm volatile("" ::: "memory");
#pragma unroll
        for (int i = 0; i < 8; ++i) { const int row = q + 8 * i; const LAS unsigned* tp = tl + row * 33 + 4 * seg;
            v4u o; o.x = tp[0]; o.y = tp[1]; o.z = tp[2]; o.w = tp[3];
            *(v4u*)(dst + (size_t)row * 1024) = o; }
        LDS_WAIT(); asm volatile("" ::: "memory");
    }
}

__device__ __forceinline__ void phase_mix_naive(Frame& F, int l) {
    const bool last = (l == DEPTH - 1);
    SUBPR_START(13)
    { const int gw = F.bid * NWAVES + F.wave, NGW = F.G * NWAVES;
      for (int it = gw; it < 4096; it += NGW) attn_item(F, l, it);
      if (!last && F.wave == 3 && F.bid < 128) attn_item(F, l, 4096 + F.bid); }
    SUBPR_STOP(13)
    SUBPR_START(15)
    if (!last) { const int rank = F.wave * F.G + F.bid, NR = F.G * NWAVES;
      LAS float* wl = (LAS float*)(F.lds + F.wave * 4096);
      for (int it = rank; it < 256 + 512; it += NR) {
          if (it < 256) hyena_ctx_wave(F, l, it, wl, (LAS f32x2*)(wl + 512));
          else { const int j = it - 256; fnet_ctx_wave(F, j >> 8, (j >> 6) & 3, j & 63, (LAS f32x2*)wl, (LAS f32x2*)(wl + 512)); } } }
    SUBPR_STOP(15)
    __syncthreads();
    SUBPR_START(14)
    for (int c = F.bid; c < 256; c += F.G) hyena_item_fft(F, l, c);
    SUBPR_STOP(14)
    SUBPR_START(16)
    for (int it = F.bid; it < 256; it += F.G) fnet_item_fft(F, it >> 7, (it >> 5) & 3, it & 31);
    SUBPR_STOP(16)
}

__device__ __forceinline__ f32x4 small_gemm_tile(Frame& F, const bf16* A, int lda, const bf16* Bt, int ldb, int kbeg, int klen, int row0, int col0) {
    typedef short bf16x8_t __attribute__((ext_vector_type(8))); typedef float f32x16_t __attribute__((ext_vector_type(16)));
    LAS float* part = (LAS float*)F.lds;
    const int r = F.lane & 31, h = F.lane >> 5, kw = klen >> 3, k0 = kbeg + F.wave * kw + 8 * h;
    const bf16* ap = A + (size_t)(row0 + r) * lda + k0; const bf16* bp0 = Bt + (size_t)(col0 + r) * ldb + k0; const bf16* bp1 = bp0 + (size_t)32 * ldb;
    f32x16_t acc0, acc1;
#pragma unroll
    for (int q = 0; q < 16; ++q) { acc0[q] = 0.f; acc1[q] = 0.f; }
#pragma unroll 4
    for (int k = 0; k < kw; k += 16) { const bf16x8_t a = *(const bf16x8_t*)(ap + k), b0 = *(const bf16x8_t*)(bp0 + k), b1 = *(const bf16x8_t*)(bp1 + k);
        acc0 = __builtin_amdgcn_mfma_f32_32x32x16_bf16(b0, a, acc0, 0, 0, 0); acc1 = __builtin_amdgcn_mfma_f32_32x32x16_bf16(b1, a, acc1, 0, 0, 0); }
#pragma unroll
    for (int q = 0; q < 16; ++q) { const int col = (q & 3) + 8 * (q >> 2) + 4 * h; part[(F.wave * 64 + col) * 32 + r] = acc0[q]; part[(F.wave * 64 + 32 + col) * 32 + r] = acc1[q]; }
    __syncthreads();
    const int tok = F.tid & 31, cq = F.tid >> 5; f32x4 s = {0.f, 0.f, 0.f, 0.f};
#pragma unroll
    for (int w = 0; w < 8; ++w)
#pragma unroll
        for (int e = 0; e < 4; ++e) s[e] += part[(w * 64 + 4 * cq + e) * 32 + tok];
    __syncthreads();
    return s;
}
__device__ __forceinline__ void ctx_merge(Frame& F, int l) {
    for (int it = F.bid; it < 256; it += F.G) { const int row0 = ML + (it >> 4) * 32, col0 = (it & 15) * 64;
        const bf16* A = (const bf16*)(wsp(F) + WS_AM); const bf16* Bt = ((const bf16*)(wsp(F) + WS_WPA)) + (size_t)l * 1024 * 1024; const bf16* PR = (const bf16*)(wsp(F) + WS_PR);
        const int row = row0 + (F.tid & 31), col = col0 + 4 * (F.tid >> 5); f32x4 tot = {0.f, 0.f, 0.f, 0.f};
#pragma unroll
        for (int br = 0; br < 3; ++br) { const f32x4 p = small_gemm_tile(F, A, 1024, Bt, 1024, br == 0 ? 0 : (br == 1 ? 512 : 768), br == 0 ? 512 : 256, row0, col0);
            const v2u gw = *(const v2u*)(PR + (size_t)row * INW + 1792 + br * 1024 + col);
            tot[0] += bflo(gw.x) * p[0]; tot[1] += bfhi(gw.x) * p[1]; tot[2] += bflo(gw.y) * p[2]; tot[3] += bfhi(gw.y) * p[3]; }
        v2u o; o.x = pk2(tot[0], tot[1]); o.y = pk2(tot[2], tot[3]); *(v2u*)(((bf16*)(wsp(F) + WS_M)) + (size_t)row * 1024 + col) = o; }
}
__device__ __forceinline__ void ctx_resid(Frame& F, const bf16* A, int K, const bf16* Bt, const float* gate_ctx  ) {
    for (int it = F.bid; it < 256; it += F.G) { const int row0 = ML + (it >> 4) * 32, col0 = (it & 15) * 64;
        const f32x4 p = small_gemm_tile(F, A, K, Bt, K, 0, K, row0, col0);
        const int row = row0 + (F.tid & 31), col = col0 + 4 * (F.tid >> 5);
        bf16* xp = ((bf16*)(wsp(F) + WS_XS)) + (size_t)row * 1024 + col;
        const v2u xw = *(const v2u*)xp; const f32x4 gv = *(const f32x4*)(gate_ctx + col);
        v2u o; o.x = pk2(bflo(xw.x) + gv[0] * p[0], bfhi(xw.x) + gv[1] * p[1]); o.y = pk2(bflo(xw.y) + gv[2] * p[2], bfhi(xw.y) + gv[3] * p[3]);
        *(v2u*)xp = o; }
}

constexpr int NPL = 11;
constexpr int NPHASES = 1 + DEPTH * NPL + 1;
#ifndef ONE_LAUNCH
#define ONE_LAUNCH 1
#endif

__global__ void __launch_bounds__(NTHREADS, 2) fwd_kernel(Args args) {
    extern __shared__ __attribute__((aligned(16))) unsigned char lds[];
    Frame F;
    F.lds = (LAS unsigned char*)lds;
    F.tid = threadIdx.x; F.lane = F.tid & 63; F.wave = __builtin_amdgcn_readfirstlane(F.tid >> 6);
    F.G = gridDim.x; F.bid = blockIdx.x;
    unsigned char* ws = args.ws; F.ws = ws;
    F.ctl = (unsigned*)(ws + WS_CTL);
    F.a = &args; F.z = 0;
    volatile LAS unsigned* MISC = (volatile LAS unsigned*)(F.lds + MISC_OFF);
    for (int u = F.tid; u < 64; u += NTHREADS) MISC[u] = 0u;
    __syncthreads();
    const int lo = args.ph_lo, hi = args.ph_hi;
    XcdBarrier bar; bar.bar = F.ctl + CW_BAR; bar.x = 0; bar.st = nullptr;
    if (hi - lo > 1) bar = xcd_barrier_post(F.ctl + CW_BAR, MISC + 8);
    F.pr_acc = 0ull; F.pr_t0 = 0ull;
#define PR_TYPE(k) ((k) == 0 ? 11 : ((k) == 1 + DEPTH * NPL ? 12 : (((k) - 1) % NPL)))
#ifndef PROBE_LAYERS
#define PROBE_LAYERS 0xF
#endif
#define PR_LAYER(k) ((k) == 0 || (k) == 1 + DEPTH * NPL ? 0 : (((k) - 1) / NPL))
#define PR_START(k) if (PROBE_MASK && ((PROBE_MASK >> PR_TYPE(k)) & 1) && ((PROBE_LAYERS >> PR_LAYER(k)) & 1)) F.pr_t0 = __builtin_amdgcn_s_memrealtime();
#define PR_STOP(k) if (PROBE_MASK && ((PROBE_MASK >> PR_TYPE(k)) & 1) && ((PROBE_LAYERS >> PR_LAYER(k)) & 1)) F.pr_acc += __builtin_amdgcn_s_memrealtime() - F.pr_t0;
#define PH_BEGIN(k) if (lo <= (k) && (k) < hi) { PR_START(k) { int t_ = threadIdx.x; asm volatile("" : "+v"(t_)); F.tid = t_; F.lane = t_ & 63; F.wave = __builtin_amdgcn_readfirstlane(t_ >> 6); int z_ = 0; asm volatile("" : "+s"(z_)); F.z = z_; }
#define PH_END(k) if ((k) + 1 < hi) xcd_barrier_impl(bar.bar, bar.x, bar.st); PR_STOP(k) }

    PH_BEGIN(0) phase_prologue(F); PH_END(0)

    for (int l = 0; l < DEPTH; ++l) {
        const int pb = 1 + l * NPL;
        const float* modl = ((float*)(wsp(F) + WS_CTL) + CW_MOD) + (size_t)l * 3 * 6144;
        const bool moe = (l & 1) != 0; const int fi = l >> 1;

        PH_BEGIN(pb + 0)
            if (l > 0 && ((l - 1) & 1)) phase_norm<false, true, true>(F, l, nullptr, nullptr, inp(F, I_N1G) + l * 1024, 0, nullptr, MT, F.G > 64 ? 8 : 0);
            else if (l == 0) phase_norm<false, false, true, false>(F, l, inp(F, I_X), inp(F, I_CTX), inp(F, I_N1G) + l * 1024, 0, nullptr, MT, F.G > 64 ? 8 : 0);
            else phase_norm<false, false, true>(F, l, nullptr, nullptr, inp(F, I_N1G) + l * 1024, 0, nullptr, MT, F.G > 64 ? 8 : 0);
            for (int it = F.bid; it < 264; it += F.G) { if (it < 256) filter_tile(F, l, SEQ, it * 32, ((float*)(wsp(F) + WS_HF)), it == F.bid); else filter_tile(F, l, CTXL, (it - 256) * 32, ((float*)(wsp(F) + WS_HFC)), it == F.bid); }
        PH_END(pb + 0)

        PH_BEGIN(pb + 1)
            pg8::Gemm g{((bf16*)(wsp(F) + WS_H)), ((bf16*)(wsp(F) + WS_WIN)) + (size_t)l * INW * 1024, MT, INW, 1024}; pg8::StaticOrder S; S.init(MT, INW, F.G, F.bid);
            pg8::EpiIn E{wsp(F), l};
            pg8::gemm_phase<pg8::EpiIn, pg8::StaticOrder, true, true>(F.lds, g, S, E);
        PH_END(pb + 1)


        PH_BEGIN(pb + 3) phase_mix_naive(F, l); PH_END(pb + 3)

        PH_BEGIN(pb + 4) phase_trans(F); PH_END(pb + 4)

        PH_BEGIN(pb + 5)
            if (l != DEPTH - 1) ctx_merge(F, l);
            pg8::Gemm g{((bf16*)(wsp(F) + WS_AM)), ((bf16*)(wsp(F) + WS_WPA)) + (size_t)l * 1024 * 1024, ML, 1024, 1024}; pg8::StaticOrder S; S.init(ML, 1024, F.G, F.bid);
            pg8::EpiMerge E{((bf16*)(wsp(F) + WS_PR)), ((bf16*)(wsp(F) + WS_M))};
            pg8::gemm_phase<pg8::EpiMerge, pg8::StaticOrder, true, true>(F.lds, g, S, E);
        PH_END(pb + 5)

        PH_BEGIN(pb + 6)
            if (l != DEPTH - 1) ctx_resid(F, (const bf16*)(wsp(F) + WS_M), 1024, ((const bf16*)(wsp(F) + WS_WO)) + (size_t)l * 1024 * 1024, modl + 2 * 6144 + 2048);
            pg8::Gemm g{((bf16*)(wsp(F) + WS_M)), ((bf16*)(wsp(F) + WS_WO)) + (size_t)l * 1024 * 1024, ML, 1024, 1024}; pg8::StaticOrder S; S.init(ML, 1024, F.G, F.bid);
            pg8::EpiResid E{((bf16*)(wsp(F) + WS_XS)), modl + 2048};
            pg8::gemm_phase<pg8::EpiResid, pg8::StaticOrder, true, true>(F.lds, g, S, E);
        PH_END(pb + 6)

        PH_BEGIN(pb + 7)
            if (moe) phase_norm<true, false, true>(F, l, nullptr, nullptr, inp(F, I_N2G) + l * 1024, 3072, inp(F, I_ROUTER) + (size_t)fi * 1024 * 8, MT);
            else phase_norm<false, false, true>(F, l, nullptr, nullptr, inp(F, I_N2G) + l * 1024, 3072, nullptr, MT);
        PH_END(pb + 7)

        if (moe) {
            PH_BEGIN(pb + 8) phase_gather(F, l); PH_END(pb + 8)
        }

        PH_BEGIN(pb + 9)
            LAS int* poff = (LAS int*)(F.lds + LDS_TAB + 64);
            if (moe) {
                moe_offsets(F, l, poff);
                pg8::Gemm g{((bf16*)(wsp(F) + WS_XG)), ((bf16*)(wsp(F) + WS_MGU)) + (size_t)(fi * 8) * 5632 * 1024, MOE_MAXP * 256, 8 * 5632, 1024}; pg8::MoeOrder S{22, F.G, F.bid, poff};
                pg8::EpiSwiglu E{((bf16*)(wsp(F) + WS_HIDG)), DFF, 22};
                pg8::gemm_phase<pg8::EpiSwiglu, pg8::MoeOrder, true, true>(F.lds, g, S, E);
            } else {
                pg8::Gemm g{((bf16*)(wsp(F) + WS_H)), ((bf16*)(wsp(F) + WS_FGU)) + (size_t)fi * 5632 * 1024, MT, 5632, 1024}; pg8::StaticOrder S; S.init(MT, 5632, F.G, F.bid);
                pg8::EpiSwiglu E{((bf16*)(wsp(F) + WS_HID)), DFF, 22};
                pg8::gemm_phase<pg8::EpiSwiglu, pg8::StaticOrder, true, true>(F.lds, g, S, E);
            }
        PH_END(pb + 9)

        PH_BEGIN(pb + 10)
            LAS int* poff = (LAS int*)(F.lds + LDS_TAB + 64);
            if (moe) {
                moe_offsets(F, l, poff);
                pg8::Gemm g{((bf16*)(wsp(F) + WS_HIDG)), ((bf16*)(wsp(F) + WS_MD)) + (size_t)(fi * 8) * 1024 * 2816, MOE_MAXP * 256, 8 * 1024, DFF}; pg8::MoeOrder S{4, F.G, F.bid, poff};
                pg8::EpiStore E{((bf16*)(wsp(F) + WS_Y)), 1024, 4};
                pg8::gemm_phase<pg8::EpiStore, pg8::MoeOrder, true, true>(F.lds, g, S, E);
            } else {
                ctx_resid(F, (const bf16*)(wsp(F) + WS_HID), DFF, ((const bf16*)(wsp(F) + WS_FD)) + (size_t)fi * 1024 * 2816, modl + 2 * 6144 + 5120);
                pg8::Gemm g{((bf16*)(wsp(F) + WS_HID)), ((bf16*)(wsp(F) + WS_FD)) + (size_t)fi * 1024 * 2816, ML, 1024, DFF}; pg8::StaticOrder S; S.init(ML, 1024, F.G, F.bid);
                pg8::EpiResid E{((bf16*)(wsp(F) + WS_XS)), modl + 5120};
                pg8::gemm_phase<pg8::EpiResid, pg8::StaticOrder, true, true>(F.lds, g, S, E);
            }
        PH_END(pb + 10)
    }
    PH_BEGIN(1 + DEPTH * NPL) phase_norm<false, true, false>(F, DEPTH - 1, nullptr, nullptr, nullptr, 0, nullptr, ML); PH_END(1 + DEPTH * NPL)
#undef PH_BEGIN
#undef PH_END
    if (PROBE_MASK && blockIdx.x == 0) { const unsigned long long t0 = __builtin_amdgcn_s_memrealtime(); while (__builtin_amdgcn_s_memrealtime() - t0 < F.pr_acc * PROBE_AMP) __builtin_amdgcn_s_sleep(8); }
}

extern "C" void kernel_launch(void* const* d_in, const int* in_sizes, int n_in, void* d_out, int out_size, void* d_ws, size_t ws_size, hipStream_t stream) {
    static int grid = 0;
    if (grid == 0) {
        if (n_in != 33 || out_size != ML * DM || ws_size < WS_END2) { fprintf(stderr, "kernel_launch: unexpected shapes (n_in %d out %d ws %zu need %zu)\n", n_in, out_size, ws_size, (size_t)WS_END2); grid = -1; return; }
        int dev = 0, cus = 0, per_cu = 0;
        if (hipGetDevice(&dev) != hipSuccess || hipDeviceGetAttribute(&cus, hipDeviceAttributeMultiprocessorCount, dev) != hipSuccess) { grid = -1; return; }
        if (hipFuncSetAttribute((const void*)fwd_kernel, hipFuncAttributeMaxDynamicSharedMemorySize, LDS_BYTES) != hipSuccess) { fprintf(stderr, "kernel_launch: hipFuncSetAttribute failed\n"); grid = -1; return; }
        if (hipOccupancyMaxActiveBlocksPerMultiprocessor(&per_cu, (const void*)fwd_kernel, NTHREADS, LDS_BYTES) != hipSuccess || per_cu < 1) { fprintf(stderr, "kernel_launch: occupancy query says %d\n", per_cu); }
        (void)hipGetLastError();
        grid = cus;
    }
    if (grid < 0) return;
    if (hipMemsetAsync((char*)d_ws + WS_CTL, 0, CTL_ZERO_BYTES, stream) != hipSuccess) return;
    Args a{};
    for (int i = 0; i < 33; ++i) a.in[i] = (const float*)d_in[i];
    a.in[33] = (const float*)d_out; a.ws = (unsigned char*)d_ws;
#if ONE_LAUNCH
    a.ph_lo = 0; a.ph_hi = NPHASES;
    hipLaunchKernelGGL(fwd_kernel, dim3(grid), dim3(NTHREADS), LDS_BYTES, stream, a);
#else
    for (int k = 0; k < NPHASES; ++k) {
        if (k >= 1 && k < NPHASES - 1) { const int l = (k - 1) / NPL, p = (k - 1) % NPL; if ((l & 1) == 0 && p == 8) continue; }
        a.ph_lo = k; a.ph_hi = k + 1;
        hipLaunchKernelGGL(fwd_kernel, dim3(grid), dim3(NTHREADS), LDS_BYTES, stream, a);
    }
#endif
}
```

```cpp
#include <hip/hip_runtime.h>
#include <cstdio>
#include <cstdint>
#ifndef PROBE_MASK
#define PROBE_MASK 0
#endif
#ifndef PROBE_AMP
#define PROBE_AMP 4
#endif
#define SUBPR_START(t) if (PROBE_MASK && ((PROBE_MASK >> (t)) & 1)) { __syncthreads(); F.pr_t0 = __builtin_amdgcn_s_memrealtime(); }
#define SUBPR_STOP(t) if (PROBE_MASK && ((PROBE_MASK >> (t)) & 1)) { __syncthreads(); F.pr_acc += __builtin_amdgcn_s_memrealtime() - F.pr_t0; }
namespace pg8 {
#define PG8_LAS __attribute__((address_space(3)))
typedef unsigned short bf16_t;
typedef short bf16x8 __attribute__((ext_vector_type(8)));
typedef float f32x4 __attribute__((ext_vector_type(4)));
typedef unsigned u32x4 __attribute__((ext_vector_type(4)));
constexpr int BM = 256, BK = 64, HALF = 128, HTB = HALF * BK * 2  , STAGE_BYTES = 8 * HTB, NXCD = 8, WGM = 8;

__host__ __device__ __forceinline__ int lds_byte(int r, int c) { const int st = (r >> 4) * 2 + (c >> 5), rr = r & 15, cc = c & 31, ob = rr * 64 + cc * 2; return st * 1024 + (ob ^ (((ob >> 9) & 1) << 5)); }
__host__ __device__ __forceinline__ void stage_rc(int b, int& R, int& C) { const int st = b / 1024, sb = b % 1024, swz = sb ^ (((sb >> 9) & 1) << 5); R = (st >> 1) * 16 + swz / 64; C = (st & 1) * 32 + (swz % 64) / 2; }
__host__ __device__ __forceinline__ int perm32(int rho) { const int n = rho >> 4, i = rho & 15; return 8 * (i >> 2) + 4 * n + (i & 3); }

struct Unit { int pm, pn; };
struct Gemm { const bf16_t* A; const bf16_t* Bt; int M, N, K; };

struct StaticOrder {
    int nM, nN, nwg, G, c;
    __host__ __device__ void init(int M, int N, int G_, int c_) { nM = M / BM; nN = N / BM; nwg = nM * nN; G = G_; c = c_; }
    __host__ __device__ bool next(int i, Unit& u) const {
        const long L = (long)i * G + c; if (L >= nwg) return false;
        int wgid = (int)L; { const int q = nwg / NXCD, r = nwg % NXCD, xcd = wgid % NXCD, off = wgid / NXCD; wgid = (xcd < r ? xcd * (q + 1) : r * (q + 1) + (xcd - r) * q) + off; }
        const int nig = WGM * nN, gid = wgid / nig, fm = gid * WGM, gsz = (nM - fm) < WGM ? (nM - fm) : WGM;
        u.pm = fm + ((wgid % nig) % gsz); u.pn = (wgid % nig) / gsz; return true;
    }
    __device__ __forceinline__ void a_ready(const Unit&) const {}
    __device__ __forceinline__ void done(const Unit&) const {}
};

__device__ __forceinline__ unsigned cvt_pk_bf16(float lo, float hi) { typedef float f32x2_c __attribute__((ext_vector_type(2))); typedef __bf16 bf16x2_c __attribute__((ext_vector_type(2))); f32x2_c v = {lo, hi}; bf16x2_c b = __builtin_convertvector(v, bf16x2_c); return __builtin_bit_cast(unsigned, b); }
typedef float f32x2 __attribute__((ext_vector_type(2)));
template <class Epi, class Sched, bool ALIGN_EPI = false, bool SP2 = false>
__device__ __forceinline__ void gemm_phase(PG8_LAS unsigned char* lds, const Gemm g, const Sched& S, const Epi& E) {
    int tid_ = threadIdx.x; asm volatile("" : "+v"(tid_)); const int tid = tid_, wid = __builtin_amdgcn_readfirstlane(tid >> 6), lane = tid & 63, wr = wid >> 2, wc = wid & 3, fr = lane & 15, fq = lane >> 4;
    const int K = g.K, nt = K / BK;
    unsigned voffA[2], voffB[2];
#pragma unroll
    for (int i = 0; i < 2; ++i) { int R, C; stage_rc(tid * 16 + i * 8192, R, C); const int Rb = Epi::PERM ? ((R & ~31) + perm32(R & 31)) : R;
        voffA[i] = (unsigned)(R * K + C) * 2u; voffB[i] = (unsigned)(Rb * K + C) * 2u; }
    const size_t kstep = (size_t)(BK * 2);
    const size_t hstep = (size_t)HALF * K * 2;
    const size_t tstep = 2 * hstep;
    const unsigned ldsw = (unsigned)wid * 1024u;
    const int aoff = lds_byte(wr * 64 + fr, fq * 8), boff = lds_byte(wc * 32 + fr, fq * 8);
#define PG8_SA(b, h) (((b) * 2 + (h)) * HTB)
#define PG8_SB(b, h) ((4 + (b) * 2 + (h)) * HTB)
#define PG8_STAGE(bufoff, gbase, voff) do { _Pragma("unroll") for (int _i = 0; _i < 2; ++_i) \
        __builtin_amdgcn_global_load_lds((const unsigned*)((const char*)(gbase) + (voff)[_i]), (PG8_LAS unsigned*)(lds + (bufoff) + ldsw + _i * 8192), 16, 0, 0); } while (0)
#define PG8_LDA(dst, b, h) do { _Pragma("unroll") for (int m = 0; m < 4; ++m) _Pragma("unroll") for (int k = 0; k < 2; ++k) dst[m][k] = *(const PG8_LAS bf16x8*)(lds + PG8_SA(b, h) + aoff + m * 2048 + k * 1024); } while (0)
#define PG8_LDB(dst, b, h) do { _Pragma("unroll") for (int n = 0; n < 2; ++n) _Pragma("unroll") for (int k = 0; k < 2; ++k) dst[n][k] = *(const PG8_LAS bf16x8*)(lds + PG8_SB(b, h) + boff + n * 2048 + k * 1024); } while (0)
#define PG8_MMA(ai, bj, At, Bt) do { __builtin_amdgcn_s_setprio(1); _Pragma("unroll") for (int m = 0; m < 4; ++m) _Pragma("unroll") for (int n = 0; n < 2; ++n) _Pragma("unroll") for (int k = 0; k < 2; ++k) \
        acc[ai][bj][m][n] = __builtin_amdgcn_mfma_f32_16x16x32_bf16(Bt[n][k], At[m][k], acc[ai][bj][m][n], 0, 0, 0); __builtin_amdgcn_s_setprio(0); } while (0)
#define PG8_WAIT_V(n) asm volatile("s_waitcnt vmcnt(" #n ")" ::: "memory")
#define PG8_WAIT_L(n) asm volatile("s_waitcnt lgkmcnt(" #n ")" ::: "memory")
#define PG8_BAR __builtin_amdgcn_s_barrier()
#define PG8_SCHED __builtin_amdgcn_sched_barrier(0)
    Unit cur, nxt; int ui = 0;
    if (!S.next(0, cur)) return;
    f32x4 acc[2][2][4][2];
#pragma unroll
    for (int a = 0; a < 2; ++a)
#pragma unroll
        for (int b = 0; b < 2; ++b)
#pragma unroll
            for (int m = 0; m < 4; ++m)
#pragma unroll
                for (int n = 0; n < 2; ++n) acc[a][b][m][n] = (f32x4){0.f, 0.f, 0.f, 0.f};
    bf16x8 At[4][2], B0[2][2], B1[2][2];
    const char* cA = (const char*)g.A + (size_t)cur.pm * tstep; const char* cB = (const char*)g.Bt + (size_t)cur.pn * tstep;
    S.a_ready(cur);
    if constexpr (SP2) {
        PG8_STAGE(PG8_SB(0, 0), cB, voffB); PG8_STAGE(PG8_SB(0, 1), cB + hstep, voffB); PG8_STAGE(PG8_SA(0, 0), cA, voffA); PG8_STAGE(PG8_SA(0, 1), cA + hstep, voffA);
        if (wr == 1) PG8_BAR;
        PG8_WAIT_V(2); PG8_BAR;
        PG8_STAGE(PG8_SB(1, 0), cB + kstep, voffB); PG8_STAGE(PG8_SA(1, 0), cA + kstep, voffA); PG8_STAGE(PG8_SB(1, 1), cB + hstep + kstep, voffB);
        PG8_WAIT_V(6); PG8_BAR;
    } else {
        PG8_STAGE(PG8_SB(0, 0), cB, voffB); PG8_STAGE(PG8_SA(0, 0), cA, voffA); PG8_STAGE(PG8_SB(0, 1), cB + hstep, voffB); PG8_STAGE(PG8_SA(0, 1), cA + hstep, voffA);
        if (wr == 1) PG8_BAR;
        PG8_WAIT_V(4); PG8_BAR;
        PG8_STAGE(PG8_SB(1, 0), cB + kstep, voffB); PG8_STAGE(PG8_SA(1, 0), cA + kstep, voffA); PG8_STAGE(PG8_SB(1, 1), cB + hstep + kstep, voffB);
        PG8_WAIT_V(6); PG8_BAR;
    }
    for (;;) {
        const bool has_next = S.next(ui + 1, nxt);
        const char* nA = has_next ? (const char*)g.A + (size_t)nxt.pm * tstep : cA; const char* nB = has_next ? (const char*)g.Bt + (size_t)nxt.pn * tstep : cB;
        for (int t = 0; t < nt; t += 2) {
            if constexpr (Epi::HOOK) { if (E.hook_at(t)) E.hook(acc, cur, t, wr, wc, fr, fq); }
            const bool last = (t == nt - 2);
            const char* a1 = cA + (size_t)(t + 1) * kstep;
            const char* a2 = last ? nA : cA + (size_t)(t + 2) * kstep; const char* b2 = last ? nB : cB + (size_t)(t + 2) * kstep;
            const char* a3 = a2 + kstep; const char* b3 = b2 + kstep;
            if (last && has_next) S.a_ready(nxt);
            if constexpr (SP2) {
            PG8_LDB(B0, 0, 0); PG8_LDB(B1, 0, 1); PG8_SCHED; PG8_LDA(At, 0, 0); PG8_STAGE(PG8_SA(1, 1), a1 + hstep, voffA);
            PG8_WAIT_V(8); PG8_WAIT_L(0); PG8_BAR; PG8_MMA(0, 0, At, B0); PG8_MMA(0, 1, At, B1); PG8_BAR; PG8_SCHED;
            PG8_LDA(At, 0, 1); PG8_STAGE(PG8_SB(0, 0), b2, voffB); PG8_STAGE(PG8_SB(0, 1), b2 + hstep, voffB); PG8_STAGE(PG8_SA(0, 0), a2, voffA);
            PG8_WAIT_V(8); PG8_WAIT_L(0); PG8_BAR; PG8_MMA(1, 0, At, B0); PG8_MMA(1, 1, At, B1); PG8_BAR; PG8_SCHED;
            PG8_LDB(B0, 1, 0); PG8_LDB(B1, 1, 1); PG8_SCHED; PG8_LDA(At, 1, 0); PG8_STAGE(PG8_SA(0, 1), a2 + hstep, voffA);
            PG8_WAIT_V(8); PG8_WAIT_L(0); PG8_BAR; PG8_MMA(0, 0, At, B0); PG8_MMA(0, 1, At, B1); PG8_BAR; PG8_SCHED;
            PG8_LDA(At, 1, 1); PG8_STAGE(PG8_SB(1, 0), b3, voffB); PG8_STAGE(PG8_SB(1, 1), b3 + hstep, voffB); PG8_STAGE(PG8_SA(1, 0), a3, voffA);
            PG8_WAIT_V(8); PG8_WAIT_L(0); PG8_BAR; PG8_MMA(1, 0, At, B0); PG8_MMA(1, 1, At, B1); PG8_BAR; PG8_SCHED;
            } else {
            PG8_LDB(B0, 0, 0); PG8_SCHED; PG8_LDA(At, 0, 0); PG8_STAGE(PG8_SA(1, 1), a1 + hstep, voffA);
            PG8_WAIT_L(8); PG8_BAR; PG8_WAIT_L(0); PG8_MMA(0, 0, At, B0); PG8_BAR; PG8_SCHED;
            PG8_LDB(B1, 0, 1); PG8_STAGE(PG8_SB(0, 0), b2, voffB);
            PG8_BAR; PG8_WAIT_L(0); PG8_MMA(0, 1, At, B1); PG8_BAR;
            PG8_LDA(At, 0, 1); PG8_STAGE(PG8_SA(0, 0), a2, voffA);
            PG8_BAR; PG8_WAIT_L(0); PG8_MMA(1, 0, At, B0); PG8_BAR; PG8_SCHED;
            PG8_STAGE(PG8_SB(0, 1), b2 + hstep, voffB);
            PG8_WAIT_V(6); PG8_BAR; PG8_MMA(1, 1, At, B1); PG8_BAR;
            PG8_LDB(B0, 1, 0); PG8_SCHED; PG8_LDA(At, 1, 0); PG8_STAGE(PG8_SA(0, 1), a2 + hstep, voffA);
            PG8_WAIT_L(8); PG8_BAR; PG8_WAIT_L(0); PG8_MMA(0, 0, At, B0); PG8_BAR; PG8_SCHED;
            PG8_LDB(B1, 1, 1); PG8_STAGE(PG8_SB(1, 0), b3, voffB);
            PG8_BAR; PG8_WAIT_L(0); PG8_MMA(0, 1, At, B1); PG8_BAR;
            PG8_LDA(At, 1, 1); PG8_STAGE(PG8_SA(1, 0), a3, voffA);
            PG8_BAR; PG8_WAIT_L(0); PG8_MMA(1, 0, At, B0); PG8_BAR; PG8_SCHED;
            PG8_STAGE(PG8_SB(1, 1), b3 + hstep, voffB);
            PG8_WAIT_V(6); PG8_BAR; PG8_MMA(1, 1, At, B1); PG8_BAR;
            }
        }
        if constexpr (ALIGN_EPI) { if (wr == 0) PG8_BAR; }
        if constexpr (!Epi::AFTER_DRAIN) { E(acc, cur, wr, wc, fr, fq); S.done(cur); }
        if (!has_next) break;
#pragma unroll
        for (int a = 0; a < 2; ++a)
#pragma unroll
            for (int b = 0; b < 2; ++b)
#pragma unroll
                for (int m = 0; m < 4; ++m)
#pragma unroll
                    for (int n = 0; n < 2; ++n) acc[a][b][m][n] = (f32x4){0.f, 0.f, 0.f, 0.f};
        cur = nxt; cA = nA; cB = nB; ++ui;
        if constexpr (ALIGN_EPI) { if (wr == 1) PG8_BAR; }
    }
    PG8_WAIT_V(0);
    if constexpr (!ALIGN_EPI) { if (wr == 0) PG8_BAR; }
    PG8_BAR;
    if constexpr (Epi::AFTER_DRAIN) { E.fused(acc, cur, wr, wc, fr, fq, lds, wid, lane); S.done(cur); }
#undef PG8_SA
#undef PG8_SB
#undef PG8_STAGE
#undef PG8_LDA
#undef PG8_LDB
#undef PG8_MMA
#undef PG8_WAIT_V
#undef PG8_WAIT_L
#undef PG8_BAR
#undef PG8_SCHED
}
}

constexpr int NWAVES = 8, NTHREADS = 512;
constexpr int BATCH = 2, SEQ = 8192, DM = 1024, DEPTH = 4, CTXL = 256;
constexpr int ML = BATCH * SEQ;
constexpr int MC = BATCH * CTXL;
constexpr int MT = ML + MC;
constexpr int HD = 64, NH = 8, NKV = 2;
constexpr int QW = 512, KVW = 128;
constexpr int HYW = 256, FNW = 256;
constexpr int Q_END = 512, K_END = 640, V_END = 768, HY_END = 1536, FN_END = 1792, INW = 4864;
constexpr int DFF = 2816, NEXP = 8;
constexpr int FH = 64, FEMB = 33;
constexpr float EPS = 1e-6f;

constexpr size_t MiB = 1u << 20;
constexpr size_t WS_CTL = 0, CTL_ZERO_BYTES = 64 * 1024, CTL_BYTES = 4 * MiB;
constexpr size_t WS_WIN = 4 * MiB;
constexpr size_t WS_WPA = WS_WIN + 38 * MiB;
constexpr size_t WS_WPH = WS_WPA + 4 * MiB;
constexpr size_t WS_WPF = WS_WPH + 2 * MiB;
constexpr size_t WS_WO = WS_WPF + 2 * MiB;
constexpr size_t WS_FGU = WS_WO + 8 * MiB;
constexpr size_t WS_FD = WS_FGU + 22 * MiB;
constexpr size_t WS_MGU = WS_FD + 11 * MiB;
constexpr size_t WS_MD = WS_MGU + 176 * MiB;
constexpr size_t WS_XC = WS_MD + 88 * MiB;
constexpr size_t WS_H = WS_XC + 2 * MiB;
constexpr size_t WS_COMB = WS_H + 33 * MiB;
constexpr size_t WS_HF = WS_COMB + 1 * MiB;
constexpr size_t WS_HFC = WS_HF + 32 * MiB;
constexpr size_t WS_S = WS_HFC + 1 * MiB;
constexpr size_t WS_PR = WS_S;
constexpr size_t WS_QK = WS_PR + 157 * MiB;
constexpr size_t WS_ATT = WS_QK + 21 * MiB;
constexpr size_t WS_HYO = WS_ATT + 17 * MiB;
constexpr size_t WS_FNO = WS_HYO + 9 * MiB;
constexpr size_t WS_AM = WS_ATT;
constexpr size_t WS_MACC = WS_FNO + 9 * MiB;
constexpr size_t WS_M = WS_MACC + 66 * MiB;
constexpr size_t WS_END = WS_M + 33 * MiB;
constexpr size_t WS_KS = WS_MACC;
constexpr size_t WS_ZS = WS_MACC + 64 * MiB;
constexpr size_t WS_HYT = WS_MACC + 80 * MiB;
constexpr size_t WS_FNT = WS_MACC + 89 * MiB;
static_assert(WS_FNT + 9 * MiB <= WS_MACC + 99 * MiB, "mix scratch inside MACC + M");
constexpr size_t WS_CTMP = WS_M;
constexpr size_t WS_UT = WS_END;
constexpr size_t WS_VT = WS_UT + 33 * MiB;
constexpr size_t WS_KT = WS_VT + 5 * MiB;
constexpr size_t WS_XS = WS_KT + 5 * MiB;
constexpr size_t WS_END2 = WS_XS + 33 * MiB;
constexpr int NKB = MT / 32;
constexpr size_t WS_HID = WS_S;
constexpr int MOE_MAXP = 140;
constexpr size_t WS_XG = WS_S;
constexpr size_t WS_HIDG = WS_S + 70 * MiB;
constexpr size_t WS_Y = WS_S + 263 * MiB;
static_assert((size_t)MOE_MAXP * 256 * 2816 * 2 <= 193 * MiB && WS_Y + 70 * MiB <= WS_S + 350 * MiB, "moe scratch");
static_assert((size_t)MT * INW * 2 <= 157 * MiB && (size_t)MT * DFF * 2 <= 157 * MiB, "scratch sizes");
#define EPI_WS_PR WS_PR
#define EPI_WS_UT WS_UT
#define EPI_WS_VT WS_VT
#define EPI_WS_KT WS_KT
#define EPI_WS_QK WS_QK
#define EPI_WS_QKG (WS_CTL + (size_t)CW_QKG * 4)
constexpr int CW_BAR = 4096;
constexpr int CW_QKG = 12288;
constexpr int CW_CNT = 8192;
constexpr int CW_MOD = 262144;
static_assert((CW_MOD + 4 * 3 * 6144) * 4 <= (int)CTL_BYTES && (CW_CNT + 4 * 64) * 4 <= (int)CTL_ZERO_BYTES && (CW_BAR + 3456) * 4 <= (int)CTL_ZERO_BYTES, "ctl");

constexpr int LDS_BYTES = 147456;
constexpr int MISC_OFF = LDS_BYTES - 256;
constexpr int LDS_TAB = 131072;

#define LAS __attribute__((address_space(3)))
typedef unsigned short bf16;
typedef unsigned v4u __attribute__((ext_vector_type(4)));
typedef unsigned v2u __attribute__((ext_vector_type(2)));
typedef float f32x4 __attribute__((ext_vector_type(4)));
typedef float f32x2 __attribute__((ext_vector_type(2)));
#define LDS_WAIT() asm volatile("s_waitcnt lgkmcnt(0)" ::: "memory")
__device__ __forceinline__ unsigned f2bf(float f) { unsigned u = __builtin_bit_cast(unsigned, f); return (u + 0x7fffu + ((u >> 16) & 1u)) >> 16; }
__device__ __forceinline__ unsigned pk2(float lo, float hi) { return f2bf(lo) | (f2bf(hi) << 16); }
__device__ __forceinline__ float bf2f(unsigned short h) { return __builtin_bit_cast(float, (unsigned)h << 16); }
__device__ __forceinline__ float bflo(unsigned w) { return __builtin_bit_cast(float, w << 16); }
__device__ __forceinline__ float bfhi(unsigned w) { return __builtin_bit_cast(float, w & 0xffff0000u); }
__device__ __forceinline__ float shx(float v, int lane, int o) { return __builtin_bit_cast(float, __builtin_amdgcn_ds_bpermute((lane ^ o) << 2, __builtin_bit_cast(int, v))); }
__device__ __forceinline__ float wave_sum(float v, int lane) {
#pragma unroll
    for (int o = 1; o < 64; o <<= 1) v += shx(v, lane, o);
    return v;
}
__device__ __forceinline__ float wave_max(float v, int lane) {
#pragma unroll
    for (int o = 1; o < 64; o <<= 1) v = fmaxf(v, shx(v, lane, o));
    return v;
}
__device__ __forceinline__ float sin_rev(float r) { return __builtin_amdgcn_sinf(__builtin_amdgcn_fractf(r)); }
__device__ __forceinline__ float cos_rev(float r) { return __builtin_amdgcn_cosf(__builtin_amdgcn_fractf(r)); }
__device__ __forceinline__ float sigmoidf_(float x) { return __builtin_amdgcn_rcpf(1.0f + __expf(-x)); }
constexpr float INV_2PI = 0.15915494309189535f;

#define XB_TMO      128
#define XB_XCNT(j)  (256  + 64 * (j))
#define XB_XSUB(j)  (1280 + 64 * (j))
#define XB_XGEN(j)  (2304 + 64 * (j))
#define XB_TOP      3328
#define XB_TOPGEN   3392
#define XCD_BAR_WORDS 3456
#define XB_SPIN_CAP (1u << 18)

__device__ __forceinline__ unsigned xb_ld(unsigned* p)              { return __hip_atomic_load(p, __ATOMIC_RELAXED, __HIP_MEMORY_SCOPE_AGENT); }
__device__ __forceinline__ unsigned xb_add(unsigned* p, unsigned v) { return __hip_atomic_fetch_add(p, v, __ATOMIC_RELAXED, __HIP_MEMORY_SCOPE_AGENT); }
__device__ __forceinline__ unsigned xb_xcc_id() { return (unsigned)__builtin_amdgcn_s_getreg((3 << 11) | 20) & 0xFu; }
#define XB_SPIN(cond, bar) do { unsigned _sp = 0; while (cond) { __builtin_amdgcn_s_sleep(1); \
    if ((++_sp & 255u) == 0u) { if (xb_ld(&(bar)[XB_TMO])) break; if (_sp > XB_SPIN_CAP) { atomicAdd(&(bar)[XB_TMO], 1u); break; } } } } while (0)

struct XcdBarrier {
    unsigned* bar; unsigned x;
    volatile LAS unsigned* st;
};

__device__ __forceinline__ XcdBarrier xcd_barrier_post(unsigned* bar, volatile LAS unsigned* st) {
    XcdBarrier b; b.bar = bar; b.x = xb_xcc_id(); b.st = st;
    if (threadIdx.x == 0) (void)xb_add(&bar[XB_XCNT(b.x)], 1u);
    return b;
}
__device__ __forceinline__ void xcd_barrier_complete(unsigned* bar, unsigned x, unsigned& nloc, unsigned& nx) {
    const unsigned G = gridDim.x * gridDim.y * gridDim.z;
    unsigned sum, cnt, mine, sp = 0u;
    for (;;) {
        sum = 0u; cnt = 0u; mine = 0u;
#pragma unroll
        for (unsigned j = 0; j < 16; ++j) { const unsigned c = xb_ld(&bar[XB_XCNT(j)]); sum += c; cnt += (c > 0u) ? 1u : 0u; mine = (j == x) ? c : mine; }
        if (sum == G) break;
        __builtin_amdgcn_s_sleep(1);
        if ((++sp & 255u) == 0u) { if (xb_ld(&bar[XB_TMO])) break; if (sp > XB_SPIN_CAP) { atomicAdd(&bar[XB_TMO], 1u); break; } }
    }
    nloc = mine > 0u ? mine : 1u; nx = cnt > 0u ? cnt : 1u;
}

__device__ __attribute__((noinline)) void xcd_barrier_impl(unsigned* b_bar, unsigned b_x, volatile LAS unsigned* b_st) {
    XcdBarrier b; b.bar = b_bar; b.x = b_x; b.st = b_st;
    asm volatile("s_waitcnt vmcnt(0)" ::: "memory");
    __syncthreads();
    if (threadIdx.x == 0) {
        unsigned* bar = b.bar;
        __builtin_amdgcn_s_waitcnt(0);
        unsigned nloc = b.st[0], nx = b.st[1];
        if (nloc == 0u) { xcd_barrier_complete(bar, b.x, nloc, nx); b.st[0] = nloc; b.st[1] = nx; }
        const unsigned old = xb_add(&bar[XB_XSUB(b.x)], 1u);
        const unsigned gen = old / nloc;
        if (old + 1u == (gen + 1u) * nloc) {
            __builtin_amdgcn_fence(__ATOMIC_RELEASE, "agent");
            asm volatile("s_waitcnt vmcnt(0)" ::: "memory");
            const unsigned og = xb_add(&bar[XB_TOP], 1u);
            const unsigned tg = og / nx;
            if (og + 1u == (tg + 1u) * nx) xb_add(&bar[XB_TOPGEN], 1u);
            else XB_SPIN(xb_ld(&bar[XB_TOPGEN]) == tg, bar);
            __builtin_amdgcn_fence(__ATOMIC_ACQUIRE, "agent");
            xb_add(&bar[XB_XGEN(b.x)], 1u);
            asm volatile("s_waitcnt vmcnt(0)" ::: "memory");
        } else {
            XB_SPIN(xb_ld(&bar[XB_XGEN(b.x)]) == gen, bar);
            __builtin_amdgcn_fence(__ATOMIC_ACQUIRE, "agent");
            asm volatile("s_waitcnt vmcnt(0)" ::: "memory");
        }
    }
    __syncthreads();
}

struct Args { const float* in[34]; unsigned char* ws; int ph_lo, ph_hi; };
struct Frame {
    LAS unsigned char* lds;
    unsigned* ctl;
    unsigned char* ws;
    int tid, lane, wave, G, bid;
    const struct Args* a; int z;
    unsigned long long pr_acc, pr_t0;
};
__device__ __forceinline__ const float* inp(const Frame& F, int i) { return F.a->in[i + F.z]; }
__device__ __forceinline__ float* outp(const Frame& F) { return (float*)F.a->in[33 + F.z]; }
__device__ __forceinline__ unsigned char* wsp(const Frame& F) { return F.a->ws + F.z; }
enum { I_X = 0, I_C, I_CTX, I_CCTX, I_WADA, I_BADA, I_N1G, I_N2G, I_WIN, I_QG, I_KG, I_SINK, I_HCW, I_HCB, I_FW1, I_FB1, I_FF1, I_FW2, I_FB2, I_FF2, I_FW3, I_HBIAS,
       I_WPA, I_WPH, I_WPF, I_WOUT, I_FG, I_FU, I_FDN, I_ROUTER, I_MG, I_MU, I_MDN };

namespace pg8 {
struct EpiStore {
    static constexpr bool PERM = true, AFTER_DRAIN = false, HOOK = false;
    bf16_t* O; int ldc; int ntn;
    __device__ __forceinline__ void operator()(const f32x4 (&acc)[2][2][4][2], const Unit& u, int wr, int wc, int fr, int fq) const {
        const int row0 = u.pm * BM + wr * 64 + fr, col0 = (u.pn % ntn) * BM + wc * 32 + 8 * fq;
#pragma unroll
        for (int ai = 0; ai < 2; ++ai)
#pragma unroll
            for (int m = 0; m < 4; ++m) { bf16_t* rowp = O + (size_t)(row0 + ai * HALF + m * 16) * ldc + col0;
#pragma unroll
                for (int bj = 0; bj < 2; ++bj) { const f32x4 v0 = acc[ai][bj][m][0], v1 = acc[ai][bj][m][1];
                    u32x4 w; w.x = cvt_pk_bf16(v0[0], v0[1]); w.y = cvt_pk_bf16(v0[2], v0[3]); w.z = cvt_pk_bf16(v1[0], v1[1]); w.w = cvt_pk_bf16(v1[2], v1[3]);
                    *(u32x4*)(rowp + bj * HALF) = w; } }
    }
};
struct EpiIn {
    static constexpr bool PERM = true, AFTER_DRAIN = false, HOOK = false;
    unsigned char* ws; int l;
    __device__ __forceinline__ void operator()(const f32x4 (&acc)[2][2][4][2], const Unit& u, int wr, int wc, int fr_, int fq_) const {
        int fr = fr_, fq = fq_; asm volatile("" : "+v"(fr), "+v"(fq));
        constexpr int ldc = 4864, mt = 16896;
        bf16_t* const O = (bf16_t*)(ws + EPI_WS_PR); bf16_t* const UT = (bf16_t*)(ws + EPI_WS_UT); bf16_t* const VT = (bf16_t*)(ws + EPI_WS_VT); bf16_t* const KT = (bf16_t*)(ws + EPI_WS_KT); bf16_t* const QK = (bf16_t*)(ws + EPI_WS_QK);
        const float* const qg = (const float*)(ws + EPI_WS_QKG) + l * 128; const float* const kg = qg + 64;
        const int row0 = u.pm * BM + wr * 64 + fr, col0 = u.pn * BM + wc * 32 + 8 * fq;
        if (u.pn < 2 || (u.pn == 2 && wc < 2)) {
            const bool isk = (u.pn == 2); const float* gain = isk ? kg : qg; const int lane = fr + 16 * fq; const bool rope = u.pm < 64;
            f32x4 gn[2][2]; float invf[4];
#pragma unroll
            for (int bj = 0; bj < 2; ++bj)
#pragma unroll
                for (int n = 0; n < 2; ++n) gn[bj][n] = *(const f32x4*)(gain + 32 * bj + 16 * n + 4 * fq);
#pragma unroll
            for (int e = 0; e < 4; ++e) invf[e] = exp2f(-(float)(4 * fq + e) * (13.287712379549449f / 16.0f)) * 0.15915494309189535f;
            const float osc = isk ? 1.0f : 0.18033688011112042f;
#pragma unroll
            for (int ai = 0; ai < 2; ++ai)
#pragma unroll
                for (int m = 0; m < 4; ++m) { const int row = row0 + ai * HALF + m * 16;
                    float ss = 0.f;
#pragma unroll
                    for (int bj = 0; bj < 2; ++bj)
#pragma unroll
                        for (int n = 0; n < 2; ++n) { const f32x4 v = acc[ai][bj][m][n]; ss += (v[0] * v[0] + v[1] * v[1]) + (v[2] * v[2] + v[3] * v[3]); }
                    { const unsigned sb = __builtin_bit_cast(unsigned, ss); auto r16 = __builtin_amdgcn_permlane16_swap(sb, sb, false, false);
                      ss = __builtin_bit_cast(float, (unsigned)r16[0]) + __builtin_bit_cast(float, (unsigned)r16[1]);
                      const unsigned sc = __builtin_bit_cast(unsigned, ss); auto r32 = __builtin_amdgcn_permlane32_swap(sc, sc, false, false);
                      ss = __builtin_bit_cast(float, (unsigned)r32[0]) + __builtin_bit_cast(float, (unsigned)r32[1]); }
                    const float rstd = 1.0f / sqrtf(ss * (1.0f / 64.0f) + 1e-6f) * osc;
                    const int t = row & 8191;
#pragma unroll
                    for (int bj = 0; bj < 2; ++bj) { const float pos = (float)(bj == 0 ? (t >> 6) : (t & 63));
                        f32x4 o1, o2;
#pragma unroll
                        for (int e = 0; e < 4; ++e) { float cs = 1.f, sn = 0.f;
                            if (rope) { const float rev = __builtin_amdgcn_fractf(pos * invf[e]); cs = __builtin_amdgcn_cosf(rev); sn = __builtin_amdgcn_sinf(rev); }
                            const float y1 = acc[ai][bj][m][0][e] * rstd * gn[bj][0][e], y2 = acc[ai][bj][m][1][e] * rstd * gn[bj][1][e];
                            o1[e] = y1 * cs - y2 * sn; o2[e] = y1 * sn + y2 * cs; }
                        typedef unsigned u32x2v __attribute__((ext_vector_type(2)));
                        u32x2v w1, w2; w1.x = cvt_pk_bf16(o1[0], o1[1]); w1.y = cvt_pk_bf16(o1[2], o1[3]); w2.x = cvt_pk_bf16(o2[0], o2[1]); w2.y = cvt_pk_bf16(o2[2], o2[3]);
                        if (!isk) { bf16_t* qp = QK + (size_t)row * 640 + (4 * u.pn + wc) * 64 + 32 * bj + 4 * fq; *(u32x2v*)qp = w1; *(u32x2v*)(qp + 16) = w2; }
                        else { bf16_t* kp = KT + (unsigned)(((wc * (mt >> 5) + (row >> 5)) * 4 + 2 * bj) * 512 + (fq >> 1) * 256 + (row & 31) * 8 + 4 * (fq & 1)); *(u32x2v*)kp = w1; *(u32x2v*)(kp + 512) = w2; }
                    }
                    asm volatile("" ::: "memory"); __builtin_amdgcn_sched_barrier(0); }
        } else if (u.pn == 2) {
            bf16_t* vb = VT + (unsigned)(((fr >> 2) & 1) * 256 + ((fr >> 3) & 1) * 4 + (fr & 3) + (u.pm * 8 + wr * 2) * 2048 + (wc - 2) * (mt >> 5) * 2048 + fq * 64);
#pragma unroll
            for (int ai = 0; ai < 2; ++ai)
#pragma unroll
                for (int bj = 0; bj < 2; ++bj)
#pragma unroll
                    for (int m = 0; m < 4; ++m)
#pragma unroll
                        for (int n = 0; n < 2; ++n)
#pragma unroll
                            for (int e = 0; e < 4; ++e) vb[bj * 1024 + ai * 4 * 2048 + (m >> 1) * 2048 + (m & 1) * 512 + (4 * n + e) * 8] = (bf16_t)(cvt_pk_bf16(acc[ai][bj][m][n][e], 0.f) & 0xffffu);
        } else if (u.pn < 7) {
#pragma unroll
            for (int ai = 0; ai < 2; ++ai)
#pragma unroll
                for (int bj = 0; bj < 2; ++bj)
#pragma unroll
                    for (int n = 0; n < 2; ++n)
#pragma unroll
                        for (int e = 0; e < 4; ++e) { bf16_t* cp = UT + (unsigned)((col0 - 768 + bj * HALF + n * 4 + e) * mt + row0 + ai * HALF);
#pragma unroll
                            for (int m = 0; m < 4; ++m) cp[m * 16] = (bf16_t)(cvt_pk_bf16(acc[ai][bj][m][n][e], 0.f) & 0xffffu); }
        } else {
#pragma unroll
            for (int ai = 0; ai < 2; ++ai)
#pragma unroll
                for (int m = 0; m < 4; ++m) { unsigned char* rowp = (unsigned char*)O + (unsigned)(row0 + ai * HALF + m * 16) * 3072u + (unsigned)(col0 - 1792);
#pragma unroll
                    for (int bj = 0; bj < 2; ++bj) { f32x4 v0 = acc[ai][bj][m][0], v1 = acc[ai][bj][m][1];
#pragma unroll
                        for (int e = 0; e < 4; ++e) { v0[e] = fmaxf(__builtin_floorf(255.0f * __builtin_amdgcn_rcpf(1.0f + __expf(-v0[e])) + 0.5f), 1.0f); v1[e] = fmaxf(__builtin_floorf(255.0f * __builtin_amdgcn_rcpf(1.0f + __expf(-v1[e])) + 0.5f), 1.0f); }
                        typedef unsigned u32x2v __attribute__((ext_vector_type(2))); u32x2v w; w.x = 0u; w.y = 0u;
                        w.x = __builtin_amdgcn_cvt_pk_u8_f32(v0[0], 0, w.x); w.x = __builtin_amdgcn_cvt_pk_u8_f32(v0[1], 1, w.x); w.x = __builtin_amdgcn_cvt_pk_u8_f32(v0[2], 2, w.x); w.x = __builtin_amdgcn_cvt_pk_u8_f32(v0[3], 3, w.x);
                        w.y = __builtin_amdgcn_cvt_pk_u8_f32(v1[0], 0, w.y); w.y = __builtin_amdgcn_cvt_pk_u8_f32(v1[1], 1, w.y); w.y = __builtin_amdgcn_cvt_pk_u8_f32(v1[2], 2, w.y); w.y = __builtin_amdgcn_cvt_pk_u8_f32(v1[3], 3, w.y);
                        *(u32x2v*)(rowp + bj * HALF) = w; } }
        }
    }
};
struct EpiSwiglu {
    static constexpr bool PERM = true, AFTER_DRAIN = false, HOOK = false;
    bf16_t* O; int ldc; int ntn;
    __device__ __forceinline__ void operator()(const f32x4 (&acc)[2][2][4][2], const Unit& u, int wr, int wc, int fr, int fq) const {
        const int row0 = u.pm * BM + wr * 64 + fr, col0 = (u.pn % ntn) * HALF + wc * 32 + 8 * fq;
#pragma unroll
        for (int ai = 0; ai < 2; ++ai)
#pragma unroll
            for (int m = 0; m < 4; ++m) { bf16_t* rowp = O + (size_t)(row0 + ai * HALF + m * 16) * ldc + col0;
                float h[8];
#pragma unroll
                for (int n = 0; n < 2; ++n)
#pragma unroll
                    for (int e = 0; e < 4; ++e) { const float g = acc[ai][0][m][n][e], uu = acc[ai][1][m][n][e]; h[n * 4 + e] = g * __builtin_amdgcn_rcpf(1.0f + __expf(-g)) * uu; }
                u32x4 w; w.x = cvt_pk_bf16(h[0], h[1]); w.y = cvt_pk_bf16(h[2], h[3]); w.z = cvt_pk_bf16(h[4], h[5]); w.w = cvt_pk_bf16(h[6], h[7]);
                *(u32x4*)rowp = w; }
    }
};
struct EpiMerge {
    static constexpr bool PERM = true, AFTER_DRAIN = false, HOOK = true;
    const unsigned char* G8  ; bf16_t* Mo;
    __device__ __forceinline__ bool hook_at(int t) const { return t == 8 || t == 12; }
    __device__ __forceinline__ static void ld8(const unsigned char* p, float (&g)[8]) { typedef unsigned u32x2v __attribute__((ext_vector_type(2))); const u32x2v w = *(const u32x2v*)p;
        g[0] = (float)(w.x & 0xffu); g[1] = (float)((w.x >> 8) & 0xffu); g[2] = (float)((w.x >> 16) & 0xffu); g[3] = (float)(w.x >> 24);
        g[4] = (float)(w.y & 0xffu); g[5] = (float)((w.y >> 8) & 0xffu); g[6] = (float)((w.y >> 16) & 0xffu); g[7] = (float)(w.y >> 24); }
    __device__ __forceinline__ void hook(f32x4 (&acc)[2][2][4][2], const Unit& u, int t, int wr, int wc, int fr, int fq) const {
        const int col0 = u.pn * BM + wc * 32 + 8 * fq; const int ga = t == 8 ? 0 : 1;
#pragma unroll
        for (int ai = 0; ai < 2; ++ai)
#pragma unroll
            for (int m = 0; m < 4; ++m) { const int r = u.pm * BM + ai * HALF + wr * 64 + m * 16 + fr; const unsigned char* gp = G8 + (unsigned)r * 3072u + (unsigned)(ga * 1024 + col0);
#pragma unroll
                for (int bj = 0; bj < 2; ++bj) { float sa[8], sb[8]; ld8(gp + bj * HALF, sa); ld8(gp + 1024 + bj * HALF, sb);
#pragma unroll
                    for (int e = 0; e < 4; ++e) { acc[ai][bj][m][0][e] *= sa[e] * __builtin_amdgcn_rcpf(sb[e]); acc[ai][bj][m][1][e] *= sa[4 + e] * __builtin_amdgcn_rcpf(sb[4 + e]); } } }
    }
    __device__ __forceinline__ void operator()(const f32x4 (&acc)[2][2][4][2], const Unit& u, int wr, int wc, int fr, int fq) const {
        const int col0 = u.pn * BM + wc * 32 + 8 * fq;
#pragma unroll
        for (int ai = 0; ai < 2; ++ai)
#pragma unroll
            for (int m = 0; m < 4; ++m) { const int r = u.pm * BM + ai * HALF + wr * 64 + m * 16 + fr; const unsigned char* gp = G8 + (unsigned)r * 3072u + (unsigned)(2048 + col0);
#pragma unroll
                for (int bj = 0; bj < 2; ++bj) { float s2[8]; ld8(gp + bj * HALF, s2); const f32x4 v0 = acc[ai][bj][m][0] * (1.0f / 255.0f), v1 = acc[ai][bj][m][1] * (1.0f / 255.0f);
                    u32x4 w; w.x = cvt_pk_bf16(v0[0] * s2[0], v0[1] * s2[1]); w.y = cvt_pk_bf16(v0[2] * s2[2], v0[3] * s2[3]); w.z = cvt_pk_bf16(v1[0] * s2[4], v1[1] * s2[5]); w.w = cvt_pk_bf16(v1[2] * s2[6], v1[3] * s2[7]);
                    *(u32x4*)(Mo + (size_t)r * 1024 + col0 + bj * HALF) = w; } }
    }
};
struct EpiResid {
    static constexpr bool PERM = false, AFTER_DRAIN = false, HOOK = false;
    bf16_t* xs  ; const float* gate  ;
    __device__ __forceinline__ void operator()(const f32x4 (&acc)[2][2][4][2], const Unit& u, int wr, int wc, int fr, int fq) const {
        const int col0 = u.pn * BM + wc * 32 + 4 * fq;
        const int cond = u.pm >> 5;
        const float* gp = gate + cond * 6144;
        f32x4 gv[2][2];
#pragma unroll
        for (int bj = 0; bj < 2; ++bj)
#pragma unroll
            for (int n = 0; n < 2; ++n) gv[bj][n] = *(const f32x4*)(gp + col0 + bj * HALF + n * 16);
        typedef unsigned u32x2v __attribute__((ext_vector_type(2)));
#pragma unroll
        for (int ai = 0; ai < 2; ++ai)
#pragma unroll
            for (int m = 0; m < 4; ++m) { const int r = u.pm * BM + ai * HALF + wr * 64 + m * 16 + fr;
#pragma unroll
                for (int bj = 0; bj < 2; ++bj)
#pragma unroll
                    for (int n = 0; n < 2; ++n) { const unsigned off = (unsigned)r * 1024u + (unsigned)(col0 + bj * HALF + n * 16);
                        const u32x2v xw = *(const u32x2v*)(xs + off);
                        f32x4 xv; xv[0] = __builtin_bit_cast(float, xw.x << 16); xv[1] = __builtin_bit_cast(float, xw.x & 0xffff0000u); xv[2] = __builtin_bit_cast(float, xw.y << 16); xv[3] = __builtin_bit_cast(float, xw.y & 0xffff0000u);
                        const f32x4 y = xv + gv[bj][n] * acc[ai][bj][m][n];
                        u32x2v o; o.x = cvt_pk_bf16(y[0], y[1]); o.y = cvt_pk_bf16(y[2], y[3]);
                        *(u32x2v*)(xs + off) = o; } }
    }
};
struct MoeOrder {
    int ntn, G, c; const PG8_LAS int* poff;
    __device__ __forceinline__ bool next(int i, Unit& u) const {
        const int L = i * G + c; const int np = __builtin_amdgcn_readfirstlane(poff[8]);
        if (L >= np * ntn) return false;
        const int p = L / ntn, t = L - p * ntn; int e = 0;
#pragma unroll
        for (int k = 1; k < 8; ++k) e += (p >= __builtin_amdgcn_readfirstlane(poff[k])) ? 1 : 0;
        u.pm = p; u.pn = e * ntn + t; return true;
    }
    __device__ __forceinline__ void a_ready(const Unit&) const {}
    __device__ __forceinline__ void done(const Unit&) const {}
};
}

struct TrDesc { const float* W; bf16* WT; int K, N, map, ldk, koff, item; bool skip; };
__device__ __forceinline__ void tr_load(const TrDesc& d, float (&tv)[32], int lane) {
    if (d.skip) return;
    const int nblk = d.N / 32, kb = d.item / nblk, nb = d.item % nblk, k0 = 64 * kb, n0 = 32 * nb;
#pragma unroll
    for (int i = 0; i < 32; ++i) tv[i] = d.W[(size_t)(k0 + 2 * i + (lane >> 5)) * d.N + n0 + (lane & 31)];
}
__device__ __forceinline__ void tr_finish(const TrDesc& d, const float (&tv)[32], LAS float* scr, int lane) {
    if (d.skip) return;
    const int nblk = d.N / 32, kb = d.item / nblk, nb = d.item % nblk, k0 = 64 * kb, n0 = 32 * nb;
#pragma unroll
    for (int i = 0; i < 32; ++i) scr[(2 * i + (lane >> 5)) * 33 + (lane & 31)] = tv[i];
    LDS_WAIT(); asm volatile("" ::: "memory");
    const int c = lane & 7;
#pragma unroll
    for (int j = 0; j < 4; ++j) { const int n = (lane >> 3) + 8 * j; const LAS float* s = scr + (8 * c) * 33 + n;
        v4u o; o.x = pk2(s[0 * 33], s[1 * 33]); o.y = pk2(s[2 * 33], s[3 * 33]); o.z = pk2(s[4 * 33], s[5 * 33]); o.w = pk2(s[6 * 33], s[7 * 33]);
        const int nn = n0 + n; int drow;
        if (d.map == 0) drow = nn;
        else if (d.map == 3) {
            if (nn < 640) { const int head = nn >> 6, dd = nn & 63, a = dd >> 5, hf = (dd >> 4) & 1, f = dd & 15; const int tile = head < 8 ? (head >> 2) : 2, wcc = head < 8 ? (head & 3) : (head - 8);
                drow = tile * 256 + 128 * a + 32 * wcc + 8 * (f >> 2) + 4 * hf + (f & 3); }
            else if (nn < 768) { const int vh = (nn - 640) >> 6, dd = nn & 63; drow = 512 + 128 * (dd >> 5) + 32 * (2 + vh) + (dd & 31); }
            else drow = nn; }
        else drow = (nn >> 7) * 256 + (nn & 127) + (d.map == 2 ? 128 : 0);
        *(v4u*)(d.WT + (size_t)drow * d.ldk + d.koff + k0 + 8 * c) = o; }
    LDS_WAIT(); asm volatile("" ::: "memory");
}
#define TR_GROUP(SRC, DST, CNT, KK, NN, MAP, DSTRIDE, LDK, KOFF) if (!found) { constexpr int per = ((KK) / 64) * ((NN) / 32); constexpr int tot = (CNT) * per; \
    if (r < tot) { const int mi = r / per; d.W = (SRC) + (size_t)mi * (KK) * (NN); d.WT = (DST) + (size_t)mi * (DSTRIDE); d.K = (KK); d.N = (NN); d.map = (MAP); d.ldk = (LDK); d.koff = (KOFF); d.item = r % per; found = true; } else r -= tot; }
__device__ __forceinline__ TrDesc tr_decode(Frame& F, int it) {
    TrDesc d; d.W = nullptr; d.WT = nullptr; d.K = 64; d.N = 32; d.map = 0; d.ldk = 64; d.koff = 0; d.item = 0; d.skip = false;
    int r = it; bool found = false;
    TR_GROUP(inp(F, I_WIN), ((bf16*)(wsp(F) + WS_WIN)), 4, 1024, 4864, 3, (size_t)4864 * 1024, 1024, 0)
    if (found && d.N == 4864) { const int nb = d.item % 152; d.skip = (nb >= 48 && nb < 56); }
    TR_GROUP(inp(F, I_WPA), ((bf16*)(wsp(F) + WS_WPA)), 4, 512, 1024, 0, (size_t)1024 * 1024, 1024, 0)
    TR_GROUP(inp(F, I_WPH), ((bf16*)(wsp(F) + WS_WPA)), 4, 256, 1024, 0, (size_t)1024 * 1024, 1024, 512)
    TR_GROUP(inp(F, I_WPF), ((bf16*)(wsp(F) + WS_WPA)), 4, 256, 1024, 0, (size_t)1024 * 1024, 1024, 768)
    TR_GROUP(inp(F, I_WOUT), ((bf16*)(wsp(F) + WS_WO)), 4, 1024, 1024, 0, (size_t)1024 * 1024, 1024, 0)
    TR_GROUP(inp(F, I_FG), ((bf16*)(wsp(F) + WS_FGU)), 2, 1024, 2816, 1, (size_t)5632 * 1024, 1024, 0)
    TR_GROUP(inp(F, I_FU), ((bf16*)(wsp(F) + WS_FGU)), 2, 1024, 2816, 2, (size_t)5632 * 1024, 1024, 0)
    TR_GROUP(inp(F, I_FDN), ((bf16*)(wsp(F) + WS_FD)), 2, 2816, 1024, 0, (size_t)1024 * 2816, 2816, 0)
    TR_GROUP(inp(F, I_MG), ((bf16*)(wsp(F) + WS_MGU)), 16, 1024, 2816, 1, (size_t)5632 * 1024, 1024, 0)
    TR_GROUP(inp(F, I_MU), ((bf16*)(wsp(F) + WS_MGU)), 16, 1024, 2816, 2, (size_t)5632 * 1024, 1024, 0)
    TR_GROUP(inp(F, I_MDN), ((bf16*)(wsp(F) + WS_MD)), 16, 2816, 1024, 0, (size_t)1024 * 2816, 2816, 0)
    return d;
}

__device__ __forceinline__ void phase_prologue(Frame& F) {
    constexpr int TOT_ITEMS = 4 * (16 * 152 + 8 * 32 + 4 * 32 + 4 * 32 + 16 * 32) + 2 * (16 * 88 * 2 + 44 * 32) + 16 * (16 * 88 * 2 + 44 * 32);
    constexpr int PER_BLOCK = (TOT_ITEMS + 255) / 256;
    LAS float* scr = (LAS float*)(F.lds + F.wave * 8448);
    LAS float* tl = (LAS float*)(F.lds + 8 * 8448);
    LAS float* sl = (LAS float*)(F.lds + 8 * 8448 + 17152);
    LAS int* ctr = (LAS int*)(F.lds + 8 * 8448 + 17152 + 12288);
    for (int i = F.tid; i < 3072; i += NTHREADS) { const float cv = i < 2048 ? inp(F, I_C)[i] : inp(F, I_CCTX)[i - 2048]; sl[i] = cv * sigmoidf_(cv); }
    if (F.tid == 0) ctr[0] = 0;
    if (F.bid == 0) { for (int i = F.tid; i < 512; i += NTHREADS) { const int ll = i >> 7, j = i & 127; ((float*)(wsp(F) + WS_CTL) + CW_QKG)[i] = j < 64 ? inp(F, I_QG)[ll * 64 + j] : inp(F, I_KG)[ll * 64 + j - 64]; } }
    __syncthreads();
    if (F.wave >= 6) {
        for (int it = (F.wave - 6) * F.G + F.bid; it < 4 * 96; it += 2 * F.G) {
            const int l = it / 96, cb = it % 96;
            const float* W = inp(F, I_WADA) + (size_t)l * 1024 * 6144 + cb * 64 + F.lane;
            float a0 = 0.f, a1 = 0.f, a2 = 0.f;
#pragma unroll 16
            for (int k = 0; k < 1024; ++k) { const float w = W[(size_t)k * 6144]; a0 += w * sl[k]; a1 += w * sl[1024 + k]; a2 += w * sl[2048 + k]; }
            const float bb = inp(F, I_BADA)[l * 6144 + cb * 64 + F.lane];
            float* mo = ((float*)(wsp(F) + WS_CTL) + CW_MOD) + (size_t)l * 3 * 6144 + cb * 64 + F.lane;
            mo[0] = a0 + bb; mo[6144] = a1 + bb; mo[2 * 6144] = a2 + bb;
        }
    } else if (F.wave == 5) {
        LAS float* ctab = tl + 64 * 65; LAS float* stab = ctab + 64;
        ctab[F.lane] = cos_rev((float)F.lane * (1.0f / 64.0f)); stab[F.lane] = sin_rev((float)F.lane * (1.0f / 64.0f));
        for (int it = F.bid; it < 4 * 16 * 4; it += F.G) {
            const int l = it >> 6, kb = (it >> 2) & 15, g = it & 3;
            const float* W = inp(F, I_WIN) + (size_t)l * 1024 * 4864 + (size_t)(kb * 64) * 4864 + 1536 + g * 64;
#pragma unroll 8
            for (int kk = 0; kk < 64; ++kk) tl[kk * 65 + F.lane] = W[(size_t)kk * 4864 + F.lane];
            LDS_WAIT(); asm volatile("" ::: "memory");
            bf16* dst = ((bf16*)(wsp(F) + WS_WIN)) + (size_t)l * 4864 * 1024 + (size_t)(1536 + g * 64) * 1024 + kb * 64 + F.lane;
            for (int j = 0; j < 64; ++j) {
                const int mm = j <= 32 ? j : j - 32; float a = 0.f;
                if (j <= 32) { for (int c = 0; c < 64; ++c) a += tl[F.lane * 65 + c] * ctab[(mm * c) & 63]; }
                else { for (int c = 0; c < 64; ++c) a += tl[F.lane * 65 + c] * stab[(mm * c) & 63]; }
                dst[(size_t)j * 1024] = (bf16)f2bf(a);
            }
            LDS_WAIT(); asm volatile("" ::: "memory");
        }
    }
    {
        const int ib = F.bid * PER_BLOCK, ie = (ib + PER_BLOCK) < TOT_ITEMS ? (ib + PER_BLOCK) : TOT_ITEMS;
        int it = ib + __builtin_amdgcn_readfirstlane(F.lane == 0 ? atomicAdd((int*)ctr, 1) : 0);
        if (it < ie) {
            TrDesc cur = tr_decode(F, it); float tv[32], tn[32];
            tr_load(cur, tv, F.lane);
            for (;;) {
                const int itn = ib + __builtin_amdgcn_readfirstlane(F.lane == 0 ? atomicAdd((int*)ctr, 1) : 0);
                TrDesc nxt = cur; const bool more = itn < ie;
                if (more) { nxt = tr_decode(F, itn); tr_load(nxt, tn, F.lane); }
                tr_finish(cur, tv, scr, F.lane);
                if (!more) break;
                cur = nxt;
#pragma unroll
                for (int i = 0; i < 32; ++i) tv[i] = tn[i];
            }
        }
    }
}

__device__ __forceinline__ void moe_offsets(Frame& F, int l, LAS int* poff) {
    if (F.tid == 0) { const unsigned* cnt = (const unsigned*)(wsp(F) + WS_CTL) + CW_CNT + l * 64; int o = 0;
        for (int e = 0; e < 8; ++e) { poff[e] = o; o += (int)((__hip_atomic_load(cnt + e, __ATOMIC_RELAXED, __HIP_MEMORY_SCOPE_AGENT) + 255u) >> 8); } poff[8] = o; }
    __syncthreads();
}
template <bool XB> struct NormRaw { typedef f32x4 T; };
template <> struct NormRaw<true> { typedef v2u T; };
__device__ __forceinline__ f32x4 norm_cvt(const f32x4 a) { return a; }
__device__ __forceinline__ f32x4 norm_cvt(const v2u a) { f32x4 r; r[0] = bflo(a.x); r[1] = bfhi(a.x); r[2] = bflo(a.y); r[3] = bfhi(a.y); return r; }
template <bool ROUTER, bool COMBINE, bool NORM, bool XB = true>
__device__ __forceinline__ void phase_norm(Frame& F, int l, const float* xlat, const float* xctx, const float* g, int moff, const float* wr, int nrows, int skipb = 0) {
    const int gw = (F.bid - skipb) * NWAVES + F.wave + (F.bid < skipb ? (1 << 28) : 0), NGW = (F.G - skipb) * NWAVES;
    const float* mod = ((float*)(wsp(F) + WS_CTL) + CW_MOD) + (size_t)l * 3 * 6144 + moff;
    LAS int* lcnt = (LAS int*)(F.lds + LDS_TAB);
    LAS float* wrl = (LAS float*)F.lds;
    unsigned* info_all = (unsigned*)(wsp(F) + WS_COMB);
    if (ROUTER) { if (F.tid < 16) lcnt[F.tid] = 0;
        for (int i = F.tid; i < 2048; i += NTHREADS) { const int c = i >> 1, hf = i & 1; *(LAS f32x4*)(wrl + 4 * (hf * 1024 + (((c >> 8) * 4 + (c & 3)) * 64 + ((c >> 2) & 63)))) = *(const f32x4*)(wr + 4 * i); }
        __syncthreads(); }
    f32x4 gg[4], s1[4], s0[4]; int cur_cond = -1;
    if (NORM) {
#pragma unroll
        for (int j = 0; j < 4; ++j) gg[j] = *(const f32x4*)(g + 256 * j + 4 * F.lane);
    }
    typedef typename NormRaw<XB>::T RawT;
    bf16* const XS = (bf16*)(wsp(F) + WS_XS);
    f32x4 v[4]; RawT vn[4], vn2[4];
#define NORM_LOADROW(DST, rr_) { if (XB) { const bf16* xr = XS + (size_t)(rr_) * 1024; _Pragma("unroll") for (int j = 0; j < 4; ++j) DST[j] = *(const RawT*)(xr + 256 * j + 4 * F.lane); } \
        else { const float* xr = (rr_) >= ML ? xctx + (size_t)((rr_) - ML) * 1024 : xlat + (size_t)(rr_) * 1024; _Pragma("unroll") for (int j = 0; j < 4; ++j) DST[j] = *(const RawT*)(xr + 256 * j + 4 * F.lane); } }
    if (gw < nrows) NORM_LOADROW(vn, gw)
    if (gw + NGW < nrows) NORM_LOADROW(vn2, gw + NGW)
    for (int r = gw; r < nrows; r += NGW) {
        const bool isctx = r >= ML; const int cond = isctx ? 2 : (r >> 13);
#pragma unroll
        for (int j = 0; j < 4; ++j) { v[j] = norm_cvt(vn[j]); vn[j] = vn2[j]; }
        { const int rn = r + 2 * NGW; if (rn < nrows) NORM_LOADROW(vn2, rn) }
        if (!XB) {
#pragma unroll
            for (int j = 0; j < 4; ++j) { v2u o; o.x = pk2(v[j][0], v[j][1]); o.y = pk2(v[j][2], v[j][3]); *(v2u*)(XS + (size_t)r * 1024 + 256 * j + 4 * F.lane) = o; }
        }
        float s = 0.f;
        if (COMBINE) {
            const unsigned* info = info_all + (size_t)r * 8;
            const float w0 = __builtin_bit_cast(float, info[2]), w1 = __builtin_bit_cast(float, info[3]);
            const bf16* y0 = ((const bf16*)(wsp(F) + WS_Y)) + (size_t)info[6] * 1024; const bf16* y1 = ((const bf16*)(wsp(F) + WS_Y)) + (size_t)info[7] * 1024;
            const float* gt = ((float*)(wsp(F) + WS_CTL) + CW_MOD) + (size_t)(l - (NORM ? 1 : 0)) * 3 * 6144 + 5120 + cond * 6144;
#pragma unroll
            for (int j = 0; j < 4; ++j) { const int c = 256 * j + 4 * F.lane;
                const v2u a = *(const v2u*)(y0 + c), b = *(const v2u*)(y1 + c); const f32x4 gtv = *(const f32x4*)(gt + c);
                v[j][0] += gtv[0] * (w0 * bflo(a.x) + w1 * bflo(b.x)); v[j][1] += gtv[1] * (w0 * bfhi(a.x) + w1 * bfhi(b.x));
                v[j][2] += gtv[2] * (w0 * bflo(a.y) + w1 * bflo(b.y)); v[j][3] += gtv[3] * (w0 * bfhi(a.y) + w1 * bfhi(b.y));
                if (NORM) { v2u o; o.x = pk2(v[j][0], v[j][1]); o.y = pk2(v[j][2], v[j][3]); *(v2u*)(XS + (size_t)r * 1024 + c) = o; }
                else *(f32x4*)(outp(F) + (size_t)r * 1024 + c) = v[j]; }
        }
        if (!NORM) continue;
        if (cond != cur_cond) { cur_cond = cond; const float* sh = mod + cond * 6144; const float* sc = sh + 1024;
#pragma unroll
            for (int j = 0; j < 4; ++j) { s1[j] = *(const f32x4*)(sc + 256 * j + 4 * F.lane); s0[j] = *(const f32x4*)(sh + 256 * j + 4 * F.lane); } }
#pragma unroll
        for (int j = 0; j < 4; ++j) s += (v[j][0] * v[j][0] + v[j][1] * v[j][1]) + (v[j][2] * v[j][2] + v[j][3] * v[j][3]);
        const float rstd = 1.0f / sqrtf(wave_sum(s, F.lane) * (1.0f / 1024.0f) + EPS);
        float lg[8];
        if (ROUTER) {
#pragma unroll
            for (int e = 0; e < 8; ++e) lg[e] = 0.f;
        }
#pragma unroll
        for (int j = 0; j < 4; ++j) { const int c = 256 * j + 4 * F.lane;
            f32x4 y;
#pragma unroll
            for (int e = 0; e < 4; ++e) y[e] = (v[j][e] * rstd * gg[j][e]) * (1.0f + s1[j][e]) + s0[j][e];
            v2u o; o.x = pk2(y[0], y[1]); o.y = pk2(y[2], y[3]);
            *(v2u*)(((bf16*)(wsp(F) + WS_H)) + (size_t)r * 1024 + c) = o;
            if (ROUTER) {
#pragma unroll
                for (int e = 0; e < 4; ++e) { const f32x4 w0 = *(LAS f32x4*)(wrl + 4 * ((j * 4 + e) * 64 + F.lane)), w1 = *(LAS f32x4*)(wrl + 4 * (1024 + (j * 4 + e) * 64 + F.lane));
                    lg[0] += y[e] * w0[0]; lg[1] += y[e] * w0[1]; lg[2] += y[e] * w0[2]; lg[3] += y[e] * w0[3];
                    lg[4] += y[e] * w1[0]; lg[5] += y[e] * w1[1]; lg[6] += y[e] * w1[2]; lg[7] += y[e] * w1[3]; }
            }
        }
        if (ROUTER) {
#pragma unroll
            for (int e = 0; e < 8; ++e) lg[e] = wave_sum(lg[e], F.lane);
            int i0 = 0; float v0 = lg[0];
#pragma unroll
            for (int e = 1; e < 8; ++e) if (lg[e] > v0) { v0 = lg[e]; i0 = e; }
            int i1 = -1; float v1 = -INFINITY;
#pragma unroll
            for (int e = 0; e < 8; ++e) if (e != i0 && lg[e] > v1) { v1 = lg[e]; i1 = e; }
            const float w0 = 1.0f / (1.0f + __expf(v1 - v0)), w1 = 1.0f - w0;
            if (F.lane == 0) { const int p0 = atomicAdd((int*)(lcnt + i0), 1), p1 = atomicAdd((int*)(lcnt + i1), 1);
                unsigned* info = info_all + (size_t)r * 8;
                info[0] = (unsigned)i0; info[1] = (unsigned)i1; info[2] = __builtin_bit_cast(unsigned, w0); info[3] = __builtin_bit_cast(unsigned, w1); info[4] = (unsigned)p0; info[5] = (unsigned)p1; }
        }
    }
    if (ROUTER) {
        asm volatile("s_waitcnt vmcnt(0) lgkmcnt(0)" ::: "memory");
        __syncthreads();
        if (F.tid < 8) { unsigned* cnt = (unsigned*)(wsp(F) + WS_CTL) + CW_CNT + l * 64; lcnt[8 + F.tid] = (int)__hip_atomic_fetch_add(cnt + F.tid, (unsigned)lcnt[F.tid], __ATOMIC_RELAXED, __HIP_MEMORY_SCOPE_AGENT); }
        __syncthreads();
        for (int r = gw; r < nrows; r += NGW) { if (F.lane < 2) { unsigned* info = info_all + (size_t)r * 8; const int e = (int)info[F.lane]; info[4 + F.lane] += (unsigned)lcnt[8 + e]; } }
    }
}

#undef NORM_LOADROW
__device__ __forceinline__ void phase_gather(Frame& F, int l) {
    LAS int* poff = (LAS int*)(F.lds + LDS_TAB + 64);
    moe_offsets(F, l, poff);
    const int gw = F.bid * NWAVES + F.wave, NGW = F.G * NWAVES;
    unsigned* info_all = (unsigned*)(wsp(F) + WS_COMB);
    for (int it = gw; it < MT * 2; it += NGW) {
        const int tok = it >> 1, k = it & 1; unsigned* info = info_all + (size_t)tok * 8;
        const int e = (int)info[k], pos = (int)info[4 + k]; const int grow = 256 * poff[e] + pos;
        if (F.lane == 0) info[6 + k] = (unsigned)grow;
        const v4u* s = (const v4u*)(((const bf16*)(wsp(F) + WS_H)) + (size_t)tok * 1024); v4u* d = (v4u*)(((bf16*)(wsp(F) + WS_XG)) + (size_t)grow * 1024);
        d[F.lane] = s[F.lane]; d[64 + F.lane] = s[64 + F.lane];
    }
}

__device__ __forceinline__ void filter_tile(Frame& F, int l, int L, int p0, float* dst  , bool stage) {
    LAS float* emb = (LAS float*)F.lds;
    LAS float* h1 = emb + 32 * 33;
    LAS float* h2 = h1 + 32 * 65;
    LAS float* w1s = h2 + 32 * 65;
    LAS float* w2s = w1s + 33 * 64;
    const float* w1 = inp(F, I_FW1) + l * 33 * 64; const float* b1 = inp(F, I_FB1) + l * 64; const float* f1 = inp(F, I_FF1) + l * 64;
    const float* w2 = inp(F, I_FW2) + l * 64 * 64; const float* b2 = inp(F, I_FB2) + l * 64; const float* f2 = inp(F, I_FF2) + l * 64;
    const float* w3 = inp(F, I_FW3) + (size_t)l * 64 * 1024;
    float awA[32], awB[32];
#define FILT_LOADW(AW, blk_) { unsigned vo_ = (unsigned)((F.lane >> 5) * 8192 + (blk_) * 32 + (F.lane & 31)); asm volatile("" : "+v"(vo_)); _Pragma("unroll") for (int s = 0; s < 32; ++s) AW[s] = (w3 + (size_t)(16 * (s >> 3) + (s & 7)) * 1024)[vo_]; }
    FILT_LOADW(awA, F.wave) __builtin_amdgcn_sched_barrier(0);
    if (stage) {
        const f32x4 sa = *(const f32x4*)(w1 + 4 * F.tid), sb = *(const f32x4*)(w2 + 4 * F.tid), sc = *(const f32x4*)(w2 + 4 * (F.tid + NTHREADS));
        f32x4 sd = sa; if (F.tid < 16) sd = *(const f32x4*)(w1 + 4 * (F.tid + NTHREADS));
        *(LAS f32x4*)(w1s + 4 * F.tid) = sa; *(LAS f32x4*)(w2s + 4 * F.tid) = sb; *(LAS f32x4*)(w2s + 4 * (F.tid + NTHREADS)) = sc;
        if (F.tid < 16) *(LAS f32x4*)(w1s + 4 * (F.tid + NTHREADS)) = sd;
    }
    for (int idx = F.tid; idx < 32 * 33; idx += NTHREADS) {
        const int pos = idx / 33, f = idx % 33, i = p0 + pos;
        float val;
        if (f == 0) val = (float)i / (float)(L - 1);
        else { const int j = (f - 1) & 15; const float fb = 1e-4f + (float)j * ((15.0f - 1e-4f) / 15.0f); const float rev = fb * (float)i / (float)L;
               val = (f <= 16) ? cos_rev(rev) : -sin_rev(rev); }
        emb[pos * 33 + f] = val;
    }
    __syncthreads();
    { const int pos = F.tid >> 4, u0 = (F.tid & 15) * 4;
      f32x4 a = *(const f32x4*)(b1 + u0);
#pragma unroll 11
      for (int f = 0; f < 33; ++f) a += emb[pos * 33 + f] * *(LAS f32x4*)(w1s + f * 64 + u0);
      const f32x4 fr = *(const f32x4*)(f1 + u0);
#pragma unroll
      for (int e = 0; e < 4; ++e) h1[pos * 65 + u0 + e] = sin_rev(fr[e] * a[e] * INV_2PI);
    }
    __syncthreads();
    { const int pos = F.tid >> 4, u0 = (F.tid & 15) * 4;
      f32x4 a = *(const f32x4*)(b2 + u0);
#pragma unroll 16
      for (int f = 0; f < 64; ++f) a += h1[pos * 65 + f] * *(LAS f32x4*)(w2s + f * 64 + u0);
      const f32x4 fr = *(const f32x4*)(f2 + u0);
#pragma unroll
      for (int e = 0; e < 4; ++e) h2[pos * 65 + u0 + e] = sin_rev(fr[e] * a[e] * INV_2PI);
    }
    __syncthreads();
    { const int r = F.lane & 31, h = F.lane >> 5;
      typedef float f32x16_t __attribute__((ext_vector_type(16))); typedef short bf16x8_t __attribute__((ext_vector_type(8)));
      const int i = p0 + r; const float t = (float)i / (float)(L - 1);
#define FILT_SPLIT(X, HI, LO) { v4u hi_, lo_; \
        _Pragma("unroll") for (int p = 0; p < 4; ++p) { const float x0 = (X)[2 * p], x1 = (X)[2 * p + 1]; const unsigned hw = pg8::cvt_pk_bf16(x0, x1); hi_[p] = hw; lo_[p] = pg8::cvt_pk_bf16(x0 - bflo(hw), x1 - bfhi(hw)); } \
        HI = __builtin_bit_cast(bf16x8_t, hi_); LO = __builtin_bit_cast(bf16x8_t, lo_); }
      bf16x8_t bh[4], bl[4];
#pragma unroll
      for (int kk = 0; kk < 4; ++kk) { float hv[8];
#pragma unroll
          for (int e = 0; e < 8; ++e) hv[e] = h2[r * 65 + 16 * kk + 8 * h + e];
          FILT_SPLIT(hv, bh[kk], bl[kk]) }
#define FILT_BLOCK(AW, blk_) { int c0 = (blk_) * 32; asm volatile("" : "+v"(c0)); f32x16_t acc;        \
        _Pragma("unroll") for (int q = 0; q < 16; ++q) acc[q] = 0.f; \
        _Pragma("unroll") for (int kk = 0; kk < 4; ++kk) { bf16x8_t ah_, al_; FILT_SPLIT((AW + 8 * kk), ah_, al_) \
            acc = __builtin_amdgcn_mfma_f32_32x32x16_bf16(al_, bh[kk], acc, 0, 0, 0); acc = __builtin_amdgcn_mfma_f32_32x32x16_bf16(ah_, bl[kk], acc, 0, 0, 0); acc = __builtin_amdgcn_mfma_f32_32x32x16_bf16(ah_, bh[kk], acc, 0, 0, 0); } \
        _Pragma("unroll") for (int q = 0; q < 16; ++q) { const int col = c0 + (q & 3) + 8 * (q >> 2) + 4 * h; const int ch = col & 255; \
            const float delta = 3.0701134573253946f + 12.280453829301578f * ((float)ch * (1.0f / 255.0f)); \
            dst[(size_t)col * L + i] = acc[q] * __expf(-t * delta); } }
#pragma unroll 1
      for (int jj = 0; jj < 2; ++jj) {
          FILT_LOADW(awB, F.wave + 8 * (2 * jj + 1)) __builtin_amdgcn_sched_barrier(0); FILT_BLOCK(awA, F.wave + 16 * jj) __builtin_amdgcn_sched_barrier(0);
          FILT_LOADW(awA, F.wave + 8 * ((2 * jj + 2) & 3)) __builtin_amdgcn_sched_barrier(0); FILT_BLOCK(awB, F.wave + 8 * (2 * jj + 1)) __builtin_amdgcn_sched_barrier(0);
      }
#undef FILT_BLOCK
#undef FILT_LOADW
#undef FILT_SPLIT
    }
    __syncthreads();
}

__device__ __forceinline__ void phase_qkprep(Frame& F, int l) {
    const int gw = F.bid * NWAVES + F.wave, NGW = F.G * NWAVES;
    const int lane = F.lane; const int a = lane >> 5, half = (lane >> 4) & 1, f = lane & 15;
    const float inv = exp2f(-(float)f * (13.287712379549449f / 16.0f)) * INV_2PI;
    const float gq = inp(F, I_QG)[l * 64 + lane], gk = inp(F, I_KG)[l * 64 + lane];
    for (int r = gw; r < MT; r += NGW) {
        const bool isctx = r >= ML; const int t = r & 8191; const int pos = a == 0 ? (t >> 6) : (t & 63);
        float cs = 1.f, sn = 0.f;
        if (!isctx) { const float rev = (float)pos * inv; cs = cos_rev(rev); sn = sin_rev(rev); }
        const bf16* pr = ((bf16*)(wsp(F) + WS_PR)) + (size_t)r * INW;
        bf16* qk = ((bf16*)(wsp(F) + WS_QK)) + (size_t)r * 640;
#pragma unroll
        for (int h = 0; h < 10; ++h) {
            const float v = bf2f(pr[h * 64 + lane]);
            const float ss = wave_sum(v * v, lane);
            const float y = v * (1.0f / sqrtf(ss * (1.0f / 64.0f) + EPS)) * (h < 8 ? gq : gk);
            const float p = shx(y, lane, 16);
            const float o = half == 0 ? y * cs - p * sn : y * cs + p * sn;
            if (h < 8) qk[h * 64 + lane] = (bf16)f2bf(o * 0.18033688011112042f);
            else ((bf16*)(wsp(F) + WS_KT))[(size_t)((((h - 8) * NKB + (r >> 5)) * 4 + (lane >> 4)) * 512 + ((lane >> 3) & 1) * 256 + (r & 31) * 8 + (lane & 7))] = (bf16)f2bf(o);
        }
    }
}

__device__ __forceinline__ float block_sum(Frame& F, float v, LAS float* red) {
    v = wave_sum(v, F.lane);
    __syncthreads();
    if (F.lane == 0) red[F.wave] = v;
    __syncthreads();
    float t = 0.f;
#pragma unroll
    for (int w = 0; w < NWAVES; ++w) t += red[w];
    return t;
}

template <int L>
__device__ __forceinline__ float hy_uc(const bf16* UT, int rowbase, int b, int t, int ch, const float* cw, const float* cb) {
    float a = cb[ch];
    const bf16* up = UT + (size_t)ch * MT + rowbase + b * L;
#pragma unroll
    for (int j = 0; j < 3; ++j) { const int tt = t + j - 1; const bool ok = tt >= 0 && tt < L; const float x = bf2f(up[ok ? tt : t]); a += ok ? x * cw[j * 768 + ch] : 0.f; }
    return a;
}

template <int L>
__device__ __forceinline__ void hyena_item_naive(Frame& F, int l, int c, int rowbase, const float* taps) {
    constexpr int NT = (L + NTHREADS - 1) / NTHREADS;
    LAS float* kt = (LAS float*)F.lds;
    LAS f32x2* z = (LAS f32x2*)(F.lds + 2 * L * 4);
    LAS float* red = (LAS float*)(F.lds + 2 * L * 4 + L * 8);
    const float* cw = inp(F, I_HCW) + l * 3 * 768; const float* cb = inp(F, I_HCB) + l * 768; const float* hb = inp(F, I_HBIAS) + l * 512;
    for (int t = F.tid; t < L; t += NTHREADS) { f32x2 v; v.x = hy_uc<L>(((bf16*)(wsp(F) + WS_UT)), rowbase, 0, t, 512 + c, cw, cb); v.y = hy_uc<L>(((bf16*)(wsp(F) + WS_UT)), rowbase, 1, t, 512 + c, cw, cb); z[t] = v; }
    for (int o = 0; o < 2; ++o) {
        const float* fwd = taps + (size_t)(o * 256 + c) * L; const float* bwd = taps + (size_t)(512 + o * 256 + c) * L;
        float part = 0.f;
        for (int d = F.tid; d < L; d += NTHREADS) { const float kf = fwd[d]; kt[L + d] = kf; part += fabsf(kf);
            if (d >= 1) { const float kb = bwd[d]; kt[L - d] = kb; part += fabsf(kb); } else kt[0] = 0.f; }
        const float tot = block_sum(F, part, red);
        const float inv = 1.0f / tot;
        __syncthreads();
        float* tmp = (float*)(wsp(F) + WS_CTMP) + (size_t)c * 2 * L;
#pragma unroll 1
        for (int t = F.tid; t < L; t += NTHREADS) {
            float a0 = 0.f, a1 = 0.f;
#pragma unroll 4
            for (int s = 0; s < L; ++s) { const f32x2 zz = z[s]; const float kv = kt[L + t - s]; a0 += kv * zz.x; a1 += kv * zz.y; }
            tmp[t] = a0; tmp[L + t] = a1;
        }
        __syncthreads();
        const float bo = hb[o * 256 + c];
#pragma unroll 1
        for (int t = F.tid; t < L; t += NTHREADS) {
            const float g0 = hy_uc<L>(((bf16*)(wsp(F) + WS_UT)), rowbase, 0, t, o * 256 + c, cw, cb), g1 = hy_uc<L>(((bf16*)(wsp(F) + WS_UT)), rowbase, 1, t, o * 256 + c, cw, cb);
            const f32x2 zo = z[t]; f32x2 zn; zn.x = g0 * (tmp[t] * inv + bo * zo.x); zn.y = g1 * (tmp[L + t] * inv + bo * zo.y); z[t] = zn;
        }
        __syncthreads();
    }
    for (int t = F.tid; t < L; t += NTHREADS) { const f32x2 v = z[t];
        ((bf16*)(wsp(F) + WS_HYT))[(size_t)c * MT + rowbase + t] = (bf16)f2bf(v.x); ((bf16*)(wsp(F) + WS_HYT))[(size_t)c * MT + rowbase + L + t] = (bf16)f2bf(v.y); }
    __syncthreads();
}

template <int L>
__device__ __forceinline__ void fnet_item_naive(Frame& F, int b, int g, int m, int rowbase) {
    LAS f32x2* AB = (LAS f32x2*)F.lds;
    LAS f32x2* tab = (LAS f32x2*)(F.lds + L * 8);
    LAS f32x2* cs64 = (LAS f32x2*)(F.lds + 2 * L * 8);
    for (int i = F.tid; i < L; i += NTHREADS) { f32x2 v; const float rev = (float)i / (float)L; v.x = cos_rev(rev); v.y = sin_rev(rev); tab[i] = v; }
    if (F.tid < 64) { f32x2 v; const float rev = (float)F.tid / 64.0f; v.x = cos_rev(rev); v.y = sin_rev(rev); cs64[F.tid] = v; }
    __syncthreads();
    for (int n = F.tid; n < L; n += NTHREADS) {
        const bf16* ut = ((const bf16*)(wsp(F) + WS_UT)) + (size_t)(768 + g * 64) * MT + rowbase + b * L + n;
        const int mm = m <= 32 ? m : 64 - m;
        f32x2 v; v.x = bf2f(ut[(size_t)mm * MT]);
        v.y = (m == 0 || m == 32) ? 0.f : (m < 32 ? bf2f(ut[(size_t)(32 + m) * MT]) : -bf2f(ut[(size_t)(32 + mm) * MT]));
        AB[n] = v;
    }
    __syncthreads();
    const float scale = 1.0f / sqrtf((float)L * 64.0f);
    for (int k = F.tid; k < L; k += NTHREADS) {
        float acc = 0.f; int idx = 0;
        for (int n = 0; n < L; ++n) { const f32x2 ab = AB[n]; const f32x2 cs = tab[idx]; acc += ab.x * cs.x - ab.y * cs.y; idx = (idx + k) & (L - 1); }
        ((bf16*)(wsp(F) + WS_FNT))[(size_t)(g * 64 + m) * MT + rowbase + b * L + k] = (bf16)f2bf(acc * scale);
    }
    __syncthreads();
}

#ifdef FFT_HOST
#define FFT_LDS
#define FFT_HD
static inline float fft_cos_rev(float r) { return (float)cos(6.283185307179586 * (double)r); }
static inline float fft_sin_rev(float r) { return (float)sin(6.283185307179586 * (double)r); }
#else
#define FFT_LDS LAS
#define FFT_HD __device__ __forceinline__
__device__ __forceinline__ float fft_cos_rev(float r) { return __builtin_amdgcn_cosf(r); }
__device__ __forceinline__ float fft_sin_rev(float r) { return __builtin_amdgcn_sinf(r); }
#endif
FFT_HD int fft_phys(int i) { return i + ((i >> 5) << 1); }
FFT_HD f32x2 fft_cmul(f32x2 a, f32x2 b) { const f32x2 ax = {a.x, a.x}, ay = {a.y, a.y}, bs = {-b.y, b.x}; return ax * b + ay * bs; }
template <int R> FFT_HD constexpr int fft_brev(int p) { int r = 0; for (int b = 1; b < R; b <<= 1) { r = (r << 1) | ((p & b) ? 1 : 0); } return r; }
template <int R, bool INV> FFT_HD void fft_regs(f32x2 (&a)[R]) {
    constexpr float C16[16] = {1.0f, 0.92387953251128674f, 0.70710678118654752f, 0.38268343236508977f, 0.0f, -0.38268343236508977f, -0.70710678118654752f, -0.92387953251128674f,
                               -1.0f, -0.92387953251128674f, -0.70710678118654752f, -0.38268343236508977f, 0.0f, 0.38268343236508977f, 0.70710678118654752f, 0.92387953251128674f};
    constexpr float S16[16] = {0.0f, 0.38268343236508977f, 0.70710678118654752f, 0.92387953251128674f, 1.0f, 0.92387953251128674f, 0.70710678118654752f, 0.38268343236508977f,
                               0.0f, -0.38268343236508977f, -0.70710678118654752f, -0.92387953251128674f, -1.0f, -0.92387953251128674f, -0.70710678118654752f, -0.38268343236508977f};
#pragma unroll
    for (int s = R / 2; s >= 1; s >>= 1) {
#pragma unroll
        for (int i = 0; i < R; ++i) {
            if ((i & s) == 0) {
                const int k = i & (s - 1);
                const f32x2 u = a[i], v = a[i + s];
                a[i] = u + v;
                const f32x2 d = u - v;
                if (k == 0) a[i + s] = d;
                else if (2 * k == s) { f32x2 t; if (INV) { t.x = -d.y; t.y = d.x; } else { t.x = d.y; t.y = -d.x; } a[i + s] = t; }
                else { const int idx = k * (16 / (2 * s)); f32x2 w; w.x = C16[idx]; w.y = INV ? S16[idx] : -S16[idx]; a[i + s] = fft_cmul(d, w); }
            }
        }
    }
}
template <int N, int NCUR, int R, bool INV, int NT>
FFT_HD void fft_pass(FFT_LDS f32x2* buf, int tid) {
    constexpr int M = NCUR / R;
    if constexpr (M == 1) {
        constexpr int U = 4; static_assert((N / R) % (NT * U) == 0, "trip count");
#pragma unroll 1
        for (int i0 = tid; i0 < N / R; i0 += NT * U) {
            f32x2 a[U][R]; int pb[U];
#pragma unroll
            for (int u = 0; u < U; ++u) { pb[u] = fft_phys((i0 + u * NT) * R);
#pragma unroll
                for (int q = 0; q < R; ++q) a[u][q] = buf[pb[u] + q]; }
#pragma unroll
            for (int u = 0; u < U; ++u) fft_regs<R, INV>(a[u]);
#pragma unroll
            for (int u = 0; u < U; ++u)
#pragma unroll
                for (int p = 0; p < R; ++p) buf[pb[u] + p] = a[u][fft_brev<R>(p)];
        }
        return;
    }
    constexpr int U = ((N / R) % (NT * 2) == 0) ? 2 : 1;
#pragma unroll 1
    for (int i0 = tid; i0 < N / R; i0 += NT * U) {
        f32x2 a[U][R]; int pb[U]; f32x2 w1[U];
#pragma unroll
        for (int u = 0; u < U; ++u) { const int i = i0 + u * NT; const int blk = i / M, j = i - blk * M, base = blk * NCUR + j;
            pb[u] = fft_phys(base);
#pragma unroll
            for (int q = 0; q < R; ++q) a[u][q] = buf[pb[u] + q * M + 2 * ((q * M) >> 5)];
            const float rev = (float)j * (1.0f / (float)NCUR); w1[u].x = fft_cos_rev(rev); w1[u].y = INV ? fft_sin_rev(rev) : -fft_sin_rev(rev); }
#pragma unroll
        for (int u = 0; u < U; ++u) {
            f32x2 w[R]; w[1] = w1[u];
#pragma unroll
            for (int p = 2; p < R; ++p) { const int hb = (p >= 8) ? 8 : ((p >= 4) ? 4 : 2); w[p] = (p == hb) ? fft_cmul(w[hb / 2], w[hb / 2]) : fft_cmul(w[hb], w[p - hb]); }
            if (INV) {
#pragma unroll
                for (int p = 1; p < R; ++p) a[u][p] = fft_cmul(a[u][p], w[p]);
                fft_regs<R, INV>(a[u]);
            } else {
                fft_regs<R, INV>(a[u]);
#pragma unroll
                for (int p = 1; p < R; ++p) a[u][fft_brev<R>(p)] = fft_cmul(a[u][fft_brev<R>(p)], w[p]);
            }
#pragma unroll
            for (int p = 0; p < R; ++p) buf[pb[u] + p * M + 2 * ((p * M) >> 5)] = a[u][fft_brev<R>(p)];
        }
    }
}
#ifdef FFT_HOST
#define FFT_SYNC()
#else
#define FFT_SYNC() __syncthreads()
#endif

template <bool INV> __device__ __forceinline__ void fft16k(LAS f32x2* buf, int tid) {
    constexpr int N = 16384;
    if (!INV) { fft_pass<N, 16384, 16, false, NTHREADS>(buf, tid); __syncthreads(); fft_pass<N, 1024, 16, false, NTHREADS>(buf, tid); __syncthreads();
                fft_pass<N, 64, 16, false, NTHREADS>(buf, tid); __syncthreads(); fft_pass<N, 4, 4, false, NTHREADS>(buf, tid); __syncthreads(); }
    else { fft_pass<N, 4, 4, true, NTHREADS>(buf, tid); __syncthreads(); fft_pass<N, 64, 16, true, NTHREADS>(buf, tid); __syncthreads();
           fft_pass<N, 1024, 16, true, NTHREADS>(buf, tid); __syncthreads(); fft_pass<N, 16384, 16, true, NTHREADS>(buf, tid); __syncthreads(); }
}
__device__ __forceinline__ void fft8k_fwd(LAS f32x2* buf, int tid) {
    constexpr int N = 8192;
    fft_pass<N, 8192, 16, false, NTHREADS>(buf, tid); __syncthreads(); fft_pass<N, 512, 16, false, NTHREADS>(buf, tid); __syncthreads();
    fft_pass<N, 32, 16, false, NTHREADS>(buf, tid); __syncthreads(); fft_pass<N, 2, 2, false, NTHREADS>(buf, tid); __syncthreads();
}

__device__ __forceinline__ void hy_uc8(const bf16* UT, int b, int t0, int ch, const float* cw, const float* cb, float (&o)[8]) {
    const bf16* up = UT + (size_t)ch * MT + b * SEQ + t0;
    const v4u w = *(const v4u*)up;
    const bool hl = t0 > 0, hr = t0 + 8 < SEQ;
    const float hm = bf2f(up[hl ? -1 : 0]), hp = bf2f(up[hr ? 8 : 7]);
    float x[10]; x[0] = hl ? hm : 0.f; x[9] = hr ? hp : 0.f;
    x[1] = bflo(w.x); x[2] = bfhi(w.x); x[3] = bflo(w.y); x[4] = bfhi(w.y); x[5] = bflo(w.z); x[6] = bfhi(w.z); x[7] = bflo(w.w); x[8] = bfhi(w.w);
    const float w0 = cw[ch], w1 = cw[768 + ch], w2 = cw[1536 + ch], bias = cb[ch];
#pragma unroll
    for (int e = 0; e < 8; ++e) o[e] = ((bias + x[e] * w0) + x[e + 1] * w1) + x[e + 2] * w2;
}
__device__ __forceinline__ void hyena_item_fft(Frame& F, int l, int c) {
    constexpr int L = SEQ, N = 2 * SEQ;
    LAS f32x2* buf = (LAS f32x2*)F.lds;
    LAS float* red = (LAS float*)(F.lds + 139264);
    const bf16* UT = (const bf16*)(wsp(F) + WS_UT);
    const float* cw = inp(F, I_HCW) + l * 3 * 768; const float* cb = inp(F, I_HCB) + l * 768; const float* hb = inp(F, I_HBIAS) + l * 512;
    f32x2* kspec = (f32x2*)(wsp(F) + WS_KS) + (size_t)F.bid * 2 * N;
    const float* HFp = (const float*)(wsp(F) + WS_HF);
    {
        const float* f0 = HFp + (size_t)c * L; const float* b0 = HFp + (size_t)(512 + c) * L; const float* f1 = HFp + (size_t)(256 + c) * L; const float* b1 = HFp + (size_t)(768 + c) * L;
        float p0 = 0.f, p1 = 0.f;
#pragma unroll
        for (int k = 0; k < 4; ++k) { const int i0 = 4 * (F.tid + NTHREADS * k);
            const f32x4 a = *(const f32x4*)(f0 + i0), b = *(const f32x4*)(f1 + i0), cbk = *(const f32x4*)(b0 + i0), d = *(const f32x4*)(b1 + i0);
            LAS f32x4* bp = (LAS f32x4*)(buf + fft_phys(i0));
            f32x4 w; w[0] = a[0]; w[1] = b[0]; w[2] = a[1]; w[3] = b[1]; bp[0] = w; w[0] = a[2]; w[1] = b[2]; w[2] = a[3]; w[3] = b[3]; bp[1] = w;
#pragma unroll
            for (int e = 0; e < 4; ++e) { p0 += fabsf(a[e]); p1 += fabsf(b[e]); }
            if (i0 > 0) { p0 += fabsf(cbk[0]); p1 += fabsf(d[0]); f32x2 v; v.x = cbk[0]; v.y = d[0]; buf[fft_phys(N - i0)] = v; }
            else { float zf = 0.f; asm volatile("" : "+v"(zf)); f32x2 v; v.x = zf; v.y = zf; buf[fft_phys(L)] = v; }
#pragma unroll
            for (int e = 1; e < 4; ++e) { p0 += fabsf(cbk[e]); p1 += fabsf(d[e]); f32x2 v; v.x = cbk[e]; v.y = d[e]; buf[fft_phys(N - i0 - e)] = v; } }
        const float tot0 = block_sum(F, p0, red); const float tot1 = block_sum(F, p1, red);
        __syncthreads();
        fft16k<false>(buf, F.tid);
        const float s0 = 0.5f / tot0, s1 = 0.5f / tot1;
        typedef _Float16 f16x2 __attribute__((ext_vector_type(2)));
        int tp = F.tid; asm volatile("" : "+v"(tp));
#pragma unroll 2
        for (int k = 0; k < 8; ++k) { const int pos0 = 4 * (tp + NTHREADS * k);
            const LAS f32x4* ap = (const LAS f32x4*)(buf + fft_phys(pos0)); const f32x4 a01 = ap[0], a23 = ap[1];
            f32x2 o0[4], o1[4];
#pragma unroll
            for (int e = 0; e < 4; ++e) { const int pos = pos0 + e;
                const int f = (pos >> 10) + 16 * ((pos >> 6) & 15) + 256 * ((pos >> 2) & 15) + 4096 * (pos & 3), nf = (N - f) & (N - 1);
                const int pos2 = (nf & 15) * 1024 + ((nf >> 4) & 15) * 64 + ((nf >> 8) & 15) * 4 + (nf >> 12);
                f32x2 a; a.x = (e < 2 ? a01 : a23)[2 * (e & 1)]; a.y = (e < 2 ? a01 : a23)[2 * (e & 1) + 1];
                const f32x2 b = buf[fft_phys(pos2)];
                f32x2 k0, k1; k0.x = ((a.x + b.x) * s0); k0.y = ((a.y - b.y) * s0); k1.x = ((a.y + b.y) * s1); k1.y = ((b.x - a.x) * s1);
                o0[e] = k0; o1[e] = k1; }
            { f32x4 w; w[0] = o0[0].x; w[1] = o0[0].y; w[2] = o0[1].x; w[3] = o0[1].y; *(f32x4*)(kspec + pos0) = w; w[0] = o0[2].x; w[1] = o0[2].y; w[2] = o0[3].x; w[3] = o0[3].y; *(f32x4*)(kspec + pos0 + 2) = w;
              w[0] = o1[0].x; w[1] = o1[0].y; w[2] = o1[1].x; w[3] = o1[1].y; *(f32x4*)(kspec + N + pos0) = w; w[0] = o1[2].x; w[1] = o1[2].y; w[2] = o1[3].x; w[3] = o1[3].y; *(f32x4*)(kspec + N + pos0 + 2) = w; } }
        __syncthreads();
    }
    f32x2 zr[2][8];
    int tz = F.tid; asm volatile("" : "+v"(tz));
#pragma unroll
    for (int k = 0; k < 2; ++k) { const int t0 = 8 * (tz + NTHREADS * k);
        float zf = 0.f; asm volatile("" : "+v"(zf)); f32x4 zero4; zero4[0] = zf; zero4[1] = zf; zero4[2] = zf; zero4[3] = zf;
        float a0[8], a1[8]; hy_uc8(UT, 0, t0, 512 + c, cw, cb, a0); hy_uc8(UT, 1, t0, 512 + c, cw, cb, a1);
        LAS f32x4* bp = (LAS f32x4*)(buf + fft_phys(t0)); LAS f32x4* zp = (LAS f32x4*)(buf + fft_phys(L + t0));
#pragma unroll
        for (int e = 0; e < 8; ++e) { zr[k][e].x = a0[e]; zr[k][e].y = a1[e]; }
#pragma unroll
        for (int e2 = 0; e2 < 4; ++e2) { f32x4 w; w[0] = a0[2 * e2]; w[1] = a1[2 * e2]; w[2] = a0[2 * e2 + 1]; w[3] = a1[2 * e2 + 1]; bp[e2] = w; zp[e2] = zero4; } }
    __syncthreads();
#pragma unroll 1
    for (int o = 0; o < 2; ++o) {
        fft16k<false>(buf, F.tid);
        { int tm = F.tid; asm volatile("" : "+v"(tm));
          const f32x2* ks = kspec + o * N;
#pragma unroll
          for (int kh = 0; kh < 2; ++kh) {
              f32x4 kw[4][2];
#pragma unroll
              for (int k = 0; k < 4; ++k) { const f32x2* kp = ks + 4 * (tm + NTHREADS * (4 * kh + k)); kw[k][0] = *(const f32x4*)kp; kw[k][1] = *(const f32x4*)(kp + 2); }
#pragma unroll
              for (int k = 0; k < 4; ++k) { LAS f32x4* bp = (LAS f32x4*)(buf + fft_phys(4 * (tm + NTHREADS * (4 * kh + k))));
#pragma unroll
                  for (int e2 = 0; e2 < 2; ++e2) { const f32x4 z = bp[e2];
                      f32x2 za, zb, ka, kb; za.x = z[0]; za.y = z[1]; zb.x = z[2]; zb.y = z[3]; ka.x = kw[k][e2][0]; ka.y = kw[k][e2][1]; kb.x = kw[k][e2][2]; kb.y = kw[k][e2][3];
                      const f32x2 ra = fft_cmul(za, ka), rb = fft_cmul(zb, kb);
                      f32x4 w; w[0] = ra.x; w[1] = ra.y; w[2] = rb.x; w[3] = rb.y; bp[e2] = w; } } } }
        __syncthreads();
        fft16k<true>(buf, F.tid);
        const float bo = hb[o * 256 + c]; const float invn = 1.0f / (float)N;
        int tg = F.tid; asm volatile("" : "+v"(tg));
#pragma unroll
        for (int k = 0; k < 2; ++k) { const int t0 = 8 * (tg + NTHREADS * k);
            float zf = 0.f; asm volatile("" : "+v"(zf)); f32x4 zero4; zero4[0] = zf; zero4[1] = zf; zero4[2] = zf; zero4[3] = zf;
            float g0[8], g1[8]; hy_uc8(UT, 0, t0, o * 256 + c, cw, cb, g0); hy_uc8(UT, 1, t0, o * 256 + c, cw, cb, g1);
            LAS f32x4* bp = (LAS f32x4*)(buf + fft_phys(t0)); LAS f32x4* zp = (LAS f32x4*)(buf + fft_phys(L + t0));
#pragma unroll
            for (int e2 = 0; e2 < 4; ++e2) { const f32x4 cv = bp[e2];
                f32x2 za, zb; za.x = g0[2 * e2] * (cv[0] * invn + bo * zr[k][2 * e2].x); za.y = g1[2 * e2] * (cv[1] * invn + bo * zr[k][2 * e2].y);
                zb.x = g0[2 * e2 + 1] * (cv[2] * invn + bo * zr[k][2 * e2 + 1].x); zb.y = g1[2 * e2 + 1] * (cv[3] * invn + bo * zr[k][2 * e2 + 1].y);
                zr[k][2 * e2] = za; zr[k][2 * e2 + 1] = zb; }
            if (o == 0) {
#pragma unroll
                for (int e2 = 0; e2 < 4; ++e2) { f32x4 w; w[0] = zr[k][2 * e2].x; w[1] = zr[k][2 * e2].y; w[2] = zr[k][2 * e2 + 1].x; w[3] = zr[k][2 * e2 + 1].y; bp[e2] = w; zp[e2] = zero4; }
            } else {
                v4u o0, o1; o0.x = pk2(zr[k][0].x, zr[k][1].x); o0.y = pk2(zr[k][2].x, zr[k][3].x); o0.z = pk2(zr[k][4].x, zr[k][5].x); o0.w = pk2(zr[k][6].x, zr[k][7].x);
                o1.x = pk2(zr[k][0].y, zr[k][1].y); o1.y = pk2(zr[k][2].y, zr[k][3].y); o1.z = pk2(zr[k][4].y, zr[k][5].y); o1.w = pk2(zr[k][6].y, zr[k][7].y);
                bf16* hy = ((bf16*)(wsp(F) + WS_HYT)) + (size_t)c * MT + t0;
                *(v4u*)hy = o0; *(v4u*)(hy + L) = o1;
            } }
        __syncthreads();
    }
}

__device__ __forceinline__ void fnet_item_fft(Frame& F, int b, int g, int m) {
    constexpr int N = SEQ;
    LAS f32x2* buf = (LAS f32x2*)F.lds;
    LAS float* re = (LAS float*)(F.lds + 69632);
    LAS float* im = re + N;
    const bf16* ut = ((const bf16*)(wsp(F) + WS_UT)) + (size_t)(768 + g * 64) * MT + b * N;
    bf16* fnt = ((bf16*)(wsp(F) + WS_FNT)) + (size_t)(g * 64) * MT + b * N;
    const float sgn = (m == 0) ? 1.0f : -1.0f;
#pragma unroll
    for (int k = 0; k < 2; ++k) { const int n0 = 8 * (F.tid + NTHREADS * k);
        const v4u a = *(const v4u*)(ut + (size_t)m * MT + n0), bb = *(const v4u*)(ut + (size_t)(32 + m) * MT + n0);
        LAS f32x4* bp = (LAS f32x4*)(buf + fft_phys(n0));
        f32x4 w; w[0] = bflo(a.x); w[1] = sgn * bflo(bb.x); w[2] = bfhi(a.x); w[3] = sgn * bfhi(bb.x); bp[0] = w;
        w[0] = bflo(a.y); w[1] = sgn * bflo(bb.y); w[2] = bfhi(a.y); w[3] = sgn * bfhi(bb.y); bp[1] = w;
        w[0] = bflo(a.z); w[1] = sgn * bflo(bb.z); w[2] = bfhi(a.z); w[3] = sgn * bfhi(bb.z); bp[2] = w;
        w[0] = bflo(a.w); w[1] = sgn * bflo(bb.w); w[2] = bfhi(a.w); w[3] = sgn * bfhi(bb.w); bp[3] = w; }
    __syncthreads();
    fft8k_fwd(buf, F.tid);
#pragma unroll 4
    for (int pos = F.tid; pos < N; pos += NTHREADS) { const int k = (pos >> 9) + 16 * ((pos >> 5) & 15) + 256 * ((pos >> 1) & 15) + 4096 * (pos & 1);
        const f32x2 v = buf[fft_phys(pos)]; re[k] = v.x; if (m == 0) im[k] = v.y; }
    __syncthreads();
    const float scale = 1.0f / sqrtf((float)N * 64.0f);
#pragma unroll
    for (int j = 0; j < 2; ++j) { const int k0 = 8 * (F.tid + NTHREADS * j);
        float ra[8], rb[8];
        { const f32x4 x0 = *(const LAS f32x4*)(re + k0), x1 = *(const LAS f32x4*)(re + k0 + 4);
#pragma unroll
          for (int e = 0; e < 4; ++e) { ra[e] = x0[e]; ra[4 + e] = x1[e]; }
#pragma unroll
          for (int e = 0; e < 8; ++e) rb[e] = re[(N - k0 - e) & (N - 1)]; }
        if (m == 0) {
            float ia[8], ib[8];
            const f32x4 y0 = *(const LAS f32x4*)(im + k0), y1 = *(const LAS f32x4*)(im + k0 + 4);
#pragma unroll
            for (int e = 0; e < 4; ++e) { ia[e] = y0[e]; ia[4 + e] = y1[e]; }
#pragma unroll
            for (int e = 0; e < 8; ++e) ib[e] = im[(N - k0 - e) & (N - 1)];
            const float hs = 0.5f * scale;
            v4u o0, o1;
            o0.x = pk2((ra[0] + rb[0]) * hs, (ra[1] + rb[1]) * hs); o0.y = pk2((ra[2] + rb[2]) * hs, (ra[3] + rb[3]) * hs); o0.z = pk2((ra[4] + rb[4]) * hs, (ra[5] + rb[5]) * hs); o0.w = pk2((ra[6] + rb[6]) * hs, (ra[7] + rb[7]) * hs);
            o1.x = pk2((ia[0] + ib[0]) * hs, (ia[1] + ib[1]) * hs); o1.y = pk2((ia[2] + ib[2]) * hs, (ia[3] + ib[3]) * hs); o1.z = pk2((ia[4] + ib[4]) * hs, (ia[5] + ib[5]) * hs); o1.w = pk2((ia[6] + ib[6]) * hs, (ia[7] + ib[7]) * hs);
            *(v4u*)(fnt + k0) = o0; *(v4u*)(fnt + (size_t)32 * MT + k0) = o1;
        } else {
            v4u o0, o1;
            o0.x = pk2(ra[0] * scale, ra[1] * scale); o0.y = pk2(ra[2] * scale, ra[3] * scale); o0.z = pk2(ra[4] * scale, ra[5] * scale); o0.w = pk2(ra[6] * scale, ra[7] * scale);
            o1.x = pk2(rb[0] * scale, rb[1] * scale); o1.y = pk2(rb[2] * scale, rb[3] * scale); o1.z = pk2(rb[4] * scale, rb[5] * scale); o1.w = pk2(rb[6] * scale, rb[7] * scale);
            *(v4u*)(fnt + (size_t)m * MT + k0) = o0; *(v4u*)(fnt + (size_t)(64 - m) * MT + k0) = o1;
        } }
    __syncthreads();
}

typedef short bf16x8 __attribute__((ext_vector_type(8)));
typedef float f32x16 __attribute__((ext_vector_type(16)));
__device__ __forceinline__ unsigned cvtpk(float lo, float hi) { return pg8::cvt_pk_bf16(lo, hi); }
struct AttnChunk { bf16x8 k[4]; bf16x8 v[2][2]; };
__device__ __forceinline__ void attn_load_chunk(AttnChunk& C, const bf16* KT, const bf16* VT, int keyrow0, int kvh, int lane) {
    const int kb = keyrow0 >> 5;
    const bf16* kp = KT + (size_t)((kvh * NKB + kb) * 4) * 512 + lane * 8;
#pragma unroll
    for (int s = 0; s < 4; ++s) C.k[s] = *(const bf16x8*)(kp + s * 512);
    const bf16* vp = VT + (size_t)((kvh * NKB + kb) * 4) * 512 + lane * 8;
#pragma unroll
    for (int dd = 0; dd < 2; ++dd)
#pragma unroll
        for (int s = 0; s < 2; ++s) C.v[dd][s] = *(const bf16x8*)(vp + (dd * 2 + s) * 512);
}
__device__ __forceinline__ void attn_item(Frame& F, int l, int item) {
    const int lane = F.lane, r = lane & 31, h = lane >> 5;
    const bf16* QK = (const bf16*)(wsp(F) + WS_QK); const bf16* VT = (const bf16*)(wsp(F) + WS_VT); const bf16* KT = (const bf16*)(wsp(F) + WS_KT);
    int g, kvh, b, qrow0, t0; bool isctx;
    if (item < 4096) { g = item & 3; const int qblk = (item >> 2) & 255; kvh = (item >> 10) & 1; b = item >> 11; isctx = false; t0 = qblk * 32; qrow0 = b * SEQ + t0; }
    else { const int j = item - 4096; g = j & 3; const int qb = (j >> 2) & 7; kvh = (j >> 5) & 1; b = j >> 6; isctx = true; t0 = 0; qrow0 = ML + b * CTXL + qb * 32; }
    const int head = 4 * kvh + g;
    bf16x8 qf[4];
    { const bf16* qp = QK + (size_t)(qrow0 + r) * 640 + head * 64 + 8 * h;
#pragma unroll
      for (int s = 0; s < 4; ++s) qf[s] = *(const bf16x8*)(qp + 16 * s); }
    float m = inp(F, I_SINK)[l * 8 + head] * 1.4426950408889634f;
    float lsum = (h == 0) ? 1.0f : 0.0f;
    f32x16 o0, o1;
#pragma unroll
    for (int i = 0; i < 16; ++i) { o0[i] = 0.f; o1[i] = 0.f; }
    int c_lo = 0, nl = 0;
    if (!isctx) { const int qblk = t0 >> 5; c_lo = qblk < 4 ? 4 - qblk : 0; const int c_hi = (259 - qblk) < 8 ? (259 - qblk) : 8; nl = c_hi - c_lo + 1; }
    const int n = nl + 8;
    const int lrow0 = b * SEQ + t0 - 128 + 32 * c_lo, crow0 = ML + b * CTXL - 32 * nl;
#define ATT_LOAD(BUF, i_) { const int ii_ = (i_) < n ? (i_) : n - 1; attn_load_chunk(BUF, KT, VT, ii_ < nl ? lrow0 + 32 * ii_ : crow0 + 32 * ii_, kvh, lane); }
#define ATT_COMPUTE(BUF, i_) { \
        const int cc_ = (i_) < nl ? c_lo + (i_) : 100; \
        f32x16 S; \
        _Pragma("unroll") for (int i = 0; i < 16; ++i) S[i] = 0.f; \
        _Pragma("unroll") for (int s = 0; s < 4; ++s) S = __builtin_amdgcn_mfma_f32_32x32x16_bf16(BUF.k[s], qf[s], S, 0, 0, 0); \
        if (cc_ == 0 || cc_ == 8) { \
            _Pragma("unroll") for (int i = 0; i < 16; ++i) { const int kidx = (i & 3) + 8 * (i >> 2) + 4 * h; const bool ok = (cc_ == 0) ? (kidx >= r) : (kidx <= r); if (!ok) S[i] = -INFINITY; } \
        } \
        float cm = S[0]; \
        _Pragma("unroll") for (int i = 1; i < 16; ++i) cm = fmaxf(cm, S[i]); \
        cm = fmaxf(cm, shx(cm, lane, 32)); \
        const float mn = fmaxf(m, cm), alpha = __builtin_amdgcn_exp2f(m - mn); m = mn; \
        float ps = 0.f; \
        _Pragma("unroll") for (int i = 0; i < 16; ++i) { S[i] = __builtin_amdgcn_exp2f(S[i] - m); ps += S[i]; } \
        lsum = lsum * alpha + ps; \
        _Pragma("unroll") for (int i = 0; i < 16; ++i) { o0[i] *= alpha; o1[i] *= alpha; } \
        bf16x8 pf[2]; \
        _Pragma("unroll") for (int s = 0; s < 2; ++s) { v4u w; w.x = cvtpk(S[8 * s + 0], S[8 * s + 1]); w.y = cvtpk(S[8 * s + 2], S[8 * s + 3]); w.z = cvtpk(S[8 * s + 4], S[8 * s + 5]); w.w = cvtpk(S[8 * s + 6], S[8 * s + 7]); pf[s] = __builtin_bit_cast(bf16x8, w); } \
        _Pragma("unroll") for (int s = 0; s < 2; ++s) { \
            o0 = __builtin_amdgcn_mfma_f32_32x32x16_bf16(BUF.v[0][s], pf[s], o0, 0, 0, 0); \
            o1 = __builtin_amdgcn_mfma_f32_32x32x16_bf16(BUF.v[1][s], pf[s], o1, 0, 0, 0); \
        } }
    AttnChunk ca, cb2, cc3;
    ATT_LOAD(ca, 0) ATT_LOAD(cb2, 1)
    { int ci = 0;
      for (;;) {
        ATT_LOAD(cc3, ci + 2) ATT_COMPUTE(ca, ci) if (++ci >= n) break;
        ATT_LOAD(ca, ci + 2) ATT_COMPUTE(cb2, ci) if (++ci >= n) break;
        ATT_LOAD(cb2, ci + 2) ATT_COMPUTE(cc3, ci) if (++ci >= n) break;
      } }
#undef ATT_LOAD
#undef ATT_COMPUTE
    lsum += shx(lsum, lane, 32);
    const float inv = 1.0f / lsum;
    bf16* op = ((bf16*)(wsp(F) + WS_AM)) + (size_t)(qrow0 + r) * 1024 + head * 64 + 4 * h;
#pragma unroll
    for (int g4 = 0; g4 < 4; ++g4) {
        v2u w0; w0.x = cvtpk(o0[4 * g4 + 0] * inv, o0[4 * g4 + 1] * inv); w0.y = cvtpk(o0[4 * g4 + 2] * inv, o0[4 * g4 + 3] * inv); *(v2u*)(op + 8 * g4) = w0;
        v2u w1; w1.x = cvtpk(o1[4 * g4 + 0] * inv, o1[4 * g4 + 1] * inv); w1.y = cvtpk(o1[4 * g4 + 2] * inv, o1[4 * g4 + 3] * inv); *(v2u*)(op + 32 + 8 * g4) = w1;
    }
}

__device__ __forceinline__ void attn_item_naive(Frame& F, int l, int r, int kvh, LAS float* wq, LAS float* wp) {
    const int lane = F.lane;
    const bool isctx = r >= ML; const int b = isctx ? ((r - ML) >> 8) : (r >> 13); const int t = r & 8191;
    const int lo = (t - 128) < 0 ? 0 : (t - 128), hi = (t + 128) > (SEQ - 1) ? (SEQ - 1) : (t + 128);
    const int nloc = isctx ? 0 : (hi - lo + 1), nk = nloc + CTXL;
#pragma unroll
    for (int h = 0; h < 4; ++h) wq[h * 64 + lane] = bf2f(((bf16*)(wsp(F) + WS_QK))[(size_t)r * 640 + (4 * kvh + h) * 64 + lane]) * 0.125f;
    LDS_WAIT(); asm volatile("" ::: "memory");
    for (int j = lane; j < nk; j += 64) {
        const int krow = j < nloc ? (b * SEQ + lo + j) : (ML + b * CTXL + (j - nloc));
        const bf16* kp = ((bf16*)(wsp(F) + WS_QK)) + (size_t)krow * 640 + 512 + kvh * 64;
        float s0 = 0.f, s1 = 0.f, s2 = 0.f, s3 = 0.f;
#pragma unroll
        for (int d8 = 0; d8 < 8; ++d8) { const v4u kw = *(const v4u*)(kp + d8 * 8);
            float kf[8]; kf[0] = bflo(kw.x); kf[1] = bfhi(kw.x); kf[2] = bflo(kw.y); kf[3] = bfhi(kw.y); kf[4] = bflo(kw.z); kf[5] = bfhi(kw.z); kf[6] = bflo(kw.w); kf[7] = bfhi(kw.w);
#pragma unroll
            for (int e = 0; e < 8; ++e) { const int d = d8 * 8 + e; s0 += kf[e] * wq[d]; s1 += kf[e] * wq[64 + d]; s2 += kf[e] * wq[128 + d]; s3 += kf[e] * wq[192 + d]; } }
        f32x4 sv; sv[0] = s0; sv[1] = s1; sv[2] = s2; sv[3] = s3;
        *(LAS f32x4*)(wp + j * 4) = sv;
    }
    LDS_WAIT(); asm volatile("" ::: "memory");
    f32x4 mx = {-INFINITY, -INFINITY, -INFINITY, -INFINITY};
    for (int j = lane; j < nk; j += 64) { const f32x4 sv = *(LAS f32x4*)(wp + j * 4);
#pragma unroll
        for (int h = 0; h < 4; ++h) mx[h] = fmaxf(mx[h], sv[h]); }
    f32x4 sink, den;
#pragma unroll
    for (int h = 0; h < 4; ++h) { sink[h] = inp(F, I_SINK)[l * 8 + 4 * kvh + h]; mx[h] = fmaxf(wave_max(mx[h], lane), sink[h]); den[h] = 0.f; }
    for (int j = lane; j < nk; j += 64) { f32x4 sv = *(LAS f32x4*)(wp + j * 4);
#pragma unroll
        for (int h = 0; h < 4; ++h) { sv[h] = __expf(sv[h] - mx[h]); den[h] += sv[h]; }
        *(LAS f32x4*)(wp + j * 4) = sv; }
#pragma unroll
    for (int h = 0; h < 4; ++h) den[h] = wave_sum(den[h], lane) + __expf(sink[h] - mx[h]);
    LDS_WAIT(); asm volatile("" ::: "memory");
    f32x4 o = {0.f, 0.f, 0.f, 0.f};
    for (int j = 0; j < nk; ++j) {
        const int krow = j < nloc ? (b * SEQ + lo + j) : (ML + b * CTXL + (j - nloc));
        const float v = bf2f(((bf16*)(wsp(F) + WS_PR))[(size_t)krow * INW + K_END + kvh * 64 + lane]);
        const f32x4 p = *(LAS f32x4*)(wp + j * 4);
        o += p * v;
    }
#pragma unroll
    for (int h = 0; h < 4; ++h) ((bf16*)(wsp(F) + WS_ATT))[(size_t)r * 512 + (4 * kvh + h) * 64 + lane] = (bf16)f2bf(o[h] / den[h]);
    LDS_WAIT(); asm volatile("" ::: "memory");
}


__device__ __forceinline__ void hyena_ctx_wave(Frame& F, int l, int c, LAS float* kt  , LAS f32x2* z  ) {
    constexpr int L = CTXL; const int lane = F.lane;
    const bf16* UT = (const bf16*)(wsp(F) + WS_UT); const float* HFC = (const float*)(wsp(F) + WS_HFC);
    const float* cw = inp(F, I_HCW) + l * 3 * 768; const float* cb = inp(F, I_HCB) + l * 768; const float* hb = inp(F, I_HBIAS) + l * 512;
#pragma unroll
    for (int j = 0; j < 4; ++j) { const int t = lane + 64 * j; f32x2 v; v.x = hy_uc<L>(UT, ML, 0, t, 512 + c, cw, cb); v.y = hy_uc<L>(UT, ML, 1, t, 512 + c, cw, cb); z[t] = v; }
    for (int o = 0; o < 2; ++o) {
        const float* fwd = HFC + (size_t)(o * 256 + c) * L; const float* bwd = HFC + (size_t)(512 + o * 256 + c) * L;
        float part = 0.f;
#pragma unroll
        for (int j = 0; j < 4; ++j) { const int d = lane + 64 * j; const float kf = fwd[d]; kt[L + d] = kf; part += fabsf(kf);
            if (d >= 1) { const float kb = bwd[d]; kt[L - d] = kb; part += fabsf(kb); } else kt[0] = 0.f; }
        const float inv = 1.0f / wave_sum(part, lane);
        LDS_WAIT(); asm volatile("" ::: "memory");
        float r0[4] = {0.f, 0.f, 0.f, 0.f}, r1[4] = {0.f, 0.f, 0.f, 0.f};
#pragma unroll 4
        for (int s = 0; s < L; ++s) { const f32x2 zz = z[s];
#pragma unroll
            for (int j = 0; j < 4; ++j) { const float kv = kt[L + lane + 64 * j - s]; r0[j] += kv * zz.x; r1[j] += kv * zz.y; } }
        LDS_WAIT(); asm volatile("" ::: "memory");
        const float bo = hb[o * 256 + c];
#pragma unroll
        for (int j = 0; j < 4; ++j) { const int t = lane + 64 * j;
            const float g0 = hy_uc<L>(UT, ML, 0, t, o * 256 + c, cw, cb), g1 = hy_uc<L>(UT, ML, 1, t, o * 256 + c, cw, cb);
            const f32x2 zo = z[t]; f32x2 zn; zn.x = g0 * (r0[j] * inv + bo * zo.x); zn.y = g1 * (r1[j] * inv + bo * zo.y); z[t] = zn; }
        LDS_WAIT(); asm volatile("" ::: "memory");
    }
    bf16* hyt = ((bf16*)(wsp(F) + WS_HYT)) + (size_t)c * MT + ML;
#pragma unroll
    for (int j = 0; j < 4; ++j) { const int t = lane + 64 * j; const f32x2 v = z[t]; hyt[t] = (bf16)f2bf(v.x); hyt[L + t] = (bf16)f2bf(v.y); }
    LDS_WAIT(); asm volatile("" ::: "memory");
}
__device__ __forceinline__ void fnet_ctx_wave(Frame& F, int b, int g, int m, LAS f32x2* AB  , LAS f32x2* tab  ) {
    constexpr int L = CTXL; const int lane = F.lane;
    const bf16* ut = ((const bf16*)(wsp(F) + WS_UT)) + (size_t)(768 + g * 64) * MT + ML + b * L;
    const int mm = m <= 32 ? m : 64 - m;
#pragma unroll
    for (int j = 0; j < 4; ++j) { const int n = lane + 64 * j; f32x2 t; const float rev = (float)n * (1.0f / (float)L); t.x = cos_rev(rev); t.y = sin_rev(rev); tab[n] = t;
        f32x2 v; v.x = bf2f(ut[(size_t)mm * MT + n]);
        v.y = (m == 0 || m == 32) ? 0.f : (m < 32 ? bf2f(ut[(size_t)(32 + m) * MT + n]) : -bf2f(ut[(size_t)(32 + mm) * MT + n]));
        AB[n] = v; }
    LDS_WAIT(); asm volatile("" ::: "memory");
    const float scale = 1.0f / sqrtf((float)L * 64.0f);
    bf16* fnt = ((bf16*)(wsp(F) + WS_FNT)) + (size_t)(g * 64 + m) * MT + ML + b * L;
    { float acc[4] = {0.f, 0.f, 0.f, 0.f}; int idx[4] = {0, 0, 0, 0};
#pragma unroll 4
      for (int n = 0; n < L; ++n) { const f32x2 ab = AB[n];
#pragma unroll
          for (int j = 0; j < 4; ++j) { const f32x2 cs = tab[idx[j]]; acc[j] += ab.x * cs.x - ab.y * cs.y; idx[j] = (idx[j] + lane + 64 * j) & (L - 1); } }
#pragma unroll
      for (int j = 0; j < 4; ++j) fnt[lane + 64 * j] = (bf16)f2bf(acc[j] * scale); }
    LDS_WAIT(); asm volatile("" ::: "memory");
}

__device__ __forceinline__ void phase_trans(Frame& F) {
    LAS unsigned* tl = (LAS unsigned*)(F.lds + F.wave * 16640);
    const int gw = F.bid * NWAVES + F.wave, NGW = F.G * NWAVES, lane = F.lane;
    const int seg = lane & 7, q = lane >> 3;
    for (int it = gw; it < 2 * 264 * 4; it += NGW) {
        const int which = it / (264 * 4), rem = it % (264 * 4), rt = rem >> 2, ct = rem & 3;
        const bf16* src = (which == 0 ? ((const bf16*)(wsp(F) + WS_HYT)) : ((const bf16*)(wsp(F) + WS_FNT))) + (size_t)(ct * 64) * MT + rt * 64 + 8 * seg;
        bf16* dst = ((bf16*)(wsp(F) + WS_AM)) + (which == 0 ? 512 : 768) + (size_t)(rt * 64) * 1024 + ct * 64 + 8 * seg;
        v4u a[4], b[4];
#pragma unroll
        for (int j = 0; j < 4; ++j) { const bf16* p = src + (size_t)(2 * (8 * j + q)) * MT; a[j] = *(const v4u*)p; b[j] = *(const v4u*)(p + MT); }
#pragma unroll
        for (int j = 0; j < 4; ++j) { LAS unsigned* tp = tl + (8 * seg) * 33 + 8 * j + q;
            tp[0 * 33] = (a[j].x & 0xffffu) | (b[j].x << 16); tp[1 * 33] = (a[j].x >> 16) | (b[j].x & 0xffff0000u);
            tp[2 * 33] = (a[j].y & 0xffffu) | (b[j].y << 16); tp[3 * 33] = (a[j].y >> 16) | (b[j].y & 0xffff0000u);
            tp[4 * 33] = (a[j].z & 0xffffu) | (b[j].z << 16); tp[5 * 33] = (a[j].z >> 16) | (b[j].z & 0xffff0000u);
            tp[6 * 33] = (a[j].w & 0xffffu) | (b[j].w << 16); tp[7 * 33] = (a[j].w >> 16) | (b[j].w & 0xffff0000u); }
        LDS_WAIT(); asm volatile("" ::: "memory");
#pragma unroll
        for (int i = 0; i < 8; ++i) { const int row = q + 8 * i; const LAS unsigned* tp = tl + row * 33 + 4 * seg;
            v4u o; o.x = tp[0]; o.y = tp[1]; o.z = tp[2]; o.w = tp[3];
            *(v4u*)(dst + (size_t)row * 1024) = o; }
        LDS_WAIT(); asm volatile("" ::: "memory");
    }
}

__device__ __forceinline__ void phase_mix_naive(Frame& F, int l) {
    const bool last = (l == DEPTH - 1);
    SUBPR_START(13)
    { const int gw = F.bid * NWAVES + F.wave, NGW = F.G * NWAVES;
      for (int it = gw; it < 4096; it += NGW) attn_item(F, l, it);
      if (!last && F.wave == 3 && F.bid < 128) attn_item(F, l, 4096 + F.bid); }
    SUBPR_STOP(13)
    SUBPR_START(15)
    if (!last) { const int rank = F.wave * F.G + F.bid, NR = F.G * NWAVES;
      LAS float* wl = (LAS float*)(F.lds + F.wave * 4096);
      for (int it = rank; it < 256 + 512; it += NR) {
          if (it < 256) hyena_ctx_wave(F, l, it, wl, (LAS f32x2*)(wl + 512));
          else { const int j = it - 256; fnet_ctx_wave(F, j >> 8, (j >> 6) & 3, j & 63, (LAS f32x2*)wl, (LAS f32x2*)(wl + 512)); } } }
    SUBPR_STOP(15)
    __syncthreads();
    SUBPR_START(14)
    for (int c = F.bid; c < 256; c += F.G) hyena_item_fft(F, l, c);
    SUBPR_STOP(14)
    SUBPR_START(16)
    for (int it = F.bid; it < 256; it += F.G) fnet_item_fft(F, it >> 7, (it >> 5) & 3, it & 31);
    SUBPR_STOP(16)
}

__device__ __forceinline__ void small_gemm_partial(Frame& F, const bf16* A, int lda, const bf16* Bt, int ldb, int k0w, int kw, int row0, int col0) {
    typedef short bf16x8_t __attribute__((ext_vector_type(8))); typedef float f32x16_t __attribute__((ext_vector_type(16)));
    LAS float* part = (LAS float*)F.lds;
    const int r = F.lane & 31, h = F.lane >> 5, k0 = k0w + 8 * h;
    const bf16* ap = A + (size_t)(row0 + r) * lda + k0; const bf16* bp0 = Bt + (size_t)(col0 + r) * ldb + k0; const bf16* bp1 = bp0 + (size_t)32 * ldb;
    f32x16_t acc0, acc1;
#pragma unroll
    for (int q = 0; q < 16; ++q) { acc0[q] = 0.f; acc1[q] = 0.f; }
#pragma unroll 8
    for (int k = 0; k < kw; k += 16) { const bf16x8_t a = *(const bf16x8_t*)(ap + k), b0 = *(const bf16x8_t*)(bp0 + k), b1 = *(const bf16x8_t*)(bp1 + k);
        acc0 = __builtin_amdgcn_mfma_f32_32x32x16_bf16(b0, a, acc0, 0, 0, 0); acc1 = __builtin_amdgcn_mfma_f32_32x32x16_bf16(b1, a, acc1, 0, 0, 0); }
#pragma unroll
    for (int q = 0; q < 16; ++q) { const int col = (q & 3) + 8 * (q >> 2) + 4 * h; part[(F.wave * 64 + col) * 32 + r] = acc0[q]; part[(F.wave * 64 + 32 + col) * 32 + r] = acc1[q]; }
    __syncthreads();
}
__device__ __forceinline__ f32x4 small_gemm_reduce(Frame& F, int w0, int w1) {
    const LAS float* part = (const LAS float*)F.lds;
    const int tok = F.tid & 31, cq = F.tid >> 5; f32x4 s = {0.f, 0.f, 0.f, 0.f};
    for (int w = w0; w < w1; ++w)
#pragma unroll
        for (int e = 0; e < 4; ++e) s[e] += part[(w * 64 + 4 * cq + e) * 32 + tok];
    return s;
}
__device__ __forceinline__ f32x4 small_gemm_tile(Frame& F, const bf16* A, int lda, const bf16* Bt, int ldb, int kbeg, int klen, int row0, int col0) {
    const int kw = klen >> 3;
    small_gemm_partial(F, A, lda, Bt, ldb, kbeg + F.wave * kw, kw, row0, col0);
    const f32x4 s = small_gemm_reduce(F, 0, 8);
    __syncthreads();
    return s;
}
__device__ __forceinline__ void ctx_merge(Frame& F, int l) {
    for (int it = F.bid; it < 256; it += F.G) { const int row0 = ML + (it >> 4) * 32, col0 = (it & 15) * 64;
        const bf16* A = (const bf16*)(wsp(F) + WS_AM); const bf16* Bt = ((const bf16*)(wsp(F) + WS_WPA)) + (size_t)l * 1024 * 1024; const unsigned char* G8 = (const unsigned char*)(wsp(F) + WS_PR);
        const int row = row0 + (F.tid & 31), col = col0 + 4 * (F.tid >> 5); f32x4 tot = {0.f, 0.f, 0.f, 0.f};
        small_gemm_partial(F, A, 1024, Bt, 1024, 128 * F.wave, 128, row0, col0);
#pragma unroll
        for (int br = 0; br < 3; ++br) { const f32x4 p = small_gemm_reduce(F, br == 0 ? 0 : (br == 1 ? 4 : 6), br == 0 ? 4 : (br == 1 ? 6 : 8));
            const unsigned gw = *(const unsigned*)(G8 + (size_t)row * 3072 + br * 1024 + col);
            tot[0] += (float)(gw & 0xffu) * p[0]; tot[1] += (float)((gw >> 8) & 0xffu) * p[1]; tot[2] += (float)((gw >> 16) & 0xffu) * p[2]; tot[3] += (float)(gw >> 24) * p[3]; }
        __syncthreads();
        tot = tot * (1.0f / 255.0f);
        v2u o; o.x = pk2(tot[0], tot[1]); o.y = pk2(tot[2], tot[3]); *(v2u*)(((bf16*)(wsp(F) + WS_M)) + (size_t)row * 1024 + col) = o; }
}
__device__ __forceinline__ void ctx_resid(Frame& F, const bf16* A, int K, const bf16* Bt, const float* gate_ctx  ) {
    for (int it = F.bid; it < 256; it += F.G) { const int row0 = ML + (it >> 4) * 32, col0 = (it & 15) * 64;
        const f32x4 p = small_gemm_tile(F, A, K, Bt, K, 0, K, row0, col0);
        const int row = row0 + (F.tid & 31), col = col0 + 4 * (F.tid >> 5);
        bf16* xp = ((bf16*)(wsp(F) + WS_XS)) + (size_t)row * 1024 + col;
        const v2u xw = *(const v2u*)xp; const f32x4 gv = *(const f32x4*)(gate_ctx + col);
        v2u o; o.x = pk2(bflo(xw.x) + gv[0] * p[0], bfhi(xw.x) + gv[1] * p[1]); o.y = pk2(bflo(xw.y) + gv[2] * p[2], bfhi(xw.y) + gv[3] * p[3]);
        *(v2u*)xp = o; }
}

constexpr int NPL = 11;
constexpr int NPHASES = 1 + DEPTH * NPL + 1;
#ifndef ONE_LAUNCH
#define ONE_LAUNCH 1
#endif

__global__ void __launch_bounds__(NTHREADS, 2) fwd_kernel(Args args) {
    extern __shared__ __attribute__((aligned(16))) unsigned char lds[];
    Frame F;
    F.lds = (LAS unsigned char*)lds;
    F.tid = threadIdx.x; F.lane = F.tid & 63; F.wave = __builtin_amdgcn_readfirstlane(F.tid >> 6);
    F.G = gridDim.x; F.bid = blockIdx.x;
    unsigned char* ws = args.ws; F.ws = ws;
    F.ctl = (unsigned*)(ws + WS_CTL);
    F.a = &args; F.z = 0;
    volatile LAS unsigned* MISC = (volatile LAS unsigned*)(F.lds + MISC_OFF);
    for (int u = F.tid; u < 64; u += NTHREADS) MISC[u] = 0u;
    __syncthreads();
    const int lo = args.ph_lo, hi = args.ph_hi;
    XcdBarrier bar; bar.bar = F.ctl + CW_BAR; bar.x = 0; bar.st = nullptr;
    if (hi - lo > 1) bar = xcd_barrier_post(F.ctl + CW_BAR, MISC + 8);
    F.pr_acc = 0ull; F.pr_t0 = 0ull;
#define PR_TYPE(k) ((k) == 0 ? 11 : ((k) == 1 + DEPTH * NPL ? 12 : (((k) - 1) % NPL)))
#ifndef PROBE_LAYERS
#define PROBE_LAYERS 0xF
#endif
#define PR_LAYER(k) ((k) == 0 || (k) == 1 + DEPTH * NPL ? 0 : (((k) - 1) / NPL))
#define PR_START(k) if (PROBE_MASK && ((PROBE_MASK >> PR_TYPE(k)) & 1) && ((PROBE_LAYERS >> PR_LAYER(k)) & 1)) F.pr_t0 = __builtin_amdgcn_s_memrealtime();
#define PR_STOP(k) if (PROBE_MASK && ((PROBE_MASK >> PR_TYPE(k)) & 1) && ((PROBE_LAYERS >> PR_LAYER(k)) & 1)) F.pr_acc += __builtin_amdgcn_s_memrealtime() - F.pr_t0;
#define PH_BEGIN(k) if (lo <= (k) && (k) < hi) { PR_START(k) { int t_ = threadIdx.x; asm volatile("" : "+v"(t_)); F.tid = t_; F.lane = t_ & 63; F.wave = __builtin_amdgcn_readfirstlane(t_ >> 6); int z_ = 0; asm volatile("" : "+s"(z_)); F.z = z_; }
#define PH_END(k) if ((k) + 1 < hi) xcd_barrier_impl(bar.bar, bar.x, bar.st); PR_STOP(k) }

    PH_BEGIN(0) phase_prologue(F); PH_END(0)

    for (int l = 0; l < DEPTH; ++l) {
        const int pb = 1 + l * NPL;
        const float* modl = ((float*)(wsp(F) + WS_CTL) + CW_MOD) + (size_t)l * 3 * 6144;
        const bool moe = (l & 1) != 0; const int fi = l >> 1;

        PH_BEGIN(pb + 0)
            if (l > 0 && ((l - 1) & 1)) phase_norm<false, true, true>(F, l, nullptr, nullptr, inp(F, I_N1G) + l * 1024, 0, nullptr, MT, F.G > 64 ? 8 : 0);
            else if (l == 0) phase_norm<false, false, true, false>(F, l, inp(F, I_X), inp(F, I_CTX), inp(F, I_N1G) + l * 1024, 0, nullptr, MT, F.G > 64 ? 8 : 0);
            else phase_norm<false, false, true>(F, l, nullptr, nullptr, inp(F, I_N1G) + l * 1024, 0, nullptr, MT, F.G > 64 ? 8 : 0);
            for (int it = F.bid; it < 264; it += F.G) { if (it < 256) filter_tile(F, l, SEQ, it * 32, ((float*)(wsp(F) + WS_HF)), it == F.bid); else filter_tile(F, l, CTXL, (it - 256) * 32, ((float*)(wsp(F) + WS_HFC)), it == F.bid); }
        PH_END(pb + 0)

        PH_BEGIN(pb + 1)
            pg8::Gemm g{((bf16*)(wsp(F) + WS_H)), ((bf16*)(wsp(F) + WS_WIN)) + (size_t)l * INW * 1024, MT, INW, 1024}; pg8::StaticOrder S; S.init(MT, INW, F.G, F.bid);
            pg8::EpiIn E{wsp(F), l};
            pg8::gemm_phase<pg8::EpiIn, pg8::StaticOrder, true, true>(F.lds, g, S, E);
        PH_END(pb + 1)


        PH_BEGIN(pb + 3) phase_mix_naive(F, l); PH_END(pb + 3)

        PH_BEGIN(pb + 4) phase_trans(F); PH_END(pb + 4)

        PH_BEGIN(pb + 5)
            if (l != DEPTH - 1) ctx_merge(F, l);
            pg8::Gemm g{((bf16*)(wsp(F) + WS_AM)), ((bf16*)(wsp(F) + WS_WPA)) + (size_t)l * 1024 * 1024, ML, 1024, 1024}; pg8::StaticOrder S; S.init(ML, 1024, F.G, F.bid);
            pg8::EpiMerge E{((const unsigned char*)(wsp(F) + WS_PR)), ((bf16*)(wsp(F) + WS_M))};
            pg8::gemm_phase<pg8::EpiMerge, pg8::StaticOrder, true, true>(F.lds, g, S, E);
        PH_END(pb + 5)

        PH_BEGIN(pb + 6)
            if (l != DEPTH - 1) ctx_resid(F, (const bf16*)(wsp(F) + WS_M), 1024, ((const bf16*)(wsp(F) + WS_WO)) + (size_t)l * 1024 * 1024, modl + 2 * 6144 + 2048);
            pg8::Gemm g{((bf16*)(wsp(F) + WS_M)), ((bf16*)(wsp(F) + WS_WO)) + (size_t)l * 1024 * 1024, ML, 1024, 1024}; pg8::StaticOrder S; S.init(ML, 1024, F.G, F.bid);
            pg8::EpiResid E{((bf16*)(wsp(F) + WS_XS)), modl + 2048};
            pg8::gemm_phase<pg8::EpiResid, pg8::StaticOrder, true, true>(F.lds, g, S, E);
        PH_END(pb + 6)

        PH_BEGIN(pb + 7)
            if (moe) phase_norm<true, false, true>(F, l, nullptr, nullptr, inp(F, I_N2G) + l * 1024, 3072, inp(F, I_ROUTER) + (size_t)fi * 1024 * 8, MT);
            else phase_norm<false, false, true>(F, l, nullptr, nullptr, inp(F, I_N2G) + l * 1024, 3072, nullptr, MT);
        PH_END(pb + 7)

        if (moe) {
            PH_BEGIN(pb + 8) phase_gather(F, l); PH_END(pb + 8)
        }

        PH_BEGIN(pb + 9)
            LAS int* poff = (LAS int*)(F.lds + LDS_TAB + 64);
            if (moe) {
                moe_offsets(F, l, poff);
                pg8::Gemm g{((bf16*)(wsp(F) + WS_XG)), ((bf16*)(wsp(F) + WS_MGU)) + (size_t)(fi * 8) * 5632 * 1024, MOE_MAXP * 256, 8 * 5632, 1024}; pg8::MoeOrder S{22, F.G, F.bid, poff};
                pg8::EpiSwiglu E{((bf16*)(wsp(F) + WS_HIDG)), DFF, 22};
                pg8::gemm_phase<pg8::EpiSwiglu, pg8::MoeOrder, true, true>(F.lds, g, S, E);
            } else {
                pg8::Gemm g{((bf16*)(wsp(F) + WS_H)), ((bf16*)(wsp(F) + WS_FGU)) + (size_t)fi * 5632 * 1024, MT, 5632, 1024}; pg8::StaticOrder S; S.init(MT, 5632, F.G, F.bid);
                pg8::EpiSwiglu E{((bf16*)(wsp(F) + WS_HID)), DFF, 22};
                pg8::gemm_phase<pg8::EpiSwiglu, pg8::StaticOrder, true, true>(F.lds, g, S, E);
            }
        PH_END(pb + 9)

        PH_BEGIN(pb + 10)
            LAS int* poff = (LAS int*)(F.lds + LDS_TAB + 64);
            if (moe) {
                moe_offsets(F, l, poff);
                pg8::Gemm g{((bf16*)(wsp(F) + WS_HIDG)), ((bf16*)(wsp(F) + WS_MD)) + (size_t)(fi * 8) * 1024 * 2816, MOE_MAXP * 256, 8 * 1024, DFF}; pg8::MoeOrder S{4, F.G, F.bid, poff};
                pg8::EpiStore E{((bf16*)(wsp(F) + WS_Y)), 1024, 4};
                pg8::gemm_phase<pg8::EpiStore, pg8::MoeOrder, true, true>(F.lds, g, S, E);
            } else {
                ctx_resid(F, (const bf16*)(wsp(F) + WS_HID), DFF, ((const bf16*)(wsp(F) + WS_FD)) + (size_t)fi * 1024 * 2816, modl + 2 * 6144 + 5120);
                pg8::Gemm g{((bf16*)(wsp(F) + WS_HID)), ((bf16*)(wsp(F) + WS_FD)) + (size_t)fi * 1024 * 2816, ML, 1024, DFF}; pg8::StaticOrder S; S.init(ML, 1024, F.G, F.bid);
                pg8::EpiResid E{((bf16*)(wsp(F) + WS_XS)), modl + 5120};
                pg8::gemm_phase<pg8::EpiResid, pg8::StaticOrder, true, true>(F.lds, g, S, E);
            }
        PH_END(pb + 10)
    }
    PH_BEGIN(1 + DEPTH * NPL) phase_norm<false, true, false>(F, DEPTH - 1, nullptr, nullptr, nullptr, 0, nullptr, ML); PH_END(1 + DEPTH * NPL)
#undef PH_BEGIN
#undef PH_END
    if (PROBE_MASK && blockIdx.x == 0) { const unsigned long long t0 = __builtin_amdgcn_s_memrealtime(); while (__builtin_amdgcn_s_memrealtime() - t0 < F.pr_acc * PROBE_AMP) __builtin_amdgcn_s_sleep(8); }
}

extern "C" void kernel_launch(void* const* d_in, const int* in_sizes, int n_in, void* d_out, int out_size, void* d_ws, size_t ws_size, hipStream_t stream) {
    static int grid = 0;
    if (grid == 0) {
        if (n_in != 33 || out_size != ML * DM || ws_size < WS_END2) { fprintf(stderr, "kernel_launch: unexpected shapes (n_in %d out %d ws %zu need %zu)\n", n_in, out_size, ws_size, (size_t)WS_END2); grid = -1; return; }
        int dev = 0, cus = 0, per_cu = 0;
        if (hipGetDevice(&dev) != hipSuccess || hipDeviceGetAttribute(&cus, hipDeviceAttributeMultiprocessorCount, dev) != hipSuccess) { grid = -1; return; }
        if (hipFuncSetAttribute((const void*)fwd_kernel, hipFuncAttributeMaxDynamicSharedMemorySize, LDS_BYTES) != hipSuccess) { fprintf(stderr, "kernel_launch: hipFuncSetAttribute failed\n"); grid = -1; return; }
        if (hipOccupancyMaxActiveBlocksPerMultiprocessor(&per_cu, (const void*)fwd_kernel, NTHREADS, LDS_BYTES) != hipSuccess || per_cu < 1) { fprintf(stderr, "kernel_launch: occupancy query says %d\n", per_cu); }
        (void)hipGetLastError();
        grid = cus;
    }
    if (grid < 0) return;
    if (hipMemsetAsync((char*)d_ws + WS_CTL, 0, CTL_ZERO_BYTES, stream) != hipSuccess) return;
    Args a{};
    for (int i = 0; i < 33; ++i) a.in[i] = (const float*)d_in[i];
    a.in[33] = (const float*)d_out; a.ws = (unsigned char*)d_ws;
#if ONE_LAUNCH
    a.ph_lo = 0; a.ph_hi = NPHASES;
    hipLaunchKernelGGL(fwd_kernel, dim3(grid), dim3(NTHREADS), LDS_BYTES, stream, a);
#else
    for (int k = 0; k < NPHASES; ++k) {
        if (k >= 1 && k < NPHASES - 1) { const int l = (k - 1) / NPL, p = (k - 1) % NPL; if ((l & 1) == 0 && p == 8) continue; }
        a.ph_lo = k; a.ph_hi = k + 1;
        hipLaunchKernelGGL(fwd_kernel, dim3(grid), dim3(NTHREADS), LDS_BYTES, stream, a);
    }
#endif
}
```

```cpp
#include <hip/hip_runtime.h>
#include <cstdio>
#include <cstdint>
#ifndef PROBE_MASK
#define PROBE_MASK 0
#endif
#ifndef PROBE_AMP
#define PROBE_AMP 4
#endif
#define SUBPR_START(t) if (PROBE_MASK && ((PROBE_MASK >> (t)) & 1)) { __syncthreads(); F.pr_t0 = __builtin_amdgcn_s_memrealtime(); }
#define SUBPR_STOP(t) if (PROBE_MASK && ((PROBE_MASK >> (t)) & 1)) { __syncthreads(); F.pr_acc += __builtin_amdgcn_s_memrealtime() - F.pr_t0; }
namespace pg8 {
#define PG8_LAS __attribute__((address_space(3)))
typedef unsigned short bf16_t;
typedef short bf16x8 __attribute__((ext_vector_type(8)));
typedef float f32x4 __attribute__((ext_vector_type(4)));
typedef unsigned u32x4 __attribute__((ext_vector_type(4)));
constexpr int BM = 256, BK = 64, HALF = 128, HTB = HALF * BK * 2  , STAGE_BYTES = 8 * HTB, NXCD = 8, WGM = 8;

__host__ __device__ __forceinline__ int lds_byte(int r, int c) { const int st = (r >> 4) * 2 + (c >> 5), rr = r & 15, cc = c & 31, ob = rr * 64 + cc * 2; return st * 1024 + (ob ^ (((ob >> 9) & 1) << 5)); }
__host__ __device__ __forceinline__ void stage_rc(int b, int& R, int& C) { const int st = b / 1024, sb = b % 1024, swz = sb ^ (((sb >> 9) & 1) << 5); R = (st >> 1) * 16 + swz / 64; C = (st & 1) * 32 + (swz % 64) / 2; }
__host__ __device__ __forceinline__ int perm32(int rho) { const int n = rho >> 4, i = rho & 15; return 8 * (i >> 2) + 4 * n + (i & 3); }

struct Unit { int pm, pn; };
struct Gemm { const bf16_t* A; const bf16_t* Bt; int M, N, K; };

struct StaticOrder {
    int nM, nN, nwg, G, c;
    __host__ __device__ void init(int M, int N, int G_, int c_) { nM = M / BM; nN = N / BM; nwg = nM * nN; G = G_; c = c_; }
    __host__ __device__ bool next(int i, Unit& u) const {
        const long L = (long)i * G + c; if (L >= nwg) return false;
        int wgid = (int)L; { const int q = nwg / NXCD, r = nwg % NXCD, xcd = wgid % NXCD, off = wgid / NXCD; wgid = (xcd < r ? xcd * (q + 1) : r * (q + 1) + (xcd - r) * q) + off; }
        const int nig = WGM * nN, gid = wgid / nig, fm = gid * WGM, gsz = (nM - fm) < WGM ? (nM - fm) : WGM;
        u.pm = fm + ((wgid % nig) % gsz); u.pn = (wgid % nig) / gsz; return true;
    }
    __device__ __forceinline__ void a_ready(const Unit&) const {}
    __device__ __forceinline__ void done(const Unit&) const {}
};

__device__ __forceinline__ unsigned cvt_pk_bf16(float lo, float hi) { typedef float f32x2_c __attribute__((ext_vector_type(2))); typedef __bf16 bf16x2_c __attribute__((ext_vector_type(2))); f32x2_c v = {lo, hi}; bf16x2_c b = __builtin_convertvector(v, bf16x2_c); return __builtin_bit_cast(unsigned, b); }
typedef float f32x2 __attribute__((ext_vector_type(2)));
template <class Epi, class Sched, bool ALIGN_EPI = false, bool SP2 = false, bool GATHER_A = false>
__device__ __forceinline__ void gemm_phase(PG8_LAS unsigned char* lds, const Gemm g, const Sched& S, const Epi& E) {
    int tid_ = threadIdx.x; asm volatile("" : "+v"(tid_)); const int tid = tid_, wid = __builtin_amdgcn_readfirstlane(tid >> 6), lane = tid & 63, wr = wid >> 2, wc = wid & 3, fr = lane & 15, fq = lane >> 4;
    const int K = g.K, nt = K / BK;
    unsigned voffA[2], voffB[2];
#pragma unroll
    for (int i = 0; i < 2; ++i) { int R, C; stage_rc(tid * 16 + i * 8192, R, C); const int Rb = Epi::PERM ? ((R & ~31) + perm32(R & 31)) : R;
        voffA[i] = (unsigned)(R * K + C) * 2u; voffB[i] = (unsigned)(Rb * K + C) * 2u; }
    const size_t kstep = (size_t)(BK * 2);
    const size_t hstep = (size_t)HALF * K * 2;
    const size_t tstep = 2 * hstep;
    const unsigned ldsw = (unsigned)wid * 1024u;
    const int aoff = lds_byte(wr * 64 + fr, fq * 8), boff = lds_byte(wc * 32 + fr, fq * 8);
#define PG8_SA(b, h) (((b) * 2 + (h)) * HTB)
#define PG8_SB(b, h) ((4 + (b) * 2 + (h)) * HTB)
#define PG8_STAGE(bufoff, gbase, voff) do { _Pragma("unroll") for (int _i = 0; _i < 2; ++_i) \
        __builtin_amdgcn_global_load_lds((const unsigned*)((const char*)(gbase) + (voff)[_i]), (PG8_LAS unsigned*)(lds + (bufoff) + ldsw + _i * 8192), 16, 0, 0); } while (0)
#define PG8_STAGE_A(bufoff, pA, kg, hh) do { if constexpr (GATHER_A) { _Pragma("unroll") for (int _i = 0; _i < 2; ++_i) \
        __builtin_amdgcn_global_load_lds((const unsigned*)((const char*)(kg) + cG[hh][_i]), (PG8_LAS unsigned*)(lds + (bufoff) + ldsw + _i * 8192), 16, 0, 0); } else { PG8_STAGE(bufoff, (pA) + (hh) * hstep, voffA); } } while (0)
#define PG8_LDA(dst, b, h) do { _Pragma("unroll") for (int m = 0; m < 4; ++m) _Pragma("unroll") for (int k = 0; k < 2; ++k) dst[m][k] = *(const PG8_LAS bf16x8*)(lds + PG8_SA(b, h) + aoff + m * 2048 + k * 1024); } while (0)
#define PG8_LDB(dst, b, h) do { _Pragma("unroll") for (int n = 0; n < 2; ++n) _Pragma("unroll") for (int k = 0; k < 2; ++k) dst[n][k] = *(const PG8_LAS bf16x8*)(lds + PG8_SB(b, h) + boff + n * 2048 + k * 1024); } while (0)
#define PG8_MMA(ai, bj, At, Bt) do { __builtin_amdgcn_s_setprio(1); _Pragma("unroll") for (int m = 0; m < 4; ++m) _Pragma("unroll") for (int n = 0; n < 2; ++n) _Pragma("unroll") for (int k = 0; k < 2; ++k) \
        acc[ai][bj][m][n] = __builtin_amdgcn_mfma_f32_16x16x32_bf16(Bt[n][k], At[m][k], acc[ai][bj][m][n], 0, 0, 0); __builtin_amdgcn_s_setprio(0); } while (0)
#define PG8_WAIT_V(n) asm volatile("s_waitcnt vmcnt(" #n ")" ::: "memory")
#define PG8_WAIT_L(n) asm volatile("s_waitcnt lgkmcnt(" #n ")" ::: "memory")
#define PG8_BAR __builtin_amdgcn_s_barrier()
#define PG8_SCHED __builtin_amdgcn_sched_barrier(0)
    Unit cur, nxt; int ui = 0;
    if (!S.next(0, cur)) return;
    f32x4 acc[2][2][4][2];
#pragma unroll
    for (int a = 0; a < 2; ++a)
#pragma unroll
        for (int b = 0; b < 2; ++b)
#pragma unroll
            for (int m = 0; m < 4; ++m)
#pragma unroll
                for (int n = 0; n < 2; ++n) acc[a][b][m][n] = (f32x4){0.f, 0.f, 0.f, 0.f};
    bf16x8 At[4][2], B0[2][2], B1[2][2];
    const char* cA = (const char*)g.A + (size_t)cur.pm * tstep; const char* cB = (const char*)g.Bt + (size_t)cur.pn * tstep;
    S.a_ready(cur);
    unsigned cG[2][2] = {{0u, 0u}, {0u, 0u}}; const char* const gA = (const char*)g.A;
    auto load_cg = [&](int uidx) {
        if constexpr (GATHER_A) {
#pragma unroll
            for (int i = 0; i < 2; ++i) { int R, C; stage_rc(tid * 16 + i * 8192, R, C);
#pragma unroll
                for (int hh = 0; hh < 2; ++hh) cG[hh][i] = S.gtab[uidx * 256 + hh * HALF + R] + (unsigned)(C * 2); } } };
    load_cg(0);
    if constexpr (SP2) {
        PG8_STAGE(PG8_SB(0, 0), cB, voffB); PG8_STAGE(PG8_SB(0, 1), cB + hstep, voffB); PG8_STAGE_A(PG8_SA(0, 0), cA, gA, 0); PG8_STAGE_A(PG8_SA(0, 1), cA, gA, 1);
        if (wr == 1) PG8_BAR;
        PG8_WAIT_V(2); PG8_BAR;
        PG8_STAGE(PG8_SB(1, 0), cB + kstep, voffB); PG8_STAGE_A(PG8_SA(1, 0), cA + kstep, gA + kstep, 0); PG8_STAGE(PG8_SB(1, 1), cB + hstep + kstep, voffB);
        PG8_WAIT_V(6); PG8_BAR;
    } else {
        PG8_STAGE(PG8_SB(0, 0), cB, voffB); PG8_STAGE(PG8_SA(0, 0), cA, voffA); PG8_STAGE(PG8_SB(0, 1), cB + hstep, voffB); PG8_STAGE(PG8_SA(0, 1), cA + hstep, voffA);
        if (wr == 1) PG8_BAR;
        PG8_WAIT_V(4); PG8_BAR;
        PG8_STAGE(PG8_SB(1, 0), cB + kstep, voffB); PG8_STAGE(PG8_SA(1, 0), cA + kstep, voffA); PG8_STAGE(PG8_SB(1, 1), cB + hstep + kstep, voffB);
        PG8_WAIT_V(6); PG8_BAR;
    }
    for (;;) {
        const bool has_next = S.next(ui + 1, nxt);
        const char* nA = has_next ? (const char*)g.A + (size_t)nxt.pm * tstep : cA; const char* nB = has_next ? (const char*)g.Bt + (size_t)nxt.pn * tstep : cB;
        for (int t = 0; t < nt; t += 2) {
            if constexpr (Epi::HOOK) { if (E.hook_at(t)) E.hook(acc, cur, t, wr, wc, fr, fq); }
            const bool last = (t == nt - 2);
            const char* a1 = cA + (size_t)(t + 1) * kstep;
            const char* a2 = last ? nA : cA + (size_t)(t + 2) * kstep; const char* b2 = last ? nB : cB + (size_t)(t + 2) * kstep;
            const char* a3 = a2 + kstep; const char* b3 = b2 + kstep;
            const char* g1 = gA + (size_t)(t + 1) * kstep; const char* g2 = last ? gA : gA + (size_t)(t + 2) * kstep; const char* g3 = g2 + kstep;
            if (last && has_next) S.a_ready(nxt);
            if constexpr (SP2) {
            PG8_LDB(B0, 0, 0); PG8_LDB(B1, 0, 1); PG8_SCHED; PG8_LDA(At, 0, 0); PG8_STAGE_A(PG8_SA(1, 1), a1, g1, 1);
            if constexpr (GATHER_A) { if (last && has_next) load_cg(ui + 1); }
            PG8_WAIT_V(8); PG8_WAIT_L(0); PG8_BAR; PG8_MMA(0, 0, At, B0); PG8_MMA(0, 1, At, B1); PG8_BAR; PG8_SCHED;
            PG8_LDA(At, 0, 1); PG8_STAGE(PG8_SB(0, 0), b2, voffB); PG8_STAGE(PG8_SB(0, 1), b2 + hstep, voffB); PG8_STAGE_A(PG8_SA(0, 0), a2, g2, 0);
            PG8_WAIT_V(8); PG8_WAIT_L(0); PG8_BAR; PG8_MMA(1, 0, At, B0); PG8_MMA(1, 1, At, B1); PG8_BAR; PG8_SCHED;
            PG8_LDB(B0, 1, 0); PG8_LDB(B1, 1, 1); PG8_SCHED; PG8_LDA(At, 1, 0); PG8_STAGE_A(PG8_SA(0, 1), a2, g2, 1);
            PG8_WAIT_V(8); PG8_WAIT_L(0); PG8_BAR; PG8_MMA(0, 0, At, B0); PG8_MMA(0, 1, At, B1); PG8_BAR; PG8_SCHED;
            PG8_LDA(At, 1, 1); PG8_STAGE(PG8_SB(1, 0), b3, voffB); PG8_STAGE(PG8_SB(1, 1), b3 + hstep, voffB); PG8_STAGE_A(PG8_SA(1, 0), a3, g3, 0);
            PG8_WAIT_V(8); PG8_WAIT_L(0); PG8_BAR; PG8_MMA(1, 0, At, B0); PG8_MMA(1, 1, At, B1); PG8_BAR; PG8_SCHED;
            } else {
            PG8_LDB(B0, 0, 0); PG8_SCHED; PG8_LDA(At, 0, 0); PG8_STAGE(PG8_SA(1, 1), a1 + hstep, voffA);
            PG8_WAIT_L(8); PG8_BAR; PG8_WAIT_L(0); PG8_MMA(0, 0, At, B0); PG8_BAR; PG8_SCHED;
            PG8_LDB(B1, 0, 1); PG8_STAGE(PG8_SB(0, 0), b2, voffB);
            PG8_BAR; PG8_WAIT_L(0); PG8_MMA(0, 1, At, B1); PG8_BAR;
            PG8_LDA(At, 0, 1); PG8_STAGE(PG8_SA(0, 0), a2, voffA);
            PG8_BAR; PG8_WAIT_L(0); PG8_MMA(1, 0, At, B0); PG8_BAR; PG8_SCHED;
            PG8_STAGE(PG8_SB(0, 1), b2 + hstep, voffB);
            PG8_WAIT_V(6); PG8_BAR; PG8_MMA(1, 1, At, B1); PG8_BAR;
            PG8_LDB(B0, 1, 0); PG8_SCHED; PG8_LDA(At, 1, 0); PG8_STAGE(PG8_SA(0, 1), a2 + hstep, voffA);
            PG8_WAIT_L(8); PG8_BAR; PG8_WAIT_L(0); PG8_MMA(0, 0, At, B0); PG8_BAR; PG8_SCHED;
            PG8_LDB(B1, 1, 1); PG8_STAGE(PG8_SB(1, 0), b3, voffB);
            PG8_BAR; PG8_WAIT_L(0); PG8_MMA(0, 1, At, B1); PG8_BAR;
            PG8_LDA(At, 1, 1); PG8_STAGE(PG8_SA(1, 0), a3, voffA);
            PG8_BAR; PG8_WAIT_L(0); PG8_MMA(1, 0, At, B0); PG8_BAR; PG8_SCHED;
            PG8_STAGE(PG8_SB(1, 1), b3 + hstep, voffB);
            PG8_WAIT_V(6); PG8_BAR; PG8_MMA(1, 1, At, B1); PG8_BAR;
            }
        }
        if constexpr (ALIGN_EPI) { if (wr == 0) PG8_BAR; }
        if constexpr (!Epi::AFTER_DRAIN) { E(acc, cur, wr, wc, fr, fq); S.done(cur); }
        if (!has_next) break;
#pragma unroll
        for (int a = 0; a < 2; ++a)
#pragma unroll
            for (int b = 0; b < 2; ++b)
#pragma unroll
                for (int m = 0; m < 4; ++m)
#pragma unroll
                    for (int n = 0; n < 2; ++n) acc[a][b][m][n] = (f32x4){0.f, 0.f, 0.f, 0.f};
        cur = nxt; cA = nA; cB = nB; ++ui;
        if constexpr (ALIGN_EPI) { if (wr == 1) PG8_BAR; }
    }
    PG8_WAIT_V(0);
    if constexpr (!ALIGN_EPI) { if (wr == 0) PG8_BAR; }
    PG8_BAR;
    if constexpr (Epi::AFTER_DRAIN) { E.fused(acc, cur, wr, wc, fr, fq, lds, wid, lane); S.done(cur); }
#undef PG8_SA
#undef PG8_SB
#undef PG8_STAGE
#undef PG8_STAGE_A
#undef PG8_LDA
#undef PG8_LDB
#undef PG8_MMA
#undef PG8_WAIT_V
#undef PG8_WAIT_L
#undef PG8_BAR
#undef PG8_SCHED
}
}

constexpr int NWAVES = 8, NTHREADS = 512;
constexpr int BATCH = 2, SEQ = 8192, DM = 1024, DEPTH = 4, CTXL = 256;
constexpr int ML = BATCH * SEQ;
constexpr int MC = BATCH * CTXL;
constexpr int MT = ML + MC;
constexpr int HD = 64, NH = 8, NKV = 2;
constexpr int QW = 512, KVW = 128;
constexpr int HYW = 256, FNW = 256;
constexpr int Q_END = 512, K_END = 640, V_END = 768, HY_END = 1536, FN_END = 1792, INW = 4864;
constexpr int DFF = 2816, NEXP = 8;
constexpr int FH = 64, FEMB = 33;
constexpr float EPS = 1e-6f;

constexpr size_t MiB = 1u << 20;
constexpr size_t WS_CTL = 0, CTL_ZERO_BYTES = 64 * 1024, CTL_BYTES = 4 * MiB;
constexpr size_t WS_WIN = 4 * MiB;
constexpr size_t WS_WPA = WS_WIN + 38 * MiB;
constexpr size_t WS_WPH = WS_WPA + 4 * MiB;
constexpr size_t WS_WPF = WS_WPH + 2 * MiB;
constexpr size_t WS_WO = WS_WPF + 2 * MiB;
constexpr size_t WS_FGU = WS_WO + 8 * MiB;
constexpr size_t WS_FD = WS_FGU + 22 * MiB;
constexpr size_t WS_MGU = WS_FD + 11 * MiB;
constexpr size_t WS_MD = WS_MGU + 176 * MiB;
constexpr size_t WS_XC = WS_MD + 88 * MiB;
constexpr size_t WS_H = WS_XC + 2 * MiB;
constexpr size_t WS_COMB = WS_H + 33 * MiB;
constexpr size_t WS_HF = WS_COMB + 1 * MiB;
constexpr size_t WS_HFC = WS_HF + 32 * MiB;
constexpr size_t WS_S = WS_HFC + 1 * MiB;
constexpr size_t WS_PR = WS_S;
constexpr size_t WS_QK = WS_PR + 157 * MiB;
constexpr size_t WS_ATT = WS_QK + 21 * MiB;
constexpr size_t WS_HYO = WS_ATT + 17 * MiB;
constexpr size_t WS_FNO = WS_HYO + 9 * MiB;
constexpr size_t WS_AM = WS_ATT;
constexpr size_t WS_MACC = WS_FNO + 9 * MiB;
constexpr size_t WS_M = WS_MACC + 66 * MiB;
constexpr size_t WS_END = WS_M + 33 * MiB;
constexpr size_t WS_KS = WS_MACC;
constexpr size_t WS_ZS = WS_MACC + 64 * MiB;
constexpr size_t WS_HYT = WS_MACC + 80 * MiB;
constexpr size_t WS_FNT = WS_MACC + 89 * MiB;
static_assert(WS_FNT + 9 * MiB <= WS_MACC + 99 * MiB, "mix scratch inside MACC + M");
constexpr size_t WS_CTMP = WS_M;
constexpr size_t WS_UT = WS_END;
constexpr size_t WS_VT = WS_UT + 33 * MiB;
constexpr size_t WS_KT = WS_VT + 5 * MiB;
constexpr size_t WS_XS = WS_KT + 5 * MiB;
constexpr size_t WS_TOKE = WS_XS + 33 * MiB;
constexpr size_t WS_END2 = WS_TOKE + 1 * MiB;
constexpr int NKB = MT / 32;
constexpr size_t WS_HID = WS_S;
constexpr int MOE_MAXP = 140;
constexpr size_t WS_XG = WS_S;
constexpr size_t WS_HIDG = WS_S + 70 * MiB;
constexpr size_t WS_Y = WS_S + 263 * MiB;
static_assert((size_t)MOE_MAXP * 256 * 2816 * 2 <= 193 * MiB && WS_Y + 70 * MiB <= WS_S + 350 * MiB, "moe scratch");
static_assert((size_t)MT * INW * 2 <= 157 * MiB && (size_t)MT * DFF * 2 <= 157 * MiB, "scratch sizes");
#define EPI_WS_PR WS_PR
#define EPI_WS_UT WS_UT
#define EPI_WS_VT WS_VT
#define EPI_WS_KT WS_KT
#define EPI_WS_QK WS_QK
#define EPI_WS_QKG (WS_CTL + (size_t)CW_QKG * 4)
constexpr int CW_BAR = 4096;
constexpr int CW_QKG = 12288;
constexpr int CW_CNT = 8192;
constexpr int CW_MOD = 262144;
static_assert((CW_MOD + 4 * 3 * 6144) * 4 <= (int)CTL_BYTES && (CW_CNT + 4 * 64) * 4 <= (int)CTL_ZERO_BYTES && (CW_BAR + 3456) * 4 <= (int)CTL_ZERO_BYTES, "ctl");

constexpr int LDS_BYTES = 147456;
constexpr int MISC_OFF = LDS_BYTES - 256;
constexpr int LDS_TAB = 131072;

#define LAS __attribute__((address_space(3)))
typedef unsigned short bf16;
typedef unsigned v4u __attribute__((ext_vector_type(4)));
typedef unsigned v2u __attribute__((ext_vector_type(2)));
typedef float f32x4 __attribute__((ext_vector_type(4)));
typedef float f32x2 __attribute__((ext_vector_type(2)));
#define LDS_WAIT() asm volatile("s_waitcnt lgkmcnt(0)" ::: "memory")
__device__ __forceinline__ unsigned f2bf(float f) { unsigned u = __builtin_bit_cast(unsigned, f); return (u + 0x7fffu + ((u >> 16) & 1u)) >> 16; }
__device__ __forceinline__ unsigned pk2(float lo, float hi) { return f2bf(lo) | (f2bf(hi) << 16); }
__device__ __forceinline__ float bf2f(unsigned short h) { return __builtin_bit_cast(float, (unsigned)h << 16); }
__device__ __forceinline__ float bflo(unsigned w) { return __builtin_bit_cast(float, w << 16); }
__device__ __forceinline__ float bfhi(unsigned w) { return __builtin_bit_cast(float, w & 0xffff0000u); }
__device__ __forceinline__ float shx(float v, int lane, int o) { return __builtin_bit_cast(float, __builtin_amdgcn_ds_bpermute((lane ^ o) << 2, __builtin_bit_cast(int, v))); }
__device__ __forceinline__ float wave_sum(float v, int lane) {
#pragma unroll
    for (int o = 1; o < 64; o <<= 1) v += shx(v, lane, o);
    return v;
}
__device__ __forceinline__ float wave_max(float v, int lane) {
#pragma unroll
    for (int o = 1; o < 64; o <<= 1) v = fmaxf(v, shx(v, lane, o));
    return v;
}
__device__ __forceinline__ float sin_rev(float r) { return __builtin_amdgcn_sinf(__builtin_amdgcn_fractf(r)); }
__device__ __forceinline__ float cos_rev(float r) { return __builtin_amdgcn_cosf(__builtin_amdgcn_fractf(r)); }
__device__ __forceinline__ float sigmoidf_(float x) { return __builtin_amdgcn_rcpf(1.0f + __expf(-x)); }
constexpr float INV_2PI = 0.15915494309189535f;

#define XB_TMO      128
#define XB_XCNT(j)  (256  + 64 * (j))
#define XB_XSUB(j)  (1280 + 64 * (j))
#define XB_XGEN(j)  (2304 + 64 * (j))
#define XB_TOP      3328
#define XB_TOPGEN   3392
#define XCD_BAR_WORDS 3456
#define XB_SPIN_CAP (1u << 18)

__device__ __forceinline__ unsigned xb_ld(unsigned* p)              { return __hip_atomic_load(p, __ATOMIC_RELAXED, __HIP_MEMORY_SCOPE_AGENT); }
__device__ __forceinline__ unsigned xb_add(unsigned* p, unsigned v) { return __hip_atomic_fetch_add(p, v, __ATOMIC_RELAXED, __HIP_MEMORY_SCOPE_AGENT); }
__device__ __forceinline__ unsigned xb_xcc_id() { return (unsigned)__builtin_amdgcn_s_getreg((3 << 11) | 20) & 0xFu; }
#define XB_SPIN(cond, bar) do { unsigned _sp = 0; while (cond) { __builtin_amdgcn_s_sleep(1); \
    if ((++_sp & 255u) == 0u) { if (xb_ld(&(bar)[XB_TMO])) break; if (_sp > XB_SPIN_CAP) { atomicAdd(&(bar)[XB_TMO], 1u); break; } } } } while (0)

struct XcdBarrier {
    unsigned* bar; unsigned x;
    volatile LAS unsigned* st;
};

__device__ __forceinline__ XcdBarrier xcd_barrier_post(unsigned* bar, volatile LAS unsigned* st) {
    XcdBarrier b; b.bar = bar; b.x = xb_xcc_id(); b.st = st;
    if (threadIdx.x == 0) (void)xb_add(&bar[XB_XCNT(b.x)], 1u);
    return b;
}
__device__ __forceinline__ void xcd_barrier_complete(unsigned* bar, unsigned x, unsigned& nloc, unsigned& nx) {
    const unsigned G = gridDim.x * gridDim.y * gridDim.z;
    unsigned sum, cnt, mine, sp = 0u;
    for (;;) {
        sum = 0u; cnt = 0u; mine = 0u;
#pragma unroll
        for (unsigned j = 0; j < 16; ++j) { const unsigned c = xb_ld(&bar[XB_XCNT(j)]); sum += c; cnt += (c > 0u) ? 1u : 0u; mine = (j == x) ? c : mine; }
        if (sum == G) break;
        __builtin_amdgcn_s_sleep(1);
        if ((++sp & 255u) == 0u) { if (xb_ld(&bar[XB_TMO])) break; if (sp > XB_SPIN_CAP) { atomicAdd(&bar[XB_TMO], 1u); break; } }
    }
    nloc = mine > 0u ? mine : 1u; nx = cnt > 0u ? cnt : 1u;
}

__device__ __attribute__((noinline)) void xcd_barrier_impl(unsigned* b_bar, unsigned b_x, volatile LAS unsigned* b_st) {
    XcdBarrier b; b.bar = b_bar; b.x = b_x; b.st = b_st;
    asm volatile("s_waitcnt vmcnt(0)" ::: "memory");
    __syncthreads();
    if (threadIdx.x == 0) {
        unsigned* bar = b.bar;
        __builtin_amdgcn_s_waitcnt(0);
        unsigned nloc = b.st[0], nx = b.st[1];
        if (nloc == 0u) { xcd_barrier_complete(bar, b.x, nloc, nx); b.st[0] = nloc; b.st[1] = nx; }
        const unsigned old = xb_add(&bar[XB_XSUB(b.x)], 1u);
        const unsigned gen = old / nloc;
        if (old + 1u == (gen + 1u) * nloc) {
            __builtin_amdgcn_fence(__ATOMIC_RELEASE, "agent");
            asm volatile("s_waitcnt vmcnt(0)" ::: "memory");
            const unsigned og = xb_add(&bar[XB_TOP], 1u);
            const unsigned tg = og / nx;
            if (og + 1u == (tg + 1u) * nx) xb_add(&bar[XB_TOPGEN], 1u);
            else XB_SPIN(xb_ld(&bar[XB_TOPGEN]) == tg, bar);
            __builtin_amdgcn_fence(__ATOMIC_ACQUIRE, "agent");
            xb_add(&bar[XB_XGEN(b.x)], 1u);
            asm volatile("s_waitcnt vmcnt(0)" ::: "memory");
        } else {
            XB_SPIN(xb_ld(&bar[XB_XGEN(b.x)]) == gen, bar);
            __builtin_amdgcn_fence(__ATOMIC_ACQUIRE, "agent");
            asm volatile("s_waitcnt vmcnt(0)" ::: "memory");
        }
    }
    __syncthreads();
}

struct Args { const float* in[34]; unsigned char* ws; int ph_lo, ph_hi; };
struct Frame {
    LAS unsigned char* lds;
    unsigned* ctl;
    unsigned char* ws;
    int tid, lane, wave, G, bid;
    const struct Args* a; int z;
    unsigned long long pr_acc, pr_t0;
};
__device__ __forceinline__ const float* inp(const Frame& F, int i) { return F.a->in[i + F.z]; }
__device__ __forceinline__ float* outp(const Frame& F) { return (float*)F.a->in[33 + F.z]; }
__device__ __forceinline__ unsigned char* wsp(const Frame& F) { return F.a->ws + F.z; }
enum { I_X = 0, I_C, I_CTX, I_CCTX, I_WADA, I_BADA, I_N1G, I_N2G, I_WIN, I_QG, I_KG, I_SINK, I_HCW, I_HCB, I_FW1, I_FB1, I_FF1, I_FW2, I_FB2, I_FF2, I_FW3, I_HBIAS,
       I_WPA, I_WPH, I_WPF, I_WOUT, I_FG, I_FU, I_FDN, I_ROUTER, I_MG, I_MU, I_MDN };

namespace pg8 {
struct EpiStore {
    static constexpr bool PERM = true, AFTER_DRAIN = false, HOOK = false;
    bf16_t* O; int ldc; int ntn;
    __device__ __forceinline__ void operator()(const f32x4 (&acc)[2][2][4][2], const Unit& u, int wr, int wc, int fr, int fq) const {
        const int row0 = u.pm * BM + wr * 64 + fr, col0 = (u.pn % ntn) * BM + wc * 32 + 8 * fq;
#pragma unroll
        for (int ai = 0; ai < 2; ++ai)
#pragma unroll
            for (int m = 0; m < 4; ++m) { bf16_t* rowp = O + (size_t)(row0 + ai * HALF + m * 16) * ldc + col0;
#pragma unroll
                for (int bj = 0; bj < 2; ++bj) { const f32x4 v0 = acc[ai][bj][m][0], v1 = acc[ai][bj][m][1];
                    u32x4 w; w.x = cvt_pk_bf16(v0[0], v0[1]); w.y = cvt_pk_bf16(v0[2], v0[3]); w.z = cvt_pk_bf16(v1[0], v1[1]); w.w = cvt_pk_bf16(v1[2], v1[3]);
                    *(u32x4*)(rowp + bj * HALF) = w; } }
    }
};
struct EpiIn {
    static constexpr bool PERM = true, AFTER_DRAIN = false, HOOK = false;
    unsigned char* ws; int l;
    __device__ __forceinline__ void operator()(const f32x4 (&acc)[2][2][4][2], const Unit& u, int wr, int wc, int fr_, int fq_) const {
        int fr = fr_, fq = fq_; asm volatile("" : "+v"(fr), "+v"(fq));
        constexpr int ldc = 4864, mt = 16896;
        bf16_t* const O = (bf16_t*)(ws + EPI_WS_PR); bf16_t* const UT = (bf16_t*)(ws + EPI_WS_UT); bf16_t* const VT = (bf16_t*)(ws + EPI_WS_VT); bf16_t* const KT = (bf16_t*)(ws + EPI_WS_KT); bf16_t* const QK = (bf16_t*)(ws + EPI_WS_QK);
        const float* const qg = (const float*)(ws + EPI_WS_QKG) + l * 128; const float* const kg = qg + 64;
        const int row0 = u.pm * BM + wr * 64 + fr, col0 = u.pn * BM + wc * 32 + 8 * fq;
        if (u.pn < 2 || (u.pn == 2 && wc < 2)) {
            const bool isk = (u.pn == 2); const float* gain = isk ? kg : qg; const int lane = fr + 16 * fq; const bool rope = u.pm < 64;
            f32x4 gn[2][2]; float invf[4];
#pragma unroll
            for (int bj = 0; bj < 2; ++bj)
#pragma unroll
                for (int n = 0; n < 2; ++n) gn[bj][n] = *(const f32x4*)(gain + 32 * bj + 16 * n + 4 * fq);
#pragma unroll
            for (int e = 0; e < 4; ++e) invf[e] = exp2f(-(float)(4 * fq + e) * (13.287712379549449f / 16.0f)) * 0.15915494309189535f;
            const float osc = isk ? 1.0f : 0.18033688011112042f;
#pragma unroll
            for (int ai = 0; ai < 2; ++ai)
#pragma unroll
                for (int m = 0; m < 4; ++m) { const int row = row0 + ai * HALF + m * 16;
                    float ss = 0.f;
#pragma unroll
                    for (int bj = 0; bj < 2; ++bj)
#pragma unroll
                        for (int n = 0; n < 2; ++n) { const f32x4 v = acc[ai][bj][m][n]; ss += (v[0] * v[0] + v[1] * v[1]) + (v[2] * v[2] + v[3] * v[3]); }
                    { const unsigned sb = __builtin_bit_cast(unsigned, ss); auto r16 = __builtin_amdgcn_permlane16_swap(sb, sb, false, false);
                      ss = __builtin_bit_cast(float, (unsigned)r16[0]) + __builtin_bit_cast(float, (unsigned)r16[1]);
                      const unsigned sc = __builtin_bit_cast(unsigned, ss); auto r32 = __builtin_amdgcn_permlane32_swap(sc, sc, false, false);
                      ss = __builtin_bit_cast(float, (unsigned)r32[0]) + __builtin_bit_cast(float, (unsigned)r32[1]); }
                    const float rstd = 1.0f / sqrtf(ss * (1.0f / 64.0f) + 1e-6f) * osc;
                    const int t = row & 8191;
#pragma unroll
                    for (int bj = 0; bj < 2; ++bj) { const float pos = (float)(bj == 0 ? (t >> 6) : (t & 63));
                        f32x4 o1, o2;
#pragma unroll
                        for (int e = 0; e < 4; ++e) { float cs = 1.f, sn = 0.f;
                            if (rope) { const float rev = __builtin_amdgcn_fractf(pos * invf[e]); cs = __builtin_amdgcn_cosf(rev); sn = __builtin_amdgcn_sinf(rev); }
                            const float y1 = acc[ai][bj][m][0][e] * rstd * gn[bj][0][e], y2 = acc[ai][bj][m][1][e] * rstd * gn[bj][1][e];
                            o1[e] = y1 * cs - y2 * sn; o2[e] = y1 * sn + y2 * cs; }
                        typedef unsigned u32x2v __attribute__((ext_vector_type(2)));
                        u32x2v w1, w2; w1.x = cvt_pk_bf16(o1[0], o1[1]); w1.y = cvt_pk_bf16(o1[2], o1[3]); w2.x = cvt_pk_bf16(o2[0], o2[1]); w2.y = cvt_pk_bf16(o2[2], o2[3]);
                        if (!isk) { bf16_t* qp = QK + (size_t)row * 640 + (4 * u.pn + wc) * 64 + 32 * bj + 4 * fq; *(u32x2v*)qp = w1; *(u32x2v*)(qp + 16) = w2; }
                        else { bf16_t* kp = KT + (unsigned)(((wc * (mt >> 5) + (row >> 5)) * 4 + 2 * bj) * 512 + (fq >> 1) * 256 + (row & 31) * 8 + 4 * (fq & 1)); *(u32x2v*)kp = w1; *(u32x2v*)(kp + 512) = w2; }
                    }
                    asm volatile("" ::: "memory"); __builtin_amdgcn_sched_barrier(0); }
        } else if (u.pn == 2) {
            bf16_t* vb = VT + (unsigned)(((fr >> 2) & 1) * 256 + ((fr >> 3) & 1) * 4 + (fr & 3) + (u.pm * 8 + wr * 2) * 2048 + (wc - 2) * (mt >> 5) * 2048 + fq * 64);
#pragma unroll
            for (int ai = 0; ai < 2; ++ai)
#pragma unroll
                for (int bj = 0; bj < 2; ++bj)
#pragma unroll
                    for (int m = 0; m < 4; ++m)
#pragma unroll
                        for (int n = 0; n < 2; ++n)
#pragma unroll
                            for (int e = 0; e < 4; ++e) vb[bj * 1024 + ai * 4 * 2048 + (m >> 1) * 2048 + (m & 1) * 512 + (4 * n + e) * 8] = (bf16_t)(cvt_pk_bf16(acc[ai][bj][m][n][e], 0.f) & 0xffffu);
        } else if (u.pn < 7) {
#pragma unroll
            for (int ai = 0; ai < 2; ++ai)
#pragma unroll
                for (int bj = 0; bj < 2; ++bj)
#pragma unroll
                    for (int n = 0; n < 2; ++n)
#pragma unroll
                        for (int e = 0; e < 4; ++e) { bf16_t* cp = UT + (unsigned)((col0 - 768 + bj * HALF + n * 4 + e) * mt + row0 + ai * HALF);
#pragma unroll
                            for (int m = 0; m < 4; ++m) cp[m * 16] = (bf16_t)(cvt_pk_bf16(acc[ai][bj][m][n][e], 0.f) & 0xffffu); }
        } else {
#pragma unroll
            for (int ai = 0; ai < 2; ++ai)
#pragma unroll
                for (int m = 0; m < 4; ++m) { unsigned char* rowp = (unsigned char*)O + (unsigned)(row0 + ai * HALF + m * 16) * 3072u + (unsigned)(col0 - 1792);
#pragma unroll
                    for (int bj = 0; bj < 2; ++bj) { f32x4 v0 = acc[ai][bj][m][0], v1 = acc[ai][bj][m][1];
#pragma unroll
                        for (int e = 0; e < 4; ++e) { v0[e] = fmaxf(__builtin_floorf(255.0f * __builtin_amdgcn_rcpf(1.0f + __expf(-v0[e])) + 0.5f), 1.0f); v1[e] = fmaxf(__builtin_floorf(255.0f * __builtin_amdgcn_rcpf(1.0f + __expf(-v1[e])) + 0.5f), 1.0f); }
                        typedef unsigned u32x2v __attribute__((ext_vector_type(2))); u32x2v w; w.x = 0u; w.y = 0u;
                        w.x = __builtin_amdgcn_cvt_pk_u8_f32(v0[0], 0, w.x); w.x = __builtin_amdgcn_cvt_pk_u8_f32(v0[1], 1, w.x); w.x = __builtin_amdgcn_cvt_pk_u8_f32(v0[2], 2, w.x); w.x = __builtin_amdgcn_cvt_pk_u8_f32(v0[3], 3, w.x);
                        w.y = __builtin_amdgcn_cvt_pk_u8_f32(v1[0], 0, w.y); w.y = __builtin_amdgcn_cvt_pk_u8_f32(v1[1], 1, w.y); w.y = __builtin_amdgcn_cvt_pk_u8_f32(v1[2], 2, w.y); w.y = __builtin_amdgcn_cvt_pk_u8_f32(v1[3], 3, w.y);
                        *(u32x2v*)(rowp + bj * HALF) = w; } }
        }
    }
};
struct EpiSwiglu {
    static constexpr bool PERM = true, AFTER_DRAIN = false, HOOK = false;
    bf16_t* O; int ldc; int ntn;
    __device__ __forceinline__ void operator()(const f32x4 (&acc)[2][2][4][2], const Unit& u, int wr, int wc, int fr, int fq) const {
        const int row0 = u.pm * BM + wr * 64 + fr, col0 = (u.pn % ntn) * HALF + wc * 32 + 8 * fq;
#pragma unroll
        for (int ai = 0; ai < 2; ++ai)
#pragma unroll
            for (int m = 0; m < 4; ++m) { bf16_t* rowp = O + (size_t)(row0 + ai * HALF + m * 16) * ldc + col0;
                float h[8];
#pragma unroll
                for (int n = 0; n < 2; ++n)
#pragma unroll
                    for (int e = 0; e < 4; ++e) { const float g = acc[ai][0][m][n][e], uu = acc[ai][1][m][n][e]; h[n * 4 + e] = g * __builtin_amdgcn_rcpf(1.0f + __expf(-g)) * uu; }
                u32x4 w; w.x = cvt_pk_bf16(h[0], h[1]); w.y = cvt_pk_bf16(h[2], h[3]); w.z = cvt_pk_bf16(h[4], h[5]); w.w = cvt_pk_bf16(h[6], h[7]);
                *(u32x4*)rowp = w; }
    }
};
struct EpiMerge {
    static constexpr bool PERM = true, AFTER_DRAIN = false, HOOK = true;
    const unsigned char* G8  ; bf16_t* Mo;
    __device__ __forceinline__ bool hook_at(int t) const { return t == 8 || t == 12; }
    __device__ __forceinline__ static void ld8(const unsigned char* p, float (&g)[8]) { typedef unsigned u32x2v __attribute__((ext_vector_type(2))); const u32x2v w = *(const u32x2v*)p;
        g[0] = (float)(w.x & 0xffu); g[1] = (float)((w.x >> 8) & 0xffu); g[2] = (float)((w.x >> 16) & 0xffu); g[3] = (float)(w.x >> 24);
        g[4] = (float)(w.y & 0xffu); g[5] = (float)((w.y >> 8) & 0xffu); g[6] = (float)((w.y >> 16) & 0xffu); g[7] = (float)(w.y >> 24); }
    __device__ __forceinline__ void hook(f32x4 (&acc)[2][2][4][2], const Unit& u, int t, int wr, int wc, int fr, int fq) const {
        const int col0 = u.pn * BM + wc * 32 + 8 * fq; const int ga = t == 8 ? 0 : 1;
#pragma unroll
        for (int ai = 0; ai < 2; ++ai)
#pragma unroll
            for (int m = 0; m < 4; ++m) { const int r = u.pm * BM + ai * HALF + wr * 64 + m * 16 + fr; const unsigned char* gp = G8 + (unsigned)r * 3072u + (unsigned)(ga * 1024 + col0);
#pragma unroll
                for (int bj = 0; bj < 2; ++bj) { float sa[8], sb[8]; ld8(gp + bj * HALF, sa); ld8(gp + 1024 + bj * HALF, sb);
#pragma unroll
                    for (int e = 0; e < 4; ++e) { acc[ai][bj][m][0][e] *= sa[e] * __builtin_amdgcn_rcpf(sb[e]); acc[ai][bj][m][1][e] *= sa[4 + e] * __builtin_amdgcn_rcpf(sb[4 + e]); } } }
    }
    __device__ __forceinline__ void operator()(const f32x4 (&acc)[2][2][4][2], const Unit& u, int wr, int wc, int fr, int fq) const {
        const int col0 = u.pn * BM + wc * 32 + 8 * fq;
#pragma unroll
        for (int ai = 0; ai < 2; ++ai)
#pragma unroll
            for (int m = 0; m < 4; ++m) { const int r = u.pm * BM + ai * HALF + wr * 64 + m * 16 + fr; const unsigned char* gp = G8 + (unsigned)r * 3072u + (unsigned)(2048 + col0);
#pragma unroll
                for (int bj = 0; bj < 2; ++bj) { float s2[8]; ld8(gp + bj * HALF, s2); const f32x4 v0 = acc[ai][bj][m][0] * (1.0f / 255.0f), v1 = acc[ai][bj][m][1] * (1.0f / 255.0f);
                    u32x4 w; w.x = cvt_pk_bf16(v0[0] * s2[0], v0[1] * s2[1]); w.y = cvt_pk_bf16(v0[2] * s2[2], v0[3] * s2[3]); w.z = cvt_pk_bf16(v1[0] * s2[4], v1[1] * s2[5]); w.w = cvt_pk_bf16(v1[2] * s2[6], v1[3] * s2[7]);
                    *(u32x4*)(Mo + (size_t)r * 1024 + col0 + bj * HALF) = w; } }
    }
};
struct EpiResid {
    static constexpr bool PERM = false, AFTER_DRAIN = false, HOOK = false;
    bf16_t* xs  ; const float* gate  ;
    __device__ __forceinline__ void operator()(const f32x4 (&acc)[2][2][4][2], const Unit& u, int wr, int wc, int fr, int fq) const {
        const int col0 = u.pn * BM + wc * 32 + 4 * fq;
        const int cond = u.pm >> 5;
        const float* gp = gate + cond * 6144;
        f32x4 gv[2][2];
#pragma unroll
        for (int bj = 0; bj < 2; ++bj)
#pragma unroll
            for (int n = 0; n < 2; ++n) gv[bj][n] = *(const f32x4*)(gp + col0 + bj * HALF + n * 16);
        typedef unsigned u32x2v __attribute__((ext_vector_type(2)));
#pragma unroll
        for (int ai = 0; ai < 2; ++ai)
#pragma unroll
            for (int m = 0; m < 4; ++m) { const int r = u.pm * BM + ai * HALF + wr * 64 + m * 16 + fr;
#pragma unroll
                for (int bj = 0; bj < 2; ++bj)
#pragma unroll
                    for (int n = 0; n < 2; ++n) { const unsigned off = (unsigned)r * 1024u + (unsigned)(col0 + bj * HALF + n * 16);
                        const u32x2v xw = *(const u32x2v*)(xs + off);
                        f32x4 xv; xv[0] = __builtin_bit_cast(float, xw.x << 16); xv[1] = __builtin_bit_cast(float, xw.x & 0xffff0000u); xv[2] = __builtin_bit_cast(float, xw.y << 16); xv[3] = __builtin_bit_cast(float, xw.y & 0xffff0000u);
                        const f32x4 y = xv + gv[bj][n] * acc[ai][bj][m][n];
                        u32x2v o; o.x = cvt_pk_bf16(y[0], y[1]); o.y = cvt_pk_bf16(y[2], y[3]);
                        *(u32x2v*)(xs + off) = o; } }
    }
};
struct MoeOrder {
    int ntn, G, c; const PG8_LAS int* poff; const PG8_LAS unsigned* gtab;
    __device__ __forceinline__ bool next(int i, Unit& u) const {
        const int L = i * G + c; const int np = __builtin_amdgcn_readfirstlane(poff[8]);
        if (L >= np * ntn) return false;
        const int p = L / ntn, t = L - p * ntn; int e = 0;
#pragma unroll
        for (int k = 1; k < 8; ++k) e += (p >= __builtin_amdgcn_readfirstlane(poff[k])) ? 1 : 0;
        u.pm = p; u.pn = e * ntn + t; return true;
    }
    __device__ __forceinline__ void a_ready(const Unit&) const {}
    __device__ __forceinline__ void done(const Unit&) const {}
};
}

struct TrDesc { const float* W; bf16* WT; int K, N, map, ldk, koff, item; bool skip; };
__device__ __forceinline__ void tr_load(const TrDesc& d, float (&tv)[32], int lane) {
    if (d.skip) return;
    const int nblk = d.N / 32, kb = d.item / nblk, nb = d.item % nblk, k0 = 64 * kb, n0 = 32 * nb;
#pragma unroll
    for (int i = 0; i < 32; ++i) tv[i] = d.W[(size_t)(k0 + 2 * i + (lane >> 5)) * d.N + n0 + (lane & 31)];
}
__device__ __forceinline__ void tr_finish(const TrDesc& d, const float (&tv)[32], LAS float* scr, int lane) {
    if (d.skip) return;
    const int nblk = d.N / 32, kb = d.item / nblk, nb = d.item % nblk, k0 = 64 * kb, n0 = 32 * nb;
#pragma unroll
    for (int i = 0; i < 32; ++i) scr[(2 * i + (lane >> 5)) * 33 + (lane & 31)] = tv[i];
    LDS_WAIT(); asm volatile("" ::: "memory");
    const int c = lane & 7;
#pragma unroll
    for (int j = 0; j < 4; ++j) { const int n = (lane >> 3) + 8 * j; const LAS float* s = scr + (8 * c) * 33 + n;
        v4u o; o.x = pk2(s[0 * 33], s[1 * 33]); o.y = pk2(s[2 * 33], s[3 * 33]); o.z = pk2(s[4 * 33], s[5 * 33]); o.w = pk2(s[6 * 33], s[7 * 33]);
        const int nn = n0 + n; int drow;
        if (d.map == 0) drow = nn;
        else if (d.map == 3) {
            if (nn < 640) { const int head = nn >> 6, dd = nn & 63, a = dd >> 5, hf = (dd >> 4) & 1, f = dd & 15; const int tile = head < 8 ? (head >> 2) : 2, wcc = head < 8 ? (head & 3) : (head - 8);
                drow = tile * 256 + 128 * a + 32 * wcc + 8 * (f >> 2) + 4 * hf + (f & 3); }
            else if (nn < 768) { const int vh = (nn - 640) >> 6, dd = nn & 63; drow = 512 + 128 * (dd >> 5) + 32 * (2 + vh) + (dd & 31); }
            else drow = nn; }
        else drow = (nn >> 7) * 256 + (nn & 127) + (d.map == 2 ? 128 : 0);
        *(v4u*)(d.WT + (size_t)drow * d.ldk + d.koff + k0 + 8 * c) = o; }
    LDS_WAIT(); asm volatile("" ::: "memory");
}
#define TR_GROUP(SRC, DST, CNT, KK, NN, MAP, DSTRIDE, LDK, KOFF) if (!found) { constexpr int per = ((KK) / 64) * ((NN) / 32); constexpr int tot = (CNT) * per; \
    if (r < tot) { const int mi = r / per; d.W = (SRC) + (size_t)mi * (KK) * (NN); d.WT = (DST) + (size_t)mi * (DSTRIDE); d.K = (KK); d.N = (NN); d.map = (MAP); d.ldk = (LDK); d.koff = (KOFF); d.item = r % per; found = true; } else r -= tot; }
__device__ __forceinline__ TrDesc tr_decode(Frame& F, int it) {
    TrDesc d; d.W = nullptr; d.WT = nullptr; d.K = 64; d.N = 32; d.map = 0; d.ldk = 64; d.koff = 0; d.item = 0; d.skip = false;
    int r = it; bool found = false;
    TR_GROUP(inp(F, I_WIN), ((bf16*)(wsp(F) + WS_WIN)), 4, 1024, 4864, 3, (size_t)4864 * 1024, 1024, 0)
    if (found && d.N == 4864) { const int nb = d.item % 152; d.skip = (nb >= 48 && nb < 56); }
    TR_GROUP(inp(F, I_WPA), ((bf16*)(wsp(F) + WS_WPA)), 4, 512, 1024, 0, (size_t)1024 * 1024, 1024, 0)
    TR_GROUP(inp(F, I_WPH), ((bf16*)(wsp(F) + WS_WPA)), 4, 256, 1024, 0, (size_t)1024 * 1024, 1024, 512)
    TR_GROUP(inp(F, I_WPF), ((bf16*)(wsp(F) + WS_WPA)), 4, 256, 1024, 0, (size_t)1024 * 1024, 1024, 768)
    TR_GROUP(inp(F, I_WOUT), ((bf16*)(wsp(F) + WS_WO)), 4, 1024, 1024, 0, (size_t)1024 * 1024, 1024, 0)
    TR_GROUP(inp(F, I_FG), ((bf16*)(wsp(F) + WS_FGU)), 2, 1024, 2816, 1, (size_t)5632 * 1024, 1024, 0)
    TR_GROUP(inp(F, I_FU), ((bf16*)(wsp(F) + WS_FGU)), 2, 1024, 2816, 2, (size_t)5632 * 1024, 1024, 0)
    TR_GROUP(inp(F, I_FDN), ((bf16*)(wsp(F) + WS_FD)), 2, 2816, 1024, 0, (size_t)1024 * 2816, 2816, 0)
    TR_GROUP(inp(F, I_MG), ((bf16*)(wsp(F) + WS_MGU)), 16, 1024, 2816, 1, (size_t)5632 * 1024, 1024, 0)
    TR_GROUP(inp(F, I_MU), ((bf16*)(wsp(F) + WS_MGU)), 16, 1024, 2816, 2, (size_t)5632 * 1024, 1024, 0)
    TR_GROUP(inp(F, I_MDN), ((bf16*)(wsp(F) + WS_MD)), 16, 2816, 1024, 0, (size_t)1024 * 2816, 2816, 0)
    return d;
}

__device__ __forceinline__ void phase_prologue(Frame& F) {
    constexpr int TOT_ITEMS = 4 * (16 * 152 + 8 * 32 + 4 * 32 + 4 * 32 + 16 * 32) + 2 * (16 * 88 * 2 + 44 * 32) + 16 * (16 * 88 * 2 + 44 * 32);
    constexpr int PER_BLOCK = (TOT_ITEMS + 255) / 256;
    LAS float* scr = (LAS float*)(F.lds + F.wave * 8448);
    LAS float* tl = (LAS float*)(F.lds + 8 * 8448);
    LAS float* sl = (LAS float*)(F.lds + 8 * 8448 + 17152);
    LAS int* ctr = (LAS int*)(F.lds + 8 * 8448 + 17152 + 12288);
    for (int i = F.tid; i < 3072; i += NTHREADS) { const float cv = i < 2048 ? inp(F, I_C)[i] : inp(F, I_CCTX)[i - 2048]; sl[i] = cv * sigmoidf_(cv); }
    if (F.tid == 0) ctr[0] = 0;
    if (F.bid == 0) { for (int i = F.tid; i < 512; i += NTHREADS) { const int ll = i >> 7, j = i & 127; ((float*)(wsp(F) + WS_CTL) + CW_QKG)[i] = j < 64 ? inp(F, I_QG)[ll * 64 + j] : inp(F, I_KG)[ll * 64 + j - 64]; } }
    __syncthreads();
    if (F.wave >= 6) {
        for (int it = (F.wave - 6) * F.G + F.bid; it < 4 * 96; it += 2 * F.G) {
            const int l = it / 96, cb = it % 96;
            const float* W = inp(F, I_WADA) + (size_t)l * 1024 * 6144 + cb * 64 + F.lane;
            float a0 = 0.f, a1 = 0.f, a2 = 0.f;
#pragma unroll 16
            for (int k = 0; k < 1024; ++k) { const float w = W[(size_t)k * 6144]; a0 += w * sl[k]; a1 += w * sl[1024 + k]; a2 += w * sl[2048 + k]; }
            const float bb = inp(F, I_BADA)[l * 6144 + cb * 64 + F.lane];
            float* mo = ((float*)(wsp(F) + WS_CTL) + CW_MOD) + (size_t)l * 3 * 6144 + cb * 64 + F.lane;
            mo[0] = a0 + bb; mo[6144] = a1 + bb; mo[2 * 6144] = a2 + bb;
        }
    } else if (F.wave == 5) {
        LAS float* ctab = tl + 64 * 65; LAS float* stab = ctab + 64;
        ctab[F.lane] = cos_rev((float)F.lane * (1.0f / 64.0f)); stab[F.lane] = sin_rev((float)F.lane * (1.0f / 64.0f));
        for (int it = F.bid; it < 4 * 16 * 4; it += F.G) {
            const int l = it >> 6, kb = (it >> 2) & 15, g = it & 3;
            const float* W = inp(F, I_WIN) + (size_t)l * 1024 * 4864 + (size_t)(kb * 64) * 4864 + 1536 + g * 64;
#pragma unroll 8
            for (int kk = 0; kk < 64; ++kk) tl[kk * 65 + F.lane] = W[(size_t)kk * 4864 + F.lane];
            LDS_WAIT(); asm volatile("" ::: "memory");
            bf16* dst = ((bf16*)(wsp(F) + WS_WIN)) + (size_t)l * 4864 * 1024 + (size_t)(1536 + g * 64) * 1024 + kb * 64 + F.lane;
            for (int j = 0; j < 64; ++j) {
                const int mm = j <= 32 ? j : j - 32; float a = 0.f;
                if (j <= 32) { for (int c = 0; c < 64; ++c) a += tl[F.lane * 65 + c] * ctab[(mm * c) & 63]; }
                else { for (int c = 0; c < 64; ++c) a += tl[F.lane * 65 + c] * stab[(mm * c) & 63]; }
                dst[(size_t)j * 1024] = (bf16)f2bf(a);
            }
            LDS_WAIT(); asm volatile("" ::: "memory");
        }
    }
    {
        const int ib = F.bid * PER_BLOCK, ie = (ib + PER_BLOCK) < TOT_ITEMS ? (ib + PER_BLOCK) : TOT_ITEMS;
        int it = ib + __builtin_amdgcn_readfirstlane(F.lane == 0 ? atomicAdd((int*)ctr, 1) : 0);
        if (it < ie) {
            TrDesc cur = tr_decode(F, it); float tv[32], tn[32];
            tr_load(cur, tv, F.lane);
            for (;;) {
                const int itn = ib + __builtin_amdgcn_readfirstlane(F.lane == 0 ? atomicAdd((int*)ctr, 1) : 0);
                TrDesc nxt = cur; const bool more = itn < ie;
                if (more) { nxt = tr_decode(F, itn); tr_load(nxt, tn, F.lane); }
                tr_finish(cur, tv, scr, F.lane);
                if (!more) break;
                cur = nxt;
#pragma unroll
                for (int i = 0; i < 32; ++i) tv[i] = tn[i];
            }
        }
    }
}

__device__ __forceinline__ void moe_offsets(Frame& F, int l, LAS int* poff) {
    if (F.tid == 0) { const unsigned* cnt = (const unsigned*)(wsp(F) + WS_CTL) + CW_CNT + l * 64; int o = 0;
        for (int e = 0; e < 8; ++e) { poff[e] = o; o += (int)((__hip_atomic_load(cnt + e, __ATOMIC_RELAXED, __HIP_MEMORY_SCOPE_AGENT) + 255u) >> 8); } poff[8] = o; }
    __syncthreads();
}
template <bool XB> struct NormRaw { typedef f32x4 T; };
template <> struct NormRaw<true> { typedef v2u T; };
__device__ __forceinline__ f32x4 norm_cvt(const f32x4 a) { return a; }
__device__ __forceinline__ f32x4 norm_cvt(const v2u a) { f32x4 r; r[0] = bflo(a.x); r[1] = bfhi(a.x); r[2] = bflo(a.y); r[3] = bfhi(a.y); return r; }
template <bool ROUTER, bool COMBINE, bool NORM, bool XB = true>
__device__ __forceinline__ void phase_norm(Frame& F, int l, const float* xlat, const float* xctx, const float* g, int moff, const float* wr, int nrows, int skipb = 0) {
    const int gw = (F.bid - skipb) * NWAVES + F.wave + (F.bid < skipb ? (1 << 28) : 0), NGW = (F.G - skipb) * NWAVES;
    const float* mod = ((float*)(wsp(F) + WS_CTL) + CW_MOD) + (size_t)l * 3 * 6144 + moff;
    LAS int* lcnt = (LAS int*)(F.lds + LDS_TAB);
    LAS float* wrl = (LAS float*)F.lds;
    unsigned* info_all = (unsigned*)(wsp(F) + WS_COMB);
    if (ROUTER) { if (F.tid < 16) lcnt[F.tid] = 0;
        for (int i = F.tid; i < 2048; i += NTHREADS) { const int c = i >> 1, hf = i & 1; *(LAS f32x4*)(wrl + 4 * (hf * 1024 + (((c >> 8) * 4 + (c & 3)) * 64 + ((c >> 2) & 63)))) = *(const f32x4*)(wr + 4 * i); }
        __syncthreads(); }
    LAS int* cpoff = (LAS int*)(F.lds + LDS_TAB + 64);
    if (COMBINE) moe_offsets(F, l - (NORM ? 1 : 0), cpoff);
    f32x4 gg[4], s1[4], s0[4]; int cur_cond = -1;
    if (NORM) {
#pragma unroll
        for (int j = 0; j < 4; ++j) gg[j] = *(const f32x4*)(g + 256 * j + 4 * F.lane);
    }
    typedef typename NormRaw<XB>::T RawT;
    bf16* const XS = (bf16*)(wsp(F) + WS_XS);
    f32x4 v[4]; RawT vn[4], vn2[4];
#define NORM_LOADROW(DST, rr_) { if (XB) { const bf16* xr = XS + (size_t)(rr_) * 1024; _Pragma("unroll") for (int j = 0; j < 4; ++j) DST[j] = *(const RawT*)(xr + 256 * j + 4 * F.lane); } \
        else { const float* xr = (rr_) >= ML ? xctx + (size_t)((rr_) - ML) * 1024 : xlat + (size_t)(rr_) * 1024; _Pragma("unroll") for (int j = 0; j < 4; ++j) DST[j] = *(const RawT*)(xr + 256 * j + 4 * F.lane); } }
    if (gw < nrows) NORM_LOADROW(vn, gw)
    if (gw + NGW < nrows) NORM_LOADROW(vn2, gw + NGW)
    for (int r = gw; r < nrows; r += NGW) {
        const bool isctx = r >= ML; const int cond = isctx ? 2 : (r >> 13);
#pragma unroll
        for (int j = 0; j < 4; ++j) { v[j] = norm_cvt(vn[j]); vn[j] = vn2[j]; }
        { const int rn = r + 2 * NGW; if (rn < nrows) NORM_LOADROW(vn2, rn) }
        if (!XB) {
#pragma unroll
            for (int j = 0; j < 4; ++j) { v2u o; o.x = pk2(v[j][0], v[j][1]); o.y = pk2(v[j][2], v[j][3]); *(v2u*)(XS + (size_t)r * 1024 + 256 * j + 4 * F.lane) = o; }
        }
        float s = 0.f;
        if (COMBINE) {
            const unsigned* info = info_all + (size_t)r * 8;
            const float w0 = __builtin_bit_cast(float, info[2]), w1 = __builtin_bit_cast(float, info[3]);
            const bf16* y0 = ((const bf16*)(wsp(F) + WS_Y)) + (size_t)(256 * cpoff[info[0]] + (int)info[4]) * 1024; const bf16* y1 = ((const bf16*)(wsp(F) + WS_Y)) + (size_t)(256 * cpoff[info[1]] + (int)info[5]) * 1024;
            const float* gt = ((float*)(wsp(F) + WS_CTL) + CW_MOD) + (size_t)(l - (NORM ? 1 : 0)) * 3 * 6144 + 5120 + cond * 6144;
#pragma unroll
            for (int j = 0; j < 4; ++j) { const int c = 256 * j + 4 * F.lane;
                const v2u a = *(const v2u*)(y0 + c), b = *(const v2u*)(y1 + c); const f32x4 gtv = *(const f32x4*)(gt + c);
                v[j][0] += gtv[0] * (w0 * bflo(a.x) + w1 * bflo(b.x)); v[j][1] += gtv[1] * (w0 * bfhi(a.x) + w1 * bfhi(b.x));
                v[j][2] += gtv[2] * (w0 * bflo(a.y) + w1 * bflo(b.y)); v[j][3] += gtv[3] * (w0 * bfhi(a.y) + w1 * bfhi(b.y));
                if (NORM) { v2u o; o.x = pk2(v[j][0], v[j][1]); o.y = pk2(v[j][2], v[j][3]); *(v2u*)(XS + (size_t)r * 1024 + c) = o; }
                else *(f32x4*)(outp(F) + (size_t)r * 1024 + c) = v[j]; }
        }
        if (!NORM) continue;
        if (cond != cur_cond) { cur_cond = cond; const float* sh = mod + cond * 6144; const float* sc = sh + 1024;
#pragma unroll
            for (int j = 0; j < 4; ++j) { s1[j] = *(const f32x4*)(sc + 256 * j + 4 * F.lane); s0[j] = *(const f32x4*)(sh + 256 * j + 4 * F.lane); } }
#pragma unroll
        for (int j = 0; j < 4; ++j) s += (v[j][0] * v[j][0] + v[j][1] * v[j][1]) + (v[j][2] * v[j][2] + v[j][3] * v[j][3]);
        const float rstd = 1.0f / sqrtf(wave_sum(s, F.lane) * (1.0f / 1024.0f) + EPS);
        float lg[8];
        if (ROUTER) {
#pragma unroll
            for (int e = 0; e < 8; ++e) lg[e] = 0.f;
        }
#pragma unroll
        for (int j = 0; j < 4; ++j) { const int c = 256 * j + 4 * F.lane;
            f32x4 y;
#pragma unroll
            for (int e = 0; e < 4; ++e) y[e] = (v[j][e] * rstd * gg[j][e]) * (1.0f + s1[j][e]) + s0[j][e];
            v2u o; o.x = pk2(y[0], y[1]); o.y = pk2(y[2], y[3]);
            *(v2u*)(((bf16*)(wsp(F) + WS_H)) + (size_t)r * 1024 + c) = o;
            if (ROUTER) {
#pragma unroll
                for (int e = 0; e < 4; ++e) { const f32x4 w0 = *(LAS f32x4*)(wrl + 4 * ((j * 4 + e) * 64 + F.lane)), w1 = *(LAS f32x4*)(wrl + 4 * (1024 + (j * 4 + e) * 64 + F.lane));
                    lg[0] += y[e] * w0[0]; lg[1] += y[e] * w0[1]; lg[2] += y[e] * w0[2]; lg[3] += y[e] * w0[3];
                    lg[4] += y[e] * w1[0]; lg[5] += y[e] * w1[1]; lg[6] += y[e] * w1[2]; lg[7] += y[e] * w1[3]; }
            }
        }
        if (ROUTER) {
#pragma unroll
            for (int e = 0; e < 8; ++e) lg[e] = wave_sum(lg[e], F.lane);
            int i0 = 0; float v0 = lg[0];
#pragma unroll
            for (int e = 1; e < 8; ++e) if (lg[e] > v0) { v0 = lg[e]; i0 = e; }
            int i1 = -1; float v1 = -INFINITY;
#pragma unroll
            for (int e = 0; e < 8; ++e) if (e != i0 && lg[e] > v1) { v1 = lg[e]; i1 = e; }
            const float w0 = 1.0f / (1.0f + __expf(v1 - v0)), w1 = 1.0f - w0;
            if (F.lane == 0) { const int p0 = atomicAdd((int*)(lcnt + i0), 1), p1 = atomicAdd((int*)(lcnt + i1), 1);
                unsigned* info = info_all + (size_t)r * 8;
                info[0] = (unsigned)i0; info[1] = (unsigned)i1; info[2] = __builtin_bit_cast(unsigned, w0); info[3] = __builtin_bit_cast(unsigned, w1); info[4] = (unsigned)p0; info[5] = (unsigned)p1; }
        }
    }
    if (ROUTER) {
        asm volatile("s_waitcnt vmcnt(0) lgkmcnt(0)" ::: "memory");
        __syncthreads();
        if (F.tid < 8) { unsigned* cnt = (unsigned*)(wsp(F) + WS_CTL) + CW_CNT + l * 64; lcnt[8 + F.tid] = (int)__hip_atomic_fetch_add(cnt + F.tid, (unsigned)lcnt[F.tid], __ATOMIC_RELAXED, __HIP_MEMORY_SCOPE_AGENT); }
        __syncthreads();
        for (int r = gw; r < nrows; r += NGW) { if (F.lane < 2) { unsigned* info = info_all + (size_t)r * 8; const int e = (int)info[F.lane]; const unsigned pos = info[4 + F.lane] + (unsigned)lcnt[8 + e]; info[4 + F.lane] = pos;
            ((unsigned*)(wsp(F) + WS_TOKE))[(size_t)e * MT + pos] = (unsigned)r; } }
    }
}

#undef NORM_LOADROW
__device__ __forceinline__ void phase_gather(Frame& F, int l) {
    LAS int* poff = (LAS int*)(F.lds + LDS_TAB + 64);
    moe_offsets(F, l, poff);
    const int gw = F.bid * NWAVES + F.wave, NGW = F.G * NWAVES;
    unsigned* info_all = (unsigned*)(wsp(F) + WS_COMB);
    for (int it = gw; it < MT * 2; it += NGW) {
        const int tok = it >> 1, k = it & 1; unsigned* info = info_all + (size_t)tok * 8;
        const int e = (int)info[k], pos = (int)info[4 + k]; const int grow = 256 * poff[e] + pos;
        if (F.lane == 0) info[6 + k] = (unsigned)grow;
        const v4u* s = (const v4u*)(((const bf16*)(wsp(F) + WS_H)) + (size_t)tok * 1024); v4u* d = (v4u*)(((bf16*)(wsp(F) + WS_XG)) + (size_t)grow * 1024);
        d[F.lane] = s[F.lane]; d[64 + F.lane] = s[64 + F.lane];
    }
}

__device__ __forceinline__ void filter_tile(Frame& F, int l, int L, int p0, float* dst  , bool stage) {
    LAS float* emb = (LAS float*)F.lds;
    LAS float* h1 = emb + 32 * 33;
    LAS float* h2 = h1 + 32 * 65;
    LAS float* w1s = h2 + 32 * 65;
    LAS float* w2s = w1s + 33 * 64;
    const float* w1 = inp(F, I_FW1) + l * 33 * 64; const float* b1 = inp(F, I_FB1) + l * 64; const float* f1 = inp(F, I_FF1) + l * 64;
    const float* w2 = inp(F, I_FW2) + l * 64 * 64; const float* b2 = inp(F, I_FB2) + l * 64; const float* f2 = inp(F, I_FF2) + l * 64;
    const float* w3 = inp(F, I_FW3) + (size_t)l * 64 * 1024;
    float awA[32], awB[32];
#define FILT_LOADW(AW, blk_) { unsigned vo_ = (unsigned)((F.lane >> 5) * 8192 + (blk_) * 32 + (F.lane & 31)); asm volatile("" : "+v"(vo_)); _Pragma("unroll") for (int s = 0; s < 32; ++s) AW[s] = (w3 + (size_t)(16 * (s >> 3) + (s & 7)) * 1024)[vo_]; }
    FILT_LOADW(awA, F.wave) __builtin_amdgcn_sched_barrier(0);
    if (stage) {
        const f32x4 sa = *(const f32x4*)(w1 + 4 * F.tid), sb = *(const f32x4*)(w2 + 4 * F.tid), sc = *(const f32x4*)(w2 + 4 * (F.tid + NTHREADS));
        f32x4 sd = sa; if (F.tid < 16) sd = *(const f32x4*)(w1 + 4 * (F.tid + NTHREADS));
        *(LAS f32x4*)(w1s + 4 * F.tid) = sa; *(LAS f32x4*)(w2s + 4 * F.tid) = sb; *(LAS f32x4*)(w2s + 4 * (F.tid + NTHREADS)) = sc;
        if (F.tid < 16) *(LAS f32x4*)(w1s + 4 * (F.tid + NTHREADS)) = sd;
    }
    for (int idx = F.tid; idx < 32 * 33; idx += NTHREADS) {
        const int pos = idx / 33, f = idx % 33, i = p0 + pos;
        float val;
        if (f == 0) val = (float)i / (float)(L - 1);
        else { const int j = (f - 1) & 15; const float fb = 1e-4f + (float)j * ((15.0f - 1e-4f) / 15.0f); const float rev = fb * (float)i / (float)L;
               val = (f <= 16) ? cos_rev(rev) : -sin_rev(rev); }
        emb[pos * 33 + f] = val;
    }
    __syncthreads();
    { const int pos = F.tid >> 4, u0 = (F.tid & 15) * 4;
      f32x4 a = *(const f32x4*)(b1 + u0);
#pragma unroll 11
      for (int f = 0; f < 33; ++f) a += emb[pos * 33 + f] * *(LAS f32x4*)(w1s + f * 64 + u0);
      const f32x4 fr = *(const f32x4*)(f1 + u0);
#pragma unroll
      for (int e = 0; e < 4; ++e) h1[pos * 65 + u0 + e] = sin_rev(fr[e] * a[e] * INV_2PI);
    }
    __syncthreads();
    { const int pos = F.tid >> 4, u0 = (F.tid & 15) * 4;
      f32x4 a = *(const f32x4*)(b2 + u0);
#pragma unroll 16
      for (int f = 0; f < 64; ++f) a += h1[pos * 65 + f] * *(LAS f32x4*)(w2s + f * 64 + u0);
      const f32x4 fr = *(const f32x4*)(f2 + u0);
#pragma unroll
      for (int e = 0; e < 4; ++e) h2[pos * 65 + u0 + e] = sin_rev(fr[e] * a[e] * INV_2PI);
    }
    __syncthreads();
    { const int r = F.lane & 31, h = F.lane >> 5;
      typedef float f32x16_t __attribute__((ext_vector_type(16))); typedef short bf16x8_t __attribute__((ext_vector_type(8)));
      const int i = p0 + r; const float t = (float)i / (float)(L - 1);
#define FILT_SPLIT(X, HI, LO) { v4u hi_, lo_; \
        _Pragma("unroll") for (int p = 0; p < 4; ++p) { const float x0 = (X)[2 * p], x1 = (X)[2 * p + 1]; const unsigned hw = pg8::cvt_pk_bf16(x0, x1); hi_[p] = hw; lo_[p] = pg8::cvt_pk_bf16(x0 - bflo(hw), x1 - bfhi(hw)); } \
        HI = __builtin_bit_cast(bf16x8_t, hi_); LO = __builtin_bit_cast(bf16x8_t, lo_); }
      bf16x8_t bh[4], bl[4];
#pragma unroll
      for (int kk = 0; kk < 4; ++kk) { float hv[8];
#pragma unroll
          for (int e = 0; e < 8; ++e) hv[e] = h2[r * 65 + 16 * kk + 8 * h + e];
          FILT_SPLIT(hv, bh[kk], bl[kk]) }
#define FILT_BLOCK(AW, blk_) { int c0 = (blk_) * 32; asm volatile("" : "+v"(c0)); f32x16_t acc;        \
        _Pragma("unroll") for (int q = 0; q < 16; ++q) acc[q] = 0.f; \
        _Pragma("unroll") for (int kk = 0; kk < 4; ++kk) { bf16x8_t ah_, al_; FILT_SPLIT((AW + 8 * kk), ah_, al_) \
            acc = __builtin_amdgcn_mfma_f32_32x32x16_bf16(al_, bh[kk], acc, 0, 0, 0); acc = __builtin_amdgcn_mfma_f32_32x32x16_bf16(ah_, bl[kk], acc, 0, 0, 0); acc = __builtin_amdgcn_mfma_f32_32x32x16_bf16(ah_, bh[kk], acc, 0, 0, 0); } \
        _Pragma("unroll") for (int q = 0; q < 16; ++q) { const int col = c0 + (q & 3) + 8 * (q >> 2) + 4 * h; const int ch = col & 255; \
            const float delta = 3.0701134573253946f + 12.280453829301578f * ((float)ch * (1.0f / 255.0f)); \
            dst[(size_t)col * L + i] = acc[q] * __expf(-t * delta); } }
#pragma unroll 1
      for (int jj = 0; jj < 2; ++jj) {
          FILT_LOADW(awB, F.wave + 8 * (2 * jj + 1)) __builtin_amdgcn_sched_barrier(0); FILT_BLOCK(awA, F.wave + 16 * jj) __builtin_amdgcn_sched_barrier(0);
          FILT_LOADW(awA, F.wave + 8 * ((2 * jj + 2) & 3)) __builtin_amdgcn_sched_barrier(0); FILT_BLOCK(awB, F.wave + 8 * (2 * jj + 1)) __builtin_amdgcn_sched_barrier(0);
      }
#undef FILT_BLOCK
#undef FILT_LOADW
#undef FILT_SPLIT
    }
    __syncthreads();
}

__device__ __forceinline__ void phase_qkprep(Frame& F, int l) {
    const int gw = F.bid * NWAVES + F.wave, NGW = F.G * NWAVES;
    const int lane = F.lane; const int a = lane >> 5, half = (lane >> 4) & 1, f = lane & 15;
    const float inv = exp2f(-(float)f * (13.287712379549449f / 16.0f)) * INV_2PI;
    const float gq = inp(F, I_QG)[l * 64 + lane], gk = inp(F, I_KG)[l * 64 + lane];
    for (int r = gw; r < MT; r += NGW) {
        const bool isctx = r >= ML; const int t = r & 8191; const int pos = a == 0 ? (t >> 6) : (t & 63);
        float cs = 1.f, sn = 0.f;
        if (!isctx) { const float rev = (float)pos * inv; cs = cos_rev(rev); sn = sin_rev(rev); }
        const bf16* pr = ((bf16*)(wsp(F) + WS_PR)) + (size_t)r * INW;
        bf16* qk = ((bf16*)(wsp(F) + WS_QK)) + (size_t)r * 640;
#pragma unroll
        for (int h = 0; h < 10; ++h) {
            const float v = bf2f(pr[h * 64 + lane]);
            const float ss = wave_sum(v * v, lane);
            const float y = v * (1.0f / sqrtf(ss * (1.0f / 64.0f) + EPS)) * (h < 8 ? gq : gk);
            const float p = shx(y, lane, 16);
            const float o = half == 0 ? y * cs - p * sn : y * cs + p * sn;
            if (h < 8) qk[h * 64 + lane] = (bf16)f2bf(o * 0.18033688011112042f);
            else ((bf16*)(wsp(F) + WS_KT))[(size_t)((((h - 8) * NKB + (r >> 5)) * 4 + (lane >> 4)) * 512 + ((lane >> 3) & 1) * 256 + (r & 31) * 8 + (lane & 7))] = (bf16)f2bf(o);
        }
    }
}

__device__ __forceinline__ float block_sum(Frame& F, float v, LAS float* red) {
    v = wave_sum(v, F.lane);
    __syncthreads();
    if (F.lane == 0) red[F.wave] = v;
    __syncthreads();
    float t = 0.f;
#pragma unroll
    for (int w = 0; w < NWAVES; ++w) t += red[w];
    return t;
}

template <int L>
__device__ __forceinline__ float hy_uc(const bf16* UT, int rowbase, int b, int t, int ch, const float* cw, const float* cb) {
    float a = cb[ch];
    const bf16* up = UT + (size_t)ch * MT + rowbase + b * L;
#pragma unroll
    for (int j = 0; j < 3; ++j) { const int tt = t + j - 1; const bool ok = tt >= 0 && tt < L; const float x = bf2f(up[ok ? tt : t]); a += ok ? x * cw[j * 768 + ch] : 0.f; }
    return a;
}

template <int L>
__device__ __forceinline__ void hyena_item_naive(Frame& F, int l, int c, int rowbase, const float* taps) {
    constexpr int NT = (L + NTHREADS - 1) / NTHREADS;
    LAS float* kt = (LAS float*)F.lds;
    LAS f32x2* z = (LAS f32x2*)(F.lds + 2 * L * 4);
    LAS float* red = (LAS float*)(F.lds + 2 * L * 4 + L * 8);
    const float* cw = inp(F, I_HCW) + l * 3 * 768; const float* cb = inp(F, I_HCB) + l * 768; const float* hb = inp(F, I_HBIAS) + l * 512;
    for (int t = F.tid; t < L; t += NTHREADS) { f32x2 v; v.x = hy_uc<L>(((bf16*)(wsp(F) + WS_UT)), rowbase, 0, t, 512 + c, cw, cb); v.y = hy_uc<L>(((bf16*)(wsp(F) + WS_UT)), rowbase, 1, t, 512 + c, cw, cb); z[t] = v; }
    for (int o = 0; o < 2; ++o) {
        const float* fwd = taps + (size_t)(o * 256 + c) * L; const float* bwd = taps + (size_t)(512 + o * 256 + c) * L;
        float part = 0.f;
        for (int d = F.tid; d < L; d += NTHREADS) { const float kf = fwd[d]; kt[L + d] = kf; part += fabsf(kf);
            if (d >= 1) { const float kb = bwd[d]; kt[L - d] = kb; part += fabsf(kb); } else kt[0] = 0.f; }
        const float tot = block_sum(F, part, red);
        const float inv = 1.0f / tot;
        __syncthreads();
        float* tmp = (float*)(wsp(F) + WS_CTMP) + (size_t)c * 2 * L;
#pragma unroll 1
        for (int t = F.tid; t < L; t += NTHREADS) {
            float a0 = 0.f, a1 = 0.f;
#pragma unroll 4
            for (int s = 0; s < L; ++s) { const f32x2 zz = z[s]; const float kv = kt[L + t - s]; a0 += kv * zz.x; a1 += kv * zz.y; }
            tmp[t] = a0; tmp[L + t] = a1;
        }
        __syncthreads();
        const float bo = hb[o * 256 + c];
#pragma unroll 1
        for (int t = F.tid; t < L; t += NTHREADS) {
            const float g0 = hy_uc<L>(((bf16*)(wsp(F) + WS_UT)), rowbase, 0, t, o * 256 + c, cw, cb), g1 = hy_uc<L>(((bf16*)(wsp(F) + WS_UT)), rowbase, 1, t, o * 256 + c, cw, cb);
            const f32x2 zo = z[t]; f32x2 zn; zn.x = g0 * (tmp[t] * inv + bo * zo.x); zn.y = g1 * (tmp[L + t] * inv + bo * zo.y); z[t] = zn;
        }
        __syncthreads();
    }
    for (int t = F.tid; t < L; t += NTHREADS) { const f32x2 v = z[t];
        ((bf16*)(wsp(F) + WS_HYT))[(size_t)c * MT + rowbase + t] = (bf16)f2bf(v.x); ((bf16*)(wsp(F) + WS_HYT))[(size_t)c * MT + rowbase + L + t] = (bf16)f2bf(v.y); }
    __syncthreads();
}

template <int L>
__device__ __forceinline__ void fnet_item_naive(Frame& F, int b, int g, int m, int rowbase) {
    LAS f32x2* AB = (LAS f32x2*)F.lds;
    LAS f32x2* tab = (LAS f32x2*)(F.lds + L * 8);
    LAS f32x2* cs64 = (LAS f32x2*)(F.lds + 2 * L * 8);
    for (int i = F.tid; i < L; i += NTHREADS) { f32x2 v; const float rev = (float)i / (float)L; v.x = cos_rev(rev); v.y = sin_rev(rev); tab[i] = v; }
    if (F.tid < 64) { f32x2 v; const float rev = (float)F.tid / 64.0f; v.x = cos_rev(rev); v.y = sin_rev(rev); cs64[F.tid] = v; }
    __syncthreads();
    for (int n = F.tid; n < L; n += NTHREADS) {
        const bf16* ut = ((const bf16*)(wsp(F) + WS_UT)) + (size_t)(768 + g * 64) * MT + rowbase + b * L + n;
        const int mm = m <= 32 ? m : 64 - m;
        f32x2 v; v.x = bf2f(ut[(size_t)mm * MT]);
        v.y = (m == 0 || m == 32) ? 0.f : (m < 32 ? bf2f(ut[(size_t)(32 + m) * MT]) : -bf2f(ut[(size_t)(32 + mm) * MT]));
        AB[n] = v;
    }
    __syncthreads();
    const float scale = 1.0f / sqrtf((float)L * 64.0f);
    for (int k = F.tid; k < L; k += NTHREADS) {
        float acc = 0.f; int idx = 0;
        for (int n = 0; n < L; ++n) { const f32x2 ab = AB[n]; const f32x2 cs = tab[idx]; acc += ab.x * cs.x - ab.y * cs.y; idx = (idx + k) & (L - 1); }
        ((bf16*)(wsp(F) + WS_FNT))[(size_t)(g * 64 + m) * MT + rowbase + b * L + k] = (bf16)f2bf(acc * scale);
    }
    __syncthreads();
}

#ifdef FFT_HOST
#define FFT_LDS
#define FFT_HD
static inline float fft_cos_rev(float r) { return (float)cos(6.283185307179586 * (double)r); }
static inline float fft_sin_rev(float r) { return (float)sin(6.283185307179586 * (double)r); }
#else
#define FFT_LDS LAS
#define FFT_HD __device__ __forceinline__
__device__ __forceinline__ float fft_cos_rev(float r) { return __builtin_amdgcn_cosf(r); }
__device__ __forceinline__ float fft_sin_rev(float r) { return __builtin_amdgcn_sinf(r); }
#endif
FFT_HD int fft_phys(int i) { return i + ((i >> 5) << 1); }
FFT_HD f32x2 fft_cmul(f32x2 a, f32x2 b) { const f32x2 ax = {a.x, a.x}, ay = {a.y, a.y}, bs = {-b.y, b.x}; return ax * b + ay * bs; }
template <int R> FFT_HD constexpr int fft_brev(int p) { int r = 0; for (int b = 1; b < R; b <<= 1) { r = (r << 1) | ((p & b) ? 1 : 0); } return r; }
template <int R, bool INV> FFT_HD void fft_regs(f32x2 (&a)[R]) {
    constexpr float C16[16] = {1.0f, 0.92387953251128674f, 0.70710678118654752f, 0.38268343236508977f, 0.0f, -0.38268343236508977f, -0.70710678118654752f, -0.92387953251128674f,
                               -1.0f, -0.92387953251128674f, -0.70710678118654752f, -0.38268343236508977f, 0.0f, 0.38268343236508977f, 0.70710678118654752f, 0.92387953251128674f};
    constexpr float S16[16] = {0.0f, 0.38268343236508977f, 0.70710678118654752f, 0.92387953251128674f, 1.0f, 0.92387953251128674f, 0.70710678118654752f, 0.38268343236508977f,
                               0.0f, -0.38268343236508977f, -0.70710678118654752f, -0.92387953251128674f, -1.0f, -0.92387953251128674f, -0.70710678118654752f, -0.38268343236508977f};
#pragma unroll
    for (int s = R / 2; s >= 1; s >>= 1) {
#pragma unroll
        for (int i = 0; i < R; ++i) {
            if ((i & s) == 0) {
                const int k = i & (s - 1);
                const f32x2 u = a[i], v = a[i + s];
                a[i] = u + v;
                const f32x2 d = u - v;
                if (k == 0) a[i + s] = d;
                else if (2 * k == s) { f32x2 t; if (INV) { t.x = -d.y; t.y = d.x; } else { t.x = d.y; t.y = -d.x; } a[i + s] = t; }
                else { const int idx = k * (16 / (2 * s)); f32x2 w; w.x = C16[idx]; w.y = INV ? S16[idx] : -S16[idx]; a[i + s] = fft_cmul(d, w); }
            }
        }
    }
}
template <int N, int NCUR, int R, bool INV, int NT>
FFT_HD void fft_pass(FFT_LDS f32x2* buf, int tid) {
    constexpr int M = NCUR / R;
    if constexpr (M == 1) {
        constexpr int U = 4; static_assert((N / R) % (NT * U) == 0, "trip count");
#pragma unroll 1
        for (int i0 = tid; i0 < N / R; i0 += NT * U) {
            f32x2 a[U][R]; int pb[U];
#pragma unroll
            for (int u = 0; u < U; ++u) { pb[u] = fft_phys((i0 + u * NT) * R);
#pragma unroll
                for (int q = 0; q < R; ++q) a[u][q] = buf[pb[u] + q]; }
#pragma unroll
            for (int u = 0; u < U; ++u) fft_regs<R, INV>(a[u]);
#pragma unroll
            for (int u = 0; u < U; ++u)
#pragma unroll
                for (int p = 0; p < R; ++p) buf[pb[u] + p] = a[u][fft_brev<R>(p)];
        }
        return;
    }
    constexpr int U = ((N / R) % (NT * 2) == 0) ? 2 : 1;
#pragma unroll 1
    for (int i0 = tid; i0 < N / R; i0 += NT * U) {
        f32x2 a[U][R]; int pb[U]; f32x2 w1[U];
#pragma unroll
        for (int u = 0; u < U; ++u) { const int i = i0 + u * NT; const int blk = i / M, j = i - blk * M, base = blk * NCUR + j;
            pb[u] = fft_phys(base);
#pragma unroll
            for (int q = 0; q < R; ++q) a[u][q] = buf[pb[u] + q * M + 2 * ((q * M) >> 5)];
            const float rev = (float)j * (1.0f / (float)NCUR); w1[u].x = fft_cos_rev(rev); w1[u].y = INV ? fft_sin_rev(rev) : -fft_sin_rev(rev); }
#pragma unroll
        for (int u = 0; u < U; ++u) {
            f32x2 w[R]; w[1] = w1[u];
#pragma unroll
            for (int p = 2; p < R; ++p) { const int hb = (p >= 8) ? 8 : ((p >= 4) ? 4 : 2); w[p] = (p == hb) ? fft_cmul(w[hb / 2], w[hb / 2]) : fft_cmul(w[hb], w[p - hb]); }
            if (INV) {
#pragma unroll
                for (int p = 1; p < R; ++p) a[u][p] = fft_cmul(a[u][p], w[p]);
                fft_regs<R, INV>(a[u]);
            } else {
                fft_regs<R, INV>(a[u]);
#pragma unroll
                for (int p = 1; p < R; ++p) a[u][fft_brev<R>(p)] = fft_cmul(a[u][fft_brev<R>(p)], w[p]);
            }
#pragma unroll
            for (int p = 0; p < R; ++p) buf[pb[u] + p * M + 2 * ((p * M) >> 5)] = a[u][fft_brev<R>(p)];
        }
    }
}
#ifdef FFT_HOST
#define FFT_SYNC()
#else
#define FFT_SYNC() __syncthreads()
#endif

template <bool INV> __device__ __forceinline__ void fft16k(LAS f32x2* buf, int tid) {
    constexpr int N = 16384;
    if (!INV) { fft_pass<N, 16384, 16, false, NTHREADS>(buf, tid); __syncthreads(); fft_pass<N, 1024, 16, false, NTHREADS>(buf, tid); __syncthreads();
                fft_pass<N, 64, 16, false, NTHREADS>(buf, tid); __syncthreads(); fft_pass<N, 4, 4, false, NTHREADS>(buf, tid); __syncthreads(); }
    else { fft_pass<N, 4, 4, true, NTHREADS>(buf, tid); __syncthreads(); fft_pass<N, 64, 16, true, NTHREADS>(buf, tid); __syncthreads();
           fft_pass<N, 1024, 16, true, NTHREADS>(buf, tid); __syncthreads(); fft_pass<N, 16384, 16, true, NTHREADS>(buf, tid); __syncthreads(); }
}
__device__ __forceinline__ void fft8k_fwd(LAS f32x2* buf, int tid) {
    constexpr int N = 8192;
    fft_pass<N, 8192, 16, false, NTHREADS>(buf, tid); __syncthreads(); fft_pass<N, 512, 16, false, NTHREADS>(buf, tid); __syncthreads();
    fft_pass<N, 32, 16, false, NTHREADS>(buf, tid); __syncthreads(); fft_pass<N, 2, 2, false, NTHREADS>(buf, tid); __syncthreads();
}

__device__ __forceinline__ void hy_uc8(const bf16* UT, int b, int t0, int ch, const float* cw, const float* cb, float (&o)[8]) {
    const bf16* up = UT + (size_t)ch * MT + b * SEQ + t0;
    const v4u w = *(const v4u*)up;
    const bool hl = t0 > 0, hr = t0 + 8 < SEQ;
    const float hm = bf2f(up[hl ? -1 : 0]), hp = bf2f(up[hr ? 8 : 7]);
    float x[10]; x[0] = hl ? hm : 0.f; x[9] = hr ? hp : 0.f;
    x[1] = bflo(w.x); x[2] = bfhi(w.x); x[3] = bflo(w.y); x[4] = bfhi(w.y); x[5] = bflo(w.z); x[6] = bfhi(w.z); x[7] = bflo(w.w); x[8] = bfhi(w.w);
    const float w0 = cw[ch], w1 = cw[768 + ch], w2 = cw[1536 + ch], bias = cb[ch];
#pragma unroll
    for (int e = 0; e < 8; ++e) o[e] = ((bias + x[e] * w0) + x[e + 1] * w1) + x[e + 2] * w2;
}
__device__ __forceinline__ void hyena_item_fft(Frame& F, int l, int c) {
    constexpr int L = SEQ, N = 2 * SEQ;
    LAS f32x2* buf = (LAS f32x2*)F.lds;
    LAS float* red = (LAS float*)(F.lds + 139264);
    const bf16* UT = (const bf16*)(wsp(F) + WS_UT);
    const float* cw = inp(F, I_HCW) + l * 3 * 768; const float* cb = inp(F, I_HCB) + l * 768; const float* hb = inp(F, I_HBIAS) + l * 512;
    f32x2* kspec = (f32x2*)(wsp(F) + WS_KS) + (size_t)F.bid * 2 * N;
    const float* HFp = (const float*)(wsp(F) + WS_HF);
    {
        const float* f0 = HFp + (size_t)c * L; const float* b0 = HFp + (size_t)(512 + c) * L; const float* f1 = HFp + (size_t)(256 + c) * L; const float* b1 = HFp + (size_t)(768 + c) * L;
        float p0 = 0.f, p1 = 0.f;
#pragma unroll
        for (int k = 0; k < 4; ++k) { const int i0 = 4 * (F.tid + NTHREADS * k);
            const f32x4 a = *(const f32x4*)(f0 + i0), b = *(const f32x4*)(f1 + i0), cbk = *(const f32x4*)(b0 + i0), d = *(const f32x4*)(b1 + i0);
            LAS f32x4* bp = (LAS f32x4*)(buf + fft_phys(i0));
            f32x4 w; w[0] = a[0]; w[1] = b[0]; w[2] = a[1]; w[3] = b[1]; bp[0] = w; w[0] = a[2]; w[1] = b[2]; w[2] = a[3]; w[3] = b[3]; bp[1] = w;
#pragma unroll
            for (int e = 0; e < 4; ++e) { p0 += fabsf(a[e]); p1 += fabsf(b[e]); }
            if (i0 > 0) { p0 += fabsf(cbk[0]); p1 += fabsf(d[0]); f32x2 v; v.x = cbk[0]; v.y = d[0]; buf[fft_phys(N - i0)] = v; }
            else { float zf = 0.f; asm volatile("" : "+v"(zf)); f32x2 v; v.x = zf; v.y = zf; buf[fft_phys(L)] = v; }
#pragma unroll
            for (int e = 1; e < 4; ++e) { p0 += fabsf(cbk[e]); p1 += fabsf(d[e]); f32x2 v; v.x = cbk[e]; v.y = d[e]; buf[fft_phys(N - i0 - e)] = v; } }
        const float tot0 = block_sum(F, p0, red); const float tot1 = block_sum(F, p1, red);
        __syncthreads();
        fft16k<false>(buf, F.tid);
        const float s0 = 0.5f / tot0, s1 = 0.5f / tot1;
        typedef _Float16 f16x2 __attribute__((ext_vector_type(2)));
        int tp = F.tid; asm volatile("" : "+v"(tp));
#pragma unroll 2
        for (int k = 0; k < 8; ++k) { const int pos0 = 4 * (tp + NTHREADS * k);
            const LAS f32x4* ap = (const LAS f32x4*)(buf + fft_phys(pos0)); const f32x4 a01 = ap[0], a23 = ap[1];
            f32x2 o0[4], o1[4];
#pragma unroll
            for (int e = 0; e < 4; ++e) { const int pos = pos0 + e;
                const int f = (pos >> 10) + 16 * ((pos >> 6) & 15) + 256 * ((pos >> 2) & 15) + 4096 * (pos & 3), nf = (N - f) & (N - 1);
                const int pos2 = (nf & 15) * 1024 + ((nf >> 4) & 15) * 64 + ((nf >> 8) & 15) * 4 + (nf >> 12);
                f32x2 a; a.x = (e < 2 ? a01 : a23)[2 * (e & 1)]; a.y = (e < 2 ? a01 : a23)[2 * (e & 1) + 1];
                const f32x2 b = buf[fft_phys(pos2)];
                f32x2 k0, k1; k0.x = ((a.x + b.x) * s0); k0.y = ((a.y - b.y) * s0); k1.x = ((a.y + b.y) * s1); k1.y = ((b.x - a.x) * s1);
                o0[e] = k0; o1[e] = k1; }
            { f32x4 w; w[0] = o0[0].x; w[1] = o0[0].y; w[2] = o0[1].x; w[3] = o0[1].y; *(f32x4*)(kspec + pos0) = w; w[0] = o0[2].x; w[1] = o0[2].y; w[2] = o0[3].x; w[3] = o0[3].y; *(f32x4*)(kspec + pos0 + 2) = w;
              w[0] = o1[0].x; w[1] = o1[0].y; w[2] = o1[1].x; w[3] = o1[1].y; *(f32x4*)(kspec + N + pos0) = w; w[0] = o1[2].x; w[1] = o1[2].y; w[2] = o1[3].x; w[3] = o1[3].y; *(f32x4*)(kspec + N + pos0 + 2) = w; } }
        __syncthreads();
    }
    f32x2 zr[2][8];
    int tz = F.tid; asm volatile("" : "+v"(tz));
#pragma unroll
    for (int k = 0; k < 2; ++k) { const int t0 = 8 * (tz + NTHREADS * k);
        float zf = 0.f; asm volatile("" : "+v"(zf)); f32x4 zero4; zero4[0] = zf; zero4[1] = zf; zero4[2] = zf; zero4[3] = zf;
        float a0[8], a1[8]; hy_uc8(UT, 0, t0, 512 + c, cw, cb, a0); hy_uc8(UT, 1, t0, 512 + c, cw, cb, a1);
        LAS f32x4* bp = (LAS f32x4*)(buf + fft_phys(t0)); LAS f32x4* zp = (LAS f32x4*)(buf + fft_phys(L + t0));
#pragma unroll
        for (int e = 0; e < 8; ++e) { zr[k][e].x = a0[e]; zr[k][e].y = a1[e]; }
#pragma unroll
        for (int e2 = 0; e2 < 4; ++e2) { f32x4 w; w[0] = a0[2 * e2]; w[1] = a1[2 * e2]; w[2] = a0[2 * e2 + 1]; w[3] = a1[2 * e2 + 1]; bp[e2] = w; zp[e2] = zero4; } }
    __syncthreads();
#pragma unroll 1
    for (int o = 0; o < 2; ++o) {
        fft16k<false>(buf, F.tid);
        { int tm = F.tid; asm volatile("" : "+v"(tm));
          const f32x2* ks = kspec + o * N;
#pragma unroll
          for (int kh = 0; kh < 2; ++kh) {
              f32x4 kw[4][2];
#pragma unroll
              for (int k = 0; k < 4; ++k) { const f32x2* kp = ks + 4 * (tm + NTHREADS * (4 * kh + k)); kw[k][0] = *(const f32x4*)kp; kw[k][1] = *(const f32x4*)(kp + 2); }
#pragma unroll
              for (int k = 0; k < 4; ++k) { LAS f32x4* bp = (LAS f32x4*)(buf + fft_phys(4 * (tm + NTHREADS * (4 * kh + k))));
#pragma unroll
                  for (int e2 = 0; e2 < 2; ++e2) { const f32x4 z = bp[e2];
                      f32x2 za, zb, ka, kb; za.x = z[0]; za.y = z[1]; zb.x = z[2]; zb.y = z[3]; ka.x = kw[k][e2][0]; ka.y = kw[k][e2][1]; kb.x = kw[k][e2][2]; kb.y = kw[k][e2][3];
                      const f32x2 ra = fft_cmul(za, ka), rb = fft_cmul(zb, kb);
                      f32x4 w; w[0] = ra.x; w[1] = ra.y; w[2] = rb.x; w[3] = rb.y; bp[e2] = w; } } } }
        __syncthreads();
        fft16k<true>(buf, F.tid);
        const float bo = hb[o * 256 + c]; const float invn = 1.0f / (float)N;
        int tg = F.tid; asm volatile("" : "+v"(tg));
#pragma unroll
        for (int k = 0; k < 2; ++k) { const int t0 = 8 * (tg + NTHREADS * k);
            float zf = 0.f; asm volatile("" : "+v"(zf)); f32x4 zero4; zero4[0] = zf; zero4[1] = zf; zero4[2] = zf; zero4[3] = zf;
            float g0[8], g1[8]; hy_uc8(UT, 0, t0, o * 256 + c, cw, cb, g0); hy_uc8(UT, 1, t0, o * 256 + c, cw, cb, g1);
            LAS f32x4* bp = (LAS f32x4*)(buf + fft_phys(t0)); LAS f32x4* zp = (LAS f32x4*)(buf + fft_phys(L + t0));
#pragma unroll
            for (int e2 = 0; e2 < 4; ++e2) { const f32x4 cv = bp[e2];
                f32x2 za, zb; za.x = g0[2 * e2] * (cv[0] * invn + bo * zr[k][2 * e2].x); za.y = g1[2 * e2] * (cv[1] * invn + bo * zr[k][2 * e2].y);
                zb.x = g0[2 * e2 + 1] * (cv[2] * invn + bo * zr[k][2 * e2 + 1].x); zb.y = g1[2 * e2 + 1] * (cv[3] * invn + bo * zr[k][2 * e2 + 1].y);
                zr[k][2 * e2] = za; zr[k][2 * e2 + 1] = zb; }
            if (o == 0) {
#pragma unroll
                for (int e2 = 0; e2 < 4; ++e2) { f32x4 w; w[0] = zr[k][2 * e2].x; w[1] = zr[k][2 * e2].y; w[2] = zr[k][2 * e2 + 1].x; w[3] = zr[k][2 * e2 + 1].y; bp[e2] = w; zp[e2] = zero4; }
            } else {
                v4u o0, o1; o0.x = pk2(zr[k][0].x, zr[k][1].x); o0.y = pk2(zr[k][2].x, zr[k][3].x); o0.z = pk2(zr[k][4].x, zr[k][5].x); o0.w = pk2(zr[k][6].x, zr[k][7].x);
                o1.x = pk2(zr[k][0].y, zr[k][1].y); o1.y = pk2(zr[k][2].y, zr[k][3].y); o1.z = pk2(zr[k][4].y, zr[k][5].y); o1.w = pk2(zr[k][6].y, zr[k][7].y);
                bf16* hy = ((bf16*)(wsp(F) + WS_HYT)) + (size_t)c * MT + t0;
                *(v4u*)hy = o0; *(v4u*)(hy + L) = o1;
            } }
        __syncthreads();
    }
}

__device__ __forceinline__ void fnet_item_fft(Frame& F, int b, int g, int m) {
    constexpr int N = SEQ;
    LAS f32x2* buf = (LAS f32x2*)F.lds;
    LAS float* re = (LAS float*)(F.lds + 69632);
    LAS float* im = re + N;
    const bf16* ut = ((const bf16*)(wsp(F) + WS_UT)) + (size_t)(768 + g * 64) * MT + b * N;
    bf16* fnt = ((bf16*)(wsp(F) + WS_FNT)) + (size_t)(g * 64) * MT + b * N;
    const float sgn = (m == 0) ? 1.0f : -1.0f;
#pragma unroll
    for (int k = 0; k < 2; ++k) { const int n0 = 8 * (F.tid + NTHREADS * k);
        const v4u a = *(const v4u*)(ut + (size_t)m * MT + n0), bb = *(const v4u*)(ut + (size_t)(32 + m) * MT + n0);
        LAS f32x4* bp = (LAS f32x4*)(buf + fft_phys(n0));
        f32x4 w; w[0] = bflo(a.x); w[1] = sgn * bflo(bb.x); w[2] = bfhi(a.x); w[3] = sgn * bfhi(bb.x); bp[0] = w;
        w[0] = bflo(a.y); w[1] = sgn * bflo(bb.y); w[2] = bfhi(a.y); w[3] = sgn * bfhi(bb.y); bp[1] = w;
        w[0] = bflo(a.z); w[1] = sgn * bflo(bb.z); w[2] = bfhi(a.z); w[3] = sgn * bfhi(bb.z); bp[2] = w;
        w[0] = bflo(a.w); w[1] = sgn * bflo(bb.w); w[2] = bfhi(a.w); w[3] = sgn * bfhi(bb.w); bp[3] = w; }
    __syncthreads();
    fft8k_fwd(buf, F.tid);
#pragma unroll 4
    for (int pos = F.tid; pos < N; pos += NTHREADS) { const int k = (pos >> 9) + 16 * ((pos >> 5) & 15) + 256 * ((pos >> 1) & 15) + 4096 * (pos & 1);
        const f32x2 v = buf[fft_phys(pos)]; re[k] = v.x; if (m == 0) im[k] = v.y; }
    __syncthreads();
    const float scale = 1.0f / sqrtf((float)N * 64.0f);
#pragma unroll
    for (int j = 0; j < 2; ++j) { const int k0 = 8 * (F.tid + NTHREADS * j);
        float ra[8], rb[8];
        { const f32x4 x0 = *(const LAS f32x4*)(re + k0), x1 = *(const LAS f32x4*)(re + k0 + 4);
#pragma unroll
          for (int e = 0; e < 4; ++e) { ra[e] = x0[e]; ra[4 + e] = x1[e]; }
#pragma unroll
          for (int e = 0; e < 8; ++e) rb[e] = re[(N - k0 - e) & (N - 1)]; }
        if (m == 0) {
            float ia[8], ib[8];
            const f32x4 y0 = *(const LAS f32x4*)(im + k0), y1 = *(const LAS f32x4*)(im + k0 + 4);
#pragma unroll
            for (int e = 0; e < 4; ++e) { ia[e] = y0[e]; ia[4 + e] = y1[e]; }
#pragma unroll
            for (int e = 0; e < 8; ++e) ib[e] = im[(N - k0 - e) & (N - 1)];
            const float hs = 0.5f * scale;
            v4u o0, o1;
            o0.x = pk2((ra[0] + rb[0]) * hs, (ra[1] + rb[1]) * hs); o0.y = pk2((ra[2] + rb[2]) * hs, (ra[3] + rb[3]) * hs); o0.z = pk2((ra[4] + rb[4]) * hs, (ra[5] + rb[5]) * hs); o0.w = pk2((ra[6] + rb[6]) * hs, (ra[7] + rb[7]) * hs);
            o1.x = pk2((ia[0] + ib[0]) * hs, (ia[1] + ib[1]) * hs); o1.y = pk2((ia[2] + ib[2]) * hs, (ia[3] + ib[3]) * hs); o1.z = pk2((ia[4] + ib[4]) * hs, (ia[5] + ib[5]) * hs); o1.w = pk2((ia[6] + ib[6]) * hs, (ia[7] + ib[7]) * hs);
            *(v4u*)(fnt + k0) = o0; *(v4u*)(fnt + (size_t)32 * MT + k0) = o1;
        } else {
            v4u o0, o1;
            o0.x = pk2(ra[0] * scale, ra[1] * scale); o0.y = pk2(ra[2] * scale, ra[3] * scale); o0.z = pk2(ra[4] * scale, ra[5] * scale); o0.w = pk2(ra[6] * scale, ra[7] * scale);
            o1.x = pk2(rb[0] * scale, rb[1] * scale); o1.y = pk2(rb[2] * scale, rb[3] * scale); o1.z = pk2(rb[4] * scale, rb[5] * scale); o1.w = pk2(rb[6] * scale, rb[7] * scale);
            *(v4u*)(fnt + (size_t)m * MT + k0) = o0; *(v4u*)(fnt + (size_t)(64 - m) * MT + k0) = o1;
        } }
    __syncthreads();
}

typedef short bf16x8 __attribute__((ext_vector_type(8)));
typedef float f32x16 __attribute__((ext_vector_type(16)));
__device__ __forceinline__ unsigned cvtpk(float lo, float hi) { return pg8::cvt_pk_bf16(lo, hi); }
struct AttnChunk { bf16x8 k[4]; bf16x8 v[2][2]; };
__device__ __forceinline__ void attn_load_chunk(AttnChunk& C, const bf16* KT, const bf16* VT, int keyrow0, int kvh, int lane) {
    const int kb = keyrow0 >> 5;
    const bf16* kp = KT + (size_t)((kvh * NKB + kb) * 4) * 512 + lane * 8;
#pragma unroll
    for (int s = 0; s < 4; ++s) C.k[s] = *(const bf16x8*)(kp + s * 512);
    const bf16* vp = VT + (size_t)((kvh * NKB + kb) * 4) * 512 + lane * 8;
#pragma unroll
    for (int dd = 0; dd < 2; ++dd)
#pragma unroll
        for (int s = 0; s < 2; ++s) C.v[dd][s] = *(const bf16x8*)(vp + (dd * 2 + s) * 512);
}
__device__ __forceinline__ void attn_item(Frame& F, int l, int item) {
    const int lane = F.lane, r = lane & 31, h = lane >> 5;
    const bf16* QK = (const bf16*)(wsp(F) + WS_QK); const bf16* VT = (const bf16*)(wsp(F) + WS_VT); const bf16* KT = (const bf16*)(wsp(F) + WS_KT);
    int g, kvh, b, qrow0, t0; bool isctx;
    if (item < 4096) { g = item & 3; const int qblk = (item >> 2) & 255; kvh = (item >> 10) & 1; b = item >> 11; isctx = false; t0 = qblk * 32; qrow0 = b * SEQ + t0; }
    else { const int j = item - 4096; g = j & 3; const int qb = (j >> 2) & 7; kvh = (j >> 5) & 1; b = j >> 6; isctx = true; t0 = 0; qrow0 = ML + b * CTXL + qb * 32; }
    const int head = 4 * kvh + g;
    bf16x8 qf[4];
    { const bf16* qp = QK + (size_t)(qrow0 + r) * 640 + head * 64 + 8 * h;
#pragma unroll
      for (int s = 0; s < 4; ++s) qf[s] = *(const bf16x8*)(qp + 16 * s); }
    float m = inp(F, I_SINK)[l * 8 + head] * 1.4426950408889634f;
    float lsum = (h == 0) ? 1.0f : 0.0f;
    f32x16 o0, o1;
#pragma unroll
    for (int i = 0; i < 16; ++i) { o0[i] = 0.f; o1[i] = 0.f; }
    int c_lo = 0, nl = 0;
    if (!isctx) { const int qblk = t0 >> 5; c_lo = qblk < 4 ? 4 - qblk : 0; const int c_hi = (259 - qblk) < 8 ? (259 - qblk) : 8; nl = c_hi - c_lo + 1; }
    const int n = nl + 8;
    const int lrow0 = b * SEQ + t0 - 128 + 32 * c_lo, crow0 = ML + b * CTXL - 32 * nl;
#define ATT_LOAD(BUF, i_) { const int ii_ = (i_) < n ? (i_) : n - 1; attn_load_chunk(BUF, KT, VT, ii_ < nl ? lrow0 + 32 * ii_ : crow0 + 32 * ii_, kvh, lane); }
#define ATT_COMPUTE(BUF, i_) { \
        const int cc_ = (i_) < nl ? c_lo + (i_) : 100; \
        f32x16 S; \
        _Pragma("unroll") for (int i = 0; i < 16; ++i) S[i] = 0.f; \
        _Pragma("unroll") for (int s = 0; s < 4; ++s) S = __builtin_amdgcn_mfma_f32_32x32x16_bf16(BUF.k[s], qf[s], S, 0, 0, 0); \
        if (cc_ == 0 || cc_ == 8) { \
            _Pragma("unroll") for (int i = 0; i < 16; ++i) { const int kidx = (i & 3) + 8 * (i >> 2) + 4 * h; const bool ok = (cc_ == 0) ? (kidx >= r) : (kidx <= r); if (!ok) S[i] = -INFINITY; } \
        } \
        float cm = S[0]; \
        _Pragma("unroll") for (int i = 1; i < 16; ++i) cm = fmaxf(cm, S[i]); \
        cm = fmaxf(cm, shx(cm, lane, 32)); \
        const float mn = fmaxf(m, cm), alpha = __builtin_amdgcn_exp2f(m - mn); m = mn; \
        float ps = 0.f; \
        _Pragma("unroll") for (int i = 0; i < 16; ++i) { S[i] = __builtin_amdgcn_exp2f(S[i] - m); ps += S[i]; } \
        lsum = lsum * alpha + ps; \
        _Pragma("unroll") for (int i = 0; i < 16; ++i) { o0[i] *= alpha; o1[i] *= alpha; } \
        bf16x8 pf[2]; \
        _Pragma("unroll") for (int s = 0; s < 2; ++s) { v4u w; w.x = cvtpk(S[8 * s + 0], S[8 * s + 1]); w.y = cvtpk(S[8 * s + 2], S[8 * s + 3]); w.z = cvtpk(S[8 * s + 4], S[8 * s + 5]); w.w = cvtpk(S[8 * s + 6], S[8 * s + 7]); pf[s] = __builtin_bit_cast(bf16x8, w); } \
        _Pragma("unroll") for (int s = 0; s < 2; ++s) { \
            o0 = __builtin_amdgcn_mfma_f32_32x32x16_bf16(BUF.v[0][s], pf[s], o0, 0, 0, 0); \
            o1 = __builtin_amdgcn_mfma_f32_32x32x16_bf16(BUF.v[1][s], pf[s], o1, 0, 0, 0); \
        } }
    AttnChunk ca, cb2, cc3;
    ATT_LOAD(ca, 0) ATT_LOAD(cb2, 1)
    { int ci = 0;
      for (;;) {
        ATT_LOAD(cc3, ci + 2) ATT_COMPUTE(ca, ci) if (++ci >= n) break;
        ATT_LOAD(ca, ci + 2) ATT_COMPUTE(cb2, ci) if (++ci >= n) break;
        ATT_LOAD(cb2, ci + 2) ATT_COMPUTE(cc3, ci) if (++ci >= n) break;
      } }
#undef ATT_LOAD
#undef ATT_COMPUTE
    lsum += shx(lsum, lane, 32);
    const float inv = 1.0f / lsum;
    bf16* op = ((bf16*)(wsp(F) + WS_AM)) + (size_t)(qrow0 + r) * 1024 + head * 64 + 4 * h;
#pragma unroll
    for (int g4 = 0; g4 < 4; ++g4) {
        v2u w0; w0.x = cvtpk(o0[4 * g4 + 0] * inv, o0[4 * g4 + 1] * inv); w0.y = cvtpk(o0[4 * g4 + 2] * inv, o0[4 * g4 + 3] * inv); *(v2u*)(op + 8 * g4) = w0;
        v2u w1; w1.x = cvtpk(o1[4 * g4 + 0] * inv, o1[4 * g4 + 1] * inv); w1.y = cvtpk(o1[4 * g4 + 2] * inv, o1[4 * g4 + 3] * inv); *(v2u*)(op + 32 + 8 * g4) = w1;
    }
}

__device__ __forceinline__ void attn_item_naive(Frame& F, int l, int r, int kvh, LAS float* wq, LAS float* wp) {
    const int lane = F.lane;
    const bool isctx = r >= ML; const int b = isctx ? ((r - ML) >> 8) : (r >> 13); const int t = r & 8191;
    const int lo = (t - 128) < 0 ? 0 : (t - 128), hi = (t + 128) > (SEQ - 1) ? (SEQ - 1) : (t + 128);
    const int nloc = isctx ? 0 : (hi - lo + 1), nk = nloc + CTXL;
#pragma unroll
    for (int h = 0; h < 4; ++h) wq[h * 64 + lane] = bf2f(((bf16*)(wsp(F) + WS_QK))[(size_t)r * 640 + (4 * kvh + h) * 64 + lane]) * 0.125f;
    LDS_WAIT(); asm volatile("" ::: "memory");
    for (int j = lane; j < nk; j += 64) {
        const int krow = j < nloc ? (b * SEQ + lo + j) : (ML + b * CTXL + (j - nloc));
        const bf16* kp = ((bf16*)(wsp(F) + WS_QK)) + (size_t)krow * 640 + 512 + kvh * 64;
        float s0 = 0.f, s1 = 0.f, s2 = 0.f, s3 = 0.f;
#pragma unroll
        for (int d8 = 0; d8 < 8; ++d8) { const v4u kw = *(const v4u*)(kp + d8 * 8);
            float kf[8]; kf[0] = bflo(kw.x); kf[1] = bfhi(kw.x); kf[2] = bflo(kw.y); kf[3] = bfhi(kw.y); kf[4] = bflo(kw.z); kf[5] = bfhi(kw.z); kf[6] = bflo(kw.w); kf[7] = bfhi(kw.w);
#pragma unroll
            for (int e = 0; e < 8; ++e) { const int d = d8 * 8 + e; s0 += kf[e] * wq[d]; s1 += kf[e] * wq[64 + d]; s2 += kf[e] * wq[128 + d]; s3 += kf[e] * wq[192 + d]; } }
        f32x4 sv; sv[0] = s0; sv[1] = s1; sv[2] = s2; sv[3] = s3;
        *(LAS f32x4*)(wp + j * 4) = sv;
    }
    LDS_WAIT(); asm volatile("" ::: "memory");
    f32x4 mx = {-INFINITY, -INFINITY, -INFINITY, -INFINITY};
    for (int j = lane; j < nk; j += 64) { const f32x4 sv = *(LAS f32x4*)(wp + j * 4);
#pragma unroll
        for (int h = 0; h < 4; ++h) mx[h] = fmaxf(mx[h], sv[h]); }
    f32x4 sink, den;
#pragma unroll
    for (int h = 0; h < 4; ++h) { sink[h] = inp(F, I_SINK)[l * 8 + 4 * kvh + h]; mx[h] = fmaxf(wave_max(mx[h], lane), sink[h]); den[h] = 0.f; }
    for (int j = lane; j < nk; j += 64) { f32x4 sv = *(LAS f32x4*)(wp + j * 4);
#pragma unroll
        for (int h = 0; h < 4; ++h) { sv[h] = __expf(sv[h] - mx[h]); den[h] += sv[h]; }
        *(LAS f32x4*)(wp + j * 4) = sv; }
#pragma unroll
    for (int h = 0; h < 4; ++h) den[h] = wave_sum(den[h], lane) + __expf(sink[h] - mx[h]);
    LDS_WAIT(); asm volatile("" ::: "memory");
    f32x4 o = {0.f, 0.f, 0.f, 0.f};
    for (int j = 0; j < nk; ++j) {
        const int krow = j < nloc ? (b * SEQ + lo + j) : (ML + b * CTXL + (j - nloc));
        const float v = bf2f(((bf16*)(wsp(F) + WS_PR))[(size_t)krow * INW + K_END + kvh * 64 + lane]);
        const f32x4 p = *(LAS f32x4*)(wp + j * 4);
        o += p * v;
    }
#pragma unroll
    for (int h = 0; h < 4; ++h) ((bf16*)(wsp(F) + WS_ATT))[(size_t)r * 512 + (4 * kvh + h) * 64 + lane] = (bf16)f2bf(o[h] / den[h]);
    LDS_WAIT(); asm volatile("" ::: "memory");
}


__device__ __forceinline__ void hyena_ctx_wave(Frame& F, int l, int c, LAS float* kt  , LAS f32x2* z  ) {
    constexpr int L = CTXL; const int lane = F.lane;
    const bf16* UT = (const bf16*)(wsp(F) + WS_UT); const float* HFC = (const float*)(wsp(F) + WS_HFC);
    const float* cw = inp(F, I_HCW) + l * 3 * 768; const float* cb = inp(F, I_HCB) + l * 768; const float* hb = inp(F, I_HBIAS) + l * 512;
#pragma unroll
    for (int j = 0; j < 4; ++j) { const int t = lane + 64 * j; f32x2 v; v.x = hy_uc<L>(UT, ML, 0, t, 512 + c, cw, cb); v.y = hy_uc<L>(UT, ML, 1, t, 512 + c, cw, cb); z[t] = v; }
    for (int o = 0; o < 2; ++o) {
        const float* fwd = HFC + (size_t)(o * 256 + c) * L; const float* bwd = HFC + (size_t)(512 + o * 256 + c) * L;
        float part = 0.f;
#pragma unroll
        for (int j = 0; j < 4; ++j) { const int d = lane + 64 * j; const float kf = fwd[d]; kt[L + d] = kf; part += fabsf(kf);
            if (d >= 1) { const float kb = bwd[d]; kt[L - d] = kb; part += fabsf(kb); } else kt[0] = 0.f; }
        const float inv = 1.0f / wave_sum(part, lane);
        LDS_WAIT(); asm volatile("" ::: "memory");
        float r0[4] = {0.f, 0.f, 0.f, 0.f}, r1[4] = {0.f, 0.f, 0.f, 0.f};
#pragma unroll 4
        for (int s = 0; s < L; ++s) { const f32x2 zz = z[s];
#pragma unroll
            for (int j = 0; j < 4; ++j) { const float kv = kt[L + lane + 64 * j - s]; r0[j] += kv * zz.x; r1[j] += kv * zz.y; } }
        LDS_WAIT(); asm volatile("" ::: "memory");
        const float bo = hb[o * 256 + c];
#pragma unroll
        for (int j = 0; j < 4; ++j) { const int t = lane + 64 * j;
            const float g0 = hy_uc<L>(UT, ML, 0, t, o * 256 + c, cw, cb), g1 = hy_uc<L>(UT, ML, 1, t, o * 256 + c, cw, cb);
            const f32x2 zo = z[t]; f32x2 zn; zn.x = g0 * (r0[j] * inv + bo * zo.x); zn.y = g1 * (r1[j] * inv + bo * zo.y); z[t] = zn; }
        LDS_WAIT(); asm volatile("" ::: "memory");
    }
    bf16* hyt = ((bf16*)(wsp(F) + WS_HYT)) + (size_t)c * MT + ML;
#pragma unroll
    for (int j = 0; j < 4; ++j) { const int t = lane + 64 * j; const f32x2 v = z[t]; hyt[t] = (bf16)f2bf(v.x); hyt[L + t] = (bf16)f2bf(v.y); }
    LDS_WAIT(); asm volatile("" ::: "memory");
}
__device__ __forceinline__ void fnet_ctx_wave(Frame& F, int b, int g, int m, LAS f32x2* AB  , LAS f32x2* tab  ) {
    constexpr int L = CTXL; const int lane = F.lane;
    const bf16* ut = ((const bf16*)(wsp(F) + WS_UT)) + (size_t)(768 + g * 64) * MT + ML + b * L;
    const int mm = m <= 32 ? m : 64 - m;
#pragma unroll
    for (int j = 0; j < 4; ++j) { const int n = lane + 64 * j; f32x2 t; const float rev = (float)n * (1.0f / (float)L); t.x = cos_rev(rev); t.y = sin_rev(rev); tab[n] = t;
        f32x2 v; v.x = bf2f(ut[(size_t)mm * MT + n]);
        v.y = (m == 0 || m == 32) ? 0.f : (m < 32 ? bf2f(ut[(size_t)(32 + m) * MT + n]) : -bf2f(ut[(size_t)(32 + mm) * MT + n]));
        AB[n] = v; }
    LDS_WAIT(); asm volatile("" ::: "memory");
    const float scale = 1.0f / sqrtf((float)L * 64.0f);
    bf16* fnt = ((bf16*)(wsp(F) + WS_FNT)) + (size_t)(g * 64 + m) * MT + ML + b * L;
    { float acc[4] = {0.f, 0.f, 0.f, 0.f}; int idx[4] = {0, 0, 0, 0};
#pragma unroll 4
      for (int n = 0; n < L; ++n) { const f32x2 ab = AB[n];
#pragma unroll
          for (int j = 0; j < 4; ++j) { const f32x2 cs = tab[idx[j]]; acc[j] += ab.x * cs.x - ab.y * cs.y; idx[j] = (idx[j] + lane + 64 * j) & (L - 1); } }
#pragma unroll
      for (int j = 0; j < 4; ++j) fnt[lane + 64 * j] = (bf16)f2bf(acc[j] * scale); }
    LDS_WAIT(); asm volatile("" ::: "memory");
}

__device__ __forceinline__ void phase_trans(Frame& F) {
    LAS unsigned* tl = (LAS unsigned*)(F.lds + F.wave * 16640);
    const int gw = F.bid * NWAVES + F.wave, NGW = F.G * NWAVES, lane = F.lane;
    const int seg = lane & 7, q = lane >> 3;
    for (int it = gw; it < 2 * 264 * 4; it += NGW) {
        const int which = it / (264 * 4), rem = it % (264 * 4), rt = rem >> 2, ct = rem & 3;
        const bf16* src = (which == 0 ? ((const bf16*)(wsp(F) + WS_HYT)) : ((const bf16*)(wsp(F) + WS_FNT))) + (size_t)(ct * 64) * MT + rt * 64 + 8 * seg;
        bf16* dst = ((bf16*)(wsp(F) + WS_AM)) + (which == 0 ? 512 : 768) + (size_t)(rt * 64) * 1024 + ct * 64 + 8 * seg;
        v4u a[4], b[4];
#pragma unroll
        for (int j = 0; j < 4; ++j) { const bf16* p = src + (size_t)(2 * (8 * j + q)) * MT; a[j] = *(const v4u*)p; b[j] = *(const v4u*)(p + MT); }
#pragma unroll
        for (int j = 0; j < 4; ++j) { LAS unsigned* tp = tl + (8 * seg) * 33 + 8 * j + q;
            tp[0 * 33] = (a[j].x & 0xffffu) | (b[j].x << 16); tp[1 * 33] = (a[j].x >> 16) | (b[j].x & 0xffff0000u);
            tp[2 * 33] = (a[j].y & 0xffffu) | (b[j].y << 16); tp[3 * 33] = (a[j].y >> 16) | (b[j].y & 0xffff0000u);
            tp[4 * 33] = (a[j].z & 0xffffu) | (b[j].z << 16); tp[5 * 33] = (a[j].z >> 16) | (b[j].z & 0xffff0000u);
            tp[6 * 33] = (a[j].w & 0xffffu) | (b[j].w << 16); tp[7 * 33] = (a[j].w >> 16) | (b[j].w & 0xffff0000u); }
        LDS_WAIT(); asm volatile("" ::: "memory");
#pragma unroll
        for (int i = 0; i < 8; ++i) { const int row = q + 8 * i; const LAS unsigned* tp = tl + row * 33 + 4 * seg;
            v4u o; o.x = tp[0]; o.y = tp[1]; o.z = tp[2]; o.w = tp[3];
            *(v4u*)(dst + (size_t)row * 1024) = o; }
        LDS_WAIT(); asm volatile("" ::: "memory");
    }
}

__device__ __forceinline__ void phase_mix_naive(Frame& F, int l) {
    const bool last = (l == DEPTH - 1);
    SUBPR_START(13)
    { const int gw = F.bid * NWAVES + F.wave, NGW = F.G * NWAVES;
      for (int it = gw; it < 4096; it += NGW) attn_item(F, l, it);
      if (!last && F.wave == 3 && F.bid < 128) attn_item(F, l, 4096 + F.bid); }
    SUBPR_STOP(13)
    SUBPR_START(15)
    if (!last) { const int rank = F.wave * F.G + F.bid, NR = F.G * NWAVES;
      LAS float* wl = (LAS float*)(F.lds + F.wave * 4096);
      for (int it = rank; it < 256 + 512; it += NR) {
          if (it < 256) hyena_ctx_wave(F, l, it, wl, (LAS f32x2*)(wl + 512));
          else { const int j = it - 256; fnet_ctx_wave(F, j >> 8, (j >> 6) & 3, j & 63, (LAS f32x2*)wl, (LAS f32x2*)(wl + 512)); } } }
    SUBPR_STOP(15)
    __syncthreads();
    SUBPR_START(14)
    for (int c = F.bid; c < 256; c += F.G) hyena_item_fft(F, l, c);
    SUBPR_STOP(14)
    SUBPR_START(16)
    for (int it = F.bid; it < 256; it += F.G) fnet_item_fft(F, it >> 7, (it >> 5) & 3, it & 31);
    SUBPR_STOP(16)
}

__device__ __forceinline__ void small_gemm_partial(Frame& F, const bf16* A, int lda, const bf16* Bt, int ldb, int k0w, int kw, int row0, int col0) {
    typedef short bf16x8_t __attribute__((ext_vector_type(8))); typedef float f32x16_t __attribute__((ext_vector_type(16)));
    LAS float* part = (LAS float*)F.lds;
    const int r = F.lane & 31, h = F.lane >> 5, k0 = k0w + 8 * h;
    const bf16* ap = A + (size_t)(row0 + r) * lda + k0; const bf16* bp0 = Bt + (size_t)(col0 + r) * ldb + k0; const bf16* bp1 = bp0 + (size_t)32 * ldb;
    f32x16_t acc0, acc1;
#pragma unroll
    for (int q = 0; q < 16; ++q) { acc0[q] = 0.f; acc1[q] = 0.f; }
#pragma unroll 8
    for (int k = 0; k < kw; k += 16) { const bf16x8_t a = *(const bf16x8_t*)(ap + k), b0 = *(const bf16x8_t*)(bp0 + k), b1 = *(const bf16x8_t*)(bp1 + k);
        acc0 = __builtin_amdgcn_mfma_f32_32x32x16_bf16(b0, a, acc0, 0, 0, 0); acc1 = __builtin_amdgcn_mfma_f32_32x32x16_bf16(b1, a, acc1, 0, 0, 0); }
#pragma unroll
    for (int q = 0; q < 16; ++q) { const int col = (q & 3) + 8 * (q >> 2) + 4 * h; part[(F.wave * 64 + col) * 32 + r] = acc0[q]; part[(F.wave * 64 + 32 + col) * 32 + r] = acc1[q]; }
    __syncthreads();
}
__device__ __forceinline__ f32x4 small_gemm_reduce(Frame& F, int w0, int w1) {
    const LAS float* part = (const LAS float*)F.lds;
    const int tok = F.tid & 31, cq = F.tid >> 5; f32x4 s = {0.f, 0.f, 0.f, 0.f};
    for (int w = w0; w < w1; ++w)
#pragma unroll
        for (int e = 0; e < 4; ++e) s[e] += part[(w * 64 + 4 * cq + e) * 32 + tok];
    return s;
}
__device__ __forceinline__ f32x4 small_gemm_tile(Frame& F, const bf16* A, int lda, const bf16* Bt, int ldb, int kbeg, int klen, int row0, int col0) {
    const int kw = klen >> 3;
    small_gemm_partial(F, A, lda, Bt, ldb, kbeg + F.wave * kw, kw, row0, col0);
    const f32x4 s = small_gemm_reduce(F, 0, 8);
    __syncthreads();
    return s;
}
__device__ __forceinline__ void ctx_merge(Frame& F, int l) {
    for (int it = F.bid; it < 256; it += F.G) { const int row0 = ML + (it >> 4) * 32, col0 = (it & 15) * 64;
        const bf16* A = (const bf16*)(wsp(F) + WS_AM); const bf16* Bt = ((const bf16*)(wsp(F) + WS_WPA)) + (size_t)l * 1024 * 1024; const unsigned char* G8 = (const unsigned char*)(wsp(F) + WS_PR);
        const int row = row0 + (F.tid & 31), col = col0 + 4 * (F.tid >> 5); f32x4 tot = {0.f, 0.f, 0.f, 0.f};
        small_gemm_partial(F, A, 1024, Bt, 1024, 128 * F.wave, 128, row0, col0);
#pragma unroll
        for (int br = 0; br < 3; ++br) { const f32x4 p = small_gemm_reduce(F, br == 0 ? 0 : (br == 1 ? 4 : 6), br == 0 ? 4 : (br == 1 ? 6 : 8));
            const unsigned gw = *(const unsigned*)(G8 + (size_t)row * 3072 + br * 1024 + col);
            tot[0] += (float)(gw & 0xffu) * p[0]; tot[1] += (float)((gw >> 8) & 0xffu) * p[1]; tot[2] += (float)((gw >> 16) & 0xffu) * p[2]; tot[3] += (float)(gw >> 24) * p[3]; }
        __syncthreads();
        tot = tot * (1.0f / 255.0f);
        v2u o; o.x = pk2(tot[0], tot[1]); o.y = pk2(tot[2], tot[3]); *(v2u*)(((bf16*)(wsp(F) + WS_M)) + (size_t)row * 1024 + col) = o; }
}
__device__ __forceinline__ void ctx_resid(Frame& F, const bf16* A, int K, const bf16* Bt, const float* gate_ctx  ) {
    for (int it = F.bid; it < 256; it += F.G) { const int row0 = ML + (it >> 4) * 32, col0 = (it & 15) * 64;
        const f32x4 p = small_gemm_tile(F, A, K, Bt, K, 0, K, row0, col0);
        const int row = row0 + (F.tid & 31), col = col0 + 4 * (F.tid >> 5);
        bf16* xp = ((bf16*)(wsp(F) + WS_XS)) + (size_t)row * 1024 + col;
        const v2u xw = *(const v2u*)xp; const f32x4 gv = *(const f32x4*)(gate_ctx + col);
        v2u o; o.x = pk2(bflo(xw.x) + gv[0] * p[0], bfhi(xw.x) + gv[1] * p[1]); o.y = pk2(bflo(xw.y) + gv[2] * p[2], bfhi(xw.y) + gv[3] * p[3]);
        *(v2u*)xp = o; }
}

constexpr int NPL = 11;
constexpr int NPHASES = 1 + DEPTH * NPL + 1;
#ifndef ONE_LAUNCH
#define ONE_LAUNCH 1
#endif

__global__ void __launch_bounds__(NTHREADS, 2) fwd_kernel(Args args) {
    extern __shared__ __attribute__((aligned(16))) unsigned char lds[];
    Frame F;
    F.lds = (LAS unsigned char*)lds;
    F.tid = threadIdx.x; F.lane = F.tid & 63; F.wave = __builtin_amdgcn_readfirstlane(F.tid >> 6);
    F.G = gridDim.x; F.bid = blockIdx.x;
    unsigned char* ws = args.ws; F.ws = ws;
    F.ctl = (unsigned*)(ws + WS_CTL);
    F.a = &args; F.z = 0;
    volatile LAS unsigned* MISC = (volatile LAS unsigned*)(F.lds + MISC_OFF);
    for (int u = F.tid; u < 64; u += NTHREADS) MISC[u] = 0u;
    __syncthreads();
    const int lo = args.ph_lo, hi = args.ph_hi;
    XcdBarrier bar; bar.bar = F.ctl + CW_BAR; bar.x = 0; bar.st = nullptr;
    if (hi - lo > 1) bar = xcd_barrier_post(F.ctl + CW_BAR, MISC + 8);
    F.pr_acc = 0ull; F.pr_t0 = 0ull;
#define PR_TYPE(k) ((k) == 0 ? 11 : ((k) == 1 + DEPTH * NPL ? 12 : (((k) - 1) % NPL)))
#ifndef PROBE_LAYERS
#define PROBE_LAYERS 0xF
#endif
#define PR_LAYER(k) ((k) == 0 || (k) == 1 + DEPTH * NPL ? 0 : (((k) - 1) / NPL))
#define PR_START(k) if (PROBE_MASK && ((PROBE_MASK >> PR_TYPE(k)) & 1) && ((PROBE_LAYERS >> PR_LAYER(k)) & 1)) F.pr_t0 = __builtin_amdgcn_s_memrealtime();
#define PR_STOP(k) if (PROBE_MASK && ((PROBE_MASK >> PR_TYPE(k)) & 1) && ((PROBE_LAYERS >> PR_LAYER(k)) & 1)) F.pr_acc += __builtin_amdgcn_s_memrealtime() - F.pr_t0;
#define PH_BEGIN(k) if (lo <= (k) && (k) < hi) { PR_START(k) { int t_ = threadIdx.x; asm volatile("" : "+v"(t_)); F.tid = t_; F.lane = t_ & 63; F.wave = __builtin_amdgcn_readfirstlane(t_ >> 6); int z_ = 0; asm volatile("" : "+s"(z_)); F.z = z_; }
#define PH_END(k) if ((k) + 1 < hi) xcd_barrier_impl(bar.bar, bar.x, bar.st); PR_STOP(k) }

    PH_BEGIN(0) phase_prologue(F); PH_END(0)

    for (int l = 0; l < DEPTH; ++l) {
        const int pb = 1 + l * NPL;
        const float* modl = ((float*)(wsp(F) + WS_CTL) + CW_MOD) + (size_t)l * 3 * 6144;
        const bool moe = (l & 1) != 0; const int fi = l >> 1;

        PH_BEGIN(pb + 0)
            if (l > 0 && ((l - 1) & 1)) phase_norm<false, true, true>(F, l, nullptr, nullptr, inp(F, I_N1G) + l * 1024, 0, nullptr, MT, F.G > 64 ? 8 : 0);
            else if (l == 0) phase_norm<false, false, true, false>(F, l, inp(F, I_X), inp(F, I_CTX), inp(F, I_N1G) + l * 1024, 0, nullptr, MT, F.G > 64 ? 8 : 0);
            else phase_norm<false, false, true>(F, l, nullptr, nullptr, inp(F, I_N1G) + l * 1024, 0, nullptr, MT, F.G > 64 ? 8 : 0);
            for (int it = F.bid; it < 264; it += F.G) { if (it < 256) filter_tile(F, l, SEQ, it * 32, ((float*)(wsp(F) + WS_HF)), it == F.bid); else filter_tile(F, l, CTXL, (it - 256) * 32, ((float*)(wsp(F) + WS_HFC)), it == F.bid); }
        PH_END(pb + 0)

        PH_BEGIN(pb + 1)
            pg8::Gemm g{((bf16*)(wsp(F) + WS_H)), ((bf16*)(wsp(F) + WS_WIN)) + (size_t)l * INW * 1024, MT, INW, 1024}; pg8::StaticOrder S; S.init(MT, INW, F.G, F.bid);
            pg8::EpiIn E{wsp(F), l};
            pg8::gemm_phase<pg8::EpiIn, pg8::StaticOrder, true, true>(F.lds, g, S, E);
        PH_END(pb + 1)


        PH_BEGIN(pb + 3) phase_mix_naive(F, l); PH_END(pb + 3)

        PH_BEGIN(pb + 4) phase_trans(F); PH_END(pb + 4)

        PH_BEGIN(pb + 5)
            if (l != DEPTH - 1) ctx_merge(F, l);
            pg8::Gemm g{((bf16*)(wsp(F) + WS_AM)), ((bf16*)(wsp(F) + WS_WPA)) + (size_t)l * 1024 * 1024, ML, 1024, 1024}; pg8::StaticOrder S; S.init(ML, 1024, F.G, F.bid);
            pg8::EpiMerge E{((const unsigned char*)(wsp(F) + WS_PR)), ((bf16*)(wsp(F) + WS_M))};
            pg8::gemm_phase<pg8::EpiMerge, pg8::StaticOrder, true, true>(F.lds, g, S, E);
        PH_END(pb + 5)

        PH_BEGIN(pb + 6)
            if (l != DEPTH - 1) ctx_resid(F, (const bf16*)(wsp(F) + WS_M), 1024, ((const bf16*)(wsp(F) + WS_WO)) + (size_t)l * 1024 * 1024, modl + 2 * 6144 + 2048);
            pg8::Gemm g{((bf16*)(wsp(F) + WS_M)), ((bf16*)(wsp(F) + WS_WO)) + (size_t)l * 1024 * 1024, ML, 1024, 1024}; pg8::StaticOrder S; S.init(ML, 1024, F.G, F.bid);
            pg8::EpiResid E{((bf16*)(wsp(F) + WS_XS)), modl + 2048};
            pg8::gemm_phase<pg8::EpiResid, pg8::StaticOrder, true, true>(F.lds, g, S, E);
        PH_END(pb + 6)

        PH_BEGIN(pb + 7)
            if (moe) phase_norm<true, false, true>(F, l, nullptr, nullptr, inp(F, I_N2G) + l * 1024, 3072, inp(F, I_ROUTER) + (size_t)fi * 1024 * 8, MT);
            else phase_norm<false, false, true>(F, l, nullptr, nullptr, inp(F, I_N2G) + l * 1024, 3072, nullptr, MT);
        PH_END(pb + 7)


        PH_BEGIN(pb + 9)
            LAS int* poff = (LAS int*)(F.lds + LDS_TAB + 64);
            if (moe) {
                moe_offsets(F, l, poff);
                LAS unsigned* gtab = (LAS unsigned*)(F.lds + LDS_TAB + 128);
                pg8::Gemm g{((bf16*)(wsp(F) + WS_H)), ((bf16*)(wsp(F) + WS_MGU)) + (size_t)(fi * 8) * 5632 * 1024, MOE_MAXP * 256, 8 * 5632, 1024}; pg8::MoeOrder S{22, F.G, F.bid, poff, gtab};
                {
                    const unsigned* cnt = (const unsigned*)(wsp(F) + WS_CTL) + CW_CNT + l * 64; const unsigned* toke = (const unsigned*)(wsp(F) + WS_TOKE);
                    pg8::Unit u;
                    for (int i = 0; S.next(i, u); ++i) { const int e = u.pn / 22, local = u.pm - poff[e];
                        if (F.tid < 256) { const int pos = local * 256 + F.tid; const unsigned ce = __hip_atomic_load(cnt + e, __ATOMIC_RELAXED, __HIP_MEMORY_SCOPE_AGENT);
                            unsigned tok = 0u; if ((unsigned)pos < ce) tok = toke[(size_t)e * MT + pos];
                            gtab[i * 256 + F.tid] = (tok < (unsigned)MT ? tok : 0u) * 2048u; } }
                    __syncthreads(); }
                pg8::EpiSwiglu E{((bf16*)(wsp(F) + WS_HIDG)), DFF, 22};
                pg8::gemm_phase<pg8::EpiSwiglu, pg8::MoeOrder, true, true, true>(F.lds, g, S, E);
            } else {
                pg8::Gemm g{((bf16*)(wsp(F) + WS_H)), ((bf16*)(wsp(F) + WS_FGU)) + (size_t)fi * 5632 * 1024, MT, 5632, 1024}; pg8::StaticOrder S; S.init(MT, 5632, F.G, F.bid);
                pg8::EpiSwiglu E{((bf16*)(wsp(F) + WS_HID)), DFF, 22};
                pg8::gemm_phase<pg8::EpiSwiglu, pg8::StaticOrder, true, true>(F.lds, g, S, E);
            }
        PH_END(pb + 9)

        PH_BEGIN(pb + 10)
            LAS int* poff = (LAS int*)(F.lds + LDS_TAB + 64);
            if (moe) {
                moe_offsets(F, l, poff);
                pg8::Gemm g{((bf16*)(wsp(F) + WS_HIDG)), ((bf16*)(wsp(F) + WS_MD)) + (size_t)(fi * 8) * 1024 * 2816, MOE_MAXP * 256, 8 * 1024, DFF}; pg8::MoeOrder S{4, F.G, F.bid, poff, nullptr};
                pg8::EpiStore E{((bf16*)(wsp(F) + WS_Y)), 1024, 4};
                pg8::gemm_phase<pg8::EpiStore, pg8::MoeOrder, true, true>(F.lds, g, S, E);
            } else {
                ctx_resid(F, (const bf16*)(wsp(F) + WS_HID), DFF, ((const bf16*)(wsp(F) + WS_FD)) + (size_t)fi * 1024 * 2816, modl + 2 * 6144 + 5120);
                pg8::Gemm g{((bf16*)(wsp(F) + WS_HID)), ((bf16*)(wsp(F) + WS_FD)) + (size_t)fi * 1024 * 2816, ML, 1024, DFF}; pg8::StaticOrder S; S.init(ML, 1024, F.G, F.bid);
                pg8::EpiResid E{((bf16*)(wsp(F) + WS_XS)), modl + 5120};
                pg8::gemm_phase<pg8::EpiResid, pg8::StaticOrder, true, true>(F.lds, g, S, E);
            }
        PH_END(pb + 10)
    }
    PH_BEGIN(1 + DEPTH * NPL) phase_norm<false, true, false>(F, DEPTH - 1, nullptr, nullptr, nullptr, 0, nullptr, ML); PH_END(1 + DEPTH * NPL)
#undef PH_BEGIN
#undef PH_END
    if (PROBE_MASK && blockIdx.x == 0) { const unsigned long long t0 = __builtin_amdgcn_s_memrealtime(); while (__builtin_amdgcn_s_memrealtime() - t0 < F.pr_acc * PROBE_AMP) __builtin_amdgcn_s_sleep(8); }
}

extern "C" void kernel_launch(void* const* d_in, const int* in_sizes, int n_in, void* d_out, int out_size, void* d_ws, size_t ws_size, hipStream_t stream) {
    static int grid = 0;
    if (grid == 0) {
        if (n_in != 33 || out_size != ML * DM || ws_size < WS_END2) { fprintf(stderr, "kernel_launch: unexpected shapes (n_in %d out %d ws %zu need %zu)\n", n_in, out_size, ws_size, (size_t)WS_END2); grid = -1; return; }
        int dev = 0, cus = 0, per_cu = 0;
        if (hipGetDevice(&dev) != hipSuccess || hipDeviceGetAttribute(&cus, hipDeviceAttributeMultiprocessorCount, dev) != hipSuccess) { grid = -1; return; }
        if (hipFuncSetAttribute((const void*)fwd_kernel, hipFuncAttributeMaxDynamicSharedMemorySize, LDS_BYTES) != hipSuccess) { fprintf(stderr, "kernel_launch: hipFuncSetAttribute failed\n"); grid = -1; return; }
        if (hipOccupancyMaxActiveBlocksPerMultiprocessor(&per_cu, (const void*)fwd_kernel, NTHREADS, LDS_BYTES) != hipSuccess || per_cu < 1) { fprintf(stderr, "kernel_launch: occupancy query says %d\n", per_cu); }
        (void)hipGetLastError();
        grid = cus;
    }
    if (grid < 0) return;
    if (hipMemsetAsync((char*)d_ws + WS_CTL, 0, CTL_ZERO_BYTES, stream) != hipSuccess) return;
    Args a{};
    for (int i = 0; i < 33; ++i) a.in[i] = (const float*)d_in[i];
    a.in[33] = (const float*)d_out; a.ws = (unsigned char*)d_ws;
#if ONE_LAUNCH
    a.ph_lo = 0; a.ph_hi = NPHASES;
    hipLaunchKernelGGL(fwd_kernel, dim3(grid), dim3(NTHREADS), LDS_BYTES, stream, a);
#else
    for (int k = 0; k < NPHASES; ++k) {
        if (k >= 1 && k < NPHASES - 1) { const int l = (k - 1) / NPL, p = (k - 1) % NPL; if ((l & 1) == 0 && p == 8) continue; }
        a.ph_lo = k; a.ph_hi = k + 1;
        hipLaunchKernelGGL(fwd_kernel, dim3(grid), dim3(NTHREADS), LDS_BYTES, stream, a);
    }
#endif
}
```

```cpp
#include <hip/hip_runtime.h>
#include <cstdio>
#include <cstdint>
#ifndef PROBE_MASK
#define PROBE_MASK 0
#endif
#ifndef PROBE_AMP
#define PROBE_AMP 4
#endif
#define SUBPR_START(t) if (PROBE_MASK && ((PROBE_MASK >> (t)) & 1)) { __syncthreads(); F.pr_t0 = __builtin_amdgcn_s_memrealtime(); }
#define SUBPR_STOP(t) if (PROBE_MASK && ((PROBE_MASK >> (t)) & 1)) { __syncthreads(); F.pr_acc += __builtin_amdgcn_s_memrealtime() - F.pr_t0; }
namespace pg8 {
#define PG8_LAS __attribute__((address_space(3)))
typedef unsigned short bf16_t;
typedef short bf16x8 __attribute__((ext_vector_type(8)));
typedef float f32x4 __attribute__((ext_vector_type(4)));
typedef unsigned u32x4 __attribute__((ext_vector_type(4)));
constexpr int BM = 256, BK = 64, HALF = 128, HTB = HALF * BK * 2  , STAGE_BYTES = 8 * HTB, NXCD = 8, WGM = 8;

__host__ __device__ __forceinline__ int lds_byte(int r, int c) { const int st = (r >> 4) * 2 + (c >> 5), rr = r & 15, cc = c & 31, ob = rr * 64 + cc * 2; return st * 1024 + (ob ^ (((ob >> 9) & 1) << 5)); }
__host__ __device__ __forceinline__ void stage_rc(int b, int& R, int& C) { const int st = b / 1024, sb = b % 1024, swz = sb ^ (((sb >> 9) & 1) << 5); R = (st >> 1) * 16 + swz / 64; C = (st & 1) * 32 + (swz % 64) / 2; }
__host__ __device__ __forceinline__ int perm32(int rho) { const int n = rho >> 4, i = rho & 15; return 8 * (i >> 2) + 4 * n + (i & 3); }

struct Unit { int pm, pn; };
struct Gemm { const bf16_t* A; const bf16_t* Bt; int M, N, K; };

struct StaticOrder {
    int nM, nN, nwg, G, c;
    __host__ __device__ void init(int M, int N, int G_, int c_) { nM = M / BM; nN = N / BM; nwg = nM * nN; G = G_; c = c_; }
    __host__ __device__ bool next(int i, Unit& u) const {
        const long L = (long)i * G + c; if (L >= nwg) return false;
        int wgid = (int)L; { const int q = nwg / NXCD, r = nwg % NXCD, xcd = wgid % NXCD, off = wgid / NXCD; wgid = (xcd < r ? xcd * (q + 1) : r * (q + 1) + (xcd - r) * q) + off; }
        const int nig = WGM * nN, gid = wgid / nig, fm = gid * WGM, gsz = (nM - fm) < WGM ? (nM - fm) : WGM;
        u.pm = fm + ((wgid % nig) % gsz); u.pn = (wgid % nig) / gsz; return true;
    }
    __device__ __forceinline__ void a_ready(const Unit&) const {}
    __device__ __forceinline__ void done(const Unit&) const {}
};

__device__ __forceinline__ unsigned cvt_pk_bf16(float lo, float hi) { typedef float f32x2_c __attribute__((ext_vector_type(2))); typedef __bf16 bf16x2_c __attribute__((ext_vector_type(2))); f32x2_c v = {lo, hi}; bf16x2_c b = __builtin_convertvector(v, bf16x2_c); return __builtin_bit_cast(unsigned, b); }
typedef float f32x2 __attribute__((ext_vector_type(2)));
template <class Epi, class Sched, bool ALIGN_EPI = false, bool SP2 = false, bool GATHER_A = false>
__device__ __forceinline__ void gemm_phase(PG8_LAS unsigned char* lds, const Gemm g, const Sched& S, const Epi& E) {
    int tid_ = threadIdx.x; asm volatile("" : "+v"(tid_)); const int tid = tid_, wid = __builtin_amdgcn_readfirstlane(tid >> 6), lane = tid & 63, wr = wid >> 2, wc = wid & 3, fr = lane & 15, fq = lane >> 4;
    const int K = g.K, nt = K / BK;
    unsigned voffA[2], voffB[2];
#pragma unroll
    for (int i = 0; i < 2; ++i) { int R, C; stage_rc(tid * 16 + i * 8192, R, C); const int Rb = Epi::PERM ? ((R & ~31) + perm32(R & 31)) : R;
        voffA[i] = (unsigned)(R * K + C) * 2u; voffB[i] = (unsigned)(Rb * K + C) * 2u; }
    const size_t kstep = (size_t)(BK * 2);
    const size_t hstep = (size_t)HALF * K * 2;
    const size_t tstep = 2 * hstep;
    const unsigned ldsw = (unsigned)wid * 1024u;
    const int aoff = lds_byte(wr * 64 + fr, fq * 8), boff = lds_byte(wc * 32 + fr, fq * 8);
#define PG8_SA(b, h) (((b) * 2 + (h)) * HTB)
#define PG8_SB(b, h) ((4 + (b) * 2 + (h)) * HTB)
#define PG8_STAGE(bufoff, gbase, voff) do { _Pragma("unroll") for (int _i = 0; _i < 2; ++_i) \
        __builtin_amdgcn_global_load_lds((const unsigned*)((const char*)(gbase) + (voff)[_i]), (PG8_LAS unsigned*)(lds + (bufoff) + ldsw + _i * 8192), 16, 0, 0); } while (0)
#define PG8_STAGE_A(bufoff, pA, kg, hh) do { if constexpr (GATHER_A) { _Pragma("unroll") for (int _i = 0; _i < 2; ++_i) \
        __builtin_amdgcn_global_load_lds((const unsigned*)((const char*)(kg) + cG[hh][_i]), (PG8_LAS unsigned*)(lds + (bufoff) + ldsw + _i * 8192), 16, 0, 0); } else { PG8_STAGE(bufoff, (pA) + (hh) * hstep, voffA); } } while (0)
#define PG8_LDA(dst, b, h) do { _Pragma("unroll") for (int m = 0; m < 4; ++m) _Pragma("unroll") for (int k = 0; k < 2; ++k) dst[m][k] = *(const PG8_LAS bf16x8*)(lds + PG8_SA(b, h) + aoff + m * 2048 + k * 1024); } while (0)
#define PG8_LDB(dst, b, h) do { _Pragma("unroll") for (int n = 0; n < 2; ++n) _Pragma("unroll") for (int k = 0; k < 2; ++k) dst[n][k] = *(const PG8_LAS bf16x8*)(lds + PG8_SB(b, h) + boff + n * 2048 + k * 1024); } while (0)
#define PG8_MMA(ai, bj, At, Bt) do { __builtin_amdgcn_s_setprio(1); _Pragma("unroll") for (int m = 0; m < 4; ++m) _Pragma("unroll") for (int n = 0; n < 2; ++n) _Pragma("unroll") for (int k = 0; k < 2; ++k) \
        acc[ai][bj][m][n] = __builtin_amdgcn_mfma_f32_16x16x32_bf16(Bt[n][k], At[m][k], acc[ai][bj][m][n], 0, 0, 0); __builtin_amdgcn_s_setprio(0); } while (0)
#define PG8_WAIT_V(n) asm volatile("s_waitcnt vmcnt(" #n ")" ::: "memory")
#define PG8_WAIT_L(n) asm volatile("s_waitcnt lgkmcnt(" #n ")" ::: "memory")
#define PG8_BAR __builtin_amdgcn_s_barrier()
#define PG8_SCHED __builtin_amdgcn_sched_barrier(0)
    Unit cur, nxt; int ui = 0;
    if (!S.next(0, cur)) return;
    f32x4 acc[2][2][4][2];
#pragma unroll
    for (int a = 0; a < 2; ++a)
#pragma unroll
        for (int b = 0; b < 2; ++b)
#pragma unroll
            for (int m = 0; m < 4; ++m)
#pragma unroll
                for (int n = 0; n < 2; ++n) acc[a][b][m][n] = (f32x4){0.f, 0.f, 0.f, 0.f};
    bf16x8 At[4][2], B0[2][2], B1[2][2];
    const char* cA = (const char*)g.A + (size_t)cur.pm * tstep; const char* cB = (const char*)g.Bt + (size_t)cur.pn * tstep;
    S.a_ready(cur);
    unsigned cG[2][2] = {{0u, 0u}, {0u, 0u}}; const char* const gA = (const char*)g.A;
    auto load_cg = [&](int uidx) {
        if constexpr (GATHER_A) {
#pragma unroll
            for (int i = 0; i < 2; ++i) { int R, C; stage_rc(tid * 16 + i * 8192, R, C);
#pragma unroll
                for (int hh = 0; hh < 2; ++hh) cG[hh][i] = S.gtab[uidx * 256 + hh * HALF + R] + (unsigned)(C * 2); } } };
    load_cg(0);
    if constexpr (SP2) {
        PG8_STAGE(PG8_SB(0, 0), cB, voffB); PG8_STAGE(PG8_SB(0, 1), cB + hstep, voffB); PG8_STAGE_A(PG8_SA(0, 0), cA, gA, 0); PG8_STAGE_A(PG8_SA(0, 1), cA, gA, 1);
        if (wr == 1) PG8_BAR;
        PG8_WAIT_V(2); PG8_BAR;
        PG8_STAGE(PG8_SB(1, 0), cB + kstep, voffB); PG8_STAGE_A(PG8_SA(1, 0), cA + kstep, gA + kstep, 0); PG8_STAGE(PG8_SB(1, 1), cB + hstep + kstep, voffB);
        PG8_WAIT_V(6); PG8_BAR;
    } else {
        PG8_STAGE(PG8_SB(0, 0), cB, voffB); PG8_STAGE(PG8_SA(0, 0), cA, voffA); PG8_STAGE(PG8_SB(0, 1), cB + hstep, voffB); PG8_STAGE(PG8_SA(0, 1), cA + hstep, voffA);
        if (wr == 1) PG8_BAR;
        PG8_WAIT_V(4); PG8_BAR;
        PG8_STAGE(PG8_SB(1, 0), cB + kstep, voffB); PG8_STAGE(PG8_SA(1, 0), cA + kstep, voffA); PG8_STAGE(PG8_SB(1, 1), cB + hstep + kstep, voffB);
        PG8_WAIT_V(6); PG8_BAR;
    }
    for (;;) {
        const bool has_next = S.next(ui + 1, nxt);
        const char* nA = has_next ? (const char*)g.A + (size_t)nxt.pm * tstep : cA; const char* nB = has_next ? (const char*)g.Bt + (size_t)nxt.pn * tstep : cB;
        for (int t = 0; t < nt; t += 2) {
            if constexpr (Epi::HOOK) { if (E.hook_at(t)) E.hook(acc, cur, t, wr, wc, fr, fq); }
            const bool last = (t == nt - 2);
            const char* a1 = cA + (size_t)(t + 1) * kstep;
            const char* a2 = last ? nA : cA + (size_t)(t + 2) * kstep; const char* b2 = last ? nB : cB + (size_t)(t + 2) * kstep;
            const char* a3 = a2 + kstep; const char* b3 = b2 + kstep;
            const char* g1 = gA + (size_t)(t + 1) * kstep; const char* g2 = last ? gA : gA + (size_t)(t + 2) * kstep; const char* g3 = g2 + kstep;
            if (last && has_next) S.a_ready(nxt);
            if constexpr (SP2) {
            PG8_LDB(B0, 0, 0); PG8_LDB(B1, 0, 1); PG8_SCHED; PG8_LDA(At, 0, 0); PG8_STAGE_A(PG8_SA(1, 1), a1, g1, 1);
            if constexpr (GATHER_A) { if (last && has_next) load_cg(ui + 1); }
            PG8_WAIT_V(8); PG8_WAIT_L(0); PG8_BAR; PG8_MMA(0, 0, At, B0); PG8_MMA(0, 1, At, B1); PG8_BAR; PG8_SCHED;
            PG8_LDA(At, 0, 1); PG8_STAGE(PG8_SB(0, 0), b2, voffB); PG8_STAGE(PG8_SB(0, 1), b2 + hstep, voffB); PG8_STAGE_A(PG8_SA(0, 0), a2, g2, 0);
            PG8_WAIT_V(8); PG8_WAIT_L(0); PG8_BAR; PG8_MMA(1, 0, At, B0); PG8_MMA(1, 1, At, B1); PG8_BAR; PG8_SCHED;
            PG8_LDB(B0, 1, 0); PG8_LDB(B1, 1, 1); PG8_SCHED; PG8_LDA(At, 1, 0); PG8_STAGE_A(PG8_SA(0, 1), a2, g2, 1);
            PG8_WAIT_V(8); PG8_WAIT_L(0); PG8_BAR; PG8_MMA(0, 0, At, B0); PG8_MMA(0, 1, At, B1); PG8_BAR; PG8_SCHED;
            PG8_LDA(At, 1, 1); PG8_STAGE(PG8_SB(1, 0), b3, voffB); PG8_STAGE(PG8_SB(1, 1), b3 + hstep, voffB); PG8_STAGE_A(PG8_SA(1, 0), a3, g3, 0);
            PG8_WAIT_V(8); PG8_WAIT_L(0); PG8_BAR; PG8_MMA(1, 0, At, B0); PG8_MMA(1, 1, At, B1); PG8_BAR; PG8_SCHED;
            } else {
            PG8_LDB(B0, 0, 0); PG8_SCHED; PG8_LDA(At, 0, 0); PG8_STAGE(PG8_SA(1, 1), a1 + hstep, voffA);
            PG8_WAIT_L(8); PG8_BAR; PG8_WAIT_L(0); PG8_MMA(0, 0, At, B0); PG8_BAR; PG8_SCHED;
            PG8_LDB(B1, 0, 1); PG8_STAGE(PG8_SB(0, 0), b2, voffB);
            PG8_BAR; PG8_WAIT_L(0); PG8_MMA(0, 1, At, B1); PG8_BAR;
            PG8_LDA(At, 0, 1); PG8_STAGE(PG8_SA(0, 0), a2, voffA);
            PG8_BAR; PG8_WAIT_L(0); PG8_MMA(1, 0, At, B0); PG8_BAR; PG8_SCHED;
            PG8_STAGE(PG8_SB(0, 1), b2 + hstep, voffB);
            PG8_WAIT_V(6); PG8_BAR; PG8_MMA(1, 1, At, B1); PG8_BAR;
            PG8_LDB(B0, 1, 0); PG8_SCHED; PG8_LDA(At, 1, 0); PG8_STAGE(PG8_SA(0, 1), a2 + hstep, voffA);
            PG8_WAIT_L(8); PG8_BAR; PG8_WAIT_L(0); PG8_MMA(0, 0, At, B0); PG8_BAR; PG8_SCHED;
            PG8_LDB(B1, 1, 1); PG8_STAGE(PG8_SB(1, 0), b3, voffB);
            PG8_BAR; PG8_WAIT_L(0); PG8_MMA(0, 1, At, B1); PG8_BAR;
            PG8_LDA(At, 1, 1); PG8_STAGE(PG8_SA(1, 0), a3, voffA);
            PG8_BAR; PG8_WAIT_L(0); PG8_MMA(1, 0, At, B0); PG8_BAR; PG8_SCHED;
            PG8_STAGE(PG8_SB(1, 1), b3 + hstep, voffB);
            PG8_WAIT_V(6); PG8_BAR; PG8_MMA(1, 1, At, B1); PG8_BAR;
            }
        }
        if constexpr (ALIGN_EPI) { if (wr == 0) PG8_BAR; }
        if constexpr (!Epi::AFTER_DRAIN) { E(acc, cur, wr, wc, fr, fq); S.done(cur); }
        if (!has_next) break;
#pragma unroll
        for (int a = 0; a < 2; ++a)
#pragma unroll
            for (int b = 0; b < 2; ++b)
#pragma unroll
                for (int m = 0; m < 4; ++m)
#pragma unroll
                    for (int n = 0; n < 2; ++n) acc[a][b][m][n] = (f32x4){0.f, 0.f, 0.f, 0.f};
        cur = nxt; cA = nA; cB = nB; ++ui;
        if constexpr (ALIGN_EPI) { if (wr == 1) PG8_BAR; }
    }
    PG8_WAIT_V(0);
    if constexpr (!ALIGN_EPI) { if (wr == 0) PG8_BAR; }
    PG8_BAR;
    if constexpr (Epi::AFTER_DRAIN) { E.fused(acc, cur, wr, wc, fr, fq, lds, wid, lane); S.done(cur); }
#undef PG8_SA
#undef PG8_SB
#undef PG8_STAGE
#undef PG8_STAGE_A
#undef PG8_LDA
#undef PG8_LDB
#undef PG8_MMA
#undef PG8_WAIT_V
#undef PG8_WAIT_L
#undef PG8_BAR
#undef PG8_SCHED
}
}

constexpr int NWAVES = 8, NTHREADS = 512;
constexpr int BATCH = 2, SEQ = 8192, DM = 1024, DEPTH = 4, CTXL = 256;
constexpr int ML = BATCH * SEQ;
constexpr int MC = BATCH * CTXL;
constexpr int MT = ML + MC;
constexpr int HD = 64, NH = 8, NKV = 2;
constexpr int QW = 512, KVW = 128;
constexpr int HYW = 256, FNW = 256;
constexpr int Q_END = 512, K_END = 640, V_END = 768, HY_END = 1536, FN_END = 1792, INW = 4864;
constexpr int DFF = 2816, NEXP = 8;
constexpr int FH = 64, FEMB = 33;
constexpr float EPS = 1e-6f;

constexpr size_t MiB = 1u << 20;
constexpr size_t WS_CTL = 0, CTL_ZERO_BYTES = 64 * 1024, CTL_BYTES = 4 * MiB;
constexpr size_t WS_WIN = 4 * MiB;
constexpr size_t WS_WPA = WS_WIN + 38 * MiB;
constexpr size_t WS_WPH = WS_WPA + 4 * MiB;
constexpr size_t WS_WPF = WS_WPH + 2 * MiB;
constexpr size_t WS_WO = WS_WPF + 2 * MiB;
constexpr size_t WS_FGU = WS_WO + 8 * MiB;
constexpr size_t WS_FD = WS_FGU + 22 * MiB;
constexpr size_t WS_MGU = WS_FD + 11 * MiB;
constexpr size_t WS_MD = WS_MGU + 176 * MiB;
constexpr size_t WS_XC = WS_MD + 88 * MiB;
constexpr size_t WS_H = WS_XC + 2 * MiB;
constexpr size_t WS_COMB = WS_H + 33 * MiB;
constexpr size_t WS_HF = WS_COMB + 1 * MiB;
constexpr size_t WS_HFC = WS_HF + 32 * MiB;
constexpr size_t WS_S = WS_HFC + 1 * MiB;
constexpr size_t WS_PR = WS_S;
constexpr size_t WS_QK = WS_PR + 157 * MiB;
constexpr size_t WS_ATT = WS_QK + 21 * MiB;
constexpr size_t WS_HYO = WS_ATT + 17 * MiB;
constexpr size_t WS_FNO = WS_HYO + 9 * MiB;
constexpr size_t WS_AM = WS_ATT;
constexpr size_t WS_MACC = WS_FNO + 9 * MiB;
constexpr size_t WS_M = WS_MACC + 66 * MiB;
constexpr size_t WS_END = WS_M + 33 * MiB;
constexpr size_t WS_KS = WS_MACC;
constexpr size_t WS_ZS = WS_MACC + 64 * MiB;
constexpr size_t WS_HYT = WS_MACC + 80 * MiB;
constexpr size_t WS_FNT = WS_MACC + 89 * MiB;
static_assert(WS_FNT + 9 * MiB <= WS_MACC + 99 * MiB, "mix scratch inside MACC + M");
constexpr size_t WS_CTMP = WS_M;
constexpr size_t WS_UT = WS_END;
constexpr size_t WS_VT = WS_UT + 33 * MiB;
constexpr size_t WS_KT = WS_VT + 5 * MiB;
constexpr size_t WS_XS = WS_KT + 5 * MiB;
constexpr size_t WS_TOKE = WS_XS + 33 * MiB;
constexpr size_t WS_END2 = WS_TOKE + 1 * MiB;
constexpr int NKB = MT / 32;
constexpr size_t WS_HID = WS_S;
constexpr int MOE_MAXP = 140;
constexpr size_t WS_XG = WS_S;
constexpr size_t WS_HIDG = WS_S + 70 * MiB;
constexpr size_t WS_Y = WS_S + 263 * MiB;
static_assert((size_t)MOE_MAXP * 256 * 2816 * 2 <= 193 * MiB && WS_Y + 70 * MiB <= WS_S + 350 * MiB, "moe scratch");
static_assert((size_t)MT * INW * 2 <= 157 * MiB && (size_t)MT * DFF * 2 <= 157 * MiB, "scratch sizes");
#define EPI_WS_PR WS_PR
#define EPI_WS_UT WS_UT
#define EPI_WS_VT WS_VT
#define EPI_WS_KT WS_KT
#define EPI_WS_QK WS_QK
#define EPI_WS_QKG (WS_CTL + (size_t)CW_QKG * 4)
constexpr int CW_BAR = 4096;
constexpr int CW_QKG = 12288;
constexpr int CW_CNT = 8192;
constexpr int CW_MOD = 262144;
static_assert((CW_MOD + 4 * 3 * 6144) * 4 <= (int)CTL_BYTES && (CW_CNT + 4 * 64) * 4 <= (int)CTL_ZERO_BYTES && (CW_BAR + 3456) * 4 <= (int)CTL_ZERO_BYTES, "ctl");

constexpr int LDS_BYTES = 147456;
constexpr int MISC_OFF = LDS_BYTES - 256;
constexpr int LDS_TAB = 131072;

#define LAS __attribute__((address_space(3)))
typedef unsigned short bf16;
typedef unsigned v4u __attribute__((ext_vector_type(4)));
typedef unsigned v2u __attribute__((ext_vector_type(2)));
typedef float f32x4 __attribute__((ext_vector_type(4)));
typedef float f32x2 __attribute__((ext_vector_type(2)));
#define LDS_WAIT() asm volatile("s_waitcnt lgkmcnt(0)" ::: "memory")
__device__ __forceinline__ unsigned f2bf(float f) { unsigned u = __builtin_bit_cast(unsigned, f); return (u + 0x7fffu + ((u >> 16) & 1u)) >> 16; }
__device__ __forceinline__ unsigned pk2(float lo, float hi) { return f2bf(lo) | (f2bf(hi) << 16); }
__device__ __forceinline__ float bf2f(unsigned short h) { return __builtin_bit_cast(float, (unsigned)h << 16); }
__device__ __forceinline__ float bflo(unsigned w) { return __builtin_bit_cast(float, w << 16); }
__device__ __forceinline__ float bfhi(unsigned w) { return __builtin_bit_cast(float, w & 0xffff0000u); }
__device__ __forceinline__ float shx(float v, int lane, int o) { return __builtin_bit_cast(float, __builtin_amdgcn_ds_bpermute((lane ^ o) << 2, __builtin_bit_cast(int, v))); }
__device__ __forceinline__ float wave_sum(float v, int lane) {
#pragma unroll
    for (int o = 1; o < 64; o <<= 1) v += shx(v, lane, o);
    return v;
}
__device__ __forceinline__ float wave_max(float v, int lane) {
#pragma unroll
    for (int o = 1; o < 64; o <<= 1) v = fmaxf(v, shx(v, lane, o));
    return v;
}
__device__ __forceinline__ float sin_rev(float r) { return __builtin_amdgcn_sinf(__builtin_amdgcn_fractf(r)); }
__device__ __forceinline__ float cos_rev(float r) { return __builtin_amdgcn_cosf(__builtin_amdgcn_fractf(r)); }
__device__ __forceinline__ float sigmoidf_(float x) { return __builtin_amdgcn_rcpf(1.0f + __expf(-x)); }
constexpr float INV_2PI = 0.15915494309189535f;

#define XB_TMO      128
#define XB_XCNT(j)  (256  + 64 * (j))
#define XB_XSUB(j)  (1280 + 64 * (j))
#define XB_XGEN(j)  (2304 + 64 * (j))
#define XB_TOP      3328
#define XB_TOPGEN   3392
#define XCD_BAR_WORDS 3456
#define XB_SPIN_CAP (1u << 18)

__device__ __forceinline__ unsigned xb_ld(unsigned* p)              { return __hip_atomic_load(p, __ATOMIC_RELAXED, __HIP_MEMORY_SCOPE_AGENT); }
__device__ __forceinline__ unsigned xb_add(unsigned* p, unsigned v) { return __hip_atomic_fetch_add(p, v, __ATOMIC_RELAXED, __HIP_MEMORY_SCOPE_AGENT); }
__device__ __forceinline__ unsigned xb_xcc_id() { return (unsigned)__builtin_amdgcn_s_getreg((3 << 11) | 20) & 0xFu; }
#define XB_SPIN(cond, bar) do { unsigned _sp = 0; while (cond) { __builtin_amdgcn_s_sleep(1); \
    if ((++_sp & 255u) == 0u) { if (xb_ld(&(bar)[XB_TMO])) break; if (_sp > XB_SPIN_CAP) { atomicAdd(&(bar)[XB_TMO], 1u); break; } } } } while (0)

struct XcdBarrier {
    unsigned* bar; unsigned x;
    volatile LAS unsigned* st;
};

__device__ __forceinline__ XcdBarrier xcd_barrier_post(unsigned* bar, volatile LAS unsigned* st) {
    XcdBarrier b; b.bar = bar; b.x = xb_xcc_id(); b.st = st;
    if (threadIdx.x == 0) (void)xb_add(&bar[XB_XCNT(b.x)], 1u);
    return b;
}
__device__ __forceinline__ void xcd_barrier_complete(unsigned* bar, unsigned x, unsigned& nloc, unsigned& nx) {
    const unsigned G = gridDim.x * gridDim.y * gridDim.z;
    unsigned sum, cnt, mine, sp = 0u;
    for (;;) {
        sum = 0u; cnt = 0u; mine = 0u;
#pragma unroll
        for (unsigned j = 0; j < 16; ++j) { const unsigned c = xb_ld(&bar[XB_XCNT(j)]); sum += c; cnt += (c > 0u) ? 1u : 0u; mine = (j == x) ? c : mine; }
        if (sum == G) break;
        __builtin_amdgcn_s_sleep(1);
        if ((++sp & 255u) == 0u) { if (xb_ld(&bar[XB_TMO])) break; if (sp > XB_SPIN_CAP) { atomicAdd(&bar[XB_TMO], 1u); break; } }
    }
    nloc = mine > 0u ? mine : 1u; nx = cnt > 0u ? cnt : 1u;
}

__device__ __attribute__((noinline)) void xcd_barrier_impl(unsigned* b_bar, unsigned b_x, volatile LAS unsigned* b_st) {
    XcdBarrier b; b.bar = b_bar; b.x = b_x; b.st = b_st;
    asm volatile("s_waitcnt vmcnt(0)" ::: "memory");
    __syncthreads();
    if (threadIdx.x == 0) {
        unsigned* bar = b.bar;
        __builtin_amdgcn_s_waitcnt(0);
        unsigned nloc = b.st[0], nx = b.st[1];
        if (nloc == 0u) { xcd_barrier_complete(bar, b.x, nloc, nx); b.st[0] = nloc; b.st[1] = nx; }
        const unsigned old = xb_add(&bar[XB_XSUB(b.x)], 1u);
        const unsigned gen = old / nloc;
        if (old + 1u == (gen + 1u) * nloc) {
            __builtin_amdgcn_fence(__ATOMIC_RELEASE, "agent");
            asm volatile("s_waitcnt vmcnt(0)" ::: "memory");
            const unsigned og = xb_add(&bar[XB_TOP], 1u);
            const unsigned tg = og / nx;
            if (og + 1u == (tg + 1u) * nx) xb_add(&bar[XB_TOPGEN], 1u);
            else XB_SPIN(xb_ld(&bar[XB_TOPGEN]) == tg, bar);
            __builtin_amdgcn_fence(__ATOMIC_ACQUIRE, "agent");
            xb_add(&bar[XB_XGEN(b.x)], 1u);
            asm volatile("s_waitcnt vmcnt(0)" ::: "memory");
        } else {
            XB_SPIN(xb_ld(&bar[XB_XGEN(b.x)]) == gen, bar);
            __builtin_amdgcn_fence(__ATOMIC_ACQUIRE, "agent");
            asm volatile("s_waitcnt vmcnt(0)" ::: "memory");
        }
    }
    __syncthreads();
}

struct Args { const float* in[34]; unsigned char* ws; int ph_lo, ph_hi; };
struct Frame {
    LAS unsigned char* lds;
    unsigned* ctl;
    unsigned char* ws;
    int tid, lane, wave, G, bid;
    const struct Args* a; int z;
    unsigned long long pr_acc, pr_t0;
};
__device__ __forceinline__ const float* inp(const Frame& F, int i) { return F.a->in[i + F.z]; }
__device__ __forceinline__ float* outp(const Frame& F) { return (float*)F.a->in[33 + F.z]; }
__device__ __forceinline__ unsigned char* wsp(const Frame& F) { return F.a->ws + F.z; }
enum { I_X = 0, I_C, I_CTX, I_CCTX, I_WADA, I_BADA, I_N1G, I_N2G, I_WIN, I_QG, I_KG, I_SINK, I_HCW, I_HCB, I_FW1, I_FB1, I_FF1, I_FW2, I_FB2, I_FF2, I_FW3, I_HBIAS,
       I_WPA, I_WPH, I_WPF, I_WOUT, I_FG, I_FU, I_FDN, I_ROUTER, I_MG, I_MU, I_MDN };

namespace pg8 {
struct EpiStore {
    static constexpr bool PERM = true, AFTER_DRAIN = false, HOOK = false;
    bf16_t* O; int ldc; int ntn;
    __device__ __forceinline__ void operator()(const f32x4 (&acc)[2][2][4][2], const Unit& u, int wr, int wc, int fr, int fq) const {
        const int row0 = u.pm * BM + wr * 64 + fr, col0 = (u.pn % ntn) * BM + wc * 32 + 8 * fq;
#pragma unroll
        for (int ai = 0; ai < 2; ++ai)
#pragma unroll
            for (int m = 0; m < 4; ++m) { bf16_t* rowp = O + (size_t)(row0 + ai * HALF + m * 16) * ldc + col0;
#pragma unroll
                for (int bj = 0; bj < 2; ++bj) { const f32x4 v0 = acc[ai][bj][m][0], v1 = acc[ai][bj][m][1];
                    u32x4 w; w.x = cvt_pk_bf16(v0[0], v0[1]); w.y = cvt_pk_bf16(v0[2], v0[3]); w.z = cvt_pk_bf16(v1[0], v1[1]); w.w = cvt_pk_bf16(v1[2], v1[3]);
                    *(u32x4*)(rowp + bj * HALF) = w; } }
    }
};
struct EpiIn {
    static constexpr bool PERM = true, AFTER_DRAIN = false, HOOK = false;
    unsigned char* ws; int l;
    __device__ __forceinline__ void operator()(const f32x4 (&acc)[2][2][4][2], const Unit& u, int wr, int wc, int fr_, int fq_) const {
        int fr = fr_, fq = fq_; asm volatile("" : "+v"(fr), "+v"(fq));
        constexpr int ldc = 4864, mt = 16896;
        bf16_t* const O = (bf16_t*)(ws + EPI_WS_PR); bf16_t* const UT = (bf16_t*)(ws + EPI_WS_UT); bf16_t* const VT = (bf16_t*)(ws + EPI_WS_VT); bf16_t* const KT = (bf16_t*)(ws + EPI_WS_KT); bf16_t* const QK = (bf16_t*)(ws + EPI_WS_QK);
        const float* const qg = (const float*)(ws + EPI_WS_QKG) + l * 128; const float* const kg = qg + 64;
        const int row0 = u.pm * BM + wr * 64 + fr, col0 = u.pn * BM + wc * 32 + 8 * fq;
        if (u.pn < 2 || (u.pn == 2 && wc < 2)) {
            const bool isk = (u.pn == 2); const float* gain = isk ? kg : qg; const int lane = fr + 16 * fq; const bool rope = u.pm < 64;
            f32x4 gn[2][2]; float invf[4];
#pragma unroll
            for (int bj = 0; bj < 2; ++bj)
#pragma unroll
                for (int n = 0; n < 2; ++n) gn[bj][n] = *(const f32x4*)(gain + 32 * bj + 16 * n + 4 * fq);
#pragma unroll
            for (int e = 0; e < 4; ++e) invf[e] = exp2f(-(float)(4 * fq + e) * (13.287712379549449f / 16.0f)) * 0.15915494309189535f;
            const float osc = isk ? 1.0f : 0.18033688011112042f;
#pragma unroll
            for (int ai = 0; ai < 2; ++ai)
#pragma unroll
                for (int m = 0; m < 4; ++m) { const int row = row0 + ai * HALF + m * 16;
                    float ss = 0.f;
#pragma unroll
                    for (int bj = 0; bj < 2; ++bj)
#pragma unroll
                        for (int n = 0; n < 2; ++n) { const f32x4 v = acc[ai][bj][m][n]; ss += (v[0] * v[0] + v[1] * v[1]) + (v[2] * v[2] + v[3] * v[3]); }
                    { const unsigned sb = __builtin_bit_cast(unsigned, ss); auto r16 = __builtin_amdgcn_permlane16_swap(sb, sb, false, false);
                      ss = __builtin_bit_cast(float, (unsigned)r16[0]) + __builtin_bit_cast(float, (unsigned)r16[1]);
                      const unsigned sc = __builtin_bit_cast(unsigned, ss); auto r32 = __builtin_amdgcn_permlane32_swap(sc, sc, false, false);
                      ss = __builtin_bit_cast(float, (unsigned)r32[0]) + __builtin_bit_cast(float, (unsigned)r32[1]); }
                    const float rstd = 1.0f / sqrtf(ss * (1.0f / 64.0f) + 1e-6f) * osc;
                    const int t = row & 8191;
#pragma unroll
                    for (int bj = 0; bj < 2; ++bj) { const float pos = (float)(bj == 0 ? (t >> 6) : (t & 63));
                        f32x4 o1, o2;
#pragma unroll
                        for (int e = 0; e < 4; ++e) { float cs = 1.f, sn = 0.f;
                            if (rope) { const float rev = __builtin_amdgcn_fractf(pos * invf[e]); cs = __builtin_amdgcn_cosf(rev); sn = __builtin_amdgcn_sinf(rev); }
                            const float y1 = acc[ai][bj][m][0][e] * rstd * gn[bj][0][e], y2 = acc[ai][bj][m][1][e] * rstd * gn[bj][1][e];
                            o1[e] = y1 * cs - y2 * sn; o2[e] = y1 * sn + y2 * cs; }
                        typedef unsigned u32x2v __attribute__((ext_vector_type(2)));
                        u32x2v w1, w2; w1.x = cvt_pk_bf16(o1[0], o1[1]); w1.y = cvt_pk_bf16(o1[2], o1[3]); w2.x = cvt_pk_bf16(o2[0], o2[1]); w2.y = cvt_pk_bf16(o2[2], o2[3]);
                        if (!isk) { bf16_t* qp = QK + (size_t)row * 640 + (4 * u.pn + wc) * 64 + 32 * bj + 4 * fq; *(u32x2v*)qp = w1; *(u32x2v*)(qp + 16) = w2; }
                        else { bf16_t* kp = KT + (unsigned)(((wc * (mt >> 5) + (row >> 5)) * 4 + 2 * bj) * 512 + (fq >> 1) * 256 + (row & 31) * 8 + 4 * (fq & 1)); *(u32x2v*)kp = w1; *(u32x2v*)(kp + 512) = w2; }
                    }
                    asm volatile("" ::: "memory"); __builtin_amdgcn_sched_barrier(0); }
        } else if (u.pn == 2) {
            bf16_t* vb = VT + (unsigned)(((fr >> 2) & 1) * 256 + ((fr >> 3) & 1) * 4 + (fr & 3) + (u.pm * 8 + wr * 2) * 2048 + (wc - 2) * (mt >> 5) * 2048 + fq * 64);
#pragma unroll
            for (int ai = 0; ai < 2; ++ai)
#pragma unroll
                for (int bj = 0; bj < 2; ++bj)
#pragma unroll
                    for (int m = 0; m < 4; ++m)
#pragma unroll
                        for (int n = 0; n < 2; ++n)
#pragma unroll
                            for (int e = 0; e < 4; ++e) vb[bj * 1024 + ai * 4 * 2048 + (m >> 1) * 2048 + (m & 1) * 512 + (4 * n + e) * 8] = (bf16_t)(cvt_pk_bf16(acc[ai][bj][m][n][e], 0.f) & 0xffffu);
        } else if (u.pn < 7) {
#pragma unroll
            for (int ai = 0; ai < 2; ++ai)
#pragma unroll
                for (int bj = 0; bj < 2; ++bj)
#pragma unroll
                    for (int n = 0; n < 2; ++n)
#pragma unroll
                        for (int e = 0; e < 4; ++e) { bf16_t* cp = UT + (unsigned)((col0 - 768 + bj * HALF + n * 4 + e) * mt + row0 + ai * HALF);
#pragma unroll
                            for (int m = 0; m < 4; ++m) cp[m * 16] = (bf16_t)(cvt_pk_bf16(acc[ai][bj][m][n][e], 0.f) & 0xffffu); }
        } else {
#pragma unroll
            for (int ai = 0; ai < 2; ++ai)
#pragma unroll
                for (int m = 0; m < 4; ++m) { unsigned char* rowp = (unsigned char*)O + (unsigned)(row0 + ai * HALF + m * 16) * 3072u + (unsigned)(col0 - 1792);
#pragma unroll
                    for (int bj = 0; bj < 2; ++bj) { f32x4 v0 = acc[ai][bj][m][0], v1 = acc[ai][bj][m][1];
#pragma unroll
                        for (int e = 0; e < 4; ++e) { v0[e] = fmaxf(__builtin_floorf(255.0f * __builtin_amdgcn_rcpf(1.0f + __expf(-v0[e])) + 0.5f), 1.0f); v1[e] = fmaxf(__builtin_floorf(255.0f * __builtin_amdgcn_rcpf(1.0f + __expf(-v1[e])) + 0.5f), 1.0f); }
                        typedef unsigned u32x2v __attribute__((ext_vector_type(2))); u32x2v w; w.x = 0u; w.y = 0u;
                        w.x = __builtin_amdgcn_cvt_pk_u8_f32(v0[0], 0, w.x); w.x = __builtin_amdgcn_cvt_pk_u8_f32(v0[1], 1, w.x); w.x = __builtin_amdgcn_cvt_pk_u8_f32(v0[2], 2, w.x); w.x = __builtin_amdgcn_cvt_pk_u8_f32(v0[3], 3, w.x);
                        w.y = __builtin_amdgcn_cvt_pk_u8_f32(v1[0], 0, w.y); w.y = __builtin_amdgcn_cvt_pk_u8_f32(v1[1], 1, w.y); w.y = __builtin_amdgcn_cvt_pk_u8_f32(v1[2], 2, w.y); w.y = __builtin_amdgcn_cvt_pk_u8_f32(v1[3], 3, w.y);
                        *(u32x2v*)(rowp + bj * HALF) = w; } }
        }
    }
};
struct EpiSwiglu {
    static constexpr bool PERM = true, AFTER_DRAIN = false, HOOK = false;
    bf16_t* O; int ldc; int ntn;
    __device__ __forceinline__ void operator()(const f32x4 (&acc)[2][2][4][2], const Unit& u, int wr, int wc, int fr, int fq) const {
        const int row0 = u.pm * BM + wr * 64 + fr, col0 = (u.pn % ntn) * HALF + wc * 32 + 8 * fq;
#pragma unroll
        for (int ai = 0; ai < 2; ++ai)
#pragma unroll
            for (int m = 0; m < 4; ++m) { bf16_t* rowp = O + (size_t)(row0 + ai * HALF + m * 16) * ldc + col0;
                float h[8];
#pragma unroll
                for (int n = 0; n < 2; ++n)
#pragma unroll
                    for (int e = 0; e < 4; ++e) { const float g = acc[ai][0][m][n][e], uu = acc[ai][1][m][n][e]; h[n * 4 + e] = g * __builtin_amdgcn_rcpf(1.0f + __expf(-g)) * uu; }
                u32x4 w; w.x = cvt_pk_bf16(h[0], h[1]); w.y = cvt_pk_bf16(h[2], h[3]); w.z = cvt_pk_bf16(h[4], h[5]); w.w = cvt_pk_bf16(h[6], h[7]);
                *(u32x4*)rowp = w; }
    }
};
struct EpiMerge {
    static constexpr bool PERM = true, AFTER_DRAIN = false, HOOK = true;
    const unsigned char* G8  ; bf16_t* Mo;
    __device__ __forceinline__ bool hook_at(int t) const { return t == 8 || t == 12; }
    __device__ __forceinline__ static void ld8(const unsigned char* p, float (&g)[8]) { typedef unsigned u32x2v __attribute__((ext_vector_type(2))); const u32x2v w = *(const u32x2v*)p;
        g[0] = (float)(w.x & 0xffu); g[1] = (float)((w.x >> 8) & 0xffu); g[2] = (float)((w.x >> 16) & 0xffu); g[3] = (float)(w.x >> 24);
        g[4] = (float)(w.y & 0xffu); g[5] = (float)((w.y >> 8) & 0xffu); g[6] = (float)((w.y >> 16) & 0xffu); g[7] = (float)(w.y >> 24); }
    __device__ __forceinline__ void hook(f32x4 (&acc)[2][2][4][2], const Unit& u, int t, int wr, int wc, int fr, int fq) const {
        const int col0 = u.pn * BM + wc * 32 + 8 * fq; const int ga = t == 8 ? 0 : 1;
#pragma unroll
        for (int ai = 0; ai < 2; ++ai)
#pragma unroll
            for (int m = 0; m < 4; ++m) { const int r = u.pm * BM + ai * HALF + wr * 64 + m * 16 + fr; const unsigned char* gp = G8 + (unsigned)r * 3072u + (unsigned)(ga * 1024 + col0);
#pragma unroll
                for (int bj = 0; bj < 2; ++bj) { float sa[8], sb[8]; ld8(gp + bj * HALF, sa); ld8(gp + 1024 + bj * HALF, sb);
#pragma unroll
                    for (int e = 0; e < 4; ++e) { acc[ai][bj][m][0][e] *= sa[e] * __builtin_amdgcn_rcpf(sb[e]); acc[ai][bj][m][1][e] *= sa[4 + e] * __builtin_amdgcn_rcpf(sb[4 + e]); } } }
    }
    __device__ __forceinline__ void operator()(const f32x4 (&acc)[2][2][4][2], const Unit& u, int wr, int wc, int fr, int fq) const {
        const int col0 = u.pn * BM + wc * 32 + 8 * fq;
#pragma unroll
        for (int ai = 0; ai < 2; ++ai)
#pragma unroll
            for (int m = 0; m < 4; ++m) { const int r = u.pm * BM + ai * HALF + wr * 64 + m * 16 + fr; const unsigned char* gp = G8 + (unsigned)r * 3072u + (unsigned)(2048 + col0);
#pragma unroll
                for (int bj = 0; bj < 2; ++bj) { float s2[8]; ld8(gp + bj * HALF, s2); const f32x4 v0 = acc[ai][bj][m][0] * (1.0f / 255.0f), v1 = acc[ai][bj][m][1] * (1.0f / 255.0f);
                    u32x4 w; w.x = cvt_pk_bf16(v0[0] * s2[0], v0[1] * s2[1]); w.y = cvt_pk_bf16(v0[2] * s2[2], v0[3] * s2[3]); w.z = cvt_pk_bf16(v1[0] * s2[4], v1[1] * s2[5]); w.w = cvt_pk_bf16(v1[2] * s2[6], v1[3] * s2[7]);
                    *(u32x4*)(Mo + (size_t)r * 1024 + col0 + bj * HALF) = w; } }
    }
};
struct EpiResid {
    static constexpr bool PERM = false, AFTER_DRAIN = false, HOOK = false;
    bf16_t* xs  ; const float* gate  ;
    __device__ __forceinline__ void operator()(const f32x4 (&acc)[2][2][4][2], const Unit& u, int wr, int wc, int fr, int fq) const {
        const int col0 = u.pn * BM + wc * 32 + 4 * fq;
        const int cond = u.pm >> 5;
        const float* gp = gate + cond * 6144;
        f32x4 gv[2][2];
#pragma unroll
        for (int bj = 0; bj < 2; ++bj)
#pragma unroll
            for (int n = 0; n < 2; ++n) gv[bj][n] = *(const f32x4*)(gp + col0 + bj * HALF + n * 16);
        typedef unsigned u32x2v __attribute__((ext_vector_type(2)));
#pragma unroll
        for (int ai = 0; ai < 2; ++ai)
#pragma unroll
            for (int m = 0; m < 4; ++m) { const int r = u.pm * BM + ai * HALF + wr * 64 + m * 16 + fr;
#pragma unroll
                for (int bj = 0; bj < 2; ++bj)
#pragma unroll
                    for (int n = 0; n < 2; ++n) { const unsigned off = (unsigned)r * 1024u + (unsigned)(col0 + bj * HALF + n * 16);
                        const u32x2v xw = *(const u32x2v*)(xs + off);
                        f32x4 xv; xv[0] = __builtin_bit_cast(float, xw.x << 16); xv[1] = __builtin_bit_cast(float, xw.x & 0xffff0000u); xv[2] = __builtin_bit_cast(float, xw.y << 16); xv[3] = __builtin_bit_cast(float, xw.y & 0xffff0000u);
                        const f32x4 y = xv + gv[bj][n] * acc[ai][bj][m][n];
                        u32x2v o; o.x = cvt_pk_bf16(y[0], y[1]); o.y = cvt_pk_bf16(y[2], y[3]);
                        *(u32x2v*)(xs + off) = o; } }
    }
};
struct MoeOrder {
    int ntn, G, c; const PG8_LAS int* poff; const PG8_LAS unsigned* gtab;
    __device__ __forceinline__ bool next(int i, Unit& u) const {
        const int L = i * G + c; const int np = __builtin_amdgcn_readfirstlane(poff[8]);
        if (L >= np * ntn) return false;
        const int p = L / ntn, t = L - p * ntn; int e = 0;
#pragma unroll
        for (int k = 1; k < 8; ++k) e += (p >= __builtin_amdgcn_readfirstlane(poff[k])) ? 1 : 0;
        u.pm = p; u.pn = e * ntn + t; return true;
    }
    __device__ __forceinline__ void a_ready(const Unit&) const {}
    __device__ __forceinline__ void done(const Unit&) const {}
};
}

struct TrDesc { const float* W; bf16* WT; int K, N, map, ldk, koff, item; bool skip; };
__device__ __forceinline__ void tr_load(const TrDesc& d, float (&tv)[32], int lane) {
    if (d.skip) return;
    const int nblk = d.N / 32, kb = d.item / nblk, nb = d.item % nblk, k0 = 64 * kb, n0 = 32 * nb;
#pragma unroll
    for (int i = 0; i < 32; ++i) tv[i] = d.W[(size_t)(k0 + 2 * i + (lane >> 5)) * d.N + n0 + (lane & 31)];
}
__device__ __forceinline__ void tr_finish(const TrDesc& d, const float (&tv)[32], LAS float* scr, int lane) {
    if (d.skip) return;
    const int nblk = d.N / 32, kb = d.item / nblk, nb = d.item % nblk, k0 = 64 * kb, n0 = 32 * nb;
#pragma unroll
    for (int i = 0; i < 32; ++i) scr[(2 * i + (lane >> 5)) * 33 + (lane & 31)] = tv[i];
    LDS_WAIT(); asm volatile("" ::: "memory");
    const int c = lane & 7;
#pragma unroll
    for (int j = 0; j < 4; ++j) { const int n = (lane >> 3) + 8 * j; const LAS float* s = scr + (8 * c) * 33 + n;
        v4u o; o.x = pk2(s[0 * 33], s[1 * 33]); o.y = pk2(s[2 * 33], s[3 * 33]); o.z = pk2(s[4 * 33], s[5 * 33]); o.w = pk2(s[6 * 33], s[7 * 33]);
        const int nn = n0 + n; int drow;
        if (d.map == 0) drow = nn;
        else if (d.map == 3) {
            if (nn < 640) { const int head = nn >> 6, dd = nn & 63, a = dd >> 5, hf = (dd >> 4) & 1, f = dd & 15; const int tile = head < 8 ? (head >> 2) : 2, wcc = head < 8 ? (head & 3) : (head - 8);
                drow = tile * 256 + 128 * a + 32 * wcc + 8 * (f >> 2) + 4 * hf + (f & 3); }
            else if (nn < 768) { const int vh = (nn - 640) >> 6, dd = nn & 63; drow = 512 + 128 * (dd >> 5) + 32 * (2 + vh) + (dd & 31); }
            else drow = nn; }
        else drow = (nn >> 7) * 256 + (nn & 127) + (d.map == 2 ? 128 : 0);
        *(v4u*)(d.WT + (size_t)drow * d.ldk + d.koff + k0 + 8 * c) = o; }
    LDS_WAIT(); asm volatile("" ::: "memory");
}
#define TR_GROUP(SRC, DST, CNT, KK, NN, MAP, DSTRIDE, LDK, KOFF) if (!found) { constexpr int per = ((KK) / 64) * ((NN) / 32); constexpr int tot = (CNT) * per; \
    if (r < tot) { const int mi = r / per; d.W = (SRC) + (size_t)mi * (KK) * (NN); d.WT = (DST) + (size_t)mi * (DSTRIDE); d.K = (KK); d.N = (NN); d.map = (MAP); d.ldk = (LDK); d.koff = (KOFF); d.item = r % per; found = true; } else r -= tot; }
__device__ __forceinline__ TrDesc tr_decode(Frame& F, int it) {
    TrDesc d; d.W = nullptr; d.WT = nullptr; d.K = 64; d.N = 32; d.map = 0; d.ldk = 64; d.koff = 0; d.item = 0; d.skip = false;
    int r = it; bool found = false;
    TR_GROUP(inp(F, I_WIN), ((bf16*)(wsp(F) + WS_WIN)), 4, 1024, 4864, 3, (size_t)4864 * 1024, 1024, 0)
    if (found && d.N == 4864) { const int nb = d.item % 152; d.skip = (nb >= 48 && nb < 56); }
    TR_GROUP(inp(F, I_WPA), ((bf16*)(wsp(F) + WS_WPA)), 4, 512, 1024, 0, (size_t)1024 * 1024, 1024, 0)
    TR_GROUP(inp(F, I_WPH), ((bf16*)(wsp(F) + WS_WPA)), 4, 256, 1024, 0, (size_t)1024 * 1024, 1024, 512)
    TR_GROUP(inp(F, I_WPF), ((bf16*)(wsp(F) + WS_WPA)), 4, 256, 1024, 0, (size_t)1024 * 1024, 1024, 768)
    TR_GROUP(inp(F, I_WOUT), ((bf16*)(wsp(F) + WS_WO)), 4, 1024, 1024, 0, (size_t)1024 * 1024, 1024, 0)
    TR_GROUP(inp(F, I_FG), ((bf16*)(wsp(F) + WS_FGU)), 2, 1024, 2816, 1, (size_t)5632 * 1024, 1024, 0)
    TR_GROUP(inp(F, I_FU), ((bf16*)(wsp(F) + WS_FGU)), 2, 1024, 2816, 2, (size_t)5632 * 1024, 1024, 0)
    TR_GROUP(inp(F, I_FDN), ((bf16*)(wsp(F) + WS_FD)), 2, 2816, 1024, 0, (size_t)1024 * 2816, 2816, 0)
    TR_GROUP(inp(F, I_MG), ((bf16*)(wsp(F) + WS_MGU)), 16, 1024, 2816, 1, (size_t)5632 * 1024, 1024, 0)
    TR_GROUP(inp(F, I_MU), ((bf16*)(wsp(F) + WS_MGU)), 16, 1024, 2816, 2, (size_t)5632 * 1024, 1024, 0)
    TR_GROUP(inp(F, I_MDN), ((bf16*)(wsp(F) + WS_MD)), 16, 2816, 1024, 0, (size_t)1024 * 2816, 2816, 0)
    return d;
}

__device__ __forceinline__ void phase_prologue(Frame& F) {
    constexpr int TOT_ITEMS = 4 * (16 * 152 + 8 * 32 + 4 * 32 + 4 * 32 + 16 * 32) + 2 * (16 * 88 * 2 + 44 * 32) + 16 * (16 * 88 * 2 + 44 * 32);
    constexpr int PER_BLOCK = (TOT_ITEMS + 255) / 256;
    LAS float* scr = (LAS float*)(F.lds + F.wave * 8448);
    LAS float* tl = (LAS float*)(F.lds + 8 * 8448);
    LAS float* sl = (LAS float*)(F.lds + 8 * 8448 + 17152);
    LAS int* ctr = (LAS int*)(F.lds + 8 * 8448 + 17152 + 12288);
    for (int i = F.tid; i < 3072; i += NTHREADS) { const float cv = i < 2048 ? inp(F, I_C)[i] : inp(F, I_CCTX)[i - 2048]; sl[i] = cv * sigmoidf_(cv); }
    if (F.tid == 0) ctr[0] = 0;
    if (F.bid == 0) { for (int i = F.tid; i < 512; i += NTHREADS) { const int ll = i >> 7, j = i & 127; ((float*)(wsp(F) + WS_CTL) + CW_QKG)[i] = j < 64 ? inp(F, I_QG)[ll * 64 + j] : inp(F, I_KG)[ll * 64 + j - 64]; } }
    __syncthreads();
    if (F.wave >= 6) {
        for (int it = (F.wave - 6) * F.G + F.bid; it < 4 * 96; it += 2 * F.G) {
            const int l = it / 96, cb = it % 96;
            const float* W = inp(F, I_WADA) + (size_t)l * 1024 * 6144 + cb * 64 + F.lane;
            float a0 = 0.f, a1 = 0.f, a2 = 0.f;
#pragma unroll 16
            for (int k = 0; k < 1024; ++k) { const float w = W[(size_t)k * 6144]; a0 += w * sl[k]; a1 += w * sl[1024 + k]; a2 += w * sl[2048 + k]; }
            const float bb = inp(F, I_BADA)[l * 6144 + cb * 64 + F.lane];
            float* mo = ((float*)(wsp(F) + WS_CTL) + CW_MOD) + (size_t)l * 3 * 6144 + cb * 64 + F.lane;
            mo[0] = a0 + bb; mo[6144] = a1 + bb; mo[2 * 6144] = a2 + bb;
        }
    } else if (F.wave == 5) {
        LAS float* ctab = tl + 64 * 65; LAS float* stab = ctab + 64;
        ctab[F.lane] = cos_rev((float)F.lane * (1.0f / 64.0f)); stab[F.lane] = sin_rev((float)F.lane * (1.0f / 64.0f));
        for (int it = F.bid; it < 4 * 16 * 4; it += F.G) {
            const int l = it >> 6, kb = (it >> 2) & 15, g = it & 3;
            const float* W = inp(F, I_WIN) + (size_t)l * 1024 * 4864 + (size_t)(kb * 64) * 4864 + 1536 + g * 64;
#pragma unroll 8
            for (int kk = 0; kk < 64; ++kk) tl[kk * 65 + F.lane] = W[(size_t)kk * 4864 + F.lane];
            LDS_WAIT(); asm volatile("" ::: "memory");
            bf16* dst = ((bf16*)(wsp(F) + WS_WIN)) + (size_t)l * 4864 * 1024 + (size_t)(1536 + g * 64) * 1024 + kb * 64 + F.lane;
            for (int j = 0; j < 64; ++j) {
                const int mm = j <= 32 ? j : j - 32; float a = 0.f;
                if (j <= 32) { for (int c = 0; c < 64; ++c) a += tl[F.lane * 65 + c] * ctab[(mm * c) & 63]; }
                else { for (int c = 0; c < 64; ++c) a += tl[F.lane * 65 + c] * stab[(mm * c) & 63]; }
                dst[(size_t)j * 1024] = (bf16)f2bf(a);
            }
            LDS_WAIT(); asm volatile("" ::: "memory");
        }
    }
    {
        const int ib = F.bid * PER_BLOCK, ie = (ib + PER_BLOCK) < TOT_ITEMS ? (ib + PER_BLOCK) : TOT_ITEMS;
        int it = ib + __builtin_amdgcn_readfirstlane(F.lane == 0 ? atomicAdd((int*)ctr, 1) : 0);
        if (it < ie) {
            TrDesc cur = tr_decode(F, it); float tv[32], tn[32];
            tr_load(cur, tv, F.lane);
            for (;;) {
                const int itn = ib + __builtin_amdgcn_readfirstlane(F.lane == 0 ? atomicAdd((int*)ctr, 1) : 0);
                TrDesc nxt = cur; const bool more = itn < ie;
                if (more) { nxt = tr_decode(F, itn); tr_load(nxt, tn, F.lane); }
                tr_finish(cur, tv, scr, F.lane);
                if (!more) break;
                cur = nxt;
#pragma unroll
                for (int i = 0; i < 32; ++i) tv[i] = tn[i];
            }
        }
    }
}

__device__ __forceinline__ void moe_offsets(Frame& F, int l, LAS int* poff) {
    if (F.tid == 0) { const unsigned* cnt = (const unsigned*)(wsp(F) + WS_CTL) + CW_CNT + l * 64; int o = 0;
        for (int e = 0; e < 8; ++e) { poff[e] = o; o += (int)((__hip_atomic_load(cnt + e, __ATOMIC_RELAXED, __HIP_MEMORY_SCOPE_AGENT) + 255u) >> 8); } poff[8] = o; }
    __syncthreads();
}
template <bool XB> struct NormRaw { typedef f32x4 T; };
template <> struct NormRaw<true> { typedef v2u T; };
__device__ __forceinline__ f32x4 norm_cvt(const f32x4 a) { return a; }
__device__ __forceinline__ f32x4 norm_cvt(const v2u a) { f32x4 r; r[0] = bflo(a.x); r[1] = bfhi(a.x); r[2] = bflo(a.y); r[3] = bfhi(a.y); return r; }
template <bool ROUTER, bool COMBINE, bool NORM, bool XB = true>
__device__ __forceinline__ void phase_norm(Frame& F, int l, const float* xlat, const float* xctx, const float* g, int moff, const float* wr, int nrows, int skipb = 0) {
    const int gw = (F.bid - skipb) * NWAVES + F.wave + (F.bid < skipb ? (1 << 28) : 0), NGW = (F.G - skipb) * NWAVES;
    const float* mod = ((float*)(wsp(F) + WS_CTL) + CW_MOD) + (size_t)l * 3 * 6144 + moff;
    LAS int* lcnt = (LAS int*)(F.lds + LDS_TAB);
    LAS float* wrl = (LAS float*)F.lds;
    unsigned* info_all = (unsigned*)(wsp(F) + WS_COMB);
    if (ROUTER) { if (F.tid < 16) lcnt[F.tid] = 0;
        for (int i = F.tid; i < 2048; i += NTHREADS) { const int c = i >> 1, hf = i & 1; *(LAS f32x4*)(wrl + 4 * (hf * 1024 + (((c >> 8) * 4 + (c & 3)) * 64 + ((c >> 2) & 63)))) = *(const f32x4*)(wr + 4 * i); }
        __syncthreads(); }
    LAS int* cpoff = (LAS int*)(F.lds + LDS_TAB + 64);
    if (COMBINE) moe_offsets(F, l - (NORM ? 1 : 0), cpoff);
    f32x4 gg[4], s1[4], s0[4]; int cur_cond = -1;
    if (NORM) {
#pragma unroll
        for (int j = 0; j < 4; ++j) gg[j] = *(const f32x4*)(g + 256 * j + 4 * F.lane);
    }
    typedef typename NormRaw<XB>::T RawT;
    bf16* const XS = (bf16*)(wsp(F) + WS_XS);
    f32x4 v[4]; RawT vn[4], vn2[4];
#define NORM_LOADROW(DST, rr_) { if (XB) { const bf16* xr = XS + (size_t)(rr_) * 1024; _Pragma("unroll") for (int j = 0; j < 4; ++j) DST[j] = *(const RawT*)(xr + 256 * j + 4 * F.lane); } \
        else { const float* xr = (rr_) >= ML ? xctx + (size_t)((rr_) - ML) * 1024 : xlat + (size_t)(rr_) * 1024; _Pragma("unroll") for (int j = 0; j < 4; ++j) DST[j] = *(const RawT*)(xr + 256 * j + 4 * F.lane); } }
    if (gw < nrows) NORM_LOADROW(vn, gw)
    if (gw + NGW < nrows) NORM_LOADROW(vn2, gw + NGW)
    for (int r = gw; r < nrows; r += NGW) {
        const bool isctx = r >= ML; const int cond = isctx ? 2 : (r >> 13);
#pragma unroll
        for (int j = 0; j < 4; ++j) { v[j] = norm_cvt(vn[j]); vn[j] = vn2[j]; }
        { const int rn = r + 2 * NGW; if (rn < nrows) NORM_LOADROW(vn2, rn) }
        if (!XB) {
#pragma unroll
            for (int j = 0; j < 4; ++j) { v2u o; o.x = pk2(v[j][0], v[j][1]); o.y = pk2(v[j][2], v[j][3]); *(v2u*)(XS + (size_t)r * 1024 + 256 * j + 4 * F.lane) = o; }
        }
        float s = 0.f;
        if (COMBINE) {
            const unsigned* info = info_all + (size_t)r * 8;
            const float w0 = __builtin_bit_cast(float, info[2]), w1 = __builtin_bit_cast(float, info[3]);
            const bf16* y0 = ((const bf16*)(wsp(F) + WS_Y)) + (size_t)(256 * cpoff[info[0]] + (int)info[4]) * 1024; const bf16* y1 = ((const bf16*)(wsp(F) + WS_Y)) + (size_t)(256 * cpoff[info[1]] + (int)info[5]) * 1024;
            const float* gt = ((float*)(wsp(F) + WS_CTL) + CW_MOD) + (size_t)(l - (NORM ? 1 : 0)) * 3 * 6144 + 5120 + cond * 6144;
#pragma unroll
            for (int j = 0; j < 4; ++j) { const int c = 256 * j + 4 * F.lane;
                const v2u a = *(const v2u*)(y0 + c), b = *(const v2u*)(y1 + c); const f32x4 gtv = *(const f32x4*)(gt + c);
                v[j][0] += gtv[0] * (w0 * bflo(a.x) + w1 * bflo(b.x)); v[j][1] += gtv[1] * (w0 * bfhi(a.x) + w1 * bfhi(b.x));
                v[j][2] += gtv[2] * (w0 * bflo(a.y) + w1 * bflo(b.y)); v[j][3] += gtv[3] * (w0 * bfhi(a.y) + w1 * bfhi(b.y));
                if (NORM) { v2u o; o.x = pk2(v[j][0], v[j][1]); o.y = pk2(v[j][2], v[j][3]); *(v2u*)(XS + (size_t)r * 1024 + c) = o; }
                else *(f32x4*)(outp(F) + (size_t)r * 1024 + c) = v[j]; }
        }
        if (!NORM) continue;
        if (cond != cur_cond) { cur_cond = cond; const float* sh = mod + cond * 6144; const float* sc = sh + 1024;
#pragma unroll
            for (int j = 0; j < 4; ++j) { s1[j] = *(const f32x4*)(sc + 256 * j + 4 * F.lane); s0[j] = *(const f32x4*)(sh + 256 * j + 4 * F.lane); } }
#pragma unroll
        for (int j = 0; j < 4; ++j) s += (v[j][0] * v[j][0] + v[j][1] * v[j][1]) + (v[j][2] * v[j][2] + v[j][3] * v[j][3]);
        const float rstd = 1.0f / sqrtf(wave_sum(s, F.lane) * (1.0f / 1024.0f) + EPS);
        float lg[8];
        if (ROUTER) {
#pragma unroll
            for (int e = 0; e < 8; ++e) lg[e] = 0.f;
        }
#pragma unroll
        for (int j = 0; j < 4; ++j) { const int c = 256 * j + 4 * F.lane;
            f32x4 y;
#pragma unroll
            for (int e = 0; e < 4; ++e) y[e] = (v[j][e] * rstd * gg[j][e]) * (1.0f + s1[j][e]) + s0[j][e];
            v2u o; o.x = pk2(y[0], y[1]); o.y = pk2(y[2], y[3]);
            *(v2u*)(((bf16*)(wsp(F) + WS_H)) + (size_t)r * 1024 + c) = o;
            if (ROUTER) {
#pragma unroll
                for (int e = 0; e < 4; ++e) { const f32x4 w0 = *(LAS f32x4*)(wrl + 4 * ((j * 4 + e) * 64 + F.lane)), w1 = *(LAS f32x4*)(wrl + 4 * (1024 + (j * 4 + e) * 64 + F.lane));
                    lg[0] += y[e] * w0[0]; lg[1] += y[e] * w0[1]; lg[2] += y[e] * w0[2]; lg[3] += y[e] * w0[3];
                    lg[4] += y[e] * w1[0]; lg[5] += y[e] * w1[1]; lg[6] += y[e] * w1[2]; lg[7] += y[e] * w1[3]; }
            }
        }
        if (ROUTER) {
#pragma unroll
            for (int e = 0; e < 8; ++e) lg[e] = wave_sum(lg[e], F.lane);
            int i0 = 0; float v0 = lg[0];
#pragma unroll
            for (int e = 1; e < 8; ++e) if (lg[e] > v0) { v0 = lg[e]; i0 = e; }
            int i1 = -1; float v1 = -INFINITY;
#pragma unroll
            for (int e = 0; e < 8; ++e) if (e != i0 && lg[e] > v1) { v1 = lg[e]; i1 = e; }
            const float w0 = 1.0f / (1.0f + __expf(v1 - v0)), w1 = 1.0f - w0;
            if (F.lane == 0) { const int p0 = atomicAdd((int*)(lcnt + i0), 1), p1 = atomicAdd((int*)(lcnt + i1), 1);
                unsigned* info = info_all + (size_t)r * 8;
                info[0] = (unsigned)i0; info[1] = (unsigned)i1; info[2] = __builtin_bit_cast(unsigned, w0); info[3] = __builtin_bit_cast(unsigned, w1); info[4] = (unsigned)p0; info[5] = (unsigned)p1; }
        }
    }
    if (ROUTER) {
        asm volatile("s_waitcnt vmcnt(0) lgkmcnt(0)" ::: "memory");
        __syncthreads();
        if (F.tid < 8) { unsigned* cnt = (unsigned*)(wsp(F) + WS_CTL) + CW_CNT + l * 64; lcnt[8 + F.tid] = (int)__hip_atomic_fetch_add(cnt + F.tid, (unsigned)lcnt[F.tid], __ATOMIC_RELAXED, __HIP_MEMORY_SCOPE_AGENT); }
        __syncthreads();
        for (int r = gw; r < nrows; r += NGW) { if (F.lane < 2) { unsigned* info = info_all + (size_t)r * 8; const int e = (int)info[F.lane]; const unsigned pos = info[4 + F.lane] + (unsigned)lcnt[8 + e]; info[4 + F.lane] = pos;
            ((unsigned*)(wsp(F) + WS_TOKE))[(size_t)e * MT + pos] = (unsigned)r; } }
    }
}

#undef NORM_LOADROW
__device__ __forceinline__ void phase_gather(Frame& F, int l) {
    LAS int* poff = (LAS int*)(F.lds + LDS_TAB + 64);
    moe_offsets(F, l, poff);
    const int gw = F.bid * NWAVES + F.wave, NGW = F.G * NWAVES;
    unsigned* info_all = (unsigned*)(wsp(F) + WS_COMB);
    for (int it = gw; it < MT * 2; it += NGW) {
        const int tok = it >> 1, k = it & 1; unsigned* info = info_all + (size_t)tok * 8;
        const int e = (int)info[k], pos = (int)info[4 + k]; const int grow = 256 * poff[e] + pos;
        if (F.lane == 0) info[6 + k] = (unsigned)grow;
        const v4u* s = (const v4u*)(((const bf16*)(wsp(F) + WS_H)) + (size_t)tok * 1024); v4u* d = (v4u*)(((bf16*)(wsp(F) + WS_XG)) + (size_t)grow * 1024);
        d[F.lane] = s[F.lane]; d[64 + F.lane] = s[64 + F.lane];
    }
}

__device__ __forceinline__ void filter_tile(Frame& F, int l, int L, int p0, float* dst  , bool stage) {
    LAS float* emb = (LAS float*)F.lds;
    LAS float* h1 = emb + 32 * 33;
    LAS float* h2 = h1 + 32 * 65;
    LAS float* w1s = h2 + 32 * 65;
    LAS float* w2s = w1s + 33 * 64;
    const float* w1 = inp(F, I_FW1) + l * 33 * 64; const float* b1 = inp(F, I_FB1) + l * 64; const float* f1 = inp(F, I_FF1) + l * 64;
    const float* w2 = inp(F, I_FW2) + l * 64 * 64; const float* b2 = inp(F, I_FB2) + l * 64; const float* f2 = inp(F, I_FF2) + l * 64;
    const float* w3 = inp(F, I_FW3) + (size_t)l * 64 * 1024;
    float awA[32], awB[32];
#define FILT_LOADW(AW, blk_) { unsigned vo_ = (unsigned)((F.lane >> 5) * 8192 + (blk_) * 32 + (F.lane & 31)); asm volatile("" : "+v"(vo_)); _Pragma("unroll") for (int s = 0; s < 32; ++s) AW[s] = (w3 + (size_t)(16 * (s >> 3) + (s & 7)) * 1024)[vo_]; }
    FILT_LOADW(awA, F.wave) __builtin_amdgcn_sched_barrier(0);
    if (stage) {
        const f32x4 sa = *(const f32x4*)(w1 + 4 * F.tid), sb = *(const f32x4*)(w2 + 4 * F.tid), sc = *(const f32x4*)(w2 + 4 * (F.tid + NTHREADS));
        f32x4 sd = sa; if (F.tid < 16) sd = *(const f32x4*)(w1 + 4 * (F.tid + NTHREADS));
        *(LAS f32x4*)(w1s + 4 * F.tid) = sa; *(LAS f32x4*)(w2s + 4 * F.tid) = sb; *(LAS f32x4*)(w2s + 4 * (F.tid + NTHREADS)) = sc;
        if (F.tid < 16) *(LAS f32x4*)(w1s + 4 * (F.tid + NTHREADS)) = sd;
    }
    for (int idx = F.tid; idx < 32 * 33; idx += NTHREADS) {
        const int pos = idx / 33, f = idx % 33, i = p0 + pos;
        float val;
        if (f == 0) val = (float)i / (float)(L - 1);
        else { const int j = (f - 1) & 15; const float fb = 1e-4f + (float)j * ((15.0f - 1e-4f) / 15.0f); const float rev = fb * (float)i / (float)L;
               val = (f <= 16) ? cos_rev(rev) : -sin_rev(rev); }
        emb[pos * 33 + f] = val;
    }
    __syncthreads();
    { const int pos = F.tid >> 4, u0 = (F.tid & 15) * 4;
      f32x4 a = *(const f32x4*)(b1 + u0);
#pragma unroll 11
      for (int f = 0; f < 33; ++f) a += emb[pos * 33 + f] * *(LAS f32x4*)(w1s + f * 64 + u0);
      const f32x4 fr = *(const f32x4*)(f1 + u0);
#pragma unroll
      for (int e = 0; e < 4; ++e) h1[pos * 65 + u0 + e] = sin_rev(fr[e] * a[e] * INV_2PI);
    }
    __syncthreads();
    { const int pos = F.tid >> 4, u0 = (F.tid & 15) * 4;
      f32x4 a = *(const f32x4*)(b2 + u0);
#pragma unroll 16
      for (int f = 0; f < 64; ++f) a += h1[pos * 65 + f] * *(LAS f32x4*)(w2s + f * 64 + u0);
      const f32x4 fr = *(const f32x4*)(f2 + u0);
#pragma unroll
      for (int e = 0; e < 4; ++e) h2[pos * 65 + u0 + e] = sin_rev(fr[e] * a[e] * INV_2PI);
    }
    __syncthreads();
    { const int r = F.lane & 31, h = F.lane >> 5;
      typedef float f32x16_t __attribute__((ext_vector_type(16))); typedef short bf16x8_t __attribute__((ext_vector_type(8)));
      const int i = p0 + r; const float t = (float)i / (float)(L - 1);
#define FILT_SPLIT(X, HI, LO) { v4u hi_, lo_; \
        _Pragma("unroll") for (int p = 0; p < 4; ++p) { const float x0 = (X)[2 * p], x1 = (X)[2 * p + 1]; const unsigned hw = pg8::cvt_pk_bf16(x0, x1); hi_[p] = hw; lo_[p] = pg8::cvt_pk_bf16(x0 - bflo(hw), x1 - bfhi(hw)); } \
        HI = __builtin_bit_cast(bf16x8_t, hi_); LO = __builtin_bit_cast(bf16x8_t, lo_); }
      bf16x8_t bh[4], bl[4];
#pragma unroll
      for (int kk = 0; kk < 4; ++kk) { float hv[8];
#pragma unroll
          for (int e = 0; e < 8; ++e) hv[e] = h2[r * 65 + 16 * kk + 8 * h + e];
          FILT_SPLIT(hv, bh[kk], bl[kk]) }
#define FILT_BLOCK(AW, blk_) { int c0 = (blk_) * 32; asm volatile("" : "+v"(c0)); f32x16_t acc;        \
        _Pragma("unroll") for (int q = 0; q < 16; ++q) acc[q] = 0.f; \
        _Pragma("unroll") for (int kk = 0; kk < 4; ++kk) { bf16x8_t ah_, al_; FILT_SPLIT((AW + 8 * kk), ah_, al_) \
            acc = __builtin_amdgcn_mfma_f32_32x32x16_bf16(al_, bh[kk], acc, 0, 0, 0); acc = __builtin_amdgcn_mfma_f32_32x32x16_bf16(ah_, bl[kk], acc, 0, 0, 0); acc = __builtin_amdgcn_mfma_f32_32x32x16_bf16(ah_, bh[kk], acc, 0, 0, 0); } \
        _Pragma("unroll") for (int q = 0; q < 16; ++q) { const int col = c0 + (q & 3) + 8 * (q >> 2) + 4 * h; const int ch = col & 255; \
            const float delta = 3.0701134573253946f + 12.280453829301578f * ((float)ch * (1.0f / 255.0f)); \
            dst[(size_t)col * L + i] = acc[q] * __expf(-t * delta); } }
#pragma unroll 1
      for (int jj = 0; jj < 2; ++jj) {
          FILT_LOADW(awB, F.wave + 8 * (2 * jj + 1)) __builtin_amdgcn_sched_barrier(0); FILT_BLOCK(awA, F.wave + 16 * jj) __builtin_amdgcn_sched_barrier(0);
          FILT_LOADW(awA, F.wave + 8 * ((2 * jj + 2) & 3)) __builtin_amdgcn_sched_barrier(0); FILT_BLOCK(awB, F.wave + 8 * (2 * jj + 1)) __builtin_amdgcn_sched_barrier(0);
      }
#undef FILT_BLOCK
#undef FILT_LOADW
#undef FILT_SPLIT
    }
    __syncthreads();
}

__device__ __forceinline__ void phase_qkprep(Frame& F, int l) {
    const int gw = F.bid * NWAVES + F.wave, NGW = F.G * NWAVES;
    const int lane = F.lane; const int a = lane >> 5, half = (lane >> 4) & 1, f = lane & 15;
    const float inv = exp2f(-(float)f * (13.287712379549449f / 16.0f)) * INV_2PI;
    const float gq = inp(F, I_QG)[l * 64 + lane], gk = inp(F, I_KG)[l * 64 + lane];
    for (int r = gw; r < MT; r += NGW) {
        const bool isctx = r >= ML; const int t = r & 8191; const int pos = a == 0 ? (t >> 6) : (t & 63);
        float cs = 1.f, sn = 0.f;
        if (!isctx) { const float rev = (float)pos * inv; cs = cos_rev(rev); sn = sin_rev(rev); }
        const bf16* pr = ((bf16*)(wsp(F) + WS_PR)) + (size_t)r * INW;
        bf16* qk = ((bf16*)(wsp(F) + WS_QK)) + (size_t)r * 640;
#pragma unroll
        for (int h = 0; h < 10; ++h) {
            const float v = bf2f(pr[h * 64 + lane]);
            const float ss = wave_sum(v * v, lane);
            const float y = v * (1.0f / sqrtf(ss * (1.0f / 64.0f) + EPS)) * (h < 8 ? gq : gk);
            const float p = shx(y, lane, 16);
            const float o = half == 0 ? y * cs - p * sn : y * cs + p * sn;
            if (h < 8) qk[h * 64 + lane] = (bf16)f2bf(o * 0.18033688011112042f);
            else ((bf16*)(wsp(F) + WS_KT))[(size_t)((((h - 8) * NKB + (r >> 5)) * 4 + (lane >> 4)) * 512 + ((lane >> 3) & 1) * 256 + (r & 31) * 8 + (lane & 7))] = (bf16)f2bf(o);
        }
    }
}

__device__ __forceinline__ float block_sum(Frame& F, float v, LAS float* red) {
    v = wave_sum(v, F.lane);
    __syncthreads();
    if (F.lane == 0) red[F.wave] = v;
    __syncthreads();
    float t = 0.f;
#pragma unroll
    for (int w = 0; w < NWAVES; ++w) t += red[w];
    return t;
}

template <int L>
__device__ __forceinline__ float hy_uc(const bf16* UT, int rowbase, int b, int t, int ch, const float* cw, const float* cb) {
    float a = cb[ch];
    const bf16* up = UT + (size_t)ch * MT + rowbase + b * L;
#pragma unroll
    for (int j = 0; j < 3; ++j) { const int tt = t + j - 1; const bool ok = tt >= 0 && tt < L; const float x = bf2f(up[ok ? tt : t]); a += ok ? x * cw[j * 768 + ch] : 0.f; }
    return a;
}

template <int L>
__device__ __forceinline__ void hyena_item_naive(Frame& F, int l, int c, int rowbase, const float* taps) {
    constexpr int NT = (L + NTHREADS - 1) / NTHREADS;
    LAS float* kt = (LAS float*)F.lds;
    LAS f32x2* z = (LAS f32x2*)(F.lds + 2 * L * 4);
    LAS float* red = (LAS float*)(F.lds + 2 * L * 4 + L * 8);
    const float* cw = inp(F, I_HCW) + l * 3 * 768; const float* cb = inp(F, I_HCB) + l * 768; const float* hb = inp(F, I_HBIAS) + l * 512;
    for (int t = F.tid; t < L; t += NTHREADS) { f32x2 v; v.x = hy_uc<L>(((bf16*)(wsp(F) + WS_UT)), rowbase, 0, t, 512 + c, cw, cb); v.y = hy_uc<L>(((bf16*)(wsp(F) + WS_UT)), rowbase, 1, t, 512 + c, cw, cb); z[t] = v; }
    for (int o = 0; o < 2; ++o) {
        const float* fwd = taps + (size_t)(o * 256 + c) * L; const float* bwd = taps + (size_t)(512 + o * 256 + c) * L;
        float part = 0.f;
        for (int d = F.tid; d < L; d += NTHREADS) { const float kf = fwd[d]; kt[L + d] = kf; part += fabsf(kf);
            if (d >= 1) { const float kb = bwd[d]; kt[L - d] = kb; part += fabsf(kb); } else kt[0] = 0.f; }
        const float tot = block_sum(F, part, red);
        const float inv = 1.0f / tot;
        __syncthreads();
        float* tmp = (float*)(wsp(F) + WS_CTMP) + (size_t)c * 2 * L;
#pragma unroll 1
        for (int t = F.tid; t < L; t += NTHREADS) {
            float a0 = 0.f, a1 = 0.f;
#pragma unroll 4
            for (int s = 0; s < L; ++s) { const f32x2 zz = z[s]; const float kv = kt[L + t - s]; a0 += kv * zz.x; a1 += kv * zz.y; }
            tmp[t] = a0; tmp[L + t] = a1;
        }
        __syncthreads();
        const float bo = hb[o * 256 + c];
#pragma unroll 1
        for (int t = F.tid; t < L; t += NTHREADS) {
            const float g0 = hy_uc<L>(((bf16*)(wsp(F) + WS_UT)), rowbase, 0, t, o * 256 + c, cw, cb), g1 = hy_uc<L>(((bf16*)(wsp(F) + WS_UT)), rowbase, 1, t, o * 256 + c, cw, cb);
            const f32x2 zo = z[t]; f32x2 zn; zn.x = g0 * (tmp[t] * inv + bo * zo.x); zn.y = g1 * (tmp[L + t] * inv + bo * zo.y); z[t] = zn;
        }
        __syncthreads();
    }
    for (int t = F.tid; t < L; t += NTHREADS) { const f32x2 v = z[t];
        ((bf16*)(wsp(F) + WS_HYT))[(size_t)c * MT + rowbase + t] = (bf16)f2bf(v.x); ((bf16*)(wsp(F) + WS_HYT))[(size_t)c * MT + rowbase + L + t] = (bf16)f2bf(v.y); }
    __syncthreads();
}

template <int L>
__device__ __forceinline__ void fnet_item_naive(Frame& F, int b, int g, int m, int rowbase) {
    LAS f32x2* AB = (LAS f32x2*)F.lds;
    LAS f32x2* tab = (LAS f32x2*)(F.lds + L * 8);
    LAS f32x2* cs64 = (LAS f32x2*)(F.lds + 2 * L * 8);
    for (int i = F.tid; i < L; i += NTHREADS) { f32x2 v; const float rev = (float)i / (float)L; v.x = cos_rev(rev); v.y = sin_rev(rev); tab[i] = v; }
    if (F.tid < 64) { f32x2 v; const float rev = (float)F.tid / 64.0f; v.x = cos_rev(rev); v.y = sin_rev(rev); cs64[F.tid] = v; }
    __syncthreads();
    for (int n = F.tid; n < L; n += NTHREADS) {
        const bf16* ut = ((const bf16*)(wsp(F) + WS_UT)) + (size_t)(768 + g * 64) * MT + rowbase + b * L + n;
        const int mm = m <= 32 ? m : 64 - m;
        f32x2 v; v.x = bf2f(ut[(size_t)mm * MT]);
        v.y = (m == 0 || m == 32) ? 0.f : (m < 32 ? bf2f(ut[(size_t)(32 + m) * MT]) : -bf2f(ut[(size_t)(32 + mm) * MT]));
        AB[n] = v;
    }
    __syncthreads();
    const float scale = 1.0f / sqrtf((float)L * 64.0f);
    for (int k = F.tid; k < L; k += NTHREADS) {
        float acc = 0.f; int idx = 0;
        for (int n = 0; n < L; ++n) { const f32x2 ab = AB[n]; const f32x2 cs = tab[idx]; acc += ab.x * cs.x - ab.y * cs.y; idx = (idx + k) & (L - 1); }
        ((bf16*)(wsp(F) + WS_FNT))[(size_t)(g * 64 + m) * MT + rowbase + b * L + k] = (bf16)f2bf(acc * scale);
    }
    __syncthreads();
}

#ifdef FFT_HOST
#define FFT_LDS
#define FFT_HD
static inline float fft_cos_rev(float r) { return (float)cos(6.283185307179586 * (double)r); }
static inline float fft_sin_rev(float r) { return (float)sin(6.283185307179586 * (double)r); }
#else
#define FFT_LDS LAS
#define FFT_HD __device__ __forceinline__
__device__ __forceinline__ float fft_cos_rev(float r) { return __builtin_amdgcn_cosf(r); }
__device__ __forceinline__ float fft_sin_rev(float r) { return __builtin_amdgcn_sinf(r); }
#endif
FFT_HD int fft_phys(int i) { return i + ((i >> 5) << 1); }
FFT_HD f32x2 fft_cmul(f32x2 a, f32x2 b) { const f32x2 ax = {a.x, a.x}, ay = {a.y, a.y}, bs = {-b.y, b.x}; return ax * b + ay * bs; }
template <int R> FFT_HD constexpr int fft_brev(int p) { int r = 0; for (int b = 1; b < R; b <<= 1) { r = (r << 1) | ((p & b) ? 1 : 0); } return r; }
template <int R, bool INV> FFT_HD void fft_regs(f32x2 (&a)[R]) {
    constexpr float C16[16] = {1.0f, 0.92387953251128674f, 0.70710678118654752f, 0.38268343236508977f, 0.0f, -0.38268343236508977f, -0.70710678118654752f, -0.92387953251128674f,
                               -1.0f, -0.92387953251128674f, -0.70710678118654752f, -0.38268343236508977f, 0.0f, 0.38268343236508977f, 0.70710678118654752f, 0.92387953251128674f};
    constexpr float S16[16] = {0.0f, 0.38268343236508977f, 0.70710678118654752f, 0.92387953251128674f, 1.0f, 0.92387953251128674f, 0.70710678118654752f, 0.38268343236508977f,
                               0.0f, -0.38268343236508977f, -0.70710678118654752f, -0.92387953251128674f, -1.0f, -0.92387953251128674f, -0.70710678118654752f, -0.38268343236508977f};
#pragma unroll
    for (int s = R / 2; s >= 1; s >>= 1) {
#pragma unroll
        for (int i = 0; i < R; ++i) {
            if ((i & s) == 0) {
                const int k = i & (s - 1);
                const f32x2 u = a[i], v = a[i + s];
                a[i] = u + v;
                const f32x2 d = u - v;
                if (k == 0) a[i + s] = d;
                else if (2 * k == s) { f32x2 t; if (INV) { t.x = -d.y; t.y = d.x; } else { t.x = d.y; t.y = -d.x; } a[i + s] = t; }
                else { const int idx = k * (16 / (2 * s)); f32x2 w; w.x = C16[idx]; w.y = INV ? S16[idx] : -S16[idx]; a[i + s] = fft_cmul(d, w); }
            }
        }
    }
}
template <int N, int NCUR, int R, bool INV, int NT>
FFT_HD void fft_pass(FFT_LDS f32x2* buf, int tid) {
    constexpr int M = NCUR / R;
    if constexpr (M == 1) {
        constexpr int U = 4; static_assert((N / R) % (NT * U) == 0, "trip count");
#pragma unroll 1
        for (int i0 = tid; i0 < N / R; i0 += NT * U) {
            f32x2 a[U][R]; int pb[U];
#pragma unroll
            for (int u = 0; u < U; ++u) { pb[u] = fft_phys((i0 + u * NT) * R);
#pragma unroll
                for (int q = 0; q < R; ++q) a[u][q] = buf[pb[u] + q]; }
#pragma unroll
            for (int u = 0; u < U; ++u) fft_regs<R, INV>(a[u]);
#pragma unroll
            for (int u = 0; u < U; ++u)
#pragma unroll
                for (int p = 0; p < R; ++p) buf[pb[u] + p] = a[u][fft_brev<R>(p)];
        }
        return;
    }
    constexpr int U = ((N / R) % (NT * 2) == 0) ? 2 : 1;
#pragma unroll 1
    for (int i0 = tid; i0 < N / R; i0 += NT * U) {
        f32x2 a[U][R]; int pb[U]; f32x2 w1[U];
#pragma unroll
        for (int u = 0; u < U; ++u) { const int i = i0 + u * NT; const int blk = i / M, j = i - blk * M, base = blk * NCUR + j;
            pb[u] = fft_phys(base);
#pragma unroll
            for (int q = 0; q < R; ++q) a[u][q] = buf[pb[u] + q * M + 2 * ((q * M) >> 5)];
            const float rev = (float)j * (1.0f / (float)NCUR); w1[u].x = fft_cos_rev(rev); w1[u].y = INV ? fft_sin_rev(rev) : -fft_sin_rev(rev); }
#pragma unroll
        for (int u = 0; u < U; ++u) {
            f32x2 w[R]; w[1] = w1[u];
#pragma unroll
            for (int p = 2; p < R; ++p) { const int hb = (p >= 8) ? 8 : ((p >= 4) ? 4 : 2); w[p] = (p == hb) ? fft_cmul(w[hb / 2], w[hb / 2]) : fft_cmul(w[hb], w[p - hb]); }
            if (INV) {
#pragma unroll
                for (int p = 1; p < R; ++p) a[u][p] = fft_cmul(a[u][p], w[p]);
                fft_regs<R, INV>(a[u]);
            } else {
                fft_regs<R, INV>(a[u]);
#pragma unroll
                for (int p = 1; p < R; ++p) a[u][fft_brev<R>(p)] = fft_cmul(a[u][fft_brev<R>(p)], w[p]);
            }
#pragma unroll
            for (int p = 0; p < R; ++p) buf[pb[u] + p * M + 2 * ((p * M) >> 5)] = a[u][fft_brev<R>(p)];
        }
    }
}
#ifdef FFT_HOST
#define FFT_SYNC()
#else
#define FFT_SYNC() __syncthreads()
#endif

template <bool INV> __device__ __forceinline__ void fft16k(LAS f32x2* buf, int tid) {
    constexpr int N = 16384;
    if (!INV) { fft_pass<N, 16384, 16, false, NTHREADS>(buf, tid); __syncthreads(); fft_pass<N, 1024, 16, false, NTHREADS>(buf, tid); __syncthreads();
                fft_pass<N, 64, 16, false, NTHREADS>(buf, tid); __syncthreads(); fft_pass<N, 4, 4, false, NTHREADS>(buf, tid); __syncthreads(); }
    else { fft_pass<N, 4, 4, true, NTHREADS>(buf, tid); __syncthreads(); fft_pass<N, 64, 16, true, NTHREADS>(buf, tid); __syncthreads();
           fft_pass<N, 1024, 16, true, NTHREADS>(buf, tid); __syncthreads(); fft_pass<N, 16384, 16, true, NTHREADS>(buf, tid); __syncthreads(); }
}
__device__ __forceinline__ void fft8k_fwd(LAS f32x2* buf, int tid) {
    constexpr int N = 8192;
    fft_pass<N, 8192, 16, false, NTHREADS>(buf, tid); __syncthreads(); fft_pass<N, 512, 16, false, NTHREADS>(buf, tid); __syncthreads();
    fft_pass<N, 32, 16, false, NTHREADS>(buf, tid); __syncthreads(); fft_pass<N, 2, 2, false, NTHREADS>(buf, tid); __syncthreads();
}

__device__ __forceinline__ void hy_uc8(const bf16* UT, int b, int t0, int ch, const float* cw, const float* cb, float (&o)[8]) {
    const bf16* up = UT + (size_t)ch * MT + b * SEQ + t0;
    const v4u w = *(const v4u*)up;
    const bool hl = t0 > 0, hr = t0 + 8 < SEQ;
    const float hm = bf2f(up[hl ? -1 : 0]), hp = bf2f(up[hr ? 8 : 7]);
    float x[10]; x[0] = hl ? hm : 0.f; x[9] = hr ? hp : 0.f;
    x[1] = bflo(w.x); x[2] = bfhi(w.x); x[3] = bflo(w.y); x[4] = bfhi(w.y); x[5] = bflo(w.z); x[6] = bfhi(w.z); x[7] = bflo(w.w); x[8] = bfhi(w.w);
    const float w0 = cw[ch], w1 = cw[768 + ch], w2 = cw[1536 + ch], bias = cb[ch];
#pragma unroll
    for (int e = 0; e < 8; ++e) o[e] = ((bias + x[e] * w0) + x[e + 1] * w1) + x[e + 2] * w2;
}
__device__ __forceinline__ void hyena_item_fft(Frame& F, int l, int c) {
    constexpr int L = SEQ, N = 2 * SEQ;
    LAS f32x2* buf = (LAS f32x2*)F.lds;
    LAS float* red = (LAS float*)(F.lds + 139264);
    const bf16* UT = (const bf16*)(wsp(F) + WS_UT);
    const float* cw = inp(F, I_HCW) + l * 3 * 768; const float* cb = inp(F, I_HCB) + l * 768; const float* hb = inp(F, I_HBIAS) + l * 512;
    f32x2* kspec = (f32x2*)(wsp(F) + WS_KS) + (size_t)F.bid * 2 * N;
    const float* HFp = (const float*)(wsp(F) + WS_HF);
    {
        const float* f0 = HFp + (size_t)c * L; const float* b0 = HFp + (size_t)(512 + c) * L; const float* f1 = HFp + (size_t)(256 + c) * L; const float* b1 = HFp + (size_t)(768 + c) * L;
        float p0 = 0.f, p1 = 0.f;
#pragma unroll
        for (int k = 0; k < 4; ++k) { const int i0 = 4 * (F.tid + NTHREADS * k);
            const f32x4 a = *(const f32x4*)(f0 + i0), b = *(const f32x4*)(f1 + i0), cbk = *(const f32x4*)(b0 + i0), d = *(const f32x4*)(b1 + i0);
            LAS f32x4* bp = (LAS f32x4*)(buf + fft_phys(i0));
            f32x4 w; w[0] = a[0]; w[1] = b[0]; w[2] = a[1]; w[3] = b[1]; bp[0] = w; w[0] = a[2]; w[1] = b[2]; w[2] = a[3]; w[3] = b[3]; bp[1] = w;
#pragma unroll
            for (int e = 0; e < 4; ++e) { p0 += fabsf(a[e]); p1 += fabsf(b[e]); }
            if (i0 > 0) { p0 += fabsf(cbk[0]); p1 += fabsf(d[0]); f32x2 v; v.x = cbk[0]; v.y = d[0]; buf[fft_phys(N - i0)] = v; }
            else { float zf = 0.f; asm volatile("" : "+v"(zf)); f32x2 v; v.x = zf; v.y = zf; buf[fft_phys(L)] = v; }
#pragma unroll
            for (int e = 1; e < 4; ++e) { p0 += fabsf(cbk[e]); p1 += fabsf(d[e]); f32x2 v; v.x = cbk[e]; v.y = d[e]; buf[fft_phys(N - i0 - e)] = v; } }
        const float tot0 = block_sum(F, p0, red); const float tot1 = block_sum(F, p1, red);
        __syncthreads();
        fft16k<false>(buf, F.tid);
        const float s0 = 0.5f / tot0, s1 = 0.5f / tot1;
        typedef _Float16 f16x2 __attribute__((ext_vector_type(2)));
        int tp = F.tid; asm volatile("" : "+v"(tp));
#pragma unroll 2
        for (int k = 0; k < 8; ++k) { const int pos0 = 4 * (tp + NTHREADS * k);
            const LAS f32x4* ap = (const LAS f32x4*)(buf + fft_phys(pos0)); const f32x4 a01 = ap[0], a23 = ap[1];
            f32x2 o0[4], o1[4];
#pragma unroll
            for (int e = 0; e < 4; ++e) { const int pos = pos0 + e;
                const int f = (pos >> 10) + 16 * ((pos >> 6) & 15) + 256 * ((pos >> 2) & 15) + 4096 * (pos & 3), nf = (N - f) & (N - 1);
                const int pos2 = (nf & 15) * 1024 + ((nf >> 4) & 15) * 64 + ((nf >> 8) & 15) * 4 + (nf >> 12);
                f32x2 a; a.x = (e < 2 ? a01 : a23)[2 * (e & 1)]; a.y = (e < 2 ? a01 : a23)[2 * (e & 1) + 1];
                const f32x2 b = buf[fft_phys(pos2)];
                f32x2 k0, k1; k0.x = ((a.x + b.x) * s0); k0.y = ((a.y - b.y) * s0); k1.x = ((a.y + b.y) * s1); k1.y = ((b.x - a.x) * s1);
                o0[e] = k0; o1[e] = k1; }
            { f32x4 w; w[0] = o0[0].x; w[1] = o0[0].y; w[2] = o0[1].x; w[3] = o0[1].y; *(f32x4*)(kspec + pos0) = w; w[0] = o0[2].x; w[1] = o0[2].y; w[2] = o0[3].x; w[3] = o0[3].y; *(f32x4*)(kspec + pos0 + 2) = w;
              w[0] = o1[0].x; w[1] = o1[0].y; w[2] = o1[1].x; w[3] = o1[1].y; *(f32x4*)(kspec + N + pos0) = w; w[0] = o1[2].x; w[1] = o1[2].y; w[2] = o1[3].x; w[3] = o1[3].y; *(f32x4*)(kspec + N + pos0 + 2) = w; } }
        __syncthreads();
    }
    f32x2 zr[2][8];
    int tz = F.tid; asm volatile("" : "+v"(tz));
#pragma unroll
    for (int k = 0; k < 2; ++k) { const int t0 = 8 * (tz + NTHREADS * k);
        float zf = 0.f; asm volatile("" : "+v"(zf)); f32x4 zero4; zero4[0] = zf; zero4[1] = zf; zero4[2] = zf; zero4[3] = zf;
        float a0[8], a1[8]; hy_uc8(UT, 0, t0, 512 + c, cw, cb, a0); hy_uc8(UT, 1, t0, 512 + c, cw, cb, a1);
        LAS f32x4* bp = (LAS f32x4*)(buf + fft_phys(t0)); LAS f32x4* zp = (LAS f32x4*)(buf + fft_phys(L + t0));
#pragma unroll
        for (int e = 0; e < 8; ++e) { zr[k][e].x = a0[e]; zr[k][e].y = a1[e]; }
#pragma unroll
        for (int e2 = 0; e2 < 4; ++e2) { f32x4 w; w[0] = a0[2 * e2]; w[1] = a1[2 * e2]; w[2] = a0[2 * e2 + 1]; w[3] = a1[2 * e2 + 1]; bp[e2] = w; zp[e2] = zero4; } }
    __syncthreads();
#pragma unroll 1
    for (int o = 0; o < 2; ++o) {
        fft16k<false>(buf, F.tid);
        { int tm = F.tid; asm volatile("" : "+v"(tm));
          const f32x2* ks = kspec + o * N;
#pragma unroll
          for (int kh = 0; kh < 2; ++kh) {
              f32x4 kw[4][2];
#pragma unroll
              for (int k = 0; k < 4; ++k) { const f32x2* kp = ks + 4 * (tm + NTHREADS * (4 * kh + k)); kw[k][0] = *(const f32x4*)kp; kw[k][1] = *(const f32x4*)(kp + 2); }
#pragma unroll
              for (int k = 0; k < 4; ++k) { LAS f32x4* bp = (LAS f32x4*)(buf + fft_phys(4 * (tm + NTHREADS * (4 * kh + k))));
#pragma unroll
                  for (int e2 = 0; e2 < 2; ++e2) { const f32x4 z = bp[e2];
                      f32x2 za, zb, ka, kb; za.x = z[0]; za.y = z[1]; zb.x = z[2]; zb.y = z[3]; ka.x = kw[k][e2][0]; ka.y = kw[k][e2][1]; kb.x = kw[k][e2][2]; kb.y = kw[k][e2][3];
                      const f32x2 ra = fft_cmul(za, ka), rb = fft_cmul(zb, kb);
                      f32x4 w; w[0] = ra.x; w[1] = ra.y; w[2] = rb.x; w[3] = rb.y; bp[e2] = w; } } } }
        __syncthreads();
        fft16k<true>(buf, F.tid);
        const float bo = hb[o * 256 + c]; const float invn = 1.0f / (float)N;
        int tg = F.tid; asm volatile("" : "+v"(tg));
#pragma unroll
        for (int k = 0; k < 2; ++k) { const int t0 = 8 * (tg + NTHREADS * k);
            float zf = 0.f; asm volatile("" : "+v"(zf)); f32x4 zero4; zero4[0] = zf; zero4[1] = zf; zero4[2] = zf; zero4[3] = zf;
            float g0[8], g1[8]; hy_uc8(UT, 0, t0, o * 256 + c, cw, cb, g0); hy_uc8(UT, 1, t0, o * 256 + c, cw, cb, g1);
            LAS f32x4* bp = (LAS f32x4*)(buf + fft_phys(t0)); LAS f32x4* zp = (LAS f32x4*)(buf + fft_phys(L + t0));
#pragma unroll
            for (int e2 = 0; e2 < 4; ++e2) { const f32x4 cv = bp[e2];
                f32x2 za, zb; za.x = g0[2 * e2] * (cv[0] * invn + bo * zr[k][2 * e2].x); za.y = g1[2 * e2] * (cv[1] * invn + bo * zr[k][2 * e2].y);
                zb.x = g0[2 * e2 + 1] * (cv[2] * invn + bo * zr[k][2 * e2 + 1].x); zb.y = g1[2 * e2 + 1] * (cv[3] * invn + bo * zr[k][2 * e2 + 1].y);
                zr[k][2 * e2] = za; zr[k][2 * e2 + 1] = zb; }
            if (o == 0) {
#pragma unroll
                for (int e2 = 0; e2 < 4; ++e2) { f32x4 w; w[0] = zr[k][2 * e2].x; w[1] = zr[k][2 * e2].y; w[2] = zr[k][2 * e2 + 1].x; w[3] = zr[k][2 * e2 + 1].y; bp[e2] = w; zp[e2] = zero4; }
            } else {
                v4u o0, o1; o0.x = pk2(zr[k][0].x, zr[k][1].x); o0.y = pk2(zr[k][2].x, zr[k][3].x); o0.z = pk2(zr[k][4].x, zr[k][5].x); o0.w = pk2(zr[k][6].x, zr[k][7].x);
                o1.x = pk2(zr[k][0].y, zr[k][1].y); o1.y = pk2(zr[k][2].y, zr[k][3].y); o1.z = pk2(zr[k][4].y, zr[k][5].y); o1.w = pk2(zr[k][6].y, zr[k][7].y);
                bf16* hy = ((bf16*)(wsp(F) + WS_HYT)) + (size_t)c * MT + t0;
                *(v4u*)hy = o0; *(v4u*)(hy + L) = o1;
            } }
        __syncthreads();
    }
}

__device__ __forceinline__ void fnet_item_fft(Frame& F, int b, int g, int m) {
    constexpr int N = SEQ;
    LAS f32x2* buf = (LAS f32x2*)F.lds;
    LAS float* re = (LAS float*)(F.lds + 69632);
    LAS float* im = re + N;
    const bf16* ut = ((const bf16*)(wsp(F) + WS_UT)) + (size_t)(768 + g * 64) * MT + b * N;
    bf16* fnt = ((bf16*)(wsp(F) + WS_FNT)) + (size_t)(g * 64) * MT + b * N;
    const float sgn = (m == 0) ? 1.0f : -1.0f;
#pragma unroll
    for (int k = 0; k < 2; ++k) { const int n0 = 8 * (F.tid + NTHREADS * k);
        const v4u a = *(const v4u*)(ut + (size_t)m * MT + n0), bb = *(const v4u*)(ut + (size_t)(32 + m) * MT + n0);
        LAS f32x4* bp = (LAS f32x4*)(buf + fft_phys(n0));
        f32x4 w; w[0] = bflo(a.x); w[1] = sgn * bflo(bb.x); w[2] = bfhi(a.x); w[3] = sgn * bfhi(bb.x); bp[0] = w;
        w[0] = bflo(a.y); w[1] = sgn * bflo(bb.y); w[2] = bfhi(a.y); w[3] = sgn * bfhi(bb.y); bp[1] = w;
        w[0] = bflo(a.z); w[1] = sgn * bflo(bb.z); w[2] = bfhi(a.z); w[3] = sgn * bfhi(bb.z); bp[2] = w;
        w[0] = bflo(a.w); w[1] = sgn * bflo(bb.w); w[2] = bfhi(a.w); w[3] = sgn * bfhi(bb.w); bp[3] = w; }
    __syncthreads();
    fft8k_fwd(buf, F.tid);
#pragma unroll 4
    for (int pos = F.tid; pos < N; pos += NTHREADS) { const int k = (pos >> 9) + 16 * ((pos >> 5) & 15) + 256 * ((pos >> 1) & 15) + 4096 * (pos & 1);
        const f32x2 v = buf[fft_phys(pos)]; re[k] = v.x; if (m == 0) im[k] = v.y; }
    __syncthreads();
    const float scale = 1.0f / sqrtf((float)N * 64.0f);
#pragma unroll
    for (int j = 0; j < 2; ++j) { const int k0 = 8 * (F.tid + NTHREADS * j);
        float ra[8], rb[8];
        { const f32x4 x0 = *(const LAS f32x4*)(re + k0), x1 = *(const LAS f32x4*)(re + k0 + 4);
#pragma unroll
          for (int e = 0; e < 4; ++e) { ra[e] = x0[e]; ra[4 + e] = x1[e]; }
#pragma unroll
          for (int e = 0; e < 8; ++e) rb[e] = re[(N - k0 - e) & (N - 1)]; }
        if (m == 0) {
            float ia[8], ib[8];
            const f32x4 y0 = *(const LAS f32x4*)(im + k0), y1 = *(const LAS f32x4*)(im + k0 + 4);
#pragma unroll
            for (int e = 0; e < 4; ++e) { ia[e] = y0[e]; ia[4 + e] = y1[e]; }
#pragma unroll
            for (int e = 0; e < 8; ++e) ib[e] = im[(N - k0 - e) & (N - 1)];
            const float hs = 0.5f * scale;
            v4u o0, o1;
            o0.x = pk2((ra[0] + rb[0]) * hs, (ra[1] + rb[1]) * hs); o0.y = pk2((ra[2] + rb[2]) * hs, (ra[3] + rb[3]) * hs); o0.z = pk2((ra[4] + rb[4]) * hs, (ra[5] + rb[5]) * hs); o0.w = pk2((ra[6] + rb[6]) * hs, (ra[7] + rb[7]) * hs);
            o1.x = pk2((ia[0] + ib[0]) * hs, (ia[1] + ib[1]) * hs); o1.y = pk2((ia[2] + ib[2]) * hs, (ia[3] + ib[3]) * hs); o1.z = pk2((ia[4] + ib[4]) * hs, (ia[5] + ib[5]) * hs); o1.w = pk2((ia[6] + ib[6]) * hs, (ia[7] + ib[7]) * hs);
            *(v4u*)(fnt + k0) = o0; *(v4u*)(fnt + (size_t)32 * MT + k0) = o1;
        } else {
            v4u o0, o1;
            o0.x = pk2(ra[0] * scale, ra[1] * scale); o0.y = pk2(ra[2] * scale, ra[3] * scale); o0.z = pk2(ra[4] * scale, ra[5] * scale); o0.w = pk2(ra[6] * scale, ra[7] * scale);
            o1.x = pk2(rb[0] * scale, rb[1] * scale); o1.y = pk2(rb[2] * scale, rb[3] * scale); o1.z = pk2(rb[4] * scale, rb[5] * scale); o1.w = pk2(rb[6] * scale, rb[7] * scale);
            *(v4u*)(fnt + (size_t)m * MT + k0) = o0; *(v4u*)(fnt + (size_t)(64 - m) * MT + k0) = o1;
        } }
    __syncthreads();
}

typedef short bf16x8 __attribute__((ext_vector_type(8)));
typedef float f32x16 __attribute__((ext_vector_type(16)));
__device__ __forceinline__ unsigned cvtpk(float lo, float hi) { return pg8::cvt_pk_bf16(lo, hi); }
struct AttnChunk { bf16x8 k[4]; bf16x8 v[2][2]; };
__device__ __forceinline__ void attn_load_chunk(AttnChunk& C, const bf16* KT, const bf16* VT, int keyrow0, int kvh, int lane) {
    const int kb = keyrow0 >> 5;
    const bf16* kp = KT + (size_t)((kvh * NKB + kb) * 4) * 512 + lane * 8;
#pragma unroll
    for (int s = 0; s < 4; ++s) C.k[s] = *(const bf16x8*)(kp + s * 512);
    const bf16* vp = VT + (size_t)((kvh * NKB + kb) * 4) * 512 + lane * 8;
#pragma unroll
    for (int dd = 0; dd < 2; ++dd)
#pragma unroll
        for (int s = 0; s < 2; ++s) C.v[dd][s] = *(const bf16x8*)(vp + (dd * 2 + s) * 512);
}
__device__ __forceinline__ void attn_item(Frame& F, int l, int item) {
    const int lane = F.lane, r = lane & 31, h = lane >> 5;
    const bf16* QK = (const bf16*)(wsp(F) + WS_QK); const bf16* VT = (const bf16*)(wsp(F) + WS_VT); const bf16* KT = (const bf16*)(wsp(F) + WS_KT);
    int g, kvh, b, qrow0, t0; bool isctx;
    if (item < 4096) { g = item & 3; const int qblk = (item >> 2) & 255; kvh = (item >> 10) & 1; b = item >> 11; isctx = false; t0 = qblk * 32; qrow0 = b * SEQ + t0; }
    else { const int j = item - 4096; g = j & 3; const int qb = (j >> 2) & 7; kvh = (j >> 5) & 1; b = j >> 6; isctx = true; t0 = 0; qrow0 = ML + b * CTXL + qb * 32; }
    const int head = 4 * kvh + g;
    bf16x8 qf[4];
    { const bf16* qp = QK + (size_t)(qrow0 + r) * 640 + head * 64 + 8 * h;
#pragma unroll
      for (int s = 0; s < 4; ++s) qf[s] = *(const bf16x8*)(qp + 16 * s); }
    float m = inp(F, I_SINK)[l * 8 + head] * 1.4426950408889634f;
    float lsum = (h == 0) ? 1.0f : 0.0f;
    f32x16 o0, o1;
#pragma unroll
    for (int i = 0; i < 16; ++i) { o0[i] = 0.f; o1[i] = 0.f; }
    int c_lo = 0, nl = 0;
    if (!isctx) { const int qblk = t0 >> 5; c_lo = qblk < 4 ? 4 - qblk : 0; const int c_hi = (259 - qblk) < 8 ? (259 - qblk) : 8; nl = c_hi - c_lo + 1; }
    const int n = nl + 8;
    const int lrow0 = b * SEQ + t0 - 128 + 32 * c_lo, crow0 = ML + b * CTXL - 32 * nl;
#define ATT_LOAD(BUF, i_) { const int ii_ = (i_) < n ? (i_) : n - 1; attn_load_chunk(BUF, KT, VT, ii_ < nl ? lrow0 + 32 * ii_ : crow0 + 32 * ii_, kvh, lane); }
#define ATT_COMPUTE(BUF, i_) { \
        const int cc_ = (i_) < nl ? c_lo + (i_) : 100; \
        f32x16 S; \
        _Pragma("unroll") for (int i = 0; i < 16; ++i) S[i] = 0.f; \
        _Pragma("unroll") for (int s = 0; s < 4; ++s) S = __builtin_amdgcn_mfma_f32_32x32x16_bf16(BUF.k[s], qf[s], S, 0, 0, 0); \
        if (cc_ == 0 || cc_ == 8) { \
            _Pragma("unroll") for (int i = 0; i < 16; ++i) { const int kidx = (i & 3) + 8 * (i >> 2) + 4 * h; const bool ok = (cc_ == 0) ? (kidx >= r) : (kidx <= r); if (!ok) S[i] = -INFINITY; } \
        } \
        float cm = S[0]; \
        _Pragma("unroll") for (int i = 1; i < 16; ++i) cm = fmaxf(cm, S[i]); \
        cm = fmaxf(cm, shx(cm, lane, 32)); \
        const float mn = fmaxf(m, cm), alpha = __builtin_amdgcn_exp2f(m - mn); m = mn; \
        float ps = 0.f; \
        _Pragma("unroll") for (int i = 0; i < 16; ++i) { S[i] = __builtin_amdgcn_exp2f(S[i] - m); ps += S[i]; } \
        lsum = lsum * alpha + ps; \
        _Pragma("unroll") for (int i = 0; i < 16; ++i) { o0[i] *= alpha; o1[i] *= alpha; } \
        bf16x8 pf[2]; \
        _Pragma("unroll") for (int s = 0; s < 2; ++s) { v4u w; w.x = cvtpk(S[8 * s + 0], S[8 * s + 1]); w.y = cvtpk(S[8 * s + 2], S[8 * s + 3]); w.z = cvtpk(S[8 * s + 4], S[8 * s + 5]); w.w = cvtpk(S[8 * s + 6], S[8 * s + 7]); pf[s] = __builtin_bit_cast(bf16x8, w); } \
        _Pragma("unroll") for (int s = 0; s < 2; ++s) { \
            o0 = __builtin_amdgcn_mfma_f32_32x32x16_bf16(BUF.v[0][s], pf[s], o0, 0, 0, 0); \
            o1 = __builtin_amdgcn_mfma_f32_32x32x16_bf16(BUF.v[1][s], pf[s], o1, 0, 0, 0); \
        } }
    AttnChunk ca, cb2, cc3;
    ATT_LOAD(ca, 0) ATT_LOAD(cb2, 1)
    { int ci = 0;
      for (;;) {
        ATT_LOAD(cc3, ci + 2) ATT_COMPUTE(ca, ci) if (++ci >= n) break;
        ATT_LOAD(ca, ci + 2) ATT_COMPUTE(cb2, ci) if (++ci >= n) break;
        ATT_LOAD(cb2, ci + 2) ATT_COMPUTE(cc3, ci) if (++ci >= n) break;
      } }
#undef ATT_LOAD
#undef ATT_COMPUTE
    lsum += shx(lsum, lane, 32);
    const float inv = 1.0f / lsum;
    bf16* op = ((bf16*)(wsp(F) + WS_AM)) + (size_t)(qrow0 + r) * 1024 + head * 64 + 4 * h;
#pragma unroll
    for (int g4 = 0; g4 < 4; ++g4) {
        v2u w0; w0.x = cvtpk(o0[4 * g4 + 0] * inv, o0[4 * g4 + 1] * inv); w0.y = cvtpk(o0[4 * g4 + 2] * inv, o0[4 * g4 + 3] * inv); *(v2u*)(op + 8 * g4) = w0;
        v2u w1; w1.x = cvtpk(o1[4 * g4 + 0] * inv, o1[4 * g4 + 1] * inv); w1.y = cvtpk(o1[4 * g4 + 2] * inv, o1[4 * g4 + 3] * inv); *(v2u*)(op + 32 + 8 * g4) = w1;
    }
}

__device__ __forceinline__ void attn_item_naive(Frame& F, int l, int r, int kvh, LAS float* wq, LAS float* wp) {
    const int lane = F.lane;
    const bool isctx = r >= ML; const int b = isctx ? ((r - ML) >> 8) : (r >> 13); const int t = r & 8191;
    const int lo = (t - 128) < 0 ? 0 : (t - 128), hi = (t + 128) > (SEQ - 1) ? (SEQ - 1) : (t + 128);
    const int nloc = isctx ? 0 : (hi - lo + 1), nk = nloc + CTXL;
#pragma unroll
    for (int h = 0; h < 4; ++h) wq[h * 64 + lane] = bf2f(((bf16*)(wsp(F) + WS_QK))[(size_t)r * 640 + (4 * kvh + h) * 64 + lane]) * 0.125f;
    LDS_WAIT(); asm volatile("" ::: "memory");
    for (int j = lane; j < nk; j += 64) {
        const int krow = j < nloc ? (b * SEQ + lo + j) : (ML + b * CTXL + (j - nloc));
        const bf16* kp = ((bf16*)(wsp(F) + WS_QK)) + (size_t)krow * 640 + 512 + kvh * 64;
        float s0 = 0.f, s1 = 0.f, s2 = 0.f, s3 = 0.f;
#pragma unroll
        for (int d8 = 0; d8 < 8; ++d8) { const v4u kw = *(const v4u*)(kp + d8 * 8);
            float kf[8]; kf[0] = bflo(kw.x); kf[1] = bfhi(kw.x); kf[2] = bflo(kw.y); kf[3] = bfhi(kw.y); kf[4] = bflo(kw.z); kf[5] = bfhi(kw.z); kf[6] = bflo(kw.w); kf[7] = bfhi(kw.w);
#pragma unroll
            for (int e = 0; e < 8; ++e) { const int d = d8 * 8 + e; s0 += kf[e] * wq[d]; s1 += kf[e] * wq[64 + d]; s2 += kf[e] * wq[128 + d]; s3 += kf[e] * wq[192 + d]; } }
        f32x4 sv; sv[0] = s0; sv[1] = s1; sv[2] = s2; sv[3] = s3;
        *(LAS f32x4*)(wp + j * 4) = sv;
    }
    LDS_WAIT(); asm volatile("" ::: "memory");
    f32x4 mx = {-INFINITY, -INFINITY, -INFINITY, -INFINITY};
    for (int j = lane; j < nk; j += 64) { const f32x4 sv = *(LAS f32x4*)(wp + j * 4);
#pragma unroll
        for (int h = 0; h < 4; ++h) mx[h] = fmaxf(mx[h], sv[h]); }
    f32x4 sink, den;
#pragma unroll
    for (int h = 0; h < 4; ++h) { sink[h] = inp(F, I_SINK)[l * 8 + 4 * kvh + h]; mx[h] = fmaxf(wave_max(mx[h], lane), sink[h]); den[h] = 0.f; }
    for (int j = lane; j < nk; j += 64) { f32x4 sv = *(LAS f32x4*)(wp + j * 4);
#pragma unroll
        for (int h = 0; h < 4; ++h) { sv[h] = __expf(sv[h] - mx[h]); den[h] += sv[h]; }
        *(LAS f32x4*)(wp + j * 4) = sv; }
#pragma unroll
    for (int h = 0; h < 4; ++h) den[h] = wave_sum(den[h], lane) + __expf(sink[h] - mx[h]);
    LDS_WAIT(); asm volatile("" ::: "memory");
    f32x4 o = {0.f, 0.f, 0.f, 0.f};
    for (int j = 0; j < nk; ++j) {
        const int krow = j < nloc ? (b * SEQ + lo + j) : (ML + b * CTXL + (j - nloc));
        const float v = bf2f(((bf16*)(wsp(F) + WS_PR))[(size_t)krow * INW + K_END + kvh * 64 + lane]);
        const f32x4 p = *(LAS f32x4*)(wp + j * 4);
        o += p * v;
    }
#pragma unroll
    for (int h = 0; h < 4; ++h) ((bf16*)(wsp(F) + WS_ATT))[(size_t)r * 512 + (4 * kvh + h) * 64 + lane] = (bf16)f2bf(o[h] / den[h]);
    LDS_WAIT(); asm volatile("" ::: "memory");
}


__device__ __forceinline__ void hyena_ctx_wave(Frame& F, int l, int c, LAS float* kt  , LAS f32x2* z  ) {
    constexpr int L = CTXL; const int lane = F.lane;
    const bf16* UT = (const bf16*)(wsp(F) + WS_UT); const float* HFC = (const float*)(wsp(F) + WS_HFC);
    const float* cw = inp(F, I_HCW) + l * 3 * 768; const float* cb = inp(F, I_HCB) + l * 768; const float* hb = inp(F, I_HBIAS) + l * 512;
#pragma unroll
    for (int j = 0; j < 4; ++j) { const int t = lane + 64 * j; f32x2 v; v.x = hy_uc<L>(UT, ML, 0, t, 512 + c, cw, cb); v.y = hy_uc<L>(UT, ML, 1, t, 512 + c, cw, cb); z[t] = v; }
    for (int o = 0; o < 2; ++o) {
        const float* fwd = HFC + (size_t)(o * 256 + c) * L; const float* bwd = HFC + (size_t)(512 + o * 256 + c) * L;
        float part = 0.f;
#pragma unroll
        for (int j = 0; j < 4; ++j) { const int d = lane + 64 * j; const float kf = fwd[d]; kt[L + d] = kf; part += fabsf(kf);
            if (d >= 1) { const float kb = bwd[d]; kt[L - d] = kb; part += fabsf(kb); } else kt[0] = 0.f; }
        const float inv = 1.0f / wave_sum(part, lane);
        LDS_WAIT(); asm volatile("" ::: "memory");
        float r0[4] = {0.f, 0.f, 0.f, 0.f}, r1[4] = {0.f, 0.f, 0.f, 0.f};
#pragma unroll 4
        for (int s = 0; s < L; ++s) { const f32x2 zz = z[s];
#pragma unroll
            for (int j = 0; j < 4; ++j) { const float kv = kt[L + lane + 64 * j - s]; r0[j] += kv * zz.x; r1[j] += kv * zz.y; } }
        LDS_WAIT(); asm volatile("" ::: "memory");
        const float bo = hb[o * 256 + c];
#pragma unroll
        for (int j = 0; j < 4; ++j) { const int t = lane + 64 * j;
            const float g0 = hy_uc<L>(UT, ML, 0, t, o * 256 + c, cw, cb), g1 = hy_uc<L>(UT, ML, 1, t, o * 256 + c, cw, cb);
            const f32x2 zo = z[t]; f32x2 zn; zn.x = g0 * (r0[j] * inv + bo * zo.x); zn.y = g1 * (r1[j] * inv + bo * zo.y); z[t] = zn; }
        LDS_WAIT(); asm volatile("" ::: "memory");
    }
    bf16* hyt = ((bf16*)(wsp(F) + WS_HYT)) + (size_t)c * MT + ML;
#pragma unroll
    for (int j = 0; j < 4; ++j) { const int t = lane + 64 * j; const f32x2 v = z[t]; hyt[t] = (bf16)f2bf(v.x); hyt[L + t] = (bf16)f2bf(v.y); }
    LDS_WAIT(); asm volatile("" ::: "memory");
}
__device__ __forceinline__ void fnet_ctx_wave(Frame& F, int b, int g, int m, LAS f32x2* AB  , LAS f32x2* tab  ) {
    constexpr int L = CTXL; const int lane = F.lane;
    const bf16* ut = ((const bf16*)(wsp(F) + WS_UT)) + (size_t)(768 + g * 64) * MT + ML + b * L;
    const int mm = m <= 32 ? m : 64 - m;
#pragma unroll
    for (int j = 0; j < 4; ++j) { const int n = lane + 64 * j; f32x2 t; const float rev = (float)n * (1.0f / (float)L); t.x = cos_rev(rev); t.y = sin_rev(rev); tab[n] = t;
        f32x2 v; v.x = bf2f(ut[(size_t)mm * MT + n]);
        v.y = (m == 0 || m == 32) ? 0.f : (m < 32 ? bf2f(ut[(size_t)(32 + m) * MT + n]) : -bf2f(ut[(size_t)(32 + mm) * MT + n]));
        AB[n] = v; }
    LDS_WAIT(); asm volatile("" ::: "memory");
    const float scale = 1.0f / sqrtf((float)L * 64.0f);
    bf16* fnt = ((bf16*)(wsp(F) + WS_FNT)) + (size_t)(g * 64 + m) * MT + ML + b * L;
    { float acc[4] = {0.f, 0.f, 0.f, 0.f}; int idx[4] = {0, 0, 0, 0};
#pragma unroll 4
      for (int n = 0; n < L; ++n) { const f32x2 ab = AB[n];
#pragma unroll
          for (int j = 0; j < 4; ++j) { const f32x2 cs = tab[idx[j]]; acc[j] += ab.x * cs.x - ab.y * cs.y; idx[j] = (idx[j] + lane + 64 * j) & (L - 1); } }
#pragma unroll
      for (int j = 0; j < 4; ++j) fnt[lane + 64 * j] = (bf16)f2bf(acc[j] * scale); }
    LDS_WAIT(); asm volatile("" ::: "memory");
}

__device__ __forceinline__ void phase_trans(Frame& F) {
    LAS unsigned* tl = (LAS unsigned*)(F.lds + F.wave * 16640);
    const int gw = F.bid * NWAVES + F.wave, NGW = F.G * NWAVES, lane = F.lane;
    const int seg = lane & 7, q = lane >> 3;
    for (int it = gw; it < 2 * 264 * 4; it += NGW) {
        const int which = it / (264 * 4), rem = it % (264 * 4), rt = rem >> 2, ct = rem & 3;
        const bf16* src = (which == 0 ? ((const bf16*)(wsp(F) + WS_HYT)) : ((const bf16*)(wsp(F) + WS_FNT))) + (size_t)(ct * 64) * MT + rt * 64 + 8 * seg;
        bf16* dst = ((bf16*)(wsp(F) + WS_AM)) + (which == 0 ? 512 : 768) + (size_t)(rt * 64) * 1024 + ct * 64 + 8 * seg;
        v4u a[4], b[4];
#pragma unroll
        for (int j = 0; j < 4; ++j) { const bf16* p = src + (size_t)(2 * (8 * j + q)) * MT; a[j] = *(const v4u*)p; b[j] = *(const v4u*)(p + MT); }
#pragma unroll
        for (int j = 0; j < 4; ++j) { LAS unsigned* tp = tl + (8 * seg) * 33 + 8 * j + q;
            tp[0 * 33] = (a[j].x & 0xffffu) | (b[j].x << 16); tp[1 * 33] = (a[j].x >> 16) | (b[j].x & 0xffff0000u);
            tp[2 * 33] = (a[j].y & 0xffffu) | (b[j].y << 16); tp[3 * 33] = (a[j].y >> 16) | (b[j].y & 0xffff0000u);
            tp[4 * 33] = (a[j].z & 0xffffu) | (b[j].z << 16); tp[5 * 33] = (a[j].z >> 16) | (b[j].z & 0xffff0000u);
            tp[6 * 33] = (a[j].w & 0xffffu) | (b[j].w << 16); tp[7 * 33] = (a[j].w >> 16) | (b[j].w & 0xffff0000u); }
        LDS_WAIT(); asm volatile("" ::: "memory");
#pragma unroll
        for (int i = 0; i < 8; ++i) { const int row = q + 8 * i; const LAS unsigned* tp = tl + row * 33 + 4 * seg;
            v4u o; o.x = tp[0]; o.y = tp[1]; o.z = tp[2]; o.w = tp[3];
            *(v4u*)(dst + (size_t)row * 1024) = o; }
        LDS_WAIT(); asm volatile("" ::: "memory");
    }
}

__device__ __forceinline__ void phase_mix_naive(Frame& F, int l) {
    const bool last = (l == DEPTH - 1);
    SUBPR_START(13)
    { const int gw = F.bid * NWAVES + F.wave, NGW = F.G * NWAVES;
      for (int it = gw; it < 4096; it += NGW) attn_item(F, l, it);
      if (!last && F.wave == 3 && F.bid < 128) attn_item(F, l, 4096 + F.bid); }
    SUBPR_STOP(13)
    SUBPR_START(15)
    if (!last) { const int rank = F.wave * F.G + F.bid, NR = F.G * NWAVES;
      LAS float* wl = (LAS float*)(F.lds + F.wave * 4096);
      for (int it = rank; it < 256 + 512; it += NR) {
          if (it < 256) hyena_ctx_wave(F, l, it, wl, (LAS f32x2*)(wl + 512));
          else { const int j = it - 256; fnet_ctx_wave(F, j >> 8, (j >> 6) & 3, j & 63, (LAS f32x2*)wl, (LAS f32x2*)(wl + 512)); } } }
    SUBPR_STOP(15)
    __syncthreads();
    SUBPR_START(14)
    for (int c = F.bid; c < 256; c += F.G) hyena_item_fft(F, l, c);
    SUBPR_STOP(14)
    SUBPR_START(16)
    for (int it = F.bid; it < 256; it += F.G) fnet_item_fft(F, it >> 7, (it >> 5) & 3, it & 31);
    SUBPR_STOP(16)
}

__device__ __forceinline__ void small_gemm_partial(Frame& F, const bf16* A, int lda, const bf16* Bt, int ldb, int k0w, int kw, int row0, int col0) {
    typedef short bf16x8_t __attribute__((ext_vector_type(8))); typedef float f32x16_t __attribute__((ext_vector_type(16)));
    LAS float* part = (LAS float*)F.lds;
    const int r = F.lane & 31, h = F.lane >> 5, k0 = k0w + 8 * h;
    const bf16* ap = A + (size_t)(row0 + r) * lda + k0; const bf16* bp0 = Bt + (size_t)(col0 + r) * ldb + k0; const bf16* bp1 = bp0 + (size_t)32 * ldb;
    f32x16_t acc0, acc1;
#pragma unroll
    for (int q = 0; q < 16; ++q) { acc0[q] = 0.f; acc1[q] = 0.f; }
#pragma unroll 8
    for (int k = 0; k < kw; k += 16) { const bf16x8_t a = *(const bf16x8_t*)(ap + k), b0 = *(const bf16x8_t*)(bp0 + k), b1 = *(const bf16x8_t*)(bp1 + k);
        acc0 = __builtin_amdgcn_mfma_f32_32x32x16_bf16(b0, a, acc0, 0, 0, 0); acc1 = __builtin_amdgcn_mfma_f32_32x32x16_bf16(b1, a, acc1, 0, 0, 0); }
#pragma unroll
    for (int q = 0; q < 16; ++q) { const int col = (q & 3) + 8 * (q >> 2) + 4 * h; part[(F.wave * 64 + col) * 32 + r] = acc0[q]; part[(F.wave * 64 + 32 + col) * 32 + r] = acc1[q]; }
    __syncthreads();
}
__device__ __forceinline__ f32x4 small_gemm_reduce(Frame& F, int w0, int w1) {
    const LAS float* part = (const LAS float*)F.lds;
    const int tok = F.tid & 31, cq = F.tid >> 5; f32x4 s = {0.f, 0.f, 0.f, 0.f};
    for (int w = w0; w < w1; ++w)
#pragma unroll
        for (int e = 0; e < 4; ++e) s[e] += part[(w * 64 + 4 * cq + e) * 32 + tok];
    return s;
}
__device__ __forceinline__ f32x4 small_gemm_tile(Frame& F, const bf16* A, int lda, const bf16* Bt, int ldb, int kbeg, int klen, int row0, int col0) {
    const int kw = klen >> 3;
    small_gemm_partial(F, A, lda, Bt, ldb, kbeg + F.wave * kw, kw, row0, col0);
    const f32x4 s = small_gemm_reduce(F, 0, 8);
    __syncthreads();
    return s;
}
__device__ __forceinline__ void ctx_merge(Frame& F, int l) {
    for (int it = F.bid; it < 256; it += F.G) { const int row0 = ML + (it >> 4) * 32, col0 = (it & 15) * 64;
        const bf16* A = (const bf16*)(wsp(F) + WS_AM); const bf16* Bt = ((const bf16*)(wsp(F) + WS_WPA)) + (size_t)l * 1024 * 1024; const unsigned char* G8 = (const unsigned char*)(wsp(F) + WS_PR);
        const int row = row0 + (F.tid & 31), col = col0 + 4 * (F.tid >> 5); f32x4 tot = {0.f, 0.f, 0.f, 0.f};
        small_gemm_partial(F, A, 1024, Bt, 1024, 128 * F.wave, 128, row0, col0);
#pragma unroll
        for (int br = 0; br < 3; ++br) { const f32x4 p = small_gemm_reduce(F, br == 0 ? 0 : (br == 1 ? 4 : 6), br == 0 ? 4 : (br == 1 ? 6 : 8));
            const unsigned gw = *(const unsigned*)(G8 + (size_t)row * 3072 + br * 1024 + col);
            tot[0] += (float)(gw & 0xffu) * p[0]; tot[1] += (float)((gw >> 8) & 0xffu) * p[1]; tot[2] += (float)((gw >> 16) & 0xffu) * p[2]; tot[3] += (float)(gw >> 24) * p[3]; }
        __syncthreads();
        tot = tot * (1.0f / 255.0f);
        v2u o; o.x = pk2(tot[0], tot[1]); o.y = pk2(tot[2], tot[3]); *(v2u*)(((bf16*)(wsp(F) + WS_M)) + (size_t)row * 1024 + col) = o; }
}
__device__ __forceinline__ void ctx_resid(Frame& F, const bf16* A, int K, const bf16* Bt, const float* gate_ctx  ) {
    for (int it = F.bid; it < 256; it += F.G) { const int row0 = ML + (it >> 4) * 32, col0 = (it & 15) * 64;
        const f32x4 p = small_gemm_tile(F, A, K, Bt, K, 0, K, row0, col0);
        const int row = row0 + (F.tid & 31), col = col0 + 4 * (F.tid >> 5);
        bf16* xp = ((bf16*)(wsp(F) + WS_XS)) + (size_t)row * 1024 + col;
        const v2u xw = *(const v2u*)xp; const f32x4 gv = *(const f32x4*)(gate_ctx + col);
        v2u o; o.x = pk2(bflo(xw.x) + gv[0] * p[0], bfhi(xw.x) + gv[1] * p[1]); o.y = pk2(bflo(xw.y) + gv[2] * p[2], bfhi(xw.y) + gv[3] * p[3]);
        *(v2u*)xp = o; }
}

constexpr int NPL = 11;
constexpr int NPHASES = 1 + DEPTH * NPL + 1;
#ifndef ONE_LAUNCH
#define ONE_LAUNCH 1
#endif

__global__ void __launch_bounds__(NTHREADS, 2) fwd_kernel(Args args) {
    extern __shared__ __attribute__((aligned(16))) unsigned char lds[];
    Frame F;
    F.lds = (LAS unsigned char*)lds;
    F.tid = threadIdx.x; F.lane = F.tid & 63; F.wave = __builtin_amdgcn_readfirstlane(F.tid >> 6);
    F.G = gridDim.x; F.bid = blockIdx.x;
    unsigned char* ws = args.ws; F.ws = ws;
    F.ctl = (unsigned*)(ws + WS_CTL);
    F.a = &args; F.z = 0;
    volatile LAS unsigned* MISC = (volatile LAS unsigned*)(F.lds + MISC_OFF);
    for (int u = F.tid; u < 64; u += NTHREADS) MISC[u] = 0u;
    __syncthreads();
    const int lo = args.ph_lo, hi = args.ph_hi;
    XcdBarrier bar; bar.bar = F.ctl + CW_BAR; bar.x = 0; bar.st = nullptr;
    if (hi - lo > 1) bar = xcd_barrier_post(F.ctl + CW_BAR, MISC + 8);
    F.pr_acc = 0ull; F.pr_t0 = 0ull;
#define PR_TYPE(k) ((k) == 0 ? 11 : ((k) == 1 + DEPTH * NPL ? 12 : (((k) - 1) % NPL)))
#ifndef PROBE_LAYERS
#define PROBE_LAYERS 0xF
#endif
#define PR_LAYER(k) ((k) == 0 || (k) == 1 + DEPTH * NPL ? 0 : (((k) - 1) / NPL))
#define PR_START(k) if (PROBE_MASK && ((PROBE_MASK >> PR_TYPE(k)) & 1) && ((PROBE_LAYERS >> PR_LAYER(k)) & 1)) F.pr_t0 = __builtin_amdgcn_s_memrealtime();
#define PR_STOP(k) if (PROBE_MASK && ((PROBE_MASK >> PR_TYPE(k)) & 1) && ((PROBE_LAYERS >> PR_LAYER(k)) & 1)) F.pr_acc += __builtin_amdgcn_s_memrealtime() - F.pr_t0;
#define PH_BEGIN(k) if (lo <= (k) && (k) < hi) { PR_START(k) { int t_ = threadIdx.x; asm volatile("" : "+v"(t_)); F.tid = t_; F.lane = t_ & 63; F.wave = __builtin_amdgcn_readfirstlane(t_ >> 6); int z_ = 0; asm volatile("" : "+s"(z_)); F.z = z_; }
#define PH_END(k) if ((k) + 1 < hi) xcd_barrier_impl(bar.bar, bar.x, bar.st); PR_STOP(k) }

    PH_BEGIN(0) phase_prologue(F); PH_END(0)

    for (int l = 0; l < DEPTH; ++l) {
        const int pb = 1 + l * NPL;
        const float* modl = ((float*)(wsp(F) + WS_CTL) + CW_MOD) + (size_t)l * 3 * 6144;
        const bool moe = (l & 1) != 0; const int fi = l >> 1;

        PH_BEGIN(pb + 0)
            if (l > 0 && ((l - 1) & 1)) phase_norm<false, true, true>(F, l, nullptr, nullptr, inp(F, I_N1G) + l * 1024, 0, nullptr, MT, F.G > 64 ? 8 : 0);
            else if (l == 0) phase_norm<false, false, true, false>(F, l, inp(F, I_X), inp(F, I_CTX), inp(F, I_N1G) + l * 1024, 0, nullptr, MT, F.G > 64 ? 8 : 0);
            else phase_norm<false, false, true>(F, l, nullptr, nullptr, inp(F, I_N1G) + l * 1024, 0, nullptr, MT, F.G > 64 ? 8 : 0);
            for (int it = F.bid; it < 264; it += F.G) { if (it < 256) filter_tile(F, l, SEQ, it * 32, ((float*)(wsp(F) + WS_HF)), it == F.bid); else filter_tile(F, l, CTXL, (it - 256) * 32, ((float*)(wsp(F) + WS_HFC)), it == F.bid); }
        PH_END(pb + 0)

        PH_BEGIN(pb + 1)
            pg8::Gemm g{((bf16*)(wsp(F) + WS_H)), ((bf16*)(wsp(F) + WS_WIN)) + (size_t)l * INW * 1024, MT, INW, 1024}; pg8::StaticOrder S; S.init(MT, INW, F.G, F.bid);
            pg8::EpiIn E{wsp(F), l};
            pg8::gemm_phase<pg8::EpiIn, pg8::StaticOrder, true, true>(F.lds, g, S, E);
        PH_END(pb + 1)


        PH_BEGIN(pb + 3) phase_mix_naive(F, l); PH_END(pb + 3)

        PH_BEGIN(pb + 4) phase_trans(F); PH_END(pb + 4)

        PH_BEGIN(pb + 5)
            if (l != DEPTH - 1) ctx_merge(F, l);
            pg8::Gemm g{((bf16*)(wsp(F) + WS_AM)), ((bf16*)(wsp(F) + WS_WPA)) + (size_t)l * 1024 * 1024, ML, 1024, 1024}; pg8::StaticOrder S; S.init(ML, 1024, F.G, F.bid);
            pg8::EpiMerge E{((const unsigned char*)(wsp(F) + WS_PR)), ((bf16*)(wsp(F) + WS_M))};
            pg8::gemm_phase<pg8::EpiMerge, pg8::StaticOrder, true, true>(F.lds, g, S, E);
        PH_END(pb + 5)

        PH_BEGIN(pb + 6)
            if (l != DEPTH - 1) ctx_resid(F, (const bf16*)(wsp(F) + WS_M), 1024, ((const bf16*)(wsp(F) + WS_WO)) + (size_t)l * 1024 * 1024, modl + 2 * 6144 + 2048);
            pg8::Gemm g{((bf16*)(wsp(F) + WS_M)), ((bf16*)(wsp(F) + WS_WO)) + (size_t)l * 1024 * 1024, ML, 1024, 1024}; pg8::StaticOrder S; S.init(ML, 1024, F.G, F.bid);
            pg8::EpiResid E{((bf16*)(wsp(F) + WS_XS)), modl + 2048};
            pg8::gemm_phase<pg8::EpiResid, pg8::StaticOrder, true, true>(F.lds, g, S, E);
        PH_END(pb + 6)

        PH_BEGIN(pb + 7)
            if (moe) phase_norm<true, false, true>(F, l, nullptr, nullptr, inp(F, I_N2G) + l * 1024, 3072, inp(F, I_ROUTER) + (size_t)fi * 1024 * 8, MT);
            else phase_norm<false, false, true>(F, l, nullptr, nullptr, inp(F, I_N2G) + l * 1024, 3072, nullptr, MT);
        PH_END(pb + 7)


        PH_BEGIN(pb + 9)
            LAS int* poff = (LAS int*)(F.lds + LDS_TAB + 64);
            if (moe) {
                moe_offsets(F, l, poff);
                LAS unsigned* gtab = (LAS unsigned*)(F.lds + LDS_TAB + 128);
                pg8::Gemm g{((bf16*)(wsp(F) + WS_H)), ((bf16*)(wsp(F) + WS_MGU)) + (size_t)(fi * 8) * 5632 * 1024, MOE_MAXP * 256, 8 * 5632, 1024}; pg8::MoeOrder S{22, F.G, F.bid, poff, gtab};
                {
                    const unsigned* cnt = (const unsigned*)(wsp(F) + WS_CTL) + CW_CNT + l * 64; const unsigned* toke = (const unsigned*)(wsp(F) + WS_TOKE);
                    const int np = poff[8], nun = (np * 22 - F.bid + F.G - 1) / F.G;
#pragma unroll 7
                    for (int idx = F.tid; idx < nun * 256; idx += NTHREADS) { const int i = idx >> 8, row = idx & 255, p = (i * F.G + F.bid) / 22; int e = 0;
#pragma unroll
                        for (int k = 1; k < 8; ++k) e += (p >= poff[k]) ? 1 : 0;
                        const int pos = (p - poff[e]) * 256 + row; const unsigned ce = __hip_atomic_load(cnt + e, __ATOMIC_RELAXED, __HIP_MEMORY_SCOPE_AGENT);
                        unsigned tok = 0u; if ((unsigned)pos < ce) tok = toke[(size_t)e * MT + pos];
                        gtab[idx] = (tok < (unsigned)MT ? tok : 0u) * 2048u; }
                    __syncthreads(); }
                pg8::EpiSwiglu E{((bf16*)(wsp(F) + WS_HIDG)), DFF, 22};
                pg8::gemm_phase<pg8::EpiSwiglu, pg8::MoeOrder, true, true, true>(F.lds, g, S, E);
            } else {
                pg8::Gemm g{((bf16*)(wsp(F) + WS_H)), ((bf16*)(wsp(F) + WS_FGU)) + (size_t)fi * 5632 * 1024, MT, 5632, 1024}; pg8::StaticOrder S; S.init(MT, 5632, F.G, F.bid);
                pg8::EpiSwiglu E{((bf16*)(wsp(F) + WS_HID)), DFF, 22};
                pg8::gemm_phase<pg8::EpiSwiglu, pg8::StaticOrder, true, true>(F.lds, g, S, E);
            }
        PH_END(pb + 9)

        PH_BEGIN(pb + 10)
            LAS int* poff = (LAS int*)(F.lds + LDS_TAB + 64);
            if (moe) {
                moe_offsets(F, l, poff);
                pg8::Gemm g{((bf16*)(wsp(F) + WS_HIDG)), ((bf16*)(wsp(F) + WS_MD)) + (size_t)(fi * 8) * 1024 * 2816, MOE_MAXP * 256, 8 * 1024, DFF}; pg8::MoeOrder S{4, F.G, F.bid, poff, nullptr};
                pg8::EpiStore E{((bf16*)(wsp(F) + WS_Y)), 1024, 4};
                pg8::gemm_phase<pg8::EpiStore, pg8::MoeOrder, true, true>(F.lds, g, S, E);
            } else {
                ctx_resid(F, (const bf16*)(wsp(F) + WS_HID), DFF, ((const bf16*)(wsp(F) + WS_FD)) + (size_t)fi * 1024 * 2816, modl + 2 * 6144 + 5120);
                pg8::Gemm g{((bf16*)(wsp(F) + WS_HID)), ((bf16*)(wsp(F) + WS_FD)) + (size_t)fi * 1024 * 2816, ML, 1024, DFF}; pg8::StaticOrder S; S.init(ML, 1024, F.G, F.bid);
                pg8::EpiResid E{((bf16*)(wsp(F) + WS_XS)), modl + 5120};
                pg8::gemm_phase<pg8::EpiResid, pg8::StaticOrder, true, true>(F.lds, g, S, E);
            }
        PH_END(pb + 10)
    }
    PH_BEGIN(1 + DEPTH * NPL) phase_norm<false, true, false>(F, DEPTH - 1, nullptr, nullptr, nullptr, 0, nullptr, ML); PH_END(1 + DEPTH * NPL)
#undef PH_BEGIN
#undef PH_END
    if (PROBE_MASK && blockIdx.x == 0) { const unsigned long long t0 = __builtin_amdgcn_s_memrealtime(); while (__builtin_amdgcn_s_memrealtime() - t0 < F.pr_acc * PROBE_AMP) __builtin_amdgcn_s_sleep(8); }
}

extern "C" void kernel_launch(void* const* d_in, const int* in_sizes, int n_in, void* d_out, int out_size, void* d_ws, size_t ws_size, hipStream_t stream) {
    static int grid = 0;
    if (grid == 0) {
        if (n_in != 33 || out_size != ML * DM || ws_size < WS_END2) { fprintf(stderr, "kernel_launch: unexpected shapes (n_in %d out %d ws %zu need %zu)\n", n_in, out_size, ws_size, (size_t)WS_END2); grid = -1; return; }
        int dev = 0, cus = 0, per_cu = 0;
        if (hipGetDevice(&dev) != hipSuccess || hipDeviceGetAttribute(&cus, hipDeviceAttributeMultiprocessorCount, dev) != hipSuccess) { grid = -1; return; }
        if (hipFuncSetAttribute((const void*)fwd_kernel, hipFuncAttributeMaxDynamicSharedMemorySize, LDS_BYTES) != hipSuccess) { fprintf(stderr, "kernel_launch: hipFuncSetAttribute failed\n"); grid = -1; return; }
        if (hipOccupancyMaxActiveBlocksPerMultiprocessor(&per_cu, (const void*)fwd_kernel, NTHREADS, LDS_BYTES) != hipSuccess || per_cu < 1) { fprintf(stderr, "kernel_launch: occupancy query says %d\n", per_cu); }
        (void)hipGetLastError();
        grid = cus;
    }
    if (grid < 0) return;
    if (hipMemsetAsync((char*)d_ws + WS_CTL, 0, CTL_ZERO_BYTES, stream) != hipSuccess) return;
    Args a{};
    for (int i = 0; i < 33; ++i) a.in[i] = (const float*)d_in[i];
    a.in[33] = (const float*)d_out; a.ws = (unsigned char*)d_ws;
#if ONE_LAUNCH
    a.ph_lo = 0; a.ph_hi = NPHASES;
    hipLaunchKernelGGL(fwd_kernel, dim3(grid), dim3(NTHREADS), LDS_BYTES, stream, a);
#else
    for (int k = 0; k < NPHASES; ++k) {
        if (k >= 1 && k < NPHASES - 1) { const int l = (k - 1) / NPL, p = (k - 1) % NPL; if ((l & 1) == 0 && p == 8) continue; }
        a.ph_lo = k; a.ph_hi = k + 1;
        hipLaunchKernelGGL(fwd_kernel, dim3(grid), dim3(NTHREADS), LDS_BYTES, stream, a);
    }
#endif
}
```

```cpp
#include <hip/hip_runtime.h>
#include <cstdio>
#include <cstdint>
#ifndef PROBE_MASK
#define PROBE_MASK 0
#endif
#ifndef PROBE_AMP
#define PROBE_AMP 4
#endif
#define SUBPR_START(t) if (PROBE_MASK && ((PROBE_MASK >> (t)) & 1)) { __syncthreads(); F.pr_t0 = __builtin_amdgcn_s_memrealtime(); }
#define SUBPR_STOP(t) if (PROBE_MASK && ((PROBE_MASK >> (t)) & 1)) { __syncthreads(); F.pr_acc += __builtin_amdgcn_s_memrealtime() - F.pr_t0; }
namespace pg8 {
#define PG8_LAS __attribute__((address_space(3)))
typedef unsigned short bf16_t;
typedef short bf16x8 __attribute__((ext_vector_type(8)));
typedef float f32x4 __attribute__((ext_vector_type(4)));
typedef unsigned u32x4 __attribute__((ext_vector_type(4)));
constexpr int BM = 256, BK = 64, HALF = 128, HTB = HALF * BK * 2  , STAGE_BYTES = 8 * HTB, NXCD = 8, WGM = 8;

__host__ __device__ __forceinline__ int lds_byte(int r, int c) { const int st = (r >> 4) * 2 + (c >> 5), rr = r & 15, cc = c & 31, ob = rr * 64 + cc * 2; return st * 1024 + (ob ^ (((ob >> 9) & 1) << 5)); }
__host__ __device__ __forceinline__ void stage_rc(int b, int& R, int& C) { const int st = b / 1024, sb = b % 1024, swz = sb ^ (((sb >> 9) & 1) << 5); R = (st >> 1) * 16 + swz / 64; C = (st & 1) * 32 + (swz % 64) / 2; }
__host__ __device__ __forceinline__ int perm32(int rho) { const int n = rho >> 4, i = rho & 15; return 8 * (i >> 2) + 4 * n + (i & 3); }

struct Unit { int pm, pn; };
struct Gemm { const bf16_t* A; const bf16_t* Bt; int M, N, K; int ldk = 0; };

struct StaticOrder {
    int nM, nN, nwg, G, c;
    __host__ __device__ void init(int M, int N, int G_, int c_) { nM = M / BM; nN = N / BM; nwg = nM * nN; G = G_; c = c_; }
    __host__ __device__ bool next(int i, Unit& u) const {
        const long L = (long)i * G + c; if (L >= nwg) return false;
        int wgid = (int)L; { const int q = nwg / NXCD, r = nwg % NXCD, xcd = wgid % NXCD, off = wgid / NXCD; wgid = (xcd < r ? xcd * (q + 1) : r * (q + 1) + (xcd - r) * q) + off; }
        const int nig = WGM * nN, gid = wgid / nig, fm = gid * WGM, gsz = (nM - fm) < WGM ? (nM - fm) : WGM;
        u.pm = fm + ((wgid % nig) % gsz); u.pn = (wgid % nig) / gsz; return true;
    }
    __device__ __forceinline__ void a_ready(const Unit&) const {}
    __device__ __forceinline__ void done(const Unit&) const {}
    __device__ __forceinline__ int bn(const Unit& u) const { return u.pn; }
    __device__ __forceinline__ size_t kofs(const Unit&) const { return 0; }
    __device__ __forceinline__ int ntiles(const Unit&, int nt) const { return nt; }
};

__device__ __forceinline__ unsigned cvt_pk_bf16(float lo, float hi) { typedef float f32x2_c __attribute__((ext_vector_type(2))); typedef __bf16 bf16x2_c __attribute__((ext_vector_type(2))); f32x2_c v = {lo, hi}; bf16x2_c b = __builtin_convertvector(v, bf16x2_c); return __builtin_bit_cast(unsigned, b); }
typedef float f32x2 __attribute__((ext_vector_type(2)));
template <class Epi, class Sched, bool ALIGN_EPI = false, bool SP2 = false, bool GATHER_A = false>
__device__ __forceinline__ void gemm_phase(PG8_LAS unsigned char* lds, const Gemm g, const Sched& S, const Epi& E) {
    int tid_ = threadIdx.x; asm volatile("" : "+v"(tid_)); const int tid = tid_, wid = __builtin_amdgcn_readfirstlane(tid >> 6), lane = tid & 63, wr = wid >> 2, wc = wid & 3, fr = lane & 15, fq = lane >> 4;
    const int K = g.ldk ? g.ldk : g.K, nt = g.K / BK;
    unsigned voffA[2], voffB[2];
#pragma unroll
    for (int i = 0; i < 2; ++i) { int R, C; stage_rc(tid * 16 + i * 8192, R, C); const int Rb = Epi::PERM ? ((R & ~31) + perm32(R & 31)) : R;
        voffA[i] = (unsigned)(R * K + C) * 2u; voffB[i] = (unsigned)(Rb * K + C) * 2u; }
    const size_t kstep = (size_t)(BK * 2);
    const size_t hstep = (size_t)HALF * K * 2;
    const size_t tstep = 2 * hstep;
    const unsigned ldsw = (unsigned)wid * 1024u;
    const int aoff = lds_byte(wr * 64 + fr, fq * 8), boff = lds_byte(wc * 32 + fr, fq * 8);
#define PG8_SA(b, h) (((b) * 2 + (h)) * HTB)
#define PG8_SB(b, h) ((4 + (b) * 2 + (h)) * HTB)
#define PG8_STAGE(bufoff, gbase, voff) do { _Pragma("unroll") for (int _i = 0; _i < 2; ++_i) \
        __builtin_amdgcn_global_load_lds((const unsigned*)((const char*)(gbase) + (voff)[_i]), (PG8_LAS unsigned*)(lds + (bufoff) + ldsw + _i * 8192), 16, 0, 0); } while (0)
#define PG8_STAGE_A(bufoff, pA, kg, hh) do { if constexpr (GATHER_A) { _Pragma("unroll") for (int _i = 0; _i < 2; ++_i) \
        __builtin_amdgcn_global_load_lds((const unsigned*)((const char*)(kg) + cG[hh][_i]), (PG8_LAS unsigned*)(lds + (bufoff) + ldsw + _i * 8192), 16, 0, 0); } else { PG8_STAGE(bufoff, (pA) + (hh) * hstep, voffA); } } while (0)
#define PG8_STAGE_P(bufoff, s_) do { _Pragma("unroll") for (int _i = 0; _i < 2; ++_i) \
        __builtin_amdgcn_global_load_lds((const unsigned*)(E.pf_base() + pfoff + (unsigned)(((((s_) >> 2) * HALF + ((s_) & 3) * 16) * E.pf_ld() + _i * HALF) * 2)), (PG8_LAS unsigned*)(lds + (bufoff) + ldsw + _i * 8192), 16, 0, 0); } while (0)
#define PG8_LDA(dst, b, h) do { _Pragma("unroll") for (int m = 0; m < 4; ++m) _Pragma("unroll") for (int k = 0; k < 2; ++k) dst[m][k] = *(const PG8_LAS bf16x8*)(lds + PG8_SA(b, h) + aoff + m * 2048 + k * 1024); } while (0)
#define PG8_LDB(dst, b, h) do { _Pragma("unroll") for (int n = 0; n < 2; ++n) _Pragma("unroll") for (int k = 0; k < 2; ++k) dst[n][k] = *(const PG8_LAS bf16x8*)(lds + PG8_SB(b, h) + boff + n * 2048 + k * 1024); } while (0)
#define PG8_MMA(ai, bj, At, Bt) do { __builtin_amdgcn_s_setprio(1); _Pragma("unroll") for (int m = 0; m < 4; ++m) _Pragma("unroll") for (int n = 0; n < 2; ++n) _Pragma("unroll") for (int k = 0; k < 2; ++k) \
        acc[ai][bj][m][n] = __builtin_amdgcn_mfma_f32_16x16x32_bf16(Bt[n][k], At[m][k], acc[ai][bj][m][n], 0, 0, 0); __builtin_amdgcn_s_setprio(0); } while (0)
#define PG8_WAIT_V(n) asm volatile("s_waitcnt vmcnt(" #n ")" ::: "memory")
#define PG8_WAIT_L(n) asm volatile("s_waitcnt lgkmcnt(" #n ")" ::: "memory")
#define PG8_BAR __builtin_amdgcn_s_barrier()
#define PG8_SCHED __builtin_amdgcn_sched_barrier(0)
    Unit cur, nxt; int ui = 0;
    if (!S.next(0, cur)) return;
    f32x4 acc[2][2][4][2];
#pragma unroll
    for (int a = 0; a < 2; ++a)
#pragma unroll
        for (int b = 0; b < 2; ++b)
#pragma unroll
            for (int m = 0; m < 4; ++m)
#pragma unroll
                for (int n = 0; n < 2; ++n) acc[a][b][m][n] = (f32x4){0.f, 0.f, 0.f, 0.f};
    bf16x8 At[4][2], B0[2][2], B1[2][2];
    const char* cA = (const char*)g.A + (size_t)cur.pm * tstep + S.kofs(cur); const char* cB = (const char*)g.Bt + (size_t)S.bn(cur) * tstep + S.kofs(cur);
    S.a_ready(cur);
    unsigned cG[2][2] = {{0u, 0u}, {0u, 0u}}; const char* const gA = (const char*)g.A;
    auto load_cg = [&](int uidx) {
        if constexpr (GATHER_A) {
#pragma unroll
            for (int i = 0; i < 2; ++i) { int R, C; stage_rc(tid * 16 + i * 8192, R, C);
#pragma unroll
                for (int hh = 0; hh < 2; ++hh) cG[hh][i] = S.gtab[uidx * 256 + hh * HALF + R] + (unsigned)(C * 2); } } };
    load_cg(0);
    if constexpr (SP2) {
        PG8_STAGE(PG8_SB(0, 0), cB, voffB); PG8_STAGE(PG8_SB(0, 1), cB + hstep, voffB); PG8_STAGE_A(PG8_SA(0, 0), cA, gA, 0); PG8_STAGE_A(PG8_SA(0, 1), cA, gA, 1);
        if (wr == 1) PG8_BAR;
        PG8_WAIT_V(2); PG8_BAR;
        PG8_STAGE(PG8_SB(1, 0), cB + kstep, voffB); PG8_STAGE_A(PG8_SA(1, 0), cA + kstep, gA + kstep, 0); PG8_STAGE(PG8_SB(1, 1), cB + hstep + kstep, voffB);
        PG8_WAIT_V(6); PG8_BAR;
    } else {
        PG8_STAGE(PG8_SB(0, 0), cB, voffB); PG8_STAGE(PG8_SA(0, 0), cA, voffA); PG8_STAGE(PG8_SB(0, 1), cB + hstep, voffB); PG8_STAGE(PG8_SA(0, 1), cA + hstep, voffA);
        if (wr == 1) PG8_BAR;
        PG8_WAIT_V(4); PG8_BAR;
        PG8_STAGE(PG8_SB(1, 0), cB + kstep, voffB); PG8_STAGE(PG8_SA(1, 0), cA + kstep, voffA); PG8_STAGE(PG8_SB(1, 1), cB + hstep + kstep, voffB);
        PG8_WAIT_V(6); PG8_BAR;
    }
    for (;;) {
        const bool has_next = S.next(ui + 1, nxt);
        const char* nA = has_next ? (const char*)g.A + (size_t)nxt.pm * tstep + S.kofs(nxt) : cA; const char* nB = has_next ? (const char*)g.Bt + (size_t)S.bn(nxt) * tstep + S.kofs(nxt) : cB;
        const int ntu = S.ntiles(cur, nt);
        for (int t = 0; t < ntu; t += 2) {
            if constexpr (Epi::HOOK) { if (E.hook_at(t)) { if (wr == 0) PG8_BAR; E.hook(acc, cur, t, wr, wc, fr, fq); if (wr == 1) PG8_BAR; } }
            const bool last = (t == ntu - 2);
            const char* a1 = cA + (size_t)(t + 1) * kstep;
            const char* a2 = last ? nA : cA + (size_t)(t + 2) * kstep; const char* b2 = last ? nB : cB + (size_t)(t + 2) * kstep;
            const char* a3 = a2 + kstep; const char* b3 = b2 + kstep;
            bool pfl = false; unsigned pfoff = 0u;
            if constexpr (Epi::PREFETCH) { pfl = last && !has_next; if (pfl) { int fr_ = fr; asm volatile("" : "+v"(fr_)); pfoff = E.pf_off(cur, wr, wc, fr_, fq); asm volatile("" : "+v"(pfoff)); } }
            const char* g1 = gA + (size_t)(t + 1) * kstep; const char* g2 = last ? gA : gA + (size_t)(t + 2) * kstep; const char* g3 = g2 + kstep;
            if (last && has_next) S.a_ready(nxt);
            if constexpr (SP2) {
            PG8_LDB(B0, 0, 0); PG8_LDB(B1, 0, 1); PG8_SCHED; PG8_LDA(At, 0, 0); PG8_STAGE_A(PG8_SA(1, 1), a1, g1, 1);
            if constexpr (GATHER_A) { if (last && has_next) load_cg(ui + 1); }
            PG8_WAIT_V(8); PG8_WAIT_L(0); PG8_BAR; PG8_MMA(0, 0, At, B0); PG8_MMA(0, 1, At, B1); PG8_BAR; PG8_SCHED;
            PG8_LDA(At, 0, 1);
            if (pfl) { if constexpr (Epi::PREFETCH) { PG8_STAGE_P(PG8_SB(0, 0), 0); PG8_STAGE_P(PG8_SB(0, 1), 1); PG8_STAGE_P(PG8_SA(0, 0), 2); } }
            else { PG8_STAGE(PG8_SB(0, 0), b2, voffB); PG8_STAGE(PG8_SB(0, 1), b2 + hstep, voffB); PG8_STAGE_A(PG8_SA(0, 0), a2, g2, 0); }
            PG8_WAIT_V(8); PG8_WAIT_L(0); PG8_BAR; PG8_MMA(1, 0, At, B0); PG8_MMA(1, 1, At, B1); PG8_BAR; PG8_SCHED;
            PG8_LDB(B0, 1, 0); PG8_LDB(B1, 1, 1); PG8_SCHED; PG8_LDA(At, 1, 0);
            if (pfl) { if constexpr (Epi::PREFETCH) { PG8_STAGE_P(PG8_SA(0, 1), 3); } } else { PG8_STAGE_A(PG8_SA(0, 1), a2, g2, 1); }
            PG8_WAIT_V(8); PG8_WAIT_L(0); PG8_BAR; PG8_MMA(0, 0, At, B0); PG8_MMA(0, 1, At, B1); PG8_BAR; PG8_SCHED;
            PG8_LDA(At, 1, 1);
            if (pfl) { if constexpr (Epi::PREFETCH) { PG8_STAGE_P(PG8_SB(1, 0), 4); PG8_STAGE_P(PG8_SB(1, 1), 5); PG8_STAGE_P(PG8_SA(1, 0), 6); } }
            else { PG8_STAGE(PG8_SB(1, 0), b3, voffB); PG8_STAGE(PG8_SB(1, 1), b3 + hstep, voffB); PG8_STAGE_A(PG8_SA(1, 0), a3, g3, 0); }
            PG8_WAIT_V(8); PG8_WAIT_L(0); PG8_BAR; PG8_MMA(1, 0, At, B0); PG8_MMA(1, 1, At, B1); PG8_BAR; PG8_SCHED;
            } else {
            PG8_LDB(B0, 0, 0); PG8_SCHED; PG8_LDA(At, 0, 0); PG8_STAGE(PG8_SA(1, 1), a1 + hstep, voffA);
            PG8_WAIT_L(8); PG8_BAR; PG8_WAIT_L(0); PG8_MMA(0, 0, At, B0); PG8_BAR; PG8_SCHED;
            PG8_LDB(B1, 0, 1); PG8_STAGE(PG8_SB(0, 0), b2, voffB);
            PG8_BAR; PG8_WAIT_L(0); PG8_MMA(0, 1, At, B1); PG8_BAR;
            PG8_LDA(At, 0, 1); PG8_STAGE(PG8_SA(0, 0), a2, voffA);
            PG8_BAR; PG8_WAIT_L(0); PG8_MMA(1, 0, At, B0); PG8_BAR; PG8_SCHED;
            PG8_STAGE(PG8_SB(0, 1), b2 + hstep, voffB);
            PG8_WAIT_V(6); PG8_BAR; PG8_MMA(1, 1, At, B1); PG8_BAR;
            PG8_LDB(B0, 1, 0); PG8_SCHED; PG8_LDA(At, 1, 0); PG8_STAGE(PG8_SA(0, 1), a2 + hstep, voffA);
            PG8_WAIT_L(8); PG8_BAR; PG8_WAIT_L(0); PG8_MMA(0, 0, At, B0); PG8_BAR; PG8_SCHED;
            PG8_LDB(B1, 1, 1); PG8_STAGE(PG8_SB(1, 0), b3, voffB);
            PG8_BAR; PG8_WAIT_L(0); PG8_MMA(0, 1, At, B1); PG8_BAR;
            PG8_LDA(At, 1, 1); PG8_STAGE(PG8_SA(1, 0), a3, voffA);
            PG8_BAR; PG8_WAIT_L(0); PG8_MMA(1, 0, At, B0); PG8_BAR; PG8_SCHED;
            PG8_STAGE(PG8_SB(1, 1), b3 + hstep, voffB);
            PG8_WAIT_V(6); PG8_BAR; PG8_MMA(1, 1, At, B1); PG8_BAR;
            }
        }
        if constexpr (ALIGN_EPI) { if (wr == 0) PG8_BAR; }
        if constexpr (Epi::PREFETCH) { if (!has_next) { PG8_WAIT_V(0); E.pf(acc, cur, wr, wc, fr, fq, lds + (int)threadIdx.x * 16); } else E(acc, cur, wr, wc, fr, fq); S.done(cur); }
        else if constexpr (!Epi::AFTER_DRAIN) { E(acc, cur, wr, wc, fr, fq); S.done(cur); }
        if (!has_next) break;
#pragma unroll
        for (int a = 0; a < 2; ++a)
#pragma unroll
            for (int b = 0; b < 2; ++b)
#pragma unroll
                for (int m = 0; m < 4; ++m)
#pragma unroll
                    for (int n = 0; n < 2; ++n) acc[a][b][m][n] = (f32x4){0.f, 0.f, 0.f, 0.f};
        cur = nxt; cA = nA; cB = nB; ++ui;
        if constexpr (ALIGN_EPI) { if (wr == 1) PG8_BAR; }
    }
    PG8_WAIT_V(0);
    if constexpr (!ALIGN_EPI) { if (wr == 0) PG8_BAR; }
    PG8_BAR;
    if constexpr (Epi::AFTER_DRAIN) { E.fused(acc, cur, wr, wc, fr, fq, lds, wid, lane); S.done(cur); }
#undef PG8_SA
#undef PG8_SB
#undef PG8_STAGE
#undef PG8_STAGE_A
#undef PG8_STAGE_P
#undef PG8_LDA
#undef PG8_LDB
#undef PG8_MMA
#undef PG8_WAIT_V
#undef PG8_WAIT_L
#undef PG8_BAR
#undef PG8_SCHED
}
}

constexpr int NWAVES = 8, NTHREADS = 512;
constexpr int BATCH = 2, SEQ = 8192, DM = 1024, DEPTH = 4, CTXL = 256;
constexpr int ML = BATCH * SEQ;
constexpr int MC = BATCH * CTXL;
constexpr int MT = ML + MC;
constexpr int HD = 64, NH = 8, NKV = 2;
constexpr int QW = 512, KVW = 128;
constexpr int HYW = 256, FNW = 256;
constexpr int Q_END = 512, K_END = 640, V_END = 768, HY_END = 1536, FN_END = 1792, INW = 4864;
constexpr int DFF = 2816, NEXP = 8;
constexpr int FH = 64, FEMB = 33;
constexpr float EPS = 1e-6f;

constexpr size_t MiB = 1u << 20;
constexpr size_t WS_CTL = 0, CTL_ZERO_BYTES = 64 * 1024, CTL_BYTES = 4 * MiB;
constexpr size_t WS_WIN = 4 * MiB;
constexpr size_t WS_WPA = WS_WIN + 38 * MiB;
constexpr size_t WS_WPH = WS_WPA + 4 * MiB;
constexpr size_t WS_WPF = WS_WPH + 2 * MiB;
constexpr size_t WS_WO = WS_WPF + 2 * MiB;
constexpr size_t WS_FGU = WS_WO + 8 * MiB;
constexpr size_t WS_FD = WS_FGU + 22 * MiB;
constexpr size_t WS_MGU = WS_FD + 11 * MiB;
constexpr size_t WS_MD = WS_MGU + 176 * MiB;
constexpr size_t WS_XC = WS_MD + 88 * MiB;
constexpr size_t WS_H = WS_XC + 2 * MiB;
constexpr size_t WS_COMB = WS_H + 33 * MiB;
constexpr size_t WS_HF = WS_COMB + 1 * MiB;
constexpr size_t WS_HFC = WS_HF + 32 * MiB;
constexpr size_t WS_S = WS_HFC + 1 * MiB;
constexpr size_t WS_PR = WS_S;
constexpr size_t WS_QK = WS_PR + 157 * MiB;
constexpr size_t WS_ATT = WS_QK + 21 * MiB;
constexpr size_t WS_HYO = WS_ATT + 17 * MiB;
constexpr size_t WS_FNO = WS_HYO + 9 * MiB;
constexpr size_t WS_AM = WS_ATT;
constexpr size_t WS_MACC = WS_FNO + 9 * MiB;
constexpr size_t WS_M = WS_MACC + 66 * MiB;
constexpr size_t WS_END = WS_M + 33 * MiB;
constexpr size_t WS_KS = WS_MACC;
constexpr size_t WS_ZS = WS_MACC + 64 * MiB;
constexpr size_t WS_HYT = WS_MACC + 80 * MiB;
constexpr size_t WS_FNT = WS_MACC + 89 * MiB;
static_assert(WS_FNT + 9 * MiB <= WS_MACC + 99 * MiB, "mix scratch inside MACC + M");
constexpr size_t WS_CTMP = WS_M;
constexpr size_t WS_UT = WS_END;
constexpr size_t WS_VT = WS_UT + 33 * MiB;
constexpr size_t WS_KT = WS_VT + 5 * MiB;
constexpr size_t WS_XS = WS_KT + 5 * MiB;
constexpr size_t WS_TOKE = WS_XS + 33 * MiB;
constexpr size_t WS_PS = WS_TOKE + 1 * MiB;
constexpr size_t WS_END2 = WS_PS + 24 * MiB;
constexpr int NKB = MT / 32;
constexpr size_t WS_HID = WS_S;
constexpr int MOE_MAXP = 140;
constexpr size_t WS_XG = WS_S;
constexpr size_t WS_HIDG = WS_S + 70 * MiB;
constexpr size_t WS_Y = WS_S + 263 * MiB;
static_assert((size_t)MOE_MAXP * 256 * 2816 * 2 <= 193 * MiB && WS_Y + 70 * MiB <= WS_S + 350 * MiB, "moe scratch");
static_assert((size_t)MT * INW * 2 <= 157 * MiB && (size_t)MT * DFF * 2 <= 157 * MiB, "scratch sizes");
#define EPI_WS_PR WS_PR
#define EPI_WS_UT WS_UT
#define EPI_WS_VT WS_VT
#define EPI_WS_KT WS_KT
#define EPI_WS_QK WS_QK
#define EPI_WS_QKG (WS_CTL + (size_t)CW_QKG * 4)
constexpr int CW_BAR = 4096;
constexpr int CW_QKG = 12288;
constexpr int CW_CNT = 8192;
constexpr int CW_CNTW = 16384;
constexpr int CW_MOD = 262144;
static_assert((CW_MOD + 4 * 3 * 6144) * 4 <= (int)CTL_BYTES && (CW_CNT + 4 * 64) * 4 <= (int)CTL_ZERO_BYTES && (CW_BAR + 3456) * 4 <= (int)CTL_ZERO_BYTES, "ctl");

constexpr int LDS_BYTES = 147456;
constexpr int MISC_OFF = LDS_BYTES - 256;
constexpr int LDS_TAB = 131072;

#define LAS __attribute__((address_space(3)))
typedef unsigned short bf16;
typedef unsigned v4u __attribute__((ext_vector_type(4)));
typedef unsigned v2u __attribute__((ext_vector_type(2)));
typedef float f32x4 __attribute__((ext_vector_type(4)));
typedef float f32x2 __attribute__((ext_vector_type(2)));
#define LDS_WAIT() asm volatile("s_waitcnt lgkmcnt(0)" ::: "memory")
__device__ __forceinline__ unsigned f2bf(float f) { unsigned u = __builtin_bit_cast(unsigned, f); return (u + 0x7fffu + ((u >> 16) & 1u)) >> 16; }
__device__ __forceinline__ unsigned pk2(float lo, float hi) { return f2bf(lo) | (f2bf(hi) << 16); }
__device__ __forceinline__ float bf2f(unsigned short h) { return __builtin_bit_cast(float, (unsigned)h << 16); }
__device__ __forceinline__ float bflo(unsigned w) { return __builtin_bit_cast(float, w << 16); }
__device__ __forceinline__ float bfhi(unsigned w) { return __builtin_bit_cast(float, w & 0xffff0000u); }
__device__ __forceinline__ float shx(float v, int lane, int o) { return __builtin_bit_cast(float, __builtin_amdgcn_ds_bpermute((lane ^ o) << 2, __builtin_bit_cast(int, v))); }
__device__ __forceinline__ float wave_sum(float v, int lane) {
    (void)lane;
    v += __builtin_bit_cast(float, __builtin_amdgcn_update_dpp(0, __builtin_bit_cast(int, v), 0xB1, 0xf, 0xf, false));
    v += __builtin_bit_cast(float, __builtin_amdgcn_update_dpp(0, __builtin_bit_cast(int, v), 0x4E, 0xf, 0xf, false));
    v += __builtin_bit_cast(float, __builtin_amdgcn_update_dpp(0, __builtin_bit_cast(int, v), 0x141, 0xf, 0xf, false));
    v += __builtin_bit_cast(float, __builtin_amdgcn_update_dpp(0, __builtin_bit_cast(int, v), 0x140, 0xf, 0xf, false));
    const int vi = __builtin_bit_cast(int, v);
    const float r0 = __builtin_bit_cast(float, __builtin_amdgcn_readlane(vi, 0)), r1 = __builtin_bit_cast(float, __builtin_amdgcn_readlane(vi, 16));
    const float r2 = __builtin_bit_cast(float, __builtin_amdgcn_readlane(vi, 32)), r3 = __builtin_bit_cast(float, __builtin_amdgcn_readlane(vi, 48));
    return (r0 + r1) + (r2 + r3);
}
__device__ __forceinline__ float wave_max(float v, int lane) {
#pragma unroll
    for (int o = 1; o < 64; o <<= 1) v = fmaxf(v, shx(v, lane, o));
    return v;
}
__device__ __forceinline__ float sin_rev(float r) { return __builtin_amdgcn_sinf(__builtin_amdgcn_fractf(r)); }
__device__ __forceinline__ float cos_rev(float r) { return __builtin_amdgcn_cosf(__builtin_amdgcn_fractf(r)); }
__device__ __forceinline__ float sigmoidf_(float x) { return __builtin_amdgcn_rcpf(1.0f + __expf(-x)); }
constexpr float INV_2PI = 0.15915494309189535f;

#define XB_TMO      128
#define XB_XCNT(j)  (256  + 64 * (j))
#define XB_XSUB(j)  (1280 + 64 * (j))
#define XB_XGEN(j)  (2304 + 64 * (j))
#define XB_TOP      3328
#define XB_TOPGEN   3392
#define XCD_BAR_WORDS 3456
#define XB_SPIN_CAP (1u << 18)

__device__ __forceinline__ unsigned xb_ld(unsigned* p)              { return __hip_atomic_load(p, __ATOMIC_RELAXED, __HIP_MEMORY_SCOPE_AGENT); }
__device__ __forceinline__ unsigned xb_add(unsigned* p, unsigned v) { return __hip_atomic_fetch_add(p, v, __ATOMIC_RELAXED, __HIP_MEMORY_SCOPE_AGENT); }
__device__ __forceinline__ unsigned xb_xcc_id() { return (unsigned)__builtin_amdgcn_s_getreg((3 << 11) | 20) & 0xFu; }
#define XB_SPIN(cond, bar) do { unsigned _sp = 0; while (cond) { __builtin_amdgcn_s_sleep(1); \
    if ((++_sp & 255u) == 0u) { if (xb_ld(&(bar)[XB_TMO])) break; if (_sp > XB_SPIN_CAP) { atomicAdd(&(bar)[XB_TMO], 1u); break; } } } } while (0)

struct XcdBarrier {
    unsigned* bar; unsigned x;
    volatile LAS unsigned* st;
};

__device__ __forceinline__ XcdBarrier xcd_barrier_post(unsigned* bar, volatile LAS unsigned* st) {
    XcdBarrier b; b.bar = bar; b.x = xb_xcc_id(); b.st = st;
    if (threadIdx.x == 0) (void)xb_add(&bar[XB_XCNT(b.x)], 1u);
    return b;
}
__device__ __forceinline__ void xcd_barrier_complete(unsigned* bar, unsigned x, unsigned& nloc, unsigned& nx) {
    const unsigned G = gridDim.x * gridDim.y * gridDim.z;
    unsigned sum, cnt, mine, sp = 0u;
    for (;;) {
        sum = 0u; cnt = 0u; mine = 0u;
#pragma unroll
        for (unsigned j = 0; j < 16; ++j) { const unsigned c = xb_ld(&bar[XB_XCNT(j)]); sum += c; cnt += (c > 0u) ? 1u : 0u; mine = (j == x) ? c : mine; }
        if (sum == G) break;
        __builtin_amdgcn_s_sleep(1);
        if ((++sp & 255u) == 0u) { if (xb_ld(&bar[XB_TMO])) break; if (sp > XB_SPIN_CAP) { atomicAdd(&bar[XB_TMO], 1u); break; } }
    }
    nloc = mine > 0u ? mine : 1u; nx = cnt > 0u ? cnt : 1u;
}

__device__ __attribute__((noinline)) void xcd_barrier_impl(unsigned* b_bar, unsigned b_x, volatile LAS unsigned* b_st) {
    XcdBarrier b; b.bar = b_bar; b.x = b_x; b.st = b_st;
    asm volatile("s_waitcnt vmcnt(0)" ::: "memory");
    __syncthreads();
    if (threadIdx.x == 0) {
        unsigned* bar = b.bar;
        __builtin_amdgcn_s_waitcnt(0);
        unsigned nloc = b.st[0], nx = b.st[1];
        if (nloc == 0u) { xcd_barrier_complete(bar, b.x, nloc, nx); b.st[0] = nloc; b.st[1] = nx; }
        const unsigned old = xb_add(&bar[XB_XSUB(b.x)], 1u);
        const unsigned gen = old / nloc;
        if (old + 1u == (gen + 1u) * nloc) {
            __builtin_amdgcn_fence(__ATOMIC_RELEASE, "agent");
            asm volatile("s_waitcnt vmcnt(0)" ::: "memory");
            const unsigned og = xb_add(&bar[XB_TOP], 1u);
            const unsigned tg = og / nx;
            if (og + 1u == (tg + 1u) * nx) xb_add(&bar[XB_TOPGEN], 1u);
            else XB_SPIN(xb_ld(&bar[XB_TOPGEN]) == tg, bar);
            __builtin_amdgcn_fence(__ATOMIC_ACQUIRE, "agent");
            xb_add(&bar[XB_XGEN(b.x)], 1u);
            asm volatile("s_waitcnt vmcnt(0)" ::: "memory");
        } else {
            XB_SPIN(xb_ld(&bar[XB_XGEN(b.x)]) == gen, bar);
            __builtin_amdgcn_fence(__ATOMIC_ACQUIRE, "agent");
            asm volatile("s_waitcnt vmcnt(0)" ::: "memory");
        }
    }
    __syncthreads();
}

struct Args { const float* in[34]; unsigned char* ws; int ph_lo, ph_hi; };
struct Frame {
    LAS unsigned char* lds;
    unsigned* ctl;
    unsigned char* ws;
    int tid, lane, wave, G, bid;
    const struct Args* a; int z;
    unsigned long long pr_acc, pr_t0;
};
__device__ __forceinline__ const float* inp(const Frame& F, int i) { return F.a->in[i + F.z]; }
__device__ __forceinline__ float* outp(const Frame& F) { return (float*)F.a->in[33 + F.z]; }
__device__ __forceinline__ unsigned char* wsp(const Frame& F) { return F.a->ws + F.z; }
enum { I_X = 0, I_C, I_CTX, I_CCTX, I_WADA, I_BADA, I_N1G, I_N2G, I_WIN, I_QG, I_KG, I_SINK, I_HCW, I_HCB, I_FW1, I_FB1, I_FF1, I_FW2, I_FB2, I_FF2, I_FW3, I_HBIAS,
       I_WPA, I_WPH, I_WPF, I_WOUT, I_FG, I_FU, I_FDN, I_ROUTER, I_MG, I_MU, I_MDN };

namespace pg8 {
struct EpiStore {
    static constexpr bool PERM = true, AFTER_DRAIN = false, HOOK = false, PREFETCH = false;
    bf16_t* O; int ldc; int ntn;
    __device__ __forceinline__ void operator()(const f32x4 (&acc)[2][2][4][2], const Unit& u, int wr, int wc, int fr, int fq) const {
        const int row0 = u.pm * BM + wr * 64 + fr, col0 = (u.pn % ntn) * BM + wc * 32 + 8 * fq;
#pragma unroll
        for (int ai = 0; ai < 2; ++ai)
#pragma unroll
            for (int m = 0; m < 4; ++m) { bf16_t* rowp = O + (size_t)(row0 + ai * HALF + m * 16) * ldc + col0;
#pragma unroll
                for (int bj = 0; bj < 2; ++bj) { const f32x4 v0 = acc[ai][bj][m][0], v1 = acc[ai][bj][m][1];
                    u32x4 w; w.x = cvt_pk_bf16(v0[0], v0[1]); w.y = cvt_pk_bf16(v0[2], v0[3]); w.z = cvt_pk_bf16(v1[0], v1[1]); w.w = cvt_pk_bf16(v1[2], v1[3]);
                    *(u32x4*)(rowp + bj * HALF) = w; } }
    }
};
struct EpiIn {
    static constexpr bool PERM = true, AFTER_DRAIN = false, HOOK = false, PREFETCH = false;
    unsigned char* ws; int l;
    __device__ __forceinline__ void operator()(const f32x4 (&acc)[2][2][4][2], const Unit& u, int wr, int wc, int fr_, int fq_) const {
        int fr = fr_, fq = fq_; asm volatile("" : "+v"(fr), "+v"(fq));
        constexpr int ldc = 4864, mt = 16896;
        bf16_t* const O = (bf16_t*)(ws + EPI_WS_PR); bf16_t* const UT = (bf16_t*)(ws + EPI_WS_UT); bf16_t* const VT = (bf16_t*)(ws + EPI_WS_VT); bf16_t* const KT = (bf16_t*)(ws + EPI_WS_KT); bf16_t* const QK = (bf16_t*)(ws + EPI_WS_QK);
        const float* const qg = (const float*)(ws + EPI_WS_QKG) + l * 128; const float* const kg = qg + 64;
        const int row0 = u.pm * BM + wr * 64 + fr, col0 = u.pn * BM + wc * 32 + 8 * fq;
        if (u.pn < 2 || (u.pn == 2 && wc < 2)) {
            const bool isk = (u.pn == 2); const float* gain = isk ? kg : qg; const int lane = fr + 16 * fq; const bool rope = u.pm < 64;
            f32x4 gn[2][2]; float invf[4];
#pragma unroll
            for (int bj = 0; bj < 2; ++bj)
#pragma unroll
                for (int n = 0; n < 2; ++n) gn[bj][n] = *(const f32x4*)(gain + 32 * bj + 16 * n + 4 * fq);
#pragma unroll
            for (int e = 0; e < 4; ++e) invf[e] = exp2f(-(float)(4 * fq + e) * (13.287712379549449f / 16.0f)) * 0.15915494309189535f;
            const float osc = isk ? 1.0f : 0.18033688011112042f;
#pragma unroll
            for (int ai = 0; ai < 2; ++ai)
#pragma unroll
                for (int m = 0; m < 4; ++m) { const int row = row0 + ai * HALF + m * 16;
                    float ss = 0.f;
#pragma unroll
                    for (int bj = 0; bj < 2; ++bj)
#pragma unroll
                        for (int n = 0; n < 2; ++n) { const f32x4 v = acc[ai][bj][m][n]; ss += (v[0] * v[0] + v[1] * v[1]) + (v[2] * v[2] + v[3] * v[3]); }
                    { const unsigned sb = __builtin_bit_cast(unsigned, ss); auto r16 = __builtin_amdgcn_permlane16_swap(sb, sb, false, false);
                      ss = __builtin_bit_cast(float, (unsigned)r16[0]) + __builtin_bit_cast(float, (unsigned)r16[1]);
                      const unsigned sc = __builtin_bit_cast(unsigned, ss); auto r32 = __builtin_amdgcn_permlane32_swap(sc, sc, false, false);
                      ss = __builtin_bit_cast(float, (unsigned)r32[0]) + __builtin_bit_cast(float, (unsigned)r32[1]); }
                    const float rstd = 1.0f / sqrtf(ss * (1.0f / 64.0f) + 1e-6f) * osc;
                    const int t = row & 8191;
#pragma unroll
                    for (int bj = 0; bj < 2; ++bj) { const float pos = (float)(bj == 0 ? (t >> 6) : (t & 63));
                        f32x4 o1, o2;
#pragma unroll
                        for (int e = 0; e < 4; ++e) { float cs = 1.f, sn = 0.f;
                            if (rope) { const float rev = __builtin_amdgcn_fractf(pos * invf[e]); cs = __builtin_amdgcn_cosf(rev); sn = __builtin_amdgcn_sinf(rev); }
                            const float y1 = acc[ai][bj][m][0][e] * rstd * gn[bj][0][e], y2 = acc[ai][bj][m][1][e] * rstd * gn[bj][1][e];
                            o1[e] = y1 * cs - y2 * sn; o2[e] = y1 * sn + y2 * cs; }
                        typedef unsigned u32x2v __attribute__((ext_vector_type(2)));
                        u32x2v w1, w2; w1.x = cvt_pk_bf16(o1[0], o1[1]); w1.y = cvt_pk_bf16(o1[2], o1[3]); w2.x = cvt_pk_bf16(o2[0], o2[1]); w2.y = cvt_pk_bf16(o2[2], o2[3]);
                        if (!isk) { bf16_t* qp = QK + (size_t)row * 640 + (4 * u.pn + wc) * 64 + 32 * bj + 4 * fq; *(u32x2v*)qp = w1; *(u32x2v*)(qp + 16) = w2; }
                        else { bf16_t* kp = KT + (unsigned)(((wc * (mt >> 5) + (row >> 5)) * 4 + 2 * bj) * 512 + (fq >> 1) * 256 + (row & 31) * 8 + 4 * (fq & 1)); *(u32x2v*)kp = w1; *(u32x2v*)(kp + 512) = w2; }
                    }
                    asm volatile("" ::: "memory"); __builtin_amdgcn_sched_barrier(0); }
        } else if (u.pn == 2) {
            bf16_t* vb = VT + (unsigned)(((fr >> 2) & 1) * 256 + ((fr >> 3) & 1) * 4 + (fr & 3) + (u.pm * 8 + wr * 2) * 2048 + (wc - 2) * (mt >> 5) * 2048 + fq * 64);
#pragma unroll
            for (int ai = 0; ai < 2; ++ai)
#pragma unroll
                for (int bj = 0; bj < 2; ++bj)
#pragma unroll
                    for (int m = 0; m < 4; ++m)
#pragma unroll
                        for (int n = 0; n < 2; ++n)
#pragma unroll
                            for (int e = 0; e < 4; ++e) vb[bj * 1024 + ai * 4 * 2048 + (m >> 1) * 2048 + (m & 1) * 512 + (4 * n + e) * 8] = (bf16_t)(cvt_pk_bf16(acc[ai][bj][m][n][e], 0.f) & 0xffffu);
        } else if (u.pn < 7) {
#pragma unroll
            for (int ai = 0; ai < 2; ++ai)
#pragma unroll
                for (int bj = 0; bj < 2; ++bj)
#pragma unroll
                    for (int n = 0; n < 2; ++n)
#pragma unroll
                        for (int e = 0; e < 4; ++e) { bf16_t* cp = UT + (unsigned)((col0 - 768 + bj * HALF + n * 4 + e) * mt + row0 + ai * HALF);
#pragma unroll
                            for (int m = 0; m < 4; ++m) cp[m * 16] = (bf16_t)(cvt_pk_bf16(acc[ai][bj][m][n][e], 0.f) & 0xffffu); }
        } else {
#pragma unroll
            for (int ai = 0; ai < 2; ++ai)
#pragma unroll
                for (int m = 0; m < 4; ++m) {
                    unsigned char* rowp = (unsigned char*)O + (unsigned)(u.pm * 12 + (u.pn - 7)) * 65536u + (unsigned)((ai * 4 + m) * 2) * 4096u + (unsigned)(((wr * 4 + wc) * 64 + fq * 16 + fr) * 8);
#pragma unroll
                    for (int bj = 0; bj < 2; ++bj) { f32x4 v0 = acc[ai][bj][m][0], v1 = acc[ai][bj][m][1];
#pragma unroll
                        for (int e = 0; e < 4; ++e) { v0[e] = fmaxf(__builtin_floorf(255.0f * __builtin_amdgcn_rcpf(1.0f + __expf(-v0[e])) + 0.5f), 1.0f); v1[e] = fmaxf(__builtin_floorf(255.0f * __builtin_amdgcn_rcpf(1.0f + __expf(-v1[e])) + 0.5f), 1.0f); }
                        typedef unsigned u32x2v __attribute__((ext_vector_type(2))); u32x2v w; w.x = 0u; w.y = 0u;
                        w.x = __builtin_amdgcn_cvt_pk_u8_f32(v0[0], 0, w.x); w.x = __builtin_amdgcn_cvt_pk_u8_f32(v0[1], 1, w.x); w.x = __builtin_amdgcn_cvt_pk_u8_f32(v0[2], 2, w.x); w.x = __builtin_amdgcn_cvt_pk_u8_f32(v0[3], 3, w.x);
                        w.y = __builtin_amdgcn_cvt_pk_u8_f32(v1[0], 0, w.y); w.y = __builtin_amdgcn_cvt_pk_u8_f32(v1[1], 1, w.y); w.y = __builtin_amdgcn_cvt_pk_u8_f32(v1[2], 2, w.y); w.y = __builtin_amdgcn_cvt_pk_u8_f32(v1[3], 3, w.y);
                        *(u32x2v*)(rowp + bj * 4096) = w; } }
        }
    }
};
struct EpiSwiglu {
    static constexpr bool PERM = true, AFTER_DRAIN = false, HOOK = false, PREFETCH = false;
    bf16_t* O; int ldc; int ntn;
    __device__ __forceinline__ void operator()(const f32x4 (&acc)[2][2][4][2], const Unit& u, int wr, int wc, int fr, int fq) const {
        const int row0 = u.pm * BM + wr * 64 + fr, col0 = (u.pn % ntn) * HALF + wc * 32 + 8 * fq;
#pragma unroll
        for (int ai = 0; ai < 2; ++ai)
#pragma unroll
            for (int m = 0; m < 4; ++m) { bf16_t* rowp = O + (size_t)(row0 + ai * HALF + m * 16) * ldc + col0;
                float h[8];
#pragma unroll
                for (int n = 0; n < 2; ++n)
#pragma unroll
                    for (int e = 0; e < 4; ++e) { const float g = acc[ai][0][m][n][e], uu = acc[ai][1][m][n][e]; h[n * 4 + e] = g * __builtin_amdgcn_rcpf(1.0f + __expf(-g)) * uu; }
                u32x4 w; w.x = cvt_pk_bf16(h[0], h[1]); w.y = cvt_pk_bf16(h[2], h[3]); w.z = cvt_pk_bf16(h[4], h[5]); w.w = cvt_pk_bf16(h[6], h[7]);
                *(u32x4*)rowp = w; }
    }
};
struct EpiMerge {
    static constexpr bool PERM = true, AFTER_DRAIN = false, HOOK = true, PREFETCH = false;
    const unsigned char* G8  ; bf16_t* Mo;
    __device__ __forceinline__ bool hook_at(int t) const { return t == 8 || t == 12; }
    __device__ __forceinline__ static void ld8(const unsigned char* p, float (&g)[8]) { typedef unsigned u32x2v __attribute__((ext_vector_type(2))); const u32x2v w = *(const u32x2v*)p;
        g[0] = (float)(w.x & 0xffu); g[1] = (float)((w.x >> 8) & 0xffu); g[2] = (float)((w.x >> 16) & 0xffu); g[3] = (float)(w.x >> 24);
        g[4] = (float)(w.y & 0xffu); g[5] = (float)((w.y >> 8) & 0xffu); g[6] = (float)((w.y >> 16) & 0xffu); g[7] = (float)(w.y >> 24); }
    __device__ __forceinline__ void hook(f32x4 (&acc)[2][2][4][2], const Unit& u, int t, int wr, int wc, int fr, int fq) const {
        const int ga = t == 8 ? 0 : 1;
        const unsigned char* gp = G8 + (unsigned)((u.pm * 3 + ga) * 4 + u.pn) * 65536u + (unsigned)(((wr * 4 + wc) * 64 + fq * 16 + fr) * 8);
#pragma unroll
        for (int ai = 0; ai < 2; ++ai)
#pragma unroll
            for (int m = 0; m < 4; ++m)
#pragma unroll
                for (int bj = 0; bj < 2; ++bj) { float sa[8], sb[8]; ld8(gp + ((ai * 4 + m) * 2 + bj) * 4096, sa); ld8(gp + 4 * 65536 + ((ai * 4 + m) * 2 + bj) * 4096, sb);
#pragma unroll
                    for (int e = 0; e < 4; ++e) { acc[ai][bj][m][0][e] *= sa[e] * __builtin_amdgcn_rcpf(sb[e]); acc[ai][bj][m][1][e] *= sa[4 + e] * __builtin_amdgcn_rcpf(sb[4 + e]); } }
    }
    __device__ __forceinline__ void operator()(const f32x4 (&acc)[2][2][4][2], const Unit& u, int wr, int wc, int fr, int fq) const {
        const int col0 = u.pn * BM + wc * 32 + 8 * fq;
        const unsigned char* gp = G8 + (unsigned)((u.pm * 3 + 2) * 4 + u.pn) * 65536u + (unsigned)(((wr * 4 + wc) * 64 + fq * 16 + fr) * 8);
#pragma unroll
        for (int ai = 0; ai < 2; ++ai)
#pragma unroll
            for (int m = 0; m < 4; ++m) { const int r = u.pm * BM + ai * HALF + wr * 64 + m * 16 + fr;
#pragma unroll
                for (int bj = 0; bj < 2; ++bj) { float s2[8]; ld8(gp + ((ai * 4 + m) * 2 + bj) * 4096, s2); const f32x4 v0 = acc[ai][bj][m][0] * (1.0f / 255.0f), v1 = acc[ai][bj][m][1] * (1.0f / 255.0f);
                    u32x4 w; w.x = cvt_pk_bf16(v0[0] * s2[0], v0[1] * s2[1]); w.y = cvt_pk_bf16(v0[2] * s2[2], v0[3] * s2[3]); w.z = cvt_pk_bf16(v1[0] * s2[4], v1[1] * s2[5]); w.w = cvt_pk_bf16(v1[2] * s2[6], v1[3] * s2[7]);
                    *(u32x4*)(Mo + (size_t)r * 1024 + col0 + bj * HALF) = w; } }
    }
};
struct EpiResid {
    static constexpr bool PERM = true, AFTER_DRAIN = false, HOOK = false, PREFETCH = true;
    bf16_t* xs  ; const float* gate  ;
    __device__ __forceinline__ const char* pf_base() const { return (const char*)xs; }
    __device__ __forceinline__ int pf_ld() const { return 1024; }
    __device__ __forceinline__ unsigned pf_off(const Unit& u, int wr, int wc, int fr, int fq) const { return (unsigned)(((u.pm * BM + wr * 64 + fr) * 1024 + u.pn * BM + wc * 32 + 8 * fq) * 2); }
    __device__ __forceinline__ static constexpr int pf_slot(int s) { return (s == 0 ? 4 : s == 1 ? 5 : s == 2 ? 0 : s == 3 ? 1 : s == 4 ? 6 : s == 5 ? 7 : 2) * HTB; }
    template <bool PF>
    __device__ __forceinline__ void run(const f32x4 (&acc)[2][2][4][2], const Unit& u, int wr, int wc, int fr, int fq, PG8_LAS unsigned char* lp) const {
        const int col0 = u.pn * BM + wc * 32 + 8 * fq;
        const int cond = u.pm >> 5;
        const float* gp = gate + cond * 6144;
#pragma unroll
        for (int bj = 0; bj < 2; ++bj) { f32x4 gv[2];
#pragma unroll
            for (int n = 0; n < 2; ++n) gv[n] = *(const f32x4*)(gp + col0 + bj * HALF + n * 4);
#pragma unroll
            for (int ai = 0; ai < 2; ++ai)
#pragma unroll
                for (int m = 0; m < 4; ++m) { const int r = u.pm * BM + ai * HALF + wr * 64 + m * 16 + fr;
                    const unsigned off = (unsigned)r * 1024u + (unsigned)(col0 + bj * HALF);
                    u32x4 xw;
                    if (PF && ai * 4 + m < 7) xw = *(const PG8_LAS u32x4*)(lp + pf_slot(ai * 4 + m) + bj * 8192); else xw = *(const u32x4*)(xs + off);
                    f32x4 x0, x1; x0[0] = __builtin_bit_cast(float, xw.x << 16); x0[1] = __builtin_bit_cast(float, xw.x & 0xffff0000u); x0[2] = __builtin_bit_cast(float, xw.y << 16); x0[3] = __builtin_bit_cast(float, xw.y & 0xffff0000u);
                    x1[0] = __builtin_bit_cast(float, xw.z << 16); x1[1] = __builtin_bit_cast(float, xw.z & 0xffff0000u); x1[2] = __builtin_bit_cast(float, xw.w << 16); x1[3] = __builtin_bit_cast(float, xw.w & 0xffff0000u);
                    const f32x4 y0 = x0 + gv[0] * acc[ai][bj][m][0], y1 = x1 + gv[1] * acc[ai][bj][m][1];
                    u32x4 o; o.x = cvt_pk_bf16(y0[0], y0[1]); o.y = cvt_pk_bf16(y0[2], y0[3]); o.z = cvt_pk_bf16(y1[0], y1[1]); o.w = cvt_pk_bf16(y1[2], y1[3]);
                    *(u32x4*)(xs + off) = o; } }
    }
    __device__ __forceinline__ void operator()(const f32x4 (&acc)[2][2][4][2], const Unit& u, int wr, int wc, int fr, int fq) const { run<false>(acc, u, wr, wc, fr, fq, nullptr); }
    __device__ __forceinline__ void pf(const f32x4 (&acc)[2][2][4][2], const Unit& u, int wr, int wc, int fr, int fq, PG8_LAS unsigned char* lp) const { run<true>(acc, u, wr, wc, fr, fq, lp); }
};
struct MoeOrder {
    int ntn, G, c; const PG8_LAS int* poff; const PG8_LAS unsigned* gtab;
    int lmax = 1 << 30;
    __device__ __forceinline__ bool next(int i, Unit& u) const {
        const int L = i * G + c; const int np = __builtin_amdgcn_readfirstlane(poff[8]);
        if (L >= np * ntn || L >= lmax) return false;
        const int p = L / ntn, t = L - p * ntn; int e = 0;
#pragma unroll
        for (int k = 1; k < 8; ++k) e += (p >= __builtin_amdgcn_readfirstlane(poff[k])) ? 1 : 0;
        u.pm = p; u.pn = e * ntn + t; return true;
    }
    __device__ __forceinline__ void a_ready(const Unit&) const {}
    __device__ __forceinline__ void done(const Unit&) const {}
    __device__ __forceinline__ int bn(const Unit& u) const { return u.pn; }
    __device__ __forceinline__ size_t kofs(const Unit&) const { return 0; }
    __device__ __forceinline__ int ntiles(const Unit&, int nt) const { return nt; }
};
struct MoeRemOrder {
    int ntn, G, c; const PG8_LAS int* poff; int lbase;
    __device__ __forceinline__ bool next(int i, Unit& u) const {
        const int j = i * G + c; const int np = __builtin_amdgcn_readfirstlane(poff[8]); const int L = lbase + (j >> 2);
        if (L >= np * ntn) return false;
        const int p = L / ntn, t = L - p * ntn; int e = 0;
#pragma unroll
        for (int k = 1; k < 8; ++k) e += (p >= __builtin_amdgcn_readfirstlane(poff[k])) ? 1 : 0;
        u.pm = p; u.pn = (e * ntn + t) | ((j & 3) << 16); return true;
    }
    __device__ __forceinline__ void a_ready(const Unit&) const {}
    __device__ __forceinline__ void done(const Unit&) const {}
    __device__ __forceinline__ int bn(const Unit& u) const { return u.pn & 0xffff; }
    __device__ __forceinline__ size_t kofs(const Unit& u) const { const int kc = u.pn >> 16; return (size_t)(kc < 2 ? 12 * kc : 24 + 10 * (kc - 2)) * (BK * 2); }
    __device__ __forceinline__ int ntiles(const Unit& u, int) const { return (u.pn >> 16) < 2 ? 12 : 10; }
};
struct EpiStoreChunk {
    static constexpr bool PERM = true, AFTER_DRAIN = false, HOOK = false, PREFETCH = false;
    bf16_t* O; int ldc; int ntn; size_t chunk_stride;
    __device__ __forceinline__ void operator()(const f32x4 (&acc)[2][2][4][2], const Unit& u, int wr, int wc, int fr, int fq) const {
        const int row0 = u.pm * BM + wr * 64 + fr, col0 = ((u.pn & 0xffff) % ntn) * BM + wc * 32 + 8 * fq;
        bf16_t* Ok = O + (size_t)(u.pn >> 16) * chunk_stride;
#pragma unroll
        for (int ai = 0; ai < 2; ++ai)
#pragma unroll
            for (int m = 0; m < 4; ++m) { bf16_t* rowp = Ok + (size_t)(row0 + ai * HALF + m * 16) * ldc + col0;
#pragma unroll
                for (int bj = 0; bj < 2; ++bj) { const f32x4 v0 = acc[ai][bj][m][0], v1 = acc[ai][bj][m][1];
                    u32x4 w; w.x = cvt_pk_bf16(v0[0], v0[1]); w.y = cvt_pk_bf16(v0[2], v0[3]); w.z = cvt_pk_bf16(v1[0], v1[1]); w.w = cvt_pk_bf16(v1[2], v1[3]);
                    *(u32x4*)(rowp + bj * HALF) = w; } }
    }
};
}

struct TrDesc { const float* W; bf16* WT; int K, N, map, ldk, koff, item; bool skip; };
__device__ __forceinline__ void tr_load(const TrDesc& d, float (&tv)[32], int lane) {
    if (d.skip) return;
    const int nblk = d.N / 32, kb = d.item / nblk, nb = d.item % nblk, k0 = 64 * kb, n0 = 32 * nb;
#pragma unroll
    for (int i = 0; i < 32; ++i) tv[i] = d.W[(size_t)(k0 + 2 * i + (lane >> 5)) * d.N + n0 + (lane & 31)];
}
__device__ __forceinline__ void tr_finish(const TrDesc& d, const float (&tv)[32], LAS float* scr, int lane) {
    if (d.skip) return;
    const int nblk = d.N / 32, kb = d.item / nblk, nb = d.item % nblk, k0 = 64 * kb, n0 = 32 * nb;
#pragma unroll
    for (int i = 0; i < 32; ++i) scr[(2 * i + (lane >> 5)) * 33 + (lane & 31)] = tv[i];
    LDS_WAIT(); asm volatile("" ::: "memory");
    const int c = lane & 7;
#pragma unroll
    for (int j = 0; j < 4; ++j) { const int n = (lane >> 3) + 8 * j; const LAS float* s = scr + (8 * c) * 33 + n;
        v4u o; o.x = pk2(s[0 * 33], s[1 * 33]); o.y = pk2(s[2 * 33], s[3 * 33]); o.z = pk2(s[4 * 33], s[5 * 33]); o.w = pk2(s[6 * 33], s[7 * 33]);
        const int nn = n0 + n; int drow;
        if (d.map == 0) drow = nn;
        else if (d.map == 3) {
            if (nn < 640) { const int head = nn >> 6, dd = nn & 63, a = dd >> 5, hf = (dd >> 4) & 1, f = dd & 15; const int tile = head < 8 ? (head >> 2) : 2, wcc = head < 8 ? (head & 3) : (head - 8);
                drow = tile * 256 + 128 * a + 32 * wcc + 8 * (f >> 2) + 4 * hf + (f & 3); }
            else if (nn < 768) { const int vh = (nn - 640) >> 6, dd = nn & 63; drow = 512 + 128 * (dd >> 5) + 32 * (2 + vh) + (dd & 31); }
            else drow = nn; }
        else drow = (nn >> 7) * 256 + (nn & 127) + (d.map == 2 ? 128 : 0);
        *(v4u*)(d.WT + (size_t)drow * d.ldk + d.koff + k0 + 8 * c) = o; }
    LDS_WAIT(); asm volatile("" ::: "memory");
}
#define TR_GROUP(SRC, DST, CNT, KK, NN, MAP, DSTRIDE, LDK, KOFF) if (!found) { constexpr int per = ((KK) / 64) * ((NN) / 32); constexpr int tot = (CNT) * per; \
    if (r < tot) { const int mi = r / per; d.W = (SRC) + (size_t)mi * (KK) * (NN); d.WT = (DST) + (size_t)mi * (DSTRIDE); d.K = (KK); d.N = (NN); d.map = (MAP); d.ldk = (LDK); d.koff = (KOFF); d.item = r % per; found = true; } else r -= tot; }
__device__ __forceinline__ TrDesc tr_decode(Frame& F, int it) {
    TrDesc d; d.W = nullptr; d.WT = nullptr; d.K = 64; d.N = 32; d.map = 0; d.ldk = 64; d.koff = 0; d.item = 0; d.skip = false;
    int r = it; bool found = false;
    TR_GROUP(inp(F, I_WIN), ((bf16*)(wsp(F) + WS_WIN)), 4, 1024, 4864, 3, (size_t)4864 * 1024, 1024, 0)
    if (found && d.N == 4864) { const int nb = d.item % 152; d.skip = (nb >= 48 && nb < 56); }
    TR_GROUP(inp(F, I_WPA), ((bf16*)(wsp(F) + WS_WPA)), 4, 512, 1024, 0, (size_t)1024 * 1024, 1024, 0)
    TR_GROUP(inp(F, I_WPH), ((bf16*)(wsp(F) + WS_WPA)), 4, 256, 1024, 0, (size_t)1024 * 1024, 1024, 512)
    TR_GROUP(inp(F, I_WPF), ((bf16*)(wsp(F) + WS_WPA)), 4, 256, 1024, 0, (size_t)1024 * 1024, 1024, 768)
    TR_GROUP(inp(F, I_WOUT), ((bf16*)(wsp(F) + WS_WO)), 4, 1024, 1024, 0, (size_t)1024 * 1024, 1024, 0)
    TR_GROUP(inp(F, I_FG), ((bf16*)(wsp(F) + WS_FGU)), 2, 1024, 2816, 1, (size_t)5632 * 1024, 1024, 0)
    TR_GROUP(inp(F, I_FU), ((bf16*)(wsp(F) + WS_FGU)), 2, 1024, 2816, 2, (size_t)5632 * 1024, 1024, 0)
    TR_GROUP(inp(F, I_FDN), ((bf16*)(wsp(F) + WS_FD)), 2, 2816, 1024, 0, (size_t)1024 * 2816, 2816, 0)
    TR_GROUP(inp(F, I_MG), ((bf16*)(wsp(F) + WS_MGU)), 16, 1024, 2816, 1, (size_t)5632 * 1024, 1024, 0)
    TR_GROUP(inp(F, I_MU), ((bf16*)(wsp(F) + WS_MGU)), 16, 1024, 2816, 2, (size_t)5632 * 1024, 1024, 0)
    TR_GROUP(inp(F, I_MDN), ((bf16*)(wsp(F) + WS_MD)), 16, 2816, 1024, 0, (size_t)1024 * 2816, 2816, 0)
    return d;
}

__device__ __forceinline__ void phase_prologue(Frame& F) {
    constexpr int TOT_ITEMS = 4 * (16 * 152 + 8 * 32 + 4 * 32 + 4 * 32 + 16 * 32) + 2 * (16 * 88 * 2 + 44 * 32) + 16 * (16 * 88 * 2 + 44 * 32);
    constexpr int PER_BLOCK = (TOT_ITEMS + 255) / 256;
    LAS float* scr = (LAS float*)(F.lds + F.wave * 8448);
    LAS float* tl = (LAS float*)(F.lds + 8 * 8448);
    LAS float* sl = (LAS float*)(F.lds + 8 * 8448 + 17152);
    LAS int* ctr = (LAS int*)(F.lds + 8 * 8448 + 17152 + 12288);
    for (int i = F.tid; i < 3072; i += NTHREADS) { const float cv = i < 2048 ? inp(F, I_C)[i] : inp(F, I_CCTX)[i - 2048]; sl[i] = cv * sigmoidf_(cv); }
    if (F.tid == 0) ctr[0] = 0;
    if (F.bid == 0) { for (int i = F.tid; i < 512; i += NTHREADS) { const int ll = i >> 7, j = i & 127; ((float*)(wsp(F) + WS_CTL) + CW_QKG)[i] = j < 64 ? inp(F, I_QG)[ll * 64 + j] : inp(F, I_KG)[ll * 64 + j - 64]; } }
    __syncthreads();
    if (F.wave >= 6) {
        for (int it = (F.wave - 6) * F.G + F.bid; it < 4 * 96; it += 2 * F.G) {
            const int l = it / 96, cb = it % 96;
            const float* W = inp(F, I_WADA) + (size_t)l * 1024 * 6144 + cb * 64 + F.lane;
            float a0 = 0.f, a1 = 0.f, a2 = 0.f;
#pragma unroll 16
            for (int k = 0; k < 1024; ++k) { const float w = W[(size_t)k * 6144]; a0 += w * sl[k]; a1 += w * sl[1024 + k]; a2 += w * sl[2048 + k]; }
            const float bb = inp(F, I_BADA)[l * 6144 + cb * 64 + F.lane];
            float* mo = ((float*)(wsp(F) + WS_CTL) + CW_MOD) + (size_t)l * 3 * 6144 + cb * 64 + F.lane;
            mo[0] = a0 + bb; mo[6144] = a1 + bb; mo[2 * 6144] = a2 + bb;
        }
    } else if (F.wave == 5) {
        LAS float* ctab = tl + 64 * 65; LAS float* stab = ctab + 64;
        ctab[F.lane] = cos_rev((float)F.lane * (1.0f / 64.0f)); stab[F.lane] = sin_rev((float)F.lane * (1.0f / 64.0f));
        for (int it = F.bid; it < 4 * 16 * 4; it += F.G) {
            const int l = it >> 6, kb = (it >> 2) & 15, g = it & 3;
            const float* W = inp(F, I_WIN) + (size_t)l * 1024 * 4864 + (size_t)(kb * 64) * 4864 + 1536 + g * 64;
#pragma unroll 8
            for (int kk = 0; kk < 64; ++kk) tl[kk * 65 + F.lane] = W[(size_t)kk * 4864 + F.lane];
            LDS_WAIT(); asm volatile("" ::: "memory");
            bf16* dst = ((bf16*)(wsp(F) + WS_WIN)) + (size_t)l * 4864 * 1024 + (size_t)(1536 + g * 64) * 1024 + kb * 64 + F.lane;
            for (int j = 0; j < 64; ++j) {
                const int mm = j <= 32 ? j : j - 32; float a = 0.f;
                if (j <= 32) { for (int c = 0; c < 64; ++c) a += tl[F.lane * 65 + c] * ctab[(mm * c) & 63]; }
                else { for (int c = 0; c < 64; ++c) a += tl[F.lane * 65 + c] * stab[(mm * c) & 63]; }
                dst[(size_t)j * 1024] = (bf16)f2bf(a);
            }
            LDS_WAIT(); asm volatile("" ::: "memory");
        }
    }
    {
        const int ib = F.bid * PER_BLOCK, ie = (ib + PER_BLOCK) < TOT_ITEMS ? (ib + PER_BLOCK) : TOT_ITEMS;
#define TR_GRAB() (ib + __builtin_amdgcn_readfirstlane(F.lane == 0 ? atomicAdd((int*)ctr, 1) : 0))
        float t0[32], t1[32], t2[32]; TrDesc d0, d1, d2;
        int i0 = TR_GRAB(); bool v0 = i0 < ie, v1 = false, v2 = false;
        if (v0) { d0 = tr_decode(F, i0); tr_load(d0, t0, F.lane); const int i1 = TR_GRAB(); v1 = i1 < ie; if (v1) { d1 = tr_decode(F, i1); tr_load(d1, t1, F.lane); } }
        while (v0) {
            { const int i2 = v1 ? TR_GRAB() : ie; v2 = i2 < ie; if (v2) { d2 = tr_decode(F, i2); tr_load(d2, t2, F.lane); } }
            tr_finish(d0, t0, scr, F.lane); if (!v1) break;
            { const int i3 = v2 ? TR_GRAB() : ie; v0 = i3 < ie; if (v0) { d0 = tr_decode(F, i3); tr_load(d0, t0, F.lane); } }
            tr_finish(d1, t1, scr, F.lane); if (!v2) break;
            { const int i4 = v0 ? TR_GRAB() : ie; v1 = i4 < ie; if (v1) { d1 = tr_decode(F, i4); tr_load(d1, t1, F.lane); } }
            tr_finish(d2, t2, scr, F.lane);
        }
#undef TR_GRAB
    }
}

__device__ __forceinline__ void moe_offsets(Frame& F, int l, LAS int* poff) {
    if (F.tid == 0) { const unsigned* cnt = (const unsigned*)(wsp(F) + WS_CTL) + CW_CNT + l * 64; int o = 0;
        for (int e = 0; e < 8; ++e) { poff[e] = o; o += (int)((__hip_atomic_load(cnt + e, __ATOMIC_RELAXED, __HIP_MEMORY_SCOPE_AGENT) + 255u) >> 8); } poff[8] = o; }
    __syncthreads();
}
template <bool XB> struct NormRaw { typedef f32x4 T; };
template <> struct NormRaw<true> { typedef v2u T; };
__device__ __forceinline__ f32x4 norm_cvt(const f32x4 a) { return a; }
__device__ __forceinline__ f32x4 norm_cvt(const v2u a) { f32x4 r; r[0] = bflo(a.x); r[1] = bfhi(a.x); r[2] = bflo(a.y); r[3] = bfhi(a.y); return r; }
template <bool ROUTER, bool COMBINE, bool NORM, bool XB = true>
__device__ __forceinline__ void phase_norm(Frame& F, int l, const float* xlat, const float* xctx, const float* g, int moff, const float* wr, int nrows_, int skipb = 0) {
    const int gws = (F.bid - skipb) * NWAVES + F.wave + (F.bid < skipb ? (1 << 28) : 0), NGWS = (F.G - skipb) * NWAVES;
    const int rq = nrows_ / NGWS, rrem = nrows_ % NGWS;
    const int gw = ROUTER ? gws * rq + (gws < rrem ? gws : rrem) : gws, NGW = ROUTER ? 1 : NGWS, nrows = ROUTER ? gw + rq + (gws < rrem ? 1 : 0) : nrows_;
    const float* mod = ((float*)(wsp(F) + WS_CTL) + CW_MOD) + (size_t)l * 3 * 6144 + moff;
    LAS int* lcnt = (LAS int*)(F.lds + LDS_TAB + 512);
    LAS float* wrl = (LAS float*)F.lds;
    unsigned* info_all = (unsigned*)(wsp(F) + WS_COMB);
    if (ROUTER) { if (F.tid < 64) lcnt[F.tid] = 0;
        for (int i = F.tid; i < 2048; i += NTHREADS) { const int c = i >> 1, hf = i & 1; *(LAS f32x4*)(wrl + 4 * (hf * 1024 + (((c >> 8) * 4 + (c & 3)) * 64 + ((c >> 2) & 63)))) = *(const f32x4*)(wr + 4 * i); }
        __syncthreads(); }
    LAS int* cpoff = (LAS int*)(F.lds + LDS_TAB + 64);
    if (COMBINE) moe_offsets(F, l - (NORM ? 1 : 0), cpoff);
    f32x4 gg[4], s1[4], s0[4]; int cur_cond = -1;
    if (NORM) {
#pragma unroll
        for (int j = 0; j < 4; ++j) gg[j] = *(const f32x4*)(g + 256 * j + 4 * F.lane);
    }
    typedef typename NormRaw<XB>::T RawT;
    bf16* const XS = (bf16*)(wsp(F) + WS_XS);
    f32x4 v[4]; RawT vn[4], vn2[4];
#define NORM_LOADROW(DST, rr_) { if (XB) { const bf16* xr = XS + (size_t)(rr_) * 1024; _Pragma("unroll") for (int j = 0; j < 4; ++j) DST[j] = *(const RawT*)(xr + 256 * j + 4 * F.lane); } \
        else { const float* xr = (rr_) >= ML ? xctx + (size_t)((rr_) - ML) * 1024 : xlat + (size_t)(rr_) * 1024; _Pragma("unroll") for (int j = 0; j < 4; ++j) DST[j] = *(const RawT*)(xr + 256 * j + 4 * F.lane); } }
    if (gw < nrows) NORM_LOADROW(vn, gw)
    if (gw + NGW < nrows) NORM_LOADROW(vn2, gw + NGW)
    for (int r = gw; r < nrows; r += NGW) {
        const bool isctx = r >= ML; const int cond = isctx ? 2 : (r >> 13);
#pragma unroll
        for (int j = 0; j < 4; ++j) { v[j] = norm_cvt(vn[j]); vn[j] = vn2[j]; }
        { const int rn = r + 2 * NGW; if (rn < nrows) NORM_LOADROW(vn2, rn) }
        if (!XB) {
#pragma unroll
            for (int j = 0; j < 4; ++j) { v2u o; o.x = pk2(v[j][0], v[j][1]); o.y = pk2(v[j][2], v[j][3]); *(v2u*)(XS + (size_t)r * 1024 + 256 * j + 4 * F.lane) = o; }
        }
        float s = 0.f;
        if (COMBINE) {
            const unsigned* info = info_all + (size_t)r * 8;
            const float w0 = __builtin_bit_cast(float, info[2]), w1 = __builtin_bit_cast(float, info[3]);
            const int grow0 = 256 * cpoff[info[0]] + (int)info[4], grow1 = 256 * cpoff[info[1]] + (int)info[5];
            const int rsplit = ((cpoff[8] * 4 / F.G) * F.G / 4) * 256;
            const bf16* y0 = grow0 < rsplit ? ((const bf16*)(wsp(F) + WS_Y)) + (size_t)grow0 * 1024 : ((const bf16*)(wsp(F) + WS_PS)) + (size_t)(grow0 - rsplit) * 1024;
            const bf16* y1 = grow1 < rsplit ? ((const bf16*)(wsp(F) + WS_Y)) + (size_t)grow1 * 1024 : ((const bf16*)(wsp(F) + WS_PS)) + (size_t)(grow1 - rsplit) * 1024;
            const bool sp0 = grow0 >= rsplit, sp1 = grow1 >= rsplit;
            const float* gt = ((float*)(wsp(F) + WS_CTL) + CW_MOD) + (size_t)(l - (NORM ? 1 : 0)) * 3 * 6144 + 5120 + cond * 6144;
#pragma unroll
            for (int j = 0; j < 4; ++j) { const int c = 256 * j + 4 * F.lane;
                const v2u a = *(const v2u*)(y0 + c), b = *(const v2u*)(y1 + c); const f32x4 gtv = *(const f32x4*)(gt + c);
                f32x4 ya, yb; ya[0] = bflo(a.x); ya[1] = bfhi(a.x); ya[2] = bflo(a.y); ya[3] = bfhi(a.y); yb[0] = bflo(b.x); yb[1] = bfhi(b.x); yb[2] = bflo(b.y); yb[3] = bfhi(b.y);
                if (sp0) {
#pragma unroll
                    for (int kc = 1; kc < 4; ++kc) { const v2u a2 = *(const v2u*)(y0 + (size_t)kc * 12 * 256 * 1024 + c); ya[0] += bflo(a2.x); ya[1] += bfhi(a2.x); ya[2] += bflo(a2.y); ya[3] += bfhi(a2.y); } }
                if (sp1) {
#pragma unroll
                    for (int kc = 1; kc < 4; ++kc) { const v2u b2 = *(const v2u*)(y1 + (size_t)kc * 12 * 256 * 1024 + c); yb[0] += bflo(b2.x); yb[1] += bfhi(b2.x); yb[2] += bflo(b2.y); yb[3] += bfhi(b2.y); } }
                v[j][0] += gtv[0] * (w0 * ya[0] + w1 * yb[0]); v[j][1] += gtv[1] * (w0 * ya[1] + w1 * yb[1]);
                v[j][2] += gtv[2] * (w0 * ya[2] + w1 * yb[2]); v[j][3] += gtv[3] * (w0 * ya[3] + w1 * yb[3]);
                if (NORM) { v2u o; o.x = pk2(v[j][0], v[j][1]); o.y = pk2(v[j][2], v[j][3]); *(v2u*)(XS + (size_t)r * 1024 + c) = o; }
                else *(f32x4*)(outp(F) + (size_t)r * 1024 + c) = v[j]; }
        }
        if (!NORM) continue;
        if (cond != cur_cond) { cur_cond = cond; const float* sh = mod + cond * 6144; const float* sc = sh + 1024;
#pragma unroll
            for (int j = 0; j < 4; ++j) { s1[j] = *(const f32x4*)(sc + 256 * j + 4 * F.lane); s0[j] = *(const f32x4*)(sh + 256 * j + 4 * F.lane); } }
#pragma unroll
        for (int j = 0; j < 4; ++j) s += (v[j][0] * v[j][0] + v[j][1] * v[j][1]) + (v[j][2] * v[j][2] + v[j][3] * v[j][3]);
        const float rstd = 1.0f / sqrtf(wave_sum(s, F.lane) * (1.0f / 1024.0f) + EPS);
        float lg[8];
        if (ROUTER) {
#pragma unroll
            for (int e = 0; e < 8; ++e) lg[e] = 0.f;
        }
#pragma unroll
        for (int j = 0; j < 4; ++j) { const int c = 256 * j + 4 * F.lane;
            f32x4 y;
#pragma unroll
            for (int e = 0; e < 4; ++e) y[e] = (v[j][e] * rstd * gg[j][e]) * (1.0f + s1[j][e]) + s0[j][e];
            v2u o; o.x = pk2(y[0], y[1]); o.y = pk2(y[2], y[3]);
            *(v2u*)(((bf16*)(wsp(F) + WS_H)) + (size_t)r * 1024 + c) = o;
            if (ROUTER) {
#pragma unroll
                for (int e = 0; e < 4; ++e) { const f32x4 w0 = *(LAS f32x4*)(wrl + 4 * ((j * 4 + e) * 64 + F.lane)), w1 = *(LAS f32x4*)(wrl + 4 * (1024 + (j * 4 + e) * 64 + F.lane));
                    lg[0] += y[e] * w0[0]; lg[1] += y[e] * w0[1]; lg[2] += y[e] * w0[2]; lg[3] += y[e] * w0[3];
                    lg[4] += y[e] * w1[0]; lg[5] += y[e] * w1[1]; lg[6] += y[e] * w1[2]; lg[7] += y[e] * w1[3]; }
            }
        }
        if (ROUTER) {
#pragma unroll
            for (int e = 0; e < 8; ++e) lg[e] = wave_sum(lg[e], F.lane);
            int i0 = 0; float v0 = lg[0];
#pragma unroll
            for (int e = 1; e < 8; ++e) if (lg[e] > v0) { v0 = lg[e]; i0 = e; }
            int i1 = -1; float v1 = -INFINITY;
#pragma unroll
            for (int e = 0; e < 8; ++e) if (e != i0 && lg[e] > v1) { v1 = lg[e]; i1 = e; }
            const float w0 = 1.0f / (1.0f + __expf(v1 - v0)), w1 = 1.0f - w0;
            if (F.lane == 0) { LAS int* wcl = lcnt + F.wave * 8; const int p0 = wcl[i0]; wcl[i0] = p0 + 1; const int p1 = wcl[i1]; wcl[i1] = p1 + 1;
                unsigned* info = info_all + (size_t)r * 8;
                info[0] = (unsigned)i0; info[1] = (unsigned)i1; info[2] = __builtin_bit_cast(unsigned, w0); info[3] = __builtin_bit_cast(unsigned, w1); info[4] = (unsigned)p0; info[5] = (unsigned)p1; }
        }
    }
    if (ROUTER) {
        asm volatile("s_waitcnt vmcnt(0) lgkmcnt(0)" ::: "memory");
        __syncthreads();
        if (F.tid < 64) ((unsigned*)(wsp(F) + WS_CTL) + CW_CNTW)[(size_t)(F.bid * 8 + (F.tid >> 3)) * 8 + (F.tid & 7)] = (unsigned)lcnt[F.tid];
        if (F.tid < 8) { unsigned* cnt = (unsigned*)(wsp(F) + WS_CTL) + CW_CNT + l * 64; int tot = 0;
#pragma unroll
            for (int w = 0; w < 8; ++w) tot += lcnt[w * 8 + F.tid];
            (void)__hip_atomic_fetch_add(cnt + F.tid, (unsigned)tot, __ATOMIC_RELAXED, __HIP_MEMORY_SCOPE_AGENT); }
    }
}

#undef NORM_LOADROW
__device__ __forceinline__ void phase_moe_slots(Frame& F, int l) {
    const unsigned* cntw = (const unsigned*)(wsp(F) + WS_CTL) + CW_CNTW;
    LAS int* red = (LAS int*)(F.lds);
    LAS int* wb = (LAS int*)(F.lds + 4096);
    const int e = F.tid & 7, g = F.tid >> 3, nprev = F.bid * 8;
    int acc = 0;
    for (int s = g; s < nprev; s += 64) acc += (int)cntw[(size_t)s * 8 + e];
    red[g * 8 + e] = acc;
    __syncthreads();
    if (F.tid < 8) { int b = 0;
        for (int q = 0; q < 64; ++q) b += red[q * 8 + F.tid];
        for (int w = 0; w < 8; ++w) { wb[w * 8 + F.tid] = b; b += (int)cntw[(size_t)(nprev + w) * 8 + F.tid]; } }
    __syncthreads();
    unsigned* info_all = (unsigned*)(wsp(F) + WS_COMB);
    const int gws = F.bid * NWAVES + F.wave, NGWS = F.G * NWAVES, rq = MT / NGWS, rrem = MT % NGWS;
    const int gw = gws * rq + (gws < rrem ? gws : rrem), rend = gw + rq + (gws < rrem ? 1 : 0);
    for (int r = gw; r < rend; ++r) { if (F.lane < 2) { unsigned* info = info_all + (size_t)r * 8; const int ee = (int)info[F.lane]; const unsigned pos = info[4 + F.lane] + (unsigned)wb[F.wave * 8 + ee]; info[4 + F.lane] = pos;
        ((unsigned*)(wsp(F) + WS_TOKE))[(size_t)ee * MT + pos] = (unsigned)r; } }
    __syncthreads();
}
__device__ __forceinline__ void phase_gather(Frame& F, int l) {
    LAS int* poff = (LAS int*)(F.lds + LDS_TAB + 64);
    moe_offsets(F, l, poff);
    const int gw = F.bid * NWAVES + F.wave, NGW = F.G * NWAVES;
    unsigned* info_all = (unsigned*)(wsp(F) + WS_COMB);
    for (int it = gw; it < MT * 2; it += NGW) {
        const int tok = it >> 1, k = it & 1; unsigned* info = info_all + (size_t)tok * 8;
        const int e = (int)info[k], pos = (int)info[4 + k]; const int grow = 256 * poff[e] + pos;
        if (F.lane == 0) info[6 + k] = (unsigned)grow;
        const v4u* s = (const v4u*)(((const bf16*)(wsp(F) + WS_H)) + (size_t)tok * 1024); v4u* d = (v4u*)(((bf16*)(wsp(F) + WS_XG)) + (size_t)grow * 1024);
        d[F.lane] = s[F.lane]; d[64 + F.lane] = s[64 + F.lane];
    }
}

__device__ __forceinline__ void filter_tile(Frame& F, int l, int L, int p0, bf16* dst  , bool stage) {
    LAS float* emb = (LAS float*)F.lds;
    LAS float* h1 = emb + 32 * 33;
    LAS float* h2 = h1 + 32 * 65;
    LAS float* w1s = h2 + 32 * 65;
    LAS float* w2s = w1s + 33 * 64;
    const float* w1 = inp(F, I_FW1) + l * 33 * 64; const float* b1 = inp(F, I_FB1) + l * 64; const float* f1 = inp(F, I_FF1) + l * 64;
    const float* w2 = inp(F, I_FW2) + l * 64 * 64; const float* b2 = inp(F, I_FB2) + l * 64; const float* f2 = inp(F, I_FF2) + l * 64;
    const float* w3 = inp(F, I_FW3) + (size_t)l * 64 * 1024;
    float awA[32], awB[32];
#define FILT_LOADW(AW, blk_) { unsigned vo_ = (unsigned)((F.lane >> 5) * 8192 + (blk_) * 32 + (F.lane & 31)); asm volatile("" : "+v"(vo_)); _Pragma("unroll") for (int s = 0; s < 32; ++s) AW[s] = (w3 + (size_t)(16 * (s >> 3) + (s & 7)) * 1024)[vo_]; }
    FILT_LOADW(awA, F.wave) __builtin_amdgcn_sched_barrier(0);
    if (stage) {
        const f32x4 sa = *(const f32x4*)(w1 + 4 * F.tid), sb = *(const f32x4*)(w2 + 4 * F.tid), sc = *(const f32x4*)(w2 + 4 * (F.tid + NTHREADS));
        f32x4 sd = sa; if (F.tid < 16) sd = *(const f32x4*)(w1 + 4 * (F.tid + NTHREADS));
        *(LAS f32x4*)(w1s + 4 * F.tid) = sa; *(LAS f32x4*)(w2s + 4 * F.tid) = sb; *(LAS f32x4*)(w2s + 4 * (F.tid + NTHREADS)) = sc;
        if (F.tid < 16) *(LAS f32x4*)(w1s + 4 * (F.tid + NTHREADS)) = sd;
    }
    for (int idx = F.tid; idx < 32 * 33; idx += NTHREADS) {
        const int pos = idx / 33, f = idx % 33, i = p0 + pos;
        float val;
        if (f == 0) val = (float)i / (float)(L - 1);
        else { const int j = (f - 1) & 15; const float fb = 1e-4f + (float)j * ((15.0f - 1e-4f) / 15.0f); const float rev = fb * (float)i / (float)L;
               val = (f <= 16) ? cos_rev(rev) : -sin_rev(rev); }
        emb[pos * 33 + f] = val;
    }
    __syncthreads();
    { const int pos = F.tid >> 4, u0 = (F.tid & 15) * 4;
      f32x4 a = *(const f32x4*)(b1 + u0);
#pragma unroll 11
      for (int f = 0; f < 33; ++f) a += emb[pos * 33 + f] * *(LAS f32x4*)(w1s + f * 64 + u0);
      const f32x4 fr = *(const f32x4*)(f1 + u0);
#pragma unroll
      for (int e = 0; e < 4; ++e) h1[pos * 65 + u0 + e] = sin_rev(fr[e] * a[e] * INV_2PI);
    }
    __syncthreads();
    { const int pos = F.tid >> 4, u0 = (F.tid & 15) * 4;
      f32x4 a = *(const f32x4*)(b2 + u0);
#pragma unroll 16
      for (int f = 0; f < 64; ++f) a += h1[pos * 65 + f] * *(LAS f32x4*)(w2s + f * 64 + u0);
      const f32x4 fr = *(const f32x4*)(f2 + u0);
#pragma unroll
      for (int e = 0; e < 4; ++e) h2[pos * 65 + u0 + e] = sin_rev(fr[e] * a[e] * INV_2PI);
    }
    __syncthreads();
    { const int r = F.lane & 31, h = F.lane >> 5;
      typedef float f32x16_t __attribute__((ext_vector_type(16))); typedef short bf16x8_t __attribute__((ext_vector_type(8)));
      const int i = p0 + r; const float t = (float)i / (float)(L - 1);
#define FILT_SPLIT(X, HI, LO) { v4u hi_, lo_; \
        _Pragma("unroll") for (int p = 0; p < 4; ++p) { const float x0 = (X)[2 * p], x1 = (X)[2 * p + 1]; const unsigned hw = pg8::cvt_pk_bf16(x0, x1); hi_[p] = hw; lo_[p] = pg8::cvt_pk_bf16(x0 - bflo(hw), x1 - bfhi(hw)); } \
        HI = __builtin_bit_cast(bf16x8_t, hi_); LO = __builtin_bit_cast(bf16x8_t, lo_); }
      bf16x8_t bh[4], bl[4];
#pragma unroll
      for (int kk = 0; kk < 4; ++kk) { float hv[8];
#pragma unroll
          for (int e = 0; e < 8; ++e) hv[e] = h2[r * 65 + 16 * kk + 8 * h + e];
          FILT_SPLIT(hv, bh[kk], bl[kk]) }
#define FILT_BLOCK(AW, blk_) { int c0 = (blk_) * 32; asm volatile("" : "+v"(c0)); f32x16_t acc;        \
        _Pragma("unroll") for (int q = 0; q < 16; ++q) acc[q] = 0.f; \
        _Pragma("unroll") for (int kk = 0; kk < 4; ++kk) { bf16x8_t ah_, al_; FILT_SPLIT((AW + 8 * kk), ah_, al_) \
            acc = __builtin_amdgcn_mfma_f32_32x32x16_bf16(al_, bh[kk], acc, 0, 0, 0); acc = __builtin_amdgcn_mfma_f32_32x32x16_bf16(ah_, bl[kk], acc, 0, 0, 0); acc = __builtin_amdgcn_mfma_f32_32x32x16_bf16(ah_, bh[kk], acc, 0, 0, 0); } \
          \
        _Pragma("unroll") for (int qp = 0; qp < 8; ++qp) { float vv[2]; int colv[2]; \
            _Pragma("unroll") for (int u = 0; u < 2; ++u) { const int q = 2 * qp + u; const int col = c0 + (q & 3) + 8 * (q >> 2) + 4 * h; const int ch = col & 255; colv[u] = col; \
                const float delta = 3.0701134573253946f + 12.280453829301578f * ((float)ch * (1.0f / 255.0f)); vv[u] = acc[q] * __expf(-t * delta); } \
            const bool odd_ = (F.lane & 1) != 0; const float snd_ = odd_ ? vv[0] : vv[1]; \
            const float rcv_ = __builtin_bit_cast(float, __builtin_amdgcn_update_dpp(0, __builtin_bit_cast(int, snd_), 0xB1, 0xf, 0xf, false)); \
            const unsigned pk_ = odd_ ? pg8::cvt_pk_bf16(rcv_, vv[1]) : pg8::cvt_pk_bf16(vv[0], rcv_); \
            *(unsigned*)(dst + (size_t)(odd_ ? colv[1] : colv[0]) * L + (i & ~1)) = pk_; } }
#pragma unroll 1
      for (int jj = 0; jj < 2; ++jj) {
          FILT_LOADW(awB, F.wave + 8 * (2 * jj + 1)) __builtin_amdgcn_sched_barrier(0); FILT_BLOCK(awA, F.wave + 16 * jj) __builtin_amdgcn_sched_barrier(0);
          FILT_LOADW(awA, F.wave + 8 * ((2 * jj + 2) & 3)) __builtin_amdgcn_sched_barrier(0); FILT_BLOCK(awB, F.wave + 8 * (2 * jj + 1)) __builtin_amdgcn_sched_barrier(0);
      }
#undef FILT_BLOCK
#undef FILT_LOADW
#undef FILT_SPLIT
    }
    __syncthreads();
}

__device__ __forceinline__ void phase_qkprep(Frame& F, int l) {
    const int gw = F.bid * NWAVES + F.wave, NGW = F.G * NWAVES;
    const int lane = F.lane; const int a = lane >> 5, half = (lane >> 4) & 1, f = lane & 15;
    const float inv = exp2f(-(float)f * (13.287712379549449f / 16.0f)) * INV_2PI;
    const float gq = inp(F, I_QG)[l * 64 + lane], gk = inp(F, I_KG)[l * 64 + lane];
    for (int r = gw; r < MT; r += NGW) {
        const bool isctx = r >= ML; const int t = r & 8191; const int pos = a == 0 ? (t >> 6) : (t & 63);
        float cs = 1.f, sn = 0.f;
        if (!isctx) { const float rev = (float)pos * inv; cs = cos_rev(rev); sn = sin_rev(rev); }
        const bf16* pr = ((bf16*)(wsp(F) + WS_PR)) + (size_t)r * INW;
        bf16* qk = ((bf16*)(wsp(F) + WS_QK)) + (size_t)r * 640;
#pragma unroll
        for (int h = 0; h < 10; ++h) {
            const float v = bf2f(pr[h * 64 + lane]);
            const float ss = wave_sum(v * v, lane);
            const float y = v * (1.0f / sqrtf(ss * (1.0f / 64.0f) + EPS)) * (h < 8 ? gq : gk);
            const float p = shx(y, lane, 16);
            const float o = half == 0 ? y * cs - p * sn : y * cs + p * sn;
            if (h < 8) qk[h * 64 + lane] = (bf16)f2bf(o * 0.18033688011112042f);
            else ((bf16*)(wsp(F) + WS_KT))[(size_t)((((h - 8) * NKB + (r >> 5)) * 4 + (lane >> 4)) * 512 + ((lane >> 3) & 1) * 256 + (r & 31) * 8 + (lane & 7))] = (bf16)f2bf(o);
        }
    }
}

__device__ __forceinline__ float block_sum(Frame& F, float v, LAS float* red) {
    v = wave_sum(v, F.lane);
    __syncthreads();
    if (F.lane == 0) red[F.wave] = v;
    __syncthreads();
    float t = 0.f;
#pragma unroll
    for (int w = 0; w < NWAVES; ++w) t += red[w];
    return t;
}

template <int L>
__device__ __forceinline__ float hy_uc(const bf16* UT, int rowbase, int b, int t, int ch, const float* cw, const float* cb) {
    float a = cb[ch];
    const bf16* up = UT + (size_t)ch * MT + rowbase + b * L;
#pragma unroll
    for (int j = 0; j < 3; ++j) { const int tt = t + j - 1; const bool ok = tt >= 0 && tt < L; const float x = bf2f(up[ok ? tt : t]); a += ok ? x * cw[j * 768 + ch] : 0.f; }
    return a;
}

template <int L>
__device__ __forceinline__ void hyena_item_naive(Frame& F, int l, int c, int rowbase, const float* taps) {
    constexpr int NT = (L + NTHREADS - 1) / NTHREADS;
    LAS float* kt = (LAS float*)F.lds;
    LAS f32x2* z = (LAS f32x2*)(F.lds + 2 * L * 4);
    LAS float* red = (LAS float*)(F.lds + 2 * L * 4 + L * 8);
    const float* cw = inp(F, I_HCW) + l * 3 * 768; const float* cb = inp(F, I_HCB) + l * 768; const float* hb = inp(F, I_HBIAS) + l * 512;
    for (int t = F.tid; t < L; t += NTHREADS) { f32x2 v; v.x = hy_uc<L>(((bf16*)(wsp(F) + WS_UT)), rowbase, 0, t, 512 + c, cw, cb); v.y = hy_uc<L>(((bf16*)(wsp(F) + WS_UT)), rowbase, 1, t, 512 + c, cw, cb); z[t] = v; }
    for (int o = 0; o < 2; ++o) {
        const float* fwd = taps + (size_t)(o * 256 + c) * L; const float* bwd = taps + (size_t)(512 + o * 256 + c) * L;
        float part = 0.f;
        for (int d = F.tid; d < L; d += NTHREADS) { const float kf = fwd[d]; kt[L + d] = kf; part += fabsf(kf);
            if (d >= 1) { const float kb = bwd[d]; kt[L - d] = kb; part += fabsf(kb); } else kt[0] = 0.f; }
        const float tot = block_sum(F, part, red);
        const float inv = 1.0f / tot;
        __syncthreads();
        float* tmp = (float*)(wsp(F) + WS_CTMP) + (size_t)c * 2 * L;
#pragma unroll 1
        for (int t = F.tid; t < L; t += NTHREADS) {
            float a0 = 0.f, a1 = 0.f;
#pragma unroll 4
            for (int s = 0; s < L; ++s) { const f32x2 zz = z[s]; const float kv = kt[L + t - s]; a0 += kv * zz.x; a1 += kv * zz.y; }
            tmp[t] = a0; tmp[L + t] = a1;
        }
        __syncthreads();
        const float bo = hb[o * 256 + c];
#pragma unroll 1
        for (int t = F.tid; t < L; t += NTHREADS) {
            const float g0 = hy_uc<L>(((bf16*)(wsp(F) + WS_UT)), rowbase, 0, t, o * 256 + c, cw, cb), g1 = hy_uc<L>(((bf16*)(wsp(F) + WS_UT)), rowbase, 1, t, o * 256 + c, cw, cb);
            const f32x2 zo = z[t]; f32x2 zn; zn.x = g0 * (tmp[t] * inv + bo * zo.x); zn.y = g1 * (tmp[L + t] * inv + bo * zo.y); z[t] = zn;
        }
        __syncthreads();
    }
    for (int t = F.tid; t < L; t += NTHREADS) { const f32x2 v = z[t];
        ((bf16*)(wsp(F) + WS_HYT))[(size_t)c * MT + rowbase + t] = (bf16)f2bf(v.x); ((bf16*)(wsp(F) + WS_HYT))[(size_t)c * MT + rowbase + L + t] = (bf16)f2bf(v.y); }
    __syncthreads();
}

template <int L>
__device__ __forceinline__ void fnet_item_naive(Frame& F, int b, int g, int m, int rowbase) {
    LAS f32x2* AB = (LAS f32x2*)F.lds;
    LAS f32x2* tab = (LAS f32x2*)(F.lds + L * 8);
    LAS f32x2* cs64 = (LAS f32x2*)(F.lds + 2 * L * 8);
    for (int i = F.tid; i < L; i += NTHREADS) { f32x2 v; const float rev = (float)i / (float)L; v.x = cos_rev(rev); v.y = sin_rev(rev); tab[i] = v; }
    if (F.tid < 64) { f32x2 v; const float rev = (float)F.tid / 64.0f; v.x = cos_rev(rev); v.y = sin_rev(rev); cs64[F.tid] = v; }
    __syncthreads();
    for (int n = F.tid; n < L; n += NTHREADS) {
        const bf16* ut = ((const bf16*)(wsp(F) + WS_UT)) + (size_t)(768 + g * 64) * MT + rowbase + b * L + n;
        const int mm = m <= 32 ? m : 64 - m;
        f32x2 v; v.x = bf2f(ut[(size_t)mm * MT]);
        v.y = (m == 0 || m == 32) ? 0.f : (m < 32 ? bf2f(ut[(size_t)(32 + m) * MT]) : -bf2f(ut[(size_t)(32 + mm) * MT]));
        AB[n] = v;
    }
    __syncthreads();
    const float scale = 1.0f / sqrtf((float)L * 64.0f);
    for (int k = F.tid; k < L; k += NTHREADS) {
        float acc = 0.f; int idx = 0;
        for (int n = 0; n < L; ++n) { const f32x2 ab = AB[n]; const f32x2 cs = tab[idx]; acc += ab.x * cs.x - ab.y * cs.y; idx = (idx + k) & (L - 1); }
        ((bf16*)(wsp(F) + WS_FNT))[(size_t)(g * 64 + m) * MT + rowbase + b * L + k] = (bf16)f2bf(acc * scale);
    }
    __syncthreads();
}

#ifdef FFT_HOST
#define FFT_LDS
#define FFT_HD
static inline float fft_cos_rev(float r) { return (float)cos(6.283185307179586 * (double)r); }
static inline float fft_sin_rev(float r) { return (float)sin(6.283185307179586 * (double)r); }
#else
#define FFT_LDS LAS
#define FFT_HD __device__ __forceinline__
__device__ __forceinline__ float fft_cos_rev(float r) { return __builtin_amdgcn_cosf(r); }
__device__ __forceinline__ float fft_sin_rev(float r) { return __builtin_amdgcn_sinf(r); }
#endif
FFT_HD int fft_phys(int i) { return i + ((i >> 5) << 1); }
FFT_HD f32x2 fft_cmul(f32x2 a, f32x2 b) { const f32x2 ax = {a.x, a.x}, ay = {a.y, a.y}, bs = {-b.y, b.x}; return ax * b + ay * bs; }
template <int R> FFT_HD constexpr int fft_brev(int p) { int r = 0; for (int b = 1; b < R; b <<= 1) { r = (r << 1) | ((p & b) ? 1 : 0); } return r; }
template <int R, bool INV> FFT_HD void fft_regs(f32x2 (&a)[R]) {
    constexpr float C32[32] = {1.0f, 0.98078528040323043f, 0.92387953251128674f, 0.83146961230254524f, 0.70710678118654757f, 0.55557023301960229f, 0.38268343236508984f, 0.19509032201612833f, 0.0f, -0.19509032201612819f, -0.38268343236508973f, -0.55557023301960196f, -0.70710678118654746f, -0.83146961230254535f, -0.92387953251128674f, -0.98078528040323043f, -1.0f, -0.98078528040323043f, -0.92387953251128685f, -0.83146961230254546f, -0.70710678118654768f, -0.55557023301960218f, -0.38268343236509034f, -0.19509032201612866f, 0.0f, 0.1950903220161283f, 0.38268343236509f, 0.55557023301960184f, 0.70710678118654735f, 0.83146961230254524f, 0.92387953251128652f, 0.98078528040323032f};
    constexpr float S32[32] = {0.0f, 0.19509032201612825f, 0.38268343236508978f, 0.55557023301960218f, 0.70710678118654746f, 0.83146961230254524f, 0.92387953251128674f, 0.98078528040323043f, 1.0f, 0.98078528040323043f, 0.92387953251128674f, 0.83146961230254546f, 0.70710678118654757f, 0.55557023301960218f, 0.38268343236508989f, 0.19509032201612861f, 0.0f, -0.19509032201612836f, -0.38268343236508967f, -0.55557023301960196f, -0.70710678118654746f, -0.83146961230254524f, -0.92387953251128652f, -0.98078528040323032f, -1.0f, -0.98078528040323043f, -0.92387953251128663f, -0.83146961230254546f, -0.70710678118654768f, -0.55557023301960218f, -0.38268343236509039f, -0.19509032201612872f};
#pragma unroll
    for (int s = R / 2; s >= 1; s >>= 1) {
#pragma unroll
        for (int i = 0; i < R; ++i) {
            if ((i & s) == 0) {
                const int k = i & (s - 1);
                const f32x2 u = a[i], v = a[i + s];
                a[i] = u + v;
                const f32x2 d = u - v;
                if (k == 0) a[i + s] = d;
                else if (2 * k == s) { f32x2 t; if (INV) { t.x = -d.y; t.y = d.x; } else { t.x = d.y; t.y = -d.x; } a[i + s] = t; }
                else { const int idx = k * (32 / (2 * s)); f32x2 w; w.x = C32[idx]; w.y = INV ? S32[idx] : -S32[idx]; a[i + s] = fft_cmul(d, w); }
            }
        }
    }
}
template <int N, int NCUR, int R, bool INV, int NT>
FFT_HD void fft_pass(FFT_LDS f32x2* buf, int tid) {
    constexpr int M = NCUR / R;
    if constexpr (M == 1) {
        constexpr int U = (R >= 16) ? 2 : 4; static_assert((N / R) % (NT * U) == 0, "trip count");
#pragma unroll 1
        for (int i0 = tid; i0 < N / R; i0 += NT * U) {
            f32x2 a[U][R]; int pb[U];
#pragma unroll
            for (int u = 0; u < U; ++u) { pb[u] = fft_phys((i0 + u * NT) * R);
#pragma unroll
                for (int q = 0; q < R; ++q) a[u][q] = buf[pb[u] + q]; }
#pragma unroll
            for (int u = 0; u < U; ++u) fft_regs<R, INV>(a[u]);
#pragma unroll
            for (int u = 0; u < U; ++u)
#pragma unroll
                for (int p = 0; p < R; ++p) buf[pb[u] + p] = a[u][fft_brev<R>(p)];
        }
        return;
    }
    constexpr int U = ((N / R) % (NT * 2) == 0) ? 2 : 1;
#pragma unroll 1
    for (int i0 = tid; i0 < N / R; i0 += NT * U) {
        f32x2 a[U][R]; int pb[U]; f32x2 w1[U];
#pragma unroll
        for (int u = 0; u < U; ++u) { const int i = i0 + u * NT; const int blk = i / M, j = i - blk * M, base = blk * NCUR + j;
            pb[u] = fft_phys(base);
#pragma unroll
            for (int q = 0; q < R; ++q) a[u][q] = buf[pb[u] + q * M + 2 * ((q * M) >> 5)];
            const float rev = (float)j * (1.0f / (float)NCUR); w1[u].x = fft_cos_rev(rev); w1[u].y = INV ? fft_sin_rev(rev) : -fft_sin_rev(rev); }
#pragma unroll
        for (int u = 0; u < U; ++u) {
            f32x2 w[R]; w[1] = w1[u];
#pragma unroll
            for (int p = 2; p < R; ++p) { const int hb = (p >= 16) ? 16 : ((p >= 8) ? 8 : ((p >= 4) ? 4 : 2)); w[p] = (p == hb) ? fft_cmul(w[hb / 2], w[hb / 2]) : fft_cmul(w[hb], w[p - hb]); }
            if (INV) {
#pragma unroll
                for (int p = 1; p < R; ++p) a[u][p] = fft_cmul(a[u][p], w[p]);
                fft_regs<R, INV>(a[u]);
            } else {
                fft_regs<R, INV>(a[u]);
#pragma unroll
                for (int p = 1; p < R; ++p) a[u][fft_brev<R>(p)] = fft_cmul(a[u][fft_brev<R>(p)], w[p]);
            }
#pragma unroll
            for (int p = 0; p < R; ++p) buf[pb[u] + p * M + 2 * ((p * M) >> 5)] = a[u][fft_brev<R>(p)];
        }
    }
}
template <int N, int NT>
FFT_HD void fft_mid16(FFT_LDS f32x2* buf, int tid, const unsigned* ks) {
    constexpr int R = 16, U = 2; static_assert((N / R) % (NT * U) == 0, "trip count");
#pragma unroll 1
    for (int i0 = tid; i0 < N / R; i0 += NT * U) {
        f32x2 a[U][R]; v4u kw[U][R / 4]; int pb[U];
#pragma unroll
        for (int u = 0; u < U; ++u) { const int base = (i0 + u * NT) * R; pb[u] = fft_phys(base);
#pragma unroll
            for (int q = 0; q < R / 4; ++q) kw[u][q] = *(const v4u*)(ks + base + 4 * q);
#pragma unroll
            for (int q = 0; q < R; ++q) a[u][q] = buf[pb[u] + q]; }
#pragma unroll
        for (int u = 0; u < U; ++u) {
            fft_regs<R, false>(a[u]);
            f32x2 b[R];
#pragma unroll
            for (int p = 0; p < R; ++p) { const unsigned kd = kw[u][p >> 2][p & 3]; f32x2 k; k.x = __builtin_bit_cast(float, kd << 16); k.y = __builtin_bit_cast(float, kd & 0xffff0000u); b[p] = fft_cmul(a[u][fft_brev<R>(p)], k); }
            fft_regs<R, true>(b);
#pragma unroll
            for (int p = 0; p < R; ++p) buf[pb[u] + p] = b[fft_brev<R>(p)];
        }
    }
}
#ifdef FFT_HOST
#define FFT_SYNC()
#else
#define FFT_SYNC() __syncthreads()
#endif

template <bool INV> __device__ __forceinline__ void fft16k(LAS f32x2* buf, int tid) {
    constexpr int N = 16384;
    if (!INV) { fft_pass<N, 16384, 32, false, NTHREADS>(buf, tid); __syncthreads(); fft_pass<N, 512, 32, false, NTHREADS>(buf, tid); __syncthreads();
                fft_pass<N, 16, 16, false, NTHREADS>(buf, tid); __syncthreads(); }
    else { fft_pass<N, 16, 16, true, NTHREADS>(buf, tid); __syncthreads(); fft_pass<N, 512, 32, true, NTHREADS>(buf, tid); __syncthreads();
           fft_pass<N, 16384, 32, true, NTHREADS>(buf, tid); __syncthreads(); }
}
__device__ __forceinline__ void fft8k_fwd(LAS f32x2* buf, int tid) {
    constexpr int N = 8192;
    fft_pass<N, 8192, 16, false, NTHREADS>(buf, tid); __syncthreads(); fft_pass<N, 512, 16, false, NTHREADS>(buf, tid); __syncthreads();
    fft_pass<N, 32, 16, false, NTHREADS>(buf, tid); __syncthreads(); fft_pass<N, 2, 2, false, NTHREADS>(buf, tid); __syncthreads();
}

__device__ __forceinline__ void hy_uc8(const bf16* UT, int b, int t0, int ch, const float* cw, const float* cb, float (&o)[8]) {
    const bf16* up = UT + (size_t)ch * MT + b * SEQ + t0;
    const v4u w = *(const v4u*)up;
    const bool hl = t0 > 0, hr = t0 + 8 < SEQ;
    const float hm = bf2f(up[hl ? -1 : 0]), hp = bf2f(up[hr ? 8 : 7]);
    float x[10]; x[0] = hl ? hm : 0.f; x[9] = hr ? hp : 0.f;
    x[1] = bflo(w.x); x[2] = bfhi(w.x); x[3] = bflo(w.y); x[4] = bfhi(w.y); x[5] = bflo(w.z); x[6] = bfhi(w.z); x[7] = bflo(w.w); x[8] = bfhi(w.w);
    const float w0 = cw[ch], w1 = cw[768 + ch], w2 = cw[1536 + ch], bias = cb[ch];
#pragma unroll
    for (int e = 0; e < 8; ++e) o[e] = ((bias + x[e] * w0) + x[e + 1] * w1) + x[e + 2] * w2;
}
__device__ __forceinline__ void hyena_item_fft(Frame& F, int l, int c) {
    constexpr int L = SEQ, N = 2 * SEQ;
    LAS f32x2* buf = (LAS f32x2*)F.lds;
    LAS float* red = (LAS float*)(F.lds + 139264);
    const bf16* UT = (const bf16*)(wsp(F) + WS_UT);
    const float* cw = inp(F, I_HCW) + l * 3 * 768; const float* cb = inp(F, I_HCB) + l * 768; const float* hb = inp(F, I_HBIAS) + l * 512;
    unsigned* kspec = (unsigned*)(wsp(F) + WS_KS) + (size_t)F.bid * 2 * N;
    const bf16* HFp = (const bf16*)(wsp(F) + WS_HF);
    {
        const bf16* f0 = HFp + (size_t)c * L; const bf16* b0 = HFp + (size_t)(512 + c) * L; const bf16* f1 = HFp + (size_t)(256 + c) * L; const bf16* b1 = HFp + (size_t)(768 + c) * L;
        float p0 = 0.f, p1 = 0.f;
#pragma unroll
        for (int k = 0; k < 2; ++k) { const int i0 = 8 * (F.tid + NTHREADS * k);
            const v4u a4 = *(const v4u*)(f0 + i0), b4 = *(const v4u*)(f1 + i0), c4 = *(const v4u*)(b0 + i0), d4 = *(const v4u*)(b1 + i0);
            float a[8], b[8], cbk[8], d[8];
#pragma unroll
            for (int e = 0; e < 4; ++e) { a[2 * e] = bflo(a4[e]); a[2 * e + 1] = bfhi(a4[e]); b[2 * e] = bflo(b4[e]); b[2 * e + 1] = bfhi(b4[e]); cbk[2 * e] = bflo(c4[e]); cbk[2 * e + 1] = bfhi(c4[e]); d[2 * e] = bflo(d4[e]); d[2 * e + 1] = bfhi(d4[e]); }
            LAS f32x4* bp = (LAS f32x4*)(buf + fft_phys(i0));
#pragma unroll
            for (int e2 = 0; e2 < 4; ++e2) { f32x4 w; w[0] = a[2 * e2]; w[1] = b[2 * e2]; w[2] = a[2 * e2 + 1]; w[3] = b[2 * e2 + 1]; bp[e2] = w; }
#pragma unroll
            for (int e = 0; e < 8; ++e) { p0 += fabsf(a[e]); p1 += fabsf(b[e]); }
            if (i0 > 0) { p0 += fabsf(cbk[0]); p1 += fabsf(d[0]); f32x2 v; v.x = cbk[0]; v.y = d[0]; buf[fft_phys(N - i0)] = v; }
            else { float zf = 0.f; asm volatile("" : "+v"(zf)); f32x2 v; v.x = zf; v.y = zf; buf[fft_phys(L)] = v; }
#pragma unroll
            for (int e = 1; e < 8; ++e) { p0 += fabsf(cbk[e]); p1 += fabsf(d[e]); f32x2 v; v.x = cbk[e]; v.y = d[e]; buf[fft_phys(N - i0 - e)] = v; } }
        const float tot0 = block_sum(F, p0, red); const float tot1 = block_sum(F, p1, red);
        __syncthreads();
        fft16k<false>(buf, F.tid);
        const float s0 = 0.5f / tot0, s1 = 0.5f / tot1;
        typedef _Float16 f16x2 __attribute__((ext_vector_type(2)));
        int tp = F.tid; asm volatile("" : "+v"(tp));
#pragma unroll 2
        for (int k = 0; k < 8; ++k) { const int pos0 = 4 * (tp + NTHREADS * k);
            const LAS f32x4* ap = (const LAS f32x4*)(buf + fft_phys(pos0)); const f32x4 a01 = ap[0], a23 = ap[1];
            f32x2 o0[4], o1[4];
#pragma unroll
            for (int e = 0; e < 4; ++e) { const int pos = pos0 + e;
                const int f = (pos >> 9) + 32 * ((pos >> 4) & 31) + 1024 * (pos & 15), nf = (N - f) & (N - 1);
                const int pos2 = (nf & 31) * 512 + ((nf >> 5) & 31) * 16 + (nf >> 10);
                f32x2 a; a.x = (e < 2 ? a01 : a23)[2 * (e & 1)]; a.y = (e < 2 ? a01 : a23)[2 * (e & 1) + 1];
                const f32x2 b = buf[fft_phys(pos2)];
                f32x2 k0, k1; k0.x = ((a.x + b.x) * s0); k0.y = ((a.y - b.y) * s0); k1.x = ((a.y + b.y) * s1); k1.y = ((b.x - a.x) * s1);
                o0[e] = k0; o1[e] = k1; }
            { v4u w; w.x = pg8::cvt_pk_bf16(o0[0].x, o0[0].y); w.y = pg8::cvt_pk_bf16(o0[1].x, o0[1].y); w.z = pg8::cvt_pk_bf16(o0[2].x, o0[2].y); w.w = pg8::cvt_pk_bf16(o0[3].x, o0[3].y); *(v4u*)(kspec + pos0) = w;
              w.x = pg8::cvt_pk_bf16(o1[0].x, o1[0].y); w.y = pg8::cvt_pk_bf16(o1[1].x, o1[1].y); w.z = pg8::cvt_pk_bf16(o1[2].x, o1[2].y); w.w = pg8::cvt_pk_bf16(o1[3].x, o1[3].y); *(v4u*)(kspec + N + pos0) = w; } }
        __syncthreads();
    }
    f32x2 zr[2][8];
    int tz = F.tid; asm volatile("" : "+v"(tz));
#pragma unroll
    for (int k = 0; k < 2; ++k) { const int t0 = 8 * (tz + NTHREADS * k);
        float zf = 0.f; asm volatile("" : "+v"(zf)); f32x4 zero4; zero4[0] = zf; zero4[1] = zf; zero4[2] = zf; zero4[3] = zf;
        float a0[8], a1[8]; hy_uc8(UT, 0, t0, 512 + c, cw, cb, a0); hy_uc8(UT, 1, t0, 512 + c, cw, cb, a1);
        LAS f32x4* bp = (LAS f32x4*)(buf + fft_phys(t0)); LAS f32x4* zp = (LAS f32x4*)(buf + fft_phys(L + t0));
#pragma unroll
        for (int e = 0; e < 8; ++e) { zr[k][e].x = a0[e]; zr[k][e].y = a1[e]; }
#pragma unroll
        for (int e2 = 0; e2 < 4; ++e2) { f32x4 w; w[0] = a0[2 * e2]; w[1] = a1[2 * e2]; w[2] = a0[2 * e2 + 1]; w[3] = a1[2 * e2 + 1]; bp[e2] = w; zp[e2] = zero4; } }
    __syncthreads();
#pragma unroll 1
    for (int o = 0; o < 2; ++o) {
        fft_pass<N, 16384, 32, false, NTHREADS>(buf, F.tid); __syncthreads(); fft_pass<N, 512, 32, false, NTHREADS>(buf, F.tid); __syncthreads();
        fft_mid16<N, NTHREADS>(buf, F.tid, kspec + o * N); __syncthreads();
        fft_pass<N, 512, 32, true, NTHREADS>(buf, F.tid); __syncthreads(); fft_pass<N, 16384, 32, true, NTHREADS>(buf, F.tid); __syncthreads();
        const float bo = hb[o * 256 + c]; const float invn = 1.0f / (float)N;
        int tg = F.tid; asm volatile("" : "+v"(tg));
#pragma unroll
        for (int k = 0; k < 2; ++k) { const int t0 = 8 * (tg + NTHREADS * k);
            float zf = 0.f; asm volatile("" : "+v"(zf)); f32x4 zero4; zero4[0] = zf; zero4[1] = zf; zero4[2] = zf; zero4[3] = zf;
            float g0[8], g1[8]; hy_uc8(UT, 0, t0, o * 256 + c, cw, cb, g0); hy_uc8(UT, 1, t0, o * 256 + c, cw, cb, g1);
            LAS f32x4* bp = (LAS f32x4*)(buf + fft_phys(t0)); LAS f32x4* zp = (LAS f32x4*)(buf + fft_phys(L + t0));
#pragma unroll
            for (int e2 = 0; e2 < 4; ++e2) { const f32x4 cv = bp[e2];
                f32x2 za, zb; za.x = g0[2 * e2] * (cv[0] * invn + bo * zr[k][2 * e2].x); za.y = g1[2 * e2] * (cv[1] * invn + bo * zr[k][2 * e2].y);
                zb.x = g0[2 * e2 + 1] * (cv[2] * invn + bo * zr[k][2 * e2 + 1].x); zb.y = g1[2 * e2 + 1] * (cv[3] * invn + bo * zr[k][2 * e2 + 1].y);
                zr[k][2 * e2] = za; zr[k][2 * e2 + 1] = zb; }
            if (o == 0) {
#pragma unroll
                for (int e2 = 0; e2 < 4; ++e2) { f32x4 w; w[0] = zr[k][2 * e2].x; w[1] = zr[k][2 * e2].y; w[2] = zr[k][2 * e2 + 1].x; w[3] = zr[k][2 * e2 + 1].y; bp[e2] = w; zp[e2] = zero4; }
            } else {
                v4u o0, o1; o0.x = pk2(zr[k][0].x, zr[k][1].x); o0.y = pk2(zr[k][2].x, zr[k][3].x); o0.z = pk2(zr[k][4].x, zr[k][5].x); o0.w = pk2(zr[k][6].x, zr[k][7].x);
                o1.x = pk2(zr[k][0].y, zr[k][1].y); o1.y = pk2(zr[k][2].y, zr[k][3].y); o1.z = pk2(zr[k][4].y, zr[k][5].y); o1.w = pk2(zr[k][6].y, zr[k][7].y);
                bf16* hy = ((bf16*)(wsp(F) + WS_HYT)) + (size_t)c * MT + t0;
                *(v4u*)hy = o0; *(v4u*)(hy + L) = o1;
            } }
        __syncthreads();
    }
}

__device__ __forceinline__ void fnet_item_fft(Frame& F, int b, int g, int m) {
    constexpr int N = SEQ;
    LAS f32x2* buf = (LAS f32x2*)F.lds;
    LAS float* re = (LAS float*)(F.lds + 69632);
    LAS float* im = re + N;
    const bf16* ut = ((const bf16*)(wsp(F) + WS_UT)) + (size_t)(768 + g * 64) * MT + b * N;
    bf16* fnt = ((bf16*)(wsp(F) + WS_FNT)) + (size_t)(g * 64) * MT + b * N;
    const float sgn = (m == 0) ? 1.0f : -1.0f;
#pragma unroll
    for (int k = 0; k < 2; ++k) { const int n0 = 8 * (F.tid + NTHREADS * k);
        const v4u a = *(const v4u*)(ut + (size_t)m * MT + n0), bb = *(const v4u*)(ut + (size_t)(32 + m) * MT + n0);
        LAS f32x4* bp = (LAS f32x4*)(buf + fft_phys(n0));
        f32x4 w; w[0] = bflo(a.x); w[1] = sgn * bflo(bb.x); w[2] = bfhi(a.x); w[3] = sgn * bfhi(bb.x); bp[0] = w;
        w[0] = bflo(a.y); w[1] = sgn * bflo(bb.y); w[2] = bfhi(a.y); w[3] = sgn * bfhi(bb.y); bp[1] = w;
        w[0] = bflo(a.z); w[1] = sgn * bflo(bb.z); w[2] = bfhi(a.z); w[3] = sgn * bfhi(bb.z); bp[2] = w;
        w[0] = bflo(a.w); w[1] = sgn * bflo(bb.w); w[2] = bfhi(a.w); w[3] = sgn * bfhi(bb.w); bp[3] = w; }
    __syncthreads();
    fft8k_fwd(buf, F.tid);
#pragma unroll 4
    for (int pos = F.tid; pos < N; pos += NTHREADS) { const int k = (pos >> 9) + 16 * ((pos >> 5) & 15) + 256 * ((pos >> 1) & 15) + 4096 * (pos & 1);
        const f32x2 v = buf[fft_phys(pos)]; re[k] = v.x; if (m == 0) im[k] = v.y; }
    __syncthreads();
    const float scale = 1.0f / sqrtf((float)N * 64.0f);
#pragma unroll
    for (int j = 0; j < 2; ++j) { const int k0 = 8 * (F.tid + NTHREADS * j);
        float ra[8], rb[8];
        { const f32x4 x0 = *(const LAS f32x4*)(re + k0), x1 = *(const LAS f32x4*)(re + k0 + 4);
#pragma unroll
          for (int e = 0; e < 4; ++e) { ra[e] = x0[e]; ra[4 + e] = x1[e]; }
#pragma unroll
          for (int e = 0; e < 8; ++e) rb[e] = re[(N - k0 - e) & (N - 1)]; }
        if (m == 0) {
            float ia[8], ib[8];
            const f32x4 y0 = *(const LAS f32x4*)(im + k0), y1 = *(const LAS f32x4*)(im + k0 + 4);
#pragma unroll
            for (int e = 0; e < 4; ++e) { ia[e] = y0[e]; ia[4 + e] = y1[e]; }
#pragma unroll
            for (int e = 0; e < 8; ++e) ib[e] = im[(N - k0 - e) & (N - 1)];
            const float hs = 0.5f * scale;
            v4u o0, o1;
            o0.x = pk2((ra[0] + rb[0]) * hs, (ra[1] + rb[1]) * hs); o0.y = pk2((ra[2] + rb[2]) * hs, (ra[3] + rb[3]) * hs); o0.z = pk2((ra[4] + rb[4]) * hs, (ra[5] + rb[5]) * hs); o0.w = pk2((ra[6] + rb[6]) * hs, (ra[7] + rb[7]) * hs);
            o1.x = pk2((ia[0] + ib[0]) * hs, (ia[1] + ib[1]) * hs); o1.y = pk2((ia[2] + ib[2]) * hs, (ia[3] + ib[3]) * hs); o1.z = pk2((ia[4] + ib[4]) * hs, (ia[5] + ib[5]) * hs); o1.w = pk2((ia[6] + ib[6]) * hs, (ia[7] + ib[7]) * hs);
            *(v4u*)(fnt + k0) = o0; *(v4u*)(fnt + (size_t)32 * MT + k0) = o1;
        } else {
            v4u o0, o1;
            o0.x = pk2(ra[0] * scale, ra[1] * scale); o0.y = pk2(ra[2] * scale, ra[3] * scale); o0.z = pk2(ra[4] * scale, ra[5] * scale); o0.w = pk2(ra[6] * scale, ra[7] * scale);
            o1.x = pk2(rb[0] * scale, rb[1] * scale); o1.y = pk2(rb[2] * scale, rb[3] * scale); o1.z = pk2(rb[4] * scale, rb[5] * scale); o1.w = pk2(rb[6] * scale, rb[7] * scale);
            *(v4u*)(fnt + (size_t)m * MT + k0) = o0; *(v4u*)(fnt + (size_t)(64 - m) * MT + k0) = o1;
        } }
    __syncthreads();
}

typedef short bf16x8 __attribute__((ext_vector_type(8)));
typedef float f32x16 __attribute__((ext_vector_type(16)));
__device__ __forceinline__ unsigned cvtpk(float lo, float hi) { return pg8::cvt_pk_bf16(lo, hi); }
struct AttnChunk { bf16x8 k[4]; bf16x8 v[2][2]; };
__device__ __forceinline__ void attn_load_chunk(AttnChunk& C, const bf16* KT, const bf16* VT, int keyrow0, int kvh, int lane) {
    const int kb = keyrow0 >> 5;
    const bf16* kp = KT + (size_t)((kvh * NKB + kb) * 4) * 512 + lane * 8;
#pragma unroll
    for (int s = 0; s < 4; ++s) C.k[s] = *(const bf16x8*)(kp + s * 512);
    const bf16* vp = VT + (size_t)((kvh * NKB + kb) * 4) * 512 + lane * 8;
#pragma unroll
    for (int dd = 0; dd < 2; ++dd)
#pragma unroll
        for (int s = 0; s < 2; ++s) C.v[dd][s] = *(const bf16x8*)(vp + (dd * 2 + s) * 512);
}
__device__ __forceinline__ void attn_item(Frame& F, int l, int item) {
    const int lane = F.lane, r = lane & 31, h = lane >> 5;
    const bf16* QK = (const bf16*)(wsp(F) + WS_QK); const bf16* VT = (const bf16*)(wsp(F) + WS_VT); const bf16* KT = (const bf16*)(wsp(F) + WS_KT);
    int g, kvh, b, qrow0, t0; bool isctx;
    if (item < 4096) { g = item & 3; const int qblk = (item >> 2) & 255; kvh = (item >> 10) & 1; b = item >> 11; isctx = false; t0 = qblk * 32; qrow0 = b * SEQ + t0; }
    else { const int j = item - 4096; g = j & 3; const int qb = (j >> 2) & 7; kvh = (j >> 5) & 1; b = j >> 6; isctx = true; t0 = 0; qrow0 = ML + b * CTXL + qb * 32; }
    const int head = 4 * kvh + g;
    bf16x8 qf[4];
    { const bf16* qp = QK + (size_t)(qrow0 + r) * 640 + head * 64 + 8 * h;
#pragma unroll
      for (int s = 0; s < 4; ++s) qf[s] = *(const bf16x8*)(qp + 16 * s); }
    float m = inp(F, I_SINK)[l * 8 + head] * 1.4426950408889634f;
    float lsum = (h == 0) ? 1.0f : 0.0f;
    f32x16 o0, o1;
#pragma unroll
    for (int i = 0; i < 16; ++i) { o0[i] = 0.f; o1[i] = 0.f; }
    int c_lo = 0, nl = 0;
    if (!isctx) { const int qblk = t0 >> 5; c_lo = qblk < 4 ? 4 - qblk : 0; const int c_hi = (259 - qblk) < 8 ? (259 - qblk) : 8; nl = c_hi - c_lo + 1; }
    const int n = nl + 8;
    const int lrow0 = b * SEQ + t0 - 128 + 32 * c_lo, crow0 = ML + b * CTXL - 32 * nl;
#define ATT_LOAD(BUF, i_) { const int ii_ = (i_) < n ? (i_) : n - 1; attn_load_chunk(BUF, KT, VT, ii_ < nl ? lrow0 + 32 * ii_ : crow0 + 32 * ii_, kvh, lane); }
#define ATT_COMPUTE(BUF, i_) { \
        const int cc_ = (i_) < nl ? c_lo + (i_) : 100; \
        f32x16 S; \
        _Pragma("unroll") for (int i = 0; i < 16; ++i) S[i] = 0.f; \
        _Pragma("unroll") for (int s = 0; s < 4; ++s) S = __builtin_amdgcn_mfma_f32_32x32x16_bf16(BUF.k[s], qf[s], S, 0, 0, 0); \
        if (cc_ == 0 || cc_ == 8) { \
            _Pragma("unroll") for (int i = 0; i < 16; ++i) { const int kidx = (i & 3) + 8 * (i >> 2) + 4 * h; const bool ok = (cc_ == 0) ? (kidx >= r) : (kidx <= r); if (!ok) S[i] = -INFINITY; } \
        } \
        float cm = S[0]; \
        _Pragma("unroll") for (int i = 1; i < 16; ++i) cm = fmaxf(cm, S[i]); \
        cm = fmaxf(cm, shx(cm, lane, 32)); \
          \
          \
        const bool grow_ = __builtin_amdgcn_ballot_w64(cm > m + 6.0f) != 0ull; \
        if (grow_) { asm volatile("" ::: "memory"); const float mn = fmaxf(m, cm), alpha = __builtin_amdgcn_exp2f(m - mn); m = mn; lsum *= alpha; _Pragma("unroll") for (int i = 0; i < 16; ++i) { o0[i] *= alpha; o1[i] *= alpha; } } \
        float ps = 0.f; \
        _Pragma("unroll") for (int i = 0; i < 16; ++i) { S[i] = __builtin_amdgcn_exp2f(S[i] - m); ps += S[i]; } \
        lsum += ps; \
        bf16x8 pf[2]; \
        _Pragma("unroll") for (int s = 0; s < 2; ++s) { v4u w; w.x = cvtpk(S[8 * s + 0], S[8 * s + 1]); w.y = cvtpk(S[8 * s + 2], S[8 * s + 3]); w.z = cvtpk(S[8 * s + 4], S[8 * s + 5]); w.w = cvtpk(S[8 * s + 6], S[8 * s + 7]); pf[s] = __builtin_bit_cast(bf16x8, w); } \
        _Pragma("unroll") for (int s = 0; s < 2; ++s) { \
            o0 = __builtin_amdgcn_mfma_f32_32x32x16_bf16(BUF.v[0][s], pf[s], o0, 0, 0, 0); \
            o1 = __builtin_amdgcn_mfma_f32_32x32x16_bf16(BUF.v[1][s], pf[s], o1, 0, 0, 0); \
        } }
    AttnChunk ca, cb2, cc3;
    ATT_LOAD(ca, 0) ATT_LOAD(cb2, 1)
    { int ci = 0;
      for (;;) {
        ATT_LOAD(cc3, ci + 2) ATT_COMPUTE(ca, ci) if (++ci >= n) break;
        ATT_LOAD(ca, ci + 2) ATT_COMPUTE(cb2, ci) if (++ci >= n) break;
        ATT_LOAD(cb2, ci + 2) ATT_COMPUTE(cc3, ci) if (++ci >= n) break;
      } }
#undef ATT_LOAD
#undef ATT_COMPUTE
    lsum += shx(lsum, lane, 32);
    const float inv = 1.0f / lsum;
    bf16* op = ((bf16*)(wsp(F) + WS_AM)) + (size_t)(qrow0 + r) * 1024 + head * 64 + 4 * h;
#pragma unroll
    for (int g4 = 0; g4 < 4; ++g4) {
        v2u w0; w0.x = cvtpk(o0[4 * g4 + 0] * inv, o0[4 * g4 + 1] * inv); w0.y = cvtpk(o0[4 * g4 + 2] * inv, o0[4 * g4 + 3] * inv); *(v2u*)(op + 8 * g4) = w0;
        v2u w1; w1.x = cvtpk(o1[4 * g4 + 0] * inv, o1[4 * g4 + 1] * inv); w1.y = cvtpk(o1[4 * g4 + 2] * inv, o1[4 * g4 + 3] * inv); *(v2u*)(op + 32 + 8 * g4) = w1;
    }
}

__device__ __forceinline__ void attn_item_naive(Frame& F, int l, int r, int kvh, LAS float* wq, LAS float* wp) {
    const int lane = F.lane;
    const bool isctx = r >= ML; const int b = isctx ? ((r - ML) >> 8) : (r >> 13); const int t = r & 8191;
    const int lo = (t - 128) < 0 ? 0 : (t - 128), hi = (t + 128) > (SEQ - 1) ? (SEQ - 1) : (t + 128);
    const int nloc = isctx ? 0 : (hi - lo + 1), nk = nloc + CTXL;
#pragma unroll
    for (int h = 0; h < 4; ++h) wq[h * 64 + lane] = bf2f(((bf16*)(wsp(F) + WS_QK))[(size_t)r * 640 + (4 * kvh + h) * 64 + lane]) * 0.125f;
    LDS_WAIT(); asm volatile("" ::: "memory");
    for (int j = lane; j < nk; j += 64) {
        const int krow = j < nloc ? (b * SEQ + lo + j) : (ML + b * CTXL + (j - nloc));
        const bf16* kp = ((bf16*)(wsp(F) + WS_QK)) + (size_t)krow * 640 + 512 + kvh * 64;
        float s0 = 0.f, s1 = 0.f, s2 = 0.f, s3 = 0.f;
#pragma unroll
        for (int d8 = 0; d8 < 8; ++d8) { const v4u kw = *(const v4u*)(kp + d8 * 8);
            float kf[8]; kf[0] = bflo(kw.x); kf[1] = bfhi(kw.x); kf[2] = bflo(kw.y); kf[3] = bfhi(kw.y); kf[4] = bflo(kw.z); kf[5] = bfhi(kw.z); kf[6] = bflo(kw.w); kf[7] = bfhi(kw.w);
#pragma unroll
            for (int e = 0; e < 8; ++e) { const int d = d8 * 8 + e; s0 += kf[e] * wq[d]; s1 += kf[e] * wq[64 + d]; s2 += kf[e] * wq[128 + d]; s3 += kf[e] * wq[192 + d]; } }
        f32x4 sv; sv[0] = s0; sv[1] = s1; sv[2] = s2; sv[3] = s3;
        *(LAS f32x4*)(wp + j * 4) = sv;
    }
    LDS_WAIT(); asm volatile("" ::: "memory");
    f32x4 mx = {-INFINITY, -INFINITY, -INFINITY, -INFINITY};
    for (int j = lane; j < nk; j += 64) { const f32x4 sv = *(LAS f32x4*)(wp + j * 4);
#pragma unroll
        for (int h = 0; h < 4; ++h) mx[h] = fmaxf(mx[h], sv[h]); }
    f32x4 sink, den;
#pragma unroll
    for (int h = 0; h < 4; ++h) { sink[h] = inp(F, I_SINK)[l * 8 + 4 * kvh + h]; mx[h] = fmaxf(wave_max(mx[h], lane), sink[h]); den[h] = 0.f; }
    for (int j = lane; j < nk; j += 64) { f32x4 sv = *(LAS f32x4*)(wp + j * 4);
#pragma unroll
        for (int h = 0; h < 4; ++h) { sv[h] = __expf(sv[h] - mx[h]); den[h] += sv[h]; }
        *(LAS f32x4*)(wp + j * 4) = sv; }
#pragma unroll
    for (int h = 0; h < 4; ++h) den[h] = wave_sum(den[h], lane) + __expf(sink[h] - mx[h]);
    LDS_WAIT(); asm volatile("" ::: "memory");
    f32x4 o = {0.f, 0.f, 0.f, 0.f};
    for (int j = 0; j < nk; ++j) {
        const int krow = j < nloc ? (b * SEQ + lo + j) : (ML + b * CTXL + (j - nloc));
        const float v = bf2f(((bf16*)(wsp(F) + WS_PR))[(size_t)krow * INW + K_END + kvh * 64 + lane]);
        const f32x4 p = *(LAS f32x4*)(wp + j * 4);
        o += p * v;
    }
#pragma unroll
    for (int h = 0; h < 4; ++h) ((bf16*)(wsp(F) + WS_ATT))[(size_t)r * 512 + (4 * kvh + h) * 64 + lane] = (bf16)f2bf(o[h] / den[h]);
    LDS_WAIT(); asm volatile("" ::: "memory");
}


__device__ __forceinline__ void hyena_ctx_wave(Frame& F, int l, int c, LAS float* kt  , LAS f32x2* z  ) {
    constexpr int L = CTXL; const int lane = F.lane;
    const bf16* UT = (const bf16*)(wsp(F) + WS_UT); const bf16* HFC = (const bf16*)(wsp(F) + WS_HFC);
    const float* cw = inp(F, I_HCW) + l * 3 * 768; const float* cb = inp(F, I_HCB) + l * 768; const float* hb = inp(F, I_HBIAS) + l * 512;
    float zv0[4], zv1[4], g0[2][4], g1[2][4], kf[2][4], kb[2][4];
#pragma unroll
    for (int j = 0; j < 4; ++j) { const int t = lane + 64 * j;
        zv0[j] = hy_uc<L>(UT, ML, 0, t, 512 + c, cw, cb); zv1[j] = hy_uc<L>(UT, ML, 1, t, 512 + c, cw, cb);
#pragma unroll
        for (int o = 0; o < 2; ++o) { g0[o][j] = hy_uc<L>(UT, ML, 0, t, o * 256 + c, cw, cb); g1[o][j] = hy_uc<L>(UT, ML, 1, t, o * 256 + c, cw, cb);
            kf[o][j] = bf2f(HFC[(size_t)(o * 256 + c) * L + t]); const float kbv = bf2f(HFC[(size_t)(512 + o * 256 + c) * L + t]); kb[o][j] = t >= 1 ? kbv : 0.f; } }
    const float bo0 = hb[c], bo1 = hb[256 + c];
#pragma unroll
    for (int j = 0; j < 4; ++j) { f32x2 v; v.x = zv0[j]; v.y = zv1[j]; z[lane + 64 * j] = v; }
#pragma unroll
    for (int o = 0; o < 2; ++o) {
        float part = 0.f;
#pragma unroll
        for (int j = 0; j < 4; ++j) { const int d = lane + 64 * j; kt[L + d] = kf[o][j]; part += fabsf(kf[o][j]);
            if (d >= 1) { kt[L - d] = kb[o][j]; part += fabsf(kb[o][j]); } else kt[0] = 0.f; }
        const float inv = 1.0f / wave_sum(part, lane);
        LDS_WAIT(); asm volatile("" ::: "memory");
        float r0[4] = {0.f, 0.f, 0.f, 0.f}, r1[4] = {0.f, 0.f, 0.f, 0.f};
#pragma unroll 4
        for (int s = 0; s < L; ++s) { const f32x2 zz = z[s];
#pragma unroll
            for (int j = 0; j < 4; ++j) { const float kv = kt[L + lane + 64 * j - s]; r0[j] += kv * zz.x; r1[j] += kv * zz.y; } }
        LDS_WAIT(); asm volatile("" ::: "memory");
        const float bo = o == 0 ? bo0 : bo1;
#pragma unroll
        for (int j = 0; j < 4; ++j) { const int t = lane + 64 * j;
            const f32x2 zo = z[t]; f32x2 zn; zn.x = g0[o][j] * (r0[j] * inv + bo * zo.x); zn.y = g1[o][j] * (r1[j] * inv + bo * zo.y); z[t] = zn; }
        LDS_WAIT(); asm volatile("" ::: "memory");
    }
    bf16* hyt = ((bf16*)(wsp(F) + WS_HYT)) + (size_t)c * MT + ML;
#pragma unroll
    for (int j = 0; j < 4; ++j) { const int t = lane + 64 * j; const f32x2 v = z[t]; hyt[t] = (bf16)f2bf(v.x); hyt[L + t] = (bf16)f2bf(v.y); }
    LDS_WAIT(); asm volatile("" ::: "memory");
}
__device__ __forceinline__ void fnet_ctx_wave(Frame& F, int b, int g, int m, LAS f32x2* AB  , LAS f32x2* tab  ) {
    constexpr int L = CTXL; const int lane = F.lane;
    const bf16* ut = ((const bf16*)(wsp(F) + WS_UT)) + (size_t)(768 + g * 64) * MT + ML + b * L;
    const int mm = m <= 32 ? m : 64 - m;
#pragma unroll
    for (int j = 0; j < 4; ++j) { const int n = lane + 64 * j; f32x2 t; const float rev = (float)n * (1.0f / (float)L); t.x = cos_rev(rev); t.y = sin_rev(rev); tab[n] = t;
        f32x2 v; v.x = bf2f(ut[(size_t)mm * MT + n]);
        v.y = (m == 0 || m == 32) ? 0.f : (m < 32 ? bf2f(ut[(size_t)(32 + m) * MT + n]) : -bf2f(ut[(size_t)(32 + mm) * MT + n]));
        AB[n] = v; }
    LDS_WAIT(); asm volatile("" ::: "memory");
    const float scale = 1.0f / sqrtf((float)L * 64.0f);
    bf16* fnt = ((bf16*)(wsp(F) + WS_FNT)) + (size_t)(g * 64 + m) * MT + ML + b * L;
    { float acc[4] = {0.f, 0.f, 0.f, 0.f}; int idx = 0;
      for (int n = 0; n < L; n += 4) {
#pragma unroll
          for (int r = 0; r < 4; ++r) { const f32x2 ab = AB[n + r]; const f32x2 cs = tab[idx]; idx = (idx + lane) & (L - 1);
#pragma unroll
              for (int j = 0; j < 4; ++j) { const int q = (r * j) & 3;
                  const float c = q == 0 ? cs.x : (q == 1 ? -cs.y : (q == 2 ? -cs.x : cs.y)), s = q == 0 ? cs.y : (q == 1 ? cs.x : (q == 2 ? -cs.y : -cs.x));
                  acc[j] += ab.x * c - ab.y * s; } } }
#pragma unroll
      for (int j = 0; j < 4; ++j) fnt[lane + 64 * j] = (bf16)f2bf(acc[j] * scale); }
    LDS_WAIT(); asm volatile("" ::: "memory");
}

__device__ __forceinline__ void phase_trans(Frame& F) {
    LAS unsigned* tl = (LAS unsigned*)(F.lds + F.wave * 16640);
    const int gw = F.bid * NWAVES + F.wave, NGW = F.G * NWAVES, lane = F.lane;
    const int seg = lane & 7, q = lane >> 3;
    for (int it = gw; it < 2 * 264 * 4; it += NGW) {
        const int which = it / (264 * 4), rem = it % (264 * 4), rt = rem >> 2, ct = rem & 3;
        const bf16* src = (which == 0 ? ((const bf16*)(wsp(F) + WS_HYT)) : ((const bf16*)(wsp(F) + WS_FNT))) + (size_t)(ct * 64) * MT + rt * 64 + 8 * seg;
        bf16* dst = ((bf16*)(wsp(F) + WS_AM)) + (which == 0 ? 512 : 768) + (size_t)(rt * 64) * 1024 + ct * 64 + 8 * seg;
        v4u a[4], b[4];
#pragma unroll
        for (int j = 0; j < 4; ++j) { const bf16* p = src + (size_t)(2 * (8 * j + q)) * MT; a[j] = *(const v4u*)p; b[j] = *(const v4u*)(p + MT); }
#pragma unroll
        for (int j = 0; j < 4; ++j) { LAS unsigned* tp = tl + (8 * seg) * 33 + 8 * j + q;
            tp[0 * 33] = (a[j].x & 0xffffu) | (b[j].x << 16); tp[1 * 33] = (a[j].x >> 16) | (b[j].x & 0xffff0000u);
            tp[2 * 33] = (a[j].y & 0xffffu) | (b[j].y << 16); tp[3 * 33] = (a[j].y >> 16) | (b[j].y & 0xffff0000u);
            tp[4 * 33] = (a[j].z & 0xffffu) | (b[j].z << 16); tp[5 * 33] = (a[j].z >> 16) | (b[j].z & 0xffff0000u);
            tp[6 * 33] = (a[j].w & 0xffffu) | (b[j].w << 16); tp[7 * 33] = (a[j].w >> 16) | (b[j].w & 0xffff0000u); }
        LDS_WAIT(); asm volatile("" ::: "memory");
#pragma unroll
        for (int i = 0; i < 8; ++i) { const int row = q + 8 * i; const LAS unsigned* tp = tl + row * 33 + 4 * seg;
            v4u o; o.x = tp[0]; o.y = tp[1]; o.z = tp[2]; o.w = tp[3];
            *(v4u*)(dst + (size_t)row * 1024) = o; }
        LDS_WAIT(); asm volatile("" ::: "memory");
    }
}

__device__ __forceinline__ void phase_mix_naive(Frame& F, int l) {
    const bool last = (l == DEPTH - 1);
    LAS int* tick = (LAS int*)(F.lds + LDS_TAB + 320);
    if (F.tid == 0) tick[0] = 0;
    __syncthreads();
    SUBPR_START(13)
    { LAS float* wl = (LAS float*)(F.lds + F.wave * 4096);
      const int nt = last ? 16 : 20;
      for (;;) {
          const int t = __builtin_amdgcn_readfirstlane(F.lane == 0 ? atomicAdd((int*)tick, 1) : 0);
          if (t >= nt) break;
          { int z_ = F.z; asm volatile("" : "+s"(z_)); F.z = z_; int ln_ = F.lane; asm volatile("" : "+v"(ln_)); F.lane = ln_; }
          int kind = 0, arg = 0;
          if (last) arg = F.bid * NWAVES + (t & 7) + (t >> 3) * (F.G * NWAVES);
          else if (t == 0) kind = 1;
          else if (t <= 2) { kind = 2; arg = (t - 1) * 256 + F.bid; }
          else if (t <= 18) arg = F.bid * NWAVES + ((t - 3) & 7) + ((t - 3) >> 3) * (F.G * NWAVES);
          else if (F.bid < 128) arg = 4096 + F.bid;
          else kind = 3;
          if (kind == 0) attn_item(F, l, arg);
          else if (kind == 1) hyena_ctx_wave(F, l, F.bid, wl, (LAS f32x2*)(wl + 512));
          else if (kind == 2) fnet_ctx_wave(F, arg >> 8, (arg >> 6) & 3, arg & 63, (LAS f32x2*)wl, (LAS f32x2*)(wl + 512));
      } }
    SUBPR_STOP(13)
    __syncthreads();
    SUBPR_START(14)
    for (int c = F.bid; c < 256; c += F.G) hyena_item_fft(F, l, c);
    SUBPR_STOP(14)
    SUBPR_START(16)
    for (int it = F.bid; it < 256; it += F.G) fnet_item_fft(F, it >> 7, (it >> 5) & 3, it & 31);
    SUBPR_STOP(16)
}

__device__ __forceinline__ void small_gemm_partial(Frame& F, const bf16* A, int lda, const bf16* Bt, int ldb, int k0w, int kw, int row0, int col0) {
    typedef short bf16x8_t __attribute__((ext_vector_type(8))); typedef float f32x16_t __attribute__((ext_vector_type(16)));
    LAS float* part = (LAS float*)F.lds;
    const int r = F.lane & 31, h = F.lane >> 5, k0 = k0w + 8 * h;
    const bf16* ap = A + (size_t)(row0 + r) * lda + k0; const bf16* bp0 = Bt + (size_t)(col0 + r) * ldb + k0; const bf16* bp1 = bp0 + (size_t)32 * ldb;
    f32x16_t acc0, acc1;
#pragma unroll
    for (int q = 0; q < 16; ++q) { acc0[q] = 0.f; acc1[q] = 0.f; }
#pragma unroll 8
    for (int k = 0; k < kw; k += 16) { const bf16x8_t a = *(const bf16x8_t*)(ap + k), b0 = *(const bf16x8_t*)(bp0 + k), b1 = *(const bf16x8_t*)(bp1 + k);
        acc0 = __builtin_amdgcn_mfma_f32_32x32x16_bf16(b0, a, acc0, 0, 0, 0); acc1 = __builtin_amdgcn_mfma_f32_32x32x16_bf16(b1, a, acc1, 0, 0, 0); }
#pragma unroll
    for (int q = 0; q < 16; ++q) { const int col = (q & 3) + 8 * (q >> 2) + 4 * h; part[(F.wave * 64 + col) * 32 + r] = acc0[q]; part[(F.wave * 64 + 32 + col) * 32 + r] = acc1[q]; }
    __syncthreads();
}
__device__ __forceinline__ f32x4 small_gemm_reduce(Frame& F, int w0, int w1) {
    const LAS float* part = (const LAS float*)F.lds;
    const int tok = F.tid & 31, cq = F.tid >> 5; f32x4 s = {0.f, 0.f, 0.f, 0.f};
    for (int w = w0; w < w1; ++w)
#pragma unroll
        for (int e = 0; e < 4; ++e) s[e] += part[(w * 64 + 4 * cq + e) * 32 + tok];
    return s;
}
__device__ __forceinline__ f32x4 small_gemm_tile(Frame& F, const bf16* A, int lda, const bf16* Bt, int ldb, int kbeg, int klen, int row0, int col0) {
    const int kw = klen >> 3;
    small_gemm_partial(F, A, lda, Bt, ldb, kbeg + F.wave * kw, kw, row0, col0);
    const f32x4 s = small_gemm_reduce(F, 0, 8);
    __syncthreads();
    return s;
}
__device__ __forceinline__ void ctx_merge(Frame& F, int l) {
    for (int it = F.bid; it < 256; it += F.G) { const int row0 = ML + (it >> 4) * 32, col0 = (it & 15) * 64;
        const bf16* A = (const bf16*)(wsp(F) + WS_AM); const bf16* Bt = ((const bf16*)(wsp(F) + WS_WPA)) + (size_t)l * 1024 * 1024; const unsigned char* G8 = (const unsigned char*)(wsp(F) + WS_PR);
        const int row = row0 + (F.tid & 31), col = col0 + 4 * (F.tid >> 5); f32x4 tot = {0.f, 0.f, 0.f, 0.f};
        small_gemm_partial(F, A, 1024, Bt, 1024, 128 * F.wave, 128, row0, col0);
#pragma unroll
        for (int br = 0; br < 3; ++br) { const f32x4 p = small_gemm_reduce(F, br == 0 ? 0 : (br == 1 ? 4 : 6), br == 0 ? 4 : (br == 1 ? 6 : 8));
            const int r256 = row & 255, c256 = col & 255;
            const unsigned gw = *(const unsigned*)(G8 + (unsigned)(((row >> 8) * 3 + br) * 4 + (col >> 8)) * 65536u + (unsigned)((((r256 >> 7) * 4 + ((r256 >> 4) & 3)) * 2 + (c256 >> 7)) * 4096)
                                                     + (unsigned)((((((r256 >> 6) & 1) * 4 + ((c256 >> 5) & 3)) * 64 + ((c256 >> 3) & 3) * 16 + (r256 & 15)) * 8) + (col & 7)));
            tot[0] += (float)(gw & 0xffu) * p[0]; tot[1] += (float)((gw >> 8) & 0xffu) * p[1]; tot[2] += (float)((gw >> 16) & 0xffu) * p[2]; tot[3] += (float)(gw >> 24) * p[3]; }
        __syncthreads();
        tot = tot * (1.0f / 255.0f);
        v2u o; o.x = pk2(tot[0], tot[1]); o.y = pk2(tot[2], tot[3]); *(v2u*)(((bf16*)(wsp(F) + WS_M)) + (size_t)row * 1024 + col) = o; }
}
__device__ __forceinline__ void ctx_resid(Frame& F, const bf16* A, int K, const bf16* Bt, const float* gate_ctx  ) {
    for (int it = F.bid; it < 256; it += F.G) { const int row0 = ML + (it >> 4) * 32, col0 = (it & 15) * 64;
        const f32x4 p = small_gemm_tile(F, A, K, Bt, K, 0, K, row0, col0);
        const int row = row0 + (F.tid & 31), col = col0 + 4 * (F.tid >> 5);
        bf16* xp = ((bf16*)(wsp(F) + WS_XS)) + (size_t)row * 1024 + col;
        const v2u xw = *(const v2u*)xp; const f32x4 gv = *(const f32x4*)(gate_ctx + col);
        v2u o; o.x = pk2(bflo(xw.x) + gv[0] * p[0], bfhi(xw.x) + gv[1] * p[1]); o.y = pk2(bflo(xw.y) + gv[2] * p[2], bfhi(xw.y) + gv[3] * p[3]);
        *(v2u*)xp = o; }
}

constexpr int NPL = 11;
constexpr int NPHASES = 1 + DEPTH * NPL + 1;
#ifndef ONE_LAUNCH
#define ONE_LAUNCH 1
#endif

__global__ void __launch_bounds__(NTHREADS, 2) fwd_kernel(Args args) {
    extern __shared__ __attribute__((aligned(16))) unsigned char lds[];
    Frame F;
    F.lds = (LAS unsigned char*)lds;
    F.tid = threadIdx.x; F.lane = F.tid & 63; F.wave = __builtin_amdgcn_readfirstlane(F.tid >> 6);
    F.G = gridDim.x; F.bid = blockIdx.x;
    unsigned char* ws = args.ws; F.ws = ws;
    F.ctl = (unsigned*)(ws + WS_CTL);
    F.a = &args; F.z = 0;
    volatile LAS unsigned* MISC = (volatile LAS unsigned*)(F.lds + MISC_OFF);
    for (int u = F.tid; u < 64; u += NTHREADS) MISC[u] = 0u;
    __syncthreads();
    const int lo = args.ph_lo, hi = args.ph_hi;
    XcdBarrier bar; bar.bar = F.ctl + CW_BAR; bar.x = 0; bar.st = nullptr;
    if (hi - lo > 1) bar = xcd_barrier_post(F.ctl + CW_BAR, MISC + 8);
    F.pr_acc = 0ull; F.pr_t0 = 0ull;
#define PR_TYPE(k) ((k) == 0 ? 11 : ((k) == 1 + DEPTH * NPL ? 12 : (((k) - 1) % NPL)))
#ifndef PROBE_LAYERS
#define PROBE_LAYERS 0xF
#endif
#define PR_LAYER(k) ((k) == 0 || (k) == 1 + DEPTH * NPL ? 0 : (((k) - 1) / NPL))
#define PR_START(k) if (PROBE_MASK && ((PROBE_MASK >> PR_TYPE(k)) & 1) && ((PROBE_LAYERS >> PR_LAYER(k)) & 1)) F.pr_t0 = __builtin_amdgcn_s_memrealtime();
#define PR_STOP(k) if (PROBE_MASK && ((PROBE_MASK >> PR_TYPE(k)) & 1) && ((PROBE_LAYERS >> PR_LAYER(k)) & 1)) F.pr_acc += __builtin_amdgcn_s_memrealtime() - F.pr_t0;
#define PH_BEGIN(k) if (lo <= (k) && (k) < hi) { PR_START(k) { int t_ = threadIdx.x; asm volatile("" : "+v"(t_)); F.tid = t_; F.lane = t_ & 63; F.wave = __builtin_amdgcn_readfirstlane(t_ >> 6); int z_ = 0; asm volatile("" : "+s"(z_)); F.z = z_; }
#define PH_END(k) if ((k) + 1 < hi) xcd_barrier_impl(bar.bar, bar.x, bar.st); PR_STOP(k) }

    PH_BEGIN(0) phase_prologue(F); PH_END(0)

    for (int l = 0; l < DEPTH; ++l) {
        const int pb = 1 + l * NPL;
        const float* modl = ((float*)(wsp(F) + WS_CTL) + CW_MOD) + (size_t)l * 3 * 6144;
        const bool moe = (l & 1) != 0; const int fi = l >> 1;

        PH_BEGIN(pb + 0)
            if (l > 0 && ((l - 1) & 1)) phase_norm<false, true, true>(F, l, nullptr, nullptr, inp(F, I_N1G) + l * 1024, 0, nullptr, MT, F.G > 64 ? 8 : 0);
            else if (l == 0) phase_norm<false, false, true, false>(F, l, inp(F, I_X), inp(F, I_CTX), inp(F, I_N1G) + l * 1024, 0, nullptr, MT, F.G > 64 ? 8 : 0);
            else phase_norm<false, false, true>(F, l, nullptr, nullptr, inp(F, I_N1G) + l * 1024, 0, nullptr, MT, F.G > 64 ? 8 : 0);
            for (int it = F.bid; it < 264; it += F.G) { if (it < 256) filter_tile(F, l, SEQ, it * 32, ((bf16*)(wsp(F) + WS_HF)), it == F.bid); else filter_tile(F, l, CTXL, (it - 256) * 32, ((bf16*)(wsp(F) + WS_HFC)), it == F.bid); }
        PH_END(pb + 0)

        PH_BEGIN(pb + 1)
            pg8::Gemm g{((bf16*)(wsp(F) + WS_H)), ((bf16*)(wsp(F) + WS_WIN)) + (size_t)l * INW * 1024, MT, INW, 1024}; pg8::StaticOrder S; S.init(MT, INW, F.G, F.bid);
            pg8::EpiIn E{wsp(F), l};
            pg8::gemm_phase<pg8::EpiIn, pg8::StaticOrder, true, true>(F.lds, g, S, E);
        PH_END(pb + 1)


        PH_BEGIN(pb + 3) phase_mix_naive(F, l); PH_END(pb + 3)

        PH_BEGIN(pb + 4) phase_trans(F); PH_END(pb + 4)

        PH_BEGIN(pb + 5)
            if (l != DEPTH - 1) ctx_merge(F, l);
            pg8::Gemm g{((bf16*)(wsp(F) + WS_AM)), ((bf16*)(wsp(F) + WS_WPA)) + (size_t)l * 1024 * 1024, ML, 1024, 1024}; pg8::StaticOrder S; S.init(ML, 1024, F.G, F.bid);
            pg8::EpiMerge E{((const unsigned char*)(wsp(F) + WS_PR)), ((bf16*)(wsp(F) + WS_M))};
            pg8::gemm_phase<pg8::EpiMerge, pg8::StaticOrder, true, true>(F.lds, g, S, E);
        PH_END(pb + 5)

        PH_BEGIN(pb + 6)
            if (l != DEPTH - 1) ctx_resid(F, (const bf16*)(wsp(F) + WS_M), 1024, ((const bf16*)(wsp(F) + WS_WO)) + (size_t)l * 1024 * 1024, modl + 2 * 6144 + 2048);
            pg8::Gemm g{((bf16*)(wsp(F) + WS_M)), ((bf16*)(wsp(F) + WS_WO)) + (size_t)l * 1024 * 1024, ML, 1024, 1024}; pg8::StaticOrder S; S.init(ML, 1024, F.G, F.bid);
            pg8::EpiResid E{((bf16*)(wsp(F) + WS_XS)), modl + 2048};
            pg8::gemm_phase<pg8::EpiResid, pg8::StaticOrder, true, true>(F.lds, g, S, E);
        PH_END(pb + 6)

        PH_BEGIN(pb + 7)
            if (moe) phase_norm<true, false, true>(F, l, nullptr, nullptr, inp(F, I_N2G) + l * 1024, 3072, inp(F, I_ROUTER) + (size_t)fi * 1024 * 8, MT);
            else phase_norm<false, false, true>(F, l, nullptr, nullptr, inp(F, I_N2G) + l * 1024, 3072, nullptr, MT);
        PH_END(pb + 7)

        if (moe) {
            PH_BEGIN(pb + 8) phase_moe_slots(F, l); PH_END(pb + 8)
        }

        PH_BEGIN(pb + 9)
            LAS int* poff = (LAS int*)(F.lds + LDS_TAB + 64);
            if (moe) {
                moe_offsets(F, l, poff);
                LAS unsigned* gtab = (LAS unsigned*)(F.lds + LDS_TAB + 128);
                pg8::Gemm g{((bf16*)(wsp(F) + WS_H)), ((bf16*)(wsp(F) + WS_MGU)) + (size_t)(fi * 8) * 5632 * 1024, MOE_MAXP * 256, 8 * 5632, 1024}; pg8::MoeOrder S{22, F.G, F.bid, poff, gtab};
                {
                    const unsigned* cnt = (const unsigned*)(wsp(F) + WS_CTL) + CW_CNT + l * 64; const unsigned* toke = (const unsigned*)(wsp(F) + WS_TOKE);
                    const int np = poff[8], nun = (np * 22 - F.bid + F.G - 1) / F.G;
#pragma unroll 7
                    for (int idx = F.tid; idx < nun * 256; idx += NTHREADS) { const int i = idx >> 8, row = idx & 255, p = (i * F.G + F.bid) / 22; int e = 0;
#pragma unroll
                        for (int k = 1; k < 8; ++k) e += (p >= poff[k]) ? 1 : 0;
                        const int pos = (p - poff[e]) * 256 + row; const unsigned ce = __hip_atomic_load(cnt + e, __ATOMIC_RELAXED, __HIP_MEMORY_SCOPE_AGENT);
                        unsigned tok = 0u; if ((unsigned)pos < ce) tok = toke[(size_t)e * MT + pos];
                        gtab[idx] = (tok < (unsigned)MT ? tok : 0u) * 2048u; }
                    __syncthreads(); }
                pg8::EpiSwiglu E{((bf16*)(wsp(F) + WS_HIDG)), DFF, 22};
                pg8::gemm_phase<pg8::EpiSwiglu, pg8::MoeOrder, true, true, true>(F.lds, g, S, E);
            } else {
                pg8::Gemm g{((bf16*)(wsp(F) + WS_H)), ((bf16*)(wsp(F) + WS_FGU)) + (size_t)fi * 5632 * 1024, MT, 5632, 1024}; pg8::StaticOrder S; S.init(MT, 5632, F.G, F.bid);
                pg8::EpiSwiglu E{((bf16*)(wsp(F) + WS_HID)), DFF, 22};
                pg8::gemm_phase<pg8::EpiSwiglu, pg8::StaticOrder, true, true>(F.lds, g, S, E);
            }
        PH_END(pb + 9)

        PH_BEGIN(pb + 10)
            LAS int* poff = (LAS int*)(F.lds + LDS_TAB + 64);
            if (moe) {
                moe_offsets(F, l, poff);
                const int nun = poff[8] * 4, lfull = (nun / F.G) * F.G;
                { pg8::Gemm g{((bf16*)(wsp(F) + WS_HIDG)), ((bf16*)(wsp(F) + WS_MD)) + (size_t)(fi * 8) * 1024 * 2816, MOE_MAXP * 256, 8 * 1024, DFF}; pg8::MoeOrder S{4, F.G, F.bid, poff, nullptr, lfull};
                  pg8::EpiStore E{((bf16*)(wsp(F) + WS_Y)), 1024, 4};
                  pg8::gemm_phase<pg8::EpiStore, pg8::MoeOrder, true, true>(F.lds, g, S, E); }
                __syncthreads();
                { pg8::Gemm g{((bf16*)(wsp(F) + WS_HIDG)), ((bf16*)(wsp(F) + WS_MD)) + (size_t)(fi * 8) * 1024 * 2816, MOE_MAXP * 256, 8 * 1024, 12 * 64, DFF}; pg8::MoeRemOrder S{4, F.G, F.bid, poff, lfull};
                  pg8::EpiStoreChunk E{((bf16*)(wsp(F) + WS_PS)) - (size_t)(lfull / 4) * 256 * 1024, 1024, 4, (size_t)12 * 256 * 1024};
                  pg8::gemm_phase<pg8::EpiStoreChunk, pg8::MoeRemOrder, true, true>(F.lds, g, S, E); }
            } else {
                ctx_resid(F, (const bf16*)(wsp(F) + WS_HID), DFF, ((const bf16*)(wsp(F) + WS_FD)) + (size_t)fi * 1024 * 2816, modl + 2 * 6144 + 5120);
                pg8::Gemm g{((bf16*)(wsp(F) + WS_HID)), ((bf16*)(wsp(F) + WS_FD)) + (size_t)fi * 1024 * 2816, ML, 1024, DFF}; pg8::StaticOrder S; S.init(ML, 1024, F.G, F.bid);
                pg8::EpiResid E{((bf16*)(wsp(F) + WS_XS)), modl + 5120};
                pg8::gemm_phase<pg8::EpiResid, pg8::StaticOrder, true, true>(F.lds, g, S, E);
            }
        PH_END(pb + 10)
    }
    PH_BEGIN(1 + DEPTH * NPL) phase_norm<false, true, false>(F, DEPTH - 1, nullptr, nullptr, nullptr, 0, nullptr, ML); PH_END(1 + DEPTH * NPL)
#undef PH_BEGIN
#undef PH_END
    if (PROBE_MASK && blockIdx.x == 0) { const unsigned long long t0 = __builtin_amdgcn_s_memrealtime(); while (__builtin_amdgcn_s_memrealtime() - t0 < F.pr_acc * PROBE_AMP) __builtin_amdgcn_s_sleep(8); }
}

extern "C" void kernel_launch(void* const* d_in, const int* in_sizes, int n_in, void* d_out, int out_size, void* d_ws, size_t ws_size, hipStream_t stream) {
    static int grid = 0;
    if (grid == 0) {
        if (n_in != 33 || out_size != ML * DM || ws_size < WS_END2) { fprintf(stderr, "kernel_launch: unexpected shapes (n_in %d out %d ws %zu need %zu)\n", n_in, out_size, ws_size, (size_t)WS_END2); grid = -1; return; }
        int dev = 0, cus = 0, per_cu = 0;
        if (hipGetDevice(&dev) != hipSuccess || hipDeviceGetAttribute(&cus, hipDeviceAttributeMultiprocessorCount, dev) != hipSuccess) { grid = -1; return; }
        if (hipFuncSetAttribute((const void*)fwd_kernel, hipFuncAttributeMaxDynamicSharedMemorySize, LDS_BYTES) != hipSuccess) { fprintf(stderr, "kernel_launch: hipFuncSetAttribute failed\n"); grid = -1; return; }
        if (hipOccupancyMaxActiveBlocksPerMultiprocessor(&per_cu, (const void*)fwd_kernel, NTHREADS, LDS_BYTES) != hipSuccess || per_cu < 1) { fprintf(stderr, "kernel_launch: occupancy query says %d\n", per_cu); }
        (void)hipGetLastError();
        grid = cus;
    }
    if (grid < 0) return;
    if (hipMemsetAsync((char*)d_ws + WS_CTL, 0, CTL_ZERO_BYTES, stream) != hipSuccess) return;
    Args a{};
    for (int i = 0; i < 33; ++i) a.in[i] = (const float*)d_in[i];
    a.in[33] = (const float*)d_out; a.ws = (unsigned char*)d_ws;
#if ONE_LAUNCH
    a.ph_lo = 0; a.ph_hi = NPHASES;
    hipLaunchKernelGGL(fwd_kernel, dim3(grid), dim3(NTHREADS), LDS_BYTES, stream, a);
#else
    for (int k = 0; k < NPHASES; ++k) {
        if (k >= 1 && k < NPHASES - 1) { const int l = (k - 1) / NPL, p = (k - 1) % NPL; if ((l & 1) == 0 && p == 8) continue; }
        a.ph_lo = k; a.ph_hi = k + 1;
        hipLaunchKernelGGL(fwd_kernel, dim3(grid), dim3(NTHREADS), LDS_BYTES, stream, a);
    }
#endif
}
```
